# Optimizing an MI355X kernel written in HIP

```python
import math
import jax, jax.numpy as jnp
from jax import lax
import numpy as np

D_MODEL = 1024
BATCH = 4
SEQ = 4096
DEPTH = 2

D_MIX = D_MODEL
RET_WIDTH = D_MIX // 4
SSM_WIDTH = D_MIX // 4
ATT_WIDTH = D_MIX // 2
RET_DK = 64
RET_DV = 64
RET_HEADS = RET_WIDTH // RET_DV
RET_CHUNK = 128
SSM_CPG = 16
SSM_GROUPS = SSM_WIDTH // SSM_CPG
SSM_STATE = 64
ATT_HEAD_DIM = 64
ATT_HEADS = ATT_WIDTH // ATT_HEAD_DIM
ATT_KV_HEADS = 2
ATT_GQ = ATT_HEADS // ATT_KV_HEADS
KV_WIDTH = ATT_KV_HEADS * ATT_HEAD_DIM
ATT_WINDOW = 128
ATT_BLOCK = 128
D_IN = 4 * RET_WIDTH + SSM_WIDTH + ATT_WIDTH + 2 * KV_WIDTH
N_EXPERTS = 16
EXPERT_FF = 2 * D_MODEL
EC_FACTOR = 2
DEEPNORM_ALPHA = (2.0 * DEPTH) ** 0.25
DEEPNORM_BETA = (8.0 * DEPTH) ** -0.25
LN_EPS = 1e-5
NEG_INF = -1e30

kernel_name = "hybrid_retention_s5_swa_ec_encoder"


def _split_points():
    sizes = (RET_WIDTH, RET_WIDTH, RET_WIDTH, RET_WIDTH, SSM_WIDTH, ATT_WIDTH, KV_WIDTH, KV_WIDTH)
    points, acc = [], 0
    for s in sizes[:-1]:
        acc += s
        points.append(acc)
    return points


def layer_norm(x, g, b):
    xf = x.astype(jnp.float32)
    mu = jnp.mean(xf, axis=-1, keepdims=True)
    var = jnp.mean(jnp.square(xf - mu), axis=-1, keepdims=True)
    y = (xf - mu) * lax.rsqrt(var + LN_EPS) * g.astype(jnp.float32) + b.astype(jnp.float32)
    return y.astype(x.dtype)


def retention(q, k, v, g, theta):
    f32 = jnp.float32
    bsz, seq, _ = q.shape
    nc = seq // RET_CHUNK
    log_gamma = jax.nn.log_sigmoid(theta.astype(f32))
    lg_f, lg_b = log_gamma[0], log_gamma[1]
    shp = (bsz, nc, RET_CHUNK, RET_HEADS, RET_DK)
    qc = q.astype(f32).reshape(shp)
    kc = k.astype(f32).reshape(shp) * RET_DK ** -0.5
    vc = v.astype(f32).reshape(bsz, nc, RET_CHUNK, RET_HEADS, RET_DV)
    pos = jnp.arange(RET_CHUNK, dtype=f32)
    dist = pos[:, None] - pos[None, :]
    adist = jnp.abs(dist)
    dmat = jnp.where(dist >= 0, jnp.exp(lg_f[:, None, None] * adist),
                     jnp.exp(lg_b[:, None, None] * adist))
    scores = jnp.einsum('bcihd,bcjhd->bchij', qc, kc) * dmat
    inner = jnp.einsum('bchij,bcjhe->bcihe', scores, vc)
    w_f = jnp.exp(lg_f[None, :] * (RET_CHUNK - 1 - pos)[:, None])
    w_b = jnp.exp(lg_b[None, :] * pos[:, None])
    kv_f = jnp.einsum('bcjhd,bcjhe->cbhde', kc * w_f[:, :, None], vc)
    kv_b = jnp.einsum('bcjhd,bcjhe->cbhde', kc * w_b[:, :, None], vc)
    dec_f = jnp.exp(lg_f * RET_CHUNK)[None, :, None, None]
    dec_b = jnp.exp(lg_b * RET_CHUNK)[None, :, None, None]
    zero = jnp.zeros((bsz, RET_HEADS, RET_DK, RET_DV), f32)
    _, state_f = lax.scan(lambda s, kv: (dec_f * s + kv, s), zero, kv_f)
    _, state_b = lax.scan(lambda s, kv: (dec_b * s + kv, s), zero, kv_b, reverse=True)
    q_f = qc * jnp.exp(lg_f[None, :] * (pos + 1.0)[:, None])[:, :, None]
    q_b = qc * jnp.exp(lg_b[None, :] * (RET_CHUNK - pos)[:, None])[:, :, None]
    out = (inner + jnp.einsum('bcihd,cbhde->bcihe', q_f, state_f)
           + jnp.einsum('bcihd,cbhde->bcihe', q_b, state_b))
    mu = jnp.mean(out, axis=-1, keepdims=True)
    var = jnp.mean(jnp.square(out - mu), axis=-1, keepdims=True)
    out = ((out - mu) * lax.rsqrt(var + LN_EPS)).reshape(bsz, seq, RET_WIDTH)
    return (jax.nn.silu(g.astype(f32)) * out).astype(q.dtype)


def _ssm_combine(e1, e2):
    a1, b1 = e1
    a2, b2 = e2
    return a2 * a1, a2 * b1 + b2


def s5_mixer(u, lam_re, lam_im, log_step, b_re, b_im, c_re, c_im, d, w_glu, b_glu):
    f32 = jnp.float32
    bsz, seq, _ = u.shape
    lam = lax.complex(lam_re.astype(f32), lam_im.astype(f32))
    step = jnp.exp(log_step.astype(f32))[..., None]
    lam_bar = jnp.exp(lam * step)
    b = lax.complex(b_re.astype(f32), b_im.astype(f32))
    b_bar = ((lam_bar - 1.0) / lam)[..., None] * b[None]
    uf = u.astype(f32)
    ug = uf.reshape(bsz, seq, SSM_GROUPS, SSM_CPG).astype(jnp.complex64)
    bu = jnp.einsum('blgc,rgpc->rblgp', ug, b_bar)
    bu = jnp.stack([bu[0], bu[1][:, ::-1]])
    a = jnp.broadcast_to(lam_bar[:, None, None], bu.shape)
    _, states = lax.associative_scan(_ssm_combine, (a, bu), axis=2)
    states = jnp.stack([states[0], states[1][:, ::-1]])
    c = lax.complex(c_re.astype(f32), c_im.astype(f32))
    y = jnp.einsum('rgcp,rblgp->blgc', c, states).real.reshape(bsz, seq, SSM_WIDTH)
    y = jax.nn.gelu(y + d.astype(f32) * uf)
    gate = jax.nn.sigmoid(y @ w_glu.astype(f32) + b_glu.astype(f32))
    return (y * gate).astype(u.dtype)


def window_sink_attention(q, k, v, sink):
    f32 = jnp.float32
    bsz, seq, _ = q.shape
    nc = seq // ATT_BLOCK
    qb = q.reshape(bsz, nc, ATT_BLOCK, ATT_KV_HEADS, ATT_GQ, ATT_HEAD_DIM) * ATT_HEAD_DIM ** -0.5
    pad = ((0, 0), (1, 1), (0, 0), (0, 0), (0, 0))
    kp = jnp.pad(k.reshape(bsz, nc, ATT_BLOCK, ATT_KV_HEADS, ATT_HEAD_DIM), pad)
    vp = jnp.pad(v.reshape(bsz, nc, ATT_BLOCK, ATT_KV_HEADS, ATT_HEAD_DIM), pad)
    kb = jnp.concatenate([kp[:, :-2], kp[:, 1:-1], kp[:, 2:]], axis=2)
    vb = jnp.concatenate([vp[:, :-2], vp[:, 1:-1], vp[:, 2:]], axis=2)
    scores = jnp.einsum('bcqkgd,bcskd->bckgqs', qb, kb).astype(f32)
    span = jnp.arange(3 * ATT_BLOCK)
    rel = span[None, :] - ATT_BLOCK - jnp.arange(ATT_BLOCK)[:, None]
    spos = jnp.arange(nc)[:, None] * ATT_BLOCK - ATT_BLOCK + span[None, :]
    valid = (jnp.abs(rel) <= ATT_WINDOW)[None] & ((spos >= 0) & (spos < seq))[:, None, :]
    slopes = jnp.exp2(-8.0 * jnp.arange(1, ATT_HEADS + 1, dtype=f32) / ATT_HEADS)
    slopes = slopes.reshape(ATT_KV_HEADS, ATT_GQ)[None, None, :, :, None, None]
    scores = scores - slopes * jnp.abs(rel).astype(f32)
    scores = jnp.where(valid[None, :, None, None], scores, NEG_INF)
    sink_f = sink.astype(f32).reshape(ATT_KV_HEADS, ATT_GQ)[None, None, :, :, None, None]
    m = jnp.maximum(jnp.max(scores, axis=-1, keepdims=True), sink_f)
    p = jnp.exp(scores - m)
    denom = jnp.sum(p, axis=-1, keepdims=True) + jnp.exp(sink_f - m)
    probs = (p / denom).astype(v.dtype)
    out = jnp.einsum('bckgqs,bcskd->bcqkgd', probs, vb)
    return out.reshape(bsz, seq, ATT_WIDTH)


def expert_choice_ffn(x, router_w, w_gate, w_up, w_down):
    bsz, seq, _ = x.shape
    cap = EC_FACTOR * seq // N_EXPERTS
    logits = jnp.einsum('bld,de->ble', x, router_w).astype(jnp.float32)
    aff = jax.nn.softmax(logits, axis=-1)
    gates, idx = lax.top_k(jnp.swapaxes(aff, 1, 2), cap)
    bidx = jnp.arange(bsz)[:, None, None]
    xs = x[bidx, idx]
    hdn = jax.nn.silu(jnp.einsum('becd,edf->becf', xs, w_gate)) * jnp.einsum('becd,edf->becf', xs, w_up)
    out = jnp.einsum('becf,efd->becd', hdn, w_down) * gates[..., None]
    return jnp.zeros_like(x).at[bidx, idx].add(out.astype(x.dtype))


def setup_inputs(seed: int = 0) -> dict:
    key = jax.random.key(seed)
    ks = jax.random.split(key, 26)
    f32 = jnp.float32

    def nrm(k, shape, scale):
        return scale * jax.random.normal(k, shape, f32)

    x = nrm(ks[0], (BATCH, SEQ, D_MODEL), 1.0)
    ln_in_g = 1.0 + nrm(ks[1], (D_MODEL,), 0.02)
    ln_in_b = nrm(ks[2], (D_MODEL,), 0.02)
    col_scale = jnp.concatenate([
        jnp.ones((2 * RET_WIDTH,), f32), jnp.full((RET_WIDTH,), DEEPNORM_BETA, f32),
        jnp.ones((RET_WIDTH + SSM_WIDTH + ATT_WIDTH + KV_WIDTH,), f32),
        jnp.full((KV_WIDTH,), DEEPNORM_BETA, f32)])
    w_in = nrm(ks[3], (DEPTH, D_MODEL, D_IN), D_MODEL ** -0.5) * col_scale
    p_decay = 1.0 - jnp.exp2(-5.0 - jnp.arange(RET_HEADS, dtype=f32))
    ret_theta = jnp.log(p_decay / (1.0 - p_decay))[None, None, :] + nrm(ks[4], (DEPTH, 2, RET_HEADS), 0.05)
    ssm_lambda_re = -0.5 + nrm(ks[5], (DEPTH, 2, SSM_GROUPS, SSM_STATE), 0.01)
    ssm_lambda_im = jnp.pi * jnp.arange(SSM_STATE, dtype=f32) + nrm(ks[6], (DEPTH, 2, SSM_GROUPS, SSM_STATE), 0.01)
    ssm_log_step = jax.random.uniform(ks[7], (DEPTH, 2, SSM_GROUPS), f32, math.log(1e-3), math.log(1e-1))
    ssm_b_re = nrm(ks[8], (DEPTH, SSM_GROUPS, SSM_STATE, SSM_CPG), (2.0 * SSM_CPG) ** -0.5)
    ssm_b_im = nrm(ks[9], (DEPTH, SSM_GROUPS, SSM_STATE, SSM_CPG), (2.0 * SSM_CPG) ** -0.5)
    ssm_c_re = nrm(ks[10], (DEPTH, 2, SSM_GROUPS, SSM_CPG, SSM_STATE), (4.0 * SSM_STATE) ** -0.5)
    ssm_c_im = nrm(ks[11], (DEPTH, 2, SSM_GROUPS, SSM_CPG, SSM_STATE), (4.0 * SSM_STATE) ** -0.5)
    ssm_d = nrm(ks[12], (DEPTH, SSM_WIDTH), 1.0)
    ssm_w_glu = nrm(ks[13], (DEPTH, SSM_WIDTH, SSM_WIDTH), SSM_WIDTH ** -0.5)
    ssm_b_glu = nrm(ks[14], (DEPTH, SSM_WIDTH), 0.02)
    attn_sink = nrm(ks[15], (DEPTH, ATT_HEADS), 1.0)
    w_out = nrm(ks[16], (DEPTH, D_MIX, D_MODEL), D_MIX ** -0.5 * DEEPNORM_BETA)
    ln1_g = 1.0 + nrm(ks[17], (DEPTH, D_MODEL), 0.02)
    ln1_b = nrm(ks[18], (DEPTH, D_MODEL), 0.02)
    router_w = nrm(ks[19], (DEPTH, D_MODEL, N_EXPERTS), D_MODEL ** -0.5)
    exp_w_gate = nrm(ks[20], (DEPTH, N_EXPERTS, D_MODEL, EXPERT_FF), D_MODEL ** -0.5)
    exp_w_up = nrm(ks[21], (DEPTH, N_EXPERTS, D_MODEL, EXPERT_FF), D_MODEL ** -0.5 * DEEPNORM_BETA)
    exp_w_down = nrm(ks[22], (DEPTH, N_EXPERTS, EXPERT_FF, D_MODEL), EXPERT_FF ** -0.5 * DEEPNORM_BETA)
    ln2_g = 1.0 + nrm(ks[23], (DEPTH, D_MODEL), 0.02)
    ln2_b = nrm(ks[24], (DEPTH, D_MODEL), 0.02)
    return {"x": x, "ln_in_g": ln_in_g, "ln_in_b": ln_in_b, "w_in": w_in, "ret_theta": ret_theta,
            "ssm_lambda_re": ssm_lambda_re, "ssm_lambda_im": ssm_lambda_im, "ssm_log_step": ssm_log_step,
            "ssm_b_re": ssm_b_re, "ssm_b_im": ssm_b_im, "ssm_c_re": ssm_c_re, "ssm_c_im": ssm_c_im,
            "ssm_d": ssm_d, "ssm_w_glu": ssm_w_glu, "ssm_b_glu": ssm_b_glu, "attn_sink": attn_sink,
            "w_out": w_out, "ln1_g": ln1_g, "ln1_b": ln1_b, "router_w": router_w,
            "exp_w_gate": exp_w_gate, "exp_w_up": exp_w_up, "exp_w_down": exp_w_down,
            "ln2_g": ln2_g, "ln2_b": ln2_b}


def reference(x, ln_in_g, ln_in_b, w_in, ret_theta, ssm_lambda_re, ssm_lambda_im, ssm_log_step,
              ssm_b_re, ssm_b_im, ssm_c_re, ssm_c_im, ssm_d, ssm_w_glu, ssm_b_glu, attn_sink,
              w_out, ln1_g, ln1_b, router_w, exp_w_gate, exp_w_up, exp_w_down, ln2_g, ln2_b):
    h = layer_norm(x, ln_in_g, ln_in_b)
    for l in range(DEPTH):
        proj = jnp.einsum('bld,de->ble', h, w_in[l])
        rq, rk, rv, rg, su, aq, ak, av = jnp.split(proj, _split_points(), axis=-1)
        y_ret = retention(rq, rk, rv, rg, ret_theta[l])
        y_ssm = s5_mixer(su, ssm_lambda_re[l], ssm_lambda_im[l], ssm_log_step[l], ssm_b_re[l], ssm_b_im[l],
                         ssm_c_re[l], ssm_c_im[l], ssm_d[l], ssm_w_glu[l], ssm_b_glu[l])
        y_att = window_sink_attention(aq, ak, av, attn_sink[l])
        mix = jnp.einsum('ble,ed->bld', jnp.concatenate([y_ret, y_ssm, y_att], axis=-1), w_out[l])
        h = layer_norm(DEEPNORM_ALPHA * h + mix, ln1_g[l], ln1_b[l])
        ffn = expert_choice_ffn(h, router_w[l], exp_w_gate[l], exp_w_up[l], exp_w_down[l])
        h = layer_norm(DEEPNORM_ALPHA * h + ffn, ln2_g[l], ln2_b[l])
    return h
```

```cpp
#include <hip/hip_runtime.h>
#include <hip/hip_cooperative_groups.h>
#include <cstdio>
#include <cstdint>
namespace cg = cooperative_groups;
namespace pg8 {
#define PG8_LAS __attribute__((address_space(3)))
typedef unsigned short bf16_t;
typedef short bf16x8 __attribute__((ext_vector_type(8)));
typedef float f32x4 __attribute__((ext_vector_type(4)));
typedef unsigned u32x4 __attribute__((ext_vector_type(4)));
constexpr int BM = 256, BK = 64, HALF = 128, HTB = HALF * BK * 2  , STAGE_BYTES = 8 * HTB, NXCD = 8, WGM = 8;

__host__ __device__ __forceinline__ int lds_byte(int r, int c) { const int st = (r >> 4) * 2 + (c >> 5), rr = r & 15, cc = c & 31, ob = rr * 64 + cc * 2; return st * 1024 + (ob ^ (((ob >> 9) & 1) << 5)); }
__host__ __device__ __forceinline__ void stage_rc(int b, int& R, int& C) { const int st = b / 1024, sb = b % 1024, swz = sb ^ (((sb >> 9) & 1) << 5); R = (st >> 1) * 16 + swz / 64; C = (st & 1) * 32 + (swz % 64) / 2; }
__host__ __device__ __forceinline__ int perm32(int rho) { const int n = rho >> 4, i = rho & 15; return 8 * (i >> 2) + 4 * n + (i & 3); }

struct Unit { int pm, pn; };
struct Gemm { const bf16_t* A; const bf16_t* Bt; int M, N, K; };

struct StaticOrder {
    int nM, nN, nwg, G, c;
    __host__ __device__ void init(int M, int N, int G_, int c_) { nM = M / BM; nN = N / BM; nwg = nM * nN; G = G_; c = c_; }
    __host__ __device__ bool next(int i, Unit& u) const {
        const long L = (long)i * G + c; if (L >= nwg) return false;
        int wgid = (int)L; { const int q = nwg / NXCD, r = nwg % NXCD, xcd = wgid % NXCD, off = wgid / NXCD; wgid = (xcd < r ? xcd * (q + 1) : r * (q + 1) + (xcd - r) * q) + off; }
        const int nig = WGM * nN, gid = wgid / nig, fm = gid * WGM, gsz = (nM - fm) < WGM ? (nM - fm) : WGM;
        u.pm = fm + ((wgid % nig) % gsz); u.pn = (wgid % nig) / gsz; return true;
    }
    __device__ __forceinline__ void a_ready(const Unit&) const {}
    __device__ __forceinline__ void done(const Unit&) const {}
};

__device__ __forceinline__ unsigned cvt_pk_bf16(float lo, float hi) { unsigned r; asm volatile("v_cvt_pk_bf16_f32 %0, %1, %2" : "=v"(r) : "v"(lo), "v"(hi)); return r; }
typedef unsigned u32x2 __attribute__((ext_vector_type(2)));

struct GroupedOrder {
    int upe, nNe, nwg, G, c;
    __host__ __device__ void init(int nNe_, int G_, int c_) { nNe = nNe_; upe = 8 * nNe_; nwg = 16 * upe; G = G_; c = c_; }
    __host__ __device__ bool next(int i, Unit& u) const {
        const long L = (long)i * G + c; if (L >= nwg) return false;
        int wgid = (int)L; { const int q = nwg / NXCD, r = nwg % NXCD, xcd = wgid % NXCD, off = wgid / NXCD; wgid = (xcd < r ? xcd * (q + 1) : r * (q + 1) + (xcd - r) * q) + off; }
        const int e = wgid / upe, rr = wgid % upe;
        u.pm = e * 8 + (rr & 7); u.pn = e * nNe + (rr >> 3); return true;
    }
    __device__ __forceinline__ void a_ready(const Unit&) const {}
    __device__ __forceinline__ void done(const Unit&) const {}
};

struct EpiStoreBf16 {
    static constexpr bool PERM = true, AFTER_DRAIN = false;
    bf16_t* O; int ldc;
    __device__ __forceinline__ void operator()(const f32x4 (&acc)[2][2][4][2], const Unit& u, int wr, int wc, int fr, int fq) const {
        const int row0 = u.pm * BM + wr * 64 + fr, col0 = u.pn * BM + wc * 32 + 8 * fq;
#pragma unroll
        for (int ai = 0; ai < 2; ++ai)
#pragma unroll
            for (int m = 0; m < 4; ++m) { bf16_t* rowp = O + (size_t)(row0 + ai * HALF + m * 16) * ldc + col0;
#pragma unroll
                for (int bj = 0; bj < 2; ++bj) { const f32x4 v0 = acc[ai][bj][m][0], v1 = acc[ai][bj][m][1];
                    u32x4 w; w.x = cvt_pk_bf16(v0[0], v0[1]); w.y = cvt_pk_bf16(v0[2], v0[3]); w.z = cvt_pk_bf16(v1[0], v1[1]); w.w = cvt_pk_bf16(v1[2], v1[3]);
                    *(u32x4*)(rowp + bj * HALF) = w; } }
    }
};
struct EpiResF32 {
    static constexpr bool PERM = false, AFTER_DRAIN = false;
    const float* base; float* O; int ldc; float alpha;
    __device__ __forceinline__ void operator()(const f32x4 (&acc)[2][2][4][2], const Unit& u, int wr, int wc, int fr, int fq) const {
        const int row0 = u.pm * BM + wr * 64 + fr, col0 = u.pn * BM + wc * 32 + 4 * fq;
#pragma unroll
        for (int ai = 0; ai < 2; ++ai)
#pragma unroll
            for (int m = 0; m < 4; ++m) { const size_t ro = (size_t)(row0 + ai * HALF + m * 16) * ldc + col0;
#pragma unroll
                for (int bj = 0; bj < 2; ++bj)
#pragma unroll
                    for (int n = 0; n < 2; ++n) { const f32x4 b = *(const f32x4*)(base + ro + bj * HALF + 16 * n); *(f32x4*)(O + ro + bj * HALF + 16 * n) = b * alpha + acc[ai][bj][m][n]; } }
    }
};
struct EpiSwiGLU {
    static constexpr bool PERM = true, AFTER_DRAIN = false;
    bf16_t* O; int ldc; int ntn;
    __device__ __forceinline__ void operator()(const f32x4 (&acc)[2][2][4][2], const Unit& u, int wr, int wc, int fr, int fq) const {
        const int row0 = u.pm * BM + wr * 64 + fr, col0 = ((u.pn % ntn) * BM + wc * 32 + 8 * fq) >> 1;
#pragma unroll
        for (int ai = 0; ai < 2; ++ai)
#pragma unroll
            for (int m = 0; m < 4; ++m) { bf16_t* rowp = O + (size_t)(row0 + ai * HALF + m * 16) * ldc + col0;
#pragma unroll
                for (int bj = 0; bj < 2; ++bj) { const f32x4 v0 = acc[ai][bj][m][0], v1 = acc[ai][bj][m][1];
                    const float h0 = v0[0] / (1.f + __expf(-v0[0])) * v0[1], h1 = v0[2] / (1.f + __expf(-v0[2])) * v0[3];
                    const float h2 = v1[0] / (1.f + __expf(-v1[0])) * v1[1], h3 = v1[2] / (1.f + __expf(-v1[2])) * v1[3];
                    u32x2 w; w.x = cvt_pk_bf16(h0, h1); w.y = cvt_pk_bf16(h2, h3);
                    *(u32x2*)(rowp + bj * (HALF / 2)) = w; } }
    }
};
struct EpiScaleRow {
    static constexpr bool PERM = true, AFTER_DRAIN = false;
    bf16_t* O; int ldc; int ntn; const float* gate;
    __device__ __forceinline__ void operator()(const f32x4 (&acc)[2][2][4][2], const Unit& u, int wr, int wc, int fr, int fq) const {
        const int row0 = u.pm * BM + wr * 64 + fr, col0 = (u.pn % ntn) * BM + wc * 32 + 8 * fq;
#pragma unroll
        for (int ai = 0; ai < 2; ++ai)
#pragma unroll
            for (int m = 0; m < 4; ++m) { const int row = row0 + ai * HALF + m * 16; const float gsc = gate[row]; bf16_t* rowp = O + (size_t)row * ldc + col0;
#pragma unroll
                for (int bj = 0; bj < 2; ++bj) { const f32x4 v0 = acc[ai][bj][m][0] * gsc, v1 = acc[ai][bj][m][1] * gsc;
                    u32x4 w; w.x = cvt_pk_bf16(v0[0], v0[1]); w.y = cvt_pk_bf16(v0[2], v0[3]); w.z = cvt_pk_bf16(v1[0], v1[1]); w.w = cvt_pk_bf16(v1[2], v1[3]);
                    *(u32x4*)(rowp + bj * HALF) = w; } }
    }
};

template <class Epi, class Sched, bool ALIGN_EPI = false, bool SP2 = false>
__device__ __forceinline__ void gemm_phase(PG8_LAS unsigned char* lds, const Gemm g, const Sched& S, const Epi& E) {
    int tid_ = threadIdx.x; asm volatile("" : "+v"(tid_)); const int tid = tid_, wid = __builtin_amdgcn_readfirstlane(tid >> 6), lane = tid & 63, wr = wid >> 2, wc = wid & 3, fr = lane & 15, fq = lane >> 4;
    const int K = g.K, nt = K / BK;
    unsigned voffA[2], voffB[2];
#pragma unroll
    for (int i = 0; i < 2; ++i) { int R, C; stage_rc(tid * 16 + i * 8192, R, C); const int Rb = Epi::PERM ? ((R & ~31) + perm32(R & 31)) : R;
        voffA[i] = (unsigned)(R * K + C) * 2u; voffB[i] = (unsigned)(Rb * K + C) * 2u; }
    const size_t kstep = (size_t)(BK * 2);
    const size_t hstep = (size_t)HALF * K * 2;
    const size_t tstep = 2 * hstep;
    const unsigned ldsw = (unsigned)wid * 1024u;
    const int aoff = lds_byte(wr * 64 + fr, fq * 8), boff = lds_byte(wc * 32 + fr, fq * 8);
#define PG8_SA(b, h) (((b) * 2 + (h)) * HTB)
#define PG8_SB(b, h) ((4 + (b) * 2 + (h)) * HTB)
#define PG8_STAGE(bufoff, gbase, voff) do { _Pragma("unroll") for (int _i = 0; _i < 2; ++_i) \
        __builtin_amdgcn_global_load_lds((const unsigned*)((const char*)(gbase) + (voff)[_i]), (PG8_LAS unsigned*)(lds + (bufoff) + ldsw + _i * 8192), 16, 0, 0); } while (0)
#define PG8_LDA(dst, b, h) do { _Pragma("unroll") for (int m = 0; m < 4; ++m) _Pragma("unroll") for (int k = 0; k < 2; ++k) dst[m][k] = *(const PG8_LAS bf16x8*)(lds + PG8_SA(b, h) + aoff + m * 2048 + k * 1024); } while (0)
#define PG8_LDB(dst, b, h) do { _Pragma("unroll") for (int n = 0; n < 2; ++n) _Pragma("unroll") for (int k = 0; k < 2; ++k) dst[n][k] = *(const PG8_LAS bf16x8*)(lds + PG8_SB(b, h) + boff + n * 2048 + k * 1024); } while (0)
#define PG8_MMA(ai, bj, At, Bt) do { __builtin_amdgcn_s_setprio(1); _Pragma("unroll") for (int m = 0; m < 4; ++m) _Pragma("unroll") for (int n = 0; n < 2; ++n) _Pragma("unroll") for (int k = 0; k < 2; ++k) \
        acc[ai][bj][m][n] = __builtin_amdgcn_mfma_f32_16x16x32_bf16(Bt[n][k], At[m][k], acc[ai][bj][m][n], 0, 0, 0); __builtin_amdgcn_s_setprio(0); } while (0)
#define PG8_WAIT_V(n) asm volatile("s_waitcnt vmcnt(" #n ")" ::: "memory")
#define PG8_WAIT_L(n) asm volatile("s_waitcnt lgkmcnt(" #n ")" ::: "memory")
#define PG8_BAR __builtin_amdgcn_s_barrier()
#define PG8_SCHED __builtin_amdgcn_sched_barrier(0)
    Unit cur, nxt; int ui = 0;
    if (!S.next(0, cur)) return;
    f32x4 acc[2][2][4][2];
#pragma unroll
    for (int a = 0; a < 2; ++a)
#pragma unroll
        for (int b = 0; b < 2; ++b)
#pragma unroll
            for (int m = 0; m < 4; ++m)
#pragma unroll
                for (int n = 0; n < 2; ++n) acc[a][b][m][n] = (f32x4){0.f, 0.f, 0.f, 0.f};
    bf16x8 At[4][2], B0[2][2], B1[2][2];
    const char* cA = (const char*)g.A + (size_t)cur.pm * tstep; const char* cB = (const char*)g.Bt + (size_t)cur.pn * tstep;
    S.a_ready(cur);
    if constexpr (SP2) {
        PG8_STAGE(PG8_SB(0, 0), cB, voffB); PG8_STAGE(PG8_SB(0, 1), cB + hstep, voffB); PG8_STAGE(PG8_SA(0, 0), cA, voffA); PG8_STAGE(PG8_SA(0, 1), cA + hstep, voffA);
        if (wr == 1) PG8_BAR;
        PG8_WAIT_V(2); PG8_BAR;
        PG8_STAGE(PG8_SB(1, 0), cB + kstep, voffB); PG8_STAGE(PG8_SA(1, 0), cA + kstep, voffA); PG8_STAGE(PG8_SB(1, 1), cB + hstep + kstep, voffB);
        PG8_WAIT_V(6); PG8_BAR;
    } else {
        PG8_STAGE(PG8_SB(0, 0), cB, voffB); PG8_STAGE(PG8_SA(0, 0), cA, voffA); PG8_STAGE(PG8_SB(0, 1), cB + hstep, voffB); PG8_STAGE(PG8_SA(0, 1), cA + hstep, voffA);
        if (wr == 1) PG8_BAR;
        PG8_WAIT_V(4); PG8_BAR;
        PG8_STAGE(PG8_SB(1, 0), cB + kstep, voffB); PG8_STAGE(PG8_SA(1, 0), cA + kstep, voffA); PG8_STAGE(PG8_SB(1, 1), cB + hstep + kstep, voffB);
        PG8_WAIT_V(6); PG8_BAR;
    }
    for (;;) {
        const bool has_next = S.next(ui + 1, nxt);
        const char* nA = has_next ? (const char*)g.A + (size_t)nxt.pm * tstep : cA; const char* nB = has_next ? (const char*)g.Bt + (size_t)nxt.pn * tstep : cB;
        for (int t = 0; t < nt; t += 2) {
            const bool last = (t == nt - 2);
            const char* a1 = cA + (size_t)(t + 1) * kstep;
            const char* a2 = last ? nA : cA + (size_t)(t + 2) * kstep; const char* b2 = last ? nB : cB + (size_t)(t + 2) * kstep;
            const char* a3 = a2 + kstep; const char* b3 = b2 + kstep;
            if (last && has_next) S.a_ready(nxt);
            if constexpr (SP2) {
            PG8_LDB(B0, 0, 0); PG8_LDB(B1, 0, 1); PG8_SCHED; PG8_LDA(At, 0, 0); PG8_STAGE(PG8_SA(1, 1), a1 + hstep, voffA);
            PG8_WAIT_V(8); PG8_WAIT_L(0); PG8_BAR; PG8_MMA(0, 0, At, B0); PG8_MMA(0, 1, At, B1); PG8_BAR; PG8_SCHED;
            PG8_LDA(At, 0, 1); PG8_STAGE(PG8_SB(0, 0), b2, voffB); PG8_STAGE(PG8_SB(0, 1), b2 + hstep, voffB); PG8_STAGE(PG8_SA(0, 0), a2, voffA);
            PG8_WAIT_V(8); PG8_WAIT_L(0); PG8_BAR; PG8_MMA(1, 0, At, B0); PG8_MMA(1, 1, At, B1); PG8_BAR; PG8_SCHED;
            PG8_LDB(B0, 1, 0); PG8_LDB(B1, 1, 1); PG8_SCHED; PG8_LDA(At, 1, 0); PG8_STAGE(PG8_SA(0, 1), a2 + hstep, voffA);
            PG8_WAIT_V(8); PG8_WAIT_L(0); PG8_BAR; PG8_MMA(0, 0, At, B0); PG8_MMA(0, 1, At, B1); PG8_BAR; PG8_SCHED;
            PG8_LDA(At, 1, 1); PG8_STAGE(PG8_SB(1, 0), b3, voffB); PG8_STAGE(PG8_SB(1, 1), b3 + hstep, voffB); PG8_STAGE(PG8_SA(1, 0), a3, voffA);
            PG8_WAIT_V(8); PG8_WAIT_L(0); PG8_BAR; PG8_MMA(1, 0, At, B0); PG8_MMA(1, 1, At, B1); PG8_BAR; PG8_SCHED;
            } else {
            PG8_LDB(B0, 0, 0); PG8_SCHED; PG8_LDA(At, 0, 0); PG8_STAGE(PG8_SA(1, 1), a1 + hstep, voffA);
            PG8_WAIT_L(8); PG8_BAR; PG8_WAIT_L(0); PG8_MMA(0, 0, At, B0); PG8_BAR; PG8_SCHED;
            PG8_LDB(B1, 0, 1); PG8_STAGE(PG8_SB(0, 0), b2, voffB);
            PG8_BAR; PG8_WAIT_L(0); PG8_MMA(0, 1, At, B1); PG8_BAR;
            PG8_LDA(At, 0, 1); PG8_STAGE(PG8_SA(0, 0), a2, voffA);
            PG8_BAR; PG8_WAIT_L(0); PG8_MMA(1, 0, At, B0); PG8_BAR; PG8_SCHED;
            PG8_STAGE(PG8_SB(0, 1), b2 + hstep, voffB);
            PG8_WAIT_V(6); PG8_BAR; PG8_MMA(1, 1, At, B1); PG8_BAR;
            PG8_LDB(B0, 1, 0); PG8_SCHED; PG8_LDA(At, 1, 0); PG8_STAGE(PG8_SA(0, 1), a2 + hstep, voffA);
            PG8_WAIT_L(8); PG8_BAR; PG8_WAIT_L(0); PG8_MMA(0, 0, At, B0); PG8_BAR; PG8_SCHED;
            PG8_LDB(B1, 1, 1); PG8_STAGE(PG8_SB(1, 0), b3, voffB);
            PG8_BAR; PG8_WAIT_L(0); PG8_MMA(0, 1, At, B1); PG8_BAR;
            PG8_LDA(At, 1, 1); PG8_STAGE(PG8_SA(1, 0), a3, voffA);
            PG8_BAR; PG8_WAIT_L(0); PG8_MMA(1, 0, At, B0); PG8_BAR; PG8_SCHED;
            PG8_STAGE(PG8_SB(1, 1), b3 + hstep, voffB);
            PG8_WAIT_V(6); PG8_BAR; PG8_MMA(1, 1, At, B1); PG8_BAR;
            }
        }
        if constexpr (ALIGN_EPI) { if (wr == 0) PG8_BAR; }
        if constexpr (!Epi::AFTER_DRAIN) { E(acc, cur, wr, wc, fr, fq); S.done(cur); }
        if (!has_next) break;
#pragma unroll
        for (int a = 0; a < 2; ++a)
#pragma unroll
            for (int b = 0; b < 2; ++b)
#pragma unroll
                for (int m = 0; m < 4; ++m)
#pragma unroll
                    for (int n = 0; n < 2; ++n) acc[a][b][m][n] = (f32x4){0.f, 0.f, 0.f, 0.f};
        cur = nxt; cA = nA; cB = nB; ++ui;
        if constexpr (ALIGN_EPI) { if (wr == 1) PG8_BAR; }
    }
    PG8_WAIT_V(0);
    if constexpr (!ALIGN_EPI) { if (wr == 0) PG8_BAR; }
    PG8_BAR;
    if constexpr (Epi::AFTER_DRAIN) { E.fused(acc, cur, wr, wc, fr, fq, lds, wid, lane); S.done(cur); }
#undef PG8_SA
#undef PG8_SB
#undef PG8_STAGE
#undef PG8_LDA
#undef PG8_LDB
#undef PG8_MMA
#undef PG8_WAIT_V
#undef PG8_WAIT_L
#undef PG8_BAR
#undef PG8_SCHED
}
}

using pg8::bf16_t; using pg8::bf16x8; using pg8::f32x4; using pg8::u32x4; using pg8::u32x2;
#define LAS __attribute__((address_space(3)))
typedef short bf16x4 __attribute__((ext_vector_type(4)));

constexpr int NB = 4, SEQ = 4096, DM = 1024, MTOK = NB * SEQ, DIN = 2048, NE = 16, FF = 2048, CAP = 512, NROWX = NE * NB * CAP;
constexpr float ALPHA = 1.41421356237309515f, LN_EPS = 1e-5f;
constexpr int NWAVES = 8, NTHR = 512;
constexpr int LDS_BYTES = 147456;
constexpr int S5T = 32, S5NCH = SEQ / S5T;

constexpr size_t MiB = 1u << 20;
constexpr size_t WS_WIN = 0, WS_WOUT = 8 * MiB, WS_WGLU = 12 * MiB, WS_S5TAB = 13 * MiB, WS_AFFT = 14 * MiB, WS_IDX = 15 * MiB, WS_GATE = 16 * MiB, WS_SLOT = 17 * MiB;
constexpr size_t WS_WGU = 32 * MiB, WS_WD = 288 * MiB, WS_H32 = 416 * MiB, WS_HBF = 480 * MiB, WS_RA = 512 * MiB  , WS_RB = 576 * MiB  ;
constexpr size_t WS_HDN = 640 * MiB, WS_KVF = 768 * MiB, WS_KVB = 776 * MiB, WS_STF = 784 * MiB, WS_STB = 792 * MiB, WS_S5E = 800 * MiB, WS_S5C = 808 * MiB, WS_END = 816 * MiB;

struct Args { const float* in[25]; float* out; unsigned char* ws; int ph_lo, ph_hi; };

__device__ __forceinline__ unsigned f2bf(float f) { unsigned u = __float_as_uint(f); return (u + 0x7fffu + ((u >> 16) & 1u)) >> 16; }
__device__ __forceinline__ unsigned pk2(float lo, float hi) { return f2bf(lo) | (f2bf(hi) << 16); }
__device__ __forceinline__ float bflo(unsigned w) { return __uint_as_float(w << 16); }
__device__ __forceinline__ float bfhi(unsigned w) { return __uint_as_float(w & 0xffff0000u); }
__device__ __forceinline__ f32x4 mfma16(bf16x8 a, bf16x8 b, f32x4 c) { return __builtin_amdgcn_mfma_f32_16x16x32_bf16(a, b, c, 0, 0, 0); }
__device__ __forceinline__ float wave_sum(float v) {
#pragma unroll
    for (int o = 1; o < 64; o <<= 1) v += __shfl_xor(v, o);
    return v;
}
__device__ __forceinline__ bf16x8 pack8(const f32x4& a, const f32x4& b) {
    u32x4 w; w.x = pg8::cvt_pk_bf16(a[0], a[1]); w.y = pg8::cvt_pk_bf16(a[2], a[3]); w.z = pg8::cvt_pk_bf16(b[0], b[1]); w.w = pg8::cvt_pk_bf16(b[2], b[3]);
    return __builtin_bit_cast(bf16x8, w);
}
__device__ __forceinline__ bf16x8 cat8(bf16x4 lo, bf16x4 hi) { bf16x8 r; r[0] = lo[0]; r[1] = lo[1]; r[2] = lo[2]; r[3] = lo[3]; r[4] = hi[0]; r[5] = hi[1]; r[6] = hi[2]; r[7] = hi[3]; return r; }
#define LDS_WAIT() asm volatile("s_waitcnt lgkmcnt(0)" ::: "memory")

__device__ __forceinline__ void conv_item(const float* __restrict__ src, int K, int N, bf16_t* __restrict__ dst, int rmul, int ro, int kb, int nb, LAS float* scr, int lane) {
    const int k0 = kb * 64, n0 = nb * 64, r4 = lane >> 4, c4 = (lane & 15) * 4;
#pragma unroll
    for (int i = 0; i < 16; ++i) { const int kk = i * 4 + r4; const f32x4 v = *(const f32x4*)(src + (size_t)(k0 + kk) * N + n0 + c4); *(LAS f32x4*)(scr + kk * 68 + c4) = v; }
    LDS_WAIT();
    bf16_t* drow = dst + (size_t)((n0 + lane) * rmul + ro) * K + k0;
#pragma unroll
    for (int p = 0; p < 8; ++p) {
        const LAS float* s = scr + (8 * p) * 68 + lane;
        u32x4 o; o.x = pk2(s[0], s[68]); o.y = pk2(s[2 * 68], s[3 * 68]); o.z = pk2(s[4 * 68], s[5 * 68]); o.w = pk2(s[6 * 68], s[7 * 68]);
        *(u32x4*)(drow + 8 * p) = o;
    }
    LDS_WAIT();
}
__device__ __forceinline__ void sincos_rev(double f, double& sn, double& cs) {
    const double a = f * 6.283185307179586476925;
    const double q = rint(a * 0.636619772367581343);
    const double r = a - q * 1.570796326794896619;
    const double r2 = r * r;
    double s = -7.6471637318198164759e-13; s = s * r2 + 1.6059043836821614599e-10; s = s * r2 - 2.5052108385441718775e-8; s = s * r2 + 2.7557319223985890653e-6;
    s = s * r2 - 1.9841269841269841270e-4; s = s * r2 + 8.3333333333333333333e-3; s = s * r2 - 1.6666666666666666667e-1; s = s * r2 * r + r;
    double c = 4.7794773323873852974e-14; c = c * r2 - 1.1470745597729724714e-11; c = c * r2 + 2.0876756987868098979e-9; c = c * r2 - 2.7557319223985890653e-7;
    c = c * r2 + 2.4801587301587301587e-5; c = c * r2 - 1.3888888888888888889e-3; c = c * r2 + 4.1666666666666666667e-2; c = c * r2 - 0.5; c = c * r2 + 1.0;
    const int qi = ((int)q) & 3;
    sn = (qi == 0) ? s : (qi == 1) ? c : (qi == 2) ? -s : -c;
    cs = (qi == 0) ? c : (qi == 1) ? -s : (qi == 2) ? -c : s;
}
__device__ __forceinline__ double exp_small(double x) {
    const double y = x * (1.0 / 64.0);
    double e = 1.0 / 479001600.0;
    e = e * y + 1.0 / 39916800.0; e = e * y + 1.0 / 3628800.0; e = e * y + 1.0 / 362880.0; e = e * y + 1.0 / 40320.0; e = e * y + 1.0 / 5040.0; e = e * y + 1.0 / 720.0;
    e = e * y + 1.0 / 120.0; e = e * y + 1.0 / 24.0; e = e * y + 1.0 / 6.0; e = e * y + 0.5; e = e * y + 1.0; e = e * y + 1.0;
#pragma unroll
    for (int i = 0; i < 6; ++i) e = e * e;
    return e;
}
__device__ __forceinline__ void s5_table_entry(const Args& a, int t) {
    const int g = (t >> 6) & 15, lr = t >> 10;
    const double lre = (double)a.in[5][t], lim = (double)a.in[6][t];
    const double step = exp_small((double)a.in[7][lr * 16 + g]);
    const double ar = lre * step, th = lim * step;
    const double rev = th * 0.15915494309189533577; const double fr = rev - rint(rev);
    double sn, cs; sincos_rev(fr, sn, cs);
    const double mag = exp_small(ar);
    const double br = mag * cs, bi = mag * sn;
    const double nr = br - 1.0, ni = bi, den = lre * lre + lim * lim;
    const double cr = (nr * lre + ni * lim) / den, ci = (ni * lre - nr * lim) / den;
    const double rev2 = rev * (double)S5T; const double fr2 = rev2 - rint(rev2);
    double sn2, cs2; sincos_rev(fr2, sn2, cs2);
    const double mag2 = exp_small(ar * (double)S5T);
    float* o = (float*)(a.ws + WS_S5TAB) + (size_t)t * 8;
    o[0] = (float)br; o[1] = (float)bi; o[2] = (float)cr; o[3] = (float)ci; o[4] = (float)(mag2 * cs2); o[5] = (float)(mag2 * sn2); o[6] = 0.f; o[7] = 0.f;
}
__device__ __forceinline__ void ln_rows4(f32x4 (&v)[4], const float* __restrict__ g, const float* __restrict__ bt, int lane) {
    float s = 0.f;
#pragma unroll
    for (int j = 0; j < 4; ++j) s += (v[j][0] + v[j][1]) + (v[j][2] + v[j][3]);
    const float mean = wave_sum(s) * (1.f / DM); float s2 = 0.f;
#pragma unroll
    for (int j = 0; j < 4; ++j) { v[j] = v[j] - mean; s2 += (v[j][0] * v[j][0] + v[j][1] * v[j][1]) + (v[j][2] * v[j][2] + v[j][3] * v[j][3]); }
    const float rstd = 1.f / sqrtf(wave_sum(s2) * (1.f / DM) + LN_EPS);
#pragma unroll
    for (int j = 0; j < 4; ++j) { const f32x4 gv = ((const f32x4*)g)[lane + 64 * j], bv = ((const f32x4*)bt)[lane + 64 * j]; v[j] = v[j] * rstd * gv + bv; }
}
__device__ __forceinline__ void store_row(const f32x4 (&v)[4], float* o32, bf16_t* obf, int lane) {
#pragma unroll
    for (int j = 0; j < 4; ++j) {
        if (o32) ((f32x4*)o32)[lane + 64 * j] = v[j];
        if (obf) { u32x2 w; w.x = pk2(v[j][0], v[j][1]); w.y = pk2(v[j][2], v[j][3]); ((u32x2*)obf)[lane + 64 * j] = w; }
    }
}
__device__ __forceinline__ void phase_p0(const Args& a, LAS unsigned char* lds, int tid) {
    const int lane = tid & 63, wave = tid >> 6;
    const int gw = blockIdx.x * NWAVES + wave, NGW = gridDim.x * NWAVES;
    LAS float* scr = (LAS float*)(lds + wave * 17408);
    unsigned char* ws = a.ws;
    constexpr int I0 = 1024, I1 = 512, I2 = 32, I3 = 16384, I4 = 16384, I5 = 16384, NIT = I0 + I1 + I2 + I3 + I4 + I5;
    for (int it = gw; it < NIT; it += NGW) {
        int r = it;
        if (r < I3) { const int mat = r >> 9, q = r & 511; conv_item(a.in[20] + (size_t)mat * DM * FF, DM, FF, (bf16_t*)(ws + WS_WGU) + (size_t)mat * 2 * FF * DM, 2, 0, q >> 5, q & 31, scr, lane); continue; } r -= I3;
        if (r < I4) { const int mat = r >> 9, q = r & 511; conv_item(a.in[21] + (size_t)mat * DM * FF, DM, FF, (bf16_t*)(ws + WS_WGU) + (size_t)mat * 2 * FF * DM, 2, 1, q >> 5, q & 31, scr, lane); continue; } r -= I4;
        if (r < I5) { const int mat = r >> 9, q = r & 511; conv_item(a.in[22] + (size_t)mat * FF * DM, FF, DM, (bf16_t*)(ws + WS_WD) + (size_t)mat * DM * FF, 1, 0, q >> 4, q & 15, scr, lane); continue; } r -= I5;
        if (r < I0) { const int mat = r >> 9, q = r & 511; conv_item(a.in[3] + (size_t)mat * DM * DIN, DM, DIN, (bf16_t*)(ws + WS_WIN) + (size_t)mat * DIN * DM, 1, 0, q >> 5, q & 31, scr, lane); continue; } r -= I0;
        if (r < I1) { const int mat = r >> 8, q = r & 255; conv_item(a.in[16] + (size_t)mat * DM * DM, DM, DM, (bf16_t*)(ws + WS_WOUT) + (size_t)mat * DM * DM, 1, 0, q >> 4, q & 15, scr, lane); continue; } r -= I1;
        { const int mat = r >> 4, q = r & 15; conv_item(a.in[13] + (size_t)mat * 256 * 256, 256, 256, (bf16_t*)(ws + WS_WGLU) + (size_t)mat * 256 * 256, 1, 0, q >> 2, q & 3, scr, lane); }
    }
    for (int t = blockIdx.x * NTHR + tid; t < 4096; t += gridDim.x * NTHR) s5_table_entry(a, t);
    for (int m = gw; m < MTOK; m += NGW) {
        f32x4 v[4];
#pragma unroll
        for (int j = 0; j < 4; ++j) v[j] = ((const f32x4*)(a.in[0] + (size_t)m * DM))[lane + 64 * j];
        ln_rows4(v, a.in[1], a.in[2], lane);
        store_row(v, (float*)(ws + WS_H32) + (size_t)m * DM, (bf16_t*)(ws + WS_HBF) + (size_t)m * DM, lane);
    }
}

__device__ __forceinline__ void attn_item(int item, const bf16_t* __restrict__ proj, bf16_t* __restrict__ mix, const float* __restrict__ sink_l, LAS unsigned char* lds, int tid) {
    const int kh = item & 1, c = (item >> 1) & 31, b = item >> 6;
    constexpr int VS = 392;
    LAS bf16_t* Ks = (LAS bf16_t*)lds;
    LAS bf16_t* Vt = (LAS bf16_t*)(lds + 384 * 72 * 2);
#pragma unroll
    for (int i = 0; i < 6; ++i) {
        const int id = tid + NTHR * i, key = id >> 3, ch = id & 7;
        const int s = (c - 1) * 128 + key; const bool ok = (s >= 0) && (s < SEQ);
        u32x4 kv = {0u, 0u, 0u, 0u}, vv = {0u, 0u, 0u, 0u};
        if (ok) { const bf16_t* rowp = proj + (size_t)(b * SEQ + s) * DIN; kv = *(const u32x4*)(rowp + 1792 + kh * 64 + ch * 8); vv = *(const u32x4*)(rowp + 1920 + kh * 64 + ch * 8); }
        *(LAS u32x4*)(Ks + key * 72 + ch * 8) = kv;
        LAS bf16_t* vp = Vt + (ch * 8) * VS + key;
        vp[0 * VS] = (bf16_t)(vv.x & 0xffffu); vp[1 * VS] = (bf16_t)(vv.x >> 16); vp[2 * VS] = (bf16_t)(vv.y & 0xffffu); vp[3 * VS] = (bf16_t)(vv.y >> 16);
        vp[4 * VS] = (bf16_t)(vv.z & 0xffffu); vp[5 * VS] = (bf16_t)(vv.z >> 16); vp[6 * VS] = (bf16_t)(vv.w & 0xffffu); vp[7 * VS] = (bf16_t)(vv.w >> 16);
    }
    __syncthreads();
    const int lane = tid & 63, w = tid >> 6, fr = lane & 15, fq = lane >> 4;
    const int hq = kh * 4 + (w >> 1);
    const float slope = exp2f(-(float)(hq + 1));
    const float sinkv = sink_l[hq];
    const bool lo_ok = (c >= 1), hi_ok = (c <= 30);
    for (int qi = 0; qi < 4; ++qi) {
        const int qt = (w & 1) * 4 + qi, qpos = qt * 16 + fr;
        const size_t tok = (size_t)b * SEQ + c * 128 + qpos;
        const bf16_t* qp = proj + tok * DIN + 1280 + hq * 64 + fq * 8;
        const bf16x8 q0 = *(const bf16x8*)qp, q1 = *(const bf16x8*)(qp + 32);
        f32x4 s[24];
#pragma unroll
        for (int kt = 0; kt < 24; ++kt) {
            const LAS bf16_t* kp = Ks + (kt * 16 + fr) * 72 + fq * 8;
            f32x4 acc = {0.f, 0.f, 0.f, 0.f};
            acc = mfma16(*(const LAS bf16x8*)kp, q0, acc); acc = mfma16(*(const LAS bf16x8*)(kp + 32), q1, acc);
            s[kt] = acc;
        }
        float mx = sinkv;
#pragma unroll
        for (int kt = 0; kt < 24; ++kt)
#pragma unroll
            for (int j = 0; j < 4; ++j) {
                const int ks = kt * 16 + fq * 4 + j, rel = ks - 128 - qpos, arel = rel < 0 ? -rel : rel;
                const bool valid = (arel <= 128) && (kt < 8 ? lo_ok : (kt >= 16 ? hi_ok : true));
                const float v = valid ? (s[kt][j] * 0.125f - slope * (float)arel) : -1e30f;
                s[kt][j] = v; mx = fmaxf(mx, v);
            }
        mx = fmaxf(mx, __shfl_xor(mx, 16)); mx = fmaxf(mx, __shfl_xor(mx, 32));
        float sum = 0.f;
#pragma unroll
        for (int kt = 0; kt < 24; ++kt)
#pragma unroll
            for (int j = 0; j < 4; ++j) { const float p = __expf(s[kt][j] - mx); s[kt][j] = p; sum += p; }
        sum += __shfl_xor(sum, 16); sum += __shfl_xor(sum, 32);
        const float inv = 1.f / (sum + __expf(sinkv - mx));
        f32x4 o[4];
#pragma unroll
        for (int dt = 0; dt < 4; ++dt) o[dt] = (f32x4){0.f, 0.f, 0.f, 0.f};
#pragma unroll
        for (int kk = 0; kk < 12; ++kk) {
            const bf16x8 pb = pack8(s[2 * kk], s[2 * kk + 1]);
#pragma unroll
            for (int dt = 0; dt < 4; ++dt) {
                const LAS bf16_t* vp = Vt + (dt * 16 + fr) * VS + kk * 32 + fq * 4;
                o[dt] = mfma16(cat8(*(const LAS bf16x4*)vp, *(const LAS bf16x4*)(vp + 16)), pb, o[dt]);
            }
        }
        bf16_t* op = mix + tok * DM + 512 + hq * 64 + fq * 4;
#pragma unroll
        for (int dt = 0; dt < 4; ++dt) { u32x2 wv; wv.x = pk2(o[dt][0] * inv, o[dt][1] * inv); wv.y = pk2(o[dt][2] * inv, o[dt][3] * inv); *(u32x2*)(op + dt * 16) = wv; }
    }
    __syncthreads();
}

__device__ __forceinline__ float log_sigmoid(float t) { return -log1pf(__expf(-t)); }
__device__ __forceinline__ void retkv_item(int item, const bf16_t* __restrict__ proj, float* __restrict__ kvf, float* __restrict__ kvb, const float* __restrict__ theta, LAS unsigned char* lds, int tid) {
    const int h = item & 3, c = (item >> 2) & 31, b = item >> 7;
    const float lgf = log_sigmoid(theta[h]), lgb = log_sigmoid(theta[4 + h]);
    LAS bf16_t* KTf = (LAS bf16_t*)lds; LAS bf16_t* KTb = KTf + 64 * 136; LAS bf16_t* VT = KTb + 64 * 136;
#pragma unroll
    for (int i = 0; i < 2; ++i) {
        const int id = tid + NTHR * i, j = id >> 3, ch = id & 7;
        const bf16_t* rowp = proj + (size_t)(b * SEQ + c * 128 + j) * DIN;
        const u32x4 kr = *(const u32x4*)(rowp + 256 + h * 64 + ch * 8), vr = *(const u32x4*)(rowp + 512 + h * 64 + ch * 8);
        const float wf = __expf(lgf * (float)(127 - j)) * 0.125f, wb = __expf(lgb * (float)j) * 0.125f;
        const int o = (ch * 8) * 136 + j;
        KTf[o + 0 * 136] = (bf16_t)f2bf(bflo(kr.x) * wf); KTf[o + 1 * 136] = (bf16_t)f2bf(bfhi(kr.x) * wf); KTf[o + 2 * 136] = (bf16_t)f2bf(bflo(kr.y) * wf); KTf[o + 3 * 136] = (bf16_t)f2bf(bfhi(kr.y) * wf);
        KTf[o + 4 * 136] = (bf16_t)f2bf(bflo(kr.z) * wf); KTf[o + 5 * 136] = (bf16_t)f2bf(bfhi(kr.z) * wf); KTf[o + 6 * 136] = (bf16_t)f2bf(bflo(kr.w) * wf); KTf[o + 7 * 136] = (bf16_t)f2bf(bfhi(kr.w) * wf);
        KTb[o + 0 * 136] = (bf16_t)f2bf(bflo(kr.x) * wb); KTb[o + 1 * 136] = (bf16_t)f2bf(bfhi(kr.x) * wb); KTb[o + 2 * 136] = (bf16_t)f2bf(bflo(kr.y) * wb); KTb[o + 3 * 136] = (bf16_t)f2bf(bfhi(kr.y) * wb);
        KTb[o + 4 * 136] = (bf16_t)f2bf(bflo(kr.z) * wb); KTb[o + 5 * 136] = (bf16_t)f2bf(bfhi(kr.z) * wb); KTb[o + 6 * 136] = (bf16_t)f2bf(bflo(kr.w) * wb); KTb[o + 7 * 136] = (bf16_t)f2bf(bfhi(kr.w) * wb);
        VT[o + 0 * 136] = (bf16_t)(vr.x & 0xffffu); VT[o + 1 * 136] = (bf16_t)(vr.x >> 16); VT[o + 2 * 136] = (bf16_t)(vr.y & 0xffffu); VT[o + 3 * 136] = (bf16_t)(vr.y >> 16);
        VT[o + 4 * 136] = (bf16_t)(vr.z & 0xffffu); VT[o + 5 * 136] = (bf16_t)(vr.z >> 16); VT[o + 6 * 136] = (bf16_t)(vr.w & 0xffffu); VT[o + 7 * 136] = (bf16_t)(vr.w >> 16);
    }
    __syncthreads();
    const int lane = tid & 63, w = tid >> 6, fr = lane & 15, fq = lane >> 4;
    const size_t obase = (size_t)((b * 32 + c) * 4 + h) * 4096;
#pragma unroll
    for (int i = 0; i < 4; ++i) {
        const int job = w * 4 + i, dirb = job >> 4, et = (job >> 2) & 3, dt = job & 3;
        const LAS bf16_t* ap = VT + (et * 16 + fr) * 136 + fq * 8;
        const LAS bf16_t* bp = (dirb ? KTb : KTf) + (dt * 16 + fr) * 136 + fq * 8;
        f32x4 acc = {0.f, 0.f, 0.f, 0.f};
#pragma unroll
        for (int ks = 0; ks < 4; ++ks) acc = mfma16(*(const LAS bf16x8*)(ap + ks * 32), *(const LAS bf16x8*)(bp + ks * 32), acc);
        float* op = (dirb ? kvb : kvf) + obase + (et * 16 + fq * 4) * 64 + dt * 16 + fr;
        op[0] = acc[0]; op[64] = acc[1]; op[128] = acc[2]; op[192] = acc[3];
    }
    __syncthreads();
}
__device__ __forceinline__ void retout_item(int item, const bf16_t* __restrict__ proj, const float* __restrict__ stf, const float* __restrict__ stb, bf16_t* __restrict__ mix, const float* __restrict__ theta, LAS unsigned char* lds, int tid) {
    const int h = item & 3, c = (item >> 2) & 31, b = item >> 7;
    const float lgf = log_sigmoid(theta[h]), lgb = log_sigmoid(theta[4 + h]);
    LAS bf16_t* Qs = (LAS bf16_t*)lds; LAS bf16_t* Ks = Qs + 128 * 72; LAS bf16_t* VT = Ks + 128 * 72; LAS bf16_t* SFt = VT + 64 * 136; LAS bf16_t* SBt = SFt + 64 * 72;
#pragma unroll
    for (int i = 0; i < 2; ++i) {
        const int id = tid + NTHR * i, j = id >> 3, ch = id & 7;
        const bf16_t* rowp = proj + (size_t)(b * SEQ + c * 128 + j) * DIN;
        const u32x4 qr = *(const u32x4*)(rowp + h * 64 + ch * 8), kr = *(const u32x4*)(rowp + 256 + h * 64 + ch * 8), vr = *(const u32x4*)(rowp + 512 + h * 64 + ch * 8);
        *(LAS u32x4*)(Qs + j * 72 + ch * 8) = qr; *(LAS u32x4*)(Ks + j * 72 + ch * 8) = kr;
        const int o = (ch * 8) * 136 + j;
        VT[o + 0 * 136] = (bf16_t)(vr.x & 0xffffu); VT[o + 1 * 136] = (bf16_t)(vr.x >> 16); VT[o + 2 * 136] = (bf16_t)(vr.y & 0xffffu); VT[o + 3 * 136] = (bf16_t)(vr.y >> 16);
        VT[o + 4 * 136] = (bf16_t)(vr.z & 0xffffu); VT[o + 5 * 136] = (bf16_t)(vr.z >> 16); VT[o + 6 * 136] = (bf16_t)(vr.w & 0xffffu); VT[o + 7 * 136] = (bf16_t)(vr.w >> 16);
    }
    const size_t sbase = (size_t)((b * 32 + c) * 4 + h) * 4096;
#pragma unroll
    for (int i = 0; i < 8; ++i) { const int id = tid + NTHR * i, e = id >> 6, d = id & 63; SFt[e * 72 + d] = (bf16_t)f2bf(stf[sbase + id]); SBt[e * 72 + d] = (bf16_t)f2bf(stb[sbase + id]); }
    __syncthreads();
    const int lane = tid & 63, it = tid >> 6, fr = lane & 15, fq = lane >> 4;
    const int ipos = it * 16 + fr;
    const LAS bf16_t* qp = Qs + ipos * 72 + fq * 8;
    const bf16x8 qb0 = *(const LAS bf16x8*)qp, qb1 = *(const LAS bf16x8*)(qp + 32);
    f32x4 st[8];
#pragma unroll
    for (int jt = 0; jt < 8; ++jt) {
        const LAS bf16_t* kp = Ks + (jt * 16 + fr) * 72 + fq * 8;
        f32x4 acc = {0.f, 0.f, 0.f, 0.f};
        acc = mfma16(*(const LAS bf16x8*)kp, qb0, acc); acc = mfma16(*(const LAS bf16x8*)(kp + 32), qb1, acc);
#pragma unroll
        for (int jj = 0; jj < 4; ++jj) { const int dij = ipos - (jt * 16 + fq * 4 + jj); const float dec = dij >= 0 ? __expf(lgf * (float)dij) : __expf(lgb * (float)(-dij)); acc[jj] *= 0.125f * dec; }
        st[jt] = acc;
    }
    f32x4 o[4], ff[4], fb[4];
#pragma unroll
    for (int et = 0; et < 4; ++et) { o[et] = (f32x4){0.f, 0.f, 0.f, 0.f}; ff[et] = o[et]; fb[et] = o[et]; }
#pragma unroll
    for (int kk = 0; kk < 4; ++kk) {
        const bf16x8 pb = pack8(st[2 * kk], st[2 * kk + 1]);
#pragma unroll
        for (int et = 0; et < 4; ++et) { const LAS bf16_t* vp = VT + (et * 16 + fr) * 136 + kk * 32 + fq * 4; o[et] = mfma16(cat8(*(const LAS bf16x4*)vp, *(const LAS bf16x4*)(vp + 16)), pb, o[et]); }
    }
#pragma unroll
    for (int et = 0; et < 4; ++et) {
        const LAS bf16_t* fp = SFt + (et * 16 + fr) * 72 + fq * 8; const LAS bf16_t* bp = SBt + (et * 16 + fr) * 72 + fq * 8;
        ff[et] = mfma16(*(const LAS bf16x8*)fp, qb0, ff[et]); ff[et] = mfma16(*(const LAS bf16x8*)(fp + 32), qb1, ff[et]);
        fb[et] = mfma16(*(const LAS bf16x8*)bp, qb0, fb[et]); fb[et] = mfma16(*(const LAS bf16x8*)(bp + 32), qb1, fb[et]);
    }
    const float cf = __expf(lgf * (float)(ipos + 1)), cb = __expf(lgb * (float)(128 - ipos));
    float s = 0.f;
#pragma unroll
    for (int et = 0; et < 4; ++et) { o[et] = o[et] + ff[et] * cf + fb[et] * cb; s += (o[et][0] + o[et][1]) + (o[et][2] + o[et][3]); }
    s += __shfl_xor(s, 16); s += __shfl_xor(s, 32);
    const float mean = s * (1.f / 64.f); float s2 = 0.f;
#pragma unroll
    for (int et = 0; et < 4; ++et) { o[et] = o[et] - mean; s2 += (o[et][0] * o[et][0] + o[et][1] * o[et][1]) + (o[et][2] * o[et][2] + o[et][3] * o[et][3]); }
    s2 += __shfl_xor(s2, 16); s2 += __shfl_xor(s2, 32);
    const float rstd = 1.f / sqrtf(s2 * (1.f / 64.f) + LN_EPS);
    const size_t tok = (size_t)b * SEQ + c * 128 + ipos;
    const bf16_t* gp = proj + tok * DIN + 768 + h * 64 + fq * 4;
    bf16_t* op = mix + tok * DM + h * 64 + fq * 4;
#pragma unroll
    for (int et = 0; et < 4; ++et) {
        const u32x2 gr = *(const u32x2*)(gp + et * 16);
        const float g0 = bflo(gr.x), g1 = bfhi(gr.x), g2 = bflo(gr.y), g3 = bfhi(gr.y);
        const float y0 = o[et][0] * rstd * (g0 / (1.f + __expf(-g0))), y1 = o[et][1] * rstd * (g1 / (1.f + __expf(-g1)));
        const float y2 = o[et][2] * rstd * (g2 / (1.f + __expf(-g2))), y3 = o[et][3] * rstd * (g3 / (1.f + __expf(-g3)));
        u32x2 wv; wv.x = pk2(y0, y1); wv.y = pk2(y2, y3); *(u32x2*)(op + et * 16) = wv;
    }
    __syncthreads();
}

__device__ __forceinline__ void s5_load_u(const bf16_t* __restrict__ proj, int b, int ch, LAS bf16_t* U, int tid) {
#pragma unroll
    for (int i = 0; i < 2; ++i) { const int id = tid + NTHR * i, s = id >> 5, c8 = id & 31;
        *(LAS u32x4*)(U + s * 256 + c8 * 8) = *(const u32x4*)(proj + (size_t)(b * SEQ + ch * S5T + s) * DIN + 1024 + c8 * 8); }
}
#define S5_BU(BR, BI, UP) do { const u32x4 _u0 = *(const LAS u32x4*)(UP), _u1 = *(const LAS u32x4*)((UP) + 8); \
    float _u[16] = {bflo(_u0.x), bfhi(_u0.x), bflo(_u0.y), bfhi(_u0.y), bflo(_u0.z), bfhi(_u0.z), bflo(_u0.w), bfhi(_u0.w), bflo(_u1.x), bfhi(_u1.x), bflo(_u1.y), bfhi(_u1.y), bflo(_u1.z), bfhi(_u1.z), bflo(_u1.w), bfhi(_u1.w)}; \
    BR = 0.f; BI = 0.f; _Pragma("unroll") for (int _c = 0; _c < 16; ++_c) { BR = fmaf(bbr[_c], _u[_c], BR); BI = fmaf(bbi[_c], _u[_c], BI); } } while (0)
#define S5_LOAD_BBAR() \
    const float* tabp = tab + (size_t)((r * 16 + g) * 64 + p) * 8; \
    const f32x4 t0 = *(const f32x4*)tabp; const float lr_ = t0[0], li_ = t0[1], cr_ = t0[2], ci_ = t0[3]; \
    float bbr[16], bbi[16]; \
    { const float* brp = bre + (size_t)(g * 64 + p) * 16; const float* bip = bim + (size_t)(g * 64 + p) * 16; \
      _Pragma("unroll") for (int q4 = 0; q4 < 4; ++q4) { const f32x4 x = *(const f32x4*)(brp + 4 * q4), y = *(const f32x4*)(bip + 4 * q4); \
        _Pragma("unroll") for (int k = 0; k < 4; ++k) { bbr[4 * q4 + k] = cr_ * x[k] - ci_ * y[k]; bbi[4 * q4 + k] = cr_ * y[k] + ci_ * x[k]; } } }

__device__ __forceinline__ void s5e_item(int item, const bf16_t* __restrict__ proj, const float* __restrict__ tab  , const float* __restrict__ bre, const float* __restrict__ bim,
                                         float* __restrict__ E, LAS unsigned char* lds, int tid) {
    const int ch = item & (S5NCH - 1), b = item / S5NCH;
    LAS bf16_t* U = (LAS bf16_t*)lds;
    s5_load_u(proj, b, ch, U, tid);
    __syncthreads();
    const int gl = tid >> 7, r = (tid >> 6) & 1, p = tid & 63;
    for (int qd = 0; qd < 4; ++qd) {
        const int g = qd * 4 + gl;
        S5_LOAD_BBAR();
        float xr = 0.f, xi = 0.f;
        for (int s = 0; s < S5T; ++s) {
            const int si = r ? (S5T - 1 - s) : s;
            float br, bi; S5_BU(br, bi, U + si * 256 + g * 16);
            const float nr = fmaf(lr_, xr, fmaf(-li_, xi, br)), ni = fmaf(lr_, xi, fmaf(li_, xr, bi));
            xr = nr; xi = ni;
        }
        float2 ev; ev.x = xr; ev.y = xi;
        ((float2*)E)[(size_t)(((b * S5NCH + ch) * 16 + g) * 2 + r) * 64 + p] = ev;
    }
    __syncthreads();
}
__device__ __forceinline__ void s5out_item(int item, const bf16_t* __restrict__ proj, const float* __restrict__ tab, const float* __restrict__ bre, const float* __restrict__ bim,
                                           const float* __restrict__ cre  , const float* __restrict__ cim, const float* __restrict__ dvec, const bf16_t* __restrict__ wgluT, const float* __restrict__ bglu,
                                           const float* __restrict__ CIN, bf16_t* __restrict__ mix, LAS unsigned char* lds, int tid) {
    const int ch = item & (S5NCH - 1), b = item / S5NCH;
    constexpr int XS = 1032, CS = 264, YS = 264;
    LAS bf16_t* U = (LAS bf16_t*)lds;
    LAS bf16_t* X = (LAS bf16_t*)(lds + 16384);
    LAS bf16_t* Ct = (LAS bf16_t*)(lds + 16384 + 66048);
    LAS bf16_t* Y = (LAS bf16_t*)(lds + 16384 + 66048 + 33792);
    s5_load_u(proj, b, ch, U, tid);
    const int gl = tid >> 7, r = (tid >> 6) & 1, p = tid & 63;
    const int lane = tid & 63, w = tid >> 6, fr = lane & 15, fq = lane >> 4;
    for (int qd = 0; qd < 4; ++qd) {
        __syncthreads();
#pragma unroll
        for (int i = 0; i < 16; ++i) { const int id = tid + NTHR * i, pp = id & 63, cc = (id >> 6) & 15, gg = (id >> 10) & 3, rr = id >> 12;
            const size_t ci = (size_t)((rr * 16 + qd * 4 + gg) * 16 + cc) * 64 + pp;
            *(LAS unsigned*)(Ct + (gg * 16 + cc) * CS + rr * 128 + pp * 2) = pk2(cre[ci], -cim[ci]); }
        const int g = qd * 4 + gl;
        {
            S5_LOAD_BBAR();
            const float2 cin = ((const float2*)CIN)[(size_t)(((b * S5NCH + ch) * 16 + g) * 2 + r) * 64 + p];
            float xr = cin.x, xi = cin.y;
            for (int s = 0; s < S5T; ++s) {
                const int si = r ? (S5T - 1 - s) : s;
                float br, bi; S5_BU(br, bi, U + si * 256 + g * 16);
                const float nr = fmaf(lr_, xr, fmaf(-li_, xi, br)), ni = fmaf(lr_, xi, fmaf(li_, xr, bi));
                xr = nr; xi = ni;
                *(LAS unsigned*)(X + si * XS + gl * 256 + r * 128 + p * 2) = pk2(xr, xi);
            }
        }
        __syncthreads();
        {
            const int wg = w >> 1, mt = w & 1, gq = qd * 4 + wg;
            const LAS bf16_t* ap = X + (mt * 16 + fr) * XS + wg * 256 + fq * 8;
            const LAS bf16_t* bp = Ct + (wg * 16 + fr) * CS + fq * 8;
            f32x4 acc = {0.f, 0.f, 0.f, 0.f};
#pragma unroll
            for (int ks = 0; ks < 8; ++ks) acc = mfma16(*(const LAS bf16x8*)(ap + ks * 32), *(const LAS bf16x8*)(bp + ks * 32), acc);
            const int chn = gq * 16 + fr; const float dv = dvec[chn];
#pragma unroll
            for (int jj = 0; jj < 4; ++jj) { const int s = mt * 16 + fq * 4 + jj;
                const float uu = __uint_as_float(((unsigned)U[s * 256 + chn]) << 16);
                const float yv = acc[jj] + dv * uu;
                const float t = 0.7978845608028654f * (yv + 0.044715f * yv * yv * yv);
                const float gel = yv * (1.f - 1.f / (1.f + __expf(2.f * t)));
                Y[s * YS + chn] = (bf16_t)f2bf(gel); }
        }
    }
    __syncthreads();
    {
        const int mt = w & 1;
        bf16x8 af[8];
#pragma unroll
        for (int ks = 0; ks < 8; ++ks) af[ks] = *(const LAS bf16x8*)(Y + (mt * 16 + fr) * YS + ks * 32 + fq * 8);
#pragma unroll
        for (int i = 0; i < 4; ++i) {
            const int nt = (w >> 1) * 4 + i, n = nt * 16 + fr;
            const bf16_t* bp = wgluT + (size_t)n * 256 + fq * 8;
            f32x4 acc = {0.f, 0.f, 0.f, 0.f};
#pragma unroll
            for (int ks = 0; ks < 8; ++ks) acc = mfma16(af[ks], *(const bf16x8*)(bp + ks * 32), acc);
            const float bg = bglu[n];
#pragma unroll
            for (int jj = 0; jj < 4; ++jj) { const int s = mt * 16 + fq * 4 + jj;
                const float yv = __uint_as_float(((unsigned)Y[s * YS + n]) << 16);
                const float outv = yv / (1.f + __expf(-(acc[jj] + bg)));
                mix[(size_t)(b * SEQ + ch * S5T + s) * DM + 256 + n] = (bf16_t)f2bf(outv); }
        }
    }
    __syncthreads();
}

__device__ __forceinline__ void phase_scan(const Args& a, int l, int tid) {
    unsigned char* ws = a.ws;
    {
        const float* theta = a.in[4] + l * 8;
        const float* kvf = (const float*)(ws + WS_KVF); const float* kvb = (const float*)(ws + WS_KVB);
        float* stf = (float*)(ws + WS_STF); float* stb = (float*)(ws + WS_STB);
        for (int gid = blockIdx.x * NTHR + tid; gid < 131072; gid += gridDim.x * NTHR) {
            const int el = gid & 4095, dir = (gid >> 12) & 1, h = (gid >> 13) & 3, b = gid >> 15;
            const float dec = __expf(log_sigmoid(theta[dir * 4 + h]) * 128.f);
            float s = 0.f;
            if (dir == 0) { for (int c = 0; c < 32; ++c) { const size_t ix = (size_t)((b * 32 + c) * 4 + h) * 4096 + el; stf[ix] = s; s = fmaf(dec, s, kvf[ix]); } }
            else { for (int c = 31; c >= 0; --c) { const size_t ix = (size_t)((b * 32 + c) * 4 + h) * 4096 + el; stb[ix] = s; s = fmaf(dec, s, kvb[ix]); } }
        }
    }
    {
        const float* tab = (const float*)(ws + WS_S5TAB) + (size_t)l * 2048 * 8;
        const float2* E = (const float2*)(ws + WS_S5E); float2* C = (float2*)(ws + WS_S5C);
        for (int gid = blockIdx.x * NTHR + tid; gid < 8192; gid += gridDim.x * NTHR) {
            const int p = gid & 63, r = (gid >> 6) & 1, g = (gid >> 7) & 15, b = gid >> 11;
            const float* tp = tab + (size_t)((r * 16 + g) * 64 + p) * 8;
            const float tr = tp[4], ti = tp[5];
            float xr = 0.f, xi = 0.f;
            for (int k = 0; k < S5NCH; ++k) {
                const int ch = r ? (S5NCH - 1 - k) : k;
                const size_t ix = (size_t)(((b * S5NCH + ch) * 16 + g) * 2 + r) * 64 + p;
                float2 cv; cv.x = xr; cv.y = xi; C[ix] = cv;
                const float2 e = E[ix];
                const float nr = fmaf(tr, xr, fmaf(-ti, xi, e.x)), ni = fmaf(tr, xi, fmaf(ti, xr, e.y));
                xr = nr; xi = ni;
            }
        }
    }
}

__device__ __forceinline__ void phase_ln1_router(const Args& a, int l, LAS unsigned char* lds, int tid) {
    unsigned char* ws = a.ws;
    const int lane = tid & 63, wave = tid >> 6;
    LAS float* rwT = (LAS float*)lds;
    const float* rw = a.in[19] + (size_t)l * DM * NE;
    for (int i = tid; i < DM * NE; i += NTHR) rwT[(i & 15) * DM + (i >> 4)] = rw[i];
    __syncthreads();
    const float* pre = (const float*)(ws + WS_RA);
    float* afft = (float*)(ws + WS_AFFT);
    const int gw = blockIdx.x * NWAVES + wave, NGW = gridDim.x * NWAVES;
    for (int m = gw; m < MTOK; m += NGW) {
        f32x4 v[4];
#pragma unroll
        for (int j = 0; j < 4; ++j) v[j] = ((const f32x4*)(pre + (size_t)m * DM))[lane + 64 * j];
        ln_rows4(v, a.in[17] + l * DM, a.in[18] + l * DM, lane);
        store_row(v, (float*)(ws + WS_H32) + (size_t)m * DM, (bf16_t*)(ws + WS_HBF) + (size_t)m * DM, lane);
        float mine = 0.f;
#pragma unroll 2
        for (int e = 0; e < 16; ++e) {
            float s = 0.f;
#pragma unroll
            for (int j = 0; j < 4; ++j) { const f32x4 wv = *(const LAS f32x4*)(rwT + e * DM + 256 * j + 4 * lane); s += (v[j][0] * wv[0] + v[j][1] * wv[1]) + (v[j][2] * wv[2] + v[j][3] * wv[3]); }
            s = wave_sum(s);
            mine = ((lane & 15) == e) ? s : mine;
        }
        float mx = mine;
#pragma unroll
        for (int o = 1; o < 16; o <<= 1) mx = fmaxf(mx, __shfl_xor(mx, o));
        mine = expf(mine - mx);
        float sum = mine;
#pragma unroll
        for (int o = 1; o < 16; o <<= 1) sum += __shfl_xor(sum, o);
        const float inv = 1.f / sum;
        const int b = m / SEQ, t = m % SEQ;
        if (lane < 16) afft[(size_t)(b * NE + lane) * SEQ + t] = mine * inv;
    }
    __syncthreads();
}

__device__ __forceinline__ void select_item(int item, const Args& a, LAS unsigned char* lds, int tid) {
    unsigned char* ws = a.ws;
    const int q = item & 3, e = (item >> 2) & 15, b = item >> 6;
    const int lane = tid & 63, wave = tid >> 6;
    LAS unsigned* red = (LAS unsigned*)lds;
    LAS int* sel = (LAS int*)(lds + 1024);
    const float* av = (const float*)(ws + WS_AFFT) + (size_t)(b * NE + e) * SEQ + tid * 8;
    const f32x4 va = *(const f32x4*)av, vb = *(const f32x4*)(av + 4);
    unsigned v[8] = {__float_as_uint(va[0]), __float_as_uint(va[1]), __float_as_uint(va[2]), __float_as_uint(va[3]), __float_as_uint(vb[0]), __float_as_uint(vb[1]), __float_as_uint(vb[2]), __float_as_uint(vb[3])};
    unsigned x = 0u;
    for (int bit = 30; bit >= 0; --bit) {
        const unsigned cand = x | (1u << bit);
        unsigned cnt = 0u;
#pragma unroll
        for (int j = 0; j < 8; ++j) cnt += (unsigned)__popcll(__ballot(v[j] >= cand));
        LAS unsigned* rb = red + (bit & 1) * 8;
        if (lane == 0) rb[wave] = cnt;
        __syncthreads();
        unsigned tot = 0u;
#pragma unroll
        for (int k = 0; k < 8; ++k) tot += rb[k];
        if (tot >= (unsigned)CAP) x = cand;
    }
    unsigned mycnt = 0u;
#pragma unroll
    for (int j = 0; j < 8; ++j) mycnt += (v[j] > x ? 1u : 0u) + (v[j] == x ? 0x10000u : 0u);
    unsigned inc = mycnt;
#pragma unroll
    for (int o = 1; o < 64; o <<= 1) { const unsigned t = __shfl_up(inc, o); if (lane >= o) inc += t; }
    LAS unsigned* wsum = red + 64;
    __syncthreads();
    if (lane == 63) wsum[wave] = inc;
    __syncthreads();
    unsigned wpre = 0u, total = 0u;
#pragma unroll
    for (int k = 0; k < 8; ++k) { const unsigned t = wsum[k]; if (k < wave) wpre += t; total += t; }
    const unsigned excl = wpre + inc - mycnt;
    unsigned gtb = excl & 0xffffu, eqb = excl >> 16;
    const unsigned need = (unsigned)CAP - (total & 0xffffu);
    const int rowbase = (e * NB + b) * CAP;
    int* idx = (int*)(ws + WS_IDX); float* gate = (float*)(ws + WS_GATE); int* slotmap = (int*)(ws + WS_SLOT);
    const bool own_tok = ((tid >> 7) == q);
#pragma unroll
    for (int j = 0; j < 8; ++j) {
        const bool isgt = v[j] > x, iseq = v[j] == x;
        const bool issel = isgt || (iseq && eqb < need);
        const unsigned slot = gtb + (eqb < need ? eqb : need);
        const int tok = b * SEQ + tid * 8 + j;
        if (issel && (int)(slot >> 7) == q) { idx[rowbase + slot] = tok; gate[rowbase + slot] = __uint_as_float(v[j]); sel[slot & 127] = tok; }
        if (own_tok) slotmap[(size_t)tok * NE + e] = issel ? (int)(rowbase + slot) : -1;
        gtb += isgt ? 1u : 0u; eqb += iseq ? 1u : 0u;
    }
    __syncthreads();
    const bf16_t* hbf = (const bf16_t*)(ws + WS_HBF); bf16_t* xs = (bf16_t*)(ws + WS_RA);
    for (int s = wave; s < 128; s += NWAVES) {
        const int tok = sel[s];
        const u32x4* src = (const u32x4*)(hbf + (size_t)tok * DM); u32x4* dst = (u32x4*)(xs + (size_t)(rowbase + q * 128 + s) * DM);
        const u32x4 d0 = src[lane], d1 = src[lane + 64];
        dst[lane] = d0; dst[lane + 64] = d1;
    }
    __syncthreads();
}

__device__ __forceinline__ void phase_ln2(const Args& a, int l, int tid) {
    unsigned char* ws = a.ws;
    const int lane = tid & 63, wave = tid >> 6;
    const int gw = blockIdx.x * NWAVES + wave, NGW = gridDim.x * NWAVES;
    const float* h32 = (const float*)(ws + WS_H32); const int* slotmap = (const int*)(ws + WS_SLOT); const bf16_t* contrib = (const bf16_t*)(ws + WS_RB);
    const bool last = (l == 1);
    for (int m = gw; m < MTOK; m += NGW) {
        f32x4 v[4];
#pragma unroll
        for (int j = 0; j < 4; ++j) v[j] = ((const f32x4*)(h32 + (size_t)m * DM))[lane + 64 * j] * ALPHA;
        const int myslot = slotmap[(size_t)m * NE + (lane & 15)];
#pragma unroll
        for (int e = 0; e < 16; ++e) {
            const int row = __builtin_amdgcn_readlane(myslot, e);
            if (row >= 0) {
                const u32x2* cr = (const u32x2*)(contrib + (size_t)row * DM);
#pragma unroll
                for (int j = 0; j < 4; ++j) { const u32x2 wv = cr[lane + 64 * j]; v[j][0] += bflo(wv.x); v[j][1] += bfhi(wv.x); v[j][2] += bflo(wv.y); v[j][3] += bfhi(wv.y); }
            }
        }
        ln_rows4(v, a.in[23] + l * DM, a.in[24] + l * DM, lane);
        if (last) store_row(v, a.out + (size_t)m * DM, nullptr, lane);
        else store_row(v, (float*)(ws + WS_H32) + (size_t)m * DM, (bf16_t*)(ws + WS_HBF) + (size_t)m * DM, lane);
    }
}

constexpr int NPHASES = 21;
template <int L, int K>
__device__ __forceinline__ void run_phase(const Args& a, LAS unsigned char* lds, int tid) {
    unsigned char* ws = a.ws;
    constexpr int l = L;
    bf16_t* proj = (bf16_t*)(ws + WS_RA); bf16_t* mix = (bf16_t*)(ws + WS_RB);
    if constexpr (K == 0) {
        pg8::Gemm g{(const bf16_t*)(ws + WS_HBF), (const bf16_t*)(ws + WS_WIN) + (size_t)l * DIN * DM, MTOK, DIN, DM};
        pg8::StaticOrder S; S.init(MTOK, DIN, (int)gridDim.x, (int)blockIdx.x);
        pg8::EpiStoreBf16 E{proj, DIN};
        pg8::gemm_phase<pg8::EpiStoreBf16, pg8::StaticOrder, true, true>(lds, g, S, E);
    } else if constexpr (K == 1) {
        const float* tab = (const float*)(ws + WS_S5TAB) + (size_t)l * 2048 * 8;
        for (int it = blockIdx.x; it < 1280; it += gridDim.x) {
            if (it < 512) s5e_item(it, proj, tab, a.in[8] + (size_t)l * 16384, a.in[9] + (size_t)l * 16384, (float*)(ws + WS_S5E), lds, tid);
            else if (it < 768) attn_item(it - 512, proj, mix, a.in[15] + l * 8, lds, tid);
            else retkv_item(it - 768, proj, (float*)(ws + WS_KVF), (float*)(ws + WS_KVB), a.in[4] + l * 8, lds, tid);
        }
    } else if constexpr (K == 2) {
        phase_scan(a, l, tid);
    } else if constexpr (K == 3) {
        const float* tab = (const float*)(ws + WS_S5TAB) + (size_t)l * 2048 * 8;
        for (int it = blockIdx.x; it < 1024; it += gridDim.x) {
            if (it < 512) s5out_item(it, proj, tab, a.in[8] + (size_t)l * 16384, a.in[9] + (size_t)l * 16384, a.in[10] + (size_t)l * 32768, a.in[11] + (size_t)l * 32768, a.in[12] + l * 256,
                                     (const bf16_t*)(ws + WS_WGLU) + (size_t)l * 65536, a.in[14] + l * 256, (const float*)(ws + WS_S5C), mix, lds, tid);
            else retout_item(it - 512, proj, (const float*)(ws + WS_STF), (const float*)(ws + WS_STB), mix, a.in[4] + l * 8, lds, tid);
        }
    } else if constexpr (K == 4) {
        pg8::Gemm g{mix, (const bf16_t*)(ws + WS_WOUT) + (size_t)l * DM * DM, MTOK, DM, DM};
        pg8::StaticOrder S; S.init(MTOK, DM, (int)gridDim.x, (int)blockIdx.x);
        pg8::EpiResF32 E{(const float*)(ws + WS_H32), (float*)(ws + WS_RA), DM, ALPHA};
        pg8::gemm_phase<pg8::EpiResF32, pg8::StaticOrder, true, true>(lds, g, S, E);
    } else if constexpr (K == 5) {
        phase_ln1_router(a, l, lds, tid);
    } else if constexpr (K == 6) {
        for (int it = blockIdx.x; it < 256; it += gridDim.x) select_item(it, a, lds, tid);
    } else if constexpr (K == 7) {
        pg8::Gemm g{(const bf16_t*)(ws + WS_RA), (const bf16_t*)(ws + WS_WGU) + (size_t)l * NE * 2 * FF * DM, NROWX, NE * 2 * FF, DM};
        pg8::GroupedOrder S; S.init(16, (int)gridDim.x, (int)blockIdx.x);
        pg8::EpiSwiGLU E{(bf16_t*)(ws + WS_HDN), FF, 16};
        pg8::gemm_phase<pg8::EpiSwiGLU, pg8::GroupedOrder, true, true>(lds, g, S, E);
    } else if constexpr (K == 8) {
        pg8::Gemm g{(const bf16_t*)(ws + WS_HDN), (const bf16_t*)(ws + WS_WD) + (size_t)l * NE * DM * FF, NROWX, NE * DM, FF};
        pg8::GroupedOrder S; S.init(4, (int)gridDim.x, (int)blockIdx.x);
        pg8::EpiScaleRow E{(bf16_t*)(ws + WS_RB), DM, 4, (const float*)(ws + WS_GATE)};
        pg8::gemm_phase<pg8::EpiScaleRow, pg8::GroupedOrder, true, true>(lds, g, S, E);
    } else {
        phase_ln2(a, l, tid);
    }
}
__global__ void __launch_bounds__(NTHR, 2) fwd_kernel(Args a) {
    extern __shared__ __attribute__((aligned(16))) unsigned char lds_raw[];
    LAS unsigned char* lds = (LAS unsigned char*)lds_raw;
    cg::grid_group grid = cg::this_grid();
    const int lo = a.ph_lo, hi = a.ph_hi;
#define PH_BEGIN(ph) if (lo <= (ph) && (ph) < hi) { int tid = threadIdx.x; asm volatile("" : "+v"(tid));
#define PH_END(ph) if ((ph) + 1 < hi) grid.sync(); }
    PH_BEGIN(0) phase_p0(a, lds, tid); PH_END(0)
#define LAYER(L) \
    PH_BEGIN(1 + 10 * L + 0) run_phase<L, 0>(a, lds, tid); PH_END(1 + 10 * L + 0) \
    PH_BEGIN(1 + 10 * L + 1) run_phase<L, 1>(a, lds, tid); PH_END(1 + 10 * L + 1) \
    PH_BEGIN(1 + 10 * L + 2) run_phase<L, 2>(a, lds, tid); PH_END(1 + 10 * L + 2) \
    PH_BEGIN(1 + 10 * L + 3) run_phase<L, 3>(a, lds, tid); PH_END(1 + 10 * L + 3) \
    PH_BEGIN(1 + 10 * L + 4) run_phase<L, 4>(a, lds, tid); PH_END(1 + 10 * L + 4) \
    PH_BEGIN(1 + 10 * L + 5) run_phase<L, 5>(a, lds, tid); PH_END(1 + 10 * L + 5) \
    PH_BEGIN(1 + 10 * L + 6) run_phase<L, 6>(a, lds, tid); PH_END(1 + 10 * L + 6) \
    PH_BEGIN(1 + 10 * L + 7) run_phase<L, 7>(a, lds, tid); PH_END(1 + 10 * L + 7) \
    PH_BEGIN(1 + 10 * L + 8) run_phase<L, 8>(a, lds, tid); PH_END(1 + 10 * L + 8) \
    PH_BEGIN(1 + 10 * L + 9) run_phase<L, 9>(a, lds, tid); PH_END(1 + 10 * L + 9)
    LAYER(0)
    LAYER(1)
#undef LAYER
#undef PH_BEGIN
#undef PH_END
}

#ifndef ONE_LAUNCH
#define ONE_LAUNCH 1
#endif
extern "C" void kernel_launch(void* const* d_in, const int* in_sizes, int n_in, void* d_out, int out_size, void* d_ws, size_t ws_size, hipStream_t stream) {
    static int grid = 0;
    if (grid == 0) {
        if (n_in != 25 || ws_size < WS_END) { fprintf(stderr, "kernel_launch: unexpected problem (n_in %d, ws %zu)\n", n_in, ws_size); grid = -1; return; }
        int dev = 0, cus = 0, per_cu = 0;
        (void)hipGetDevice(&dev);
        (void)hipDeviceGetAttribute(&cus, hipDeviceAttributeMultiprocessorCount, dev);
        if (hipFuncSetAttribute((const void*)fwd_kernel, hipFuncAttributeMaxDynamicSharedMemorySize, LDS_BYTES) != hipSuccess) { fprintf(stderr, "kernel_launch: hipFuncSetAttribute failed\n"); grid = -1; return; }
        if (hipOccupancyMaxActiveBlocksPerMultiprocessor(&per_cu, (const void*)fwd_kernel, NTHR, LDS_BYTES) != hipSuccess || per_cu < 1) { fprintf(stderr, "kernel_launch: occupancy query says %d\n", per_cu); per_cu = 1; }
        (void)hipGetLastError();
        if (cus <= 0) cus = 256;
        grid = cus * per_cu;
    }
    if (grid < 0) return;
    Args a{};
    for (int i = 0; i < 25; ++i) a.in[i] = (const float*)d_in[i];
    a.out = (float*)d_out; a.ws = (unsigned char*)d_ws;
#if ONE_LAUNCH
    a.ph_lo = 0; a.ph_hi = NPHASES;
    void* args[] = {&a};
    hipError_t e = hipLaunchCooperativeKernel((const void*)fwd_kernel, dim3(grid), dim3(NTHR), args, LDS_BYTES, stream);
    if (e != hipSuccess) fprintf(stderr, "kernel_launch: cooperative launch failed: %s (grid %d)\n", hipGetErrorString(e), grid);
#else
    for (int ph = 0; ph < NPHASES; ++ph) {
        a.ph_lo = ph; a.ph_hi = ph + 1;
        hipLaunchKernelGGL(fwd_kernel, dim3(grid), dim3(NTHR), LDS_BYTES, stream, a);
    }
#endif
}
```

```cpp
#include <hip/hip_runtime.h>
#include <hip/hip_cooperative_groups.h>
#include <cstdio>
#include <cstdint>
namespace cg = cooperative_groups;
namespace pg8 {
#define PG8_LAS __attribute__((address_space(3)))
typedef unsigned short bf16_t;
typedef short bf16x8 __attribute__((ext_vector_type(8)));
typedef float f32x4 __attribute__((ext_vector_type(4)));
typedef unsigned u32x4 __attribute__((ext_vector_type(4)));
constexpr int BM = 256, BK = 64, HALF = 128, HTB = HALF * BK * 2  , STAGE_BYTES = 8 * HTB, NXCD = 8, WGM = 8;

__host__ __device__ __forceinline__ int lds_byte(int r, int c) { const int st = (r >> 4) * 2 + (c >> 5), rr = r & 15, cc = c & 31, ob = rr * 64 + cc * 2; return st * 1024 + (ob ^ (((ob >> 9) & 1) << 5)); }
__host__ __device__ __forceinline__ void stage_rc(int b, int& R, int& C) { const int st = b / 1024, sb = b % 1024, swz = sb ^ (((sb >> 9) & 1) << 5); R = (st >> 1) * 16 + swz / 64; C = (st & 1) * 32 + (swz % 64) / 2; }
__host__ __device__ __forceinline__ int perm32(int rho) { const int n = rho >> 4, i = rho & 15; return 8 * (i >> 2) + 4 * n + (i & 3); }

struct Unit { int pm, pn; };
struct Gemm { const bf16_t* A; const bf16_t* Bt; int M, N, K; };

struct StaticOrder {
    int nM, nN, nwg, G, c;
    __host__ __device__ void init(int M, int N, int G_, int c_) { nM = M / BM; nN = N / BM; nwg = nM * nN; G = G_; c = c_; }
    __host__ __device__ bool next(int i, Unit& u) const {
        const long L = (long)i * G + c; if (L >= nwg) return false;
        int wgid = (int)L; { const int q = nwg / NXCD, r = nwg % NXCD, xcd = wgid % NXCD, off = wgid / NXCD; wgid = (xcd < r ? xcd * (q + 1) : r * (q + 1) + (xcd - r) * q) + off; }
        const int nig = WGM * nN, gid = wgid / nig, fm = gid * WGM, gsz = (nM - fm) < WGM ? (nM - fm) : WGM;
        u.pm = fm + ((wgid % nig) % gsz); u.pn = (wgid % nig) / gsz; return true;
    }
    __device__ __forceinline__ void a_ready(const Unit&) const {}
    __device__ __forceinline__ void done(const Unit&) const {}
};

__device__ __forceinline__ unsigned cvt_pk_bf16(float lo, float hi) { unsigned r; asm volatile("v_cvt_pk_bf16_f32 %0, %1, %2" : "=v"(r) : "v"(lo), "v"(hi)); return r; }
typedef unsigned u32x2 __attribute__((ext_vector_type(2)));

struct GroupedOrder {
    int upe, nNe, nwg, G, c;
    __host__ __device__ void init(int nNe_, int G_, int c_) { nNe = nNe_; upe = 8 * nNe_; nwg = 16 * upe; G = G_; c = c_; }
    __host__ __device__ bool next(int i, Unit& u) const {
        const long L = (long)i * G + c; if (L >= nwg) return false;
        int wgid = (int)L; { const int q = nwg / NXCD, r = nwg % NXCD, xcd = wgid % NXCD, off = wgid / NXCD; wgid = (xcd < r ? xcd * (q + 1) : r * (q + 1) + (xcd - r) * q) + off; }
        const int e = wgid / upe, rr = wgid % upe;
        u.pm = e * 8 + (rr & 7); u.pn = e * nNe + (rr >> 3); return true;
    }
    __device__ __forceinline__ void a_ready(const Unit&) const {}
    __device__ __forceinline__ void done(const Unit&) const {}
};

struct EpiStoreBf16 {
    static constexpr bool PERM = true, AFTER_DRAIN = false;
    bf16_t* O; int ldc;
    __device__ __forceinline__ void operator()(const f32x4 (&acc)[2][2][4][2], const Unit& u, int wr, int wc, int fr, int fq) const {
        const int row0 = u.pm * BM + wr * 64 + fr, col0 = u.pn * BM + wc * 32 + 8 * fq;
#pragma unroll
        for (int ai = 0; ai < 2; ++ai)
#pragma unroll
            for (int m = 0; m < 4; ++m) { bf16_t* rowp = O + (size_t)(row0 + ai * HALF + m * 16) * ldc + col0;
#pragma unroll
                for (int bj = 0; bj < 2; ++bj) { const f32x4 v0 = acc[ai][bj][m][0], v1 = acc[ai][bj][m][1];
                    u32x4 w; w.x = cvt_pk_bf16(v0[0], v0[1]); w.y = cvt_pk_bf16(v0[2], v0[3]); w.z = cvt_pk_bf16(v1[0], v1[1]); w.w = cvt_pk_bf16(v1[2], v1[3]);
                    *(u32x4*)(rowp + bj * HALF) = w; } }
    }
};
struct EpiResF32 {
    static constexpr bool PERM = false, AFTER_DRAIN = false;
    const float* base; float* O; int ldc; float alpha;
    __device__ __forceinline__ void operator()(const f32x4 (&acc)[2][2][4][2], const Unit& u, int wr, int wc, int fr, int fq) const {
        const int row0 = u.pm * BM + wr * 64 + fr, col0 = u.pn * BM + wc * 32 + 4 * fq;
#pragma unroll
        for (int ai = 0; ai < 2; ++ai)
#pragma unroll
            for (int m = 0; m < 4; ++m) { const size_t ro = (size_t)(row0 + ai * HALF + m * 16) * ldc + col0;
#pragma unroll
                for (int bj = 0; bj < 2; ++bj)
#pragma unroll
                    for (int n = 0; n < 2; ++n) { const f32x4 b = *(const f32x4*)(base + ro + bj * HALF + 16 * n); *(f32x4*)(O + ro + bj * HALF + 16 * n) = b * alpha + acc[ai][bj][m][n]; } }
    }
};
struct EpiSwiGLU {
    static constexpr bool PERM = true, AFTER_DRAIN = false;
    bf16_t* O; int ldc; int ntn;
    __device__ __forceinline__ void operator()(const f32x4 (&acc)[2][2][4][2], const Unit& u, int wr, int wc, int fr, int fq) const {
        const int row0 = u.pm * BM + wr * 64 + fr, col0 = ((u.pn % ntn) * BM + wc * 32 + 8 * fq) >> 1;
#pragma unroll
        for (int ai = 0; ai < 2; ++ai)
#pragma unroll
            for (int m = 0; m < 4; ++m) { bf16_t* rowp = O + (size_t)(row0 + ai * HALF + m * 16) * ldc + col0;
#pragma unroll
                for (int bj = 0; bj < 2; ++bj) { const f32x4 v0 = acc[ai][bj][m][0], v1 = acc[ai][bj][m][1];
                    const float h0 = v0[0] / (1.f + __expf(-v0[0])) * v0[1], h1 = v0[2] / (1.f + __expf(-v0[2])) * v0[3];
                    const float h2 = v1[0] / (1.f + __expf(-v1[0])) * v1[1], h3 = v1[2] / (1.f + __expf(-v1[2])) * v1[3];
                    u32x2 w; w.x = cvt_pk_bf16(h0, h1); w.y = cvt_pk_bf16(h2, h3);
                    *(u32x2*)(rowp + bj * (HALF / 2)) = w; } }
    }
};
struct EpiScaleRow {
    static constexpr bool PERM = true, AFTER_DRAIN = false;
    bf16_t* O; int ldc; int ntn; const float* gate;
    __device__ __forceinline__ void operator()(const f32x4 (&acc)[2][2][4][2], const Unit& u, int wr, int wc, int fr, int fq) const {
        const int row0 = u.pm * BM + wr * 64 + fr, col0 = (u.pn % ntn) * BM + wc * 32 + 8 * fq;
#pragma unroll
        for (int ai = 0; ai < 2; ++ai)
#pragma unroll
            for (int m = 0; m < 4; ++m) { const int row = row0 + ai * HALF + m * 16; const float gsc = gate[row]; bf16_t* rowp = O + (size_t)row * ldc + col0;
#pragma unroll
                for (int bj = 0; bj < 2; ++bj) { const f32x4 v0 = acc[ai][bj][m][0] * gsc, v1 = acc[ai][bj][m][1] * gsc;
                    u32x4 w; w.x = cvt_pk_bf16(v0[0], v0[1]); w.y = cvt_pk_bf16(v0[2], v0[3]); w.z = cvt_pk_bf16(v1[0], v1[1]); w.w = cvt_pk_bf16(v1[2], v1[3]);
                    *(u32x4*)(rowp + bj * HALF) = w; } }
    }
};

template <class Epi, class Sched, bool ALIGN_EPI = false, bool SP2 = false>
__device__ __forceinline__ void gemm_phase(PG8_LAS unsigned char* lds, const Gemm g, const Sched& S, const Epi& E) {
    int tid_ = threadIdx.x; asm volatile("" : "+v"(tid_)); const int tid = tid_, wid = __builtin_amdgcn_readfirstlane(tid >> 6), lane = tid & 63, wr = wid >> 2, wc = wid & 3, fr = lane & 15, fq = lane >> 4;
    const int K = g.K, nt = K / BK;
    unsigned voffA[2], voffB[2];
#pragma unroll
    for (int i = 0; i < 2; ++i) { int R, C; stage_rc(tid * 16 + i * 8192, R, C); const int Rb = Epi::PERM ? ((R & ~31) + perm32(R & 31)) : R;
        voffA[i] = (unsigned)(R * K + C) * 2u; voffB[i] = (unsigned)(Rb * K + C) * 2u; }
    const size_t kstep = (size_t)(BK * 2);
    const size_t hstep = (size_t)HALF * K * 2;
    const size_t tstep = 2 * hstep;
    const unsigned ldsw = (unsigned)wid * 1024u;
    const int aoff = lds_byte(wr * 64 + fr, fq * 8), boff = lds_byte(wc * 32 + fr, fq * 8);
#define PG8_SA(b, h) (((b) * 2 + (h)) * HTB)
#define PG8_SB(b, h) ((4 + (b) * 2 + (h)) * HTB)
#define PG8_STAGE(bufoff, gbase, voff) do { _Pragma("unroll") for (int _i = 0; _i < 2; ++_i) \
        __builtin_amdgcn_global_load_lds((const unsigned*)((const char*)(gbase) + (voff)[_i]), (PG8_LAS unsigned*)(lds + (bufoff) + ldsw + _i * 8192), 16, 0, 0); } while (0)
#define PG8_LDA(dst, b, h) do { _Pragma("unroll") for (int m = 0; m < 4; ++m) _Pragma("unroll") for (int k = 0; k < 2; ++k) dst[m][k] = *(const PG8_LAS bf16x8*)(lds + PG8_SA(b, h) + aoff + m * 2048 + k * 1024); } while (0)
#define PG8_LDB(dst, b, h) do { _Pragma("unroll") for (int n = 0; n < 2; ++n) _Pragma("unroll") for (int k = 0; k < 2; ++k) dst[n][k] = *(const PG8_LAS bf16x8*)(lds + PG8_SB(b, h) + boff + n * 2048 + k * 1024); } while (0)
#define PG8_MMA(ai, bj, At, Bt) do { __builtin_amdgcn_s_setprio(1); _Pragma("unroll") for (int m = 0; m < 4; ++m) _Pragma("unroll") for (int n = 0; n < 2; ++n) _Pragma("unroll") for (int k = 0; k < 2; ++k) \
        acc[ai][bj][m][n] = __builtin_amdgcn_mfma_f32_16x16x32_bf16(Bt[n][k], At[m][k], acc[ai][bj][m][n], 0, 0, 0); __builtin_amdgcn_s_setprio(0); } while (0)
#define PG8_WAIT_V(n) asm volatile("s_waitcnt vmcnt(" #n ")" ::: "memory")
#define PG8_WAIT_L(n) asm volatile("s_waitcnt lgkmcnt(" #n ")" ::: "memory")
#define PG8_BAR __builtin_amdgcn_s_barrier()
#define PG8_SCHED __builtin_amdgcn_sched_barrier(0)
    Unit cur, nxt; int ui = 0;
    if (!S.next(0, cur)) return;
    f32x4 acc[2][2][4][2];
#pragma unroll
    for (int a = 0; a < 2; ++a)
#pragma unroll
        for (int b = 0; b < 2; ++b)
#pragma unroll
            for (int m = 0; m < 4; ++m)
#pragma unroll
                for (int n = 0; n < 2; ++n) acc[a][b][m][n] = (f32x4){0.f, 0.f, 0.f, 0.f};
    bf16x8 At[4][2], B0[2][2], B1[2][2];
    const char* cA = (const char*)g.A + (size_t)cur.pm * tstep; const char* cB = (const char*)g.Bt + (size_t)cur.pn * tstep;
    S.a_ready(cur);
    if constexpr (SP2) {
        PG8_STAGE(PG8_SB(0, 0), cB, voffB); PG8_STAGE(PG8_SB(0, 1), cB + hstep, voffB); PG8_STAGE(PG8_SA(0, 0), cA, voffA); PG8_STAGE(PG8_SA(0, 1), cA + hstep, voffA);
        if (wr == 1) PG8_BAR;
        PG8_WAIT_V(2); PG8_BAR;
        PG8_STAGE(PG8_SB(1, 0), cB + kstep, voffB); PG8_STAGE(PG8_SA(1, 0), cA + kstep, voffA); PG8_STAGE(PG8_SB(1, 1), cB + hstep + kstep, voffB);
        PG8_WAIT_V(6); PG8_BAR;
    } else {
        PG8_STAGE(PG8_SB(0, 0), cB, voffB); PG8_STAGE(PG8_SA(0, 0), cA, voffA); PG8_STAGE(PG8_SB(0, 1), cB + hstep, voffB); PG8_STAGE(PG8_SA(0, 1), cA + hstep, voffA);
        if (wr == 1) PG8_BAR;
        PG8_WAIT_V(4); PG8_BAR;
        PG8_STAGE(PG8_SB(1, 0), cB + kstep, voffB); PG8_STAGE(PG8_SA(1, 0), cA + kstep, voffA); PG8_STAGE(PG8_SB(1, 1), cB + hstep + kstep, voffB);
        PG8_WAIT_V(6); PG8_BAR;
    }
    for (;;) {
        const bool has_next = S.next(ui + 1, nxt);
        const char* nA = has_next ? (const char*)g.A + (size_t)nxt.pm * tstep : cA; const char* nB = has_next ? (const char*)g.Bt + (size_t)nxt.pn * tstep : cB;
        for (int t = 0; t < nt; t += 2) {
            const bool last = (t == nt - 2);
            const char* a1 = cA + (size_t)(t + 1) * kstep;
            const char* a2 = last ? nA : cA + (size_t)(t + 2) * kstep; const char* b2 = last ? nB : cB + (size_t)(t + 2) * kstep;
            const char* a3 = a2 + kstep; const char* b3 = b2 + kstep;
            if (last && has_next) S.a_ready(nxt);
            if constexpr (SP2) {
            PG8_LDB(B0, 0, 0); PG8_LDB(B1, 0, 1); PG8_SCHED; PG8_LDA(At, 0, 0); PG8_STAGE(PG8_SA(1, 1), a1 + hstep, voffA);
            PG8_WAIT_V(8); PG8_WAIT_L(0); PG8_BAR; PG8_MMA(0, 0, At, B0); PG8_MMA(0, 1, At, B1); PG8_BAR; PG8_SCHED;
            PG8_LDA(At, 0, 1); PG8_STAGE(PG8_SB(0, 0), b2, voffB); PG8_STAGE(PG8_SB(0, 1), b2 + hstep, voffB); PG8_STAGE(PG8_SA(0, 0), a2, voffA);
            PG8_WAIT_V(8); PG8_WAIT_L(0); PG8_BAR; PG8_MMA(1, 0, At, B0); PG8_MMA(1, 1, At, B1); PG8_BAR; PG8_SCHED;
            PG8_LDB(B0, 1, 0); PG8_LDB(B1, 1, 1); PG8_SCHED; PG8_LDA(At, 1, 0); PG8_STAGE(PG8_SA(0, 1), a2 + hstep, voffA);
            PG8_WAIT_V(8); PG8_WAIT_L(0); PG8_BAR; PG8_MMA(0, 0, At, B0); PG8_MMA(0, 1, At, B1); PG8_BAR; PG8_SCHED;
            PG8_LDA(At, 1, 1); PG8_STAGE(PG8_SB(1, 0), b3, voffB); PG8_STAGE(PG8_SB(1, 1), b3 + hstep, voffB); PG8_STAGE(PG8_SA(1, 0), a3, voffA);
            PG8_WAIT_V(8); PG8_WAIT_L(0); PG8_BAR; PG8_MMA(1, 0, At, B0); PG8_MMA(1, 1, At, B1); PG8_BAR; PG8_SCHED;
            } else {
            PG8_LDB(B0, 0, 0); PG8_SCHED; PG8_LDA(At, 0, 0); PG8_STAGE(PG8_SA(1, 1), a1 + hstep, voffA);
            PG8_WAIT_L(8); PG8_BAR; PG8_WAIT_L(0); PG8_MMA(0, 0, At, B0); PG8_BAR; PG8_SCHED;
            PG8_LDB(B1, 0, 1); PG8_STAGE(PG8_SB(0, 0), b2, voffB);
            PG8_BAR; PG8_WAIT_L(0); PG8_MMA(0, 1, At, B1); PG8_BAR;
            PG8_LDA(At, 0, 1); PG8_STAGE(PG8_SA(0, 0), a2, voffA);
            PG8_BAR; PG8_WAIT_L(0); PG8_MMA(1, 0, At, B0); PG8_BAR; PG8_SCHED;
            PG8_STAGE(PG8_SB(0, 1), b2 + hstep, voffB);
            PG8_WAIT_V(6); PG8_BAR; PG8_MMA(1, 1, At, B1); PG8_BAR;
            PG8_LDB(B0, 1, 0); PG8_SCHED; PG8_LDA(At, 1, 0); PG8_STAGE(PG8_SA(0, 1), a2 + hstep, voffA);
            PG8_WAIT_L(8); PG8_BAR; PG8_WAIT_L(0); PG8_MMA(0, 0, At, B0); PG8_BAR; PG8_SCHED;
            PG8_LDB(B1, 1, 1); PG8_STAGE(PG8_SB(1, 0), b3, voffB);
            PG8_BAR; PG8_WAIT_L(0); PG8_MMA(0, 1, At, B1); PG8_BAR;
            PG8_LDA(At, 1, 1); PG8_STAGE(PG8_SA(1, 0), a3, voffA);
            PG8_BAR; PG8_WAIT_L(0); PG8_MMA(1, 0, At, B0); PG8_BAR; PG8_SCHED;
            PG8_STAGE(PG8_SB(1, 1), b3 + hstep, voffB);
            PG8_WAIT_V(6); PG8_BAR; PG8_MMA(1, 1, At, B1); PG8_BAR;
            }
        }
        if constexpr (ALIGN_EPI) { if (wr == 0) PG8_BAR; }
        if constexpr (!Epi::AFTER_DRAIN) { E(acc, cur, wr, wc, fr, fq); S.done(cur); }
        if (!has_next) break;
#pragma unroll
        for (int a = 0; a < 2; ++a)
#pragma unroll
            for (int b = 0; b < 2; ++b)
#pragma unroll
                for (int m = 0; m < 4; ++m)
#pragma unroll
                    for (int n = 0; n < 2; ++n) acc[a][b][m][n] = (f32x4){0.f, 0.f, 0.f, 0.f};
        cur = nxt; cA = nA; cB = nB; ++ui;
        if constexpr (ALIGN_EPI) { if (wr == 1) PG8_BAR; }
    }
    PG8_WAIT_V(0);
    if constexpr (!ALIGN_EPI) { if (wr == 0) PG8_BAR; }
    PG8_BAR;
    if constexpr (Epi::AFTER_DRAIN) { E.fused(acc, cur, wr, wc, fr, fq, lds, wid, lane); S.done(cur); }
#undef PG8_SA
#undef PG8_SB
#undef PG8_STAGE
#undef PG8_LDA
#undef PG8_LDB
#undef PG8_MMA
#undef PG8_WAIT_V
#undef PG8_WAIT_L
#undef PG8_BAR
#undef PG8_SCHED
}
}

using pg8::bf16_t; using pg8::bf16x8; using pg8::f32x4; using pg8::u32x4; using pg8::u32x2;
#define LAS __attribute__((address_space(3)))
typedef short bf16x4 __attribute__((ext_vector_type(4)));

constexpr int NB = 4, SEQ = 4096, DM = 1024, MTOK = NB * SEQ, DIN = 2048, NE = 16, FF = 2048, CAP = 512, NROWX = NE * NB * CAP;
constexpr float ALPHA = 1.41421356237309515f, LN_EPS = 1e-5f;
constexpr int NWAVES = 8, NTHR = 512;
constexpr int LDS_BYTES = 147456;
constexpr int S5T = 32, S5NCH = SEQ / S5T;

constexpr size_t MiB = 1u << 20;
constexpr size_t WS_WIN = 0, WS_WOUT = 8 * MiB, WS_WGLU = 12 * MiB, WS_S5TAB = 13 * MiB, WS_AFFT = 14 * MiB, WS_IDX = 15 * MiB, WS_GATE = 16 * MiB, WS_SLOT = 17 * MiB, WS_BAR = 18 * MiB;
constexpr size_t WS_WGU = 32 * MiB, WS_WD = 288 * MiB, WS_H32 = 416 * MiB, WS_HBF = 480 * MiB, WS_RA = 512 * MiB  , WS_RB = 576 * MiB  ;
constexpr size_t WS_HDN = 640 * MiB, WS_KVF = 768 * MiB, WS_KVB = 776 * MiB, WS_STF = 784 * MiB, WS_STB = 792 * MiB, WS_S5E = 800 * MiB, WS_S5C = 808 * MiB, WS_END = 816 * MiB;

struct Args { const float* in[25]; float* out; unsigned char* ws; int ph_lo, ph_hi; };

__device__ __forceinline__ unsigned f2bf(float f) { unsigned u = __float_as_uint(f); return (u + 0x7fffu + ((u >> 16) & 1u)) >> 16; }
__device__ __forceinline__ unsigned pk2(float lo, float hi) { return f2bf(lo) | (f2bf(hi) << 16); }
__device__ __forceinline__ float bflo(unsigned w) { return __uint_as_float(w << 16); }
__device__ __forceinline__ float bfhi(unsigned w) { return __uint_as_float(w & 0xffff0000u); }
__device__ __forceinline__ f32x4 mfma16(bf16x8 a, bf16x8 b, f32x4 c) { return __builtin_amdgcn_mfma_f32_16x16x32_bf16(a, b, c, 0, 0, 0); }
__device__ __forceinline__ float wave_sum(float v) {
#pragma unroll
    for (int o = 1; o < 64; o <<= 1) v += __shfl_xor(v, o);
    return v;
}
__device__ __forceinline__ bf16x8 pack8(const f32x4& a, const f32x4& b) {
    u32x4 w; w.x = pg8::cvt_pk_bf16(a[0], a[1]); w.y = pg8::cvt_pk_bf16(a[2], a[3]); w.z = pg8::cvt_pk_bf16(b[0], b[1]); w.w = pg8::cvt_pk_bf16(b[2], b[3]);
    return __builtin_bit_cast(bf16x8, w);
}
__device__ __forceinline__ bf16x8 cat8(bf16x4 lo, bf16x4 hi) { bf16x8 r; r[0] = lo[0]; r[1] = lo[1]; r[2] = lo[2]; r[3] = lo[3]; r[4] = hi[0]; r[5] = hi[1]; r[6] = hi[2]; r[7] = hi[3]; return r; }
#define LDS_WAIT() asm volatile("s_waitcnt lgkmcnt(0)" ::: "memory")

struct ConvItem { const float* srcp; bf16_t* dstp; int N; };
__device__ __forceinline__ ConvItem conv_decode(const Args& a, int it, int lane) {
    constexpr int I3 = 16384, I4 = 16384, I5 = 16384, I0 = 1024, I1 = 512;
    unsigned char* ws = a.ws;
    const float* src; bf16_t* dst; int K, N, rmul = 1, ro = 0, kb, nb;
    int r = it;
    if (r < I3 + I4) { const int up = r >= I3; r -= up ? I3 : 0; const int mat = r >> 9, q = r & 511; src = (up ? a.in[21] : a.in[20]) + (size_t)mat * DM * FF; dst = (bf16_t*)(ws + WS_WGU) + (size_t)mat * 2 * FF * DM; K = DM; N = FF; rmul = 2; ro = up; kb = q >> 5; nb = q & 31; }
    else { r -= I3 + I4;
        if (r < I5) { const int mat = r >> 9, q = r & 511; src = a.in[22] + (size_t)mat * FF * DM; dst = (bf16_t*)(ws + WS_WD) + (size_t)mat * DM * FF; K = FF; N = DM; kb = q >> 4; nb = q & 15; }
        else { r -= I5;
            if (r < I0) { const int mat = r >> 9, q = r & 511; src = a.in[3] + (size_t)mat * DM * DIN; dst = (bf16_t*)(ws + WS_WIN) + (size_t)mat * DIN * DM; K = DM; N = DIN; kb = q >> 5; nb = q & 31; }
            else { r -= I0;
                if (r < I1) { const int mat = r >> 8, q = r & 255; src = a.in[16] + (size_t)mat * DM * DM; dst = (bf16_t*)(ws + WS_WOUT) + (size_t)mat * DM * DM; K = DM; N = DM; kb = q >> 4; nb = q & 15; }
                else { r -= I1; const int mat = r >> 4, q = r & 15; src = a.in[13] + (size_t)mat * 65536; dst = (bf16_t*)(ws + WS_WGLU) + (size_t)mat * 65536; K = 256; N = 256; kb = q >> 2; nb = q & 3; } } } }
    ConvItem c; c.N = N;
    c.srcp = src + (size_t)(kb * 64 + (lane >> 4)) * N + nb * 64 + (lane & 15) * 4;
    c.dstp = dst + (size_t)((nb * 64 + lane) * rmul + ro) * K + kb * 64;
    return c;
}
__device__ __forceinline__ void conv_load(const ConvItem& c, f32x4 (&v)[16]) {
#pragma unroll
    for (int i = 0; i < 16; ++i) v[i] = __builtin_nontemporal_load((const f32x4*)(c.srcp + (size_t)(i * 4) * c.N));
}
__device__ __forceinline__ void conv_store(const ConvItem& c, const f32x4 (&v)[16], LAS float* scr, int lane) {
    const int r4 = lane >> 4, c4 = (lane & 15) * 4;
#pragma unroll
    for (int i = 0; i < 16; ++i) *(LAS f32x4*)(scr + (i * 4 + r4) * 68 + c4) = v[i];
    LDS_WAIT();
#pragma unroll
    for (int p = 0; p < 8; ++p) {
        const LAS float* s = scr + (8 * p) * 68 + lane;
        u32x4 o; o.x = pk2(s[0], s[68]); o.y = pk2(s[2 * 68], s[3 * 68]); o.z = pk2(s[4 * 68], s[5 * 68]); o.w = pk2(s[6 * 68], s[7 * 68]);
        *(u32x4*)(c.dstp + 8 * p) = o;
    }
    LDS_WAIT();
}
__device__ __forceinline__ void sincos_rev(double f, double& sn, double& cs) {
    const double a = f * 6.283185307179586476925;
    const double q = rint(a * 0.636619772367581343);
    const double r = a - q * 1.570796326794896619;
    const double r2 = r * r;
    double s = -7.6471637318198164759e-13; s = s * r2 + 1.6059043836821614599e-10; s = s * r2 - 2.5052108385441718775e-8; s = s * r2 + 2.7557319223985890653e-6;
    s = s * r2 - 1.9841269841269841270e-4; s = s * r2 + 8.3333333333333333333e-3; s = s * r2 - 1.6666666666666666667e-1; s = s * r2 * r + r;
    double c = 4.7794773323873852974e-14; c = c * r2 - 1.1470745597729724714e-11; c = c * r2 + 2.0876756987868098979e-9; c = c * r2 - 2.7557319223985890653e-7;
    c = c * r2 + 2.4801587301587301587e-5; c = c * r2 - 1.3888888888888888889e-3; c = c * r2 + 4.1666666666666666667e-2; c = c * r2 - 0.5; c = c * r2 + 1.0;
    const int qi = ((int)q) & 3;
    sn = (qi == 0) ? s : (qi == 1) ? c : (qi == 2) ? -s : -c;
    cs = (qi == 0) ? c : (qi == 1) ? -s : (qi == 2) ? -c : s;
}
__device__ __forceinline__ double exp_small(double x) {
    const double y = x * (1.0 / 64.0);
    double e = 1.0 / 479001600.0;
    e = e * y + 1.0 / 39916800.0; e = e * y + 1.0 / 3628800.0; e = e * y + 1.0 / 362880.0; e = e * y + 1.0 / 40320.0; e = e * y + 1.0 / 5040.0; e = e * y + 1.0 / 720.0;
    e = e * y + 1.0 / 120.0; e = e * y + 1.0 / 24.0; e = e * y + 1.0 / 6.0; e = e * y + 0.5; e = e * y + 1.0; e = e * y + 1.0;
#pragma unroll
    for (int i = 0; i < 6; ++i) e = e * e;
    return e;
}
__device__ __forceinline__ void s5_table_entry(const Args& a, int t) {
    const int g = (t >> 6) & 15, lr = t >> 10;
    const double lre = (double)a.in[5][t], lim = (double)a.in[6][t];
    const double step = exp_small((double)a.in[7][lr * 16 + g]);
    const double ar = lre * step, th = lim * step;
    const double rev = th * 0.15915494309189533577; const double fr = rev - rint(rev);
    double sn, cs; sincos_rev(fr, sn, cs);
    const double mag = exp_small(ar);
    const double br = mag * cs, bi = mag * sn;
    const double nr = br - 1.0, ni = bi, den = lre * lre + lim * lim;
    const double cr = (nr * lre + ni * lim) / den, ci = (ni * lre - nr * lim) / den;
    const double rev2 = rev * (double)S5T; const double fr2 = rev2 - rint(rev2);
    double sn2, cs2; sincos_rev(fr2, sn2, cs2);
    const double mag2 = exp_small(ar * (double)S5T);
    float* o = (float*)(a.ws + WS_S5TAB) + (size_t)t * 8;
    o[0] = (float)br; o[1] = (float)bi; o[2] = (float)cr; o[3] = (float)ci; o[4] = (float)(mag2 * cs2); o[5] = (float)(mag2 * sn2); o[6] = 0.f; o[7] = 0.f;
}
__device__ __forceinline__ void ln_rows4(f32x4 (&v)[4], const float* __restrict__ g, const float* __restrict__ bt, int lane) {
    float s = 0.f;
#pragma unroll
    for (int j = 0; j < 4; ++j) s += (v[j][0] + v[j][1]) + (v[j][2] + v[j][3]);
    const float mean = wave_sum(s) * (1.f / DM); float s2 = 0.f;
#pragma unroll
    for (int j = 0; j < 4; ++j) { v[j] = v[j] - mean; s2 += (v[j][0] * v[j][0] + v[j][1] * v[j][1]) + (v[j][2] * v[j][2] + v[j][3] * v[j][3]); }
    const float rstd = 1.f / sqrtf(wave_sum(s2) * (1.f / DM) + LN_EPS);
#pragma unroll
    for (int j = 0; j < 4; ++j) { const f32x4 gv = ((const f32x4*)g)[lane + 64 * j], bv = ((const f32x4*)bt)[lane + 64 * j]; v[j] = v[j] * rstd * gv + bv; }
}
__device__ __forceinline__ void store_row(const f32x4 (&v)[4], float* o32, bf16_t* obf, int lane) {
#pragma unroll
    for (int j = 0; j < 4; ++j) {
        if (o32) ((f32x4*)o32)[lane + 64 * j] = v[j];
        if (obf) { u32x2 w; w.x = pk2(v[j][0], v[j][1]); w.y = pk2(v[j][2], v[j][3]); ((u32x2*)obf)[lane + 64 * j] = w; }
    }
}
__device__ __forceinline__ void phase_p0(const Args& a, LAS unsigned char* lds, int tid) {
    const int lane = tid & 63, wave = tid >> 6;
    const int gw = blockIdx.x * NWAVES + wave, NGW = gridDim.x * NWAVES;
    LAS float* scr = (LAS float*)(lds + wave * 17408);
    unsigned char* ws = a.ws;
    constexpr int NIT = 16384 * 3 + 1024 + 512 + 32;
    if (gw < NIT) {
        ConvItem cur = conv_decode(a, gw, lane);
        f32x4 v[16]; conv_load(cur, v);
        for (int it = gw; it < NIT; it += NGW) {
            const bool more = (it + NGW) < NIT;
            ConvItem nxt = cur; f32x4 vn[16];
            if (more) { nxt = conv_decode(a, it + NGW, lane); conv_load(nxt, vn); }
            conv_store(cur, v, scr, lane);
            if (more) { cur = nxt;
#pragma unroll
                for (int i = 0; i < 16; ++i) v[i] = vn[i]; }
        }
    }
    for (int t = blockIdx.x * NTHR + tid; t < 4096; t += gridDim.x * NTHR) s5_table_entry(a, t);
    for (int m = gw; m < MTOK; m += NGW) {
        f32x4 v[4];
#pragma unroll
        for (int j = 0; j < 4; ++j) v[j] = ((const f32x4*)(a.in[0] + (size_t)m * DM))[lane + 64 * j];
        ln_rows4(v, a.in[1], a.in[2], lane);
        store_row(v, (float*)(ws + WS_H32) + (size_t)m * DM, (bf16_t*)(ws + WS_HBF) + (size_t)m * DM, lane);
    }
}

__device__ __forceinline__ void attn_item(int item, const bf16_t* __restrict__ proj, bf16_t* __restrict__ mix, const float* __restrict__ sink_l, LAS unsigned char* lds, int tid) {
    const int kh = item & 1, c = (item >> 1) & 31, b = item >> 6;
    constexpr int VS = 392;
    LAS bf16_t* Ks = (LAS bf16_t*)lds;
    LAS bf16_t* Vt = (LAS bf16_t*)(lds + 384 * 72 * 2);
#pragma unroll
    for (int i = 0; i < 6; ++i) {
        const int id = tid + NTHR * i, key = id >> 3, ch = id & 7;
        const int s = (c - 1) * 128 + key; const bool ok = (s >= 0) && (s < SEQ);
        u32x4 kv = {0u, 0u, 0u, 0u}, vv = {0u, 0u, 0u, 0u};
        if (ok) { const bf16_t* rowp = proj + (size_t)(b * SEQ + s) * DIN; kv = *(const u32x4*)(rowp + 1792 + kh * 64 + ch * 8); vv = *(const u32x4*)(rowp + 1920 + kh * 64 + ch * 8); }
        *(LAS u32x4*)(Ks + key * 72 + ch * 8) = kv;
        LAS bf16_t* vp = Vt + (ch * 8) * VS + key;
        vp[0 * VS] = (bf16_t)(vv.x & 0xffffu); vp[1 * VS] = (bf16_t)(vv.x >> 16); vp[2 * VS] = (bf16_t)(vv.y & 0xffffu); vp[3 * VS] = (bf16_t)(vv.y >> 16);
        vp[4 * VS] = (bf16_t)(vv.z & 0xffffu); vp[5 * VS] = (bf16_t)(vv.z >> 16); vp[6 * VS] = (bf16_t)(vv.w & 0xffffu); vp[7 * VS] = (bf16_t)(vv.w >> 16);
    }
    __syncthreads();
    const int lane = tid & 63, w = tid >> 6, fr = lane & 15, fq = lane >> 4;
    const int hq = kh * 4 + (w >> 1);
    const float slope = exp2f(-(float)(hq + 1));
    const float sinkv = sink_l[hq];
    const bool lo_ok = (c >= 1), hi_ok = (c <= 30);
    for (int qi = 0; qi < 4; ++qi) {
        const int qt = (w & 1) * 4 + qi, qpos = qt * 16 + fr;
        const size_t tok = (size_t)b * SEQ + c * 128 + qpos;
        const bf16_t* qp = proj + tok * DIN + 1280 + hq * 64 + fq * 8;
        const bf16x8 q0 = *(const bf16x8*)qp, q1 = *(const bf16x8*)(qp + 32);
        f32x4 s[24];
#pragma unroll
        for (int kt = 0; kt < 24; ++kt) {
            const LAS bf16_t* kp = Ks + (kt * 16 + fr) * 72 + fq * 8;
            f32x4 acc = {0.f, 0.f, 0.f, 0.f};
            acc = mfma16(*(const LAS bf16x8*)kp, q0, acc); acc = mfma16(*(const LAS bf16x8*)(kp + 32), q1, acc);
            s[kt] = acc;
        }
        float mx = sinkv;
#pragma unroll
        for (int kt = 0; kt < 24; ++kt)
#pragma unroll
            for (int j = 0; j < 4; ++j) {
                const int ks = kt * 16 + fq * 4 + j, rel = ks - 128 - qpos, arel = rel < 0 ? -rel : rel;
                const bool valid = (arel <= 128) && (kt < 8 ? lo_ok : (kt >= 16 ? hi_ok : true));
                const float v = valid ? (s[kt][j] * 0.125f - slope * (float)arel) : -1e30f;
                s[kt][j] = v; mx = fmaxf(mx, v);
            }
        mx = fmaxf(mx, __shfl_xor(mx, 16)); mx = fmaxf(mx, __shfl_xor(mx, 32));
        float sum = 0.f;
#pragma unroll
        for (int kt = 0; kt < 24; ++kt)
#pragma unroll
            for (int j = 0; j < 4; ++j) { const float p = __expf(s[kt][j] - mx); s[kt][j] = p; sum += p; }
        sum += __shfl_xor(sum, 16); sum += __shfl_xor(sum, 32);
        const float inv = 1.f / (sum + __expf(sinkv - mx));
        f32x4 o[4];
#pragma unroll
        for (int dt = 0; dt < 4; ++dt) o[dt] = (f32x4){0.f, 0.f, 0.f, 0.f};
#pragma unroll
        for (int kk = 0; kk < 12; ++kk) {
            const bf16x8 pb = pack8(s[2 * kk], s[2 * kk + 1]);
#pragma unroll
            for (int dt = 0; dt < 4; ++dt) {
                const LAS bf16_t* vp = Vt + (dt * 16 + fr) * VS + kk * 32 + fq * 4;
                o[dt] = mfma16(cat8(*(const LAS bf16x4*)vp, *(const LAS bf16x4*)(vp + 16)), pb, o[dt]);
            }
        }
        bf16_t* op = mix + tok * DM + 512 + hq * 64 + fq * 4;
#pragma unroll
        for (int dt = 0; dt < 4; ++dt) { u32x2 wv; wv.x = pk2(o[dt][0] * inv, o[dt][1] * inv); wv.y = pk2(o[dt][2] * inv, o[dt][3] * inv); *(u32x2*)(op + dt * 16) = wv; }
    }
    __syncthreads();
}

__device__ __forceinline__ float log_sigmoid(float t) { return -log1pf(__expf(-t)); }
__device__ __forceinline__ void retkv_item(int item, const bf16_t* __restrict__ proj, float* __restrict__ kvf, float* __restrict__ kvb, const float* __restrict__ theta, LAS unsigned char* lds, int tid) {
    const int h = item & 3, c = (item >> 2) & 31, b = item >> 7;
    const float lgf = log_sigmoid(theta[h]), lgb = log_sigmoid(theta[4 + h]);
    LAS bf16_t* KTf = (LAS bf16_t*)lds; LAS bf16_t* KTb = KTf + 64 * 136; LAS bf16_t* VT = KTb + 64 * 136;
#pragma unroll
    for (int i = 0; i < 2; ++i) {
        const int id = tid + NTHR * i, j = id >> 3, ch = id & 7;
        const bf16_t* rowp = proj + (size_t)(b * SEQ + c * 128 + j) * DIN;
        const u32x4 kr = *(const u32x4*)(rowp + 256 + h * 64 + ch * 8), vr = *(const u32x4*)(rowp + 512 + h * 64 + ch * 8);
        const float wf = __expf(lgf * (float)(127 - j)) * 0.125f, wb = __expf(lgb * (float)j) * 0.125f;
        const int o = (ch * 8) * 136 + j;
        KTf[o + 0 * 136] = (bf16_t)f2bf(bflo(kr.x) * wf); KTf[o + 1 * 136] = (bf16_t)f2bf(bfhi(kr.x) * wf); KTf[o + 2 * 136] = (bf16_t)f2bf(bflo(kr.y) * wf); KTf[o + 3 * 136] = (bf16_t)f2bf(bfhi(kr.y) * wf);
        KTf[o + 4 * 136] = (bf16_t)f2bf(bflo(kr.z) * wf); KTf[o + 5 * 136] = (bf16_t)f2bf(bfhi(kr.z) * wf); KTf[o + 6 * 136] = (bf16_t)f2bf(bflo(kr.w) * wf); KTf[o + 7 * 136] = (bf16_t)f2bf(bfhi(kr.w) * wf);
        KTb[o + 0 * 136] = (bf16_t)f2bf(bflo(kr.x) * wb); KTb[o + 1 * 136] = (bf16_t)f2bf(bfhi(kr.x) * wb); KTb[o + 2 * 136] = (bf16_t)f2bf(bflo(kr.y) * wb); KTb[o + 3 * 136] = (bf16_t)f2bf(bfhi(kr.y) * wb);
        KTb[o + 4 * 136] = (bf16_t)f2bf(bflo(kr.z) * wb); KTb[o + 5 * 136] = (bf16_t)f2bf(bfhi(kr.z) * wb); KTb[o + 6 * 136] = (bf16_t)f2bf(bflo(kr.w) * wb); KTb[o + 7 * 136] = (bf16_t)f2bf(bfhi(kr.w) * wb);
        VT[o + 0 * 136] = (bf16_t)(vr.x & 0xffffu); VT[o + 1 * 136] = (bf16_t)(vr.x >> 16); VT[o + 2 * 136] = (bf16_t)(vr.y & 0xffffu); VT[o + 3 * 136] = (bf16_t)(vr.y >> 16);
        VT[o + 4 * 136] = (bf16_t)(vr.z & 0xffffu); VT[o + 5 * 136] = (bf16_t)(vr.z >> 16); VT[o + 6 * 136] = (bf16_t)(vr.w & 0xffffu); VT[o + 7 * 136] = (bf16_t)(vr.w >> 16);
    }
    __syncthreads();
    const int lane = tid & 63, w = tid >> 6, fr = lane & 15, fq = lane >> 4;
    const size_t obase = (size_t)((b * 32 + c) * 4 + h) * 4096;
#pragma unroll
    for (int i = 0; i < 4; ++i) {
        const int job = w * 4 + i, dirb = job >> 4, et = (job >> 2) & 3, dt = job & 3;
        const LAS bf16_t* ap = VT + (et * 16 + fr) * 136 + fq * 8;
        const LAS bf16_t* bp = (dirb ? KTb : KTf) + (dt * 16 + fr) * 136 + fq * 8;
        f32x4 acc = {0.f, 0.f, 0.f, 0.f};
#pragma unroll
        for (int ks = 0; ks < 4; ++ks) acc = mfma16(*(const LAS bf16x8*)(ap + ks * 32), *(const LAS bf16x8*)(bp + ks * 32), acc);
        float* op = (dirb ? kvb : kvf) + obase + (et * 16 + fq * 4) * 64 + dt * 16 + fr;
        op[0] = acc[0]; op[64] = acc[1]; op[128] = acc[2]; op[192] = acc[3];
    }
    __syncthreads();
}
__device__ __forceinline__ void retout_item(int item, const bf16_t* __restrict__ proj, const float* __restrict__ stf, const float* __restrict__ stb, bf16_t* __restrict__ mix, const float* __restrict__ theta, LAS unsigned char* lds, int tid) {
    const int h = item & 3, c = (item >> 2) & 31, b = item >> 7;
    const float lgf = log_sigmoid(theta[h]), lgb = log_sigmoid(theta[4 + h]);
    LAS bf16_t* Qs = (LAS bf16_t*)lds; LAS bf16_t* Ks = Qs + 128 * 72; LAS bf16_t* VT = Ks + 128 * 72; LAS bf16_t* SFt = VT + 64 * 136; LAS bf16_t* SBt = SFt + 64 * 72;
#pragma unroll
    for (int i = 0; i < 2; ++i) {
        const int id = tid + NTHR * i, j = id >> 3, ch = id & 7;
        const bf16_t* rowp = proj + (size_t)(b * SEQ + c * 128 + j) * DIN;
        const u32x4 qr = *(const u32x4*)(rowp + h * 64 + ch * 8), kr = *(const u32x4*)(rowp + 256 + h * 64 + ch * 8), vr = *(const u32x4*)(rowp + 512 + h * 64 + ch * 8);
        *(LAS u32x4*)(Qs + j * 72 + ch * 8) = qr; *(LAS u32x4*)(Ks + j * 72 + ch * 8) = kr;
        const int o = (ch * 8) * 136 + j;
        VT[o + 0 * 136] = (bf16_t)(vr.x & 0xffffu); VT[o + 1 * 136] = (bf16_t)(vr.x >> 16); VT[o + 2 * 136] = (bf16_t)(vr.y & 0xffffu); VT[o + 3 * 136] = (bf16_t)(vr.y >> 16);
        VT[o + 4 * 136] = (bf16_t)(vr.z & 0xffffu); VT[o + 5 * 136] = (bf16_t)(vr.z >> 16); VT[o + 6 * 136] = (bf16_t)(vr.w & 0xffffu); VT[o + 7 * 136] = (bf16_t)(vr.w >> 16);
    }
    const size_t sbase = (size_t)((b * 32 + c) * 4 + h) * 4096;
#pragma unroll
    for (int i = 0; i < 8; ++i) { const int id = tid + NTHR * i, e = id >> 6, d = id & 63; SFt[e * 72 + d] = (bf16_t)f2bf(stf[sbase + id]); SBt[e * 72 + d] = (bf16_t)f2bf(stb[sbase + id]); }
    __syncthreads();
    const int lane = tid & 63, it = tid >> 6, fr = lane & 15, fq = lane >> 4;
    const int ipos = it * 16 + fr;
    const LAS bf16_t* qp = Qs + ipos * 72 + fq * 8;
    const bf16x8 qb0 = *(const LAS bf16x8*)qp, qb1 = *(const LAS bf16x8*)(qp + 32);
    f32x4 st[8];
#pragma unroll
    for (int jt = 0; jt < 8; ++jt) {
        const LAS bf16_t* kp = Ks + (jt * 16 + fr) * 72 + fq * 8;
        f32x4 acc = {0.f, 0.f, 0.f, 0.f};
        acc = mfma16(*(const LAS bf16x8*)kp, qb0, acc); acc = mfma16(*(const LAS bf16x8*)(kp + 32), qb1, acc);
#pragma unroll
        for (int jj = 0; jj < 4; ++jj) { const int dij = ipos - (jt * 16 + fq * 4 + jj); const float dec = dij >= 0 ? __expf(lgf * (float)dij) : __expf(lgb * (float)(-dij)); acc[jj] *= 0.125f * dec; }
        st[jt] = acc;
    }
    f32x4 o[4], ff[4], fb[4];
#pragma unroll
    for (int et = 0; et < 4; ++et) { o[et] = (f32x4){0.f, 0.f, 0.f, 0.f}; ff[et] = o[et]; fb[et] = o[et]; }
#pragma unroll
    for (int kk = 0; kk < 4; ++kk) {
        const bf16x8 pb = pack8(st[2 * kk], st[2 * kk + 1]);
#pragma unroll
        for (int et = 0; et < 4; ++et) { const LAS bf16_t* vp = VT + (et * 16 + fr) * 136 + kk * 32 + fq * 4; o[et] = mfma16(cat8(*(const LAS bf16x4*)vp, *(const LAS bf16x4*)(vp + 16)), pb, o[et]); }
    }
#pragma unroll
    for (int et = 0; et < 4; ++et) {
        const LAS bf16_t* fp = SFt + (et * 16 + fr) * 72 + fq * 8; const LAS bf16_t* bp = SBt + (et * 16 + fr) * 72 + fq * 8;
        ff[et] = mfma16(*(const LAS bf16x8*)fp, qb0, ff[et]); ff[et] = mfma16(*(const LAS bf16x8*)(fp + 32), qb1, ff[et]);
        fb[et] = mfma16(*(const LAS bf16x8*)bp, qb0, fb[et]); fb[et] = mfma16(*(const LAS bf16x8*)(bp + 32), qb1, fb[et]);
    }
    const float cf = __expf(lgf * (float)(ipos + 1)), cb = __expf(lgb * (float)(128 - ipos));
    float s = 0.f;
#pragma unroll
    for (int et = 0; et < 4; ++et) { o[et] = o[et] + ff[et] * cf + fb[et] * cb; s += (o[et][0] + o[et][1]) + (o[et][2] + o[et][3]); }
    s += __shfl_xor(s, 16); s += __shfl_xor(s, 32);
    const float mean = s * (1.f / 64.f); float s2 = 0.f;
#pragma unroll
    for (int et = 0; et < 4; ++et) { o[et] = o[et] - mean; s2 += (o[et][0] * o[et][0] + o[et][1] * o[et][1]) + (o[et][2] * o[et][2] + o[et][3] * o[et][3]); }
    s2 += __shfl_xor(s2, 16); s2 += __shfl_xor(s2, 32);
    const float rstd = 1.f / sqrtf(s2 * (1.f / 64.f) + LN_EPS);
    const size_t tok = (size_t)b * SEQ + c * 128 + ipos;
    const bf16_t* gp = proj + tok * DIN + 768 + h * 64 + fq * 4;
    bf16_t* op = mix + tok * DM + h * 64 + fq * 4;
#pragma unroll
    for (int et = 0; et < 4; ++et) {
        const u32x2 gr = *(const u32x2*)(gp + et * 16);
        const float g0 = bflo(gr.x), g1 = bfhi(gr.x), g2 = bflo(gr.y), g3 = bfhi(gr.y);
        const float y0 = o[et][0] * rstd * (g0 / (1.f + __expf(-g0))), y1 = o[et][1] * rstd * (g1 / (1.f + __expf(-g1)));
        const float y2 = o[et][2] * rstd * (g2 / (1.f + __expf(-g2))), y3 = o[et][3] * rstd * (g3 / (1.f + __expf(-g3)));
        u32x2 wv; wv.x = pk2(y0, y1); wv.y = pk2(y2, y3); *(u32x2*)(op + et * 16) = wv;
    }
    __syncthreads();
}

__device__ __forceinline__ void s5_load_u(const bf16_t* __restrict__ proj, int b, int ch, LAS bf16_t* U, int tid) {
#pragma unroll
    for (int i = 0; i < 2; ++i) { const int id = tid + NTHR * i, s = id >> 5, c8 = id & 31;
        *(LAS u32x4*)(U + s * 256 + c8 * 8) = *(const u32x4*)(proj + (size_t)(b * SEQ + ch * S5T + s) * DIN + 1024 + c8 * 8); }
}
#define S5_BU(BR, BI, UP) do { const u32x4 _u0 = *(const LAS u32x4*)(UP), _u1 = *(const LAS u32x4*)((UP) + 8); \
    float _u[16] = {bflo(_u0.x), bfhi(_u0.x), bflo(_u0.y), bfhi(_u0.y), bflo(_u0.z), bfhi(_u0.z), bflo(_u0.w), bfhi(_u0.w), bflo(_u1.x), bfhi(_u1.x), bflo(_u1.y), bfhi(_u1.y), bflo(_u1.z), bfhi(_u1.z), bflo(_u1.w), bfhi(_u1.w)}; \
    BR = 0.f; BI = 0.f; _Pragma("unroll") for (int _c = 0; _c < 16; ++_c) { BR = fmaf(bbr[_c], _u[_c], BR); BI = fmaf(bbi[_c], _u[_c], BI); } } while (0)
#define S5_LOAD_BBAR() \
    const float* tabp = tab + (size_t)((r * 16 + g) * 64 + p) * 8; \
    const f32x4 t0 = *(const f32x4*)tabp; const float lr_ = t0[0], li_ = t0[1], cr_ = t0[2], ci_ = t0[3]; \
    float bbr[16], bbi[16]; \
    { const float* brp = bre + (size_t)(g * 64 + p) * 16; const float* bip = bim + (size_t)(g * 64 + p) * 16; \
      _Pragma("unroll") for (int q4 = 0; q4 < 4; ++q4) { const f32x4 x = *(const f32x4*)(brp + 4 * q4), y = *(const f32x4*)(bip + 4 * q4); \
        _Pragma("unroll") for (int k = 0; k < 4; ++k) { bbr[4 * q4 + k] = cr_ * x[k] - ci_ * y[k]; bbi[4 * q4 + k] = cr_ * y[k] + ci_ * x[k]; } } }

__device__ __forceinline__ void s5e_item(int item, const bf16_t* __restrict__ proj, const float* __restrict__ tab  , const float* __restrict__ bre, const float* __restrict__ bim,
                                         float* __restrict__ E, LAS unsigned char* lds, int tid) {
    const int ch = item & (S5NCH - 1), b = item / S5NCH;
    LAS bf16_t* U = (LAS bf16_t*)lds;
    s5_load_u(proj, b, ch, U, tid);
    __syncthreads();
    const int gl = tid >> 7, r = (tid >> 6) & 1, p = tid & 63;
    for (int qd = 0; qd < 4; ++qd) {
        const int g = qd * 4 + gl;
        S5_LOAD_BBAR();
        float xr = 0.f, xi = 0.f;
        for (int s = 0; s < S5T; ++s) {
            const int si = r ? (S5T - 1 - s) : s;
            float br, bi; S5_BU(br, bi, U + si * 256 + g * 16);
            const float nr = fmaf(lr_, xr, fmaf(-li_, xi, br)), ni = fmaf(lr_, xi, fmaf(li_, xr, bi));
            xr = nr; xi = ni;
        }
        float2 ev; ev.x = xr; ev.y = xi;
        ((float2*)E)[(size_t)(((b * S5NCH + ch) * 16 + g) * 2 + r) * 64 + p] = ev;
    }
    __syncthreads();
}
__device__ __forceinline__ void s5out_item(int item, const bf16_t* __restrict__ proj, const float* __restrict__ tab, const float* __restrict__ bre, const float* __restrict__ bim,
                                           const float* __restrict__ cre  , const float* __restrict__ cim, const float* __restrict__ dvec, const bf16_t* __restrict__ wgluT, const float* __restrict__ bglu,
                                           const float* __restrict__ CIN, bf16_t* __restrict__ mix, LAS unsigned char* lds, int tid) {
    const int ch = item & (S5NCH - 1), b = item / S5NCH;
    constexpr int XS = 1032, CS = 264, YS = 264;
    LAS bf16_t* U = (LAS bf16_t*)lds;
    LAS bf16_t* X = (LAS bf16_t*)(lds + 16384);
    LAS bf16_t* Ct = (LAS bf16_t*)(lds + 16384 + 66048);
    LAS bf16_t* Y = (LAS bf16_t*)(lds + 16384 + 66048 + 33792);
    s5_load_u(proj, b, ch, U, tid);
    const int gl = tid >> 7, r = (tid >> 6) & 1, p = tid & 63;
    const int lane = tid & 63, w = tid >> 6, fr = lane & 15, fq = lane >> 4;
    for (int qd = 0; qd < 4; ++qd) {
        __syncthreads();
#pragma unroll
        for (int i = 0; i < 16; ++i) { const int id = tid + NTHR * i, pp = id & 63, cc = (id >> 6) & 15, gg = (id >> 10) & 3, rr = id >> 12;
            const size_t ci = (size_t)((rr * 16 + qd * 4 + gg) * 16 + cc) * 64 + pp;
            *(LAS unsigned*)(Ct + (gg * 16 + cc) * CS + rr * 128 + pp * 2) = pk2(cre[ci], -cim[ci]); }
        const int g = qd * 4 + gl;
        {
            S5_LOAD_BBAR();
            const float2 cin = ((const float2*)CIN)[(size_t)(((b * S5NCH + ch) * 16 + g) * 2 + r) * 64 + p];
            float xr = cin.x, xi = cin.y;
            for (int s = 0; s < S5T; ++s) {
                const int si = r ? (S5T - 1 - s) : s;
                float br, bi; S5_BU(br, bi, U + si * 256 + g * 16);
                const float nr = fmaf(lr_, xr, fmaf(-li_, xi, br)), ni = fmaf(lr_, xi, fmaf(li_, xr, bi));
                xr = nr; xi = ni;
                *(LAS unsigned*)(X + si * XS + gl * 256 + r * 128 + p * 2) = pk2(xr, xi);
            }
        }
        __syncthreads();
        {
            const int wg = w >> 1, mt = w & 1, gq = qd * 4 + wg;
            const LAS bf16_t* ap = X + (mt * 16 + fr) * XS + wg * 256 + fq * 8;
            const LAS bf16_t* bp = Ct + (wg * 16 + fr) * CS + fq * 8;
            f32x4 acc = {0.f, 0.f, 0.f, 0.f};
#pragma unroll
            for (int ks = 0; ks < 8; ++ks) acc = mfma16(*(const LAS bf16x8*)(ap + ks * 32), *(const LAS bf16x8*)(bp + ks * 32), acc);
            const int chn = gq * 16 + fr; const float dv = dvec[chn];
#pragma unroll
            for (int jj = 0; jj < 4; ++jj) { const int s = mt * 16 + fq * 4 + jj;
                const float uu = __uint_as_float(((unsigned)U[s * 256 + chn]) << 16);
                const float yv = acc[jj] + dv * uu;
                const float t = 0.7978845608028654f * (yv + 0.044715f * yv * yv * yv);
                const float gel = yv * (1.f - 1.f / (1.f + __expf(2.f * t)));
                Y[s * YS + chn] = (bf16_t)f2bf(gel); }
        }
    }
    __syncthreads();
    {
        const int mt = w & 1;
        bf16x8 af[8];
#pragma unroll
        for (int ks = 0; ks < 8; ++ks) af[ks] = *(const LAS bf16x8*)(Y + (mt * 16 + fr) * YS + ks * 32 + fq * 8);
#pragma unroll
        for (int i = 0; i < 4; ++i) {
            const int nt = (w >> 1) * 4 + i, n = nt * 16 + fr;
            const bf16_t* bp = wgluT + (size_t)n * 256 + fq * 8;
            f32x4 acc = {0.f, 0.f, 0.f, 0.f};
#pragma unroll
            for (int ks = 0; ks < 8; ++ks) acc = mfma16(af[ks], *(const bf16x8*)(bp + ks * 32), acc);
            const float bg = bglu[n];
#pragma unroll
            for (int jj = 0; jj < 4; ++jj) { const int s = mt * 16 + fq * 4 + jj;
                const float yv = __uint_as_float(((unsigned)Y[s * YS + n]) << 16);
                const float outv = yv / (1.f + __expf(-(acc[jj] + bg)));
                mix[(size_t)(b * SEQ + ch * S5T + s) * DM + 256 + n] = (bf16_t)f2bf(outv); }
        }
    }
    __syncthreads();
}

__device__ __forceinline__ void phase_scan(const Args& a, int l, int tid) {
    unsigned char* ws = a.ws;
    const int lane = tid & 63, wave = tid >> 6;
    {
        const float* tab = (const float*)(ws + WS_S5TAB) + (size_t)l * 2048 * 8;
        const float2* __restrict__ E = (const float2*)(ws + WS_S5E); float2* __restrict__ C = (float2*)(ws + WS_S5C);
        for (int wv = blockIdx.x; wv < 128; wv += gridDim.x) if (wave == 0) {
            const int p = lane, r = wv & 1, g = (wv >> 1) & 15, b = wv >> 5;
            const float* tp = tab + (size_t)((r * 16 + g) * 64 + p) * 8;
            const float tr = tp[4], ti = tp[5];
            float xr = 0.f, xi = 0.f;
            for (int k0 = 0; k0 < S5NCH; k0 += 32) {
                float2 e[32];
#pragma unroll
                for (int k = 0; k < 32; ++k) { const int ch = r ? (S5NCH - 1 - (k0 + k)) : (k0 + k); e[k] = E[(size_t)(((b * S5NCH + ch) * 16 + g) * 2 + r) * 64 + p]; }
#pragma unroll
                for (int k = 0; k < 32; ++k) { const int ch = r ? (S5NCH - 1 - (k0 + k)) : (k0 + k);
                    float2 cv; cv.x = xr; cv.y = xi; C[(size_t)(((b * S5NCH + ch) * 16 + g) * 2 + r) * 64 + p] = cv;
                    const float nr = fmaf(tr, xr, fmaf(-ti, xi, e[k].x)), ni = fmaf(tr, xi, fmaf(ti, xr, e[k].y));
                    xr = nr; xi = ni; }
            }
        }
    }
    {
        const float* theta = a.in[4] + l * 8;
        const float* __restrict__ kvf = (const float*)(ws + WS_KVF); const float* __restrict__ kvb = (const float*)(ws + WS_KVB);
        float* __restrict__ stf = (float*)(ws + WS_STF); float* __restrict__ stb = (float*)(ws + WS_STB);
        for (int gid = blockIdx.x * NTHR + tid; gid < 131072; gid += gridDim.x * NTHR) {
            const int el = gid & 4095, dir = (gid >> 12) & 1, h = (gid >> 13) & 3, b = gid >> 15;
            const float dec = __expf(log_sigmoid(theta[dir * 4 + h]) * 128.f);
            const float* __restrict__ kv = dir ? kvb : kvf; float* __restrict__ st = dir ? stb : stf;
            float s = 0.f;
            for (int c0 = 0; c0 < 32; c0 += 16) {
                float kk[16];
#pragma unroll
                for (int k = 0; k < 16; ++k) { const int c = dir ? (31 - (c0 + k)) : (c0 + k); kk[k] = kv[(size_t)((b * 32 + c) * 4 + h) * 4096 + el]; }
#pragma unroll
                for (int k = 0; k < 16; ++k) { const int c = dir ? (31 - (c0 + k)) : (c0 + k); st[(size_t)((b * 32 + c) * 4 + h) * 4096 + el] = s; s = fmaf(dec, s, kk[k]); }
            }
        }
    }
}

__device__ __forceinline__ void phase_ln1_router(const Args& a, int l, LAS unsigned char* lds, int tid) {
    unsigned char* ws = a.ws;
    const int lane = tid & 63, wave = tid >> 6;
    LAS float* rwT = (LAS float*)lds;
    const float* rw = a.in[19] + (size_t)l * DM * NE;
    for (int i = tid; i < DM * NE; i += NTHR) rwT[(i & 15) * DM + (i >> 4)] = rw[i];
    __syncthreads();
    const float* pre = (const float*)(ws + WS_RA);
    float* afft = (float*)(ws + WS_AFFT);
    const int gw = blockIdx.x * NWAVES + wave, NGW = gridDim.x * NWAVES;
    for (int m = gw; m < MTOK; m += NGW) {
        f32x4 v[4];
#pragma unroll
        for (int j = 0; j < 4; ++j) v[j] = ((const f32x4*)(pre + (size_t)m * DM))[lane + 64 * j];
        ln_rows4(v, a.in[17] + l * DM, a.in[18] + l * DM, lane);
        store_row(v, (float*)(ws + WS_H32) + (size_t)m * DM, (bf16_t*)(ws + WS_HBF) + (size_t)m * DM, lane);
        float mine = 0.f;
#pragma unroll 2
        for (int e = 0; e < 16; ++e) {
            float s = 0.f;
#pragma unroll
            for (int j = 0; j < 4; ++j) { const f32x4 wv = *(const LAS f32x4*)(rwT + e * DM + 256 * j + 4 * lane); s += (v[j][0] * wv[0] + v[j][1] * wv[1]) + (v[j][2] * wv[2] + v[j][3] * wv[3]); }
            s = wave_sum(s);
            mine = ((lane & 15) == e) ? s : mine;
        }
        float mx = mine;
#pragma unroll
        for (int o = 1; o < 16; o <<= 1) mx = fmaxf(mx, __shfl_xor(mx, o));
        mine = expf(mine - mx);
        float sum = mine;
#pragma unroll
        for (int o = 1; o < 16; o <<= 1) sum += __shfl_xor(sum, o);
        const float inv = 1.f / sum;
        const int b = m / SEQ, t = m % SEQ;
        if (lane < 16) afft[(size_t)(b * NE + lane) * SEQ + t] = mine * inv;
    }
    __syncthreads();
}

__device__ __forceinline__ void select_item(int item, const Args& a, LAS unsigned char* lds, int tid) {
    unsigned char* ws = a.ws;
    const int q = item & 3, e = (item >> 2) & 15, b = item >> 6;
    const int lane = tid & 63, wave = tid >> 6;
    LAS unsigned* red = (LAS unsigned*)lds;
    LAS int* sel = (LAS int*)(lds + 1024);
    const float* av = (const float*)(ws + WS_AFFT) + (size_t)(b * NE + e) * SEQ + tid * 8;
    const f32x4 va = *(const f32x4*)av, vb = *(const f32x4*)(av + 4);
    unsigned v[8] = {__float_as_uint(va[0]), __float_as_uint(va[1]), __float_as_uint(va[2]), __float_as_uint(va[3]), __float_as_uint(vb[0]), __float_as_uint(vb[1]), __float_as_uint(vb[2]), __float_as_uint(vb[3])};
    unsigned x = 0u;
    for (int bit = 30; bit >= 0; --bit) {
        const unsigned cand = x | (1u << bit);
        unsigned cnt = 0u;
#pragma unroll
        for (int j = 0; j < 8; ++j) cnt += (unsigned)__popcll(__ballot(v[j] >= cand));
        LAS unsigned* rb = red + (bit & 1) * 8;
        if (lane == 0) rb[wave] = cnt;
        __syncthreads();
        unsigned tot = 0u;
#pragma unroll
        for (int k = 0; k < 8; ++k) tot += rb[k];
        if (tot >= (unsigned)CAP) x = cand;
    }
    unsigned mycnt = 0u;
#pragma unroll
    for (int j = 0; j < 8; ++j) mycnt += (v[j] > x ? 1u : 0u) + (v[j] == x ? 0x10000u : 0u);
    unsigned inc = mycnt;
#pragma unroll
    for (int o = 1; o < 64; o <<= 1) { const unsigned t = __shfl_up(inc, o); if (lane >= o) inc += t; }
    LAS unsigned* wsum = red + 64;
    __syncthreads();
    if (lane == 63) wsum[wave] = inc;
    __syncthreads();
    unsigned wpre = 0u, total = 0u;
#pragma unroll
    for (int k = 0; k < 8; ++k) { const unsigned t = wsum[k]; if (k < wave) wpre += t; total += t; }
    const unsigned excl = wpre + inc - mycnt;
    unsigned gtb = excl & 0xffffu, eqb = excl >> 16;
    const unsigned need = (unsigned)CAP - (total & 0xffffu);
    const int rowbase = (e * NB + b) * CAP;
    int* idx = (int*)(ws + WS_IDX); float* gate = (float*)(ws + WS_GATE); int* slotmap = (int*)(ws + WS_SLOT);
    const bool own_tok = ((tid >> 7) == q);
#pragma unroll
    for (int j = 0; j < 8; ++j) {
        const bool isgt = v[j] > x, iseq = v[j] == x;
        const bool issel = isgt || (iseq && eqb < need);
        const unsigned slot = gtb + (eqb < need ? eqb : need);
        const int tok = b * SEQ + tid * 8 + j;
        if (issel && (int)(slot >> 7) == q) { idx[rowbase + slot] = tok; gate[rowbase + slot] = __uint_as_float(v[j]); sel[slot & 127] = tok; }
        if (own_tok) slotmap[(size_t)tok * NE + e] = issel ? (int)(rowbase + slot) : -1;
        gtb += isgt ? 1u : 0u; eqb += iseq ? 1u : 0u;
    }
    __syncthreads();
    const bf16_t* hbf = (const bf16_t*)(ws + WS_HBF); bf16_t* xs = (bf16_t*)(ws + WS_RA);
    for (int s = wave; s < 128; s += NWAVES) {
        const int tok = sel[s];
        const u32x4* src = (const u32x4*)(hbf + (size_t)tok * DM); u32x4* dst = (u32x4*)(xs + (size_t)(rowbase + q * 128 + s) * DM);
        const u32x4 d0 = src[lane], d1 = src[lane + 64];
        dst[lane] = d0; dst[lane + 64] = d1;
    }
    __syncthreads();
}

__device__ __forceinline__ void phase_ln2(const Args& a, int l, int tid) {
    unsigned char* ws = a.ws;
    const int lane = tid & 63, wave = tid >> 6;
    const int gw = blockIdx.x * NWAVES + wave, NGW = gridDim.x * NWAVES;
    const float* h32 = (const float*)(ws + WS_H32); const int* slotmap = (const int*)(ws + WS_SLOT); const bf16_t* contrib = (const bf16_t*)(ws + WS_RB);
    const bool last = (l == 1);
    for (int m = gw; m < MTOK; m += NGW) {
        f32x4 v[4];
#pragma unroll
        for (int j = 0; j < 4; ++j) v[j] = ((const f32x4*)(h32 + (size_t)m * DM))[lane + 64 * j] * ALPHA;
        const int myslot = slotmap[(size_t)m * NE + (lane & 15)];
#pragma unroll
        for (int e = 0; e < 16; ++e) {
            const int row = __builtin_amdgcn_readlane(myslot, e);
            if (row >= 0) {
                const u32x2* cr = (const u32x2*)(contrib + (size_t)row * DM);
#pragma unroll
                for (int j = 0; j < 4; ++j) { const u32x2 wv = cr[lane + 64 * j]; v[j][0] += bflo(wv.x); v[j][1] += bfhi(wv.x); v[j][2] += bflo(wv.y); v[j][3] += bfhi(wv.y); }
            }
        }
        ln_rows4(v, a.in[23] + l * DM, a.in[24] + l * DM, lane);
        if (last) store_row(v, a.out + (size_t)m * DM, nullptr, lane);
        else store_row(v, (float*)(ws + WS_H32) + (size_t)m * DM, (bf16_t*)(ws + WS_HBF) + (size_t)m * DM, lane);
    }
}

typedef __attribute__((address_space(1))) unsigned gu32;
#define RLX_AGENT __ATOMIC_RELAXED, __HIP_MEMORY_SCOPE_AGENT
#define XB_TMO      128
#define XB_XCNT(j)  (256  + 64 * (j))
#define XB_XSUB(j)  (1280 + 64 * (j))
#define XB_XGEN(j)  (2304 + 64 * (j))
#define XB_TOP      3328
#define XB_TOPGEN   3392
#define XCD_BAR_WORDS 3456
#define XB_SPIN_CAP (1u << 18)

__device__ __forceinline__ unsigned xb_ld(unsigned* p)              { return __hip_atomic_load(p, __ATOMIC_RELAXED, __HIP_MEMORY_SCOPE_AGENT); }
__device__ __forceinline__ unsigned xb_add(unsigned* p, unsigned v) { return __hip_atomic_fetch_add(p, v, __ATOMIC_RELAXED, __HIP_MEMORY_SCOPE_AGENT); }
__device__ __forceinline__ unsigned xb_xcc_id() { return (unsigned)__builtin_amdgcn_s_getreg((3 << 11) | 20) & 0xFu; }
#define XB_SPIN(cond, bar) do { unsigned _sp = 0; while (cond) { __builtin_amdgcn_s_sleep(1); \
    if ((++_sp & 255u) == 0u) { if (xb_ld(&(bar)[XB_TMO])) break; if (_sp > XB_SPIN_CAP) { atomicAdd(&(bar)[XB_TMO], 1u); break; } } } } while (0)

struct XcdBarrier {
    unsigned* bar; unsigned x;
    volatile LAS unsigned* st;
};

__device__ __forceinline__ XcdBarrier xcd_barrier_post(unsigned* bar, volatile LAS unsigned* st) {
    XcdBarrier b; b.bar = bar; b.x = xb_xcc_id(); b.st = st;
    if (threadIdx.x == 0) (void)xb_add(&bar[XB_XCNT(b.x)], 1u);
    return b;
}
__device__ __forceinline__ void xcd_barrier_complete(unsigned* bar, unsigned x, unsigned& nloc, unsigned& nx) {
    const unsigned G = gridDim.x * gridDim.y * gridDim.z;
    unsigned sum, cnt, mine, sp = 0u;
    for (;;) {
        sum = 0u; cnt = 0u; mine = 0u;
#pragma unroll
        for (unsigned j = 0; j < 16; ++j) { const unsigned c = xb_ld(&bar[XB_XCNT(j)]); sum += c; cnt += (c > 0u) ? 1u : 0u; mine = (j == x) ? c : mine; }
        if (sum == G) break;
        __builtin_amdgcn_s_sleep(1);
        if ((++sp & 255u) == 0u) { if (xb_ld(&bar[XB_TMO])) break; if (sp > XB_SPIN_CAP) { atomicAdd(&bar[XB_TMO], 1u); break; } }
    }
    nloc = mine > 0u ? mine : 1u; nx = cnt > 0u ? cnt : 1u;
}

__device__ __forceinline__ void xcd_barrier(const XcdBarrier& b) {
    asm volatile("s_waitcnt vmcnt(0)" ::: "memory");
    __syncthreads();
    if (threadIdx.x == 0) {
        unsigned* bar = b.bar;
        __builtin_amdgcn_s_waitcnt(0);
        unsigned nloc = b.st[0], nx = b.st[1];
        if (nloc == 0u) { xcd_barrier_complete(bar, b.x, nloc, nx); b.st[0] = nloc; b.st[1] = nx; }
        const unsigned old = xb_add(&bar[XB_XSUB(b.x)], 1u);
        const unsigned gen = old / nloc;
        if (old + 1u == (gen + 1u) * nloc) {
            __builtin_amdgcn_fence(__ATOMIC_RELEASE, "agent");
            asm volatile("s_waitcnt vmcnt(0)" ::: "memory");
            const unsigned og = xb_add(&bar[XB_TOP], 1u);
            const unsigned tg = og / nx;
            if (og + 1u == (tg + 1u) * nx) xb_add(&bar[XB_TOPGEN], 1u);
            else XB_SPIN(xb_ld(&bar[XB_TOPGEN]) == tg, bar);
            __builtin_amdgcn_fence(__ATOMIC_ACQUIRE, "agent");
            xb_add(&bar[XB_XGEN(b.x)], 1u);
            asm volatile("s_waitcnt vmcnt(0)" ::: "memory");
        } else {
            XB_SPIN(xb_ld(&bar[XB_XGEN(b.x)]) == gen, bar);
            __builtin_amdgcn_fence(__ATOMIC_ACQUIRE, "agent");
            asm volatile("s_waitcnt vmcnt(0)" ::: "memory");
        }
    }
    __syncthreads();
}

constexpr int NPHASES = 21;
#ifndef REP_MASK
#define REP_MASK 0
#endif
template <int L, int K>
__device__ __forceinline__ void run_phase(const Args& a, LAS unsigned char* lds, int tid) {
    unsigned char* ws = a.ws;
    constexpr int l = L;
    bf16_t* proj = (bf16_t*)(ws + WS_RA); bf16_t* mix = (bf16_t*)(ws + WS_RB);
    if constexpr (K == 0) {
        pg8::Gemm g{(const bf16_t*)(ws + WS_HBF), (const bf16_t*)(ws + WS_WIN) + (size_t)l * DIN * DM, MTOK, DIN, DM};
        pg8::StaticOrder S; S.init(MTOK, DIN, (int)gridDim.x, (int)blockIdx.x);
        pg8::EpiStoreBf16 E{proj, DIN};
        pg8::gemm_phase<pg8::EpiStoreBf16, pg8::StaticOrder, true, true>(lds, g, S, E);
    } else if constexpr (K == 1) {
        const float* tab = (const float*)(ws + WS_S5TAB) + (size_t)l * 2048 * 8;
        for (int it = blockIdx.x; it < 1280; it += gridDim.x) {
            if (it < 512) s5e_item(it, proj, tab, a.in[8] + (size_t)l * 16384, a.in[9] + (size_t)l * 16384, (float*)(ws + WS_S5E), lds, tid);
            else if (it < 768) attn_item(it - 512, proj, mix, a.in[15] + l * 8, lds, tid);
            else retkv_item(it - 768, proj, (float*)(ws + WS_KVF), (float*)(ws + WS_KVB), a.in[4] + l * 8, lds, tid);
        }
    } else if constexpr (K == 2) {
        phase_scan(a, l, tid);
    } else if constexpr (K == 3) {
        const float* tab = (const float*)(ws + WS_S5TAB) + (size_t)l * 2048 * 8;
        for (int it = blockIdx.x; it < 1024; it += gridDim.x) {
            if (it < 512) s5out_item(it, proj, tab, a.in[8] + (size_t)l * 16384, a.in[9] + (size_t)l * 16384, a.in[10] + (size_t)l * 32768, a.in[11] + (size_t)l * 32768, a.in[12] + l * 256,
                                     (const bf16_t*)(ws + WS_WGLU) + (size_t)l * 65536, a.in[14] + l * 256, (const float*)(ws + WS_S5C), mix, lds, tid);
            else retout_item(it - 512, proj, (const float*)(ws + WS_STF), (const float*)(ws + WS_STB), mix, a.in[4] + l * 8, lds, tid);
        }
    } else if constexpr (K == 4) {
        pg8::Gemm g{mix, (const bf16_t*)(ws + WS_WOUT) + (size_t)l * DM * DM, MTOK, DM, DM};
        pg8::StaticOrder S; S.init(MTOK, DM, (int)gridDim.x, (int)blockIdx.x);
        pg8::EpiResF32 E{(const float*)(ws + WS_H32), (float*)(ws + WS_RA), DM, ALPHA};
        pg8::gemm_phase<pg8::EpiResF32, pg8::StaticOrder, true, true>(lds, g, S, E);
    } else if constexpr (K == 5) {
        phase_ln1_router(a, l, lds, tid);
    } else if constexpr (K == 6) {
        for (int it = blockIdx.x; it < 256; it += gridDim.x) select_item(it, a, lds, tid);
    } else if constexpr (K == 7) {
        pg8::Gemm g{(const bf16_t*)(ws + WS_RA), (const bf16_t*)(ws + WS_WGU) + (size_t)l * NE * 2 * FF * DM, NROWX, NE * 2 * FF, DM};
        pg8::GroupedOrder S; S.init(16, (int)gridDim.x, (int)blockIdx.x);
        pg8::EpiSwiGLU E{(bf16_t*)(ws + WS_HDN), FF, 16};
        pg8::gemm_phase<pg8::EpiSwiGLU, pg8::GroupedOrder, true, true>(lds, g, S, E);
    } else if constexpr (K == 8) {
        pg8::Gemm g{(const bf16_t*)(ws + WS_HDN), (const bf16_t*)(ws + WS_WD) + (size_t)l * NE * DM * FF, NROWX, NE * DM, FF};
        pg8::GroupedOrder S; S.init(4, (int)gridDim.x, (int)blockIdx.x);
        pg8::EpiScaleRow E{(bf16_t*)(ws + WS_RB), DM, 4, (const float*)(ws + WS_GATE)};
        pg8::gemm_phase<pg8::EpiScaleRow, pg8::GroupedOrder, true, true>(lds, g, S, E);
    } else {
        phase_ln2(a, l, tid);
    }
}
__global__ void __launch_bounds__(NTHR, 2) fwd_kernel(Args a) {
    extern __shared__ __attribute__((aligned(16))) unsigned char lds_raw[];
    LAS unsigned char* lds = (LAS unsigned char*)lds_raw;
    cg::grid_group grid = cg::this_grid();
    const int lo = a.ph_lo, hi = a.ph_hi;
    volatile LAS unsigned* bst = (volatile LAS unsigned*)(lds + LDS_BYTES - 64);
    if (threadIdx.x < 16) bst[threadIdx.x] = 0u;
    __syncthreads();
    XcdBarrier bar = xcd_barrier_post((unsigned*)(a.ws + WS_BAR), bst);
    if (hi > 1000) grid.sync();
#define PH_BEGIN(ph) if (lo <= (ph) && (ph) < hi) { int tid = threadIdx.x; asm volatile("" : "+v"(tid));
#define PH_END(ph) if ((ph) + 1 < hi) xcd_barrier(bar); }
    PH_BEGIN(0) for (int rep = 0; rep <= ((REP_MASK >> 10) & 1); ++rep) phase_p0(a, lds, tid); PH_END(0)
#define LAYER(L) \
    PH_BEGIN(1 + 10 * L + 0) for (int rep = 0; rep <= ((REP_MASK >> 0) & 1); ++rep) run_phase<L, 0>(a, lds, tid); PH_END(1 + 10 * L + 0) \
    PH_BEGIN(1 + 10 * L + 1) for (int rep = 0; rep <= ((REP_MASK >> 1) & 1); ++rep) run_phase<L, 1>(a, lds, tid); PH_END(1 + 10 * L + 1) \
    PH_BEGIN(1 + 10 * L + 2) for (int rep = 0; rep <= ((REP_MASK >> 2) & 1); ++rep) run_phase<L, 2>(a, lds, tid); PH_END(1 + 10 * L + 2) \
    PH_BEGIN(1 + 10 * L + 3) for (int rep = 0; rep <= ((REP_MASK >> 3) & 1); ++rep) run_phase<L, 3>(a, lds, tid); PH_END(1 + 10 * L + 3) \
    PH_BEGIN(1 + 10 * L + 4) for (int rep = 0; rep <= ((REP_MASK >> 4) & 1); ++rep) run_phase<L, 4>(a, lds, tid); PH_END(1 + 10 * L + 4) \
    PH_BEGIN(1 + 10 * L + 5) for (int rep = 0; rep <= ((REP_MASK >> 5) & 1); ++rep) run_phase<L, 5>(a, lds, tid); PH_END(1 + 10 * L + 5) \
    PH_BEGIN(1 + 10 * L + 6) for (int rep = 0; rep <= ((REP_MASK >> 6) & 1); ++rep) run_phase<L, 6>(a, lds, tid); PH_END(1 + 10 * L + 6) \
    PH_BEGIN(1 + 10 * L + 7) for (int rep = 0; rep <= ((REP_MASK >> 7) & 1); ++rep) run_phase<L, 7>(a, lds, tid); PH_END(1 + 10 * L + 7) \
    PH_BEGIN(1 + 10 * L + 8) for (int rep = 0; rep <= ((REP_MASK >> 8) & 1); ++rep) run_phase<L, 8>(a, lds, tid); PH_END(1 + 10 * L + 8) \
    PH_BEGIN(1 + 10 * L + 9) for (int rep = 0; rep <= ((REP_MASK >> 9) & 1); ++rep) run_phase<L, 9>(a, lds, tid); PH_END(1 + 10 * L + 9)
    LAYER(0)
    LAYER(1)
#undef LAYER
#undef PH_BEGIN
#undef PH_END
}

#ifndef ONE_LAUNCH
#define ONE_LAUNCH 1
#endif
extern "C" void kernel_launch(void* const* d_in, const int* in_sizes, int n_in, void* d_out, int out_size, void* d_ws, size_t ws_size, hipStream_t stream) {
    static int grid = 0;
    if (grid == 0) {
        if (n_in != 25 || ws_size < WS_END) { fprintf(stderr, "kernel_launch: unexpected problem (n_in %d, ws %zu)\n", n_in, ws_size); grid = -1; return; }
        int dev = 0, cus = 0, per_cu = 0;
        (void)hipGetDevice(&dev);
        (void)hipDeviceGetAttribute(&cus, hipDeviceAttributeMultiprocessorCount, dev);
        if (hipFuncSetAttribute((const void*)fwd_kernel, hipFuncAttributeMaxDynamicSharedMemorySize, LDS_BYTES) != hipSuccess) { fprintf(stderr, "kernel_launch: hipFuncSetAttribute failed\n"); grid = -1; return; }
        if (hipOccupancyMaxActiveBlocksPerMultiprocessor(&per_cu, (const void*)fwd_kernel, NTHR, LDS_BYTES) != hipSuccess || per_cu < 1) { fprintf(stderr, "kernel_launch: occupancy query says %d\n", per_cu); per_cu = 1; }
        (void)hipGetLastError();
        if (cus <= 0) cus = 256;
        grid = cus * per_cu;
    }
    if (grid < 0) return;
    Args a{};
    for (int i = 0; i < 25; ++i) a.in[i] = (const float*)d_in[i];
    a.out = (float*)d_out; a.ws = (unsigned char*)d_ws;
#if ONE_LAUNCH
    if (hipMemsetAsync((char*)d_ws + WS_BAR, 0, 16384, stream) != hipSuccess) { fprintf(stderr, "kernel_launch: memset failed\n"); return; }
    a.ph_lo = 0; a.ph_hi = NPHASES;
    void* args[] = {&a};
    hipError_t e = hipLaunchCooperativeKernel((const void*)fwd_kernel, dim3(grid), dim3(NTHR), args, LDS_BYTES, stream);
    if (e != hipSuccess) fprintf(stderr, "kernel_launch: cooperative launch failed: %s (grid %d)\n", hipGetErrorString(e), grid);
#else
    for (int ph = 0; ph < NPHASES; ++ph) {
        a.ph_lo = ph; a.ph_hi = ph + 1;
        hipLaunchKernelGGL(fwd_kernel, dim3(grid), dim3(NTHR), LDS_BYTES, stream, a);
    }
#endif
}
```

```cpp
#include <hip/hip_runtime.h>
#include <hip/hip_cooperative_groups.h>
#include <cstdio>
#include <cstdint>
namespace cg = cooperative_groups;
namespace pg8 {
#define PG8_LAS __attribute__((address_space(3)))
typedef unsigned short bf16_t;
typedef short bf16x8 __attribute__((ext_vector_type(8)));
typedef float f32x4 __attribute__((ext_vector_type(4)));
typedef unsigned u32x4 __attribute__((ext_vector_type(4)));
constexpr int BM = 256, BK = 64, HALF = 128, HTB = HALF * BK * 2  , STAGE_BYTES = 8 * HTB, NXCD = 8, WGM = 8;

__host__ __device__ __forceinline__ int lds_byte(int r, int c) { const int st = (r >> 4) * 2 + (c >> 5), rr = r & 15, cc = c & 31, ob = rr * 64 + cc * 2; return st * 1024 + (ob ^ (((ob >> 9) & 1) << 5)); }
__host__ __device__ __forceinline__ void stage_rc(int b, int& R, int& C) { const int st = b / 1024, sb = b % 1024, swz = sb ^ (((sb >> 9) & 1) << 5); R = (st >> 1) * 16 + swz / 64; C = (st & 1) * 32 + (swz % 64) / 2; }
__host__ __device__ __forceinline__ int perm32(int rho) { const int n = rho >> 4, i = rho & 15; return 8 * (i >> 2) + 4 * n + (i & 3); }

struct Unit { int pm, pn; };
struct Gemm { const bf16_t* A; const bf16_t* Bt; int M, N, K; };

struct StaticOrder {
    int nM, nN, nwg, G, c;
    __host__ __device__ void init(int M, int N, int G_, int c_) { nM = M / BM; nN = N / BM; nwg = nM * nN; G = G_; c = c_; }
    __host__ __device__ bool next(int i, Unit& u) const {
        const long L = (long)i * G + c; if (L >= nwg) return false;
        int wgid = (int)L; { const int q = nwg / NXCD, r = nwg % NXCD, xcd = wgid % NXCD, off = wgid / NXCD; wgid = (xcd < r ? xcd * (q + 1) : r * (q + 1) + (xcd - r) * q) + off; }
        const int nig = WGM * nN, gid = wgid / nig, fm = gid * WGM, gsz = (nM - fm) < WGM ? (nM - fm) : WGM;
        u.pm = fm + ((wgid % nig) % gsz); u.pn = (wgid % nig) / gsz; return true;
    }
    __device__ __forceinline__ void a_ready(const Unit&) const {}
    __device__ __forceinline__ void done(const Unit&) const {}
};

__device__ __forceinline__ unsigned cvt_pk_bf16(float lo, float hi) { unsigned r; asm volatile("v_cvt_pk_bf16_f32 %0, %1, %2" : "=v"(r) : "v"(lo), "v"(hi)); return r; }
typedef unsigned u32x2 __attribute__((ext_vector_type(2)));

struct GroupedOrder {
    int upe, nNe, nwg, G, c;
    __host__ __device__ void init(int nNe_, int G_, int c_) { nNe = nNe_; upe = 8 * nNe_; nwg = 16 * upe; G = G_; c = c_; }
    __host__ __device__ bool next(int i, Unit& u) const {
        const long L = (long)i * G + c; if (L >= nwg) return false;
        int wgid = (int)L; { const int q = nwg / NXCD, r = nwg % NXCD, xcd = wgid % NXCD, off = wgid / NXCD; wgid = (xcd < r ? xcd * (q + 1) : r * (q + 1) + (xcd - r) * q) + off; }
        const int e = wgid / upe, rr = wgid % upe;
        u.pm = e * 8 + (rr & 7); u.pn = e * nNe + (rr >> 3); return true;
    }
    __device__ __forceinline__ void a_ready(const Unit&) const {}
    __device__ __forceinline__ void done(const Unit&) const {}
};

struct EpiStoreBf16 {
    static constexpr bool PERM = true, AFTER_DRAIN = false;
    bf16_t* O; int ldc;
    __device__ __forceinline__ void operator()(const f32x4 (&acc)[2][2][4][2], const Unit& u, int wr, int wc, int fr, int fq) const {
        const int row0 = u.pm * BM + wr * 64 + fr, col0 = u.pn * BM + wc * 32 + 8 * fq;
#pragma unroll
        for (int ai = 0; ai < 2; ++ai)
#pragma unroll
            for (int m = 0; m < 4; ++m) { bf16_t* rowp = O + (size_t)(row0 + ai * HALF + m * 16) * ldc + col0;
#pragma unroll
                for (int bj = 0; bj < 2; ++bj) { const f32x4 v0 = acc[ai][bj][m][0], v1 = acc[ai][bj][m][1];
                    u32x4 w; w.x = cvt_pk_bf16(v0[0], v0[1]); w.y = cvt_pk_bf16(v0[2], v0[3]); w.z = cvt_pk_bf16(v1[0], v1[1]); w.w = cvt_pk_bf16(v1[2], v1[3]);
                    *(u32x4*)(rowp + bj * HALF) = w; } }
    }
};
struct EpiResF32 {
    static constexpr bool PERM = false, AFTER_DRAIN = false;
    const float* base; float* O; int ldc; float alpha;
    __device__ __forceinline__ void operator()(const f32x4 (&acc)[2][2][4][2], const Unit& u, int wr, int wc, int fr, int fq) const {
        const int row0 = u.pm * BM + wr * 64 + fr, col0 = u.pn * BM + wc * 32 + 4 * fq;
#pragma unroll
        for (int ai = 0; ai < 2; ++ai)
#pragma unroll
            for (int m = 0; m < 4; ++m) { const size_t ro = (size_t)(row0 + ai * HALF + m * 16) * ldc + col0;
#pragma unroll
                for (int bj = 0; bj < 2; ++bj)
#pragma unroll
                    for (int n = 0; n < 2; ++n) { const f32x4 b = *(const f32x4*)(base + ro + bj * HALF + 16 * n); *(f32x4*)(O + ro + bj * HALF + 16 * n) = b * alpha + acc[ai][bj][m][n]; } }
    }
};
struct EpiSwiGLU {
    static constexpr bool PERM = true, AFTER_DRAIN = false;
    bf16_t* O; int ldc; int ntn;
    __device__ __forceinline__ void operator()(const f32x4 (&acc)[2][2][4][2], const Unit& u, int wr, int wc, int fr, int fq) const {
        const int row0 = u.pm * BM + wr * 64 + fr, col0 = ((u.pn % ntn) * BM + wc * 32 + 8 * fq) >> 1;
#pragma unroll
        for (int ai = 0; ai < 2; ++ai)
#pragma unroll
            for (int m = 0; m < 4; ++m) { bf16_t* rowp = O + (size_t)(row0 + ai * HALF + m * 16) * ldc + col0;
#pragma unroll
                for (int bj = 0; bj < 2; ++bj) { const f32x4 v0 = acc[ai][bj][m][0], v1 = acc[ai][bj][m][1];
                    const float h0 = v0[0] / (1.f + __expf(-v0[0])) * v0[1], h1 = v0[2] / (1.f + __expf(-v0[2])) * v0[3];
                    const float h2 = v1[0] / (1.f + __expf(-v1[0])) * v1[1], h3 = v1[2] / (1.f + __expf(-v1[2])) * v1[3];
                    u32x2 w; w.x = cvt_pk_bf16(h0, h1); w.y = cvt_pk_bf16(h2, h3);
                    *(u32x2*)(rowp + bj * (HALF / 2)) = w; } }
    }
};
struct EpiScaleRow {
    static constexpr bool PERM = true, AFTER_DRAIN = false;
    bf16_t* O; int ldc; int ntn; const float* gate;
    __device__ __forceinline__ void operator()(const f32x4 (&acc)[2][2][4][2], const Unit& u, int wr, int wc, int fr, int fq) const {
        const int row0 = u.pm * BM + wr * 64 + fr, col0 = (u.pn % ntn) * BM + wc * 32 + 8 * fq;
#pragma unroll
        for (int ai = 0; ai < 2; ++ai)
#pragma unroll
            for (int m = 0; m < 4; ++m) { const int row = row0 + ai * HALF + m * 16; const float gsc = gate[row]; bf16_t* rowp = O + (size_t)row * ldc + col0;
#pragma unroll
                for (int bj = 0; bj < 2; ++bj) { const f32x4 v0 = acc[ai][bj][m][0] * gsc, v1 = acc[ai][bj][m][1] * gsc;
                    u32x4 w; w.x = cvt_pk_bf16(v0[0], v0[1]); w.y = cvt_pk_bf16(v0[2], v0[3]); w.z = cvt_pk_bf16(v1[0], v1[1]); w.w = cvt_pk_bf16(v1[2], v1[3]);
                    *(u32x4*)(rowp + bj * HALF) = w; } }
    }
};

template <class Epi, class Sched, bool ALIGN_EPI = false, bool SP2 = false>
__device__ __forceinline__ void gemm_phase(PG8_LAS unsigned char* lds, const Gemm g, const Sched& S, const Epi& E) {
    int tid_ = threadIdx.x; asm volatile("" : "+v"(tid_)); const int tid = tid_, wid = __builtin_amdgcn_readfirstlane(tid >> 6), lane = tid & 63, wr = wid >> 2, wc = wid & 3, fr = lane & 15, fq = lane >> 4;
    const int K = g.K, nt = K / BK;
    unsigned voffA[2], voffB[2];
#pragma unroll
    for (int i = 0; i < 2; ++i) { int R, C; stage_rc(tid * 16 + i * 8192, R, C); const int Rb = Epi::PERM ? ((R & ~31) + perm32(R & 31)) : R;
        voffA[i] = (unsigned)(R * K + C) * 2u; voffB[i] = (unsigned)(Rb * K + C) * 2u; }
    const size_t kstep = (size_t)(BK * 2);
    const size_t hstep = (size_t)HALF * K * 2;
    const size_t tstep = 2 * hstep;
    const unsigned ldsw = (unsigned)wid * 1024u;
    const int aoff = lds_byte(wr * 64 + fr, fq * 8), boff = lds_byte(wc * 32 + fr, fq * 8);
#define PG8_SA(b, h) (((b) * 2 + (h)) * HTB)
#define PG8_SB(b, h) ((4 + (b) * 2 + (h)) * HTB)
#define PG8_STAGE(bufoff, gbase, voff) do { _Pragma("unroll") for (int _i = 0; _i < 2; ++_i) \
        __builtin_amdgcn_global_load_lds((const unsigned*)((const char*)(gbase) + (voff)[_i]), (PG8_LAS unsigned*)(lds + (bufoff) + ldsw + _i * 8192), 16, 0, 0); } while (0)
#define PG8_LDA(dst, b, h) do { _Pragma("unroll") for (int m = 0; m < 4; ++m) _Pragma("unroll") for (int k = 0; k < 2; ++k) dst[m][k] = *(const PG8_LAS bf16x8*)(lds + PG8_SA(b, h) + aoff + m * 2048 + k * 1024); } while (0)
#define PG8_LDB(dst, b, h) do { _Pragma("unroll") for (int n = 0; n < 2; ++n) _Pragma("unroll") for (int k = 0; k < 2; ++k) dst[n][k] = *(const PG8_LAS bf16x8*)(lds + PG8_SB(b, h) + boff + n * 2048 + k * 1024); } while (0)
#define PG8_MMA(ai, bj, At, Bt) do { __builtin_amdgcn_s_setprio(1); _Pragma("unroll") for (int m = 0; m < 4; ++m) _Pragma("unroll") for (int n = 0; n < 2; ++n) _Pragma("unroll") for (int k = 0; k < 2; ++k) \
        acc[ai][bj][m][n] = __builtin_amdgcn_mfma_f32_16x16x32_bf16(Bt[n][k], At[m][k], acc[ai][bj][m][n], 0, 0, 0); __builtin_amdgcn_s_setprio(0); } while (0)
#define PG8_WAIT_V(n) asm volatile("s_waitcnt vmcnt(" #n ")" ::: "memory")
#define PG8_WAIT_L(n) asm volatile("s_waitcnt lgkmcnt(" #n ")" ::: "memory")
#define PG8_BAR __builtin_amdgcn_s_barrier()
#define PG8_SCHED __builtin_amdgcn_sched_barrier(0)
    Unit cur, nxt; int ui = 0;
    if (!S.next(0, cur)) return;
    f32x4 acc[2][2][4][2];
#pragma unroll
    for (int a = 0; a < 2; ++a)
#pragma unroll
        for (int b = 0; b < 2; ++b)
#pragma unroll
            for (int m = 0; m < 4; ++m)
#pragma unroll
                for (int n = 0; n < 2; ++n) acc[a][b][m][n] = (f32x4){0.f, 0.f, 0.f, 0.f};
    bf16x8 At[4][2], B0[2][2], B1[2][2];
    const char* cA = (const char*)g.A + (size_t)cur.pm * tstep; const char* cB = (const char*)g.Bt + (size_t)cur.pn * tstep;
    S.a_ready(cur);
    if constexpr (SP2) {
        PG8_STAGE(PG8_SB(0, 0), cB, voffB); PG8_STAGE(PG8_SB(0, 1), cB + hstep, voffB); PG8_STAGE(PG8_SA(0, 0), cA, voffA); PG8_STAGE(PG8_SA(0, 1), cA + hstep, voffA);
        if (wr == 1) PG8_BAR;
        PG8_WAIT_V(2); PG8_BAR;
        PG8_STAGE(PG8_SB(1, 0), cB + kstep, voffB); PG8_STAGE(PG8_SA(1, 0), cA + kstep, voffA); PG8_STAGE(PG8_SB(1, 1), cB + hstep + kstep, voffB);
        PG8_WAIT_V(6); PG8_BAR;
    } else {
        PG8_STAGE(PG8_SB(0, 0), cB, voffB); PG8_STAGE(PG8_SA(0, 0), cA, voffA); PG8_STAGE(PG8_SB(0, 1), cB + hstep, voffB); PG8_STAGE(PG8_SA(0, 1), cA + hstep, voffA);
        if (wr == 1) PG8_BAR;
        PG8_WAIT_V(4); PG8_BAR;
        PG8_STAGE(PG8_SB(1, 0), cB + kstep, voffB); PG8_STAGE(PG8_SA(1, 0), cA + kstep, voffA); PG8_STAGE(PG8_SB(1, 1), cB + hstep + kstep, voffB);
        PG8_WAIT_V(6); PG8_BAR;
    }
    for (;;) {
        const bool has_next = S.next(ui + 1, nxt);
        const char* nA = has_next ? (const char*)g.A + (size_t)nxt.pm * tstep : cA; const char* nB = has_next ? (const char*)g.Bt + (size_t)nxt.pn * tstep : cB;
        for (int t = 0; t < nt; t += 2) {
            const bool last = (t == nt - 2);
            const char* a1 = cA + (size_t)(t + 1) * kstep;
            const char* a2 = last ? nA : cA + (size_t)(t + 2) * kstep; const char* b2 = last ? nB : cB + (size_t)(t + 2) * kstep;
            const char* a3 = a2 + kstep; const char* b3 = b2 + kstep;
            if (last && has_next) S.a_ready(nxt);
            if constexpr (SP2) {
            PG8_LDB(B0, 0, 0); PG8_LDB(B1, 0, 1); PG8_SCHED; PG8_LDA(At, 0, 0); PG8_STAGE(PG8_SA(1, 1), a1 + hstep, voffA);
            PG8_WAIT_V(8); PG8_WAIT_L(0); PG8_BAR; PG8_MMA(0, 0, At, B0); PG8_MMA(0, 1, At, B1); PG8_BAR; PG8_SCHED;
            PG8_LDA(At, 0, 1); PG8_STAGE(PG8_SB(0, 0), b2, voffB); PG8_STAGE(PG8_SB(0, 1), b2 + hstep, voffB); PG8_STAGE(PG8_SA(0, 0), a2, voffA);
            PG8_WAIT_V(8); PG8_WAIT_L(0); PG8_BAR; PG8_MMA(1, 0, At, B0); PG8_MMA(1, 1, At, B1); PG8_BAR; PG8_SCHED;
            PG8_LDB(B0, 1, 0); PG8_LDB(B1, 1, 1); PG8_SCHED; PG8_LDA(At, 1, 0); PG8_STAGE(PG8_SA(0, 1), a2 + hstep, voffA);
            PG8_WAIT_V(8); PG8_WAIT_L(0); PG8_BAR; PG8_MMA(0, 0, At, B0); PG8_MMA(0, 1, At, B1); PG8_BAR; PG8_SCHED;
            PG8_LDA(At, 1, 1); PG8_STAGE(PG8_SB(1, 0), b3, voffB); PG8_STAGE(PG8_SB(1, 1), b3 + hstep, voffB); PG8_STAGE(PG8_SA(1, 0), a3, voffA);
            PG8_WAIT_V(8); PG8_WAIT_L(0); PG8_BAR; PG8_MMA(1, 0, At, B0); PG8_MMA(1, 1, At, B1); PG8_BAR; PG8_SCHED;
            } else {
            PG8_LDB(B0, 0, 0); PG8_SCHED; PG8_LDA(At, 0, 0); PG8_STAGE(PG8_SA(1, 1), a1 + hstep, voffA);
            PG8_WAIT_L(8); PG8_BAR; PG8_WAIT_L(0); PG8_MMA(0, 0, At, B0); PG8_BAR; PG8_SCHED;
            PG8_LDB(B1, 0, 1); PG8_STAGE(PG8_SB(0, 0), b2, voffB);
            PG8_BAR; PG8_WAIT_L(0); PG8_MMA(0, 1, At, B1); PG8_BAR;
            PG8_LDA(At, 0, 1); PG8_STAGE(PG8_SA(0, 0), a2, voffA);
            PG8_BAR; PG8_WAIT_L(0); PG8_MMA(1, 0, At, B0); PG8_BAR; PG8_SCHED;
            PG8_STAGE(PG8_SB(0, 1), b2 + hstep, voffB);
            PG8_WAIT_V(6); PG8_BAR; PG8_MMA(1, 1, At, B1); PG8_BAR;
            PG8_LDB(B0, 1, 0); PG8_SCHED; PG8_LDA(At, 1, 0); PG8_STAGE(PG8_SA(0, 1), a2 + hstep, voffA);
            PG8_WAIT_L(8); PG8_BAR; PG8_WAIT_L(0); PG8_MMA(0, 0, At, B0); PG8_BAR; PG8_SCHED;
            PG8_LDB(B1, 1, 1); PG8_STAGE(PG8_SB(1, 0), b3, voffB);
            PG8_BAR; PG8_WAIT_L(0); PG8_MMA(0, 1, At, B1); PG8_BAR;
            PG8_LDA(At, 1, 1); PG8_STAGE(PG8_SA(1, 0), a3, voffA);
            PG8_BAR; PG8_WAIT_L(0); PG8_MMA(1, 0, At, B0); PG8_BAR; PG8_SCHED;
            PG8_STAGE(PG8_SB(1, 1), b3 + hstep, voffB);
            PG8_WAIT_V(6); PG8_BAR; PG8_MMA(1, 1, At, B1); PG8_BAR;
            }
        }
        if constexpr (ALIGN_EPI) { if (wr == 0) PG8_BAR; }
        if constexpr (!Epi::AFTER_DRAIN) { E(acc, cur, wr, wc, fr, fq); S.done(cur); }
        if (!has_next) break;
#pragma unroll
        for (int a = 0; a < 2; ++a)
#pragma unroll
            for (int b = 0; b < 2; ++b)
#pragma unroll
                for (int m = 0; m < 4; ++m)
#pragma unroll
                    for (int n = 0; n < 2; ++n) acc[a][b][m][n] = (f32x4){0.f, 0.f, 0.f, 0.f};
        cur = nxt; cA = nA; cB = nB; ++ui;
        if constexpr (ALIGN_EPI) { if (wr == 1) PG8_BAR; }
    }
    PG8_WAIT_V(0);
    if constexpr (!ALIGN_EPI) { if (wr == 0) PG8_BAR; }
    PG8_BAR;
    if constexpr (Epi::AFTER_DRAIN) { E.fused(acc, cur, wr, wc, fr, fq, lds, wid, lane); S.done(cur); }
#undef PG8_SA
#undef PG8_SB
#undef PG8_STAGE
#undef PG8_LDA
#undef PG8_LDB
#undef PG8_MMA
#undef PG8_WAIT_V
#undef PG8_WAIT_L
#undef PG8_BAR
#undef PG8_SCHED
}
}

using pg8::bf16_t; using pg8::bf16x8; using pg8::f32x4; using pg8::u32x4; using pg8::u32x2;
#define LAS __attribute__((address_space(3)))
typedef short bf16x4 __attribute__((ext_vector_type(4)));

constexpr int NB = 4, SEQ = 4096, DM = 1024, MTOK = NB * SEQ, DIN = 2048, NE = 16, FF = 2048, CAP = 512, NROWX = NE * NB * CAP;
constexpr float ALPHA = 1.41421356237309515f, LN_EPS = 1e-5f;
constexpr int NWAVES = 8, NTHR = 512;
constexpr int LDS_BYTES = 147456;
constexpr int S5T = 32, S5NCH = SEQ / S5T;

constexpr size_t MiB = 1u << 20;
constexpr size_t WS_WIN = 0, WS_WOUT = 8 * MiB, WS_WGLU = 12 * MiB, WS_S5TAB = 13 * MiB, WS_AFFT = 14 * MiB, WS_IDX = 15 * MiB, WS_GATE = 16 * MiB, WS_SLOT = 17 * MiB, WS_BAR = 18 * MiB, WS_S5BT = 19 * MiB;
constexpr size_t WS_WGU = 32 * MiB, WS_WD = 288 * MiB, WS_H32 = 416 * MiB, WS_HBF = 480 * MiB, WS_RA = 512 * MiB  , WS_RB = 576 * MiB  ;
constexpr size_t WS_HDN = 640 * MiB, WS_KVF = 768 * MiB, WS_KVB = 776 * MiB, WS_STF = 784 * MiB, WS_STB = 792 * MiB, WS_S5E = 800 * MiB, WS_S5C = 808 * MiB, WS_END = 816 * MiB;

struct Args { const float* in[25]; float* out; unsigned char* ws; int ph_lo, ph_hi; };

typedef __bf16 bf16x2_hw __attribute__((ext_vector_type(2)));
typedef float f32x2_hw __attribute__((ext_vector_type(2)));
__device__ __forceinline__ unsigned pk2(float lo, float hi) { const f32x2_hw v = {lo, hi}; const bf16x2_hw b = __builtin_convertvector(v, bf16x2_hw); return __builtin_bit_cast(unsigned, b); }
__device__ __forceinline__ unsigned f2bf(float f) { return pk2(f, 0.f) & 0xffffu; }
__device__ __forceinline__ float bflo(unsigned w) { return __uint_as_float(w << 16); }
__device__ __forceinline__ float bfhi(unsigned w) { return __uint_as_float(w & 0xffff0000u); }
__device__ __forceinline__ f32x4 mfma16(bf16x8 a, bf16x8 b, f32x4 c) { return __builtin_amdgcn_mfma_f32_16x16x32_bf16(a, b, c, 0, 0, 0); }
__device__ __forceinline__ float wave_sum(float v) {
#pragma unroll
    for (int o = 1; o < 64; o <<= 1) v += __shfl_xor(v, o);
    return v;
}
__device__ __forceinline__ bf16x8 pack8(const f32x4& a, const f32x4& b) {
    u32x4 w; w.x = pk2(a[0], a[1]); w.y = pk2(a[2], a[3]); w.z = pk2(b[0], b[1]); w.w = pk2(b[2], b[3]);
    return __builtin_bit_cast(bf16x8, w);
}
__device__ __forceinline__ bf16x8 cat8(bf16x4 lo, bf16x4 hi) { bf16x8 r; r[0] = lo[0]; r[1] = lo[1]; r[2] = lo[2]; r[3] = lo[3]; r[4] = hi[0]; r[5] = hi[1]; r[6] = hi[2]; r[7] = hi[3]; return r; }
#define LDS_WAIT() asm volatile("s_waitcnt lgkmcnt(0)" ::: "memory")

struct ConvItem { const float* srcp; bf16_t* dstp; int N; int rstep; };
__device__ __forceinline__ ConvItem conv_decode(const Args& a, int it, int lane) {
    constexpr int I3 = 16384, I4 = 16384, I5 = 16384, I0 = 1024, I1 = 512;
    unsigned char* ws = a.ws;
    const float* src; bf16_t* dst; int K, N, rmul = 1, ro = 0, kb, nb;
    int r = it;
    if (r < I3 + I4) { const int up = r >= I3; r -= up ? I3 : 0; const int mat = r >> 9, q = r & 511; src = (up ? a.in[21] : a.in[20]) + (size_t)mat * DM * FF; dst = (bf16_t*)(ws + WS_WGU) + (size_t)mat * 2 * FF * DM; K = DM; N = FF; rmul = 2; ro = up; kb = q >> 5; nb = q & 31; }
    else { r -= I3 + I4;
        if (r < I5) { const int mat = r >> 9, q = r & 511; src = a.in[22] + (size_t)mat * FF * DM; dst = (bf16_t*)(ws + WS_WD) + (size_t)mat * DM * FF; K = FF; N = DM; kb = q >> 4; nb = q & 15; }
        else { r -= I5;
            if (r < I0) { const int mat = r >> 9, q = r & 511; src = a.in[3] + (size_t)mat * DM * DIN; dst = (bf16_t*)(ws + WS_WIN) + (size_t)mat * DIN * DM; K = DM; N = DIN; kb = q >> 5; nb = q & 31; }
            else { r -= I0;
                if (r < I1) { const int mat = r >> 8, q = r & 255; src = a.in[16] + (size_t)mat * DM * DM; dst = (bf16_t*)(ws + WS_WOUT) + (size_t)mat * DM * DM; K = DM; N = DM; kb = q >> 4; nb = q & 15; }
                else { r -= I1; const int mat = r >> 4, q = r & 15; src = a.in[13] + (size_t)mat * 65536; dst = (bf16_t*)(ws + WS_WGLU) + (size_t)mat * 65536; K = 256; N = 256; kb = q >> 2; nb = q & 3; } } } }
    ConvItem c; c.N = N;
    c.srcp = src + (size_t)(kb * 64 + (lane >> 4)) * N + nb * 64 + (lane & 15) * 4;
    c.dstp = dst + (size_t)((nb * 64) * rmul + ro) * K + kb * 64; c.rstep = rmul * K;
    return c;
}
__device__ __forceinline__ void conv_load(const ConvItem& c, f32x4 (&v)[16]) {
#pragma unroll
    for (int i = 0; i < 16; ++i) v[i] = __builtin_nontemporal_load((const f32x4*)(c.srcp + (size_t)(i * 4) * c.N));
}
__device__ __forceinline__ void conv_store(const ConvItem& c, const f32x4 (&v)[16], LAS float* scr, int lane) {
    const int r4 = lane >> 4, c4 = (lane & 15) * 4;
#pragma unroll
    for (int i = 0; i < 16; ++i) { const int kk = i * 4 + r4; *(LAS f32x4*)(scr + kk * 68 + (c4 ^ (((kk >> 3) & 7) * 4))) = v[i]; }
    LDS_WAIT();
    const int cc = lane & 7, nl = lane >> 3;
#pragma unroll
    for (int p = 0; p < 8; ++p) {
        const int n = nl + 8 * p;
        const LAS float* s = scr + (8 * cc) * 68 + (n ^ (4 * cc));
        u32x4 o; o.x = pk2(s[0], s[68]); o.y = pk2(s[2 * 68], s[3 * 68]); o.z = pk2(s[4 * 68], s[5 * 68]); o.w = pk2(s[6 * 68], s[7 * 68]);
        *(u32x4*)(c.dstp + (size_t)n * c.rstep + 8 * cc) = o;
    }
    LDS_WAIT();
}
__device__ __forceinline__ void sincos_rev(double f, double& sn, double& cs) {
    const double a = f * 6.283185307179586476925;
    const double q = rint(a * 0.636619772367581343);
    const double r = a - q * 1.570796326794896619;
    const double r2 = r * r;
    double s = -7.6471637318198164759e-13; s = s * r2 + 1.6059043836821614599e-10; s = s * r2 - 2.5052108385441718775e-8; s = s * r2 + 2.7557319223985890653e-6;
    s = s * r2 - 1.9841269841269841270e-4; s = s * r2 + 8.3333333333333333333e-3; s = s * r2 - 1.6666666666666666667e-1; s = s * r2 * r + r;
    double c = 4.7794773323873852974e-14; c = c * r2 - 1.1470745597729724714e-11; c = c * r2 + 2.0876756987868098979e-9; c = c * r2 - 2.7557319223985890653e-7;
    c = c * r2 + 2.4801587301587301587e-5; c = c * r2 - 1.3888888888888888889e-3; c = c * r2 + 4.1666666666666666667e-2; c = c * r2 - 0.5; c = c * r2 + 1.0;
    const int qi = ((int)q) & 3;
    sn = (qi == 0) ? s : (qi == 1) ? c : (qi == 2) ? -s : -c;
    cs = (qi == 0) ? c : (qi == 1) ? -s : (qi == 2) ? -c : s;
}
__device__ __forceinline__ double exp_small(double x) {
    const double y = x * (1.0 / 64.0);
    double e = 1.0 / 479001600.0;
    e = e * y + 1.0 / 39916800.0; e = e * y + 1.0 / 3628800.0; e = e * y + 1.0 / 362880.0; e = e * y + 1.0 / 40320.0; e = e * y + 1.0 / 5040.0; e = e * y + 1.0 / 720.0;
    e = e * y + 1.0 / 120.0; e = e * y + 1.0 / 24.0; e = e * y + 1.0 / 6.0; e = e * y + 0.5; e = e * y + 1.0; e = e * y + 1.0;
#pragma unroll
    for (int i = 0; i < 6; ++i) e = e * e;
    return e;
}
__device__ __forceinline__ void s5_coefs(const Args& a, int t, double& br, double& bi, double& cr, double& ci, double& tr, double& ti) {
    const int g = (t >> 6) & 15, lr = t >> 10;
    const double lre = (double)a.in[5][t], lim = (double)a.in[6][t];
    const double step = exp_small((double)a.in[7][lr * 16 + g]);
    const double ar = lre * step, th = lim * step;
    const double rev = th * 0.15915494309189533577; const double fr = rev - rint(rev);
    double sn, cs; sincos_rev(fr, sn, cs);
    const double mag = exp_small(ar);
    br = mag * cs; bi = mag * sn;
    const double nr = br - 1.0, ni = bi, den = lre * lre + lim * lim;
    cr = (nr * lre + ni * lim) / den; ci = (ni * lre - nr * lim) / den;
    const double rev2 = rev * (double)S5T; const double fr2 = rev2 - rint(rev2);
    double sn2, cs2; sincos_rev(fr2, sn2, cs2);
    const double mag2 = exp_small(ar * (double)S5T);
    tr = mag2 * cs2; ti = mag2 * sn2;
}
__device__ __forceinline__ void s5_table_entry(const Args& a, int t) {
    double br, bi, cr, ci, tr, ti; s5_coefs(a, t, br, bi, cr, ci, tr, ti);
    float* o = (float*)(a.ws + WS_S5TAB) + (size_t)t * 8;
    o[0] = (float)br; o[1] = (float)bi; o[2] = (float)cr; o[3] = (float)ci; o[4] = (float)tr; o[5] = (float)ti; o[6] = 0.f; o[7] = 0.f;
}
__device__ __forceinline__ void s5_bt_row(const Args& a, int t) {
    const int l = t >> 12, g = (t >> 8) & 15, n = t & 255, r = n >> 7, p = (n >> 1) & 63, ri = n & 1;
    double br, bi, cr, ci, tr, ti; s5_coefs(a, ((l * 2 + r) * 16 + g) * 64 + p, br, bi, cr, ci, tr, ti);
    const float crf = (float)cr, cif = (float)ci;
    const float* bre = a.in[8] + (size_t)((l * 16 + g) * 64 + p) * 16; const float* bim = a.in[9] + (size_t)((l * 16 + g) * 64 + p) * 16;
    u32x4 o[2];
#pragma unroll
    for (int h = 0; h < 2; ++h) {
        const f32x4 x0 = *(const f32x4*)(bre + 8 * h), x1 = *(const f32x4*)(bre + 8 * h + 4), y0 = *(const f32x4*)(bim + 8 * h), y1 = *(const f32x4*)(bim + 8 * h + 4);
        float v[8];
#pragma unroll
        for (int k = 0; k < 4; ++k) { v[k] = ri ? (crf * y0[k] + cif * x0[k]) : (crf * x0[k] - cif * y0[k]); v[4 + k] = ri ? (crf * y1[k] + cif * x1[k]) : (crf * x1[k] - cif * y1[k]); }
        o[h].x = pk2(v[0], v[1]); o[h].y = pk2(v[2], v[3]); o[h].z = pk2(v[4], v[5]); o[h].w = pk2(v[6], v[7]);
    }
    u32x4* dst = (u32x4*)((bf16_t*)(a.ws + WS_S5BT) + (size_t)t * 32);
    dst[0] = o[0]; dst[1] = o[1]; dst[2] = (u32x4){0u, 0u, 0u, 0u}; dst[3] = (u32x4){0u, 0u, 0u, 0u};
}
__device__ __forceinline__ void ln_rows4(f32x4 (&v)[4], const float* __restrict__ g, const float* __restrict__ bt, int lane) {
    float s = 0.f;
#pragma unroll
    for (int j = 0; j < 4; ++j) s += (v[j][0] + v[j][1]) + (v[j][2] + v[j][3]);
    const float mean = wave_sum(s) * (1.f / DM); float s2 = 0.f;
#pragma unroll
    for (int j = 0; j < 4; ++j) { v[j] = v[j] - mean; s2 += (v[j][0] * v[j][0] + v[j][1] * v[j][1]) + (v[j][2] * v[j][2] + v[j][3] * v[j][3]); }
    const float rstd = 1.f / sqrtf(wave_sum(s2) * (1.f / DM) + LN_EPS);
#pragma unroll
    for (int j = 0; j < 4; ++j) { const f32x4 gv = ((const f32x4*)g)[lane + 64 * j], bv = ((const f32x4*)bt)[lane + 64 * j]; v[j] = v[j] * rstd * gv + bv; }
}
__device__ __forceinline__ void store_row(const f32x4 (&v)[4], float* o32, bf16_t* obf, int lane) {
#pragma unroll
    for (int j = 0; j < 4; ++j) {
        if (o32) ((f32x4*)o32)[lane + 64 * j] = v[j];
        if (obf) { u32x2 w; w.x = pk2(v[j][0], v[j][1]); w.y = pk2(v[j][2], v[j][3]); ((u32x2*)obf)[lane + 64 * j] = w; }
    }
}
__device__ __forceinline__ void phase_p0(const Args& a, LAS unsigned char* lds, int tid) {
    const int lane = tid & 63, wave = tid >> 6;
    const int gw = blockIdx.x * NWAVES + wave, NGW = gridDim.x * NWAVES;
    LAS float* scr = (LAS float*)(lds + wave * 17408);
    unsigned char* ws = a.ws;
    constexpr int NIT = 16384 * 3 + 1024 + 512 + 32;
    if (gw < NIT) {
        ConvItem cur = conv_decode(a, gw, lane);
        f32x4 v[16]; conv_load(cur, v);
        for (int it = gw; it < NIT; it += NGW) {
            const bool more = (it + NGW) < NIT;
            ConvItem nxt = cur; f32x4 vn[16];
            if (more) { nxt = conv_decode(a, it + NGW, lane); conv_load(nxt, vn); }
            conv_store(cur, v, scr, lane);
            if (more) { cur = nxt;
#pragma unroll
                for (int i = 0; i < 16; ++i) v[i] = vn[i]; }
        }
    }
    for (int t = blockIdx.x * NTHR + tid; t < 4096; t += gridDim.x * NTHR) s5_table_entry(a, t);
    for (int t = blockIdx.x * NTHR + tid; t < 8192; t += gridDim.x * NTHR) s5_bt_row(a, t);
    for (int m = gw; m < MTOK; m += NGW) {
        f32x4 v[4];
#pragma unroll
        for (int j = 0; j < 4; ++j) v[j] = ((const f32x4*)(a.in[0] + (size_t)m * DM))[lane + 64 * j];
        ln_rows4(v, a.in[1], a.in[2], lane);
        store_row(v, (float*)(ws + WS_H32) + (size_t)m * DM, (bf16_t*)(ws + WS_HBF) + (size_t)m * DM, lane);
    }
}

__device__ __forceinline__ void attn_item(int item, const bf16_t* __restrict__ proj, bf16_t* __restrict__ mix, const float* __restrict__ sink_l, LAS unsigned char* lds, int tid) {
    const int kh = item & 1, c = (item >> 1) & 31, b = item >> 6;
    constexpr int VS = 408;
    LAS bf16_t* Ks = (LAS bf16_t*)lds;
    LAS bf16_t* Vt = (LAS bf16_t*)(lds + 384 * 72 * 2);
    const int lane = tid & 63, w = tid >> 6, fr = lane & 15, fq = lane >> 4;
    const int hq = kh * 4 + (w >> 1);
    const bf16_t* qbase = proj + ((size_t)b * SEQ + c * 128 + (w & 1) * 64 + fr) * DIN + 1280 + hq * 64 + fq * 8;
    bf16x8 qn0 = *(const bf16x8*)qbase, qn1 = *(const bf16x8*)(qbase + 32);
#pragma unroll
    for (int i = 0; i < 6; ++i) {
        const int id = tid + NTHR * i, key = id >> 3, ch = id & 7;
        const int s = (c - 1) * 128 + key; const bool ok = (s >= 0) && (s < SEQ);
        u32x4 kv = {0u, 0u, 0u, 0u}, vv = {0u, 0u, 0u, 0u};
        if (ok) { const bf16_t* rowp = proj + (size_t)(b * SEQ + s) * DIN; kv = *(const u32x4*)(rowp + 1792 + kh * 64 + ch * 8); vv = *(const u32x4*)(rowp + 1920 + kh * 64 + ch * 8); }
        *(LAS u32x4*)(Ks + key * 72 + ch * 8) = kv;
        LAS bf16_t* vp = Vt + (ch * 8) * VS + key;
        vp[0 * VS] = (bf16_t)(vv.x & 0xffffu); vp[1 * VS] = (bf16_t)(vv.x >> 16); vp[2 * VS] = (bf16_t)(vv.y & 0xffffu); vp[3 * VS] = (bf16_t)(vv.y >> 16);
        vp[4 * VS] = (bf16_t)(vv.z & 0xffffu); vp[5 * VS] = (bf16_t)(vv.z >> 16); vp[6 * VS] = (bf16_t)(vv.w & 0xffffu); vp[7 * VS] = (bf16_t)(vv.w >> 16);
    }
    if (tid < 128) { const int d = tid >> 1, hh = tid & 1; *(LAS u32x4*)(Vt + d * VS + 384 + hh * 8) = (u32x4){0u, 0u, 0u, 0u}; }
    __syncthreads();
    const float slope = exp2f(-(float)(hq + 1));
    const float sinkv = sink_l[hq];
    const bool lo_ok = (c >= 1), hi_ok = (c <= 30);
    float plo[4], phi[4];
#pragma unroll
    for (int j = 0; j < 4; ++j) { plo[j] = (fq * 4 + j >= fr) ? 0.f : -1e30f; phi[j] = (fq * 4 + j <= fr) ? 0.f : -1e30f; }
#pragma unroll 1
    for (int qi = 0; qi < 4; ++qi) {
        const int qt = (w & 1) * 4 + qi;
        const size_t tok = (size_t)b * SEQ + c * 128 + qt * 16 + fr;
        const bf16x8 qa0 = qn0, qa1 = qn1;
        float slope_l = slope; asm volatile("" : "+v"(slope_l));
        float sd[4];
#pragma unroll
        for (int j = 0; j < 4; ++j) sd[j] = slope_l * (float)(fq * 4 + j - fr);
        if (qi < 3) { const bf16_t* qp = qbase + (size_t)(qi + 1) * 16 * DIN; qn0 = *(const bf16x8*)qp; qn1 = *(const bf16x8*)(qp + 32); }
        f32x4 s[18];
        float mx = sinkv;
        const LAS bf16_t* kbase = Ks + (qt * 16 + fr) * 72 + fq * 8;
        const LAS bf16_t* vbase = Vt + fr * VS + qt * 16 + fq * 4;
#pragma unroll
        for (int i = 0; i < 17; ++i) {
            const int kt = qt + i;
            const LAS bf16_t* kp = kbase + i * (16 * 72);
            f32x4 acc = {0.f, 0.f, 0.f, 0.f};
            acc = mfma16(*(const LAS bf16x8*)kp, qa0, acc); acc = mfma16(*(const LAS bf16x8*)(kp + 32), qa1, acc);
            const float pblk = ((kt < 8) ? lo_ok : ((kt >= 16) ? hi_ok : true)) ? 0.f : -1e30f;
            const float base = slope_l * (float)(16 * i - 128);
#pragma unroll
            for (int j = 0; j < 4; ++j) {
                float t = (i < 8) ? (base + sd[j]) : ((i > 8) ? -(base + sd[j]) : -fabsf(sd[j]));
                if (i == 0) t += plo[j];
                if (i == 16) t += phi[j];
                const float v = fmaf(acc[j], 0.125f, t + pblk);
                acc[j] = v; mx = fmaxf(mx, v);
            }
            s[i] = acc;
        }
        mx = fmaxf(mx, __shfl_xor(mx, 16)); mx = fmaxf(mx, __shfl_xor(mx, 32));
        float sum = 0.f;
#pragma unroll
        for (int i = 0; i < 17; ++i)
#pragma unroll
            for (int j = 0; j < 4; ++j) { const float p = __expf(s[i][j] - mx); s[i][j] = p; sum += p; }
        s[17] = (f32x4){0.f, 0.f, 0.f, 0.f};
        sum += __shfl_xor(sum, 16); sum += __shfl_xor(sum, 32);
        const float inv = 1.f / (sum + __expf(sinkv - mx));
        f32x4 o[4];
#pragma unroll
        for (int dt = 0; dt < 4; ++dt) o[dt] = (f32x4){0.f, 0.f, 0.f, 0.f};
#pragma unroll
        for (int kk = 0; kk < 9; ++kk) {
            const bf16x8 pb = pack8(s[2 * kk], s[2 * kk + 1]);
#pragma unroll
            for (int dt = 0; dt < 4; ++dt) {
                const LAS bf16_t* vp = vbase + dt * (16 * VS) + kk * 32;
                o[dt] = mfma16(cat8(*(const LAS bf16x4*)vp, *(const LAS bf16x4*)(vp + 16)), pb, o[dt]);
            }
        }
        bf16_t* op = mix + tok * DM + 512 + hq * 64 + fq * 4;
#pragma unroll
        for (int dt = 0; dt < 4; ++dt) { u32x2 wv; wv.x = pk2(o[dt][0] * inv, o[dt][1] * inv); wv.y = pk2(o[dt][2] * inv, o[dt][3] * inv); *(u32x2*)(op + dt * 16) = wv; }
    }
    __syncthreads();
}

__device__ __forceinline__ float log_sigmoid(float t) { return -log1pf(__expf(-t)); }
__device__ __forceinline__ void retkv_item(int item, const bf16_t* __restrict__ proj, float* __restrict__ kvf, float* __restrict__ kvb, const float* __restrict__ theta, LAS unsigned char* lds, int tid) {
    const int h = item & 3, c = (item >> 2) & 31, b = item >> 7;
    const float lgf = log_sigmoid(theta[h]), lgb = log_sigmoid(theta[4 + h]);
    LAS bf16_t* KTf = (LAS bf16_t*)lds; LAS bf16_t* KTb = KTf + 64 * 136; LAS bf16_t* VT = KTb + 64 * 136;
#pragma unroll
    for (int i = 0; i < 2; ++i) {
        const int id = tid + NTHR * i, j = id >> 3, ch = id & 7;
        const bf16_t* rowp = proj + (size_t)(b * SEQ + c * 128 + j) * DIN;
        const u32x4 kr = *(const u32x4*)(rowp + 256 + h * 64 + ch * 8), vr = *(const u32x4*)(rowp + 512 + h * 64 + ch * 8);
        const float wf = __expf(lgf * (float)(127 - j)) * 0.125f, wb = __expf(lgb * (float)j) * 0.125f;
        const int o = (ch * 8) * 136 + j;
        KTf[o + 0 * 136] = (bf16_t)f2bf(bflo(kr.x) * wf); KTf[o + 1 * 136] = (bf16_t)f2bf(bfhi(kr.x) * wf); KTf[o + 2 * 136] = (bf16_t)f2bf(bflo(kr.y) * wf); KTf[o + 3 * 136] = (bf16_t)f2bf(bfhi(kr.y) * wf);
        KTf[o + 4 * 136] = (bf16_t)f2bf(bflo(kr.z) * wf); KTf[o + 5 * 136] = (bf16_t)f2bf(bfhi(kr.z) * wf); KTf[o + 6 * 136] = (bf16_t)f2bf(bflo(kr.w) * wf); KTf[o + 7 * 136] = (bf16_t)f2bf(bfhi(kr.w) * wf);
        KTb[o + 0 * 136] = (bf16_t)f2bf(bflo(kr.x) * wb); KTb[o + 1 * 136] = (bf16_t)f2bf(bfhi(kr.x) * wb); KTb[o + 2 * 136] = (bf16_t)f2bf(bflo(kr.y) * wb); KTb[o + 3 * 136] = (bf16_t)f2bf(bfhi(kr.y) * wb);
        KTb[o + 4 * 136] = (bf16_t)f2bf(bflo(kr.z) * wb); KTb[o + 5 * 136] = (bf16_t)f2bf(bfhi(kr.z) * wb); KTb[o + 6 * 136] = (bf16_t)f2bf(bflo(kr.w) * wb); KTb[o + 7 * 136] = (bf16_t)f2bf(bfhi(kr.w) * wb);
        VT[o + 0 * 136] = (bf16_t)(vr.x & 0xffffu); VT[o + 1 * 136] = (bf16_t)(vr.x >> 16); VT[o + 2 * 136] = (bf16_t)(vr.y & 0xffffu); VT[o + 3 * 136] = (bf16_t)(vr.y >> 16);
        VT[o + 4 * 136] = (bf16_t)(vr.z & 0xffffu); VT[o + 5 * 136] = (bf16_t)(vr.z >> 16); VT[o + 6 * 136] = (bf16_t)(vr.w & 0xffffu); VT[o + 7 * 136] = (bf16_t)(vr.w >> 16);
    }
    __syncthreads();
    const int lane = tid & 63, w = tid >> 6, fr = lane & 15, fq = lane >> 4;
    const size_t obase = (size_t)((b * 32 + c) * 4 + h) * 4096;
#pragma unroll
    for (int i = 0; i < 4; ++i) {
        const int job = w * 4 + i, dirb = job >> 4, et = (job >> 2) & 3, dt = job & 3;
        const LAS bf16_t* ap = VT + (et * 16 + fr) * 136 + fq * 8;
        const LAS bf16_t* bp = (dirb ? KTb : KTf) + (dt * 16 + fr) * 136 + fq * 8;
        f32x4 acc = {0.f, 0.f, 0.f, 0.f};
#pragma unroll
        for (int ks = 0; ks < 4; ++ks) acc = mfma16(*(const LAS bf16x8*)(ap + ks * 32), *(const LAS bf16x8*)(bp + ks * 32), acc);
        float* op = (dirb ? kvb : kvf) + obase + (et * 16 + fq * 4) * 64 + dt * 16 + fr;
        op[0] = acc[0]; op[64] = acc[1]; op[128] = acc[2]; op[192] = acc[3];
    }
    __syncthreads();
}
__device__ __forceinline__ void retout_item(int item, const bf16_t* __restrict__ proj, const float* __restrict__ stf, const float* __restrict__ stb, bf16_t* __restrict__ mix, const float* __restrict__ theta, LAS unsigned char* lds, int tid) {
    const int h = item & 3, c = (item >> 2) & 31, b = item >> 7;
    const float lgf = log_sigmoid(theta[h]), lgb = log_sigmoid(theta[4 + h]);
    LAS bf16_t* Qs = (LAS bf16_t*)lds; LAS bf16_t* Ks = Qs + 128 * 72; LAS bf16_t* VT = Ks + 128 * 72; LAS bf16_t* SFt = VT + 64 * 136; LAS bf16_t* SBt = SFt + 64 * 72;
#pragma unroll
    for (int i = 0; i < 2; ++i) {
        const int id = tid + NTHR * i, j = id >> 3, ch = id & 7;
        const bf16_t* rowp = proj + (size_t)(b * SEQ + c * 128 + j) * DIN;
        const u32x4 qr = *(const u32x4*)(rowp + h * 64 + ch * 8), kr = *(const u32x4*)(rowp + 256 + h * 64 + ch * 8), vr = *(const u32x4*)(rowp + 512 + h * 64 + ch * 8);
        *(LAS u32x4*)(Qs + j * 72 + ch * 8) = qr; *(LAS u32x4*)(Ks + j * 72 + ch * 8) = kr;
        const int o = (ch * 8) * 136 + j;
        VT[o + 0 * 136] = (bf16_t)(vr.x & 0xffffu); VT[o + 1 * 136] = (bf16_t)(vr.x >> 16); VT[o + 2 * 136] = (bf16_t)(vr.y & 0xffffu); VT[o + 3 * 136] = (bf16_t)(vr.y >> 16);
        VT[o + 4 * 136] = (bf16_t)(vr.z & 0xffffu); VT[o + 5 * 136] = (bf16_t)(vr.z >> 16); VT[o + 6 * 136] = (bf16_t)(vr.w & 0xffffu); VT[o + 7 * 136] = (bf16_t)(vr.w >> 16);
    }
    const size_t sbase = (size_t)((b * 32 + c) * 4 + h) * 4096;
#pragma unroll
    for (int i = 0; i < 8; ++i) { const int id = tid + NTHR * i, e = id >> 6, d = id & 63; SFt[e * 72 + d] = (bf16_t)f2bf(stf[sbase + id]); SBt[e * 72 + d] = (bf16_t)f2bf(stb[sbase + id]); }
    __syncthreads();
    const int lane = tid & 63, it = tid >> 6, fr = lane & 15, fq = lane >> 4;
    const int ipos = it * 16 + fr;
    const LAS bf16_t* qp = Qs + ipos * 72 + fq * 8;
    const bf16x8 qb0 = *(const LAS bf16x8*)qp, qb1 = *(const LAS bf16x8*)(qp + 32);
    f32x4 st[8];
#pragma unroll
    for (int jt = 0; jt < 8; ++jt) {
        const LAS bf16_t* kp = Ks + (jt * 16 + fr) * 72 + fq * 8;
        f32x4 acc = {0.f, 0.f, 0.f, 0.f};
        acc = mfma16(*(const LAS bf16x8*)kp, qb0, acc); acc = mfma16(*(const LAS bf16x8*)(kp + 32), qb1, acc);
#pragma unroll
        for (int jj = 0; jj < 4; ++jj) { const int dij = ipos - (jt * 16 + fq * 4 + jj); const float dec = dij >= 0 ? __expf(lgf * (float)dij) : __expf(lgb * (float)(-dij)); acc[jj] *= 0.125f * dec; }
        st[jt] = acc;
    }
    f32x4 o[4], ff[4], fb[4];
#pragma unroll
    for (int et = 0; et < 4; ++et) { o[et] = (f32x4){0.f, 0.f, 0.f, 0.f}; ff[et] = o[et]; fb[et] = o[et]; }
#pragma unroll
    for (int kk = 0; kk < 4; ++kk) {
        const bf16x8 pb = pack8(st[2 * kk], st[2 * kk + 1]);
#pragma unroll
        for (int et = 0; et < 4; ++et) { const LAS bf16_t* vp = VT + (et * 16 + fr) * 136 + kk * 32 + fq * 4; o[et] = mfma16(cat8(*(const LAS bf16x4*)vp, *(const LAS bf16x4*)(vp + 16)), pb, o[et]); }
    }
#pragma unroll
    for (int et = 0; et < 4; ++et) {
        const LAS bf16_t* fp = SFt + (et * 16 + fr) * 72 + fq * 8; const LAS bf16_t* bp = SBt + (et * 16 + fr) * 72 + fq * 8;
        ff[et] = mfma16(*(const LAS bf16x8*)fp, qb0, ff[et]); ff[et] = mfma16(*(const LAS bf16x8*)(fp + 32), qb1, ff[et]);
        fb[et] = mfma16(*(const LAS bf16x8*)bp, qb0, fb[et]); fb[et] = mfma16(*(const LAS bf16x8*)(bp + 32), qb1, fb[et]);
    }
    const float cf = __expf(lgf * (float)(ipos + 1)), cb = __expf(lgb * (float)(128 - ipos));
    float s = 0.f;
#pragma unroll
    for (int et = 0; et < 4; ++et) { o[et] = o[et] + ff[et] * cf + fb[et] * cb; s += (o[et][0] + o[et][1]) + (o[et][2] + o[et][3]); }
    s += __shfl_xor(s, 16); s += __shfl_xor(s, 32);
    const float mean = s * (1.f / 64.f); float s2 = 0.f;
#pragma unroll
    for (int et = 0; et < 4; ++et) { o[et] = o[et] - mean; s2 += (o[et][0] * o[et][0] + o[et][1] * o[et][1]) + (o[et][2] * o[et][2] + o[et][3] * o[et][3]); }
    s2 += __shfl_xor(s2, 16); s2 += __shfl_xor(s2, 32);
    const float rstd = 1.f / sqrtf(s2 * (1.f / 64.f) + LN_EPS);
    const size_t tok = (size_t)b * SEQ + c * 128 + ipos;
    const bf16_t* gp = proj + tok * DIN + 768 + h * 64 + fq * 4;
    bf16_t* op = mix + tok * DM + h * 64 + fq * 4;
#pragma unroll
    for (int et = 0; et < 4; ++et) {
        const u32x2 gr = *(const u32x2*)(gp + et * 16);
        const float g0 = bflo(gr.x), g1 = bfhi(gr.x), g2 = bflo(gr.y), g3 = bfhi(gr.y);
        const float y0 = o[et][0] * rstd * (g0 / (1.f + __expf(-g0))), y1 = o[et][1] * rstd * (g1 / (1.f + __expf(-g1)));
        const float y2 = o[et][2] * rstd * (g2 / (1.f + __expf(-g2))), y3 = o[et][3] * rstd * (g3 / (1.f + __expf(-g3)));
        u32x2 wv; wv.x = pk2(y0, y1); wv.y = pk2(y2, y3); *(u32x2*)(op + et * 16) = wv;
    }
    __syncthreads();
}

__device__ __forceinline__ void s5_load_u(const bf16_t* __restrict__ proj, int b, int ch, LAS bf16_t* U, int tid) {
#pragma unroll
    for (int i = 0; i < 2; ++i) { const int id = tid + NTHR * i, s = id >> 5, c8 = id & 31;
        *(LAS u32x4*)(U + s * 256 + c8 * 8) = *(const u32x4*)(proj + (size_t)(b * SEQ + ch * S5T + s) * DIN + 1024 + c8 * 8); }
}
__device__ __forceinline__ void s5_bu_tiles(const LAS bf16_t* U, const bf16_t* __restrict__ BT  , LAS bf16_t* X, int XS, int qd, int w, int fr, int fq) {
    const int wg = w >> 1, mt = w & 1, g = qd * 4 + wg;
    bf16x8 uf = {0, 0, 0, 0, 0, 0, 0, 0};
    if (fq < 2) uf = *(const LAS bf16x8*)(U + (mt * 16 + fr) * 256 + g * 16 + fq * 8);
    const bf16_t* btp = BT + (size_t)(g * 256 + fr) * 32 + fq * 8;
    LAS bf16_t* xp = X + (mt * 16 + fr) * XS + wg * 256 + fq * 4;
#pragma unroll 4
    for (int nt = 0; nt < 16; ++nt) {
        const bf16x8 bf = *(const bf16x8*)(btp + nt * 16 * 32);
        f32x4 acc = {0.f, 0.f, 0.f, 0.f};
        acc = mfma16(bf, uf, acc);
        u32x2 wv; wv.x = pk2(acc[0], acc[1]); wv.y = pk2(acc[2], acc[3]);
        *(LAS u32x2*)(xp + nt * 16) = wv;
    }
}

__device__ __forceinline__ void s5e_item(int item, const bf16_t* __restrict__ proj, const float* __restrict__ tab  , const bf16_t* __restrict__ BT,
                                         float* __restrict__ E, LAS unsigned char* lds, int tid) {
    const int ch = item & (S5NCH - 1), b = item / S5NCH;
    constexpr int XS = 1032;
    LAS bf16_t* U = (LAS bf16_t*)lds;
    LAS bf16_t* X = (LAS bf16_t*)(lds + 16384);
    s5_load_u(proj, b, ch, U, tid);
    __syncthreads();
    const int gl = tid >> 7, r = (tid >> 6) & 1, p = tid & 63;
    const int lane = tid & 63, w = tid >> 6, fr = lane & 15, fq = lane >> 4;
    for (int qd = 0; qd < 4; ++qd) {
        s5_bu_tiles(U, BT, X, XS, qd, w, fr, fq);
        __syncthreads();
        const int g = qd * 4 + gl;
        const f32x4 t0 = *(const f32x4*)(tab + (size_t)((r * 16 + g) * 64 + p) * 8); const float lr_ = t0[0], li_ = t0[1];
        float xr = 0.f, xi = 0.f;
        const LAS bf16_t* xq = X + gl * 256 + r * 128 + p * 2;
#pragma unroll 8
        for (int s = 0; s < S5T; ++s) {
            const int si = r ? (S5T - 1 - s) : s;
            const unsigned wv = *(const LAS unsigned*)(xq + si * XS);
            const float nr = fmaf(lr_, xr, fmaf(-li_, xi, bflo(wv))), ni = fmaf(lr_, xi, fmaf(li_, xr, bfhi(wv)));
            xr = nr; xi = ni;
        }
        float2 ev; ev.x = xr; ev.y = xi;
        ((float2*)E)[(size_t)(((b * S5NCH + ch) * 16 + g) * 2 + r) * 64 + p] = ev;
        __syncthreads();
    }
}
__device__ __forceinline__ void s5out_item(int item, const bf16_t* __restrict__ proj, const float* __restrict__ tab, const bf16_t* __restrict__ BT,
                                           const float* __restrict__ cre  , const float* __restrict__ cim, const float* __restrict__ dvec, const bf16_t* __restrict__ wgluT, const float* __restrict__ bglu,
                                           const float* __restrict__ CIN, bf16_t* __restrict__ mix, LAS unsigned char* lds, int tid) {
    const int ch = item & (S5NCH - 1), b = item / S5NCH;
    constexpr int XS = 1032, CS = 264, YS = 264;
    LAS bf16_t* U = (LAS bf16_t*)lds;
    LAS bf16_t* X = (LAS bf16_t*)(lds + 16384);
    LAS bf16_t* Ct = (LAS bf16_t*)(lds + 16384 + 66048);
    LAS bf16_t* Y = (LAS bf16_t*)(lds + 16384 + 66048 + 33792);
    s5_load_u(proj, b, ch, U, tid);
    const int gl = tid >> 7, r = (tid >> 6) & 1, p = tid & 63;
    const int lane = tid & 63, w = tid >> 6, fr = lane & 15, fq = lane >> 4;
    for (int qd = 0; qd < 4; ++qd) {
        __syncthreads();
#pragma unroll
        for (int i = 0; i < 16; ++i) { const int id = tid + NTHR * i, pp = id & 63, cc = (id >> 6) & 15, gg = (id >> 10) & 3, rr = id >> 12;
            const size_t ci = (size_t)((rr * 16 + qd * 4 + gg) * 16 + cc) * 64 + pp;
            *(LAS unsigned*)(Ct + (gg * 16 + cc) * CS + rr * 128 + pp * 2) = pk2(cre[ci], -cim[ci]); }
        s5_bu_tiles(U, BT, X, XS, qd, w, fr, fq);
        __syncthreads();
        const int g = qd * 4 + gl;
        {
            const f32x4 t0 = *(const f32x4*)(tab + (size_t)((r * 16 + g) * 64 + p) * 8); const float lr_ = t0[0], li_ = t0[1];
            const float2 cin = ((const float2*)CIN)[(size_t)(((b * S5NCH + ch) * 16 + g) * 2 + r) * 64 + p];
            float xr = cin.x, xi = cin.y;
            LAS bf16_t* xq = X + gl * 256 + r * 128 + p * 2;
#pragma unroll 8
            for (int s = 0; s < S5T; ++s) {
                const int si = r ? (S5T - 1 - s) : s;
                const unsigned wv = *(const LAS unsigned*)(xq + si * XS);
                const float nr = fmaf(lr_, xr, fmaf(-li_, xi, bflo(wv))), ni = fmaf(lr_, xi, fmaf(li_, xr, bfhi(wv)));
                xr = nr; xi = ni;
                *(LAS unsigned*)(xq + si * XS) = pk2(xr, xi);
            }
        }
        __syncthreads();
        {
            const int wg = w >> 1, mt = w & 1, gq = qd * 4 + wg;
            const LAS bf16_t* ap = X + (mt * 16 + fr) * XS + wg * 256 + fq * 8;
            const LAS bf16_t* bp = Ct + (wg * 16 + fr) * CS + fq * 8;
            f32x4 acc = {0.f, 0.f, 0.f, 0.f};
#pragma unroll
            for (int ks = 0; ks < 8; ++ks) acc = mfma16(*(const LAS bf16x8*)(ap + ks * 32), *(const LAS bf16x8*)(bp + ks * 32), acc);
            const int chn = gq * 16 + fr; const float dv = dvec[chn];
#pragma unroll
            for (int jj = 0; jj < 4; ++jj) { const int s = mt * 16 + fq * 4 + jj;
                const float uu = __uint_as_float(((unsigned)U[s * 256 + chn]) << 16);
                const float yv = acc[jj] + dv * uu;
                const float t = 0.7978845608028654f * (yv + 0.044715f * yv * yv * yv);
                const float gel = yv * (1.f - 1.f / (1.f + __expf(2.f * t)));
                Y[s * YS + chn] = (bf16_t)f2bf(gel); }
        }
    }
    __syncthreads();
    {
        const int mt = w & 1;
        bf16x8 af[8];
#pragma unroll
        for (int ks = 0; ks < 8; ++ks) af[ks] = *(const LAS bf16x8*)(Y + (mt * 16 + fr) * YS + ks * 32 + fq * 8);
#pragma unroll
        for (int i = 0; i < 4; ++i) {
            const int nt = (w >> 1) * 4 + i, n = nt * 16 + fr;
            const bf16_t* bp = wgluT + (size_t)n * 256 + fq * 8;
            f32x4 acc = {0.f, 0.f, 0.f, 0.f};
#pragma unroll
            for (int ks = 0; ks < 8; ++ks) acc = mfma16(af[ks], *(const bf16x8*)(bp + ks * 32), acc);
            const float bg = bglu[n];
#pragma unroll
            for (int jj = 0; jj < 4; ++jj) { const int s = mt * 16 + fq * 4 + jj;
                const float yv = __uint_as_float(((unsigned)Y[s * YS + n]) << 16);
                const float outv = yv / (1.f + __expf(-(acc[jj] + bg)));
                mix[(size_t)(b * SEQ + ch * S5T + s) * DM + 256 + n] = (bf16_t)f2bf(outv); }
        }
    }
    __syncthreads();
}

__device__ __forceinline__ void phase_scan(const Args& a, int l, int tid) {
    unsigned char* ws = a.ws;
    const int lane = tid & 63, wave = tid >> 6;
    {
        const float* tab = (const float*)(ws + WS_S5TAB) + (size_t)l * 2048 * 8;
        const float2* __restrict__ E = (const float2*)(ws + WS_S5E); float2* __restrict__ C = (float2*)(ws + WS_S5C);
        for (int wv = blockIdx.x; wv < 128; wv += gridDim.x) if (wave == 0) {
            const int p = lane, r = wv & 1, g = (wv >> 1) & 15, b = wv >> 5;
            const float* tp = tab + (size_t)((r * 16 + g) * 64 + p) * 8;
            const float tr = tp[4], ti = tp[5];
            float xr = 0.f, xi = 0.f;
            for (int k0 = 0; k0 < S5NCH; k0 += 32) {
                float2 e[32];
#pragma unroll
                for (int k = 0; k < 32; ++k) { const int ch = r ? (S5NCH - 1 - (k0 + k)) : (k0 + k); e[k] = E[(size_t)(((b * S5NCH + ch) * 16 + g) * 2 + r) * 64 + p]; }
#pragma unroll
                for (int k = 0; k < 32; ++k) { const int ch = r ? (S5NCH - 1 - (k0 + k)) : (k0 + k);
                    float2 cv; cv.x = xr; cv.y = xi; C[(size_t)(((b * S5NCH + ch) * 16 + g) * 2 + r) * 64 + p] = cv;
                    const float nr = fmaf(tr, xr, fmaf(-ti, xi, e[k].x)), ni = fmaf(tr, xi, fmaf(ti, xr, e[k].y));
                    xr = nr; xi = ni; }
            }
        }
    }
    {
        const float* theta = a.in[4] + l * 8;
        const float* __restrict__ kvf = (const float*)(ws + WS_KVF); const float* __restrict__ kvb = (const float*)(ws + WS_KVB);
        float* __restrict__ stf = (float*)(ws + WS_STF); float* __restrict__ stb = (float*)(ws + WS_STB);
        for (int gid = blockIdx.x * NTHR + tid; gid < 131072; gid += gridDim.x * NTHR) {
            const int el = gid & 4095, dir = (gid >> 12) & 1, h = (gid >> 13) & 3, b = gid >> 15;
            const float dec = __expf(log_sigmoid(theta[dir * 4 + h]) * 128.f);
            const float* __restrict__ kv = dir ? kvb : kvf; float* __restrict__ st = dir ? stb : stf;
            float s = 0.f;
            for (int c0 = 0; c0 < 32; c0 += 16) {
                float kk[16];
#pragma unroll
                for (int k = 0; k < 16; ++k) { const int c = dir ? (31 - (c0 + k)) : (c0 + k); kk[k] = kv[(size_t)((b * 32 + c) * 4 + h) * 4096 + el]; }
#pragma unroll
                for (int k = 0; k < 16; ++k) { const int c = dir ? (31 - (c0 + k)) : (c0 + k); st[(size_t)((b * 32 + c) * 4 + h) * 4096 + el] = s; s = fmaf(dec, s, kk[k]); }
            }
        }
    }
}

__device__ __forceinline__ void phase_ln1_router(const Args& a, int l, LAS unsigned char* lds, int tid) {
    unsigned char* ws = a.ws;
    const int lane = tid & 63, wave = tid >> 6;
    LAS float* rwT = (LAS float*)lds;
    const float* rw = a.in[19] + (size_t)l * DM * NE;
    for (int i = tid; i < DM * NE; i += NTHR) rwT[(i & 15) * DM + (i >> 4)] = rw[i];
    __syncthreads();
    const float* pre = (const float*)(ws + WS_RA);
    float* afft = (float*)(ws + WS_AFFT);
    const int gw = blockIdx.x * NWAVES + wave, NGW = gridDim.x * NWAVES;
    const bool b5 = (lane & 32) != 0, b4 = (lane & 16) != 0, b3 = (lane & 8) != 0, b2 = (lane & 4) != 0;
    f32x4 vn[4];
    if (gw < MTOK) {
#pragma unroll
        for (int j = 0; j < 4; ++j) vn[j] = ((const f32x4*)(pre + (size_t)gw * DM))[lane + 64 * j];
    }
    for (int m = gw; m < MTOK; m += NGW) {
        f32x4 v[4];
#pragma unroll
        for (int j = 0; j < 4; ++j) v[j] = vn[j];
        if (m + NGW < MTOK) {
#pragma unroll
            for (int j = 0; j < 4; ++j) vn[j] = ((const f32x4*)(pre + (size_t)(m + NGW) * DM))[lane + 64 * j];
        }
        ln_rows4(v, a.in[17] + l * DM, a.in[18] + l * DM, lane);
        store_row(v, (float*)(ws + WS_H32) + (size_t)m * DM, (bf16_t*)(ws + WS_HBF) + (size_t)m * DM, lane);
        float sp[16];
#pragma unroll
        for (int eg = 0; eg < 4; ++eg) {
#pragma unroll
            for (int ee = 0; ee < 4; ++ee) { const int e = eg * 4 + ee; float s = 0.f;
#pragma unroll
                for (int j = 0; j < 4; ++j) { const f32x4 wv = *(const LAS f32x4*)(rwT + e * DM + 256 * j + 4 * lane); s += (v[j][0] * wv[0] + v[j][1] * wv[1]) + (v[j][2] * wv[2] + v[j][3] * wv[3]); }
                sp[e] = s; }
            asm volatile("" ::: "memory");
        }
        float t8[8], t4[4], t2[2];
#pragma unroll
        for (int i = 0; i < 8; ++i) { const float snd = b5 ? sp[i] : sp[i + 8], kp = b5 ? sp[i + 8] : sp[i]; t8[i] = kp + __shfl_xor(snd, 32); }
#pragma unroll
        for (int i = 0; i < 4; ++i) { const float snd = b4 ? t8[i] : t8[i + 4], kp = b4 ? t8[i + 4] : t8[i]; t4[i] = kp + __shfl_xor(snd, 16); }
#pragma unroll
        for (int i = 0; i < 2; ++i) { const float snd = b3 ? t4[i] : t4[i + 2], kp = b3 ? t4[i + 2] : t4[i]; t2[i] = kp + __shfl_xor(snd, 8); }
        float lgt; { const float snd = b2 ? t2[0] : t2[1], kp = b2 ? t2[1] : t2[0]; lgt = kp + __shfl_xor(snd, 4); }
        lgt += __shfl_xor(lgt, 1); lgt += __shfl_xor(lgt, 2);
        float mx = lgt;
#pragma unroll
        for (int o = 4; o < 64; o <<= 1) mx = fmaxf(mx, __shfl_xor(mx, o));
        const float ex = expf(lgt - mx);
        float sum = ex;
#pragma unroll
        for (int o = 4; o < 64; o <<= 1) sum += __shfl_xor(sum, o);
        const int b = m / SEQ, t = m % SEQ;
        if ((lane & 3) == 0) afft[(size_t)(b * NE + (lane >> 2)) * SEQ + t] = ex / sum;
    }
    __syncthreads();
}

__device__ __forceinline__ void select_item(int item, const Args& a, LAS unsigned char* lds, int tid) {
    unsigned char* ws = a.ws;
    const int q = item & 3, e = (item >> 2) & 15, b = item >> 6;
    const int lane = tid & 63, wave = tid >> 6;
    LAS unsigned* red = (LAS unsigned*)lds;
    LAS int* sel = (LAS int*)(lds + 1024);
    const float* av = (const float*)(ws + WS_AFFT) + (size_t)(b * NE + e) * SEQ + tid * 8;
    const f32x4 va = *(const f32x4*)av, vb = *(const f32x4*)(av + 4);
    unsigned v[8] = {__float_as_uint(va[0]), __float_as_uint(va[1]), __float_as_uint(va[2]), __float_as_uint(va[3]), __float_as_uint(vb[0]), __float_as_uint(vb[1]), __float_as_uint(vb[2]), __float_as_uint(vb[3])};
    unsigned x = 0u;
    for (int bit = 30; bit >= 0; --bit) {
        const unsigned cand = x | (1u << bit);
        unsigned cnt = 0u;
#pragma unroll
        for (int j = 0; j < 8; ++j) cnt += (unsigned)__popcll(__ballot(v[j] >= cand));
        LAS unsigned* rb = red + (bit & 1) * 8;
        if (lane == 0) rb[wave] = cnt;
        __syncthreads();
        unsigned tot = 0u;
#pragma unroll
        for (int k = 0; k < 8; ++k) tot += rb[k];
        if (tot >= (unsigned)CAP) x = cand;
    }
    unsigned mycnt = 0u;
#pragma unroll
    for (int j = 0; j < 8; ++j) mycnt += (v[j] > x ? 1u : 0u) + (v[j] == x ? 0x10000u : 0u);
    unsigned inc = mycnt;
#pragma unroll
    for (int o = 1; o < 64; o <<= 1) { const unsigned t = __shfl_up(inc, o); if (lane >= o) inc += t; }
    LAS unsigned* wsum = red + 64;
    __syncthreads();
    if (lane == 63) wsum[wave] = inc;
    __syncthreads();
    unsigned wpre = 0u, total = 0u;
#pragma unroll
    for (int k = 0; k < 8; ++k) { const unsigned t = wsum[k]; if (k < wave) wpre += t; total += t; }
    const unsigned excl = wpre + inc - mycnt;
    unsigned gtb = excl & 0xffffu, eqb = excl >> 16;
    const unsigned need = (unsigned)CAP - (total & 0xffffu);
    const int rowbase = (e * NB + b) * CAP;
    int* idx = (int*)(ws + WS_IDX); float* gate = (float*)(ws + WS_GATE); int* slotmap = (int*)(ws + WS_SLOT);
    const bool own_tok = ((tid >> 7) == q);
#pragma unroll
    for (int j = 0; j < 8; ++j) {
        const bool isgt = v[j] > x, iseq = v[j] == x;
        const bool issel = isgt || (iseq && eqb < need);
        const unsigned slot = gtb + (eqb < need ? eqb : need);
        const int tok = b * SEQ + tid * 8 + j;
        if (issel && (int)(slot >> 7) == q) { idx[rowbase + slot] = tok; gate[rowbase + slot] = __uint_as_float(v[j]); sel[slot & 127] = tok; }
        if (own_tok) slotmap[(size_t)tok * NE + e] = issel ? (int)(rowbase + slot) : -1;
        gtb += isgt ? 1u : 0u; eqb += iseq ? 1u : 0u;
    }
    __syncthreads();
    const bf16_t* hbf = (const bf16_t*)(ws + WS_HBF); bf16_t* xs = (bf16_t*)(ws + WS_RA);
#pragma unroll
    for (int hb = 0; hb < 2; ++hb) {
        u32x4 d0[8], d1[8];
#pragma unroll
        for (int i = 0; i < 8; ++i) { const int tok = sel[wave + 8 * (hb * 8 + i)]; const u32x4* src = (const u32x4*)(hbf + (size_t)tok * DM); d0[i] = src[lane]; d1[i] = src[lane + 64]; }
#pragma unroll
        for (int i = 0; i < 8; ++i) { u32x4* dst = (u32x4*)(xs + (size_t)(rowbase + q * 128 + wave + 8 * (hb * 8 + i)) * DM); dst[lane] = d0[i]; dst[lane + 64] = d1[i]; }
    }
    __syncthreads();
}

__device__ __forceinline__ void phase_ln2(const Args& a, int l, int tid) {
    unsigned char* ws = a.ws;
    const int lane = tid & 63, wave = tid >> 6;
    const int gw = blockIdx.x * NWAVES + wave, NGW = gridDim.x * NWAVES;
    const float* h32 = (const float*)(ws + WS_H32); const int* slotmap = (const int*)(ws + WS_SLOT); const bf16_t* contrib = (const bf16_t*)(ws + WS_RB);
    const bool last = (l == 1);
    f32x4 vn[4]; int slot_n = -1;
    if (gw < MTOK) {
#pragma unroll
        for (int j = 0; j < 4; ++j) vn[j] = ((const f32x4*)(h32 + (size_t)gw * DM))[lane + 64 * j];
        slot_n = slotmap[(size_t)gw * NE + (lane & 15)];
    }
    for (int m = gw; m < MTOK; m += NGW) {
        f32x4 v[4];
#pragma unroll
        for (int j = 0; j < 4; ++j) v[j] = vn[j] * ALPHA;
        const int myslot = slot_n;
        unsigned bal = (unsigned)(__ballot(myslot >= 0) & 0xffffull);
        int r0 = -1, r1 = -1, r2 = -1, r3 = -1;
        if (bal) { r0 = __shfl(myslot, __builtin_ctz(bal)); bal &= bal - 1; }
        if (bal) { r1 = __shfl(myslot, __builtin_ctz(bal)); bal &= bal - 1; }
        if (bal) { r2 = __shfl(myslot, __builtin_ctz(bal)); bal &= bal - 1; }
        if (bal) { r3 = __shfl(myslot, __builtin_ctz(bal)); bal &= bal - 1; }
        u32x2 c0[4], c1[4], c2[4], c3[4];
#pragma unroll
        for (int j = 0; j < 4; ++j) { c0[j] = (u32x2){0u, 0u}; c1[j] = c0[j]; c2[j] = c0[j]; c3[j] = c0[j]; }
        if (r0 >= 0) {
#pragma unroll
            for (int j = 0; j < 4; ++j) c0[j] = ((const u32x2*)(contrib + (size_t)r0 * DM))[lane + 64 * j]; }
        if (r1 >= 0) {
#pragma unroll
            for (int j = 0; j < 4; ++j) c1[j] = ((const u32x2*)(contrib + (size_t)r1 * DM))[lane + 64 * j]; }
        if (r2 >= 0) {
#pragma unroll
            for (int j = 0; j < 4; ++j) c2[j] = ((const u32x2*)(contrib + (size_t)r2 * DM))[lane + 64 * j]; }
        if (r3 >= 0) {
#pragma unroll
            for (int j = 0; j < 4; ++j) c3[j] = ((const u32x2*)(contrib + (size_t)r3 * DM))[lane + 64 * j]; }
        if (m + NGW < MTOK) {
#pragma unroll
            for (int j = 0; j < 4; ++j) vn[j] = ((const f32x4*)(h32 + (size_t)(m + NGW) * DM))[lane + 64 * j];
            slot_n = slotmap[(size_t)(m + NGW) * NE + (lane & 15)];
        }
#pragma unroll
        for (int j = 0; j < 4; ++j) {
            v[j][0] += bflo(c0[j].x); v[j][1] += bfhi(c0[j].x); v[j][2] += bflo(c0[j].y); v[j][3] += bfhi(c0[j].y);
            v[j][0] += bflo(c1[j].x); v[j][1] += bfhi(c1[j].x); v[j][2] += bflo(c1[j].y); v[j][3] += bfhi(c1[j].y);
            v[j][0] += bflo(c2[j].x); v[j][1] += bfhi(c2[j].x); v[j][2] += bflo(c2[j].y); v[j][3] += bfhi(c2[j].y);
            v[j][0] += bflo(c3[j].x); v[j][1] += bfhi(c3[j].x); v[j][2] += bflo(c3[j].y); v[j][3] += bfhi(c3[j].y);
        }
        while (bal) {
            const int row = __shfl(myslot, __builtin_ctz(bal)); bal &= bal - 1;
            const u32x2* cr = (const u32x2*)(contrib + (size_t)row * DM);
#pragma unroll
            for (int j = 0; j < 4; ++j) { const u32x2 wv = cr[lane + 64 * j]; v[j][0] += bflo(wv.x); v[j][1] += bfhi(wv.x); v[j][2] += bflo(wv.y); v[j][3] += bfhi(wv.y); }
        }
        ln_rows4(v, a.in[23] + l * DM, a.in[24] + l * DM, lane);
        if (last) store_row(v, a.out + (size_t)m * DM, nullptr, lane);
        else store_row(v, (float*)(ws + WS_H32) + (size_t)m * DM, (bf16_t*)(ws + WS_HBF) + (size_t)m * DM, lane);
    }
}

typedef __attribute__((address_space(1))) unsigned gu32;
#define RLX_AGENT __ATOMIC_RELAXED, __HIP_MEMORY_SCOPE_AGENT
#define XB_TMO      128
#define XB_XCNT(j)  (256  + 64 * (j))
#define XB_XSUB(j)  (1280 + 64 * (j))
#define XB_XGEN(j)  (2304 + 64 * (j))
#define XB_TOP      3328
#define XB_TOPGEN   3392
#define XCD_BAR_WORDS 3456
#define XB_SPIN_CAP (1u << 18)

__device__ __forceinline__ unsigned xb_ld(unsigned* p)              { return __hip_atomic_load(p, __ATOMIC_RELAXED, __HIP_MEMORY_SCOPE_AGENT); }
__device__ __forceinline__ unsigned xb_add(unsigned* p, unsigned v) { return __hip_atomic_fetch_add(p, v, __ATOMIC_RELAXED, __HIP_MEMORY_SCOPE_AGENT); }
__device__ __forceinline__ unsigned xb_xcc_id() { return (unsigned)__builtin_amdgcn_s_getreg((3 << 11) | 20) & 0xFu; }
#define XB_SPIN(cond, bar) do { unsigned _sp = 0; while (cond) { __builtin_amdgcn_s_sleep(1); \
    if ((++_sp & 255u) == 0u) { if (xb_ld(&(bar)[XB_TMO])) break; if (_sp > XB_SPIN_CAP) { atomicAdd(&(bar)[XB_TMO], 1u); break; } } } } while (0)

struct XcdBarrier {
    unsigned* bar; unsigned x;
    volatile LAS unsigned* st;
};

__device__ __forceinline__ XcdBarrier xcd_barrier_post(unsigned* bar, volatile LAS unsigned* st) {
    XcdBarrier b; b.bar = bar; b.x = xb_xcc_id(); b.st = st;
    if (threadIdx.x == 0) (void)xb_add(&bar[XB_XCNT(b.x)], 1u);
    return b;
}
__device__ __forceinline__ void xcd_barrier_complete(unsigned* bar, unsigned x, unsigned& nloc, unsigned& nx) {
    const unsigned G = gridDim.x * gridDim.y * gridDim.z;
    unsigned sum, cnt, mine, sp = 0u;
    for (;;) {
        sum = 0u; cnt = 0u; mine = 0u;
#pragma unroll
        for (unsigned j = 0; j < 16; ++j) { const unsigned c = xb_ld(&bar[XB_XCNT(j)]); sum += c; cnt += (c > 0u) ? 1u : 0u; mine = (j == x) ? c : mine; }
        if (sum == G) break;
        __builtin_amdgcn_s_sleep(1);
        if ((++sp & 255u) == 0u) { if (xb_ld(&bar[XB_TMO])) break; if (sp > XB_SPIN_CAP) { atomicAdd(&bar[XB_TMO], 1u); break; } }
    }
    nloc = mine > 0u ? mine : 1u; nx = cnt > 0u ? cnt : 1u;
}

__device__ __forceinline__ void xcd_barrier(const XcdBarrier& b) {
    asm volatile("s_waitcnt vmcnt(0)" ::: "memory");
    __syncthreads();
    if (threadIdx.x == 0) {
        unsigned* bar = b.bar;
        __builtin_amdgcn_s_waitcnt(0);
        unsigned nloc = b.st[0], nx = b.st[1];
        if (nloc == 0u) { xcd_barrier_complete(bar, b.x, nloc, nx); b.st[0] = nloc; b.st[1] = nx; }
        const unsigned old = xb_add(&bar[XB_XSUB(b.x)], 1u);
        const unsigned gen = old / nloc;
        if (old + 1u == (gen + 1u) * nloc) {
            __builtin_amdgcn_fence(__ATOMIC_RELEASE, "agent");
            asm volatile("s_waitcnt vmcnt(0)" ::: "memory");
            const unsigned og = xb_add(&bar[XB_TOP], 1u);
            const unsigned tg = og / nx;
            if (og + 1u == (tg + 1u) * nx) xb_add(&bar[XB_TOPGEN], 1u);
            else XB_SPIN(xb_ld(&bar[XB_TOPGEN]) == tg, bar);
            __builtin_amdgcn_fence(__ATOMIC_ACQUIRE, "agent");
            xb_add(&bar[XB_XGEN(b.x)], 1u);
            asm volatile("s_waitcnt vmcnt(0)" ::: "memory");
        } else {
            XB_SPIN(xb_ld(&bar[XB_XGEN(b.x)]) == gen, bar);
            __builtin_amdgcn_fence(__ATOMIC_ACQUIRE, "agent");
            asm volatile("s_waitcnt vmcnt(0)" ::: "memory");
        }
    }
    __syncthreads();
}

constexpr int NPHASES = 21;
#ifndef REP_MASK
#define REP_MASK 0
#endif
template <int L, int K>
__device__ __forceinline__ void run_phase(const Args& a, LAS unsigned char* lds, int tid) {
    unsigned char* ws = a.ws;
    constexpr int l = L;
    bf16_t* proj = (bf16_t*)(ws + WS_RA); bf16_t* mix = (bf16_t*)(ws + WS_RB);
    if constexpr (K == 0) {
        pg8::Gemm g{(const bf16_t*)(ws + WS_HBF), (const bf16_t*)(ws + WS_WIN) + (size_t)l * DIN * DM, MTOK, DIN, DM};
        pg8::StaticOrder S; S.init(MTOK, DIN, (int)gridDim.x, (int)blockIdx.x);
        pg8::EpiStoreBf16 E{proj, DIN};
        pg8::gemm_phase<pg8::EpiStoreBf16, pg8::StaticOrder, true, true>(lds, g, S, E);
    } else if constexpr (K == 1) {
        const float* tab = (const float*)(ws + WS_S5TAB) + (size_t)l * 2048 * 8;
        constexpr int XB = ((REP_MASK >> 11) & 1) ? 512 : ((REP_MASK >> 12) & 1) ? 256 : ((REP_MASK >> 13) & 1) ? 512 : 0, XOFF = ((REP_MASK >> 11) & 1) ? 0 : ((REP_MASK >> 12) & 1) ? 512 : 768;
        for (int it0 = blockIdx.x; it0 < 1280 + XB; it0 += gridDim.x) {
            const int it = it0 < 1280 ? it0 : it0 - 1280 + XOFF;
            if (it < 512) s5e_item(it, proj, tab, (const bf16_t*)(ws + WS_S5BT) + (size_t)l * 4096 * 32, (float*)(ws + WS_S5E), lds, tid);
            else if (it < 768) attn_item(it - 512, proj, mix, a.in[15] + l * 8, lds, tid);
            else retkv_item(it - 768, proj, (float*)(ws + WS_KVF), (float*)(ws + WS_KVB), a.in[4] + l * 8, lds, tid);
        }
    } else if constexpr (K == 2) {
        phase_scan(a, l, tid);
    } else if constexpr (K == 3) {
        const float* tab = (const float*)(ws + WS_S5TAB) + (size_t)l * 2048 * 8;
        constexpr int XD = ((REP_MASK >> 14) & 3) ? 512 : 0, XOFD = ((REP_MASK >> 14) & 1) ? 0 : 512;
        for (int it0 = blockIdx.x; it0 < 1024 + XD; it0 += gridDim.x) {
            const int it = it0 < 1024 ? it0 : it0 - 1024 + XOFD;
            if (it < 512) s5out_item(it, proj, tab, (const bf16_t*)(ws + WS_S5BT) + (size_t)l * 4096 * 32, a.in[10] + (size_t)l * 32768, a.in[11] + (size_t)l * 32768, a.in[12] + l * 256,
                                     (const bf16_t*)(ws + WS_WGLU) + (size_t)l * 65536, a.in[14] + l * 256, (const float*)(ws + WS_S5C), mix, lds, tid);
            else retout_item(it - 512, proj, (const float*)(ws + WS_STF), (const float*)(ws + WS_STB), mix, a.in[4] + l * 8, lds, tid);
        }
    } else if constexpr (K == 4) {
        pg8::Gemm g{mix, (const bf16_t*)(ws + WS_WOUT) + (size_t)l * DM * DM, MTOK, DM, DM};
        pg8::StaticOrder S; S.init(MTOK, DM, (int)gridDim.x, (int)blockIdx.x);
        pg8::EpiResF32 E{(const float*)(ws + WS_H32), (float*)(ws + WS_RA), DM, ALPHA};
        pg8::gemm_phase<pg8::EpiResF32, pg8::StaticOrder, true, true>(lds, g, S, E);
    } else if constexpr (K == 5) {
        phase_ln1_router(a, l, lds, tid);
    } else if constexpr (K == 6) {
        for (int it = blockIdx.x; it < 256; it += gridDim.x) select_item(it, a, lds, tid);
    } else if constexpr (K == 7) {
        pg8::Gemm g{(const bf16_t*)(ws + WS_RA), (const bf16_t*)(ws + WS_WGU) + (size_t)l * NE * 2 * FF * DM, NROWX, NE * 2 * FF, DM};
        pg8::GroupedOrder S; S.init(16, (int)gridDim.x, (int)blockIdx.x);
        pg8::EpiSwiGLU E{(bf16_t*)(ws + WS_HDN), FF, 16};
        pg8::gemm_phase<pg8::EpiSwiGLU, pg8::GroupedOrder, true, true>(lds, g, S, E);
    } else if constexpr (K == 8) {
        pg8::Gemm g{(const bf16_t*)(ws + WS_HDN), (const bf16_t*)(ws + WS_WD) + (size_t)l * NE * DM * FF, NROWX, NE * DM, FF};
        pg8::GroupedOrder S; S.init(4, (int)gridDim.x, (int)blockIdx.x);
        pg8::EpiScaleRow E{(bf16_t*)(ws + WS_RB), DM, 4, (const float*)(ws + WS_GATE)};
        pg8::gemm_phase<pg8::EpiScaleRow, pg8::GroupedOrder, true, true>(lds, g, S, E);
    } else {
        phase_ln2(a, l, tid);
    }
}
__global__ void __launch_bounds__(NTHR, 2) fwd_kernel(Args a) {
    extern __shared__ __attribute__((aligned(16))) unsigned char lds_raw[];
    LAS unsigned char* lds = (LAS unsigned char*)lds_raw;
    cg::grid_group grid = cg::this_grid();
    const int lo = a.ph_lo, hi = a.ph_hi;
    volatile LAS unsigned* bst = (volatile LAS unsigned*)(lds + LDS_BYTES - 64);
    if (threadIdx.x < 16) bst[threadIdx.x] = 0u;
    __syncthreads();
    XcdBarrier bar = xcd_barrier_post((unsigned*)(a.ws + WS_BAR), bst);
    if (hi > 1000) grid.sync();
#define PH_BEGIN(ph) if (lo <= (ph) && (ph) < hi) { int tid = threadIdx.x; asm volatile("" : "+v"(tid));
#define PH_END(ph) if ((ph) + 1 < hi) xcd_barrier(bar); }
    PH_BEGIN(0) for (int rep = 0; rep <= ((REP_MASK >> 10) & 1); ++rep) phase_p0(a, lds, tid); PH_END(0)
#define LAYER(L) \
    PH_BEGIN(1 + 10 * L + 0) for (int rep = 0; rep <= ((REP_MASK >> 0) & 1); ++rep) run_phase<L, 0>(a, lds, tid); PH_END(1 + 10 * L + 0) \
    PH_BEGIN(1 + 10 * L + 1) for (int rep = 0; rep <= ((REP_MASK >> 1) & 1); ++rep) run_phase<L, 1>(a, lds, tid); PH_END(1 + 10 * L + 1) \
    PH_BEGIN(1 + 10 * L + 2) for (int rep = 0; rep <= ((REP_MASK >> 2) & 1); ++rep) run_phase<L, 2>(a, lds, tid); PH_END(1 + 10 * L + 2) \
    PH_BEGIN(1 + 10 * L + 3) for (int rep = 0; rep <= ((REP_MASK >> 3) & 1); ++rep) run_phase<L, 3>(a, lds, tid); PH_END(1 + 10 * L + 3) \
    PH_BEGIN(1 + 10 * L + 4) for (int rep = 0; rep <= ((REP_MASK >> 4) & 1); ++rep) run_phase<L, 4>(a, lds, tid); PH_END(1 + 10 * L + 4) \
    PH_BEGIN(1 + 10 * L + 5) for (int rep = 0; rep <= ((REP_MASK >> 5) & 1); ++rep) run_phase<L, 5>(a, lds, tid); PH_END(1 + 10 * L + 5) \
    PH_BEGIN(1 + 10 * L + 6) for (int rep = 0; rep <= ((REP_MASK >> 6) & 1); ++rep) run_phase<L, 6>(a, lds, tid); PH_END(1 + 10 * L + 6) \
    PH_BEGIN(1 + 10 * L + 7) for (int rep = 0; rep <= ((REP_MASK >> 7) & 1); ++rep) run_phase<L, 7>(a, lds, tid); PH_END(1 + 10 * L + 7) \
    PH_BEGIN(1 + 10 * L + 8) for (int rep = 0; rep <= ((REP_MASK >> 8) & 1); ++rep) run_phase<L, 8>(a, lds, tid); PH_END(1 + 10 * L + 8) \
    PH_BEGIN(1 + 10 * L + 9) for (int rep = 0; rep <= ((REP_MASK >> 9) & 1); ++rep) run_phase<L, 9>(a, lds, tid); PH_END(1 + 10 * L + 9)
    LAYER(0)
    LAYER(1)
#undef LAYER
#undef PH_BEGIN
#undef PH_END
}

#ifndef ONE_LAUNCH
#define ONE_LAUNCH 1
#endif
extern "C" void kernel_launch(void* const* d_in, const int* in_sizes, int n_in, void* d_out, int out_size, void* d_ws, size_t ws_size, hipStream_t stream) {
    static int grid = 0;
    if (grid == 0) {
        if (n_in != 25 || ws_size < WS_END) { fprintf(stderr, "kernel_launch: unexpected problem (n_in %d, ws %zu)\n", n_in, ws_size); grid = -1; return; }
        int dev = 0, cus = 0, per_cu = 0;
        (void)hipGetDevice(&dev);
        (void)hipDeviceGetAttribute(&cus, hipDeviceAttributeMultiprocessorCount, dev);
        if (hipFuncSetAttribute((const void*)fwd_kernel, hipFuncAttributeMaxDynamicSharedMemorySize, LDS_BYTES) != hipSuccess) { fprintf(stderr, "kernel_launch: hipFuncSetAttribute failed\n"); grid = -1; return; }
        if (hipOccupancyMaxActiveBlocksPerMultiprocessor(&per_cu, (const void*)fwd_kernel, NTHR, LDS_BYTES) != hipSuccess || per_cu < 1) { fprintf(stderr, "kernel_launch: occupancy query says %d\n", per_cu); per_cu = 1; }
        (void)hipGetLastError();
        if (cus <= 0) cus = 256;
        grid = cus * per_cu;
    }
    if (grid < 0) return;
    Args a{};
    for (int i = 0; i < 25; ++i) a.in[i] = (const float*)d_in[i];
    a.out = (float*)d_out; a.ws = (unsigned char*)d_ws;
#if ONE_LAUNCH
    if (hipMemsetAsync((char*)d_ws + WS_BAR, 0, 16384, stream) != hipSuccess) { fprintf(stderr, "kernel_launch: memset failed\n"); return; }
    a.ph_lo = 0; a.ph_hi = NPHASES;
    void* args[] = {&a};
    hipError_t e = hipLaunchCooperativeKernel((const void*)fwd_kernel, dim3(grid), dim3(NTHR), args, LDS_BYTES, stream);
    if (e != hipSuccess) fprintf(stderr, "kernel_launch: cooperative launch failed: %s (grid %d)\n", hipGetErrorString(e), grid);
#else
    for (int ph = 0; ph < NPHASES; ++ph) {
        a.ph_lo = ph; a.ph_hi = ph + 1;
        hipLaunchKernelGGL(fwd_kernel, dim3(grid), dim3(NTHR), LDS_BYTES, stream, a);
    }
#endif
}
```

```cpp
#include <hip/hip_runtime.h>
#include <hip/hip_cooperative_groups.h>
#include <cstdio>
#include <cstdint>
namespace cg = cooperative_groups;
namespace pg8 {
#define PG8_LAS __attribute__((address_space(3)))
typedef unsigned short bf16_t;
typedef short bf16x8 __attribute__((ext_vector_type(8)));
typedef float f32x4 __attribute__((ext_vector_type(4)));
typedef unsigned u32x4 __attribute__((ext_vector_type(4)));
constexpr int BM = 256, BK = 64, HALF = 128, HTB = HALF * BK * 2  , STAGE_BYTES = 8 * HTB, NXCD = 8, WGM = 8;

__host__ __device__ __forceinline__ int lds_byte(int r, int c) { const int st = (r >> 4) * 2 + (c >> 5), rr = r & 15, cc = c & 31, ob = rr * 64 + cc * 2; return st * 1024 + (ob ^ (((ob >> 9) & 1) << 5)); }
__host__ __device__ __forceinline__ void stage_rc(int b, int& R, int& C) { const int st = b / 1024, sb = b % 1024, swz = sb ^ (((sb >> 9) & 1) << 5); R = (st >> 1) * 16 + swz / 64; C = (st & 1) * 32 + (swz % 64) / 2; }
__host__ __device__ __forceinline__ int perm32(int rho) { const int n = rho >> 4, i = rho & 15; return 8 * (i >> 2) + 4 * n + (i & 3); }

struct Unit { int pm, pn; };
struct Gemm { const bf16_t* A; const bf16_t* Bt; int M, N, K; };

struct StaticOrder {
    int nM, nN, nwg, G, c;
    __host__ __device__ void init(int M, int N, int G_, int c_) { nM = M / BM; nN = N / BM; nwg = nM * nN; G = G_; c = c_; }
    __host__ __device__ bool next(int i, Unit& u) const {
        const long L = (long)i * G + c; if (L >= nwg) return false;
        int wgid = (int)L; { const int q = nwg / NXCD, r = nwg % NXCD, xcd = wgid % NXCD, off = wgid / NXCD; wgid = (xcd < r ? xcd * (q + 1) : r * (q + 1) + (xcd - r) * q) + off; }
        const int nig = WGM * nN, gid = wgid / nig, fm = gid * WGM, gsz = (nM - fm) < WGM ? (nM - fm) : WGM;
        u.pm = fm + ((wgid % nig) % gsz); u.pn = (wgid % nig) / gsz; return true;
    }
    __device__ __forceinline__ void a_ready(const Unit&) const {}
    __device__ __forceinline__ void done(const Unit&) const {}
};

__device__ __forceinline__ unsigned cvt_pk_bf16(float lo, float hi) { unsigned r; asm volatile("v_cvt_pk_bf16_f32 %0, %1, %2" : "=v"(r) : "v"(lo), "v"(hi)); return r; }
typedef unsigned u32x2 __attribute__((ext_vector_type(2)));

struct GroupedOrder {
    int upe, nNe, nwg, G, c;
    __host__ __device__ void init(int nNe_, int G_, int c_) { nNe = nNe_; upe = 8 * nNe_; nwg = 16 * upe; G = G_; c = c_; }
    __host__ __device__ bool next(int i, Unit& u) const {
        const long L = (long)i * G + c; if (L >= nwg) return false;
        int wgid = (int)L; { const int q = nwg / NXCD, r = nwg % NXCD, xcd = wgid % NXCD, off = wgid / NXCD; wgid = (xcd < r ? xcd * (q + 1) : r * (q + 1) + (xcd - r) * q) + off; }
        const int e = wgid / upe, rr = wgid % upe;
        u.pm = e * 8 + (rr & 7); u.pn = e * nNe + (rr >> 3); return true;
    }
    __device__ __forceinline__ void a_ready(const Unit&) const {}
    __device__ __forceinline__ void done(const Unit&) const {}
};

struct EpiStoreBf16 {
    static constexpr bool PERM = true, AFTER_DRAIN = false;
    bf16_t* O; int ldc;
    __device__ __forceinline__ void operator()(const f32x4 (&acc)[2][2][4][2], const Unit& u, int wr, int wc, int fr, int fq) const {
        const int row0 = u.pm * BM + wr * 64 + fr, col0 = u.pn * BM + wc * 32 + 8 * fq;
#pragma unroll
        for (int ai = 0; ai < 2; ++ai)
#pragma unroll
            for (int m = 0; m < 4; ++m) { bf16_t* rowp = O + (size_t)(row0 + ai * HALF + m * 16) * ldc + col0;
#pragma unroll
                for (int bj = 0; bj < 2; ++bj) { const f32x4 v0 = acc[ai][bj][m][0], v1 = acc[ai][bj][m][1];
                    u32x4 w; w.x = cvt_pk_bf16(v0[0], v0[1]); w.y = cvt_pk_bf16(v0[2], v0[3]); w.z = cvt_pk_bf16(v1[0], v1[1]); w.w = cvt_pk_bf16(v1[2], v1[3]);
                    *(u32x4*)(rowp + bj * HALF) = w; } }
    }
};
struct EpiResF32 {
    static constexpr bool PERM = false, AFTER_DRAIN = false;
    const bf16_t* base; float* O; int ldc; float alpha;
    __device__ __forceinline__ void operator()(const f32x4 (&acc)[2][2][4][2], const Unit& u, int wr, int wc, int fr, int fq) const {
        const int row0 = u.pm * BM + wr * 64 + fr, col0 = u.pn * BM + wc * 32 + 4 * fq;
#pragma unroll
        for (int ai = 0; ai < 2; ++ai)
#pragma unroll
            for (int m = 0; m < 4; ++m) { const size_t ro = (size_t)(row0 + ai * HALF + m * 16) * ldc + col0;
#pragma unroll
                for (int bj = 0; bj < 2; ++bj)
#pragma unroll
                    for (int n = 0; n < 2; ++n) { const u32x2 bw = *(const u32x2*)(base + ro + bj * HALF + 16 * n);
                        f32x4 b; b[0] = __uint_as_float(bw.x << 16); b[1] = __uint_as_float(bw.x & 0xffff0000u); b[2] = __uint_as_float(bw.y << 16); b[3] = __uint_as_float(bw.y & 0xffff0000u);
                        *(f32x4*)(O + ro + bj * HALF + 16 * n) = b * alpha + acc[ai][bj][m][n]; } }
    }
};
struct EpiSwiGLU {
    static constexpr bool PERM = true, AFTER_DRAIN = false;
    bf16_t* O; int ldc; int ntn;
    __device__ __forceinline__ void operator()(const f32x4 (&acc)[2][2][4][2], const Unit& u, int wr, int wc, int fr, int fq) const {
        const int row0 = u.pm * BM + wr * 64 + fr, col0 = ((u.pn % ntn) * BM + wc * 32 + 8 * fq) >> 1;
#pragma unroll
        for (int ai = 0; ai < 2; ++ai)
#pragma unroll
            for (int m = 0; m < 4; ++m) { bf16_t* rowp = O + (size_t)(row0 + ai * HALF + m * 16) * ldc + col0;
#pragma unroll
                for (int bj = 0; bj < 2; ++bj) { const f32x4 v0 = acc[ai][bj][m][0], v1 = acc[ai][bj][m][1];
                    const float h0 = v0[0] * v0[1] * __builtin_amdgcn_rcpf(1.f + __expf(-v0[0])), h1 = v0[2] * v0[3] * __builtin_amdgcn_rcpf(1.f + __expf(-v0[2]));
                    const float h2 = v1[0] * v1[1] * __builtin_amdgcn_rcpf(1.f + __expf(-v1[0])), h3 = v1[2] * v1[3] * __builtin_amdgcn_rcpf(1.f + __expf(-v1[2]));
                    u32x2 w; w.x = cvt_pk_bf16(h0, h1); w.y = cvt_pk_bf16(h2, h3);
                    *(u32x2*)(rowp + bj * (HALF / 2)) = w; } }
    }
};
struct EpiScaleRow {
    static constexpr bool PERM = true, AFTER_DRAIN = false;
    bf16_t* O; int ldc; int ntn; const float* gate;
    __device__ __forceinline__ void operator()(const f32x4 (&acc)[2][2][4][2], const Unit& u, int wr, int wc, int fr, int fq) const {
        const int row0 = u.pm * BM + wr * 64 + fr, col0 = (u.pn % ntn) * BM + wc * 32 + 8 * fq;
#pragma unroll
        for (int ai = 0; ai < 2; ++ai)
#pragma unroll
            for (int m = 0; m < 4; ++m) { const int row = row0 + ai * HALF + m * 16; const float gsc = gate[row]; bf16_t* rowp = O + (size_t)row * ldc + col0;
#pragma unroll
                for (int bj = 0; bj < 2; ++bj) { const f32x4 v0 = acc[ai][bj][m][0] * gsc, v1 = acc[ai][bj][m][1] * gsc;
                    u32x4 w; w.x = cvt_pk_bf16(v0[0], v0[1]); w.y = cvt_pk_bf16(v0[2], v0[3]); w.z = cvt_pk_bf16(v1[0], v1[1]); w.w = cvt_pk_bf16(v1[2], v1[3]);
                    *(u32x4*)(rowp + bj * HALF) = w; } }
    }
};

template <class Epi, class Sched, bool ALIGN_EPI = false, bool SP2 = false>
__device__ __forceinline__ void gemm_phase(PG8_LAS unsigned char* lds, const Gemm g, const Sched& S, const Epi& E) {
    int tid_ = threadIdx.x; asm volatile("" : "+v"(tid_)); const int tid = tid_, wid = __builtin_amdgcn_readfirstlane(tid >> 6), lane = tid & 63, wr = wid >> 2, wc = wid & 3, fr = lane & 15, fq = lane >> 4;
    const int K = g.K, nt = K / BK;
    unsigned voffA[2], voffB[2];
#pragma unroll
    for (int i = 0; i < 2; ++i) { int R, C; stage_rc(tid * 16 + i * 8192, R, C); const int Rb = Epi::PERM ? ((R & ~31) + perm32(R & 31)) : R;
        voffA[i] = (unsigned)(R * K + C) * 2u; voffB[i] = (unsigned)(Rb * K + C) * 2u; }
    const size_t kstep = (size_t)(BK * 2);
    const size_t hstep = (size_t)HALF * K * 2;
    const size_t tstep = 2 * hstep;
    const unsigned ldsw = (unsigned)wid * 1024u;
    const int aoff = lds_byte(wr * 64 + fr, fq * 8), boff = lds_byte(wc * 32 + fr, fq * 8);
#define PG8_SA(b, h) (((b) * 2 + (h)) * HTB)
#define PG8_SB(b, h) ((4 + (b) * 2 + (h)) * HTB)
#define PG8_STAGE(bufoff, gbase, voff) do { _Pragma("unroll") for (int _i = 0; _i < 2; ++_i) \
        __builtin_amdgcn_global_load_lds((const unsigned*)((const char*)(gbase) + (voff)[_i]), (PG8_LAS unsigned*)(lds + (bufoff) + ldsw + _i * 8192), 16, 0, 0); } while (0)
#define PG8_LDA(dst, b, h) do { _Pragma("unroll") for (int m = 0; m < 4; ++m) _Pragma("unroll") for (int k = 0; k < 2; ++k) dst[m][k] = *(const PG8_LAS bf16x8*)(lds + PG8_SA(b, h) + aoff + m * 2048 + k * 1024); } while (0)
#define PG8_LDB(dst, b, h) do { _Pragma("unroll") for (int n = 0; n < 2; ++n) _Pragma("unroll") for (int k = 0; k < 2; ++k) dst[n][k] = *(const PG8_LAS bf16x8*)(lds + PG8_SB(b, h) + boff + n * 2048 + k * 1024); } while (0)
#define PG8_MMA(ai, bj, At, Bt) do { __builtin_amdgcn_s_setprio(1); _Pragma("unroll") for (int m = 0; m < 4; ++m) _Pragma("unroll") for (int n = 0; n < 2; ++n) _Pragma("unroll") for (int k = 0; k < 2; ++k) \
        acc[ai][bj][m][n] = __builtin_amdgcn_mfma_f32_16x16x32_bf16(Bt[n][k], At[m][k], acc[ai][bj][m][n], 0, 0, 0); __builtin_amdgcn_s_setprio(0); } while (0)
#define PG8_WAIT_V(n) asm volatile("s_waitcnt vmcnt(" #n ")" ::: "memory")
#define PG8_WAIT_L(n) asm volatile("s_waitcnt lgkmcnt(" #n ")" ::: "memory")
#define PG8_BAR __builtin_amdgcn_s_barrier()
#define PG8_SCHED __builtin_amdgcn_sched_barrier(0)
    Unit cur, nxt; int ui = 0;
    if (!S.next(0, cur)) return;
    f32x4 acc[2][2][4][2];
#pragma unroll
    for (int a = 0; a < 2; ++a)
#pragma unroll
        for (int b = 0; b < 2; ++b)
#pragma unroll
            for (int m = 0; m < 4; ++m)
#pragma unroll
                for (int n = 0; n < 2; ++n) acc[a][b][m][n] = (f32x4){0.f, 0.f, 0.f, 0.f};
    bf16x8 At[4][2], B0[2][2], B1[2][2];
    const char* cA = (const char*)g.A + (size_t)cur.pm * tstep; const char* cB = (const char*)g.Bt + (size_t)cur.pn * tstep;
    S.a_ready(cur);
    if constexpr (SP2) {
        PG8_STAGE(PG8_SB(0, 0), cB, voffB); PG8_STAGE(PG8_SB(0, 1), cB + hstep, voffB); PG8_STAGE(PG8_SA(0, 0), cA, voffA); PG8_STAGE(PG8_SA(0, 1), cA + hstep, voffA);
        if (wr == 1) PG8_BAR;
        PG8_WAIT_V(2); PG8_BAR;
        PG8_STAGE(PG8_SB(1, 0), cB + kstep, voffB); PG8_STAGE(PG8_SA(1, 0), cA + kstep, voffA); PG8_STAGE(PG8_SB(1, 1), cB + hstep + kstep, voffB);
        PG8_WAIT_V(6); PG8_BAR;
    } else {
        PG8_STAGE(PG8_SB(0, 0), cB, voffB); PG8_STAGE(PG8_SA(0, 0), cA, voffA); PG8_STAGE(PG8_SB(0, 1), cB + hstep, voffB); PG8_STAGE(PG8_SA(0, 1), cA + hstep, voffA);
        if (wr == 1) PG8_BAR;
        PG8_WAIT_V(4); PG8_BAR;
        PG8_STAGE(PG8_SB(1, 0), cB + kstep, voffB); PG8_STAGE(PG8_SA(1, 0), cA + kstep, voffA); PG8_STAGE(PG8_SB(1, 1), cB + hstep + kstep, voffB);
        PG8_WAIT_V(6); PG8_BAR;
    }
    for (;;) {
        const bool has_next = S.next(ui + 1, nxt);
        const char* nA = has_next ? (const char*)g.A + (size_t)nxt.pm * tstep : cA; const char* nB = has_next ? (const char*)g.Bt + (size_t)nxt.pn * tstep : cB;
        for (int t = 0; t < nt; t += 2) {
            const bool last = (t == nt - 2);
            const char* a1 = cA + (size_t)(t + 1) * kstep;
            const char* a2 = last ? nA : cA + (size_t)(t + 2) * kstep; const char* b2 = last ? nB : cB + (size_t)(t + 2) * kstep;
            const char* a3 = a2 + kstep; const char* b3 = b2 + kstep;
            if (last && has_next) S.a_ready(nxt);
            if constexpr (SP2) {
            PG8_LDB(B0, 0, 0); PG8_LDB(B1, 0, 1); PG8_SCHED; PG8_LDA(At, 0, 0); PG8_STAGE(PG8_SA(1, 1), a1 + hstep, voffA);
            PG8_WAIT_V(8); PG8_WAIT_L(0); PG8_BAR; PG8_MMA(0, 0, At, B0); PG8_MMA(0, 1, At, B1); PG8_BAR; PG8_SCHED;
            PG8_LDA(At, 0, 1); PG8_STAGE(PG8_SB(0, 0), b2, voffB); PG8_STAGE(PG8_SB(0, 1), b2 + hstep, voffB); PG8_STAGE(PG8_SA(0, 0), a2, voffA);
            PG8_WAIT_V(8); PG8_WAIT_L(0); PG8_BAR; PG8_MMA(1, 0, At, B0); PG8_MMA(1, 1, At, B1); PG8_BAR; PG8_SCHED;
            PG8_LDB(B0, 1, 0); PG8_LDB(B1, 1, 1); PG8_SCHED; PG8_LDA(At, 1, 0); PG8_STAGE(PG8_SA(0, 1), a2 + hstep, voffA);
            PG8_WAIT_V(8); PG8_WAIT_L(0); PG8_BAR; PG8_MMA(0, 0, At, B0); PG8_MMA(0, 1, At, B1); PG8_BAR; PG8_SCHED;
            PG8_LDA(At, 1, 1); PG8_STAGE(PG8_SB(1, 0), b3, voffB); PG8_STAGE(PG8_SB(1, 1), b3 + hstep, voffB); PG8_STAGE(PG8_SA(1, 0), a3, voffA);
            PG8_WAIT_V(8); PG8_WAIT_L(0); PG8_BAR; PG8_MMA(1, 0, At, B0); PG8_MMA(1, 1, At, B1); PG8_BAR; PG8_SCHED;
            } else {
            PG8_LDB(B0, 0, 0); PG8_SCHED; PG8_LDA(At, 0, 0); PG8_STAGE(PG8_SA(1, 1), a1 + hstep, voffA);
            PG8_WAIT_L(8); PG8_BAR; PG8_WAIT_L(0); PG8_MMA(0, 0, At, B0); PG8_BAR; PG8_SCHED;
            PG8_LDB(B1, 0, 1); PG8_STAGE(PG8_SB(0, 0), b2, voffB);
            PG8_BAR; PG8_WAIT_L(0); PG8_MMA(0, 1, At, B1); PG8_BAR;
            PG8_LDA(At, 0, 1); PG8_STAGE(PG8_SA(0, 0), a2, voffA);
            PG8_BAR; PG8_WAIT_L(0); PG8_MMA(1, 0, At, B0); PG8_BAR; PG8_SCHED;
            PG8_STAGE(PG8_SB(0, 1), b2 + hstep, voffB);
            PG8_WAIT_V(6); PG8_BAR; PG8_MMA(1, 1, At, B1); PG8_BAR;
            PG8_LDB(B0, 1, 0); PG8_SCHED; PG8_LDA(At, 1, 0); PG8_STAGE(PG8_SA(0, 1), a2 + hstep, voffA);
            PG8_WAIT_L(8); PG8_BAR; PG8_WAIT_L(0); PG8_MMA(0, 0, At, B0); PG8_BAR; PG8_SCHED;
            PG8_LDB(B1, 1, 1); PG8_STAGE(PG8_SB(1, 0), b3, voffB);
            PG8_BAR; PG8_WAIT_L(0); PG8_MMA(0, 1, At, B1); PG8_BAR;
            PG8_LDA(At, 1, 1); PG8_STAGE(PG8_SA(1, 0), a3, voffA);
            PG8_BAR; PG8_WAIT_L(0); PG8_MMA(1, 0, At, B0); PG8_BAR; PG8_SCHED;
            PG8_STAGE(PG8_SB(1, 1), b3 + hstep, voffB);
            PG8_WAIT_V(6); PG8_BAR; PG8_MMA(1, 1, At, B1); PG8_BAR;
            }
        }
        if constexpr (ALIGN_EPI) { if (wr == 0) PG8_BAR; }
        if constexpr (!Epi::AFTER_DRAIN) { E(acc, cur, wr, wc, fr, fq); S.done(cur); }
        if (!has_next) break;
#pragma unroll
        for (int a = 0; a < 2; ++a)
#pragma unroll
            for (int b = 0; b < 2; ++b)
#pragma unroll
                for (int m = 0; m < 4; ++m)
#pragma unroll
                    for (int n = 0; n < 2; ++n) acc[a][b][m][n] = (f32x4){0.f, 0.f, 0.f, 0.f};
        cur = nxt; cA = nA; cB = nB; ++ui;
        if constexpr (ALIGN_EPI) { if (wr == 1) PG8_BAR; }
    }
    PG8_WAIT_V(0);
    if constexpr (!ALIGN_EPI) { if (wr == 0) PG8_BAR; }
    PG8_BAR;
    if constexpr (Epi::AFTER_DRAIN) { E.fused(acc, cur, wr, wc, fr, fq, lds, wid, lane); S.done(cur); }
#undef PG8_SA
#undef PG8_SB
#undef PG8_STAGE
#undef PG8_LDA
#undef PG8_LDB
#undef PG8_MMA
#undef PG8_WAIT_V
#undef PG8_WAIT_L
#undef PG8_BAR
#undef PG8_SCHED
}
}

using pg8::bf16_t; using pg8::bf16x8; using pg8::f32x4; using pg8::u32x4; using pg8::u32x2;
#define LAS __attribute__((address_space(3)))
typedef short bf16x4 __attribute__((ext_vector_type(4)));

constexpr int NB = 4, SEQ = 4096, DM = 1024, MTOK = NB * SEQ, DIN = 2048, NE = 16, FF = 2048, CAP = 512, NROWX = NE * NB * CAP;
constexpr float ALPHA = 1.41421356237309515f, LN_EPS = 1e-5f;
constexpr int NWAVES = 8, NTHR = 512;
constexpr int LDS_BYTES = 147456;
constexpr int S5T = 32, S5NCH = SEQ / S5T;

constexpr size_t MiB = 1u << 20;
constexpr size_t WS_WIN = 0, WS_WOUT = 8 * MiB, WS_WGLU = 12 * MiB, WS_S5TAB = 13 * MiB, WS_AFFT = 14 * MiB, WS_IDX = 15 * MiB, WS_GATE = 16 * MiB, WS_SLOT = 17 * MiB, WS_BAR = 18 * MiB, WS_S5BT = 19 * MiB, WS_S5CT = 20 * MiB;
constexpr size_t WS_WGU = 32 * MiB, WS_WD = 288 * MiB, WS_H32 = 416 * MiB, WS_HBF = 480 * MiB, WS_RA = 512 * MiB  , WS_RB = 576 * MiB  ;
constexpr size_t WS_HDN = 640 * MiB, WS_KVF = 768 * MiB, WS_KVB = 776 * MiB, WS_STF = 784 * MiB, WS_STB = 792 * MiB, WS_S5E = 800 * MiB, WS_S5C = 808 * MiB, WS_END = 816 * MiB;

struct Args { const float* in[25]; float* out; unsigned char* ws; int ph_lo, ph_hi; };

typedef __bf16 bf16x2_hw __attribute__((ext_vector_type(2)));
typedef float f32x2_hw __attribute__((ext_vector_type(2)));
__device__ __forceinline__ unsigned pk2(float lo, float hi) { const f32x2_hw v = {lo, hi}; const bf16x2_hw b = __builtin_convertvector(v, bf16x2_hw); return __builtin_bit_cast(unsigned, b); }
__device__ __forceinline__ unsigned f2bf(float f) { return pk2(f, 0.f) & 0xffffu; }
__device__ __forceinline__ float bflo(unsigned w) { return __uint_as_float(w << 16); }
__device__ __forceinline__ float bfhi(unsigned w) { return __uint_as_float(w & 0xffff0000u); }
__device__ __forceinline__ f32x4 mfma16(bf16x8 a, bf16x8 b, f32x4 c) { return __builtin_amdgcn_mfma_f32_16x16x32_bf16(a, b, c, 0, 0, 0); }
__device__ __forceinline__ float wave_sum(float v) {
#pragma unroll
    for (int o = 1; o < 64; o <<= 1) v += __shfl_xor(v, o);
    return v;
}
__device__ __forceinline__ bf16x8 pack8(const f32x4& a, const f32x4& b) {
    u32x4 w; w.x = pk2(a[0], a[1]); w.y = pk2(a[2], a[3]); w.z = pk2(b[0], b[1]); w.w = pk2(b[2], b[3]);
    return __builtin_bit_cast(bf16x8, w);
}
__device__ __forceinline__ bf16x8 cat8(bf16x4 lo, bf16x4 hi) { bf16x8 r; r[0] = lo[0]; r[1] = lo[1]; r[2] = lo[2]; r[3] = lo[3]; r[4] = hi[0]; r[5] = hi[1]; r[6] = hi[2]; r[7] = hi[3]; return r; }
#define LDS_WAIT() asm volatile("s_waitcnt lgkmcnt(0)" ::: "memory")

struct ConvItem { const float* srcp; bf16_t* dstp; int N; int rstep; };
__device__ __forceinline__ ConvItem conv_decode(const Args& a, int it, int lane) {
    constexpr int I3 = 16384, I4 = 16384, I5 = 16384, I0 = 1024, I1 = 512;
    unsigned char* ws = a.ws;
    const float* src; bf16_t* dst; int K, N, rmul = 1, ro = 0, kb, nb;
    int r = it;
    if (r < I3 + I4) { const int up = r >= I3; r -= up ? I3 : 0; const int mat = r >> 9, q = r & 511; src = (up ? a.in[21] : a.in[20]) + (size_t)mat * DM * FF; dst = (bf16_t*)(ws + WS_WGU) + (size_t)mat * 2 * FF * DM; K = DM; N = FF; rmul = 2; ro = up; kb = q >> 5; nb = q & 31; }
    else { r -= I3 + I4;
        if (r < I5) { const int mat = r >> 9, q = r & 511; src = a.in[22] + (size_t)mat * FF * DM; dst = (bf16_t*)(ws + WS_WD) + (size_t)mat * DM * FF; K = FF; N = DM; kb = q >> 4; nb = q & 15; }
        else { r -= I5;
            if (r < I0) { const int mat = r >> 9, q = r & 511; src = a.in[3] + (size_t)mat * DM * DIN; dst = (bf16_t*)(ws + WS_WIN) + (size_t)mat * DIN * DM; K = DM; N = DIN; kb = q >> 5; nb = q & 31; }
            else { r -= I0;
                if (r < I1) { const int mat = r >> 8, q = r & 255; src = a.in[16] + (size_t)mat * DM * DM; dst = (bf16_t*)(ws + WS_WOUT) + (size_t)mat * DM * DM; K = DM; N = DM; kb = q >> 4; nb = q & 15; }
                else { r -= I1; const int mat = r >> 4, q = r & 15; src = a.in[13] + (size_t)mat * 65536; dst = (bf16_t*)(ws + WS_WGLU) + (size_t)mat * 65536; K = 256; N = 256; kb = q >> 2; nb = q & 3; } } } }
    ConvItem c; c.N = N;
    c.srcp = src + (size_t)(kb * 64 + (lane >> 4)) * N + nb * 64 + (lane & 15) * 4;
    c.dstp = dst + (size_t)((nb * 64) * rmul + ro) * K + kb * 64; c.rstep = rmul * K;
    return c;
}
__device__ __forceinline__ void conv_load(const ConvItem& c, f32x4 (&v)[16]) {
#pragma unroll
    for (int i = 0; i < 16; ++i) v[i] = __builtin_nontemporal_load((const f32x4*)(c.srcp + (size_t)(i * 4) * c.N));
}
__device__ __forceinline__ void conv_store(const ConvItem& c, const f32x4 (&v)[16], LAS float* scr, int lane) {
    const int r4 = lane >> 4, c4 = (lane & 15) * 4;
#pragma unroll
    for (int i = 0; i < 16; ++i) { const int kk = i * 4 + r4; *(LAS f32x4*)(scr + kk * 68 + (c4 ^ (((kk >> 3) & 7) * 4))) = v[i]; }
    LDS_WAIT();
    const int cc = lane & 7, nl = lane >> 3;
#pragma unroll
    for (int p = 0; p < 8; ++p) {
        const int n = nl + 8 * p;
        const LAS float* s = scr + (8 * cc) * 68 + (n ^ (4 * cc));
        u32x4 o; o.x = pk2(s[0], s[68]); o.y = pk2(s[2 * 68], s[3 * 68]); o.z = pk2(s[4 * 68], s[5 * 68]); o.w = pk2(s[6 * 68], s[7 * 68]);
        *(u32x4*)(c.dstp + (size_t)n * c.rstep + 8 * cc) = o;
    }
    LDS_WAIT();
}
__device__ __forceinline__ void sincos_rev(double f, double& sn, double& cs) {
    const double a = f * 6.283185307179586476925;
    const double q = rint(a * 0.636619772367581343);
    const double r = a - q * 1.570796326794896619;
    const double r2 = r * r;
    double s = -7.6471637318198164759e-13; s = s * r2 + 1.6059043836821614599e-10; s = s * r2 - 2.5052108385441718775e-8; s = s * r2 + 2.7557319223985890653e-6;
    s = s * r2 - 1.9841269841269841270e-4; s = s * r2 + 8.3333333333333333333e-3; s = s * r2 - 1.6666666666666666667e-1; s = s * r2 * r + r;
    double c = 4.7794773323873852974e-14; c = c * r2 - 1.1470745597729724714e-11; c = c * r2 + 2.0876756987868098979e-9; c = c * r2 - 2.7557319223985890653e-7;
    c = c * r2 + 2.4801587301587301587e-5; c = c * r2 - 1.3888888888888888889e-3; c = c * r2 + 4.1666666666666666667e-2; c = c * r2 - 0.5; c = c * r2 + 1.0;
    const int qi = ((int)q) & 3;
    sn = (qi == 0) ? s : (qi == 1) ? c : (qi == 2) ? -s : -c;
    cs = (qi == 0) ? c : (qi == 1) ? -s : (qi == 2) ? -c : s;
}
__device__ __forceinline__ double exp_small(double x) {
    const double y = x * (1.0 / 64.0);
    double e = 1.0 / 479001600.0;
    e = e * y + 1.0 / 39916800.0; e = e * y + 1.0 / 3628800.0; e = e * y + 1.0 / 362880.0; e = e * y + 1.0 / 40320.0; e = e * y + 1.0 / 5040.0; e = e * y + 1.0 / 720.0;
    e = e * y + 1.0 / 120.0; e = e * y + 1.0 / 24.0; e = e * y + 1.0 / 6.0; e = e * y + 0.5; e = e * y + 1.0; e = e * y + 1.0;
#pragma unroll
    for (int i = 0; i < 6; ++i) e = e * e;
    return e;
}
__device__ __forceinline__ void s5_coefs(const Args& a, int t, double& br, double& bi, double& cr, double& ci, double& tr, double& ti) {
    const int g = (t >> 6) & 15, lr = t >> 10;
    const double lre = (double)a.in[5][t], lim = (double)a.in[6][t];
    const double step = exp_small((double)a.in[7][lr * 16 + g]);
    const double ar = lre * step, th = lim * step;
    const double rev = th * 0.15915494309189533577; const double fr = rev - rint(rev);
    double sn, cs; sincos_rev(fr, sn, cs);
    const double mag = exp_small(ar);
    br = mag * cs; bi = mag * sn;
    const double nr = br - 1.0, ni = bi, den = lre * lre + lim * lim;
    cr = (nr * lre + ni * lim) / den; ci = (ni * lre - nr * lim) / den;
    const double rev2 = rev * (double)S5T; const double fr2 = rev2 - rint(rev2);
    double sn2, cs2; sincos_rev(fr2, sn2, cs2);
    const double mag2 = exp_small(ar * (double)S5T);
    tr = mag2 * cs2; ti = mag2 * sn2;
}
__device__ __forceinline__ void s5_table_entry(const Args& a, int t) {
    double br, bi, cr, ci, tr, ti; s5_coefs(a, t, br, bi, cr, ci, tr, ti);
    float* o = (float*)(a.ws + WS_S5TAB) + (size_t)t * 8;
    o[0] = (float)br; o[1] = (float)bi; o[2] = (float)cr; o[3] = (float)ci; o[4] = (float)tr; o[5] = (float)ti; o[6] = 0.f; o[7] = 0.f;
}
__device__ __forceinline__ void s5_bt_row(const Args& a, int t) {
    const int l = t >> 12, g = (t >> 8) & 15, n = t & 255, r = n >> 7, p = (n >> 1) & 63, ri = n & 1;
    double br, bi, cr, ci, tr, ti; s5_coefs(a, ((l * 2 + r) * 16 + g) * 64 + p, br, bi, cr, ci, tr, ti);
    const float crf = (float)cr, cif = (float)ci;
    const float* bre = a.in[8] + (size_t)((l * 16 + g) * 64 + p) * 16; const float* bim = a.in[9] + (size_t)((l * 16 + g) * 64 + p) * 16;
    u32x4 o[2];
#pragma unroll
    for (int h = 0; h < 2; ++h) {
        const f32x4 x0 = *(const f32x4*)(bre + 8 * h), x1 = *(const f32x4*)(bre + 8 * h + 4), y0 = *(const f32x4*)(bim + 8 * h), y1 = *(const f32x4*)(bim + 8 * h + 4);
        float v[8];
#pragma unroll
        for (int k = 0; k < 4; ++k) { v[k] = ri ? (crf * y0[k] + cif * x0[k]) : (crf * x0[k] - cif * y0[k]); v[4 + k] = ri ? (crf * y1[k] + cif * x1[k]) : (crf * x1[k] - cif * y1[k]); }
        o[h].x = pk2(v[0], v[1]); o[h].y = pk2(v[2], v[3]); o[h].z = pk2(v[4], v[5]); o[h].w = pk2(v[6], v[7]);
    }
    u32x4* dst = (u32x4*)((bf16_t*)(a.ws + WS_S5BT) + (size_t)t * 32);
    dst[0] = o[0]; dst[1] = o[1]; dst[2] = (u32x4){0u, 0u, 0u, 0u}; dst[3] = (u32x4){0u, 0u, 0u, 0u};
}
__device__ __forceinline__ void s5_ct_entry(const Args& a, int t) {
    const int p = t & 63, r = (t >> 6) & 1, c = (t >> 7) & 15, g = (t >> 11) & 15, l = t >> 15;
    const size_t ci = (size_t)(((l * 2 + r) * 16 + g) * 16 + c) * 64 + p;
    ((unsigned*)(a.ws + WS_S5CT))[t] = pk2(a.in[10][ci], -a.in[11][ci]);
}
__device__ __forceinline__ void ln_rows4(f32x4 (&v)[4], const float* __restrict__ g, const float* __restrict__ bt, int lane) {
    float s = 0.f;
#pragma unroll
    for (int j = 0; j < 4; ++j) s += (v[j][0] + v[j][1]) + (v[j][2] + v[j][3]);
    const float mean = wave_sum(s) * (1.f / DM); float s2 = 0.f;
#pragma unroll
    for (int j = 0; j < 4; ++j) { v[j] = v[j] - mean; s2 += (v[j][0] * v[j][0] + v[j][1] * v[j][1]) + (v[j][2] * v[j][2] + v[j][3] * v[j][3]); }
    const float rstd = 1.f / sqrtf(wave_sum(s2) * (1.f / DM) + LN_EPS);
#pragma unroll
    for (int j = 0; j < 4; ++j) { const f32x4 gv = ((const f32x4*)g)[lane + 64 * j], bv = ((const f32x4*)bt)[lane + 64 * j]; v[j] = v[j] * rstd * gv + bv; }
}
__device__ __forceinline__ void store_row(const f32x4 (&v)[4], float* o32, bf16_t* obf, int lane) {
#pragma unroll
    for (int j = 0; j < 4; ++j) {
        if (o32) ((f32x4*)o32)[lane + 64 * j] = v[j];
        if (obf) { u32x2 w; w.x = pk2(v[j][0], v[j][1]); w.y = pk2(v[j][2], v[j][3]); ((u32x2*)obf)[lane + 64 * j] = w; }
    }
}
__device__ __forceinline__ void phase_p0(const Args& a, LAS unsigned char* lds, int tid) {
    const int lane = tid & 63, wave = tid >> 6;
    const int gw = blockIdx.x * NWAVES + wave, NGW = gridDim.x * NWAVES;
    LAS float* scr = (LAS float*)(lds + wave * 17408);
    unsigned char* ws = a.ws;
    constexpr int NIT = 16384 * 3 + 1024 + 512 + 32;
    if (gw < NIT) {
        ConvItem cur = conv_decode(a, gw, lane);
        f32x4 v[16]; conv_load(cur, v);
        for (int it = gw; it < NIT; it += NGW) {
            const bool more = (it + NGW) < NIT;
            ConvItem nxt = cur; f32x4 vn[16];
            if (more) { nxt = conv_decode(a, it + NGW, lane); conv_load(nxt, vn); }
            conv_store(cur, v, scr, lane);
            if (more) { cur = nxt;
#pragma unroll
                for (int i = 0; i < 16; ++i) v[i] = vn[i]; }
        }
    }
    for (int t = blockIdx.x * NTHR + tid; t < 4096; t += gridDim.x * NTHR) s5_table_entry(a, t);
    for (int t = blockIdx.x * NTHR + tid; t < 8192; t += gridDim.x * NTHR) s5_bt_row(a, t);
    for (int t = blockIdx.x * NTHR + tid; t < 65536; t += gridDim.x * NTHR) s5_ct_entry(a, t);
    for (int m = gw; m < MTOK; m += NGW) {
        f32x4 v[4];
#pragma unroll
        for (int j = 0; j < 4; ++j) v[j] = ((const f32x4*)(a.in[0] + (size_t)m * DM))[lane + 64 * j];
        ln_rows4(v, a.in[1], a.in[2], lane);
        store_row(v, nullptr, (bf16_t*)(ws + WS_HBF) + (size_t)m * DM, lane);
    }
}

__device__ __forceinline__ void attn_item(int item, const bf16_t* __restrict__ proj, bf16_t* __restrict__ mix, const float* __restrict__ sink_l, LAS unsigned char* lds, int tid) {
    const int kh = item & 1, c = (item >> 1) & 31, b = item >> 6;
    constexpr int VS = 408;
    LAS bf16_t* Ks = (LAS bf16_t*)lds;
    LAS bf16_t* Vt = (LAS bf16_t*)(lds + 384 * 72 * 2);
    const int lane = tid & 63, w = tid >> 6, fr = lane & 15, fq = lane >> 4;
    const int hq = kh * 4 + (w >> 1);
    const bf16_t* qbase = proj + ((size_t)b * SEQ + c * 128 + (w & 1) * 64 + fr) * DIN + 1280 + hq * 64 + fq * 8;
    bf16x8 qn0 = *(const bf16x8*)qbase, qn1 = *(const bf16x8*)(qbase + 32);
#pragma unroll
    for (int i = 0; i < 6; ++i) {
        const int id = tid + NTHR * i, key = id >> 3, ch = id & 7;
        const int s = (c - 1) * 128 + key; const bool ok = (s >= 0) && (s < SEQ);
        u32x4 kv = {0u, 0u, 0u, 0u}, vv = {0u, 0u, 0u, 0u};
        if (ok) { const bf16_t* rowp = proj + (size_t)(b * SEQ + s) * DIN; kv = *(const u32x4*)(rowp + 1792 + kh * 64 + ch * 8); vv = *(const u32x4*)(rowp + 1920 + kh * 64 + ch * 8); }
        *(LAS u32x4*)(Ks + key * 72 + ch * 8) = kv;
        LAS bf16_t* vp = Vt + (ch * 8) * VS + key;
        vp[0 * VS] = (bf16_t)(vv.x & 0xffffu); vp[1 * VS] = (bf16_t)(vv.x >> 16); vp[2 * VS] = (bf16_t)(vv.y & 0xffffu); vp[3 * VS] = (bf16_t)(vv.y >> 16);
        vp[4 * VS] = (bf16_t)(vv.z & 0xffffu); vp[5 * VS] = (bf16_t)(vv.z >> 16); vp[6 * VS] = (bf16_t)(vv.w & 0xffffu); vp[7 * VS] = (bf16_t)(vv.w >> 16);
    }
    if (tid < 128) { const int d = tid >> 1, hh = tid & 1; *(LAS u32x4*)(Vt + d * VS + 384 + hh * 8) = (u32x4){0u, 0u, 0u, 0u}; }
    __syncthreads();
    const float slope = exp2f(-(float)(hq + 1));
    const float sinkv = sink_l[hq];
    const bool lo_ok = (c >= 1), hi_ok = (c <= 30);
    float plo[4], phi[4];
#pragma unroll
    for (int j = 0; j < 4; ++j) { plo[j] = (fq * 4 + j >= fr) ? 0.f : -1e30f; phi[j] = (fq * 4 + j <= fr) ? 0.f : -1e30f; }
#pragma unroll 1
    for (int qi = 0; qi < 4; ++qi) {
        const int qt = (w & 1) * 4 + qi;
        const size_t tok = (size_t)b * SEQ + c * 128 + qt * 16 + fr;
        const bf16x8 qa0 = qn0, qa1 = qn1;
        float slope_l = slope; asm volatile("" : "+v"(slope_l));
        float sd[4];
#pragma unroll
        for (int j = 0; j < 4; ++j) sd[j] = slope_l * (float)(fq * 4 + j - fr);
        if (qi < 3) { const bf16_t* qp = qbase + (size_t)(qi + 1) * 16 * DIN; qn0 = *(const bf16x8*)qp; qn1 = *(const bf16x8*)(qp + 32); }
        f32x4 s[18];
        float mx = sinkv;
        const LAS bf16_t* kbase = Ks + (qt * 16 + fr) * 72 + fq * 8;
        const LAS bf16_t* vbase = Vt + fr * VS + qt * 16 + fq * 4;
#pragma unroll
        for (int i = 0; i < 17; ++i) {
            const int kt = qt + i;
            const LAS bf16_t* kp = kbase + i * (16 * 72);
            f32x4 acc = {0.f, 0.f, 0.f, 0.f};
            acc = mfma16(*(const LAS bf16x8*)kp, qa0, acc); acc = mfma16(*(const LAS bf16x8*)(kp + 32), qa1, acc);
            const float pblk = ((kt < 8) ? lo_ok : ((kt >= 16) ? hi_ok : true)) ? 0.f : -1e30f;
            const float base = slope_l * (float)(16 * i - 128);
#pragma unroll
            for (int j = 0; j < 4; ++j) {
                float t = (i < 8) ? (base + sd[j]) : ((i > 8) ? -(base + sd[j]) : -fabsf(sd[j]));
                if (i == 0) t += plo[j];
                if (i == 16) t += phi[j];
                const float v = fmaf(acc[j], 0.125f, t + pblk);
                acc[j] = v; mx = fmaxf(mx, v);
            }
            s[i] = acc;
        }
        mx = fmaxf(mx, __shfl_xor(mx, 16)); mx = fmaxf(mx, __shfl_xor(mx, 32));
        float sum = 0.f;
#pragma unroll
        for (int i = 0; i < 17; ++i)
#pragma unroll
            for (int j = 0; j < 4; ++j) { const float p = __expf(s[i][j] - mx); s[i][j] = p; sum += p; }
        s[17] = (f32x4){0.f, 0.f, 0.f, 0.f};
        sum += __shfl_xor(sum, 16); sum += __shfl_xor(sum, 32);
        const float inv = 1.f / (sum + __expf(sinkv - mx));
        f32x4 o[4];
#pragma unroll
        for (int dt = 0; dt < 4; ++dt) o[dt] = (f32x4){0.f, 0.f, 0.f, 0.f};
#pragma unroll
        for (int kk = 0; kk < 9; ++kk) {
            const bf16x8 pb = pack8(s[2 * kk], s[2 * kk + 1]);
#pragma unroll
            for (int dt = 0; dt < 4; ++dt) {
                const LAS bf16_t* vp = vbase + dt * (16 * VS) + kk * 32;
                o[dt] = mfma16(cat8(*(const LAS bf16x4*)vp, *(const LAS bf16x4*)(vp + 16)), pb, o[dt]);
            }
        }
        bf16_t* op = mix + tok * DM + 512 + hq * 64 + fq * 4;
#pragma unroll
        for (int dt = 0; dt < 4; ++dt) { u32x2 wv; wv.x = pk2(o[dt][0] * inv, o[dt][1] * inv); wv.y = pk2(o[dt][2] * inv, o[dt][3] * inv); *(u32x2*)(op + dt * 16) = wv; }
    }
    __syncthreads();
}

__device__ __forceinline__ float log_sigmoid(float t) { return -log1pf(__expf(-t)); }
__device__ __forceinline__ void retkv_item(int item, const bf16_t* __restrict__ proj, float* __restrict__ kvf, float* __restrict__ kvb, const float* __restrict__ theta, LAS unsigned char* lds, int tid) {
    const int h = item & 3, c = (item >> 2) & 31, b = item >> 7;
    const float lgf = log_sigmoid(theta[h]), lgb = log_sigmoid(theta[4 + h]);
    LAS bf16_t* KTf = (LAS bf16_t*)lds; LAS bf16_t* KTb = KTf + 64 * 136; LAS bf16_t* VT = KTb + 64 * 136;
#pragma unroll
    for (int i = 0; i < 2; ++i) {
        const int id = tid + NTHR * i, j = id >> 3, ch = id & 7;
        const bf16_t* rowp = proj + (size_t)(b * SEQ + c * 128 + j) * DIN;
        const u32x4 kr = *(const u32x4*)(rowp + 256 + h * 64 + ch * 8), vr = *(const u32x4*)(rowp + 512 + h * 64 + ch * 8);
        const float wf = __expf(lgf * (float)(127 - j)) * 0.125f, wb = __expf(lgb * (float)j) * 0.125f;
        const int o = (ch * 8) * 136 + j;
        KTf[o + 0 * 136] = (bf16_t)f2bf(bflo(kr.x) * wf); KTf[o + 1 * 136] = (bf16_t)f2bf(bfhi(kr.x) * wf); KTf[o + 2 * 136] = (bf16_t)f2bf(bflo(kr.y) * wf); KTf[o + 3 * 136] = (bf16_t)f2bf(bfhi(kr.y) * wf);
        KTf[o + 4 * 136] = (bf16_t)f2bf(bflo(kr.z) * wf); KTf[o + 5 * 136] = (bf16_t)f2bf(bfhi(kr.z) * wf); KTf[o + 6 * 136] = (bf16_t)f2bf(bflo(kr.w) * wf); KTf[o + 7 * 136] = (bf16_t)f2bf(bfhi(kr.w) * wf);
        KTb[o + 0 * 136] = (bf16_t)f2bf(bflo(kr.x) * wb); KTb[o + 1 * 136] = (bf16_t)f2bf(bfhi(kr.x) * wb); KTb[o + 2 * 136] = (bf16_t)f2bf(bflo(kr.y) * wb); KTb[o + 3 * 136] = (bf16_t)f2bf(bfhi(kr.y) * wb);
        KTb[o + 4 * 136] = (bf16_t)f2bf(bflo(kr.z) * wb); KTb[o + 5 * 136] = (bf16_t)f2bf(bfhi(kr.z) * wb); KTb[o + 6 * 136] = (bf16_t)f2bf(bflo(kr.w) * wb); KTb[o + 7 * 136] = (bf16_t)f2bf(bfhi(kr.w) * wb);
        VT[o + 0 * 136] = (bf16_t)(vr.x & 0xffffu); VT[o + 1 * 136] = (bf16_t)(vr.x >> 16); VT[o + 2 * 136] = (bf16_t)(vr.y & 0xffffu); VT[o + 3 * 136] = (bf16_t)(vr.y >> 16);
        VT[o + 4 * 136] = (bf16_t)(vr.z & 0xffffu); VT[o + 5 * 136] = (bf16_t)(vr.z >> 16); VT[o + 6 * 136] = (bf16_t)(vr.w & 0xffffu); VT[o + 7 * 136] = (bf16_t)(vr.w >> 16);
    }
    __syncthreads();
    const int lane = tid & 63, w = tid >> 6, fr = lane & 15, fq = lane >> 4;
    const size_t obase = (size_t)((b * 32 + c) * 4 + h) * 4096;
#pragma unroll
    for (int i = 0; i < 4; ++i) {
        const int job = w * 4 + i, dirb = job >> 4, et = (job >> 2) & 3, dt = job & 3;
        const LAS bf16_t* ap = VT + (et * 16 + fr) * 136 + fq * 8;
        const LAS bf16_t* bp = (dirb ? KTb : KTf) + (dt * 16 + fr) * 136 + fq * 8;
        f32x4 acc = {0.f, 0.f, 0.f, 0.f};
#pragma unroll
        for (int ks = 0; ks < 4; ++ks) acc = mfma16(*(const LAS bf16x8*)(ap + ks * 32), *(const LAS bf16x8*)(bp + ks * 32), acc);
        float* op = (dirb ? kvb : kvf) + obase + (et * 16 + fq * 4) * 64 + dt * 16 + fr;
        op[0] = acc[0]; op[64] = acc[1]; op[128] = acc[2]; op[192] = acc[3];
    }
    __syncthreads();
}
__device__ __forceinline__ void retout_item(int item, const bf16_t* __restrict__ proj, const float* __restrict__ stf, const float* __restrict__ stb, bf16_t* __restrict__ mix, const float* __restrict__ theta, LAS unsigned char* lds, int tid) {
    const int h = item & 3, c = (item >> 2) & 31, b = item >> 7;
    const float lgf = log_sigmoid(theta[h]), lgb = log_sigmoid(theta[4 + h]);
    LAS bf16_t* Qs = (LAS bf16_t*)lds; LAS bf16_t* Ks = Qs + 128 * 72; LAS bf16_t* VT = Ks + 128 * 72; LAS bf16_t* SFt = VT + 64 * 136; LAS bf16_t* SBt = SFt + 64 * 72;
#pragma unroll
    for (int i = 0; i < 2; ++i) {
        const int id = tid + NTHR * i, j = id >> 3, ch = id & 7;
        const bf16_t* rowp = proj + (size_t)(b * SEQ + c * 128 + j) * DIN;
        const u32x4 qr = *(const u32x4*)(rowp + h * 64 + ch * 8), kr = *(const u32x4*)(rowp + 256 + h * 64 + ch * 8), vr = *(const u32x4*)(rowp + 512 + h * 64 + ch * 8);
        *(LAS u32x4*)(Qs + j * 72 + ch * 8) = qr; *(LAS u32x4*)(Ks + j * 72 + ch * 8) = kr;
        const int o = (ch * 8) * 136 + j;
        VT[o + 0 * 136] = (bf16_t)(vr.x & 0xffffu); VT[o + 1 * 136] = (bf16_t)(vr.x >> 16); VT[o + 2 * 136] = (bf16_t)(vr.y & 0xffffu); VT[o + 3 * 136] = (bf16_t)(vr.y >> 16);
        VT[o + 4 * 136] = (bf16_t)(vr.z & 0xffffu); VT[o + 5 * 136] = (bf16_t)(vr.z >> 16); VT[o + 6 * 136] = (bf16_t)(vr.w & 0xffffu); VT[o + 7 * 136] = (bf16_t)(vr.w >> 16);
    }
    const size_t sbase = (size_t)((b * 32 + c) * 4 + h) * 4096;
#pragma unroll
    for (int i = 0; i < 8; ++i) { const int id = tid + NTHR * i, e = id >> 6, d = id & 63; SFt[e * 72 + d] = (bf16_t)f2bf(stf[sbase + id]); SBt[e * 72 + d] = (bf16_t)f2bf(stb[sbase + id]); }
    __syncthreads();
    const int lane = tid & 63, it = tid >> 6, fr = lane & 15, fq = lane >> 4;
    const int ipos = it * 16 + fr;
    const LAS bf16_t* qp = Qs + ipos * 72 + fq * 8;
    const bf16x8 qb0 = *(const LAS bf16x8*)qp, qb1 = *(const LAS bf16x8*)(qp + 32);
    f32x4 st[8];
#pragma unroll
    for (int jt = 0; jt < 8; ++jt) {
        const LAS bf16_t* kp = Ks + (jt * 16 + fr) * 72 + fq * 8;
        f32x4 acc = {0.f, 0.f, 0.f, 0.f};
        acc = mfma16(*(const LAS bf16x8*)kp, qb0, acc); acc = mfma16(*(const LAS bf16x8*)(kp + 32), qb1, acc);
#pragma unroll
        for (int jj = 0; jj < 4; ++jj) { const int dij = ipos - (jt * 16 + fq * 4 + jj); const float dec = dij >= 0 ? __expf(lgf * (float)dij) : __expf(lgb * (float)(-dij)); acc[jj] *= 0.125f * dec; }
        st[jt] = acc;
    }
    f32x4 o[4], ff[4], fb[4];
#pragma unroll
    for (int et = 0; et < 4; ++et) { o[et] = (f32x4){0.f, 0.f, 0.f, 0.f}; ff[et] = o[et]; fb[et] = o[et]; }
#pragma unroll
    for (int kk = 0; kk < 4; ++kk) {
        const bf16x8 pb = pack8(st[2 * kk], st[2 * kk + 1]);
#pragma unroll
        for (int et = 0; et < 4; ++et) { const LAS bf16_t* vp = VT + (et * 16 + fr) * 136 + kk * 32 + fq * 4; o[et] = mfma16(cat8(*(const LAS bf16x4*)vp, *(const LAS bf16x4*)(vp + 16)), pb, o[et]); }
    }
#pragma unroll
    for (int et = 0; et < 4; ++et) {
        const LAS bf16_t* fp = SFt + (et * 16 + fr) * 72 + fq * 8; const LAS bf16_t* bp = SBt + (et * 16 + fr) * 72 + fq * 8;
        ff[et] = mfma16(*(const LAS bf16x8*)fp, qb0, ff[et]); ff[et] = mfma16(*(const LAS bf16x8*)(fp + 32), qb1, ff[et]);
        fb[et] = mfma16(*(const LAS bf16x8*)bp, qb0, fb[et]); fb[et] = mfma16(*(const LAS bf16x8*)(bp + 32), qb1, fb[et]);
    }
    const float cf = __expf(lgf * (float)(ipos + 1)), cb = __expf(lgb * (float)(128 - ipos));
    float s = 0.f;
#pragma unroll
    for (int et = 0; et < 4; ++et) { o[et] = o[et] + ff[et] * cf + fb[et] * cb; s += (o[et][0] + o[et][1]) + (o[et][2] + o[et][3]); }
    s += __shfl_xor(s, 16); s += __shfl_xor(s, 32);
    const float mean = s * (1.f / 64.f); float s2 = 0.f;
#pragma unroll
    for (int et = 0; et < 4; ++et) { o[et] = o[et] - mean; s2 += (o[et][0] * o[et][0] + o[et][1] * o[et][1]) + (o[et][2] * o[et][2] + o[et][3] * o[et][3]); }
    s2 += __shfl_xor(s2, 16); s2 += __shfl_xor(s2, 32);
    const float rstd = 1.f / sqrtf(s2 * (1.f / 64.f) + LN_EPS);
    const size_t tok = (size_t)b * SEQ + c * 128 + ipos;
    const bf16_t* gp = proj + tok * DIN + 768 + h * 64 + fq * 4;
    bf16_t* op = mix + tok * DM + h * 64 + fq * 4;
#pragma unroll
    for (int et = 0; et < 4; ++et) {
        const u32x2 gr = *(const u32x2*)(gp + et * 16);
        const float g0 = bflo(gr.x), g1 = bfhi(gr.x), g2 = bflo(gr.y), g3 = bfhi(gr.y);
        const float y0 = o[et][0] * rstd * (g0 / (1.f + __expf(-g0))), y1 = o[et][1] * rstd * (g1 / (1.f + __expf(-g1)));
        const float y2 = o[et][2] * rstd * (g2 / (1.f + __expf(-g2))), y3 = o[et][3] * rstd * (g3 / (1.f + __expf(-g3)));
        u32x2 wv; wv.x = pk2(y0, y1); wv.y = pk2(y2, y3); *(u32x2*)(op + et * 16) = wv;
    }
    __syncthreads();
}

__device__ __forceinline__ void s5_load_u(const bf16_t* __restrict__ proj, int b, int ch, LAS bf16_t* U, int tid) {
#pragma unroll
    for (int i = 0; i < 2; ++i) { const int id = tid + NTHR * i, s = id >> 5, c8 = id & 31;
        *(LAS u32x4*)(U + s * 256 + c8 * 8) = *(const u32x4*)(proj + (size_t)(b * SEQ + ch * S5T + s) * DIN + 1024 + c8 * 8); }
}
__device__ __forceinline__ void s5_bu_tiles(const LAS bf16_t* U, const bf16_t* __restrict__ BT  , LAS bf16_t* X, int XS, int qd, int w, int fr, int fq) {
    const int wg = w >> 1, mt = w & 1, g = qd * 4 + wg;
    bf16x8 uf = {0, 0, 0, 0, 0, 0, 0, 0};
    if (fq < 2) uf = *(const LAS bf16x8*)(U + (mt * 16 + fr) * 256 + g * 16 + fq * 8);
    const bf16_t* btp = BT + (size_t)(g * 256 + fr) * 32 + fq * 8;
    LAS bf16_t* xp = X + (mt * 16 + fr) * XS + wg * 256 + fq * 4;
    bf16x8 bf[16];
#pragma unroll
    for (int nt = 0; nt < 16; ++nt) bf[nt] = *(const bf16x8*)(btp + nt * 16 * 32);
#pragma unroll
    for (int nt = 0; nt < 16; ++nt) {
        f32x4 acc = {0.f, 0.f, 0.f, 0.f};
        acc = mfma16(bf[nt], uf, acc);
        u32x2 wv; wv.x = pk2(acc[0], acc[1]); wv.y = pk2(acc[2], acc[3]);
        *(LAS u32x2*)(xp + nt * 16) = wv;
    }
}

template <bool WRITE>
__device__ __forceinline__ void s5_recur(LAS bf16_t* xq, int XS, int r, float lr_, float li_, float& xr, float& xi) {
    unsigned bw[32];
#pragma unroll
    for (int k = 0; k < 32; ++k) bw[k] = *(const LAS unsigned*)(xq + k * XS);
    if (r == 0) {
#pragma unroll
        for (int s = 0; s < 32; ++s) {
            const float nr = fmaf(lr_, xr, fmaf(-li_, xi, bflo(bw[s]))), ni = fmaf(lr_, xi, fmaf(li_, xr, bfhi(bw[s])));
            xr = nr; xi = ni;
            if (WRITE) *(LAS unsigned*)(xq + s * XS) = pk2(xr, xi);
        }
    } else {
#pragma unroll
        for (int s = 31; s >= 0; --s) {
            const float nr = fmaf(lr_, xr, fmaf(-li_, xi, bflo(bw[s]))), ni = fmaf(lr_, xi, fmaf(li_, xr, bfhi(bw[s])));
            xr = nr; xi = ni;
            if (WRITE) *(LAS unsigned*)(xq + s * XS) = pk2(xr, xi);
        }
    }
}
__device__ __forceinline__ void s5e_item(int item, const bf16_t* __restrict__ proj, const float* __restrict__ tab  , const bf16_t* __restrict__ BT,
                                         float* __restrict__ E, LAS unsigned char* lds, int tid) {
    const int ch = item & (S5NCH - 1), b = item / S5NCH;
    constexpr int XS = 1032;
    LAS bf16_t* U = (LAS bf16_t*)lds;
    LAS bf16_t* X = (LAS bf16_t*)(lds + 16384);
    s5_load_u(proj, b, ch, U, tid);
    __syncthreads();
    const int gl = tid >> 7, r = (tid >> 6) & 1, p = tid & 63;
    const int lane = tid & 63, w = tid >> 6, fr = lane & 15, fq = lane >> 4;
#pragma unroll 1
    for (int qd = 0; qd < 4; ++qd) {
        const int g = qd * 4 + gl;
        const f32x4 t0 = *(const f32x4*)(tab + (size_t)((r * 16 + g) * 64 + p) * 8);
        s5_bu_tiles(U, BT, X, XS, qd, w, fr, fq);
        __syncthreads();
        float xr = 0.f, xi = 0.f;
        s5_recur<false>(X + gl * 256 + r * 128 + p * 2, XS, r, t0[0], t0[1], xr, xi);
        float2 ev; ev.x = xr; ev.y = xi;
        ((float2*)E)[(size_t)(((b * S5NCH + ch) * 16 + g) * 2 + r) * 64 + p] = ev;
        __syncthreads();
    }
}
__device__ __forceinline__ void s5out_item(int item, const bf16_t* __restrict__ proj, const float* __restrict__ tab, const bf16_t* __restrict__ BT,
                                           const bf16_t* __restrict__ CT  , const float* __restrict__ dvec, const bf16_t* __restrict__ wgluT, const float* __restrict__ bglu,
                                           const float* __restrict__ CIN, bf16_t* __restrict__ mix, LAS unsigned char* lds, int tid) {
    const int ch = item & (S5NCH - 1), b = item / S5NCH;
    constexpr int XS = 1032, YS = 264;
    LAS bf16_t* U = (LAS bf16_t*)lds;
    LAS bf16_t* X = (LAS bf16_t*)(lds + 16384);
    LAS bf16_t* Y = (LAS bf16_t*)(lds + 16384 + 66048);
    s5_load_u(proj, b, ch, U, tid);
    const int gl = tid >> 7, r = (tid >> 6) & 1, p = tid & 63;
    const int lane = tid & 63, w = tid >> 6, fr = lane & 15, fq = lane >> 4;
    const int wg = w >> 1, mt = w & 1;
    __syncthreads();
#pragma unroll 1
    for (int qd = 0; qd < 4; ++qd) {
        const int g = qd * 4 + gl, gq = qd * 4 + wg;
        const f32x4 t0 = *(const f32x4*)(tab + (size_t)((r * 16 + g) * 64 + p) * 8);
        const float2 cin = ((const float2*)CIN)[(size_t)(((b * S5NCH + ch) * 16 + g) * 2 + r) * 64 + p];
        bf16x8 cf[8];
#pragma unroll
        for (int ks = 0; ks < 8; ++ks) cf[ks] = *(const bf16x8*)(CT + (size_t)(gq * 16 + fr) * 256 + ks * 32 + fq * 8);
        s5_bu_tiles(U, BT, X, XS, qd, w, fr, fq);
        __syncthreads();
        float xr = cin.x, xi = cin.y;
        s5_recur<true>(X + gl * 256 + r * 128 + p * 2, XS, r, t0[0], t0[1], xr, xi);
        __syncthreads();
        {
            const LAS bf16_t* xp = X + (mt * 16 + fr) * XS + wg * 256 + fq * 8;
            f32x4 acc = {0.f, 0.f, 0.f, 0.f};
#pragma unroll
            for (int ks = 0; ks < 8; ++ks) acc = mfma16(cf[ks], *(const LAS bf16x8*)(xp + ks * 32), acc);
            const int s = mt * 16 + fr, chn = gq * 16 + fq * 4;
            const f32x4 dv = *(const f32x4*)(dvec + chn);
            const u32x2 uw = *(const LAS u32x2*)(U + s * 256 + chn);
            const float uu[4] = {bflo(uw.x), bfhi(uw.x), bflo(uw.y), bfhi(uw.y)};
            float gl4[4];
#pragma unroll
            for (int jj = 0; jj < 4; ++jj) {
                const float yv = acc[jj] + dv[jj] * uu[jj];
                const float t = 0.7978845608028654f * (yv + 0.044715f * yv * yv * yv);
                gl4[jj] = yv * (1.f - 1.f / (1.f + __expf(2.f * t)));
            }
            u32x2 yw; yw.x = pk2(gl4[0], gl4[1]); yw.y = pk2(gl4[2], gl4[3]);
            *(LAS u32x2*)(Y + s * YS + chn) = yw;
        }
        __syncthreads();
    }
    {
        bf16x8 yf[8];
#pragma unroll
        for (int ks = 0; ks < 8; ++ks) yf[ks] = *(const LAS bf16x8*)(Y + (mt * 16 + fr) * YS + ks * 32 + fq * 8);
        const int s = mt * 16 + fr;
        bf16_t* orow = mix + (size_t)(b * SEQ + ch * S5T + s) * DM + 256;
#pragma unroll
        for (int i = 0; i < 4; ++i) {
            const int nt = (w >> 1) * 4 + i;
            const bf16_t* ap = wgluT + (size_t)(nt * 16 + fr) * 256 + fq * 8;
            f32x4 acc = {0.f, 0.f, 0.f, 0.f};
#pragma unroll
            for (int ks = 0; ks < 8; ++ks) acc = mfma16(*(const bf16x8*)(ap + ks * 32), yf[ks], acc);
            const int n0 = nt * 16 + fq * 4;
            const f32x4 bg = *(const f32x4*)(bglu + n0);
            const u32x2 yw = *(const LAS u32x2*)(Y + s * YS + n0);
            const float yv[4] = {bflo(yw.x), bfhi(yw.x), bflo(yw.y), bfhi(yw.y)};
            float ov[4];
#pragma unroll
            for (int jj = 0; jj < 4; ++jj) ov[jj] = yv[jj] / (1.f + __expf(-(acc[jj] + bg[jj])));
            u32x2 ow; ow.x = pk2(ov[0], ov[1]); ow.y = pk2(ov[2], ov[3]);
            *(u32x2*)(orow + n0) = ow;
        }
    }
    __syncthreads();
}

__device__ __forceinline__ void phase_scan(const Args& a, int l, int tid) {
    unsigned char* ws = a.ws;
    const int lane = tid & 63, wave = tid >> 6;
    {
        const float* tab = (const float*)(ws + WS_S5TAB) + (size_t)l * 2048 * 8;
        const float2* __restrict__ E = (const float2*)(ws + WS_S5E); float2* __restrict__ C = (float2*)(ws + WS_S5C);
        for (int wv = blockIdx.x; wv < 128; wv += gridDim.x) if (wave == 0) {
            const int p = lane, r = wv & 1, g = (wv >> 1) & 15, b = wv >> 5;
            const float* tp = tab + (size_t)((r * 16 + g) * 64 + p) * 8;
            const float tr = tp[4], ti = tp[5];
            float xr = 0.f, xi = 0.f;
            for (int k0 = 0; k0 < S5NCH; k0 += 32) {
                float2 e[32];
#pragma unroll
                for (int k = 0; k < 32; ++k) { const int ch = r ? (S5NCH - 1 - (k0 + k)) : (k0 + k); e[k] = E[(size_t)(((b * S5NCH + ch) * 16 + g) * 2 + r) * 64 + p]; }
#pragma unroll
                for (int k = 0; k < 32; ++k) { const int ch = r ? (S5NCH - 1 - (k0 + k)) : (k0 + k);
                    float2 cv; cv.x = xr; cv.y = xi; C[(size_t)(((b * S5NCH + ch) * 16 + g) * 2 + r) * 64 + p] = cv;
                    const float nr = fmaf(tr, xr, fmaf(-ti, xi, e[k].x)), ni = fmaf(tr, xi, fmaf(ti, xr, e[k].y));
                    xr = nr; xi = ni; }
            }
        }
    }
    {
        const float* theta = a.in[4] + l * 8;
        const float* __restrict__ kvf = (const float*)(ws + WS_KVF); const float* __restrict__ kvb = (const float*)(ws + WS_KVB);
        float* __restrict__ stf = (float*)(ws + WS_STF); float* __restrict__ stb = (float*)(ws + WS_STB);
        for (int gid = blockIdx.x * NTHR + tid; gid < 131072; gid += gridDim.x * NTHR) {
            const int el = gid & 4095, dir = (gid >> 12) & 1, h = (gid >> 13) & 3, b = gid >> 15;
            const float dec = __expf(log_sigmoid(theta[dir * 4 + h]) * 128.f);
            const float* __restrict__ kv = dir ? kvb : kvf; float* __restrict__ st = dir ? stb : stf;
            float s = 0.f;
            for (int c0 = 0; c0 < 32; c0 += 16) {
                float kk[16];
#pragma unroll
                for (int k = 0; k < 16; ++k) { const int c = dir ? (31 - (c0 + k)) : (c0 + k); kk[k] = kv[(size_t)((b * 32 + c) * 4 + h) * 4096 + el]; }
#pragma unroll
                for (int k = 0; k < 16; ++k) { const int c = dir ? (31 - (c0 + k)) : (c0 + k); st[(size_t)((b * 32 + c) * 4 + h) * 4096 + el] = s; s = fmaf(dec, s, kk[k]); }
            }
        }
    }
}

__device__ __forceinline__ void phase_ln1_router(const Args& a, int l, LAS unsigned char* lds, int tid) {
    unsigned char* ws = a.ws;
    const int lane = tid & 63, wave = tid >> 6;
    LAS float* rwT = (LAS float*)lds;
    const float* rw = a.in[19] + (size_t)l * DM * NE;
    for (int i = tid; i < DM * NE; i += NTHR) rwT[(i & 15) * DM + (i >> 4)] = rw[i];
    __syncthreads();
    const float* pre = (const float*)(ws + WS_RA);
    float* afft = (float*)(ws + WS_AFFT);
    const int gw = blockIdx.x * NWAVES + wave, NGW = gridDim.x * NWAVES;
    const bool b5 = (lane & 32) != 0, b4 = (lane & 16) != 0, b3 = (lane & 8) != 0, b2 = (lane & 4) != 0;
    f32x4 vn[4];
    if (gw < MTOK) {
#pragma unroll
        for (int j = 0; j < 4; ++j) vn[j] = ((const f32x4*)(pre + (size_t)gw * DM))[lane + 64 * j];
    }
    for (int m = gw; m < MTOK; m += NGW) {
        f32x4 v[4];
#pragma unroll
        for (int j = 0; j < 4; ++j) v[j] = vn[j];
        if (m + NGW < MTOK) {
#pragma unroll
            for (int j = 0; j < 4; ++j) vn[j] = ((const f32x4*)(pre + (size_t)(m + NGW) * DM))[lane + 64 * j];
        }
        ln_rows4(v, a.in[17] + l * DM, a.in[18] + l * DM, lane);
        store_row(v, nullptr, (bf16_t*)(ws + WS_HBF) + (size_t)m * DM, lane);
        float sp[16];
#pragma unroll
        for (int eg = 0; eg < 4; ++eg) {
#pragma unroll
            for (int ee = 0; ee < 4; ++ee) { const int e = eg * 4 + ee; float s = 0.f;
#pragma unroll
                for (int j = 0; j < 4; ++j) { const f32x4 wv = *(const LAS f32x4*)(rwT + e * DM + 256 * j + 4 * lane); s += (v[j][0] * wv[0] + v[j][1] * wv[1]) + (v[j][2] * wv[2] + v[j][3] * wv[3]); }
                sp[e] = s; }
            asm volatile("" ::: "memory");
        }
        float t8[8], t4[4], t2[2];
#pragma unroll
        for (int i = 0; i < 8; ++i) { const float snd = b5 ? sp[i] : sp[i + 8], kp = b5 ? sp[i + 8] : sp[i]; t8[i] = kp + __shfl_xor(snd, 32); }
#pragma unroll
        for (int i = 0; i < 4; ++i) { const float snd = b4 ? t8[i] : t8[i + 4], kp = b4 ? t8[i + 4] : t8[i]; t4[i] = kp + __shfl_xor(snd, 16); }
#pragma unroll
        for (int i = 0; i < 2; ++i) { const float snd = b3 ? t4[i] : t4[i + 2], kp = b3 ? t4[i + 2] : t4[i]; t2[i] = kp + __shfl_xor(snd, 8); }
        float lgt; { const float snd = b2 ? t2[0] : t2[1], kp = b2 ? t2[1] : t2[0]; lgt = kp + __shfl_xor(snd, 4); }
        lgt += __shfl_xor(lgt, 1); lgt += __shfl_xor(lgt, 2);
        float mx = lgt;
#pragma unroll
        for (int o = 4; o < 64; o <<= 1) mx = fmaxf(mx, __shfl_xor(mx, o));
        const float ex = expf(lgt - mx);
        float sum = ex;
#pragma unroll
        for (int o = 4; o < 64; o <<= 1) sum += __shfl_xor(sum, o);
        const int b = m / SEQ, t = m % SEQ;
        if ((lane & 3) == 0) afft[(size_t)(b * NE + (lane >> 2)) * SEQ + t] = ex / sum;
    }
    __syncthreads();
}

__device__ __forceinline__ void select_item(int item, const Args& a, LAS unsigned char* lds, int tid) {
    unsigned char* ws = a.ws;
    const int q = item & 3, e = (item >> 2) & 15, b = item >> 6;
    const int lane = tid & 63, wave = tid >> 6;
    LAS unsigned* red = (LAS unsigned*)lds;
    LAS int* sel = (LAS int*)(lds + 1024);
    const float* av = (const float*)(ws + WS_AFFT) + (size_t)(b * NE + e) * SEQ + tid * 8;
    const f32x4 va = *(const f32x4*)av, vb = *(const f32x4*)(av + 4);
    unsigned v[8] = {__float_as_uint(va[0]), __float_as_uint(va[1]), __float_as_uint(va[2]), __float_as_uint(va[3]), __float_as_uint(vb[0]), __float_as_uint(vb[1]), __float_as_uint(vb[2]), __float_as_uint(vb[3])};
    unsigned x = 0u;
    for (int bit = 30; bit >= 0; --bit) {
        const unsigned cand = x | (1u << bit);
        unsigned cnt = 0u;
#pragma unroll
        for (int j = 0; j < 8; ++j) cnt += (unsigned)__popcll(__ballot(v[j] >= cand));
        LAS unsigned* rb = red + (bit & 1) * 8;
        if (lane == 0) rb[wave] = cnt;
        __syncthreads();
        unsigned tot = 0u;
#pragma unroll
        for (int k = 0; k < 8; ++k) tot += rb[k];
        if (tot >= (unsigned)CAP) x = cand;
    }
    unsigned mycnt = 0u;
#pragma unroll
    for (int j = 0; j < 8; ++j) mycnt += (v[j] > x ? 1u : 0u) + (v[j] == x ? 0x10000u : 0u);
    unsigned inc = mycnt;
#pragma unroll
    for (int o = 1; o < 64; o <<= 1) { const unsigned t = __shfl_up(inc, o); if (lane >= o) inc += t; }
    LAS unsigned* wsum = red + 64;
    __syncthreads();
    if (lane == 63) wsum[wave] = inc;
    __syncthreads();
    unsigned wpre = 0u, total = 0u;
#pragma unroll
    for (int k = 0; k < 8; ++k) { const unsigned t = wsum[k]; if (k < wave) wpre += t; total += t; }
    const unsigned excl = wpre + inc - mycnt;
    unsigned gtb = excl & 0xffffu, eqb = excl >> 16;
    const unsigned need = (unsigned)CAP - (total & 0xffffu);
    const int rowbase = (e * NB + b) * CAP;
    int* idx = (int*)(ws + WS_IDX); float* gate = (float*)(ws + WS_GATE); int* slotmap = (int*)(ws + WS_SLOT);
    const bool own_tok = ((tid >> 7) == q);
#pragma unroll
    for (int j = 0; j < 8; ++j) {
        const bool isgt = v[j] > x, iseq = v[j] == x;
        const bool issel = isgt || (iseq && eqb < need);
        const unsigned slot = gtb + (eqb < need ? eqb : need);
        const int tok = b * SEQ + tid * 8 + j;
        if (issel && (int)(slot >> 7) == q) { idx[rowbase + slot] = tok; gate[rowbase + slot] = __uint_as_float(v[j]); sel[slot & 127] = tok; }
        if (own_tok) slotmap[(size_t)tok * NE + e] = issel ? (int)(rowbase + slot) : -1;
        gtb += isgt ? 1u : 0u; eqb += iseq ? 1u : 0u;
    }
    __syncthreads();
    const bf16_t* hbf = (const bf16_t*)(ws + WS_HBF); bf16_t* xs = (bf16_t*)(ws + WS_RA);
#pragma unroll
    for (int hb = 0; hb < 2; ++hb) {
        u32x4 d0[8], d1[8];
#pragma unroll
        for (int i = 0; i < 8; ++i) { const int tok = sel[wave + 8 * (hb * 8 + i)]; const u32x4* src = (const u32x4*)(hbf + (size_t)tok * DM); d0[i] = src[lane]; d1[i] = src[lane + 64]; }
#pragma unroll
        for (int i = 0; i < 8; ++i) { u32x4* dst = (u32x4*)(xs + (size_t)(rowbase + q * 128 + wave + 8 * (hb * 8 + i)) * DM); dst[lane] = d0[i]; dst[lane + 64] = d1[i]; }
    }
    __syncthreads();
}

__device__ __forceinline__ void phase_ln2(const Args& a, int l, int tid) {
    unsigned char* ws = a.ws;
    const int lane = tid & 63, wave = tid >> 6;
    const int gw = blockIdx.x * NWAVES + wave, NGW = gridDim.x * NWAVES;
    const bf16_t* hbf = (const bf16_t*)(ws + WS_HBF); const int* slotmap = (const int*)(ws + WS_SLOT); const bf16_t* contrib = (const bf16_t*)(ws + WS_RB);
    const bool last = (l == 1);
    u32x2 vn[4]; int slot_n = -1;
    if (gw < MTOK) {
#pragma unroll
        for (int j = 0; j < 4; ++j) vn[j] = ((const u32x2*)(hbf + (size_t)gw * DM))[lane + 64 * j];
        slot_n = slotmap[(size_t)gw * NE + (lane & 15)];
    }
    for (int m = gw; m < MTOK; m += NGW) {
        f32x4 v[4];
#pragma unroll
        for (int j = 0; j < 4; ++j) { v[j][0] = bflo(vn[j].x) * ALPHA; v[j][1] = bfhi(vn[j].x) * ALPHA; v[j][2] = bflo(vn[j].y) * ALPHA; v[j][3] = bfhi(vn[j].y) * ALPHA; }
        const int myslot = slot_n;
        unsigned bal = (unsigned)(__ballot(myslot >= 0) & 0xffffull);
        int r0 = -1, r1 = -1, r2 = -1, r3 = -1;
        if (bal) { r0 = __shfl(myslot, __builtin_ctz(bal)); bal &= bal - 1; }
        if (bal) { r1 = __shfl(myslot, __builtin_ctz(bal)); bal &= bal - 1; }
        if (bal) { r2 = __shfl(myslot, __builtin_ctz(bal)); bal &= bal - 1; }
        if (bal) { r3 = __shfl(myslot, __builtin_ctz(bal)); bal &= bal - 1; }
        u32x2 c0[4], c1[4], c2[4], c3[4];
#pragma unroll
        for (int j = 0; j < 4; ++j) { c0[j] = (u32x2){0u, 0u}; c1[j] = c0[j]; c2[j] = c0[j]; c3[j] = c0[j]; }
        if (r0 >= 0) {
#pragma unroll
            for (int j = 0; j < 4; ++j) c0[j] = ((const u32x2*)(contrib + (size_t)r0 * DM))[lane + 64 * j]; }
        if (r1 >= 0) {
#pragma unroll
            for (int j = 0; j < 4; ++j) c1[j] = ((const u32x2*)(contrib + (size_t)r1 * DM))[lane + 64 * j]; }
        if (r2 >= 0) {
#pragma unroll
            for (int j = 0; j < 4; ++j) c2[j] = ((const u32x2*)(contrib + (size_t)r2 * DM))[lane + 64 * j]; }
        if (r3 >= 0) {
#pragma unroll
            for (int j = 0; j < 4; ++j) c3[j] = ((const u32x2*)(contrib + (size_t)r3 * DM))[lane + 64 * j]; }
        if (m + NGW < MTOK) {
#pragma unroll
            for (int j = 0; j < 4; ++j) vn[j] = ((const u32x2*)(hbf + (size_t)(m + NGW) * DM))[lane + 64 * j];
            slot_n = slotmap[(size_t)(m + NGW) * NE + (lane & 15)];
        }
#pragma unroll
        for (int j = 0; j < 4; ++j) {
            v[j][0] += bflo(c0[j].x); v[j][1] += bfhi(c0[j].x); v[j][2] += bflo(c0[j].y); v[j][3] += bfhi(c0[j].y);
            v[j][0] += bflo(c1[j].x); v[j][1] += bfhi(c1[j].x); v[j][2] += bflo(c1[j].y); v[j][3] += bfhi(c1[j].y);
            v[j][0] += bflo(c2[j].x); v[j][1] += bfhi(c2[j].x); v[j][2] += bflo(c2[j].y); v[j][3] += bfhi(c2[j].y);
            v[j][0] += bflo(c3[j].x); v[j][1] += bfhi(c3[j].x); v[j][2] += bflo(c3[j].y); v[j][3] += bfhi(c3[j].y);
        }
        while (bal) {
            const int row = __shfl(myslot, __builtin_ctz(bal)); bal &= bal - 1;
            const u32x2* cr = (const u32x2*)(contrib + (size_t)row * DM);
#pragma unroll
            for (int j = 0; j < 4; ++j) { const u32x2 wv = cr[lane + 64 * j]; v[j][0] += bflo(wv.x); v[j][1] += bfhi(wv.x); v[j][2] += bflo(wv.y); v[j][3] += bfhi(wv.y); }
        }
        ln_rows4(v, a.in[23] + l * DM, a.in[24] + l * DM, lane);
        if (last) store_row(v, a.out + (size_t)m * DM, nullptr, lane);
        else store_row(v, nullptr, (bf16_t*)(ws + WS_HBF) + (size_t)m * DM, lane);
    }
}

typedef __attribute__((address_space(1))) unsigned gu32;
#define RLX_AGENT __ATOMIC_RELAXED, __HIP_MEMORY_SCOPE_AGENT
#define XB_TMO      128
#define XB_XCNT(j)  (256  + 64 * (j))
#define XB_XSUB(j)  (1280 + 64 * (j))
#define XB_XGEN(j)  (2304 + 64 * (j))
#define XB_TOP      3328
#define XB_TOPGEN   3392
#define XCD_BAR_WORDS 3456
#define XB_SPIN_CAP (1u << 18)

__device__ __forceinline__ unsigned xb_ld(unsigned* p)              { return __hip_atomic_load(p, __ATOMIC_RELAXED, __HIP_MEMORY_SCOPE_AGENT); }
__device__ __forceinline__ unsigned xb_add(unsigned* p, unsigned v) { return __hip_atomic_fetch_add(p, v, __ATOMIC_RELAXED, __HIP_MEMORY_SCOPE_AGENT); }
__device__ __forceinline__ unsigned xb_xcc_id() { return (unsigned)__builtin_amdgcn_s_getreg((3 << 11) | 20) & 0xFu; }
#define XB_SPIN(cond, bar) do { unsigned _sp = 0; while (cond) { __builtin_amdgcn_s_sleep(1); \
    if ((++_sp & 255u) == 0u) { if (xb_ld(&(bar)[XB_TMO])) break; if (_sp > XB_SPIN_CAP) { atomicAdd(&(bar)[XB_TMO], 1u); break; } } } } while (0)

struct XcdBarrier {
    unsigned* bar; unsigned x;
    volatile LAS unsigned* st;
};

__device__ __forceinline__ XcdBarrier xcd_barrier_post(unsigned* bar, volatile LAS unsigned* st) {
    XcdBarrier b; b.bar = bar; b.x = xb_xcc_id(); b.st = st;
    if (threadIdx.x == 0) (void)xb_add(&bar[XB_XCNT(b.x)], 1u);
    return b;
}
__device__ __forceinline__ void xcd_barrier_complete(unsigned* bar, unsigned x, unsigned& nloc, unsigned& nx) {
    const unsigned G = gridDim.x * gridDim.y * gridDim.z;
    unsigned sum, cnt, mine, sp = 0u;
    for (;;) {
        sum = 0u; cnt = 0u; mine = 0u;
#pragma unroll
        for (unsigned j = 0; j < 16; ++j) { const unsigned c = xb_ld(&bar[XB_XCNT(j)]); sum += c; cnt += (c > 0u) ? 1u : 0u; mine = (j == x) ? c : mine; }
        if (sum == G) break;
        __builtin_amdgcn_s_sleep(1);
        if ((++sp & 255u) == 0u) { if (xb_ld(&bar[XB_TMO])) break; if (sp > XB_SPIN_CAP) { atomicAdd(&bar[XB_TMO], 1u); break; } }
    }
    nloc = mine > 0u ? mine : 1u; nx = cnt > 0u ? cnt : 1u;
}

__device__ __forceinline__ void xcd_barrier(const XcdBarrier& b) {
    asm volatile("s_waitcnt vmcnt(0)" ::: "memory");
    __syncthreads();
    if (threadIdx.x == 0) {
        unsigned* bar = b.bar;
        __builtin_amdgcn_s_waitcnt(0);
        unsigned nloc = b.st[0], nx = b.st[1];
        if (nloc == 0u) { xcd_barrier_complete(bar, b.x, nloc, nx); b.st[0] = nloc; b.st[1] = nx; }
        const unsigned old = xb_add(&bar[XB_XSUB(b.x)], 1u);
        const unsigned gen = old / nloc;
        if (old + 1u == (gen + 1u) * nloc) {
            __builtin_amdgcn_fence(__ATOMIC_RELEASE, "agent");
            asm volatile("s_waitcnt vmcnt(0)" ::: "memory");
            const unsigned og = xb_add(&bar[XB_TOP], 1u);
            const unsigned tg = og / nx;
            if (og + 1u == (tg + 1u) * nx) xb_add(&bar[XB_TOPGEN], 1u);
            else XB_SPIN(xb_ld(&bar[XB_TOPGEN]) == tg, bar);
            __builtin_amdgcn_fence(__ATOMIC_ACQUIRE, "agent");
            xb_add(&bar[XB_XGEN(b.x)], 1u);
            asm volatile("s_waitcnt vmcnt(0)" ::: "memory");
        } else {
            XB_SPIN(xb_ld(&bar[XB_XGEN(b.x)]) == gen, bar);
            __builtin_amdgcn_fence(__ATOMIC_ACQUIRE, "agent");
            asm volatile("s_waitcnt vmcnt(0)" ::: "memory");
        }
    }
    __syncthreads();
}

constexpr int NPHASES = 21;
#ifndef REP_MASK
#define REP_MASK 0
#endif
template <int L, int K>
__device__ __forceinline__ void run_phase(const Args& a, LAS unsigned char* lds, int tid) {
    unsigned char* ws = a.ws;
    constexpr int l = L;
    bf16_t* proj = (bf16_t*)(ws + WS_RA); bf16_t* mix = (bf16_t*)(ws + WS_RB);
    if constexpr (K == 0) {
        pg8::Gemm g{(const bf16_t*)(ws + WS_HBF), (const bf16_t*)(ws + WS_WIN) + (size_t)l * DIN * DM, MTOK, DIN, DM};
        pg8::StaticOrder S; S.init(MTOK, DIN, (int)gridDim.x, (int)blockIdx.x);
        pg8::EpiStoreBf16 E{proj, DIN};
        pg8::gemm_phase<pg8::EpiStoreBf16, pg8::StaticOrder, true, true>(lds, g, S, E);
    } else if constexpr (K == 1) {
        const float* tab = (const float*)(ws + WS_S5TAB) + (size_t)l * 2048 * 8;
        constexpr int XB = ((REP_MASK >> 11) & 1) ? 512 : ((REP_MASK >> 12) & 1) ? 256 : ((REP_MASK >> 13) & 1) ? 512 : 0, XOFF = ((REP_MASK >> 11) & 1) ? 0 : ((REP_MASK >> 12) & 1) ? 512 : 768;
        for (int it0 = blockIdx.x; it0 < 1280 + XB; it0 += gridDim.x) {
            const int it = it0 < 1280 ? it0 : it0 - 1280 + XOFF;
            if (it < 512) s5e_item(it, proj, tab, (const bf16_t*)(ws + WS_S5BT) + (size_t)l * 4096 * 32, (float*)(ws + WS_S5E), lds, tid);
            else if (it < 768) attn_item(it - 512, proj, mix, a.in[15] + l * 8, lds, tid);
            else retkv_item(it - 768, proj, (float*)(ws + WS_KVF), (float*)(ws + WS_KVB), a.in[4] + l * 8, lds, tid);
        }
    } else if constexpr (K == 2) {
        phase_scan(a, l, tid);
    } else if constexpr (K == 3) {
        const float* tab = (const float*)(ws + WS_S5TAB) + (size_t)l * 2048 * 8;
        constexpr int XD = ((REP_MASK >> 14) & 3) ? 512 : 0, XOFD = ((REP_MASK >> 14) & 1) ? 0 : 512;
        for (int it0 = blockIdx.x; it0 < 1024 + XD; it0 += gridDim.x) {
            const int it = it0 < 1024 ? it0 : it0 - 1024 + XOFD;
            if (it < 512) s5out_item(it, proj, tab, (const bf16_t*)(ws + WS_S5BT) + (size_t)l * 4096 * 32, (const bf16_t*)(ws + WS_S5CT) + (size_t)l * 65536, a.in[12] + l * 256,
                                     (const bf16_t*)(ws + WS_WGLU) + (size_t)l * 65536, a.in[14] + l * 256, (const float*)(ws + WS_S5C), mix, lds, tid);
            else retout_item(it - 512, proj, (const float*)(ws + WS_STF), (const float*)(ws + WS_STB), mix, a.in[4] + l * 8, lds, tid);
        }
    } else if constexpr (K == 4) {
        pg8::Gemm g{mix, (const bf16_t*)(ws + WS_WOUT) + (size_t)l * DM * DM, MTOK, DM, DM};
        pg8::StaticOrder S; S.init(MTOK, DM, (int)gridDim.x, (int)blockIdx.x);
        pg8::EpiResF32 E{(const bf16_t*)(ws + WS_HBF), (float*)(ws + WS_RA), DM, ALPHA};
        pg8::gemm_phase<pg8::EpiResF32, pg8::StaticOrder, true, true>(lds, g, S, E);
    } else if constexpr (K == 5) {
        phase_ln1_router(a, l, lds, tid);
    } else if constexpr (K == 6) {
        for (int it = blockIdx.x; it < 256; it += gridDim.x) select_item(it, a, lds, tid);
    } else if constexpr (K == 7) {
        pg8::Gemm g{(const bf16_t*)(ws + WS_RA), (const bf16_t*)(ws + WS_WGU) + (size_t)l * NE * 2 * FF * DM, NROWX, NE * 2 * FF, DM};
        pg8::GroupedOrder S; S.init(16, (int)gridDim.x, (int)blockIdx.x);
        pg8::EpiSwiGLU E{(bf16_t*)(ws + WS_HDN), FF, 16};
        pg8::gemm_phase<pg8::EpiSwiGLU, pg8::GroupedOrder, true, true>(lds, g, S, E);
    } else if constexpr (K == 8) {
        pg8::Gemm g{(const bf16_t*)(ws + WS_HDN), (const bf16_t*)(ws + WS_WD) + (size_t)l * NE * DM * FF, NROWX, NE * DM, FF};
        pg8::GroupedOrder S; S.init(4, (int)gridDim.x, (int)blockIdx.x);
        pg8::EpiScaleRow E{(bf16_t*)(ws + WS_RB), DM, 4, (const float*)(ws + WS_GATE)};
        pg8::gemm_phase<pg8::EpiScaleRow, pg8::GroupedOrder, true, true>(lds, g, S, E);
    } else {
        phase_ln2(a, l, tid);
    }
}
__global__ void __launch_bounds__(NTHR, 2) fwd_kernel(Args a) {
    extern __shared__ __attribute__((aligned(16))) unsigned char lds_raw[];
    LAS unsigned char* lds = (LAS unsigned char*)lds_raw;
    cg::grid_group grid = cg::this_grid();
    const int lo = a.ph_lo, hi = a.ph_hi;
    volatile LAS unsigned* bst = (volatile LAS unsigned*)(lds + LDS_BYTES - 64);
    if (threadIdx.x < 16) bst[threadIdx.x] = 0u;
    __syncthreads();
    XcdBarrier bar = xcd_barrier_post((unsigned*)(a.ws + WS_BAR), bst);
    if (hi > 1000) grid.sync();
#define PH_BEGIN(ph) if (lo <= (ph) && (ph) < hi) { int tid = threadIdx.x; asm volatile("" : "+v"(tid));
#define PH_END(ph) if ((ph) + 1 < hi) xcd_barrier(bar); }
    PH_BEGIN(0) for (int rep = 0; rep <= ((REP_MASK >> 10) & 1); ++rep) phase_p0(a, lds, tid); PH_END(0)
#define LAYER(L) \
    PH_BEGIN(1 + 10 * L + 0) for (int rep = 0; rep <= ((REP_MASK >> 0) & 1); ++rep) run_phase<L, 0>(a, lds, tid); PH_END(1 + 10 * L + 0) \
    PH_BEGIN(1 + 10 * L + 1) for (int rep = 0; rep <= ((REP_MASK >> 1) & 1); ++rep) run_phase<L, 1>(a, lds, tid); PH_END(1 + 10 * L + 1) \
    PH_BEGIN(1 + 10 * L + 2) for (int rep = 0; rep <= ((REP_MASK >> 2) & 1); ++rep) run_phase<L, 2>(a, lds, tid); PH_END(1 + 10 * L + 2) \
    PH_BEGIN(1 + 10 * L + 3) for (int rep = 0; rep <= ((REP_MASK >> 3) & 1); ++rep) run_phase<L, 3>(a, lds, tid); PH_END(1 + 10 * L + 3) \
    PH_BEGIN(1 + 10 * L + 4) for (int rep = 0; rep <= ((REP_MASK >> 4) & 1); ++rep) run_phase<L, 4>(a, lds, tid); PH_END(1 + 10 * L + 4) \
    PH_BEGIN(1 + 10 * L + 5) for (int rep = 0; rep <= ((REP_MASK >> 5) & 1); ++rep) run_phase<L, 5>(a, lds, tid); PH_END(1 + 10 * L + 5) \
    PH_BEGIN(1 + 10 * L + 6) for (int rep = 0; rep <= ((REP_MASK >> 6) & 1); ++rep) run_phase<L, 6>(a, lds, tid); PH_END(1 + 10 * L + 6) \
    PH_BEGIN(1 + 10 * L + 7) for (int rep = 0; rep <= ((REP_MASK >> 7) & 1); ++rep) run_phase<L, 7>(a, lds, tid); PH_END(1 + 10 * L + 7) \
    PH_BEGIN(1 + 10 * L + 8) for (int rep = 0; rep <= ((REP_MASK >> 8) & 1); ++rep) run_phase<L, 8>(a, lds, tid); PH_END(1 + 10 * L + 8) \
    PH_BEGIN(1 + 10 * L + 9) for (int rep = 0; rep <= (((REP_MASK >> 9) & 1) && L == 1 ? 1 : 0); ++rep) run_phase<L, 9>(a, lds, tid); PH_END(1 + 10 * L + 9)
    LAYER(0)
    LAYER(1)
#undef LAYER
#undef PH_BEGIN
#undef PH_END
}

#ifndef ONE_LAUNCH
#define ONE_LAUNCH 1
#endif
extern "C" void kernel_launch(void* const* d_in, const int* in_sizes, int n_in, void* d_out, int out_size, void* d_ws, size_t ws_size, hipStream_t stream) {
    static int grid = 0;
    if (grid == 0) {
        if (n_in != 25 || ws_size < WS_END) { fprintf(stderr, "kernel_launch: unexpected problem (n_in %d, ws %zu)\n", n_in, ws_size); grid = -1; return; }
        int dev = 0, cus = 0, per_cu = 0;
        (void)hipGetDevice(&dev);
        (void)hipDeviceGetAttribute(&cus, hipDeviceAttributeMultiprocessorCount, dev);
        if (hipFuncSetAttribute((const void*)fwd_kernel, hipFuncAttributeMaxDynamicSharedMemorySize, LDS_BYTES) != hipSuccess) { fprintf(stderr, "kernel_launch: hipFuncSetAttribute failed\n"); grid = -1; return; }
        if (hipOccupancyMaxActiveBlocksPerMultiprocessor(&per_cu, (const void*)fwd_kernel, NTHR, LDS_BYTES) != hipSuccess || per_cu < 1) { fprintf(stderr, "kernel_launch: occupancy query says %d\n", per_cu); per_cu = 1; }
        (void)hipGetLastError();
        if (cus <= 0) cus = 256;
        grid = cus * per_cu;
    }
    if (grid < 0) return;
    Args a{};
    for (int i = 0; i < 25; ++i) a.in[i] = (const float*)d_in[i];
    a.out = (float*)d_out; a.ws = (unsigned char*)d_ws;
#if ONE_LAUNCH
    if (hipMemsetAsync((char*)d_ws + WS_BAR, 0, 16384, stream) != hipSuccess) { fprintf(stderr, "kernel_launch: memset failed\n"); return; }
    a.ph_lo = 0; a.ph_hi = NPHASES;
    void* args[] = {&a};
    hipError_t e = hipLaunchCooperativeKernel((const void*)fwd_kernel, dim3(grid), dim3(NTHR), args, LDS_BYTES, stream);
    if (e != hipSuccess) fprintf(stderr, "kernel_launch: cooperative launch failed: %s (grid %d)\n", hipGetErrorString(e), grid);
#else
    for (int ph = 0; ph < NPHASES; ++ph) {
        a.ph_lo = ph; a.ph_hi = ph + 1;
        hipLaunchKernelGGL(fwd_kernel, dim3(grid), dim3(NTHR), LDS_BYTES, stream, a);
    }
#endif
}
```

```cpp
#include <hip/hip_runtime.h>
#include <hip/hip_cooperative_groups.h>
#include <cstdio>
#include <cstdint>
namespace cg = cooperative_groups;
namespace pg8 {
#define PG8_LAS __attribute__((address_space(3)))
typedef unsigned short bf16_t;
typedef short bf16x8 __attribute__((ext_vector_type(8)));
typedef float f32x4 __attribute__((ext_vector_type(4)));
typedef unsigned u32x4 __attribute__((ext_vector_type(4)));
constexpr int BM = 256, BK = 64, HALF = 128, HTB = HALF * BK * 2  , STAGE_BYTES = 8 * HTB, NXCD = 8, WGM = 8;

__host__ __device__ __forceinline__ int lds_byte(int r, int c) { const int st = (r >> 4) * 2 + (c >> 5), rr = r & 15, cc = c & 31, ob = rr * 64 + cc * 2; return st * 1024 + (ob ^ (((ob >> 9) & 1) << 5)); }
__host__ __device__ __forceinline__ void stage_rc(int b, int& R, int& C) { const int st = b / 1024, sb = b % 1024, swz = sb ^ (((sb >> 9) & 1) << 5); R = (st >> 1) * 16 + swz / 64; C = (st & 1) * 32 + (swz % 64) / 2; }
__host__ __device__ __forceinline__ int perm32(int rho) { const int n = rho >> 4, i = rho & 15; return 8 * (i >> 2) + 4 * n + (i & 3); }

struct Unit { int pm, pn; };
struct Gemm { const bf16_t* A; const bf16_t* Bt; int M, N, K; };

struct StaticOrder {
    int nM, nN, nwg, G, c;
    __host__ __device__ void init(int M, int N, int G_, int c_) { nM = M / BM; nN = N / BM; nwg = nM * nN; G = G_; c = c_; }
    __host__ __device__ bool next(int i, Unit& u) const {
        const long L = (long)i * G + c; if (L >= nwg) return false;
        int wgid = (int)L; { const int q = nwg / NXCD, r = nwg % NXCD, xcd = wgid % NXCD, off = wgid / NXCD; wgid = (xcd < r ? xcd * (q + 1) : r * (q + 1) + (xcd - r) * q) + off; }
        const int nig = WGM * nN, gid = wgid / nig, fm = gid * WGM, gsz = (nM - fm) < WGM ? (nM - fm) : WGM;
        u.pm = fm + ((wgid % nig) % gsz); u.pn = (wgid % nig) / gsz; return true;
    }
    __device__ __forceinline__ void a_ready(const Unit&) const {}
    __device__ __forceinline__ void done(const Unit&) const {}
};

__device__ __forceinline__ unsigned cvt_pk_bf16(float lo, float hi) { unsigned r; asm volatile("v_cvt_pk_bf16_f32 %0, %1, %2" : "=v"(r) : "v"(lo), "v"(hi)); return r; }
typedef unsigned u32x2 __attribute__((ext_vector_type(2)));

struct GroupedOrder {
    int upe, nNe, nwg, G, c;
    __host__ __device__ void init(int nNe_, int G_, int c_) { nNe = nNe_; upe = 8 * nNe_; nwg = 16 * upe; G = G_; c = c_; }
    __host__ __device__ bool next(int i, Unit& u) const {
        const long L = (long)i * G + c; if (L >= nwg) return false;
        int wgid = (int)L; { const int q = nwg / NXCD, r = nwg % NXCD, xcd = wgid % NXCD, off = wgid / NXCD; wgid = (xcd < r ? xcd * (q + 1) : r * (q + 1) + (xcd - r) * q) + off; }
        const int e = wgid / upe, rr = wgid % upe;
        u.pm = e * 8 + (rr & 7); u.pn = e * nNe + (rr >> 3); return true;
    }
    __device__ __forceinline__ void a_ready(const Unit&) const {}
    __device__ __forceinline__ void done(const Unit&) const {}
};

struct EpiStoreBf16 {
    static constexpr bool PERM = true, AFTER_DRAIN = false;
    bf16_t* O; int ldc;
    __device__ __forceinline__ void operator()(const f32x4 (&acc)[2][2][4][2], const Unit& u, int wr, int wc, int fr, int fq) const {
        const int row0 = u.pm * BM + wr * 64 + fr, col0 = u.pn * BM + wc * 32 + 8 * fq;
#pragma unroll
        for (int ai = 0; ai < 2; ++ai)
#pragma unroll
            for (int m = 0; m < 4; ++m) { bf16_t* rowp = O + (size_t)(row0 + ai * HALF + m * 16) * ldc + col0;
#pragma unroll
                for (int bj = 0; bj < 2; ++bj) { const f32x4 v0 = acc[ai][bj][m][0], v1 = acc[ai][bj][m][1];
                    u32x4 w; w.x = cvt_pk_bf16(v0[0], v0[1]); w.y = cvt_pk_bf16(v0[2], v0[3]); w.z = cvt_pk_bf16(v1[0], v1[1]); w.w = cvt_pk_bf16(v1[2], v1[3]);
                    *(u32x4*)(rowp + bj * HALF) = w; } }
    }
};
struct EpiResF32 {
    static constexpr bool PERM = false, AFTER_DRAIN = false;
    const bf16_t* base; float* O; int ldc; float alpha;
    __device__ __forceinline__ void operator()(const f32x4 (&acc)[2][2][4][2], const Unit& u, int wr, int wc, int fr, int fq) const {
        const int row0 = u.pm * BM + wr * 64 + fr, col0 = u.pn * BM + wc * 32 + 4 * fq;
#pragma unroll
        for (int ai = 0; ai < 2; ++ai)
#pragma unroll
            for (int m = 0; m < 4; ++m) { const size_t ro = (size_t)(row0 + ai * HALF + m * 16) * ldc + col0;
#pragma unroll
                for (int bj = 0; bj < 2; ++bj)
#pragma unroll
                    for (int n = 0; n < 2; ++n) { const u32x2 bw = *(const u32x2*)(base + ro + bj * HALF + 16 * n);
                        f32x4 b; b[0] = __uint_as_float(bw.x << 16); b[1] = __uint_as_float(bw.x & 0xffff0000u); b[2] = __uint_as_float(bw.y << 16); b[3] = __uint_as_float(bw.y & 0xffff0000u);
                        *(f32x4*)(O + ro + bj * HALF + 16 * n) = b * alpha + acc[ai][bj][m][n]; } }
    }
};
struct EpiSwiGLU {
    static constexpr bool PERM = true, AFTER_DRAIN = false;
    bf16_t* O; int ldc; int ntn;
    __device__ __forceinline__ void operator()(const f32x4 (&acc)[2][2][4][2], const Unit& u, int wr, int wc, int fr, int fq) const {
        const int row0 = u.pm * BM + wr * 64 + fr, col0 = ((u.pn % ntn) * BM + wc * 32 + 8 * fq) >> 1;
#pragma unroll
        for (int ai = 0; ai < 2; ++ai)
#pragma unroll
            for (int m = 0; m < 4; ++m) { bf16_t* rowp = O + (size_t)(row0 + ai * HALF + m * 16) * ldc + col0;
#pragma unroll
                for (int bj = 0; bj < 2; ++bj) { const f32x4 v0 = acc[ai][bj][m][0], v1 = acc[ai][bj][m][1];
                    const float h0 = v0[0] * v0[1] * __builtin_amdgcn_rcpf(1.f + __expf(-v0[0])), h1 = v0[2] * v0[3] * __builtin_amdgcn_rcpf(1.f + __expf(-v0[2]));
                    const float h2 = v1[0] * v1[1] * __builtin_amdgcn_rcpf(1.f + __expf(-v1[0])), h3 = v1[2] * v1[3] * __builtin_amdgcn_rcpf(1.f + __expf(-v1[2]));
                    u32x2 w; w.x = cvt_pk_bf16(h0, h1); w.y = cvt_pk_bf16(h2, h3);
                    *(u32x2*)(rowp + bj * (HALF / 2)) = w; } }
    }
};
struct EpiScaleRow {
    static constexpr bool PERM = true, AFTER_DRAIN = false;
    bf16_t* O; int ldc; int ntn; const float* gate;
    __device__ __forceinline__ void operator()(const f32x4 (&acc)[2][2][4][2], const Unit& u, int wr, int wc, int fr, int fq) const {
        const int row0 = u.pm * BM + wr * 64 + fr, col0 = (u.pn % ntn) * BM + wc * 32 + 8 * fq;
#pragma unroll
        for (int ai = 0; ai < 2; ++ai)
#pragma unroll
            for (int m = 0; m < 4; ++m) { const int row = row0 + ai * HALF + m * 16; const float gsc = gate[row]; bf16_t* rowp = O + (size_t)row * ldc + col0;
#pragma unroll
                for (int bj = 0; bj < 2; ++bj) { const f32x4 v0 = acc[ai][bj][m][0] * gsc, v1 = acc[ai][bj][m][1] * gsc;
                    u32x4 w; w.x = cvt_pk_bf16(v0[0], v0[1]); w.y = cvt_pk_bf16(v0[2], v0[3]); w.z = cvt_pk_bf16(v1[0], v1[1]); w.w = cvt_pk_bf16(v1[2], v1[3]);
                    *(u32x4*)(rowp + bj * HALF) = w; } }
    }
};

template <class Epi, class Sched, bool ALIGN_EPI = false, bool SP2 = false>
__device__ __forceinline__ void gemm_phase(PG8_LAS unsigned char* lds, const Gemm g, const Sched& S, const Epi& E) {
    int tid_ = threadIdx.x; asm volatile("" : "+v"(tid_)); const int tid = tid_, wid = __builtin_amdgcn_readfirstlane(tid >> 6), lane = tid & 63, wr = wid >> 2, wc = wid & 3, fr = lane & 15, fq = lane >> 4;
    const int K = g.K, nt = K / BK;
    unsigned voffA[2], voffB[2];
#pragma unroll
    for (int i = 0; i < 2; ++i) { int R, C; stage_rc(tid * 16 + i * 8192, R, C); const int Rb = Epi::PERM ? ((R & ~31) + perm32(R & 31)) : R;
        voffA[i] = (unsigned)(R * K + C) * 2u; voffB[i] = (unsigned)(Rb * K + C) * 2u; }
    const size_t kstep = (size_t)(BK * 2);
    const size_t hstep = (size_t)HALF * K * 2;
    const size_t tstep = 2 * hstep;
    const unsigned ldsw = (unsigned)wid * 1024u;
    const int aoff = lds_byte(wr * 64 + fr, fq * 8), boff = lds_byte(wc * 32 + fr, fq * 8);
#define PG8_SA(b, h) (((b) * 2 + (h)) * HTB)
#define PG8_SB(b, h) ((4 + (b) * 2 + (h)) * HTB)
#define PG8_STAGE(bufoff, gbase, voff) do { _Pragma("unroll") for (int _i = 0; _i < 2; ++_i) \
        __builtin_amdgcn_global_load_lds((const unsigned*)((const char*)(gbase) + (voff)[_i]), (PG8_LAS unsigned*)(lds + (bufoff) + ldsw + _i * 8192), 16, 0, 0); } while (0)
#define PG8_LDA(dst, b, h) do { _Pragma("unroll") for (int m = 0; m < 4; ++m) _Pragma("unroll") for (int k = 0; k < 2; ++k) dst[m][k] = *(const PG8_LAS bf16x8*)(lds + PG8_SA(b, h) + aoff + m * 2048 + k * 1024); } while (0)
#define PG8_LDB(dst, b, h) do { _Pragma("unroll") for (int n = 0; n < 2; ++n) _Pragma("unroll") for (int k = 0; k < 2; ++k) dst[n][k] = *(const PG8_LAS bf16x8*)(lds + PG8_SB(b, h) + boff + n * 2048 + k * 1024); } while (0)
#define PG8_MMA(ai, bj, At, Bt) do { __builtin_amdgcn_s_setprio(1); _Pragma("unroll") for (int m = 0; m < 4; ++m) _Pragma("unroll") for (int n = 0; n < 2; ++n) _Pragma("unroll") for (int k = 0; k < 2; ++k) \
        acc[ai][bj][m][n] = __builtin_amdgcn_mfma_f32_16x16x32_bf16(Bt[n][k], At[m][k], acc[ai][bj][m][n], 0, 0, 0); __builtin_amdgcn_s_setprio(0); } while (0)
#define PG8_WAIT_V(n) asm volatile("s_waitcnt vmcnt(" #n ")" ::: "memory")
#define PG8_WAIT_L(n) asm volatile("s_waitcnt lgkmcnt(" #n ")" ::: "memory")
#define PG8_BAR __builtin_amdgcn_s_barrier()
#define PG8_SCHED __builtin_amdgcn_sched_barrier(0)
    Unit cur, nxt; int ui = 0;
    if (!S.next(0, cur)) return;
    f32x4 acc[2][2][4][2];
#pragma unroll
    for (int a = 0; a < 2; ++a)
#pragma unroll
        for (int b = 0; b < 2; ++b)
#pragma unroll
            for (int m = 0; m < 4; ++m)
#pragma unroll
                for (int n = 0; n < 2; ++n) acc[a][b][m][n] = (f32x4){0.f, 0.f, 0.f, 0.f};
    bf16x8 At[4][2], B0[2][2], B1[2][2];
    const char* cA = (const char*)g.A + (size_t)cur.pm * tstep; const char* cB = (const char*)g.Bt + (size_t)cur.pn * tstep;
    S.a_ready(cur);
    if constexpr (SP2) {
        PG8_STAGE(PG8_SB(0, 0), cB, voffB); PG8_STAGE(PG8_SB(0, 1), cB + hstep, voffB); PG8_STAGE(PG8_SA(0, 0), cA, voffA); PG8_STAGE(PG8_SA(0, 1), cA + hstep, voffA);
        if (wr == 1) PG8_BAR;
        PG8_WAIT_V(2); PG8_BAR;
        PG8_STAGE(PG8_SB(1, 0), cB + kstep, voffB); PG8_STAGE(PG8_SA(1, 0), cA + kstep, voffA); PG8_STAGE(PG8_SB(1, 1), cB + hstep + kstep, voffB);
        PG8_WAIT_V(6); PG8_BAR;
    } else {
        PG8_STAGE(PG8_SB(0, 0), cB, voffB); PG8_STAGE(PG8_SA(0, 0), cA, voffA); PG8_STAGE(PG8_SB(0, 1), cB + hstep, voffB); PG8_STAGE(PG8_SA(0, 1), cA + hstep, voffA);
        if (wr == 1) PG8_BAR;
        PG8_WAIT_V(4); PG8_BAR;
        PG8_STAGE(PG8_SB(1, 0), cB + kstep, voffB); PG8_STAGE(PG8_SA(1, 0), cA + kstep, voffA); PG8_STAGE(PG8_SB(1, 1), cB + hstep + kstep, voffB);
        PG8_WAIT_V(6); PG8_BAR;
    }
    for (;;) {
        const bool has_next = S.next(ui + 1, nxt);
        const char* nA = has_next ? (const char*)g.A + (size_t)nxt.pm * tstep : cA; const char* nB = has_next ? (const char*)g.Bt + (size_t)nxt.pn * tstep : cB;
        for (int t = 0; t < nt; t += 2) {
            const bool last = (t == nt - 2);
            const char* a1 = cA + (size_t)(t + 1) * kstep;
            const char* a2 = last ? nA : cA + (size_t)(t + 2) * kstep; const char* b2 = last ? nB : cB + (size_t)(t + 2) * kstep;
            const char* a3 = a2 + kstep; const char* b3 = b2 + kstep;
            if (last && has_next) S.a_ready(nxt);
            if constexpr (SP2) {
            PG8_LDB(B0, 0, 0); PG8_LDB(B1, 0, 1); PG8_SCHED; PG8_LDA(At, 0, 0); PG8_STAGE(PG8_SA(1, 1), a1 + hstep, voffA);
            PG8_WAIT_V(8); PG8_WAIT_L(0); PG8_BAR; PG8_MMA(0, 0, At, B0); PG8_MMA(0, 1, At, B1); PG8_BAR; PG8_SCHED;
            PG8_LDA(At, 0, 1); PG8_STAGE(PG8_SB(0, 0), b2, voffB); PG8_STAGE(PG8_SB(0, 1), b2 + hstep, voffB); PG8_STAGE(PG8_SA(0, 0), a2, voffA);
            PG8_WAIT_V(8); PG8_WAIT_L(0); PG8_BAR; PG8_MMA(1, 0, At, B0); PG8_MMA(1, 1, At, B1); PG8_BAR; PG8_SCHED;
            PG8_LDB(B0, 1, 0); PG8_LDB(B1, 1, 1); PG8_SCHED; PG8_LDA(At, 1, 0); PG8_STAGE(PG8_SA(0, 1), a2 + hstep, voffA);
            PG8_WAIT_V(8); PG8_WAIT_L(0); PG8_BAR; PG8_MMA(0, 0, At, B0); PG8_MMA(0, 1, At, B1); PG8_BAR; PG8_SCHED;
            PG8_LDA(At, 1, 1); PG8_STAGE(PG8_SB(1, 0), b3, voffB); PG8_STAGE(PG8_SB(1, 1), b3 + hstep, voffB); PG8_STAGE(PG8_SA(1, 0), a3, voffA);
            PG8_WAIT_V(8); PG8_WAIT_L(0); PG8_BAR; PG8_MMA(1, 0, At, B0); PG8_MMA(1, 1, At, B1); PG8_BAR; PG8_SCHED;
            } else {
            PG8_LDB(B0, 0, 0); PG8_SCHED; PG8_LDA(At, 0, 0); PG8_STAGE(PG8_SA(1, 1), a1 + hstep, voffA);
            PG8_WAIT_L(8); PG8_BAR; PG8_WAIT_L(0); PG8_MMA(0, 0, At, B0); PG8_BAR; PG8_SCHED;
            PG8_LDB(B1, 0, 1); PG8_STAGE(PG8_SB(0, 0), b2, voffB);
            PG8_BAR; PG8_WAIT_L(0); PG8_MMA(0, 1, At, B1); PG8_BAR;
            PG8_LDA(At, 0, 1); PG8_STAGE(PG8_SA(0, 0), a2, voffA);
            PG8_BAR; PG8_WAIT_L(0); PG8_MMA(1, 0, At, B0); PG8_BAR; PG8_SCHED;
            PG8_STAGE(PG8_SB(0, 1), b2 + hstep, voffB);
            PG8_WAIT_V(6); PG8_BAR; PG8_MMA(1, 1, At, B1); PG8_BAR;
            PG8_LDB(B0, 1, 0); PG8_SCHED; PG8_LDA(At, 1, 0); PG8_STAGE(PG8_SA(0, 1), a2 + hstep, voffA);
            PG8_WAIT_L(8); PG8_BAR; PG8_WAIT_L(0); PG8_MMA(0, 0, At, B0); PG8_BAR; PG8_SCHED;
            PG8_LDB(B1, 1, 1); PG8_STAGE(PG8_SB(1, 0), b3, voffB);
            PG8_BAR; PG8_WAIT_L(0); PG8_MMA(0, 1, At, B1); PG8_BAR;
            PG8_LDA(At, 1, 1); PG8_STAGE(PG8_SA(1, 0), a3, voffA);
            PG8_BAR; PG8_WAIT_L(0); PG8_MMA(1, 0, At, B0); PG8_BAR; PG8_SCHED;
            PG8_STAGE(PG8_SB(1, 1), b3 + hstep, voffB);
            PG8_WAIT_V(6); PG8_BAR; PG8_MMA(1, 1, At, B1); PG8_BAR;
            }
        }
        if constexpr (ALIGN_EPI) { if (wr == 0) PG8_BAR; }
        if constexpr (!Epi::AFTER_DRAIN) { E(acc, cur, wr, wc, fr, fq); S.done(cur); }
        if (!has_next) break;
#pragma unroll
        for (int a = 0; a < 2; ++a)
#pragma unroll
            for (int b = 0; b < 2; ++b)
#pragma unroll
                for (int m = 0; m < 4; ++m)
#pragma unroll
                    for (int n = 0; n < 2; ++n) acc[a][b][m][n] = (f32x4){0.f, 0.f, 0.f, 0.f};
        cur = nxt; cA = nA; cB = nB; ++ui;
        if constexpr (ALIGN_EPI) { if (wr == 1) PG8_BAR; }
    }
    PG8_WAIT_V(0);
    if constexpr (!ALIGN_EPI) { if (wr == 0) PG8_BAR; }
    PG8_BAR;
    if constexpr (Epi::AFTER_DRAIN) { E.fused(acc, cur, wr, wc, fr, fq, lds, wid, lane); S.done(cur); }
#undef PG8_SA
#undef PG8_SB
#undef PG8_STAGE
#undef PG8_LDA
#undef PG8_LDB
#undef PG8_MMA
#undef PG8_WAIT_V
#undef PG8_WAIT_L
#undef PG8_BAR
#undef PG8_SCHED
}
}

using pg8::bf16_t; using pg8::bf16x8; using pg8::f32x4; using pg8::u32x4; using pg8::u32x2;
#define LAS __attribute__((address_space(3)))
typedef short bf16x4 __attribute__((ext_vector_type(4)));

constexpr int NB = 4, SEQ = 4096, DM = 1024, MTOK = NB * SEQ, DIN = 2048, NE = 16, FF = 2048, CAP = 512, NROWX = NE * NB * CAP;
constexpr float ALPHA = 1.41421356237309515f, LN_EPS = 1e-5f;
constexpr int NWAVES = 8, NTHR = 512;
constexpr int LDS_BYTES = 147456;
constexpr int S5T = 32, S5NCH = SEQ / S5T;

constexpr size_t MiB = 1u << 20;
constexpr size_t WS_WIN = 0, WS_WOUT = 8 * MiB, WS_WGLU = 12 * MiB, WS_S5TAB = 13 * MiB, WS_AFFT = 14 * MiB, WS_IDX = 15 * MiB, WS_GATE = 16 * MiB, WS_SLOT = 17 * MiB, WS_BAR = 18 * MiB, WS_S5BT = 19 * MiB, WS_S5CT = 20 * MiB;
constexpr size_t WS_WGU = 32 * MiB, WS_WD = 288 * MiB, WS_H32 = 416 * MiB, WS_HBF = 480 * MiB, WS_RA = 512 * MiB  , WS_RB = 576 * MiB  ;
constexpr size_t WS_HDN = 640 * MiB, WS_KVF = 768 * MiB, WS_KVB = 776 * MiB, WS_STF = 784 * MiB, WS_STB = 792 * MiB, WS_S5E = 800 * MiB, WS_S5C = 808 * MiB, WS_END = 816 * MiB;

struct Args { const float* in[25]; float* out; unsigned char* ws; int ph_lo, ph_hi; };

typedef __bf16 bf16x2_hw __attribute__((ext_vector_type(2)));
typedef float f32x2_hw __attribute__((ext_vector_type(2)));
__device__ __forceinline__ unsigned pk2(float lo, float hi) { const f32x2_hw v = {lo, hi}; const bf16x2_hw b = __builtin_convertvector(v, bf16x2_hw); return __builtin_bit_cast(unsigned, b); }
__device__ __forceinline__ unsigned f2bf(float f) { return pk2(f, 0.f) & 0xffffu; }
__device__ __forceinline__ float bflo(unsigned w) { return __uint_as_float(w << 16); }
__device__ __forceinline__ float bfhi(unsigned w) { return __uint_as_float(w & 0xffff0000u); }
__device__ __forceinline__ f32x4 mfma16(bf16x8 a, bf16x8 b, f32x4 c) { return __builtin_amdgcn_mfma_f32_16x16x32_bf16(a, b, c, 0, 0, 0); }
__device__ __forceinline__ float wave_sum(float v) {
#pragma unroll
    for (int o = 1; o < 64; o <<= 1) v += __shfl_xor(v, o);
    return v;
}
__device__ __forceinline__ bf16x8 pack8(const f32x4& a, const f32x4& b) {
    u32x4 w; w.x = pk2(a[0], a[1]); w.y = pk2(a[2], a[3]); w.z = pk2(b[0], b[1]); w.w = pk2(b[2], b[3]);
    return __builtin_bit_cast(bf16x8, w);
}
__device__ __forceinline__ bf16x8 cat8(bf16x4 lo, bf16x4 hi) { bf16x8 r; r[0] = lo[0]; r[1] = lo[1]; r[2] = lo[2]; r[3] = lo[3]; r[4] = hi[0]; r[5] = hi[1]; r[6] = hi[2]; r[7] = hi[3]; return r; }
#define LDS_WAIT() asm volatile("s_waitcnt lgkmcnt(0)" ::: "memory")

struct ConvItem { const float* srcp; bf16_t* dstp; int N; int rstep; };
__device__ __forceinline__ ConvItem conv_decode(const Args& a, int it, int lane) {
    constexpr int I3 = 16384, I4 = 16384, I5 = 16384, I0 = 1024, I1 = 512;
    unsigned char* ws = a.ws;
    const float* src; bf16_t* dst; int K, N, rmul = 1, ro = 0, kb, nb;
    int r = it;
    if (r < I3 + I4) { const int up = r >= I3; r -= up ? I3 : 0; const int mat = r >> 9, q = r & 511; src = (up ? a.in[21] : a.in[20]) + (size_t)mat * DM * FF; dst = (bf16_t*)(ws + WS_WGU) + (size_t)mat * 2 * FF * DM; K = DM; N = FF; rmul = 2; ro = up; kb = q >> 5; nb = q & 31; }
    else { r -= I3 + I4;
        if (r < I5) { const int mat = r >> 9, q = r & 511; src = a.in[22] + (size_t)mat * FF * DM; dst = (bf16_t*)(ws + WS_WD) + (size_t)mat * DM * FF; K = FF; N = DM; kb = q >> 4; nb = q & 15; }
        else { r -= I5;
            if (r < I0) { const int mat = r >> 9, q = r & 511; src = a.in[3] + (size_t)mat * DM * DIN; dst = (bf16_t*)(ws + WS_WIN) + (size_t)mat * DIN * DM; K = DM; N = DIN; kb = q >> 5; nb = q & 31; }
            else { r -= I0;
                if (r < I1) { const int mat = r >> 8, q = r & 255; src = a.in[16] + (size_t)mat * DM * DM; dst = (bf16_t*)(ws + WS_WOUT) + (size_t)mat * DM * DM; K = DM; N = DM; kb = q >> 4; nb = q & 15; }
                else { r -= I1; const int mat = r >> 4, q = r & 15; src = a.in[13] + (size_t)mat * 65536; dst = (bf16_t*)(ws + WS_WGLU) + (size_t)mat * 65536; K = 256; N = 256; kb = q >> 2; nb = q & 3; } } } }
    ConvItem c; c.N = N;
    c.srcp = src + (size_t)(kb * 64 + (lane >> 4)) * N + nb * 64 + (lane & 15) * 4;
    c.dstp = dst + (size_t)((nb * 64) * rmul + ro) * K + kb * 64; c.rstep = rmul * K;
    return c;
}
__device__ __forceinline__ void conv_load(const ConvItem& c, f32x4 (&v)[16]) {
#pragma unroll
    for (int i = 0; i < 16; ++i) v[i] = __builtin_nontemporal_load((const f32x4*)(c.srcp + (size_t)(i * 4) * c.N));
}
__device__ __forceinline__ void conv_store(const ConvItem& c, const f32x4 (&v)[16], LAS float* scr, int lane) {
    const int r4 = lane >> 4, c4 = (lane & 15) * 4;
#pragma unroll
    for (int i = 0; i < 16; ++i) { const int kk = i * 4 + r4; *(LAS f32x4*)(scr + kk * 68 + (c4 ^ (((kk >> 3) & 7) * 4))) = v[i]; }
    LDS_WAIT();
    const int cc = lane & 7, nl = lane >> 3;
#pragma unroll
    for (int p = 0; p < 8; ++p) {
        const int n = nl + 8 * p;
        const LAS float* s = scr + (8 * cc) * 68 + (n ^ (4 * cc));
        u32x4 o; o.x = pk2(s[0], s[68]); o.y = pk2(s[2 * 68], s[3 * 68]); o.z = pk2(s[4 * 68], s[5 * 68]); o.w = pk2(s[6 * 68], s[7 * 68]);
        *(u32x4*)(c.dstp + (size_t)n * c.rstep + 8 * cc) = o;
    }
    LDS_WAIT();
}
__device__ __forceinline__ void sincos_rev(double f, double& sn, double& cs) {
    const double a = f * 6.283185307179586476925;
    const double q = rint(a * 0.636619772367581343);
    const double r = a - q * 1.570796326794896619;
    const double r2 = r * r;
    double s = -7.6471637318198164759e-13; s = s * r2 + 1.6059043836821614599e-10; s = s * r2 - 2.5052108385441718775e-8; s = s * r2 + 2.7557319223985890653e-6;
    s = s * r2 - 1.9841269841269841270e-4; s = s * r2 + 8.3333333333333333333e-3; s = s * r2 - 1.6666666666666666667e-1; s = s * r2 * r + r;
    double c = 4.7794773323873852974e-14; c = c * r2 - 1.1470745597729724714e-11; c = c * r2 + 2.0876756987868098979e-9; c = c * r2 - 2.7557319223985890653e-7;
    c = c * r2 + 2.4801587301587301587e-5; c = c * r2 - 1.3888888888888888889e-3; c = c * r2 + 4.1666666666666666667e-2; c = c * r2 - 0.5; c = c * r2 + 1.0;
    const int qi = ((int)q) & 3;
    sn = (qi == 0) ? s : (qi == 1) ? c : (qi == 2) ? -s : -c;
    cs = (qi == 0) ? c : (qi == 1) ? -s : (qi == 2) ? -c : s;
}
__device__ __forceinline__ double exp_small(double x) {
    const double y = x * (1.0 / 64.0);
    double e = 1.0 / 479001600.0;
    e = e * y + 1.0 / 39916800.0; e = e * y + 1.0 / 3628800.0; e = e * y + 1.0 / 362880.0; e = e * y + 1.0 / 40320.0; e = e * y + 1.0 / 5040.0; e = e * y + 1.0 / 720.0;
    e = e * y + 1.0 / 120.0; e = e * y + 1.0 / 24.0; e = e * y + 1.0 / 6.0; e = e * y + 0.5; e = e * y + 1.0; e = e * y + 1.0;
#pragma unroll
    for (int i = 0; i < 6; ++i) e = e * e;
    return e;
}
__device__ __forceinline__ void s5_coefs(const Args& a, int t, double& br, double& bi, double& cr, double& ci, double& tr, double& ti) {
    const int g = (t >> 6) & 15, lr = t >> 10;
    const double lre = (double)a.in[5][t], lim = (double)a.in[6][t];
    const double step = exp_small((double)a.in[7][lr * 16 + g]);
    const double ar = lre * step, th = lim * step;
    const double rev = th * 0.15915494309189533577; const double fr = rev - rint(rev);
    double sn, cs; sincos_rev(fr, sn, cs);
    const double mag = exp_small(ar);
    br = mag * cs; bi = mag * sn;
    const double nr = br - 1.0, ni = bi, den = lre * lre + lim * lim;
    cr = (nr * lre + ni * lim) / den; ci = (ni * lre - nr * lim) / den;
    const double rev2 = rev * (double)S5T; const double fr2 = rev2 - rint(rev2);
    double sn2, cs2; sincos_rev(fr2, sn2, cs2);
    const double mag2 = exp_small(ar * (double)S5T);
    tr = mag2 * cs2; ti = mag2 * sn2;
}
__device__ __forceinline__ void s5_table_entry(const Args& a, int t) {
    double br, bi, cr, ci, tr, ti; s5_coefs(a, t, br, bi, cr, ci, tr, ti);
    float* o = (float*)(a.ws + WS_S5TAB) + (size_t)t * 8;
    o[0] = (float)br; o[1] = (float)bi; o[2] = (float)cr; o[3] = (float)ci; o[4] = (float)tr; o[5] = (float)ti; o[6] = 0.f; o[7] = 0.f;
}
__device__ __forceinline__ void s5_bt_row(const Args& a, int t) {
    const int l = t >> 12, g = (t >> 8) & 15, n = t & 255, r = n >> 7, p = (n >> 1) & 63, ri = n & 1;
    double br, bi, cr, ci, tr, ti; s5_coefs(a, ((l * 2 + r) * 16 + g) * 64 + p, br, bi, cr, ci, tr, ti);
    const float crf = (float)cr, cif = (float)ci;
    const float* bre = a.in[8] + (size_t)((l * 16 + g) * 64 + p) * 16; const float* bim = a.in[9] + (size_t)((l * 16 + g) * 64 + p) * 16;
    u32x4 o[2];
#pragma unroll
    for (int h = 0; h < 2; ++h) {
        const f32x4 x0 = *(const f32x4*)(bre + 8 * h), x1 = *(const f32x4*)(bre + 8 * h + 4), y0 = *(const f32x4*)(bim + 8 * h), y1 = *(const f32x4*)(bim + 8 * h + 4);
        float v[8];
#pragma unroll
        for (int k = 0; k < 4; ++k) { v[k] = ri ? (crf * y0[k] + cif * x0[k]) : (crf * x0[k] - cif * y0[k]); v[4 + k] = ri ? (crf * y1[k] + cif * x1[k]) : (crf * x1[k] - cif * y1[k]); }
        o[h].x = pk2(v[0], v[1]); o[h].y = pk2(v[2], v[3]); o[h].z = pk2(v[4], v[5]); o[h].w = pk2(v[6], v[7]);
    }
    u32x4* dst = (u32x4*)((bf16_t*)(a.ws + WS_S5BT) + (size_t)t * 32);
    dst[0] = o[0]; dst[1] = o[1]; dst[2] = (u32x4){0u, 0u, 0u, 0u}; dst[3] = (u32x4){0u, 0u, 0u, 0u};
}
__device__ __forceinline__ void s5_ct_entry(const Args& a, int t) {
    const int p = t & 63, r = (t >> 6) & 1, c = (t >> 7) & 15, g = (t >> 11) & 15, l = t >> 15;
    const size_t ci = (size_t)(((l * 2 + r) * 16 + g) * 16 + c) * 64 + p;
    ((unsigned*)(a.ws + WS_S5CT))[t] = pk2(a.in[10][ci], -a.in[11][ci]);
}
__device__ __forceinline__ void ln_rows4(f32x4 (&v)[4], const float* __restrict__ g, const float* __restrict__ bt, int lane) {
    float s = 0.f;
#pragma unroll
    for (int j = 0; j < 4; ++j) s += (v[j][0] + v[j][1]) + (v[j][2] + v[j][3]);
    const float mean = wave_sum(s) * (1.f / DM); float s2 = 0.f;
#pragma unroll
    for (int j = 0; j < 4; ++j) { v[j] = v[j] - mean; s2 += (v[j][0] * v[j][0] + v[j][1] * v[j][1]) + (v[j][2] * v[j][2] + v[j][3] * v[j][3]); }
    const float rstd = 1.f / sqrtf(wave_sum(s2) * (1.f / DM) + LN_EPS);
#pragma unroll
    for (int j = 0; j < 4; ++j) { const f32x4 gv = ((const f32x4*)g)[lane + 64 * j], bv = ((const f32x4*)bt)[lane + 64 * j]; v[j] = v[j] * rstd * gv + bv; }
}
__device__ __forceinline__ void store_row(const f32x4 (&v)[4], float* o32, bf16_t* obf, int lane) {
#pragma unroll
    for (int j = 0; j < 4; ++j) {
        if (o32) ((f32x4*)o32)[lane + 64 * j] = v[j];
        if (obf) { u32x2 w; w.x = pk2(v[j][0], v[j][1]); w.y = pk2(v[j][2], v[j][3]); ((u32x2*)obf)[lane + 64 * j] = w; }
    }
}
__device__ __forceinline__ void phase_p0(const Args& a, LAS unsigned char* lds, int tid) {
    const int lane = tid & 63, wave = tid >> 6;
    const int gw = blockIdx.x * NWAVES + wave, NGW = gridDim.x * NWAVES;
    LAS float* scr = (LAS float*)(lds + wave * 17408);
    unsigned char* ws = a.ws;
    constexpr int NIT = 16384 * 3 + 1024 + 512 + 32;
    if (gw < NIT) {
        ConvItem cur = conv_decode(a, gw, lane);
        f32x4 v[16]; conv_load(cur, v);
        for (int it = gw; it < NIT; it += NGW) {
            const bool more = (it + NGW) < NIT;
            ConvItem nxt = cur; f32x4 vn[16];
            if (more) { nxt = conv_decode(a, it + NGW, lane); conv_load(nxt, vn); }
            conv_store(cur, v, scr, lane);
            if (more) { cur = nxt;
#pragma unroll
                for (int i = 0; i < 16; ++i) v[i] = vn[i]; }
        }
    }
    for (int t = blockIdx.x * NTHR + tid; t < 4096; t += gridDim.x * NTHR) s5_table_entry(a, t);
    for (int t = blockIdx.x * NTHR + tid; t < 8192; t += gridDim.x * NTHR) s5_bt_row(a, t);
    for (int t = blockIdx.x * NTHR + tid; t < 65536; t += gridDim.x * NTHR) s5_ct_entry(a, t);
    for (int m = gw; m < MTOK; m += NGW) {
        f32x4 v[4];
#pragma unroll
        for (int j = 0; j < 4; ++j) v[j] = ((const f32x4*)(a.in[0] + (size_t)m * DM))[lane + 64 * j];
        ln_rows4(v, a.in[1], a.in[2], lane);
        store_row(v, nullptr, (bf16_t*)(ws + WS_HBF) + (size_t)m * DM, lane);
    }
}

__device__ __forceinline__ void attn_item(int item, const bf16_t* __restrict__ proj, bf16_t* __restrict__ mix, const float* __restrict__ sink_l, LAS unsigned char* lds, int tid) {
    const int kh = item & 1, c = (item >> 1) & 31, b = item >> 6;
    constexpr int VS = 408;
    LAS bf16_t* Ks = (LAS bf16_t*)lds;
    LAS bf16_t* Vt = (LAS bf16_t*)(lds + 384 * 72 * 2);
    const int lane = tid & 63, w = tid >> 6, fr = lane & 15, fq = lane >> 4;
    const int hq = kh * 4 + (w >> 1);
    const bf16_t* qbase = proj + ((size_t)b * SEQ + c * 128 + (w & 1) * 64 + fr) * DIN + 1280 + hq * 64 + fq * 8;
    bf16x8 qn0 = *(const bf16x8*)qbase, qn1 = *(const bf16x8*)(qbase + 32);
#pragma unroll
    for (int i = 0; i < 6; ++i) {
        const int id = tid + NTHR * i, key = id >> 3, ch = id & 7;
        const int s = (c - 1) * 128 + key; const bool ok = (s >= 0) && (s < SEQ);
        u32x4 kv = {0u, 0u, 0u, 0u}, vv = {0u, 0u, 0u, 0u};
        if (ok) { const bf16_t* rowp = proj + (size_t)(b * SEQ + s) * DIN; kv = *(const u32x4*)(rowp + 1792 + kh * 64 + ch * 8); vv = *(const u32x4*)(rowp + 1920 + kh * 64 + ch * 8); }
        *(LAS u32x4*)(Ks + key * 72 + ch * 8) = kv;
        LAS bf16_t* vp = Vt + (ch * 8) * VS + key;
        vp[0 * VS] = (bf16_t)(vv.x & 0xffffu); vp[1 * VS] = (bf16_t)(vv.x >> 16); vp[2 * VS] = (bf16_t)(vv.y & 0xffffu); vp[3 * VS] = (bf16_t)(vv.y >> 16);
        vp[4 * VS] = (bf16_t)(vv.z & 0xffffu); vp[5 * VS] = (bf16_t)(vv.z >> 16); vp[6 * VS] = (bf16_t)(vv.w & 0xffffu); vp[7 * VS] = (bf16_t)(vv.w >> 16);
    }
    if (tid < 128) { const int d = tid >> 1, hh = tid & 1; *(LAS u32x4*)(Vt + d * VS + 384 + hh * 8) = (u32x4){0u, 0u, 0u, 0u}; }
    __syncthreads();
    const float slope = exp2f(-(float)(hq + 1));
    const float sinkv = sink_l[hq];
    const bool lo_ok = (c >= 1), hi_ok = (c <= 30);
    float plo[4], phi[4];
#pragma unroll
    for (int j = 0; j < 4; ++j) { plo[j] = (fq * 4 + j >= fr) ? 0.f : -1e30f; phi[j] = (fq * 4 + j <= fr) ? 0.f : -1e30f; }
#pragma unroll 1
    for (int qi = 0; qi < 4; ++qi) {
        const int qt = (w & 1) * 4 + qi;
        const size_t tok = (size_t)b * SEQ + c * 128 + qt * 16 + fr;
        const bf16x8 qa0 = qn0, qa1 = qn1;
        float slope_l = slope; asm volatile("" : "+v"(slope_l));
        float sd[4];
#pragma unroll
        for (int j = 0; j < 4; ++j) sd[j] = slope_l * (float)(fq * 4 + j - fr);
        if (qi < 3) { const bf16_t* qp = qbase + (size_t)(qi + 1) * 16 * DIN; qn0 = *(const bf16x8*)qp; qn1 = *(const bf16x8*)(qp + 32); }
        f32x4 s[18];
        float mx = sinkv;
        const LAS bf16_t* kbase = Ks + (qt * 16 + fr) * 72 + fq * 8;
        const LAS bf16_t* vbase = Vt + fr * VS + qt * 16 + fq * 4;
#pragma unroll
        for (int i = 0; i < 17; ++i) {
            const int kt = qt + i;
            const LAS bf16_t* kp = kbase + i * (16 * 72);
            f32x4 acc = {0.f, 0.f, 0.f, 0.f};
            acc = mfma16(*(const LAS bf16x8*)kp, qa0, acc); acc = mfma16(*(const LAS bf16x8*)(kp + 32), qa1, acc);
            const float pblk = ((kt < 8) ? lo_ok : ((kt >= 16) ? hi_ok : true)) ? 0.f : -1e30f;
            const float base = slope_l * (float)(16 * i - 128);
#pragma unroll
            for (int j = 0; j < 4; ++j) {
                float t = (i < 8) ? (base + sd[j]) : ((i > 8) ? -(base + sd[j]) : -fabsf(sd[j]));
                if (i == 0) t += plo[j];
                if (i == 16) t += phi[j];
                const float v = fmaf(acc[j], 0.125f, t + pblk);
                acc[j] = v; mx = fmaxf(mx, v);
            }
            s[i] = acc;
        }
        mx = fmaxf(mx, __shfl_xor(mx, 16)); mx = fmaxf(mx, __shfl_xor(mx, 32));
        float sum = 0.f;
#pragma unroll
        for (int i = 0; i < 17; ++i)
#pragma unroll
            for (int j = 0; j < 4; ++j) { const float p = __expf(s[i][j] - mx); s[i][j] = p; sum += p; }
        s[17] = (f32x4){0.f, 0.f, 0.f, 0.f};
        sum += __shfl_xor(sum, 16); sum += __shfl_xor(sum, 32);
        const float inv = 1.f / (sum + __expf(sinkv - mx));
        f32x4 o[4];
#pragma unroll
        for (int dt = 0; dt < 4; ++dt) o[dt] = (f32x4){0.f, 0.f, 0.f, 0.f};
#pragma unroll
        for (int kk = 0; kk < 9; ++kk) {
            const bf16x8 pb = pack8(s[2 * kk], s[2 * kk + 1]);
#pragma unroll
            for (int dt = 0; dt < 4; ++dt) {
                const LAS bf16_t* vp = vbase + dt * (16 * VS) + kk * 32;
                o[dt] = mfma16(cat8(*(const LAS bf16x4*)vp, *(const LAS bf16x4*)(vp + 16)), pb, o[dt]);
            }
        }
        bf16_t* op = mix + tok * DM + 512 + hq * 64 + fq * 4;
#pragma unroll
        for (int dt = 0; dt < 4; ++dt) { u32x2 wv; wv.x = pk2(o[dt][0] * inv, o[dt][1] * inv); wv.y = pk2(o[dt][2] * inv, o[dt][3] * inv); *(u32x2*)(op + dt * 16) = wv; }
    }
    __syncthreads();
}

__device__ __forceinline__ float log_sigmoid(float t) { return -log1pf(__expf(-t)); }
__device__ __forceinline__ void retkv_item(int item, const bf16_t* __restrict__ proj, float* __restrict__ kvf, float* __restrict__ kvb, const float* __restrict__ theta, LAS unsigned char* lds, int tid) {
    const int h = item & 3, c = (item >> 2) & 31, b = item >> 7;
    const float lgf = log_sigmoid(theta[h]), lgb = log_sigmoid(theta[4 + h]);
    LAS bf16_t* KTf = (LAS bf16_t*)lds; LAS bf16_t* KTb = KTf + 64 * 136; LAS bf16_t* VT = KTb + 64 * 136;
#pragma unroll
    for (int i = 0; i < 2; ++i) {
        const int id = tid + NTHR * i, j = id >> 3, ch = id & 7;
        const bf16_t* rowp = proj + (size_t)(b * SEQ + c * 128 + j) * DIN;
        const u32x4 kr = *(const u32x4*)(rowp + 256 + h * 64 + ch * 8), vr = *(const u32x4*)(rowp + 512 + h * 64 + ch * 8);
        const float wf = __expf(lgf * (float)(127 - j)) * 0.125f, wb = __expf(lgb * (float)j) * 0.125f;
        const int o = (ch * 8) * 136 + j;
        KTf[o + 0 * 136] = (bf16_t)f2bf(bflo(kr.x) * wf); KTf[o + 1 * 136] = (bf16_t)f2bf(bfhi(kr.x) * wf); KTf[o + 2 * 136] = (bf16_t)f2bf(bflo(kr.y) * wf); KTf[o + 3 * 136] = (bf16_t)f2bf(bfhi(kr.y) * wf);
        KTf[o + 4 * 136] = (bf16_t)f2bf(bflo(kr.z) * wf); KTf[o + 5 * 136] = (bf16_t)f2bf(bfhi(kr.z) * wf); KTf[o + 6 * 136] = (bf16_t)f2bf(bflo(kr.w) * wf); KTf[o + 7 * 136] = (bf16_t)f2bf(bfhi(kr.w) * wf);
        KTb[o + 0 * 136] = (bf16_t)f2bf(bflo(kr.x) * wb); KTb[o + 1 * 136] = (bf16_t)f2bf(bfhi(kr.x) * wb); KTb[o + 2 * 136] = (bf16_t)f2bf(bflo(kr.y) * wb); KTb[o + 3 * 136] = (bf16_t)f2bf(bfhi(kr.y) * wb);
        KTb[o + 4 * 136] = (bf16_t)f2bf(bflo(kr.z) * wb); KTb[o + 5 * 136] = (bf16_t)f2bf(bfhi(kr.z) * wb); KTb[o + 6 * 136] = (bf16_t)f2bf(bflo(kr.w) * wb); KTb[o + 7 * 136] = (bf16_t)f2bf(bfhi(kr.w) * wb);
        VT[o + 0 * 136] = (bf16_t)(vr.x & 0xffffu); VT[o + 1 * 136] = (bf16_t)(vr.x >> 16); VT[o + 2 * 136] = (bf16_t)(vr.y & 0xffffu); VT[o + 3 * 136] = (bf16_t)(vr.y >> 16);
        VT[o + 4 * 136] = (bf16_t)(vr.z & 0xffffu); VT[o + 5 * 136] = (bf16_t)(vr.z >> 16); VT[o + 6 * 136] = (bf16_t)(vr.w & 0xffffu); VT[o + 7 * 136] = (bf16_t)(vr.w >> 16);
    }
    __syncthreads();
    const int lane = tid & 63, w = tid >> 6, fr = lane & 15, fq = lane >> 4;
    const size_t obase = (size_t)((b * 32 + c) * 4 + h) * 4096;
#pragma unroll
    for (int i = 0; i < 4; ++i) {
        const int job = w * 4 + i, dirb = job >> 4, et = (job >> 2) & 3, dt = job & 3;
        const LAS bf16_t* ap = VT + (et * 16 + fr) * 136 + fq * 8;
        const LAS bf16_t* bp = (dirb ? KTb : KTf) + (dt * 16 + fr) * 136 + fq * 8;
        f32x4 acc = {0.f, 0.f, 0.f, 0.f};
#pragma unroll
        for (int ks = 0; ks < 4; ++ks) acc = mfma16(*(const LAS bf16x8*)(ap + ks * 32), *(const LAS bf16x8*)(bp + ks * 32), acc);
        float* op = (dirb ? kvb : kvf) + obase + (et * 16 + fq * 4) * 64 + dt * 16 + fr;
        op[0] = acc[0]; op[64] = acc[1]; op[128] = acc[2]; op[192] = acc[3];
    }
    __syncthreads();
}
__device__ __forceinline__ void retout_item(int item, const bf16_t* __restrict__ proj, const float* __restrict__ stf, const float* __restrict__ stb, bf16_t* __restrict__ mix, const float* __restrict__ theta, LAS unsigned char* lds, int tid) {
    const int h = item & 3, c = (item >> 2) & 31, b = item >> 7;
    const float lgf = log_sigmoid(theta[h]), lgb = log_sigmoid(theta[4 + h]);
    LAS bf16_t* Qs = (LAS bf16_t*)lds; LAS bf16_t* Ks = Qs + 128 * 72; LAS bf16_t* VT = Ks + 128 * 72; LAS bf16_t* SFt = VT + 64 * 136; LAS bf16_t* SBt = SFt + 64 * 72;
#pragma unroll
    for (int i = 0; i < 2; ++i) {
        const int id = tid + NTHR * i, j = id >> 3, ch = id & 7;
        const bf16_t* rowp = proj + (size_t)(b * SEQ + c * 128 + j) * DIN;
        const u32x4 qr = *(const u32x4*)(rowp + h * 64 + ch * 8), kr = *(const u32x4*)(rowp + 256 + h * 64 + ch * 8), vr = *(const u32x4*)(rowp + 512 + h * 64 + ch * 8);
        *(LAS u32x4*)(Qs + j * 72 + ch * 8) = qr; *(LAS u32x4*)(Ks + j * 72 + ch * 8) = kr;
        const int o = (ch * 8) * 136 + j;
        VT[o + 0 * 136] = (bf16_t)(vr.x & 0xffffu); VT[o + 1 * 136] = (bf16_t)(vr.x >> 16); VT[o + 2 * 136] = (bf16_t)(vr.y & 0xffffu); VT[o + 3 * 136] = (bf16_t)(vr.y >> 16);
        VT[o + 4 * 136] = (bf16_t)(vr.z & 0xffffu); VT[o + 5 * 136] = (bf16_t)(vr.z >> 16); VT[o + 6 * 136] = (bf16_t)(vr.w & 0xffffu); VT[o + 7 * 136] = (bf16_t)(vr.w >> 16);
    }
    const size_t sbase = (size_t)((b * 32 + c) * 4 + h) * 4096;
#pragma unroll
    for (int i = 0; i < 8; ++i) { const int id = tid + NTHR * i, e = id >> 6, d = id & 63; SFt[e * 72 + d] = (bf16_t)f2bf(stf[sbase + id]); SBt[e * 72 + d] = (bf16_t)f2bf(stb[sbase + id]); }
    __syncthreads();
    const int lane = tid & 63, it = tid >> 6, fr = lane & 15, fq = lane >> 4;
    const int ipos = it * 16 + fr;
    const LAS bf16_t* qp = Qs + ipos * 72 + fq * 8;
    const bf16x8 qb0 = *(const LAS bf16x8*)qp, qb1 = *(const LAS bf16x8*)(qp + 32);
    f32x4 st[8];
#pragma unroll
    for (int jt = 0; jt < 8; ++jt) {
        const LAS bf16_t* kp = Ks + (jt * 16 + fr) * 72 + fq * 8;
        f32x4 acc = {0.f, 0.f, 0.f, 0.f};
        acc = mfma16(*(const LAS bf16x8*)kp, qb0, acc); acc = mfma16(*(const LAS bf16x8*)(kp + 32), qb1, acc);
#pragma unroll
        for (int jj = 0; jj < 4; ++jj) { const int dij = ipos - (jt * 16 + fq * 4 + jj); const float dec = dij >= 0 ? __expf(lgf * (float)dij) : __expf(lgb * (float)(-dij)); acc[jj] *= 0.125f * dec; }
        st[jt] = acc;
    }
    f32x4 o[4], ff[4], fb[4];
#pragma unroll
    for (int et = 0; et < 4; ++et) { o[et] = (f32x4){0.f, 0.f, 0.f, 0.f}; ff[et] = o[et]; fb[et] = o[et]; }
#pragma unroll
    for (int kk = 0; kk < 4; ++kk) {
        const bf16x8 pb = pack8(st[2 * kk], st[2 * kk + 1]);
#pragma unroll
        for (int et = 0; et < 4; ++et) { const LAS bf16_t* vp = VT + (et * 16 + fr) * 136 + kk * 32 + fq * 4; o[et] = mfma16(cat8(*(const LAS bf16x4*)vp, *(const LAS bf16x4*)(vp + 16)), pb, o[et]); }
    }
#pragma unroll
    for (int et = 0; et < 4; ++et) {
        const LAS bf16_t* fp = SFt + (et * 16 + fr) * 72 + fq * 8; const LAS bf16_t* bp = SBt + (et * 16 + fr) * 72 + fq * 8;
        ff[et] = mfma16(*(const LAS bf16x8*)fp, qb0, ff[et]); ff[et] = mfma16(*(const LAS bf16x8*)(fp + 32), qb1, ff[et]);
        fb[et] = mfma16(*(const LAS bf16x8*)bp, qb0, fb[et]); fb[et] = mfma16(*(const LAS bf16x8*)(bp + 32), qb1, fb[et]);
    }
    const float cf = __expf(lgf * (float)(ipos + 1)), cb = __expf(lgb * (float)(128 - ipos));
    float s = 0.f;
#pragma unroll
    for (int et = 0; et < 4; ++et) { o[et] = o[et] + ff[et] * cf + fb[et] * cb; s += (o[et][0] + o[et][1]) + (o[et][2] + o[et][3]); }
    s += __shfl_xor(s, 16); s += __shfl_xor(s, 32);
    const float mean = s * (1.f / 64.f); float s2 = 0.f;
#pragma unroll
    for (int et = 0; et < 4; ++et) { o[et] = o[et] - mean; s2 += (o[et][0] * o[et][0] + o[et][1] * o[et][1]) + (o[et][2] * o[et][2] + o[et][3] * o[et][3]); }
    s2 += __shfl_xor(s2, 16); s2 += __shfl_xor(s2, 32);
    const float rstd = 1.f / sqrtf(s2 * (1.f / 64.f) + LN_EPS);
    const size_t tok = (size_t)b * SEQ + c * 128 + ipos;
    const bf16_t* gp = proj + tok * DIN + 768 + h * 64 + fq * 4;
    bf16_t* op = mix + tok * DM + h * 64 + fq * 4;
#pragma unroll
    for (int et = 0; et < 4; ++et) {
        const u32x2 gr = *(const u32x2*)(gp + et * 16);
        const float g0 = bflo(gr.x), g1 = bfhi(gr.x), g2 = bflo(gr.y), g3 = bfhi(gr.y);
        const float y0 = o[et][0] * rstd * (g0 / (1.f + __expf(-g0))), y1 = o[et][1] * rstd * (g1 / (1.f + __expf(-g1)));
        const float y2 = o[et][2] * rstd * (g2 / (1.f + __expf(-g2))), y3 = o[et][3] * rstd * (g3 / (1.f + __expf(-g3)));
        u32x2 wv; wv.x = pk2(y0, y1); wv.y = pk2(y2, y3); *(u32x2*)(op + et * 16) = wv;
    }
    __syncthreads();
}

constexpr int S5XS = 136;
struct S5Pass { bf16x8 bf[8]; f32x4 t0; };
__device__ __forceinline__ void s5_fetch(S5Pass& P, const float* __restrict__ tab, const bf16_t* __restrict__ BT, int g, int r, int lane) {
    const int fr = lane & 15, fq = lane >> 4;
    P.t0 = *(const f32x4*)(tab + (size_t)((r * 16 + g) * 64 + lane) * 8);
    const bf16_t* btp = BT + (size_t)(g * 256 + r * 128 + fr) * 32 + fq * 8;
#pragma unroll
    for (int nt = 0; nt < 8; ++nt) P.bf[nt] = *(const bf16x8*)(btp + nt * 16 * 32);
}
__device__ __forceinline__ void s5_bu(LAS bf16_t* Xw, const S5Pass& P, bf16x8 uf0, bf16x8 uf1, int lane) {
    const int fr = lane & 15, fq = lane >> 4;
#pragma unroll
    for (int mt = 0; mt < 2; ++mt)
#pragma unroll
        for (int nt = 0; nt < 8; ++nt) {
            f32x4 acc = {0.f, 0.f, 0.f, 0.f};
            acc = mfma16(P.bf[nt], mt ? uf1 : uf0, acc);
            u32x2 wv; wv.x = pk2(acc[0], acc[1]); wv.y = pk2(acc[2], acc[3]);
            *(LAS u32x2*)(Xw + (mt * 16 + fr) * S5XS + nt * 16 + fq * 4) = wv;
        }
    asm volatile("s_waitcnt lgkmcnt(0)" ::: "memory");
}
template <bool WRITE>
__device__ __forceinline__ void s5_recur(LAS bf16_t* xq, int r, float lr_, float li_, float& xr, float& xi) {
#pragma unroll 1
    for (int blk = 0; blk < 4; ++blk) {
        LAS bf16_t* q = xq + (r ? (3 - blk) : blk) * (8 * S5XS);
        unsigned bw[8];
#pragma unroll
        for (int k = 0; k < 8; ++k) bw[k] = *(const LAS unsigned*)(q + k * S5XS);
        if (r == 0) {
#pragma unroll
            for (int s = 0; s < 8; ++s) {
                const float nr = fmaf(lr_, xr, fmaf(-li_, xi, bflo(bw[s]))), ni = fmaf(lr_, xi, fmaf(li_, xr, bfhi(bw[s])));
                xr = nr; xi = ni;
                if (WRITE) *(LAS unsigned*)(q + s * S5XS) = pk2(xr, xi);
            }
        } else {
#pragma unroll
            for (int s = 7; s >= 0; --s) {
                const float nr = fmaf(lr_, xr, fmaf(-li_, xi, bflo(bw[s]))), ni = fmaf(lr_, xi, fmaf(li_, xr, bfhi(bw[s])));
                xr = nr; xi = ni;
                if (WRITE) *(LAS unsigned*)(q + s * S5XS) = pk2(xr, xi);
            }
        }
    }
    if (WRITE) asm volatile("s_waitcnt lgkmcnt(0)" ::: "memory");
}
__device__ __forceinline__ void s5_ufrag(const bf16_t* __restrict__ proj, int b, int ch, int g, int lane, bf16x8& uf0, bf16x8& uf1) {
    const int fr = lane & 15, fq = lane >> 4;
    uf0 = (bf16x8){0, 0, 0, 0, 0, 0, 0, 0}; uf1 = uf0;
    if (fq < 2) { const bf16_t* up = proj + (size_t)(b * SEQ + ch * S5T + fr) * DIN + 1024 + g * 16 + fq * 8; uf0 = *(const bf16x8*)up; uf1 = *(const bf16x8*)(up + (size_t)16 * DIN); }
}

__device__ __forceinline__ void s5e_item(int item, const bf16_t* __restrict__ proj, const float* __restrict__ tab  , const bf16_t* __restrict__ BT,
                                         float* __restrict__ E, LAS unsigned char* lds, int tid) {
    const int ch = item & (S5NCH - 1), b = item / S5NCH;
    const int lane = tid & 63, w = tid >> 6;
    LAS bf16_t* Xw = (LAS bf16_t*)lds + w * (32 * S5XS);
    S5Pass cur;
    s5_fetch(cur, tab, BT, w, 0, lane);
    bf16x8 uf0, uf1;
    s5_ufrag(proj, b, ch, w, lane, uf0, uf1);
#pragma unroll 1
    for (int ps = 0; ps < 4; ++ps) {
        const int g = w + 8 * (ps >> 1), r = ps & 1;
        const float lr_ = cur.t0[0], li_ = cur.t0[1];
        s5_bu(Xw, cur, uf0, uf1, lane);
        if (ps < 3) s5_fetch(cur, tab, BT, w + 8 * ((ps + 1) >> 1), (ps + 1) & 1, lane);
        if (ps == 1) s5_ufrag(proj, b, ch, w + 8, lane, uf0, uf1);
        float xr = 0.f, xi = 0.f;
        s5_recur<false>(Xw + lane * 2, r, lr_, li_, xr, xi);
        float2 ev; ev.x = xr; ev.y = xi;
        ((float2*)E)[(size_t)(((b * S5NCH + ch) * 16 + g) * 2 + r) * 64 + lane] = ev;
        asm volatile("s_waitcnt lgkmcnt(0)" ::: "memory");
    }
    __syncthreads();
}
__device__ __forceinline__ void s5out_item(int item, const bf16_t* __restrict__ proj, const float* __restrict__ tab, const bf16_t* __restrict__ BT,
                                           const bf16_t* __restrict__ CT  , const float* __restrict__ dvec, const bf16_t* __restrict__ wgluT, const float* __restrict__ bglu,
                                           const float* __restrict__ CIN, bf16_t* __restrict__ mix, LAS unsigned char* lds, int tid) {
    const int ch = item & (S5NCH - 1), b = item / S5NCH;
    constexpr int YS = 264;
    const int lane = tid & 63, w = tid >> 6, fr = lane & 15, fq = lane >> 4;
    LAS bf16_t* Xw = (LAS bf16_t*)lds + w * (32 * S5XS);
    LAS bf16_t* Y = (LAS bf16_t*)(lds + 8 * 32 * S5XS * 2);
    S5Pass cur; bf16x8 ccf[4]; float2 ccin;
    s5_fetch(cur, tab, BT, w, 0, lane);
    ccin = ((const float2*)CIN)[(size_t)(((b * S5NCH + ch) * 16 + w) * 2 + 0) * 64 + lane];
#pragma unroll
    for (int ks = 0; ks < 4; ++ks) ccf[ks] = *(const bf16x8*)(CT + (size_t)(w * 16 + fr) * 256 + ks * 32 + fq * 8);
    bf16x8 uf0, uf1;
    s5_ufrag(proj, b, ch, w, lane, uf0, uf1);
    f32x4 ya0 = {0.f, 0.f, 0.f, 0.f}, ya1 = ya0;
#pragma unroll 1
    for (int ps = 0; ps < 4; ++ps) {
        const int g = w + 8 * (ps >> 1), r = ps & 1;
        const int gn = w + 8 * ((ps + 1) >> 1), rn = (ps + 1) & 1;
        const float lr_ = cur.t0[0], li_ = cur.t0[1];
        s5_bu(Xw, cur, uf0, uf1, lane);
        if (ps < 3) s5_fetch(cur, tab, BT, gn, rn, lane);
        if (ps == 1) s5_ufrag(proj, b, ch, w + 8, lane, uf0, uf1);
        float xr = ccin.x, xi = ccin.y;
        s5_recur<true>(Xw + lane * 2, r, lr_, li_, xr, xi);
        if (ps < 3) ccin = ((const float2*)CIN)[(size_t)(((b * S5NCH + ch) * 16 + gn) * 2 + rn) * 64 + lane];
#pragma unroll
        for (int ks = 0; ks < 4; ++ks) {
            ya0 = mfma16(ccf[ks], *(const LAS bf16x8*)(Xw + fr * S5XS + ks * 32 + fq * 8), ya0);
            ya1 = mfma16(ccf[ks], *(const LAS bf16x8*)(Xw + (16 + fr) * S5XS + ks * 32 + fq * 8), ya1);
        }
        if (ps < 3) {
#pragma unroll
            for (int ks = 0; ks < 4; ++ks) ccf[ks] = *(const bf16x8*)(CT + (size_t)(gn * 16 + fr) * 256 + rn * 128 + ks * 32 + fq * 8);
        }
        if (r == 1) {
            const int chn = g * 16 + fq * 4;
            const f32x4 dv = *(const f32x4*)(dvec + chn);
#pragma unroll
            for (int mt = 0; mt < 2; ++mt) {
                const int s = mt * 16 + fr;
                const u32x2 uw = *(const u32x2*)(proj + (size_t)(b * SEQ + ch * S5T + s) * DIN + 1024 + chn);
                const float uu[4] = {bflo(uw.x), bfhi(uw.x), bflo(uw.y), bfhi(uw.y)};
                float gl4[4];
#pragma unroll
                for (int jj = 0; jj < 4; ++jj) {
                    const float yv = (mt ? ya1[jj] : ya0[jj]) + dv[jj] * uu[jj];
                    const float t = 0.7978845608028654f * (yv + 0.044715f * yv * yv * yv);
                    gl4[jj] = yv * (1.f - __builtin_amdgcn_rcpf(1.f + __expf(2.f * t)));
                }
                u32x2 yw; yw.x = pk2(gl4[0], gl4[1]); yw.y = pk2(gl4[2], gl4[3]);
                *(LAS u32x2*)(Y + s * YS + chn) = yw;
            }
            ya0 = (f32x4){0.f, 0.f, 0.f, 0.f}; ya1 = ya0;
        }
        asm volatile("s_waitcnt lgkmcnt(0)" ::: "memory");
    }
    __syncthreads();
    {
        const int mt = w & 1;
        bf16x8 yf[8];
#pragma unroll
        for (int ks = 0; ks < 8; ++ks) yf[ks] = *(const LAS bf16x8*)(Y + (mt * 16 + fr) * YS + ks * 32 + fq * 8);
        const int s = mt * 16 + fr;
        bf16_t* orow = mix + (size_t)(b * SEQ + ch * S5T + s) * DM + 256;
#pragma unroll 2
        for (int i = 0; i < 4; ++i) {
            const int nt = (w >> 1) * 4 + i;
            const bf16_t* ap = wgluT + (size_t)(nt * 16 + fr) * 256 + fq * 8;
            f32x4 acc = {0.f, 0.f, 0.f, 0.f};
#pragma unroll
            for (int ks = 0; ks < 8; ++ks) acc = mfma16(*(const bf16x8*)(ap + ks * 32), yf[ks], acc);
            const int n0 = nt * 16 + fq * 4;
            const f32x4 bg = *(const f32x4*)(bglu + n0);
            const u32x2 yw = *(const LAS u32x2*)(Y + s * YS + n0);
            const float yv[4] = {bflo(yw.x), bfhi(yw.x), bflo(yw.y), bfhi(yw.y)};
            float ov[4];
#pragma unroll
            for (int jj = 0; jj < 4; ++jj) ov[jj] = yv[jj] * __builtin_amdgcn_rcpf(1.f + __expf(-(acc[jj] + bg[jj])));
            u32x2 ow; ow.x = pk2(ov[0], ov[1]); ow.y = pk2(ov[2], ov[3]);
            *(u32x2*)(orow + n0) = ow;
        }
    }
    __syncthreads();
}

__device__ __forceinline__ void phase_scan(const Args& a, int l, int tid) {
    unsigned char* ws = a.ws;
    const int lane = tid & 63, wave = tid >> 6;
    {
        const float* tab = (const float*)(ws + WS_S5TAB) + (size_t)l * 2048 * 8;
        const float2* __restrict__ E = (const float2*)(ws + WS_S5E); float2* __restrict__ C = (float2*)(ws + WS_S5C);
        for (int wv = blockIdx.x; wv < 128; wv += gridDim.x) if (wave == 0) {
            const int p = lane, r = wv & 1, g = (wv >> 1) & 15, b = wv >> 5;
            const float* tp = tab + (size_t)((r * 16 + g) * 64 + p) * 8;
            const float tr = tp[4], ti = tp[5];
            float xr = 0.f, xi = 0.f;
            for (int k0 = 0; k0 < S5NCH; k0 += 32) {
                float2 e[32];
#pragma unroll
                for (int k = 0; k < 32; ++k) { const int ch = r ? (S5NCH - 1 - (k0 + k)) : (k0 + k); e[k] = E[(size_t)(((b * S5NCH + ch) * 16 + g) * 2 + r) * 64 + p]; }
#pragma unroll
                for (int k = 0; k < 32; ++k) { const int ch = r ? (S5NCH - 1 - (k0 + k)) : (k0 + k);
                    float2 cv; cv.x = xr; cv.y = xi; C[(size_t)(((b * S5NCH + ch) * 16 + g) * 2 + r) * 64 + p] = cv;
                    const float nr = fmaf(tr, xr, fmaf(-ti, xi, e[k].x)), ni = fmaf(tr, xi, fmaf(ti, xr, e[k].y));
                    xr = nr; xi = ni; }
            }
        }
    }
    {
        const float* theta = a.in[4] + l * 8;
        const float* __restrict__ kvf = (const float*)(ws + WS_KVF); const float* __restrict__ kvb = (const float*)(ws + WS_KVB);
        float* __restrict__ stf = (float*)(ws + WS_STF); float* __restrict__ stb = (float*)(ws + WS_STB);
        for (int gid = blockIdx.x * NTHR + tid; gid < 131072; gid += gridDim.x * NTHR) {
            const int el = gid & 4095, dir = (gid >> 12) & 1, h = (gid >> 13) & 3, b = gid >> 15;
            const float dec = __expf(log_sigmoid(theta[dir * 4 + h]) * 128.f);
            const float* __restrict__ kv = dir ? kvb : kvf; float* __restrict__ st = dir ? stb : stf;
            float s = 0.f;
            for (int c0 = 0; c0 < 32; c0 += 16) {
                float kk[16];
#pragma unroll
                for (int k = 0; k < 16; ++k) { const int c = dir ? (31 - (c0 + k)) : (c0 + k); kk[k] = kv[(size_t)((b * 32 + c) * 4 + h) * 4096 + el]; }
#pragma unroll
                for (int k = 0; k < 16; ++k) { const int c = dir ? (31 - (c0 + k)) : (c0 + k); st[(size_t)((b * 32 + c) * 4 + h) * 4096 + el] = s; s = fmaf(dec, s, kk[k]); }
            }
        }
    }
}

__device__ __forceinline__ void phase_ln1_router(const Args& a, int l, LAS unsigned char* lds, int tid) {
    unsigned char* ws = a.ws;
    const int lane = tid & 63, wave = tid >> 6;
    LAS float* rwT = (LAS float*)lds;
    const float* rw = a.in[19] + (size_t)l * DM * NE;
    for (int i = tid; i < DM * NE; i += NTHR) rwT[(i & 15) * DM + (i >> 4)] = rw[i];
    __syncthreads();
    const float* pre = (const float*)(ws + WS_RA);
    float* afft = (float*)(ws + WS_AFFT);
    const int gw = blockIdx.x * NWAVES + wave, NGW = gridDim.x * NWAVES;
    const bool b5 = (lane & 32) != 0, b4 = (lane & 16) != 0, b3 = (lane & 8) != 0, b2 = (lane & 4) != 0;
    f32x4 vn[4];
    if (gw < MTOK) {
#pragma unroll
        for (int j = 0; j < 4; ++j) vn[j] = ((const f32x4*)(pre + (size_t)gw * DM))[lane + 64 * j];
    }
    for (int m = gw; m < MTOK; m += NGW) {
        f32x4 v[4];
#pragma unroll
        for (int j = 0; j < 4; ++j) v[j] = vn[j];
        if (m + NGW < MTOK) {
#pragma unroll
            for (int j = 0; j < 4; ++j) vn[j] = ((const f32x4*)(pre + (size_t)(m + NGW) * DM))[lane + 64 * j];
        }
        ln_rows4(v, a.in[17] + l * DM, a.in[18] + l * DM, lane);
        store_row(v, nullptr, (bf16_t*)(ws + WS_HBF) + (size_t)m * DM, lane);
        float sp[16];
#pragma unroll
        for (int eg = 0; eg < 4; ++eg) {
#pragma unroll
            for (int ee = 0; ee < 4; ++ee) { const int e = eg * 4 + ee; float s = 0.f;
#pragma unroll
                for (int j = 0; j < 4; ++j) { const f32x4 wv = *(const LAS f32x4*)(rwT + e * DM + 256 * j + 4 * lane); s += (v[j][0] * wv[0] + v[j][1] * wv[1]) + (v[j][2] * wv[2] + v[j][3] * wv[3]); }
                sp[e] = s; }
            asm volatile("" ::: "memory");
        }
        float t8[8], t4[4], t2[2];
#pragma unroll
        for (int i = 0; i < 8; ++i) { const float snd = b5 ? sp[i] : sp[i + 8], kp = b5 ? sp[i + 8] : sp[i]; t8[i] = kp + __shfl_xor(snd, 32); }
#pragma unroll
        for (int i = 0; i < 4; ++i) { const float snd = b4 ? t8[i] : t8[i + 4], kp = b4 ? t8[i + 4] : t8[i]; t4[i] = kp + __shfl_xor(snd, 16); }
#pragma unroll
        for (int i = 0; i < 2; ++i) { const float snd = b3 ? t4[i] : t4[i + 2], kp = b3 ? t4[i + 2] : t4[i]; t2[i] = kp + __shfl_xor(snd, 8); }
        float lgt; { const float snd = b2 ? t2[0] : t2[1], kp = b2 ? t2[1] : t2[0]; lgt = kp + __shfl_xor(snd, 4); }
        lgt += __shfl_xor(lgt, 1); lgt += __shfl_xor(lgt, 2);
        float mx = lgt;
#pragma unroll
        for (int o = 4; o < 64; o <<= 1) mx = fmaxf(mx, __shfl_xor(mx, o));
        const float ex = expf(lgt - mx);
        float sum = ex;
#pragma unroll
        for (int o = 4; o < 64; o <<= 1) sum += __shfl_xor(sum, o);
        const int b = m / SEQ, t = m % SEQ;
        if ((lane & 3) == 0) afft[(size_t)(b * NE + (lane >> 2)) * SEQ + t] = ex / sum;
    }
    __syncthreads();
}

__device__ __forceinline__ void select_item(int item, const Args& a, LAS unsigned char* lds, int tid) {
    unsigned char* ws = a.ws;
    const int q = item & 3, e = (item >> 2) & 15, b = item >> 6;
    const int lane = tid & 63, wave = tid >> 6;
    LAS unsigned* red = (LAS unsigned*)lds;
    LAS int* sel = (LAS int*)(lds + 1024);
    const float* av = (const float*)(ws + WS_AFFT) + (size_t)(b * NE + e) * SEQ + tid * 8;
    const f32x4 va = *(const f32x4*)av, vb = *(const f32x4*)(av + 4);
    unsigned v[8] = {__float_as_uint(va[0]), __float_as_uint(va[1]), __float_as_uint(va[2]), __float_as_uint(va[3]), __float_as_uint(vb[0]), __float_as_uint(vb[1]), __float_as_uint(vb[2]), __float_as_uint(vb[3])};
    unsigned x = 0u;
    for (int bit = 30; bit >= 0; --bit) {
        const unsigned cand = x | (1u << bit);
        unsigned cnt = 0u;
#pragma unroll
        for (int j = 0; j < 8; ++j) cnt += (unsigned)__popcll(__ballot(v[j] >= cand));
        LAS unsigned* rb = red + (bit & 1) * 8;
        if (lane == 0) rb[wave] = cnt;
        __syncthreads();
        unsigned tot = 0u;
#pragma unroll
        for (int k = 0; k < 8; ++k) tot += rb[k];
        if (tot >= (unsigned)CAP) x = cand;
    }
    unsigned mycnt = 0u;
#pragma unroll
    for (int j = 0; j < 8; ++j) mycnt += (v[j] > x ? 1u : 0u) + (v[j] == x ? 0x10000u : 0u);
    unsigned inc = mycnt;
#pragma unroll
    for (int o = 1; o < 64; o <<= 1) { const unsigned t = __shfl_up(inc, o); if (lane >= o) inc += t; }
    LAS unsigned* wsum = red + 64;
    __syncthreads();
    if (lane == 63) wsum[wave] = inc;
    __syncthreads();
    unsigned wpre = 0u, total = 0u;
#pragma unroll
    for (int k = 0; k < 8; ++k) { const unsigned t = wsum[k]; if (k < wave) wpre += t; total += t; }
    const unsigned excl = wpre + inc - mycnt;
    unsigned gtb = excl & 0xffffu, eqb = excl >> 16;
    const unsigned need = (unsigned)CAP - (total & 0xffffu);
    const int rowbase = (e * NB + b) * CAP;
    int* idx = (int*)(ws + WS_IDX); float* gate = (float*)(ws + WS_GATE); int* slotmap = (int*)(ws + WS_SLOT);
    const bool own_tok = ((tid >> 7) == q);
#pragma unroll
    for (int j = 0; j < 8; ++j) {
        const bool isgt = v[j] > x, iseq = v[j] == x;
        const bool issel = isgt || (iseq && eqb < need);
        const unsigned slot = gtb + (eqb < need ? eqb : need);
        const int tok = b * SEQ + tid * 8 + j;
        if (issel && (int)(slot >> 7) == q) { idx[rowbase + slot] = tok; gate[rowbase + slot] = __uint_as_float(v[j]); sel[slot & 127] = tok; }
        if (own_tok) slotmap[(size_t)tok * NE + e] = issel ? (int)(rowbase + slot) : -1;
        gtb += isgt ? 1u : 0u; eqb += iseq ? 1u : 0u;
    }
    __syncthreads();
    const bf16_t* hbf = (const bf16_t*)(ws + WS_HBF); bf16_t* xs = (bf16_t*)(ws + WS_RA);
#pragma unroll
    for (int hb = 0; hb < 2; ++hb) {
        u32x4 d0[8], d1[8];
#pragma unroll
        for (int i = 0; i < 8; ++i) { const int tok = sel[wave + 8 * (hb * 8 + i)]; const u32x4* src = (const u32x4*)(hbf + (size_t)tok * DM); d0[i] = src[lane]; d1[i] = src[lane + 64]; }
#pragma unroll
        for (int i = 0; i < 8; ++i) { u32x4* dst = (u32x4*)(xs + (size_t)(rowbase + q * 128 + wave + 8 * (hb * 8 + i)) * DM); dst[lane] = d0[i]; dst[lane + 64] = d1[i]; }
    }
    __syncthreads();
}

__device__ __forceinline__ void phase_ln2(const Args& a, int l, int tid) {
    unsigned char* ws = a.ws;
    const int lane = tid & 63, wave = tid >> 6;
    const int gw = blockIdx.x * NWAVES + wave, NGW = gridDim.x * NWAVES;
    const bf16_t* hbf = (const bf16_t*)(ws + WS_HBF); const int* slotmap = (const int*)(ws + WS_SLOT); const bf16_t* contrib = (const bf16_t*)(ws + WS_RB);
    const bool last = (l == 1);
    u32x2 vn[4]; int slot_n = -1;
    if (gw < MTOK) {
#pragma unroll
        for (int j = 0; j < 4; ++j) vn[j] = ((const u32x2*)(hbf + (size_t)gw * DM))[lane + 64 * j];
        slot_n = slotmap[(size_t)gw * NE + (lane & 15)];
    }
    for (int m = gw; m < MTOK; m += NGW) {
        f32x4 v[4];
#pragma unroll
        for (int j = 0; j < 4; ++j) { v[j][0] = bflo(vn[j].x) * ALPHA; v[j][1] = bfhi(vn[j].x) * ALPHA; v[j][2] = bflo(vn[j].y) * ALPHA; v[j][3] = bfhi(vn[j].y) * ALPHA; }
        const int myslot = slot_n;
        unsigned bal = (unsigned)(__ballot(myslot >= 0) & 0xffffull);
        int r0 = -1, r1 = -1, r2 = -1, r3 = -1;
        if (bal) { r0 = __shfl(myslot, __builtin_ctz(bal)); bal &= bal - 1; }
        if (bal) { r1 = __shfl(myslot, __builtin_ctz(bal)); bal &= bal - 1; }
        if (bal) { r2 = __shfl(myslot, __builtin_ctz(bal)); bal &= bal - 1; }
        if (bal) { r3 = __shfl(myslot, __builtin_ctz(bal)); bal &= bal - 1; }
        u32x2 c0[4], c1[4], c2[4], c3[4];
#pragma unroll
        for (int j = 0; j < 4; ++j) { c0[j] = (u32x2){0u, 0u}; c1[j] = c0[j]; c2[j] = c0[j]; c3[j] = c0[j]; }
        if (r0 >= 0) {
#pragma unroll
            for (int j = 0; j < 4; ++j) c0[j] = ((const u32x2*)(contrib + (size_t)r0 * DM))[lane + 64 * j]; }
        if (r1 >= 0) {
#pragma unroll
            for (int j = 0; j < 4; ++j) c1[j] = ((const u32x2*)(contrib + (size_t)r1 * DM))[lane + 64 * j]; }
        if (r2 >= 0) {
#pragma unroll
            for (int j = 0; j < 4; ++j) c2[j] = ((const u32x2*)(contrib + (size_t)r2 * DM))[lane + 64 * j]; }
        if (r3 >= 0) {
#pragma unroll
            for (int j = 0; j < 4; ++j) c3[j] = ((const u32x2*)(contrib + (size_t)r3 * DM))[lane + 64 * j]; }
        if (m + NGW < MTOK) {
#pragma unroll
            for (int j = 0; j < 4; ++j) vn[j] = ((const u32x2*)(hbf + (size_t)(m + NGW) * DM))[lane + 64 * j];
            slot_n = slotmap[(size_t)(m + NGW) * NE + (lane & 15)];
        }
#pragma unroll
        for (int j = 0; j < 4; ++j) {
            v[j][0] += bflo(c0[j].x); v[j][1] += bfhi(c0[j].x); v[j][2] += bflo(c0[j].y); v[j][3] += bfhi(c0[j].y);
            v[j][0] += bflo(c1[j].x); v[j][1] += bfhi(c1[j].x); v[j][2] += bflo(c1[j].y); v[j][3] += bfhi(c1[j].y);
            v[j][0] += bflo(c2[j].x); v[j][1] += bfhi(c2[j].x); v[j][2] += bflo(c2[j].y); v[j][3] += bfhi(c2[j].y);
            v[j][0] += bflo(c3[j].x); v[j][1] += bfhi(c3[j].x); v[j][2] += bflo(c3[j].y); v[j][3] += bfhi(c3[j].y);
        }
        while (bal) {
            const int row = __shfl(myslot, __builtin_ctz(bal)); bal &= bal - 1;
            const u32x2* cr = (const u32x2*)(contrib + (size_t)row * DM);
#pragma unroll
            for (int j = 0; j < 4; ++j) { const u32x2 wv = cr[lane + 64 * j]; v[j][0] += bflo(wv.x); v[j][1] += bfhi(wv.x); v[j][2] += bflo(wv.y); v[j][3] += bfhi(wv.y); }
        }
        ln_rows4(v, a.in[23] + l * DM, a.in[24] + l * DM, lane);
        if (last) store_row(v, a.out + (size_t)m * DM, nullptr, lane);
        else store_row(v, nullptr, (bf16_t*)(ws + WS_HBF) + (size_t)m * DM, lane);
    }
}

typedef __attribute__((address_space(1))) unsigned gu32;
#define RLX_AGENT __ATOMIC_RELAXED, __HIP_MEMORY_SCOPE_AGENT
#define XB_TMO      128
#define XB_XCNT(j)  (256  + 64 * (j))
#define XB_XSUB(j)  (1280 + 64 * (j))
#define XB_XGEN(j)  (2304 + 64 * (j))
#define XB_TOP      3328
#define XB_TOPGEN   3392
#define XCD_BAR_WORDS 3456
#define XB_SPIN_CAP (1u << 18)

__device__ __forceinline__ unsigned xb_ld(unsigned* p)              { return __hip_atomic_load(p, __ATOMIC_RELAXED, __HIP_MEMORY_SCOPE_AGENT); }
__device__ __forceinline__ unsigned xb_add(unsigned* p, unsigned v) { return __hip_atomic_fetch_add(p, v, __ATOMIC_RELAXED, __HIP_MEMORY_SCOPE_AGENT); }
__device__ __forceinline__ unsigned xb_xcc_id() { return (unsigned)__builtin_amdgcn_s_getreg((3 << 11) | 20) & 0xFu; }
#define XB_SPIN(cond, bar) do { unsigned _sp = 0; while (cond) { __builtin_amdgcn_s_sleep(1); \
    if ((++_sp & 255u) == 0u) { if (xb_ld(&(bar)[XB_TMO])) break; if (_sp > XB_SPIN_CAP) { atomicAdd(&(bar)[XB_TMO], 1u); break; } } } } while (0)

struct XcdBarrier {
    unsigned* bar; unsigned x;
    volatile LAS unsigned* st;
};

__device__ __forceinline__ XcdBarrier xcd_barrier_post(unsigned* bar, volatile LAS unsigned* st) {
    XcdBarrier b; b.bar = bar; b.x = xb_xcc_id(); b.st = st;
    if (threadIdx.x == 0) (void)xb_add(&bar[XB_XCNT(b.x)], 1u);
    return b;
}
__device__ __forceinline__ void xcd_barrier_complete(unsigned* bar, unsigned x, unsigned& nloc, unsigned& nx) {
    const unsigned G = gridDim.x * gridDim.y * gridDim.z;
    unsigned sum, cnt, mine, sp = 0u;
    for (;;) {
        sum = 0u; cnt = 0u; mine = 0u;
#pragma unroll
        for (unsigned j = 0; j < 16; ++j) { const unsigned c = xb_ld(&bar[XB_XCNT(j)]); sum += c; cnt += (c > 0u) ? 1u : 0u; mine = (j == x) ? c : mine; }
        if (sum == G) break;
        __builtin_amdgcn_s_sleep(1);
        if ((++sp & 255u) == 0u) { if (xb_ld(&bar[XB_TMO])) break; if (sp > XB_SPIN_CAP) { atomicAdd(&bar[XB_TMO], 1u); break; } }
    }
    nloc = mine > 0u ? mine : 1u; nx = cnt > 0u ? cnt : 1u;
}

__device__ __forceinline__ void xcd_barrier(const XcdBarrier& b) {
    asm volatile("s_waitcnt vmcnt(0)" ::: "memory");
    __syncthreads();
    if (threadIdx.x == 0) {
        unsigned* bar = b.bar;
        __builtin_amdgcn_s_waitcnt(0);
        unsigned nloc = b.st[0], nx = b.st[1];
        if (nloc == 0u) { xcd_barrier_complete(bar, b.x, nloc, nx); b.st[0] = nloc; b.st[1] = nx; }
        const unsigned old = xb_add(&bar[XB_XSUB(b.x)], 1u);
        const unsigned gen = old / nloc;
        if (old + 1u == (gen + 1u) * nloc) {
            __builtin_amdgcn_fence(__ATOMIC_RELEASE, "agent");
            asm volatile("s_waitcnt vmcnt(0)" ::: "memory");
            const unsigned og = xb_add(&bar[XB_TOP], 1u);
            const unsigned tg = og / nx;
            if (og + 1u == (tg + 1u) * nx) xb_add(&bar[XB_TOPGEN], 1u);
            else XB_SPIN(xb_ld(&bar[XB_TOPGEN]) == tg, bar);
            __builtin_amdgcn_fence(__ATOMIC_ACQUIRE, "agent");
            xb_add(&bar[XB_XGEN(b.x)], 1u);
            asm volatile("s_waitcnt vmcnt(0)" ::: "memory");
        } else {
            XB_SPIN(xb_ld(&bar[XB_XGEN(b.x)]) == gen, bar);
            __builtin_amdgcn_fence(__ATOMIC_ACQUIRE, "agent");
            asm volatile("s_waitcnt vmcnt(0)" ::: "memory");
        }
    }
    __syncthreads();
}

constexpr int NPHASES = 21;
#ifndef REP_MASK
#define REP_MASK 0
#endif
template <int L, int K>
__device__ __forceinline__ void run_phase(const Args& a, LAS unsigned char* lds, int tid) {
    unsigned char* ws = a.ws;
    constexpr int l = L;
    bf16_t* proj = (bf16_t*)(ws + WS_RA); bf16_t* mix = (bf16_t*)(ws + WS_RB);
    if constexpr (K == 0) {
        pg8::Gemm g{(const bf16_t*)(ws + WS_HBF), (const bf16_t*)(ws + WS_WIN) + (size_t)l * DIN * DM, MTOK, DIN, DM};
        pg8::StaticOrder S; S.init(MTOK, DIN, (int)gridDim.x, (int)blockIdx.x);
        pg8::EpiStoreBf16 E{proj, DIN};
        pg8::gemm_phase<pg8::EpiStoreBf16, pg8::StaticOrder, true, true>(lds, g, S, E);
    } else if constexpr (K == 1) {
        const float* tab = (const float*)(ws + WS_S5TAB) + (size_t)l * 2048 * 8;
        constexpr int XB = ((REP_MASK >> 11) & 1) ? 512 : ((REP_MASK >> 12) & 1) ? 256 : ((REP_MASK >> 13) & 1) ? 512 : 0, XOFF = ((REP_MASK >> 11) & 1) ? 0 : ((REP_MASK >> 12) & 1) ? 512 : 768;
        for (int it0 = blockIdx.x; it0 < 1280 + XB; it0 += gridDim.x) {
            const int it = it0 < 1280 ? it0 : it0 - 1280 + XOFF;
            if (it < 512) s5e_item(it, proj, tab, (const bf16_t*)(ws + WS_S5BT) + (size_t)l * 4096 * 32, (float*)(ws + WS_S5E), lds, tid);
            else if (it < 768) attn_item(it - 512, proj, mix, a.in[15] + l * 8, lds, tid);
            else retkv_item(it - 768, proj, (float*)(ws + WS_KVF), (float*)(ws + WS_KVB), a.in[4] + l * 8, lds, tid);
        }
    } else if constexpr (K == 2) {
        phase_scan(a, l, tid);
    } else if constexpr (K == 3) {
        const float* tab = (const float*)(ws + WS_S5TAB) + (size_t)l * 2048 * 8;
        constexpr int XD = ((REP_MASK >> 14) & 3) ? 512 : 0, XOFD = ((REP_MASK >> 14) & 1) ? 0 : 512;
        for (int it0 = blockIdx.x; it0 < 1024 + XD; it0 += gridDim.x) {
            const int it = it0 < 1024 ? it0 : it0 - 1024 + XOFD;
            if (it < 512) s5out_item(it, proj, tab, (const bf16_t*)(ws + WS_S5BT) + (size_t)l * 4096 * 32, (const bf16_t*)(ws + WS_S5CT) + (size_t)l * 65536, a.in[12] + l * 256,
                                     (const bf16_t*)(ws + WS_WGLU) + (size_t)l * 65536, a.in[14] + l * 256, (const float*)(ws + WS_S5C), mix, lds, tid);
            else retout_item(it - 512, proj, (const float*)(ws + WS_STF), (const float*)(ws + WS_STB), mix, a.in[4] + l * 8, lds, tid);
        }
    } else if constexpr (K == 4) {
        pg8::Gemm g{mix, (const bf16_t*)(ws + WS_WOUT) + (size_t)l * DM * DM, MTOK, DM, DM};
        pg8::StaticOrder S; S.init(MTOK, DM, (int)gridDim.x, (int)blockIdx.x);
        pg8::EpiResF32 E{(const bf16_t*)(ws + WS_HBF), (float*)(ws + WS_RA), DM, ALPHA};
        pg8::gemm_phase<pg8::EpiResF32, pg8::StaticOrder, true, true>(lds, g, S, E);
    } else if constexpr (K == 5) {
        phase_ln1_router(a, l, lds, tid);
    } else if constexpr (K == 6) {
        for (int it = blockIdx.x; it < 256; it += gridDim.x) select_item(it, a, lds, tid);
    } else if constexpr (K == 7) {
        pg8::Gemm g{(const bf16_t*)(ws + WS_RA), (const bf16_t*)(ws + WS_WGU) + (size_t)l * NE * 2 * FF * DM, NROWX, NE * 2 * FF, DM};
        pg8::GroupedOrder S; S.init(16, (int)gridDim.x, (int)blockIdx.x);
        pg8::EpiSwiGLU E{(bf16_t*)(ws + WS_HDN), FF, 16};
        pg8::gemm_phase<pg8::EpiSwiGLU, pg8::GroupedOrder, true, true>(lds, g, S, E);
    } else if constexpr (K == 8) {
        pg8::Gemm g{(const bf16_t*)(ws + WS_HDN), (const bf16_t*)(ws + WS_WD) + (size_t)l * NE * DM * FF, NROWX, NE * DM, FF};
        pg8::GroupedOrder S; S.init(4, (int)gridDim.x, (int)blockIdx.x);
        pg8::EpiScaleRow E{(bf16_t*)(ws + WS_RB), DM, 4, (const float*)(ws + WS_GATE)};
        pg8::gemm_phase<pg8::EpiScaleRow, pg8::GroupedOrder, true, true>(lds, g, S, E);
    } else {
        phase_ln2(a, l, tid);
    }
}
__global__ void __launch_bounds__(NTHR, 2) fwd_kernel(Args a) {
    extern __shared__ __attribute__((aligned(16))) unsigned char lds_raw[];
    LAS unsigned char* lds = (LAS unsigned char*)lds_raw;
    cg::grid_group grid = cg::this_grid();
    const int lo = a.ph_lo, hi = a.ph_hi;
    volatile LAS unsigned* bst = (volatile LAS unsigned*)(lds + LDS_BYTES - 64);
    if (threadIdx.x < 16) bst[threadIdx.x] = 0u;
    __syncthreads();
    XcdBarrier bar = xcd_barrier_post((unsigned*)(a.ws + WS_BAR), bst);
    if (hi > 1000) grid.sync();
#define PH_BEGIN(ph) if (lo <= (ph) && (ph) < hi) { int tid = threadIdx.x; asm volatile("" : "+v"(tid));
#define PH_END(ph) if ((ph) + 1 < hi) xcd_barrier(bar); }
    PH_BEGIN(0) for (int rep = 0; rep <= ((REP_MASK >> 10) & 1); ++rep) phase_p0(a, lds, tid); PH_END(0)
#define LAYER(L) \
    PH_BEGIN(1 + 10 * L + 0) for (int rep = 0; rep <= ((REP_MASK >> 0) & 1); ++rep) run_phase<L, 0>(a, lds, tid); PH_END(1 + 10 * L + 0) \
    PH_BEGIN(1 + 10 * L + 1) for (int rep = 0; rep <= ((REP_MASK >> 1) & 1); ++rep) run_phase<L, 1>(a, lds, tid); PH_END(1 + 10 * L + 1) \
    PH_BEGIN(1 + 10 * L + 2) for (int rep = 0; rep <= ((REP_MASK >> 2) & 1); ++rep) run_phase<L, 2>(a, lds, tid); PH_END(1 + 10 * L + 2) \
    PH_BEGIN(1 + 10 * L + 3) for (int rep = 0; rep <= ((REP_MASK >> 3) & 1); ++rep) run_phase<L, 3>(a, lds, tid); PH_END(1 + 10 * L + 3) \
    PH_BEGIN(1 + 10 * L + 4) for (int rep = 0; rep <= ((REP_MASK >> 4) & 1); ++rep) run_phase<L, 4>(a, lds, tid); PH_END(1 + 10 * L + 4) \
    PH_BEGIN(1 + 10 * L + 5) for (int rep = 0; rep <= ((REP_MASK >> 5) & 1); ++rep) run_phase<L, 5>(a, lds, tid); PH_END(1 + 10 * L + 5) \
    PH_BEGIN(1 + 10 * L + 6) for (int rep = 0; rep <= ((REP_MASK >> 6) & 1); ++rep) run_phase<L, 6>(a, lds, tid); PH_END(1 + 10 * L + 6) \
    PH_BEGIN(1 + 10 * L + 7) for (int rep = 0; rep <= ((REP_MASK >> 7) & 1); ++rep) run_phase<L, 7>(a, lds, tid); PH_END(1 + 10 * L + 7) \
    PH_BEGIN(1 + 10 * L + 8) for (int rep = 0; rep <= ((REP_MASK >> 8) & 1); ++rep) run_phase<L, 8>(a, lds, tid); PH_END(1 + 10 * L + 8) \
    PH_BEGIN(1 + 10 * L + 9) for (int rep = 0; rep <= (((REP_MASK >> 9) & 1) && L == 1 ? 1 : 0); ++rep) run_phase<L, 9>(a, lds, tid); PH_END(1 + 10 * L + 9)
    LAYER(0)
    LAYER(1)
#undef LAYER
#undef PH_BEGIN
#undef PH_END
}

#ifndef ONE_LAUNCH
#define ONE_LAUNCH 1
#endif
extern "C" void kernel_launch(void* const* d_in, const int* in_sizes, int n_in, void* d_out, int out_size, void* d_ws, size_t ws_size, hipStream_t stream) {
    static int grid = 0;
    if (grid == 0) {
        if (n_in != 25 || ws_size < WS_END) { fprintf(stderr, "kernel_launch: unexpected problem (n_in %d, ws %zu)\n", n_in, ws_size); grid = -1; return; }
        int dev = 0, cus = 0, per_cu = 0;
        (void)hipGetDevice(&dev);
        (void)hipDeviceGetAttribute(&cus, hipDeviceAttributeMultiprocessorCount, dev);
        if (hipFuncSetAttribute((const void*)fwd_kernel, hipFuncAttributeMaxDynamicSharedMemorySize, LDS_BYTES) != hipSuccess) { fprintf(stderr, "kernel_launch: hipFuncSetAttribute failed\n"); grid = -1; return; }
        if (hipOccupancyMaxActiveBlocksPerMultiprocessor(&per_cu, (const void*)fwd_kernel, NTHR, LDS_BYTES) != hipSuccess || per_cu < 1) { fprintf(stderr, "kernel_launch: occupancy query says %d\n", per_cu); per_cu = 1; }
        (void)hipGetLastError();
        if (cus <= 0) cus = 256;
        grid = cus * per_cu;
    }
    if (grid < 0) return;
    Args a{};
    for (int i = 0; i < 25; ++i) a.in[i] = (const float*)d_in[i];
    a.out = (float*)d_out; a.ws = (unsigned char*)d_ws;
#if ONE_LAUNCH
    if (hipMemsetAsync((char*)d_ws + WS_BAR, 0, 16384, stream) != hipSuccess) { fprintf(stderr, "kernel_launch: memset failed\n"); return; }
    a.ph_lo = 0; a.ph_hi = NPHASES;
    void* args[] = {&a};
    hipError_t e = hipLaunchCooperativeKernel((const void*)fwd_kernel, dim3(grid), dim3(NTHR), args, LDS_BYTES, stream);
    if (e != hipSuccess) fprintf(stderr, "kernel_launch: cooperative launch failed: %s (grid %d)\n", hipGetErrorString(e), grid);
#else
    for (int ph = 0; ph < NPHASES; ++ph) {
        a.ph_lo = ph; a.ph_hi = ph + 1;
        hipLaunchKernelGGL(fwd_kernel, dim3(grid), dim3(NTHR), LDS_BYTES, stream, a);
    }
#endif
}
```

```cpp
#include <hip/hip_runtime.h>
#include <hip/hip_cooperative_groups.h>
#include <cstdio>
#include <cstdint>
namespace cg = cooperative_groups;
namespace pg8 {
#define PG8_LAS __attribute__((address_space(3)))
typedef unsigned short bf16_t;
typedef short bf16x8 __attribute__((ext_vector_type(8)));
typedef float f32x4 __attribute__((ext_vector_type(4)));
typedef unsigned u32x4 __attribute__((ext_vector_type(4)));
constexpr int BM = 256, BK = 64, HALF = 128, HTB = HALF * BK * 2  , STAGE_BYTES = 8 * HTB, NXCD = 8, WGM = 8;

__host__ __device__ __forceinline__ int lds_byte(int r, int c) { const int st = (r >> 4) * 2 + (c >> 5), rr = r & 15, cc = c & 31, ob = rr * 64 + cc * 2; return st * 1024 + (ob ^ (((ob >> 9) & 1) << 5)); }
__host__ __device__ __forceinline__ void stage_rc(int b, int& R, int& C) { const int st = b / 1024, sb = b % 1024, swz = sb ^ (((sb >> 9) & 1) << 5); R = (st >> 1) * 16 + swz / 64; C = (st & 1) * 32 + (swz % 64) / 2; }
__host__ __device__ __forceinline__ int perm32(int rho) { const int n = rho >> 4, i = rho & 15; return 8 * (i >> 2) + 4 * n + (i & 3); }

struct Unit { int pm, pn; };
struct Gemm { const bf16_t* A; const bf16_t* Bt; int M, N, K; };

struct StaticOrder {
    int nM, nN, nwg, G, c;
    __host__ __device__ void init(int M, int N, int G_, int c_) { nM = M / BM; nN = N / BM; nwg = nM * nN; G = G_; c = c_; }
    __host__ __device__ bool next(int i, Unit& u) const {
        const long L = (long)i * G + c; if (L >= nwg) return false;
        int wgid = (int)L; { const int q = nwg / NXCD, r = nwg % NXCD, xcd = wgid % NXCD, off = wgid / NXCD; wgid = (xcd < r ? xcd * (q + 1) : r * (q + 1) + (xcd - r) * q) + off; }
        const int nig = WGM * nN, gid = wgid / nig, fm = gid * WGM, gsz = (nM - fm) < WGM ? (nM - fm) : WGM;
        u.pm = fm + ((wgid % nig) % gsz); u.pn = (wgid % nig) / gsz; return true;
    }
    __device__ __forceinline__ void a_ready(const Unit&) const {}
    __device__ __forceinline__ void done(const Unit&) const {}
};

__device__ __forceinline__ unsigned cvt_pk_bf16(float lo, float hi) { unsigned r; asm volatile("v_cvt_pk_bf16_f32 %0, %1, %2" : "=v"(r) : "v"(lo), "v"(hi)); return r; }
typedef unsigned u32x2 __attribute__((ext_vector_type(2)));

struct GroupedOrder {
    int upe, nNe, nwg, G, c;
    __host__ __device__ void init(int nNe_, int G_, int c_) { nNe = nNe_; upe = 8 * nNe_; nwg = 16 * upe; G = G_; c = c_; }
    __host__ __device__ bool next(int i, Unit& u) const {
        const long L = (long)i * G + c; if (L >= nwg) return false;
        int wgid = (int)L; { const int q = nwg / NXCD, r = nwg % NXCD, xcd = wgid % NXCD, off = wgid / NXCD; wgid = (xcd < r ? xcd * (q + 1) : r * (q + 1) + (xcd - r) * q) + off; }
        const int e = wgid / upe, rr = wgid % upe;
        u.pm = e * 8 + (rr & 7); u.pn = e * nNe + (rr >> 3); return true;
    }
    __device__ __forceinline__ void a_ready(const Unit&) const {}
    __device__ __forceinline__ void done(const Unit&) const {}
};

struct EpiStoreBf16 {
    static constexpr bool PERM = true, AFTER_DRAIN = false;
    bf16_t* O; int ldc;
    __device__ __forceinline__ void operator()(const f32x4 (&acc)[2][2][4][2], const Unit& u, int wr, int wc, int fr, int fq) const {
        const int row0 = u.pm * BM + wr * 64 + fr, col0 = u.pn * BM + wc * 32 + 8 * fq;
#pragma unroll
        for (int ai = 0; ai < 2; ++ai)
#pragma unroll
            for (int m = 0; m < 4; ++m) { bf16_t* rowp = O + (size_t)(row0 + ai * HALF + m * 16) * ldc + col0;
#pragma unroll
                for (int bj = 0; bj < 2; ++bj) { const f32x4 v0 = acc[ai][bj][m][0], v1 = acc[ai][bj][m][1];
                    u32x4 w; w.x = cvt_pk_bf16(v0[0], v0[1]); w.y = cvt_pk_bf16(v0[2], v0[3]); w.z = cvt_pk_bf16(v1[0], v1[1]); w.w = cvt_pk_bf16(v1[2], v1[3]);
                    *(u32x4*)(rowp + bj * HALF) = w; } }
    }
};
struct EpiResF32 {
    static constexpr bool PERM = false, AFTER_DRAIN = false;
    const bf16_t* base; float* O; int ldc; float alpha;
    __device__ __forceinline__ void operator()(const f32x4 (&acc)[2][2][4][2], const Unit& u, int wr, int wc, int fr, int fq) const {
        const int row0 = u.pm * BM + wr * 64 + fr, col0 = u.pn * BM + wc * 32 + 4 * fq;
#pragma unroll
        for (int ai = 0; ai < 2; ++ai)
#pragma unroll
            for (int m = 0; m < 4; ++m) { const size_t ro = (size_t)(row0 + ai * HALF + m * 16) * ldc + col0;
#pragma unroll
                for (int bj = 0; bj < 2; ++bj)
#pragma unroll
                    for (int n = 0; n < 2; ++n) { const u32x2 bw = *(const u32x2*)(base + ro + bj * HALF + 16 * n);
                        f32x4 b; b[0] = __uint_as_float(bw.x << 16); b[1] = __uint_as_float(bw.x & 0xffff0000u); b[2] = __uint_as_float(bw.y << 16); b[3] = __uint_as_float(bw.y & 0xffff0000u);
                        *(f32x4*)(O + ro + bj * HALF + 16 * n) = b * alpha + acc[ai][bj][m][n]; } }
    }
};
struct EpiSwiGLU {
    static constexpr bool PERM = true, AFTER_DRAIN = false;
    bf16_t* O; int ldc; int ntn;
    __device__ __forceinline__ void operator()(const f32x4 (&acc)[2][2][4][2], const Unit& u, int wr, int wc, int fr, int fq) const {
        const int row0 = u.pm * BM + wr * 64 + fr, col0 = ((u.pn % ntn) * BM + wc * 32 + 8 * fq) >> 1;
#pragma unroll
        for (int ai = 0; ai < 2; ++ai)
#pragma unroll
            for (int m = 0; m < 4; ++m) { bf16_t* rowp = O + (size_t)(row0 + ai * HALF + m * 16) * ldc + col0;
#pragma unroll
                for (int bj = 0; bj < 2; ++bj) { const f32x4 v0 = acc[ai][bj][m][0], v1 = acc[ai][bj][m][1];
                    const float h0 = v0[0] * v0[1] * __builtin_amdgcn_rcpf(1.f + __expf(-v0[0])), h1 = v0[2] * v0[3] * __builtin_amdgcn_rcpf(1.f + __expf(-v0[2]));
                    const float h2 = v1[0] * v1[1] * __builtin_amdgcn_rcpf(1.f + __expf(-v1[0])), h3 = v1[2] * v1[3] * __builtin_amdgcn_rcpf(1.f + __expf(-v1[2]));
                    u32x2 w; w.x = cvt_pk_bf16(h0, h1); w.y = cvt_pk_bf16(h2, h3);
                    *(u32x2*)(rowp + bj * (HALF / 2)) = w; } }
    }
};
struct EpiScaleRow {
    static constexpr bool PERM = true, AFTER_DRAIN = false;
    bf16_t* O; int ldc; int ntn; const float* gate;
    __device__ __forceinline__ void operator()(const f32x4 (&acc)[2][2][4][2], const Unit& u, int wr, int wc, int fr, int fq) const {
        const int row0 = u.pm * BM + wr * 64 + fr, col0 = (u.pn % ntn) * BM + wc * 32 + 8 * fq;
#pragma unroll
        for (int ai = 0; ai < 2; ++ai)
#pragma unroll
            for (int m = 0; m < 4; ++m) { const int row = row0 + ai * HALF + m * 16; const float gsc = gate[row]; bf16_t* rowp = O + (size_t)row * ldc + col0;
#pragma unroll
                for (int bj = 0; bj < 2; ++bj) { const f32x4 v0 = acc[ai][bj][m][0] * gsc, v1 = acc[ai][bj][m][1] * gsc;
                    u32x4 w; w.x = cvt_pk_bf16(v0[0], v0[1]); w.y = cvt_pk_bf16(v0[2], v0[3]); w.z = cvt_pk_bf16(v1[0], v1[1]); w.w = cvt_pk_bf16(v1[2], v1[3]);
                    *(u32x4*)(rowp + bj * HALF) = w; } }
    }
};

template <class Epi, class Sched, bool ALIGN_EPI = false, bool SP2 = false, bool GATHER = false>
__device__ __forceinline__ void gemm_phase(PG8_LAS unsigned char* lds, const Gemm g, const Sched& S, const Epi& E, const int* __restrict__ rowidx = nullptr) {
    static_assert(!GATHER || SP2, "GATHER is implemented for the SP2 loop");
    int tid_ = threadIdx.x; asm volatile("" : "+v"(tid_)); const int tid = tid_, wid = __builtin_amdgcn_readfirstlane(tid >> 6), lane = tid & 63, wr = wid >> 2, wc = wid & 3, fr = lane & 15, fq = lane >> 4;
    const int K = g.K, nt = K / BK;
    unsigned voffA[2], voffB[2];
#pragma unroll
    for (int i = 0; i < 2; ++i) { int R, C; stage_rc(tid * 16 + i * 8192, R, C); const int Rb = Epi::PERM ? ((R & ~31) + perm32(R & 31)) : R;
        voffA[i] = (unsigned)(R * K + C) * 2u; voffB[i] = (unsigned)(Rb * K + C) * 2u; }
    int gR[2], gCc[2];
#pragma unroll
    for (int i = 0; i < 2; ++i) { int R, C; stage_rc(tid * 16 + i * 8192, R, C); gR[i] = R; gCc[i] = C * 2; }
    unsigned gC[2][2], gN[2][2];
#define PG8_GOFF(dst, pmv) do { _Pragma("unroll") for (int _h = 0; _h < 2; ++_h) _Pragma("unroll") for (int _i = 0; _i < 2; ++_i) \
        dst[_h][_i] = (unsigned)rowidx[(pmv) * BM + _h * HALF + gR[_i]] * (unsigned)(K * 2) + (unsigned)gCc[_i]; } while (0)
    const size_t kstep = (size_t)(BK * 2);
    const size_t hstep = (size_t)HALF * K * 2;
    const size_t tstep = 2 * hstep;
    const unsigned ldsw = (unsigned)wid * 1024u;
    const int aoff = lds_byte(wr * 64 + fr, fq * 8), boff = lds_byte(wc * 32 + fr, fq * 8);
#define PG8_SA(b, h) (((b) * 2 + (h)) * HTB)
#define PG8_SB(b, h) ((4 + (b) * 2 + (h)) * HTB)
#define PG8_STAGE(bufoff, gbase, voff) do { _Pragma("unroll") for (int _i = 0; _i < 2; ++_i) \
        __builtin_amdgcn_global_load_lds((const unsigned*)((const char*)(gbase) + (voff)[_i]), (PG8_LAS unsigned*)(lds + (bufoff) + ldsw + _i * 8192), 16, 0, 0); } while (0)
#define PG8_STAGE_A(bufoff, gbase, h, nx) do { if constexpr (GATHER) { unsigned _o[2]; _o[0] = (nx) ? gN[h][0] : gC[h][0]; _o[1] = (nx) ? gN[h][1] : gC[h][1]; PG8_STAGE(bufoff, gbase, _o); } \
        else { PG8_STAGE(bufoff, (gbase) + (h) * hstep, voffA); } } while (0)
#define PG8_LDA(dst, b, h) do { _Pragma("unroll") for (int m = 0; m < 4; ++m) _Pragma("unroll") for (int k = 0; k < 2; ++k) dst[m][k] = *(const PG8_LAS bf16x8*)(lds + PG8_SA(b, h) + aoff + m * 2048 + k * 1024); } while (0)
#define PG8_LDB(dst, b, h) do { _Pragma("unroll") for (int n = 0; n < 2; ++n) _Pragma("unroll") for (int k = 0; k < 2; ++k) dst[n][k] = *(const PG8_LAS bf16x8*)(lds + PG8_SB(b, h) + boff + n * 2048 + k * 1024); } while (0)
#define PG8_MMA(ai, bj, At, Bt) do { __builtin_amdgcn_s_setprio(1); _Pragma("unroll") for (int m = 0; m < 4; ++m) _Pragma("unroll") for (int n = 0; n < 2; ++n) _Pragma("unroll") for (int k = 0; k < 2; ++k) \
        acc[ai][bj][m][n] = __builtin_amdgcn_mfma_f32_16x16x32_bf16(Bt[n][k], At[m][k], acc[ai][bj][m][n], 0, 0, 0); __builtin_amdgcn_s_setprio(0); } while (0)
#define PG8_WAIT_V(n) asm volatile("s_waitcnt vmcnt(" #n ")" ::: "memory")
#define PG8_WAIT_L(n) asm volatile("s_waitcnt lgkmcnt(" #n ")" ::: "memory")
#define PG8_BAR __builtin_amdgcn_s_barrier()
#define PG8_SCHED __builtin_amdgcn_sched_barrier(0)
    Unit cur, nxt; int ui = 0;
    if (!S.next(0, cur)) return;
    f32x4 acc[2][2][4][2];
#pragma unroll
    for (int a = 0; a < 2; ++a)
#pragma unroll
        for (int b = 0; b < 2; ++b)
#pragma unroll
            for (int m = 0; m < 4; ++m)
#pragma unroll
                for (int n = 0; n < 2; ++n) acc[a][b][m][n] = (f32x4){0.f, 0.f, 0.f, 0.f};
    bf16x8 At[4][2], B0[2][2], B1[2][2];
    const char* cA = GATHER ? (const char*)g.A : (const char*)g.A + (size_t)cur.pm * tstep; const char* cB = (const char*)g.Bt + (size_t)cur.pn * tstep;
    if constexpr (GATHER) { PG8_GOFF(gC, cur.pm); PG8_GOFF(gN, cur.pm); }
    S.a_ready(cur);
    if constexpr (SP2) {
        PG8_STAGE(PG8_SB(0, 0), cB, voffB); PG8_STAGE(PG8_SB(0, 1), cB + hstep, voffB); PG8_STAGE_A(PG8_SA(0, 0), cA, 0, false); PG8_STAGE_A(PG8_SA(0, 1), cA, 1, false);
        if (wr == 1) PG8_BAR;
        PG8_WAIT_V(2); PG8_BAR;
        PG8_STAGE(PG8_SB(1, 0), cB + kstep, voffB); PG8_STAGE_A(PG8_SA(1, 0), cA + kstep, 0, false); PG8_STAGE(PG8_SB(1, 1), cB + hstep + kstep, voffB);
        PG8_WAIT_V(6); PG8_BAR;
    } else {
        PG8_STAGE(PG8_SB(0, 0), cB, voffB); PG8_STAGE(PG8_SA(0, 0), cA, voffA); PG8_STAGE(PG8_SB(0, 1), cB + hstep, voffB); PG8_STAGE(PG8_SA(0, 1), cA + hstep, voffA);
        if (wr == 1) PG8_BAR;
        PG8_WAIT_V(4); PG8_BAR;
        PG8_STAGE(PG8_SB(1, 0), cB + kstep, voffB); PG8_STAGE(PG8_SA(1, 0), cA + kstep, voffA); PG8_STAGE(PG8_SB(1, 1), cB + hstep + kstep, voffB);
        PG8_WAIT_V(6); PG8_BAR;
    }
    for (;;) {
        const bool has_next = S.next(ui + 1, nxt);
        const char* nA = GATHER ? cA : (has_next ? (const char*)g.A + (size_t)nxt.pm * tstep : cA); const char* nB = has_next ? (const char*)g.Bt + (size_t)nxt.pn * tstep : cB;
        if constexpr (GATHER) { if (has_next) PG8_GOFF(gN, nxt.pm); }
        for (int t = 0; t < nt; t += 2) {
            const bool last = (t == nt - 2);
            const char* a1 = cA + (size_t)(t + 1) * kstep;
            const char* a2 = last ? nA : cA + (size_t)(t + 2) * kstep; const char* b2 = last ? nB : cB + (size_t)(t + 2) * kstep;
            const char* a3 = a2 + kstep; const char* b3 = b2 + kstep;
            if (last && has_next) S.a_ready(nxt);
            if constexpr (SP2) {
            PG8_LDB(B0, 0, 0); PG8_LDB(B1, 0, 1); PG8_SCHED; PG8_LDA(At, 0, 0); PG8_STAGE_A(PG8_SA(1, 1), a1, 1, false);
            PG8_WAIT_V(8); PG8_WAIT_L(0); PG8_BAR; PG8_MMA(0, 0, At, B0); PG8_MMA(0, 1, At, B1); PG8_BAR; PG8_SCHED;
            PG8_LDA(At, 0, 1); PG8_STAGE(PG8_SB(0, 0), b2, voffB); PG8_STAGE(PG8_SB(0, 1), b2 + hstep, voffB); PG8_STAGE_A(PG8_SA(0, 0), a2, 0, last);
            PG8_WAIT_V(8); PG8_WAIT_L(0); PG8_BAR; PG8_MMA(1, 0, At, B0); PG8_MMA(1, 1, At, B1); PG8_BAR; PG8_SCHED;
            PG8_LDB(B0, 1, 0); PG8_LDB(B1, 1, 1); PG8_SCHED; PG8_LDA(At, 1, 0); PG8_STAGE_A(PG8_SA(0, 1), a2, 1, last);
            PG8_WAIT_V(8); PG8_WAIT_L(0); PG8_BAR; PG8_MMA(0, 0, At, B0); PG8_MMA(0, 1, At, B1); PG8_BAR; PG8_SCHED;
            PG8_LDA(At, 1, 1); PG8_STAGE(PG8_SB(1, 0), b3, voffB); PG8_STAGE(PG8_SB(1, 1), b3 + hstep, voffB); PG8_STAGE_A(PG8_SA(1, 0), a3, 0, last);
            PG8_WAIT_V(8); PG8_WAIT_L(0); PG8_BAR; PG8_MMA(1, 0, At, B0); PG8_MMA(1, 1, At, B1); PG8_BAR; PG8_SCHED;
            } else {
            PG8_LDB(B0, 0, 0); PG8_SCHED; PG8_LDA(At, 0, 0); PG8_STAGE(PG8_SA(1, 1), a1 + hstep, voffA);
            PG8_WAIT_L(8); PG8_BAR; PG8_WAIT_L(0); PG8_MMA(0, 0, At, B0); PG8_BAR; PG8_SCHED;
            PG8_LDB(B1, 0, 1); PG8_STAGE(PG8_SB(0, 0), b2, voffB);
            PG8_BAR; PG8_WAIT_L(0); PG8_MMA(0, 1, At, B1); PG8_BAR;
            PG8_LDA(At, 0, 1); PG8_STAGE(PG8_SA(0, 0), a2, voffA);
            PG8_BAR; PG8_WAIT_L(0); PG8_MMA(1, 0, At, B0); PG8_BAR; PG8_SCHED;
            PG8_STAGE(PG8_SB(0, 1), b2 + hstep, voffB);
            PG8_WAIT_V(6); PG8_BAR; PG8_MMA(1, 1, At, B1); PG8_BAR;
            PG8_LDB(B0, 1, 0); PG8_SCHED; PG8_LDA(At, 1, 0); PG8_STAGE(PG8_SA(0, 1), a2 + hstep, voffA);
            PG8_WAIT_L(8); PG8_BAR; PG8_WAIT_L(0); PG8_MMA(0, 0, At, B0); PG8_BAR; PG8_SCHED;
            PG8_LDB(B1, 1, 1); PG8_STAGE(PG8_SB(1, 0), b3, voffB);
            PG8_BAR; PG8_WAIT_L(0); PG8_MMA(0, 1, At, B1); PG8_BAR;
            PG8_LDA(At, 1, 1); PG8_STAGE(PG8_SA(1, 0), a3, voffA);
            PG8_BAR; PG8_WAIT_L(0); PG8_MMA(1, 0, At, B0); PG8_BAR; PG8_SCHED;
            PG8_STAGE(PG8_SB(1, 1), b3 + hstep, voffB);
            PG8_WAIT_V(6); PG8_BAR; PG8_MMA(1, 1, At, B1); PG8_BAR;
            }
        }
        if constexpr (ALIGN_EPI) { if (wr == 0) PG8_BAR; }
        if constexpr (!Epi::AFTER_DRAIN) { E(acc, cur, wr, wc, fr, fq); S.done(cur); }
        if (!has_next) break;
#pragma unroll
        for (int a = 0; a < 2; ++a)
#pragma unroll
            for (int b = 0; b < 2; ++b)
#pragma unroll
                for (int m = 0; m < 4; ++m)
#pragma unroll
                    for (int n = 0; n < 2; ++n) acc[a][b][m][n] = (f32x4){0.f, 0.f, 0.f, 0.f};
        cur = nxt; cA = nA; cB = nB; ++ui;
        if constexpr (GATHER) { _Pragma("unroll") for (int _h = 0; _h < 2; ++_h) _Pragma("unroll") for (int _i = 0; _i < 2; ++_i) gC[_h][_i] = gN[_h][_i]; }
        if constexpr (ALIGN_EPI) { if (wr == 1) PG8_BAR; }
    }
    PG8_WAIT_V(0);
    if constexpr (!ALIGN_EPI) { if (wr == 0) PG8_BAR; }
    PG8_BAR;
    if constexpr (Epi::AFTER_DRAIN) { E.fused(acc, cur, wr, wc, fr, fq, lds, wid, lane); S.done(cur); }
#undef PG8_SA
#undef PG8_SB
#undef PG8_STAGE
#undef PG8_STAGE_A
#undef PG8_GOFF
#undef PG8_LDA
#undef PG8_LDB
#undef PG8_MMA
#undef PG8_WAIT_V
#undef PG8_WAIT_L
#undef PG8_BAR
#undef PG8_SCHED
}
}

using pg8::bf16_t; using pg8::bf16x8; using pg8::f32x4; using pg8::u32x4; using pg8::u32x2;
#define LAS __attribute__((address_space(3)))
typedef short bf16x4 __attribute__((ext_vector_type(4)));

constexpr int NB = 4, SEQ = 4096, DM = 1024, MTOK = NB * SEQ, DIN = 2048, NE = 16, FF = 2048, CAP = 512, NROWX = NE * NB * CAP;
constexpr float ALPHA = 1.41421356237309515f, LN_EPS = 1e-5f;
constexpr int NWAVES = 8, NTHR = 512;
constexpr int LDS_BYTES = 147456;
constexpr int S5T = 32, S5NCH = SEQ / S5T;

constexpr size_t MiB = 1u << 20;
constexpr size_t WS_WIN = 0, WS_WOUT = 8 * MiB, WS_WGLU = 12 * MiB, WS_S5TAB = 13 * MiB, WS_AFFT = 14 * MiB, WS_IDX = 15 * MiB, WS_GATE = 16 * MiB, WS_SLOT = 17 * MiB, WS_BAR = 18 * MiB, WS_S5BT = 19 * MiB, WS_S5CT = 20 * MiB;
constexpr size_t WS_WGU = 32 * MiB, WS_WD = 288 * MiB, WS_H32 = 416 * MiB, WS_HBF = 480 * MiB, WS_RA = 512 * MiB  , WS_RB = 576 * MiB  ;
constexpr size_t WS_HDN = 640 * MiB, WS_KVF = 768 * MiB, WS_KVB = 776 * MiB, WS_STF = 784 * MiB, WS_STB = 792 * MiB, WS_S5E = 800 * MiB, WS_S5C = 808 * MiB, WS_END = 816 * MiB;

struct Args { const float* in[25]; float* out; unsigned char* ws; int ph_lo, ph_hi; };

typedef __bf16 bf16x2_hw __attribute__((ext_vector_type(2)));
typedef float f32x2_hw __attribute__((ext_vector_type(2)));
__device__ __forceinline__ unsigned pk2(float lo, float hi) { const f32x2_hw v = {lo, hi}; const bf16x2_hw b = __builtin_convertvector(v, bf16x2_hw); return __builtin_bit_cast(unsigned, b); }
__device__ __forceinline__ unsigned f2bf(float f) { return pk2(f, 0.f) & 0xffffu; }
__device__ __forceinline__ float bflo(unsigned w) { return __uint_as_float(w << 16); }
__device__ __forceinline__ float bfhi(unsigned w) { return __uint_as_float(w & 0xffff0000u); }
__device__ __forceinline__ f32x4 mfma16(bf16x8 a, bf16x8 b, f32x4 c) { return __builtin_amdgcn_mfma_f32_16x16x32_bf16(a, b, c, 0, 0, 0); }
__device__ __forceinline__ float wave_sum(float v) {
#pragma unroll
    for (int o = 1; o < 64; o <<= 1) v += __shfl_xor(v, o);
    return v;
}
__device__ __forceinline__ bf16x8 pack8(const f32x4& a, const f32x4& b) {
    u32x4 w; w.x = pk2(a[0], a[1]); w.y = pk2(a[2], a[3]); w.z = pk2(b[0], b[1]); w.w = pk2(b[2], b[3]);
    return __builtin_bit_cast(bf16x8, w);
}
__device__ __forceinline__ bf16x8 cat8(bf16x4 lo, bf16x4 hi) { bf16x8 r; r[0] = lo[0]; r[1] = lo[1]; r[2] = lo[2]; r[3] = lo[3]; r[4] = hi[0]; r[5] = hi[1]; r[6] = hi[2]; r[7] = hi[3]; return r; }
#define LDS_WAIT() asm volatile("s_waitcnt lgkmcnt(0)" ::: "memory")

struct ConvItem { const float* srcp; bf16_t* dstp; int N; int rstep; };
__device__ __forceinline__ ConvItem conv_decode(const Args& a, int it, int lane) {
    constexpr int I3 = 16384, I4 = 16384, I5 = 16384, I0 = 1024, I1 = 512;
    unsigned char* ws = a.ws;
    const float* src; bf16_t* dst; int K, N, rmul = 1, ro = 0, kb, nb;
    int r = it;
    if (r < I3 + I4) { const int up = r >= I3; r -= up ? I3 : 0; const int mat = r >> 9, q = r & 511; src = (up ? a.in[21] : a.in[20]) + (size_t)mat * DM * FF; dst = (bf16_t*)(ws + WS_WGU) + (size_t)mat * 2 * FF * DM; K = DM; N = FF; rmul = 2; ro = up; kb = q >> 5; nb = q & 31; }
    else { r -= I3 + I4;
        if (r < I5) { const int mat = r >> 9, q = r & 511; src = a.in[22] + (size_t)mat * FF * DM; dst = (bf16_t*)(ws + WS_WD) + (size_t)mat * DM * FF; K = FF; N = DM; kb = q >> 4; nb = q & 15; }
        else { r -= I5;
            if (r < I0) { const int mat = r >> 9, q = r & 511; src = a.in[3] + (size_t)mat * DM * DIN; dst = (bf16_t*)(ws + WS_WIN) + (size_t)mat * DIN * DM; K = DM; N = DIN; kb = q >> 5; nb = q & 31; }
            else { r -= I0;
                if (r < I1) { const int mat = r >> 8, q = r & 255; src = a.in[16] + (size_t)mat * DM * DM; dst = (bf16_t*)(ws + WS_WOUT) + (size_t)mat * DM * DM; K = DM; N = DM; kb = q >> 4; nb = q & 15; }
                else { r -= I1; const int mat = r >> 4, q = r & 15; src = a.in[13] + (size_t)mat * 65536; dst = (bf16_t*)(ws + WS_WGLU) + (size_t)mat * 65536; K = 256; N = 256; kb = q >> 2; nb = q & 3; } } } }
    ConvItem c; c.N = N;
    c.srcp = src + (size_t)(kb * 64 + (lane >> 4)) * N + nb * 64 + (lane & 15) * 4;
    c.dstp = dst + (size_t)((nb * 64) * rmul + ro) * K + kb * 64; c.rstep = rmul * K;
    return c;
}
__device__ __forceinline__ void conv_load(const ConvItem& c, f32x4 (&v)[16]) {
#pragma unroll
    for (int i = 0; i < 16; ++i) v[i] = __builtin_nontemporal_load((const f32x4*)(c.srcp + (size_t)(i * 4) * c.N));
}
__device__ __forceinline__ void conv_store(const ConvItem& c, const f32x4 (&v)[16], LAS float* scr, int lane) {
    const int r4 = lane >> 4, c4 = (lane & 15) * 4;
#pragma unroll
    for (int i = 0; i < 16; ++i) { const int kk = i * 4 + r4; *(LAS f32x4*)(scr + kk * 68 + (c4 ^ (((kk >> 3) & 7) * 4))) = v[i]; }
    LDS_WAIT();
    const int cc = lane & 7, nl = lane >> 3;
#pragma unroll
    for (int p = 0; p < 8; ++p) {
        const int n = nl + 8 * p;
        const LAS float* s = scr + (8 * cc) * 68 + (n ^ (4 * cc));
        u32x4 o; o.x = pk2(s[0], s[68]); o.y = pk2(s[2 * 68], s[3 * 68]); o.z = pk2(s[4 * 68], s[5 * 68]); o.w = pk2(s[6 * 68], s[7 * 68]);
        *(u32x4*)(c.dstp + (size_t)n * c.rstep + 8 * cc) = o;
    }
    LDS_WAIT();
}
__device__ __forceinline__ void sincos_rev(double f, double& sn, double& cs) {
    const double a = f * 6.283185307179586476925;
    const double q = rint(a * 0.636619772367581343);
    const double r = a - q * 1.570796326794896619;
    const double r2 = r * r;
    double s = -7.6471637318198164759e-13; s = s * r2 + 1.6059043836821614599e-10; s = s * r2 - 2.5052108385441718775e-8; s = s * r2 + 2.7557319223985890653e-6;
    s = s * r2 - 1.9841269841269841270e-4; s = s * r2 + 8.3333333333333333333e-3; s = s * r2 - 1.6666666666666666667e-1; s = s * r2 * r + r;
    double c = 4.7794773323873852974e-14; c = c * r2 - 1.1470745597729724714e-11; c = c * r2 + 2.0876756987868098979e-9; c = c * r2 - 2.7557319223985890653e-7;
    c = c * r2 + 2.4801587301587301587e-5; c = c * r2 - 1.3888888888888888889e-3; c = c * r2 + 4.1666666666666666667e-2; c = c * r2 - 0.5; c = c * r2 + 1.0;
    const int qi = ((int)q) & 3;
    sn = (qi == 0) ? s : (qi == 1) ? c : (qi == 2) ? -s : -c;
    cs = (qi == 0) ? c : (qi == 1) ? -s : (qi == 2) ? -c : s;
}
__device__ __forceinline__ double exp_small(double x) {
    const double y = x * (1.0 / 64.0);
    double e = 1.0 / 479001600.0;
    e = e * y + 1.0 / 39916800.0; e = e * y + 1.0 / 3628800.0; e = e * y + 1.0 / 362880.0; e = e * y + 1.0 / 40320.0; e = e * y + 1.0 / 5040.0; e = e * y + 1.0 / 720.0;
    e = e * y + 1.0 / 120.0; e = e * y + 1.0 / 24.0; e = e * y + 1.0 / 6.0; e = e * y + 0.5; e = e * y + 1.0; e = e * y + 1.0;
#pragma unroll
    for (int i = 0; i < 6; ++i) e = e * e;
    return e;
}
__device__ __forceinline__ void s5_coefs(const Args& a, int t, double& br, double& bi, double& cr, double& ci, double& tr, double& ti) {
    const int g = (t >> 6) & 15, lr = t >> 10;
    const double lre = (double)a.in[5][t], lim = (double)a.in[6][t];
    const double step = exp_small((double)a.in[7][lr * 16 + g]);
    const double ar = lre * step, th = lim * step;
    const double rev = th * 0.15915494309189533577; const double fr = rev - rint(rev);
    double sn, cs; sincos_rev(fr, sn, cs);
    const double mag = exp_small(ar);
    br = mag * cs; bi = mag * sn;
    const double nr = br - 1.0, ni = bi, den = lre * lre + lim * lim;
    cr = (nr * lre + ni * lim) / den; ci = (ni * lre - nr * lim) / den;
    const double rev2 = rev * (double)S5T; const double fr2 = rev2 - rint(rev2);
    double sn2, cs2; sincos_rev(fr2, sn2, cs2);
    const double mag2 = exp_small(ar * (double)S5T);
    tr = mag2 * cs2; ti = mag2 * sn2;
}
__device__ __forceinline__ void s5_table_entry(const Args& a, int t) {
    double br, bi, cr, ci, tr, ti; s5_coefs(a, t, br, bi, cr, ci, tr, ti);
    float* o = (float*)(a.ws + WS_S5TAB) + (size_t)t * 8;
    o[0] = (float)br; o[1] = (float)bi; o[2] = (float)cr; o[3] = (float)ci; o[4] = (float)tr; o[5] = (float)ti; o[6] = 0.f; o[7] = 0.f;
}
__device__ __forceinline__ void s5_bt_row(const Args& a, int t) {
    const int l = t >> 12, g = (t >> 8) & 15, n = t & 255, r = n >> 7, p = (n >> 1) & 63, ri = n & 1;
    double br, bi, cr, ci, tr, ti; s5_coefs(a, ((l * 2 + r) * 16 + g) * 64 + p, br, bi, cr, ci, tr, ti);
    const float crf = (float)cr, cif = (float)ci;
    const float* bre = a.in[8] + (size_t)((l * 16 + g) * 64 + p) * 16; const float* bim = a.in[9] + (size_t)((l * 16 + g) * 64 + p) * 16;
    u32x4 o[2];
#pragma unroll
    for (int h = 0; h < 2; ++h) {
        const f32x4 x0 = *(const f32x4*)(bre + 8 * h), x1 = *(const f32x4*)(bre + 8 * h + 4), y0 = *(const f32x4*)(bim + 8 * h), y1 = *(const f32x4*)(bim + 8 * h + 4);
        float v[8];
#pragma unroll
        for (int k = 0; k < 4; ++k) { v[k] = ri ? (crf * y0[k] + cif * x0[k]) : (crf * x0[k] - cif * y0[k]); v[4 + k] = ri ? (crf * y1[k] + cif * x1[k]) : (crf * x1[k] - cif * y1[k]); }
        o[h].x = pk2(v[0], v[1]); o[h].y = pk2(v[2], v[3]); o[h].z = pk2(v[4], v[5]); o[h].w = pk2(v[6], v[7]);
    }
    u32x4* dst = (u32x4*)((bf16_t*)(a.ws + WS_S5BT) + (size_t)t * 32);
    dst[0] = o[0]; dst[1] = o[1]; dst[2] = (u32x4){0u, 0u, 0u, 0u}; dst[3] = (u32x4){0u, 0u, 0u, 0u};
}
__device__ __forceinline__ void s5_ct_entry(const Args& a, int t) {
    const int p = t & 63, r = (t >> 6) & 1, c = (t >> 7) & 15, g = (t >> 11) & 15, l = t >> 15;
    const size_t ci = (size_t)(((l * 2 + r) * 16 + g) * 16 + c) * 64 + p;
    ((unsigned*)(a.ws + WS_S5CT))[t] = pk2(a.in[10][ci], -a.in[11][ci]);
}
__device__ __forceinline__ void ln_rows4(f32x4 (&v)[4], const float* __restrict__ g, const float* __restrict__ bt, int lane) {
    float s = 0.f;
#pragma unroll
    for (int j = 0; j < 4; ++j) s += (v[j][0] + v[j][1]) + (v[j][2] + v[j][3]);
    const float mean = wave_sum(s) * (1.f / DM); float s2 = 0.f;
#pragma unroll
    for (int j = 0; j < 4; ++j) { v[j] = v[j] - mean; s2 += (v[j][0] * v[j][0] + v[j][1] * v[j][1]) + (v[j][2] * v[j][2] + v[j][3] * v[j][3]); }
    const float rstd = 1.f / sqrtf(wave_sum(s2) * (1.f / DM) + LN_EPS);
#pragma unroll
    for (int j = 0; j < 4; ++j) { const f32x4 gv = ((const f32x4*)g)[lane + 64 * j], bv = ((const f32x4*)bt)[lane + 64 * j]; v[j] = v[j] * rstd * gv + bv; }
}
__device__ __forceinline__ void store_row(const f32x4 (&v)[4], float* o32, bf16_t* obf, int lane) {
#pragma unroll
    for (int j = 0; j < 4; ++j) {
        if (o32) ((f32x4*)o32)[lane + 64 * j] = v[j];
        if (obf) { u32x2 w; w.x = pk2(v[j][0], v[j][1]); w.y = pk2(v[j][2], v[j][3]); ((u32x2*)obf)[lane + 64 * j] = w; }
    }
}
__device__ __forceinline__ void phase_p0(const Args& a, LAS unsigned char* lds, int tid) {
    const int lane = tid & 63, wave = tid >> 6;
    const int gw = blockIdx.x * NWAVES + wave, NGW = gridDim.x * NWAVES;
    LAS float* scr = (LAS float*)(lds + wave * 17408);
    unsigned char* ws = a.ws;
    constexpr int NIT = 16384 * 3 + 1024 + 512 + 32;
    if (gw < NIT) {
        ConvItem cur = conv_decode(a, gw, lane);
        f32x4 v[16]; conv_load(cur, v);
        for (int it = gw; it < NIT; it += NGW) {
            const bool more = (it + NGW) < NIT;
            ConvItem nxt = cur; f32x4 vn[16];
            if (more) { nxt = conv_decode(a, it + NGW, lane); conv_load(nxt, vn); }
            conv_store(cur, v, scr, lane);
            if (more) { cur = nxt;
#pragma unroll
                for (int i = 0; i < 16; ++i) v[i] = vn[i]; }
        }
    }
    for (int t = blockIdx.x * NTHR + tid; t < 4096; t += gridDim.x * NTHR) s5_table_entry(a, t);
    for (int t = blockIdx.x * NTHR + tid; t < 8192; t += gridDim.x * NTHR) s5_bt_row(a, t);
    for (int t = blockIdx.x * NTHR + tid; t < 65536; t += gridDim.x * NTHR) s5_ct_entry(a, t);
    for (int m = gw; m < MTOK; m += NGW) {
        f32x4 v[4];
#pragma unroll
        for (int j = 0; j < 4; ++j) v[j] = ((const f32x4*)(a.in[0] + (size_t)m * DM))[lane + 64 * j];
        ln_rows4(v, a.in[1], a.in[2], lane);
        store_row(v, nullptr, (bf16_t*)(ws + WS_HBF) + (size_t)m * DM, lane);
    }
}

__device__ __forceinline__ void attn_item(int item, const bf16_t* __restrict__ proj, bf16_t* __restrict__ mix, const float* __restrict__ sink_l, LAS unsigned char* lds, int tid) {
    const int kh = item & 1, c = (item >> 1) & 31, b = item >> 6;
    constexpr int VS = 408;
    LAS bf16_t* Ks = (LAS bf16_t*)lds;
    LAS bf16_t* Vt = (LAS bf16_t*)(lds + 384 * 72 * 2);
    const int lane = tid & 63, w = tid >> 6, fr = lane & 15, fq = lane >> 4;
    const int hq = kh * 4 + (w >> 1);
    const bf16_t* qbase = proj + ((size_t)b * SEQ + c * 128 + (w & 1) * 64 + fr) * DIN + 1280 + hq * 64 + fq * 8;
    bf16x8 qn0 = *(const bf16x8*)qbase, qn1 = *(const bf16x8*)(qbase + 32);
#pragma unroll
    for (int i = 0; i < 6; ++i) {
        const int id = tid + NTHR * i, key = id >> 3, ch = id & 7;
        const int s = (c - 1) * 128 + key; const bool ok = (s >= 0) && (s < SEQ);
        u32x4 kv = {0u, 0u, 0u, 0u}, vv = {0u, 0u, 0u, 0u};
        if (ok) { const bf16_t* rowp = proj + (size_t)(b * SEQ + s) * DIN; kv = *(const u32x4*)(rowp + 1792 + kh * 64 + ch * 8); vv = *(const u32x4*)(rowp + 1920 + kh * 64 + ch * 8); }
        *(LAS u32x4*)(Ks + key * 72 + ch * 8) = kv;
        LAS bf16_t* vp = Vt + (ch * 8) * VS + key;
        vp[0 * VS] = (bf16_t)(vv.x & 0xffffu); vp[1 * VS] = (bf16_t)(vv.x >> 16); vp[2 * VS] = (bf16_t)(vv.y & 0xffffu); vp[3 * VS] = (bf16_t)(vv.y >> 16);
        vp[4 * VS] = (bf16_t)(vv.z & 0xffffu); vp[5 * VS] = (bf16_t)(vv.z >> 16); vp[6 * VS] = (bf16_t)(vv.w & 0xffffu); vp[7 * VS] = (bf16_t)(vv.w >> 16);
    }
    if (tid < 128) { const int d = tid >> 1, hh = tid & 1; *(LAS u32x4*)(Vt + d * VS + 384 + hh * 8) = (u32x4){0u, 0u, 0u, 0u}; }
    __syncthreads();
    const float slope = exp2f(-(float)(hq + 1));
    const float sinkv = sink_l[hq];
    const bool lo_ok = (c >= 1), hi_ok = (c <= 30);
    float plo[4], phi[4];
#pragma unroll
    for (int j = 0; j < 4; ++j) { plo[j] = (fq * 4 + j >= fr) ? 0.f : -1e30f; phi[j] = (fq * 4 + j <= fr) ? 0.f : -1e30f; }
#pragma unroll 1
    for (int qi = 0; qi < 4; ++qi) {
        const int qt = (w & 1) * 4 + qi;
        const size_t tok = (size_t)b * SEQ + c * 128 + qt * 16 + fr;
        const bf16x8 qa0 = qn0, qa1 = qn1;
        float slope_l = slope; asm volatile("" : "+v"(slope_l));
        float sd[4];
#pragma unroll
        for (int j = 0; j < 4; ++j) sd[j] = slope_l * (float)(fq * 4 + j - fr);
        if (qi < 3) { const bf16_t* qp = qbase + (size_t)(qi + 1) * 16 * DIN; qn0 = *(const bf16x8*)qp; qn1 = *(const bf16x8*)(qp + 32); }
        f32x4 s[18];
        float mx = sinkv;
        const LAS bf16_t* kbase = Ks + (qt * 16 + fr) * 72 + fq * 8;
        const LAS bf16_t* vbase = Vt + fr * VS + qt * 16 + fq * 4;
#pragma unroll
        for (int i = 0; i < 17; ++i) {
            const int kt = qt + i;
            const LAS bf16_t* kp = kbase + i * (16 * 72);
            f32x4 acc = {0.f, 0.f, 0.f, 0.f};
            acc = mfma16(*(const LAS bf16x8*)kp, qa0, acc); acc = mfma16(*(const LAS bf16x8*)(kp + 32), qa1, acc);
            const float pblk = ((kt < 8) ? lo_ok : ((kt >= 16) ? hi_ok : true)) ? 0.f : -1e30f;
            const float base = slope_l * (float)(16 * i - 128);
#pragma unroll
            for (int j = 0; j < 4; ++j) {
                float t = (i < 8) ? (base + sd[j]) : ((i > 8) ? -(base + sd[j]) : -fabsf(sd[j]));
                if (i == 0) t += plo[j];
                if (i == 16) t += phi[j];
                const float v = fmaf(acc[j], 0.125f, t + pblk);
                acc[j] = v; mx = fmaxf(mx, v);
            }
            s[i] = acc;
        }
        mx = fmaxf(mx, __shfl_xor(mx, 16)); mx = fmaxf(mx, __shfl_xor(mx, 32));
        float sum = 0.f;
#pragma unroll
        for (int i = 0; i < 17; ++i)
#pragma unroll
            for (int j = 0; j < 4; ++j) { const float p = __expf(s[i][j] - mx); s[i][j] = p; sum += p; }
        s[17] = (f32x4){0.f, 0.f, 0.f, 0.f};
        sum += __shfl_xor(sum, 16); sum += __shfl_xor(sum, 32);
        const float inv = 1.f / (sum + __expf(sinkv - mx));
        f32x4 o[4];
#pragma unroll
        for (int dt = 0; dt < 4; ++dt) o[dt] = (f32x4){0.f, 0.f, 0.f, 0.f};
#pragma unroll
        for (int kk = 0; kk < 9; ++kk) {
            const bf16x8 pb = pack8(s[2 * kk], s[2 * kk + 1]);
#pragma unroll
            for (int dt = 0; dt < 4; ++dt) {
                const LAS bf16_t* vp = vbase + dt * (16 * VS) + kk * 32;
                o[dt] = mfma16(cat8(*(const LAS bf16x4*)vp, *(const LAS bf16x4*)(vp + 16)), pb, o[dt]);
            }
        }
        bf16_t* op = mix + tok * DM + 512 + hq * 64 + fq * 4;
#pragma unroll
        for (int dt = 0; dt < 4; ++dt) { u32x2 wv; wv.x = pk2(o[dt][0] * inv, o[dt][1] * inv); wv.y = pk2(o[dt][2] * inv, o[dt][3] * inv); *(u32x2*)(op + dt * 16) = wv; }
    }
    __syncthreads();
}

__device__ __forceinline__ float log_sigmoid(float t) { return -log1pf(__expf(-t)); }
__device__ __forceinline__ void retkv_item(int item, const bf16_t* __restrict__ proj, float* __restrict__ kvf, float* __restrict__ kvb, const float* __restrict__ theta, LAS unsigned char* lds, int tid) {
    const int h = item & 3, c = (item >> 2) & 31, b = item >> 7;
    const float lgf = log_sigmoid(theta[h]), lgb = log_sigmoid(theta[4 + h]);
    LAS bf16_t* KTf = (LAS bf16_t*)lds; LAS bf16_t* KTb = KTf + 64 * 136; LAS bf16_t* VT = KTb + 64 * 136;
#pragma unroll
    for (int i = 0; i < 2; ++i) {
        const int id = tid + NTHR * i, j = id >> 3, ch = id & 7;
        const bf16_t* rowp = proj + (size_t)(b * SEQ + c * 128 + j) * DIN;
        const u32x4 kr = *(const u32x4*)(rowp + 256 + h * 64 + ch * 8), vr = *(const u32x4*)(rowp + 512 + h * 64 + ch * 8);
        const float wf = __expf(lgf * (float)(127 - j)) * 0.125f, wb = __expf(lgb * (float)j) * 0.125f;
        const int o = (ch * 8) * 136 + j;
        KTf[o + 0 * 136] = (bf16_t)f2bf(bflo(kr.x) * wf); KTf[o + 1 * 136] = (bf16_t)f2bf(bfhi(kr.x) * wf); KTf[o + 2 * 136] = (bf16_t)f2bf(bflo(kr.y) * wf); KTf[o + 3 * 136] = (bf16_t)f2bf(bfhi(kr.y) * wf);
        KTf[o + 4 * 136] = (bf16_t)f2bf(bflo(kr.z) * wf); KTf[o + 5 * 136] = (bf16_t)f2bf(bfhi(kr.z) * wf); KTf[o + 6 * 136] = (bf16_t)f2bf(bflo(kr.w) * wf); KTf[o + 7 * 136] = (bf16_t)f2bf(bfhi(kr.w) * wf);
        KTb[o + 0 * 136] = (bf16_t)f2bf(bflo(kr.x) * wb); KTb[o + 1 * 136] = (bf16_t)f2bf(bfhi(kr.x) * wb); KTb[o + 2 * 136] = (bf16_t)f2bf(bflo(kr.y) * wb); KTb[o + 3 * 136] = (bf16_t)f2bf(bfhi(kr.y) * wb);
        KTb[o + 4 * 136] = (bf16_t)f2bf(bflo(kr.z) * wb); KTb[o + 5 * 136] = (bf16_t)f2bf(bfhi(kr.z) * wb); KTb[o + 6 * 136] = (bf16_t)f2bf(bflo(kr.w) * wb); KTb[o + 7 * 136] = (bf16_t)f2bf(bfhi(kr.w) * wb);
        VT[o + 0 * 136] = (bf16_t)(vr.x & 0xffffu); VT[o + 1 * 136] = (bf16_t)(vr.x >> 16); VT[o + 2 * 136] = (bf16_t)(vr.y & 0xffffu); VT[o + 3 * 136] = (bf16_t)(vr.y >> 16);
        VT[o + 4 * 136] = (bf16_t)(vr.z & 0xffffu); VT[o + 5 * 136] = (bf16_t)(vr.z >> 16); VT[o + 6 * 136] = (bf16_t)(vr.w & 0xffffu); VT[o + 7 * 136] = (bf16_t)(vr.w >> 16);
    }
    __syncthreads();
    const int lane = tid & 63, w = tid >> 6, fr = lane & 15, fq = lane >> 4;
    const size_t obase = (size_t)((b * 32 + c) * 4 + h) * 4096;
#pragma unroll
    for (int i = 0; i < 4; ++i) {
        const int job = w * 4 + i, dirb = job >> 4, et = (job >> 2) & 3, dt = job & 3;
        const LAS bf16_t* ap = VT + (et * 16 + fr) * 136 + fq * 8;
        const LAS bf16_t* bp = (dirb ? KTb : KTf) + (dt * 16 + fr) * 136 + fq * 8;
        f32x4 acc = {0.f, 0.f, 0.f, 0.f};
#pragma unroll
        for (int ks = 0; ks < 4; ++ks) acc = mfma16(*(const LAS bf16x8*)(ap + ks * 32), *(const LAS bf16x8*)(bp + ks * 32), acc);
        float* op = (dirb ? kvb : kvf) + obase + (et * 16 + fq * 4) * 64 + dt * 16 + fr;
        op[0] = acc[0]; op[64] = acc[1]; op[128] = acc[2]; op[192] = acc[3];
    }
    __syncthreads();
}
__device__ __forceinline__ void retout_item(int item, const bf16_t* __restrict__ proj, const float* __restrict__ stf, const float* __restrict__ stb, bf16_t* __restrict__ mix, const float* __restrict__ theta, LAS unsigned char* lds, int tid) {
    const int h = item & 3, c = (item >> 2) & 31, b = item >> 7;
    const float lgf = log_sigmoid(theta[h]), lgb = log_sigmoid(theta[4 + h]);
    LAS bf16_t* Qs = (LAS bf16_t*)lds; LAS bf16_t* Ks = Qs + 128 * 72; LAS bf16_t* VT = Ks + 128 * 72; LAS bf16_t* SFt = VT + 64 * 136; LAS bf16_t* SBt = SFt + 64 * 72;
#pragma unroll
    for (int i = 0; i < 2; ++i) {
        const int id = tid + NTHR * i, j = id >> 3, ch = id & 7;
        const bf16_t* rowp = proj + (size_t)(b * SEQ + c * 128 + j) * DIN;
        const u32x4 qr = *(const u32x4*)(rowp + h * 64 + ch * 8), kr = *(const u32x4*)(rowp + 256 + h * 64 + ch * 8), vr = *(const u32x4*)(rowp + 512 + h * 64 + ch * 8);
        *(LAS u32x4*)(Qs + j * 72 + ch * 8) = qr; *(LAS u32x4*)(Ks + j * 72 + ch * 8) = kr;
        const int o = (ch * 8) * 136 + j;
        VT[o + 0 * 136] = (bf16_t)(vr.x & 0xffffu); VT[o + 1 * 136] = (bf16_t)(vr.x >> 16); VT[o + 2 * 136] = (bf16_t)(vr.y & 0xffffu); VT[o + 3 * 136] = (bf16_t)(vr.y >> 16);
        VT[o + 4 * 136] = (bf16_t)(vr.z & 0xffffu); VT[o + 5 * 136] = (bf16_t)(vr.z >> 16); VT[o + 6 * 136] = (bf16_t)(vr.w & 0xffffu); VT[o + 7 * 136] = (bf16_t)(vr.w >> 16);
    }
    const size_t sbase = (size_t)((b * 32 + c) * 4 + h) * 4096;
#pragma unroll
    for (int i = 0; i < 8; ++i) { const int id = tid + NTHR * i, e = id >> 6, d = id & 63; SFt[e * 72 + d] = (bf16_t)f2bf(stf[sbase + id]); SBt[e * 72 + d] = (bf16_t)f2bf(stb[sbase + id]); }
    __syncthreads();
    const int lane = tid & 63, it = tid >> 6, fr = lane & 15, fq = lane >> 4;
    const int ipos = it * 16 + fr;
    const LAS bf16_t* qp = Qs + ipos * 72 + fq * 8;
    const bf16x8 qb0 = *(const LAS bf16x8*)qp, qb1 = *(const LAS bf16x8*)(qp + 32);
    f32x4 st[8];
#pragma unroll
    for (int jt = 0; jt < 8; ++jt) {
        const LAS bf16_t* kp = Ks + (jt * 16 + fr) * 72 + fq * 8;
        f32x4 acc = {0.f, 0.f, 0.f, 0.f};
        acc = mfma16(*(const LAS bf16x8*)kp, qb0, acc); acc = mfma16(*(const LAS bf16x8*)(kp + 32), qb1, acc);
#pragma unroll
        for (int jj = 0; jj < 4; ++jj) { const int dij = ipos - (jt * 16 + fq * 4 + jj); const float dec = dij >= 0 ? __expf(lgf * (float)dij) : __expf(lgb * (float)(-dij)); acc[jj] *= 0.125f * dec; }
        st[jt] = acc;
    }
    f32x4 o[4], ff[4], fb[4];
#pragma unroll
    for (int et = 0; et < 4; ++et) { o[et] = (f32x4){0.f, 0.f, 0.f, 0.f}; ff[et] = o[et]; fb[et] = o[et]; }
#pragma unroll
    for (int kk = 0; kk < 4; ++kk) {
        const bf16x8 pb = pack8(st[2 * kk], st[2 * kk + 1]);
#pragma unroll
        for (int et = 0; et < 4; ++et) { const LAS bf16_t* vp = VT + (et * 16 + fr) * 136 + kk * 32 + fq * 4; o[et] = mfma16(cat8(*(const LAS bf16x4*)vp, *(const LAS bf16x4*)(vp + 16)), pb, o[et]); }
    }
#pragma unroll
    for (int et = 0; et < 4; ++et) {
        const LAS bf16_t* fp = SFt + (et * 16 + fr) * 72 + fq * 8; const LAS bf16_t* bp = SBt + (et * 16 + fr) * 72 + fq * 8;
        ff[et] = mfma16(*(const LAS bf16x8*)fp, qb0, ff[et]); ff[et] = mfma16(*(const LAS bf16x8*)(fp + 32), qb1, ff[et]);
        fb[et] = mfma16(*(const LAS bf16x8*)bp, qb0, fb[et]); fb[et] = mfma16(*(const LAS bf16x8*)(bp + 32), qb1, fb[et]);
    }
    const float cf = __expf(lgf * (float)(ipos + 1)), cb = __expf(lgb * (float)(128 - ipos));
    float s = 0.f;
#pragma unroll
    for (int et = 0; et < 4; ++et) { o[et] = o[et] + ff[et] * cf + fb[et] * cb; s += (o[et][0] + o[et][1]) + (o[et][2] + o[et][3]); }
    s += __shfl_xor(s, 16); s += __shfl_xor(s, 32);
    const float mean = s * (1.f / 64.f); float s2 = 0.f;
#pragma unroll
    for (int et = 0; et < 4; ++et) { o[et] = o[et] - mean; s2 += (o[et][0] * o[et][0] + o[et][1] * o[et][1]) + (o[et][2] * o[et][2] + o[et][3] * o[et][3]); }
    s2 += __shfl_xor(s2, 16); s2 += __shfl_xor(s2, 32);
    const float rstd = 1.f / sqrtf(s2 * (1.f / 64.f) + LN_EPS);
    const size_t tok = (size_t)b * SEQ + c * 128 + ipos;
    const bf16_t* gp = proj + tok * DIN + 768 + h * 64 + fq * 4;
    bf16_t* op = mix + tok * DM + h * 64 + fq * 4;
#pragma unroll
    for (int et = 0; et < 4; ++et) {
        const u32x2 gr = *(const u32x2*)(gp + et * 16);
        const float g0 = bflo(gr.x), g1 = bfhi(gr.x), g2 = bflo(gr.y), g3 = bfhi(gr.y);
        const float y0 = o[et][0] * rstd * (g0 / (1.f + __expf(-g0))), y1 = o[et][1] * rstd * (g1 / (1.f + __expf(-g1)));
        const float y2 = o[et][2] * rstd * (g2 / (1.f + __expf(-g2))), y3 = o[et][3] * rstd * (g3 / (1.f + __expf(-g3)));
        u32x2 wv; wv.x = pk2(y0, y1); wv.y = pk2(y2, y3); *(u32x2*)(op + et * 16) = wv;
    }
    __syncthreads();
}

constexpr int S5XS = 136;
struct S5Pass { bf16x8 bf[8]; f32x4 t0; };
__device__ __forceinline__ void s5_fetch(S5Pass& P, const float* __restrict__ tab, const bf16_t* __restrict__ BT, int g, int r, int lane) {
    const int fr = lane & 15, fq = lane >> 4;
    P.t0 = *(const f32x4*)(tab + (size_t)((r * 16 + g) * 64 + lane) * 8);
    const bf16_t* btp = BT + (size_t)(g * 256 + r * 128 + fr) * 32 + fq * 8;
#pragma unroll
    for (int nt = 0; nt < 8; ++nt) P.bf[nt] = *(const bf16x8*)(btp + nt * 16 * 32);
}
__device__ __forceinline__ void s5_bu(LAS bf16_t* Xw, const S5Pass& P, bf16x8 uf0, bf16x8 uf1, int lane) {
    const int fr = lane & 15, fq = lane >> 4;
#pragma unroll
    for (int mt = 0; mt < 2; ++mt)
#pragma unroll
        for (int nt = 0; nt < 8; ++nt) {
            f32x4 acc = {0.f, 0.f, 0.f, 0.f};
            acc = mfma16(P.bf[nt], mt ? uf1 : uf0, acc);
            u32x2 wv; wv.x = pk2(acc[0], acc[1]); wv.y = pk2(acc[2], acc[3]);
            *(LAS u32x2*)(Xw + (mt * 16 + fr) * S5XS + nt * 16 + fq * 4) = wv;
        }
    asm volatile("s_waitcnt lgkmcnt(0)" ::: "memory");
}
template <bool WRITE>
__device__ __forceinline__ void s5_recur(LAS bf16_t* xq, int r, float lr_, float li_, float& xr, float& xi) {
#pragma unroll 1
    for (int blk = 0; blk < 4; ++blk) {
        LAS bf16_t* q = xq + (r ? (3 - blk) : blk) * (8 * S5XS);
        unsigned bw[8];
#pragma unroll
        for (int k = 0; k < 8; ++k) bw[k] = *(const LAS unsigned*)(q + k * S5XS);
        if (r == 0) {
#pragma unroll
            for (int s = 0; s < 8; ++s) {
                const float nr = fmaf(lr_, xr, fmaf(-li_, xi, bflo(bw[s]))), ni = fmaf(lr_, xi, fmaf(li_, xr, bfhi(bw[s])));
                xr = nr; xi = ni;
                if (WRITE) *(LAS unsigned*)(q + s * S5XS) = pk2(xr, xi);
            }
        } else {
#pragma unroll
            for (int s = 7; s >= 0; --s) {
                const float nr = fmaf(lr_, xr, fmaf(-li_, xi, bflo(bw[s]))), ni = fmaf(lr_, xi, fmaf(li_, xr, bfhi(bw[s])));
                xr = nr; xi = ni;
                if (WRITE) *(LAS unsigned*)(q + s * S5XS) = pk2(xr, xi);
            }
        }
    }
    if (WRITE) asm volatile("s_waitcnt lgkmcnt(0)" ::: "memory");
}
__device__ __forceinline__ void s5_ufrag(const bf16_t* __restrict__ proj, int b, int ch, int g, int lane, bf16x8& uf0, bf16x8& uf1) {
    const int fr = lane & 15, fq = lane >> 4;
    uf0 = (bf16x8){0, 0, 0, 0, 0, 0, 0, 0}; uf1 = uf0;
    if (fq < 2) { const bf16_t* up = proj + (size_t)(b * SEQ + ch * S5T + fr) * DIN + 1024 + g * 16 + fq * 8; uf0 = *(const bf16x8*)up; uf1 = *(const bf16x8*)(up + (size_t)16 * DIN); }
}

__device__ __forceinline__ void s5e_item(int item, const bf16_t* __restrict__ proj, const float* __restrict__ tab  , const bf16_t* __restrict__ BT,
                                         float* __restrict__ E, LAS unsigned char* lds, int tid) {
    const int ch = item & (S5NCH - 1), b = item / S5NCH;
    const int lane = tid & 63, w = tid >> 6;
    LAS bf16_t* Xw = (LAS bf16_t*)lds + w * (32 * S5XS);
    S5Pass cur;
    s5_fetch(cur, tab, BT, w, 0, lane);
    bf16x8 uf0, uf1;
    s5_ufrag(proj, b, ch, w, lane, uf0, uf1);
#pragma unroll 1
    for (int ps = 0; ps < 4; ++ps) {
        const int g = w + 8 * (ps >> 1), r = ps & 1;
        const float lr_ = cur.t0[0], li_ = cur.t0[1];
        s5_bu(Xw, cur, uf0, uf1, lane);
        if (ps < 3) s5_fetch(cur, tab, BT, w + 8 * ((ps + 1) >> 1), (ps + 1) & 1, lane);
        if (ps == 1) s5_ufrag(proj, b, ch, w + 8, lane, uf0, uf1);
        float xr = 0.f, xi = 0.f;
        s5_recur<false>(Xw + lane * 2, r, lr_, li_, xr, xi);
        float2 ev; ev.x = xr; ev.y = xi;
        ((float2*)E)[(size_t)(((b * S5NCH + ch) * 16 + g) * 2 + r) * 64 + lane] = ev;
        asm volatile("s_waitcnt lgkmcnt(0)" ::: "memory");
    }
    __syncthreads();
}
__device__ __forceinline__ void s5out_item(int item, const bf16_t* __restrict__ proj, const float* __restrict__ tab, const bf16_t* __restrict__ BT,
                                           const bf16_t* __restrict__ CT  , const float* __restrict__ dvec, const bf16_t* __restrict__ wgluT, const float* __restrict__ bglu,
                                           const float* __restrict__ CIN, bf16_t* __restrict__ mix, LAS unsigned char* lds, int tid) {
    const int ch = item & (S5NCH - 1), b = item / S5NCH;
    constexpr int YS = 264;
    const int lane = tid & 63, w = tid >> 6, fr = lane & 15, fq = lane >> 4;
    LAS bf16_t* Xw = (LAS bf16_t*)lds + w * (32 * S5XS);
    LAS bf16_t* Y = (LAS bf16_t*)(lds + 8 * 32 * S5XS * 2);
    S5Pass cur; bf16x8 ccf[4]; float2 ccin;
    s5_fetch(cur, tab, BT, w, 0, lane);
    ccin = ((const float2*)CIN)[(size_t)(((b * S5NCH + ch) * 16 + w) * 2 + 0) * 64 + lane];
#pragma unroll
    for (int ks = 0; ks < 4; ++ks) ccf[ks] = *(const bf16x8*)(CT + (size_t)(w * 16 + fr) * 256 + ks * 32 + fq * 8);
    bf16x8 uf0, uf1;
    s5_ufrag(proj, b, ch, w, lane, uf0, uf1);
    f32x4 ya0 = {0.f, 0.f, 0.f, 0.f}, ya1 = ya0;
#pragma unroll 1
    for (int ps = 0; ps < 4; ++ps) {
        const int g = w + 8 * (ps >> 1), r = ps & 1;
        const int gn = w + 8 * ((ps + 1) >> 1), rn = (ps + 1) & 1;
        const float lr_ = cur.t0[0], li_ = cur.t0[1];
        s5_bu(Xw, cur, uf0, uf1, lane);
        if (ps < 3) s5_fetch(cur, tab, BT, gn, rn, lane);
        if (ps == 1) s5_ufrag(proj, b, ch, w + 8, lane, uf0, uf1);
        float xr = ccin.x, xi = ccin.y;
        s5_recur<true>(Xw + lane * 2, r, lr_, li_, xr, xi);
        if (ps < 3) ccin = ((const float2*)CIN)[(size_t)(((b * S5NCH + ch) * 16 + gn) * 2 + rn) * 64 + lane];
#pragma unroll
        for (int ks = 0; ks < 4; ++ks) {
            ya0 = mfma16(ccf[ks], *(const LAS bf16x8*)(Xw + fr * S5XS + ks * 32 + fq * 8), ya0);
            ya1 = mfma16(ccf[ks], *(const LAS bf16x8*)(Xw + (16 + fr) * S5XS + ks * 32 + fq * 8), ya1);
        }
        if (ps < 3) {
#pragma unroll
            for (int ks = 0; ks < 4; ++ks) ccf[ks] = *(const bf16x8*)(CT + (size_t)(gn * 16 + fr) * 256 + rn * 128 + ks * 32 + fq * 8);
        }
        if (r == 1) {
            const int chn = g * 16 + fq * 4;
            const f32x4 dv = *(const f32x4*)(dvec + chn);
#pragma unroll
            for (int mt = 0; mt < 2; ++mt) {
                const int s = mt * 16 + fr;
                const u32x2 uw = *(const u32x2*)(proj + (size_t)(b * SEQ + ch * S5T + s) * DIN + 1024 + chn);
                const float uu[4] = {bflo(uw.x), bfhi(uw.x), bflo(uw.y), bfhi(uw.y)};
                float gl4[4];
#pragma unroll
                for (int jj = 0; jj < 4; ++jj) {
                    const float yv = (mt ? ya1[jj] : ya0[jj]) + dv[jj] * uu[jj];
                    const float t = 0.7978845608028654f * (yv + 0.044715f * yv * yv * yv);
                    gl4[jj] = yv * (1.f - __builtin_amdgcn_rcpf(1.f + __expf(2.f * t)));
                }
                u32x2 yw; yw.x = pk2(gl4[0], gl4[1]); yw.y = pk2(gl4[2], gl4[3]);
                *(LAS u32x2*)(Y + s * YS + chn) = yw;
            }
            ya0 = (f32x4){0.f, 0.f, 0.f, 0.f}; ya1 = ya0;
        }
        asm volatile("s_waitcnt lgkmcnt(0)" ::: "memory");
    }
    __syncthreads();
    {
        const int mt = w & 1;
        bf16x8 yf[8];
#pragma unroll
        for (int ks = 0; ks < 8; ++ks) yf[ks] = *(const LAS bf16x8*)(Y + (mt * 16 + fr) * YS + ks * 32 + fq * 8);
        const int s = mt * 16 + fr;
        bf16_t* orow = mix + (size_t)(b * SEQ + ch * S5T + s) * DM + 256;
#pragma unroll 2
        for (int i = 0; i < 4; ++i) {
            const int nt = (w >> 1) * 4 + i;
            const bf16_t* ap = wgluT + (size_t)(nt * 16 + fr) * 256 + fq * 8;
            f32x4 acc = {0.f, 0.f, 0.f, 0.f};
#pragma unroll
            for (int ks = 0; ks < 8; ++ks) acc = mfma16(*(const bf16x8*)(ap + ks * 32), yf[ks], acc);
            const int n0 = nt * 16 + fq * 4;
            const f32x4 bg = *(const f32x4*)(bglu + n0);
            const u32x2 yw = *(const LAS u32x2*)(Y + s * YS + n0);
            const float yv[4] = {bflo(yw.x), bfhi(yw.x), bflo(yw.y), bfhi(yw.y)};
            float ov[4];
#pragma unroll
            for (int jj = 0; jj < 4; ++jj) ov[jj] = yv[jj] * __builtin_amdgcn_rcpf(1.f + __expf(-(acc[jj] + bg[jj])));
            u32x2 ow; ow.x = pk2(ov[0], ov[1]); ow.y = pk2(ov[2], ov[3]);
            *(u32x2*)(orow + n0) = ow;
        }
    }
    __syncthreads();
}

__device__ __forceinline__ void phase_scan(const Args& a, int l, int tid) {
    unsigned char* ws = a.ws;
    const int lane = tid & 63, wave = tid >> 6;
    {
        const float* tab = (const float*)(ws + WS_S5TAB) + (size_t)l * 2048 * 8;
        const float2* __restrict__ E = (const float2*)(ws + WS_S5E); float2* __restrict__ C = (float2*)(ws + WS_S5C);
        for (int wv = blockIdx.x; wv < 128; wv += gridDim.x) if (wave == 0) {
            const int p = lane, r = wv & 1, g = (wv >> 1) & 15, b = wv >> 5;
            const float* tp = tab + (size_t)((r * 16 + g) * 64 + p) * 8;
            const float tr = tp[4], ti = tp[5];
            float xr = 0.f, xi = 0.f;
            for (int k0 = 0; k0 < S5NCH; k0 += 32) {
                float2 e[32];
#pragma unroll
                for (int k = 0; k < 32; ++k) { const int ch = r ? (S5NCH - 1 - (k0 + k)) : (k0 + k); e[k] = E[(size_t)(((b * S5NCH + ch) * 16 + g) * 2 + r) * 64 + p]; }
#pragma unroll
                for (int k = 0; k < 32; ++k) { const int ch = r ? (S5NCH - 1 - (k0 + k)) : (k0 + k);
                    float2 cv; cv.x = xr; cv.y = xi; C[(size_t)(((b * S5NCH + ch) * 16 + g) * 2 + r) * 64 + p] = cv;
                    const float nr = fmaf(tr, xr, fmaf(-ti, xi, e[k].x)), ni = fmaf(tr, xi, fmaf(ti, xr, e[k].y));
                    xr = nr; xi = ni; }
            }
        }
    }
    {
        const float* theta = a.in[4] + l * 8;
        const float* __restrict__ kvf = (const float*)(ws + WS_KVF); const float* __restrict__ kvb = (const float*)(ws + WS_KVB);
        float* __restrict__ stf = (float*)(ws + WS_STF); float* __restrict__ stb = (float*)(ws + WS_STB);
        for (int gid = blockIdx.x * NTHR + tid; gid < 131072; gid += gridDim.x * NTHR) {
            const int el = gid & 4095, dir = (gid >> 12) & 1, h = (gid >> 13) & 3, b = gid >> 15;
            const float dec = __expf(log_sigmoid(theta[dir * 4 + h]) * 128.f);
            const float* __restrict__ kv = dir ? kvb : kvf; float* __restrict__ st = dir ? stb : stf;
            float s = 0.f;
            for (int c0 = 0; c0 < 32; c0 += 16) {
                float kk[16];
#pragma unroll
                for (int k = 0; k < 16; ++k) { const int c = dir ? (31 - (c0 + k)) : (c0 + k); kk[k] = kv[(size_t)((b * 32 + c) * 4 + h) * 4096 + el]; }
#pragma unroll
                for (int k = 0; k < 16; ++k) { const int c = dir ? (31 - (c0 + k)) : (c0 + k); st[(size_t)((b * 32 + c) * 4 + h) * 4096 + el] = s; s = fmaf(dec, s, kk[k]); }
            }
        }
    }
}

__device__ __forceinline__ void phase_ln1_router(const Args& a, int l, LAS unsigned char* lds, int tid) {
    unsigned char* ws = a.ws;
    const int lane = tid & 63, wave = tid >> 6;
    LAS float* rwT = (LAS float*)lds;
    const float* rw = a.in[19] + (size_t)l * DM * NE;
    for (int i = tid; i < DM * NE; i += NTHR) rwT[(i & 15) * DM + (i >> 4)] = rw[i];
    __syncthreads();
    const float* pre = (const float*)(ws + WS_RA);
    float* afft = (float*)(ws + WS_AFFT);
    const int gw = blockIdx.x * NWAVES + wave, NGW = gridDim.x * NWAVES;
    const bool b5 = (lane & 32) != 0, b4 = (lane & 16) != 0, b3 = (lane & 8) != 0, b2 = (lane & 4) != 0;
    f32x4 vn[4];
    if (gw < MTOK) {
#pragma unroll
        for (int j = 0; j < 4; ++j) vn[j] = ((const f32x4*)(pre + (size_t)gw * DM))[lane + 64 * j];
    }
    for (int m = gw; m < MTOK; m += NGW) {
        f32x4 v[4];
#pragma unroll
        for (int j = 0; j < 4; ++j) v[j] = vn[j];
        if (m + NGW < MTOK) {
#pragma unroll
            for (int j = 0; j < 4; ++j) vn[j] = ((const f32x4*)(pre + (size_t)(m + NGW) * DM))[lane + 64 * j];
        }
        ln_rows4(v, a.in[17] + l * DM, a.in[18] + l * DM, lane);
        store_row(v, nullptr, (bf16_t*)(ws + WS_HBF) + (size_t)m * DM, lane);
        float sp[16];
#pragma unroll
        for (int eg = 0; eg < 4; ++eg) {
#pragma unroll
            for (int ee = 0; ee < 4; ++ee) { const int e = eg * 4 + ee; float s = 0.f;
#pragma unroll
                for (int j = 0; j < 4; ++j) { const f32x4 wv = *(const LAS f32x4*)(rwT + e * DM + 256 * j + 4 * lane); s += (v[j][0] * wv[0] + v[j][1] * wv[1]) + (v[j][2] * wv[2] + v[j][3] * wv[3]); }
                sp[e] = s; }
            asm volatile("" ::: "memory");
        }
        float t8[8], t4[4], t2[2];
#pragma unroll
        for (int i = 0; i < 8; ++i) { const float snd = b5 ? sp[i] : sp[i + 8], kp = b5 ? sp[i + 8] : sp[i]; t8[i] = kp + __shfl_xor(snd, 32); }
#pragma unroll
        for (int i = 0; i < 4; ++i) { const float snd = b4 ? t8[i] : t8[i + 4], kp = b4 ? t8[i + 4] : t8[i]; t4[i] = kp + __shfl_xor(snd, 16); }
#pragma unroll
        for (int i = 0; i < 2; ++i) { const float snd = b3 ? t4[i] : t4[i + 2], kp = b3 ? t4[i + 2] : t4[i]; t2[i] = kp + __shfl_xor(snd, 8); }
        float lgt; { const float snd = b2 ? t2[0] : t2[1], kp = b2 ? t2[1] : t2[0]; lgt = kp + __shfl_xor(snd, 4); }
        lgt += __shfl_xor(lgt, 1); lgt += __shfl_xor(lgt, 2);
        float mx = lgt;
#pragma unroll
        for (int o = 4; o < 64; o <<= 1) mx = fmaxf(mx, __shfl_xor(mx, o));
        const float ex = expf(lgt - mx);
        float sum = ex;
#pragma unroll
        for (int o = 4; o < 64; o <<= 1) sum += __shfl_xor(sum, o);
        const int b = m / SEQ, t = m % SEQ;
        if ((lane & 3) == 0) afft[(size_t)(b * NE + (lane >> 2)) * SEQ + t] = ex / sum;
    }
    __syncthreads();
}

__device__ __forceinline__ void select_item(int item, const Args& a, LAS unsigned char* lds, int tid) {
    unsigned char* ws = a.ws;
    const int q = item & 3, e = (item >> 2) & 15, b = item >> 6;
    const int lane = tid & 63, wave = tid >> 6;
    LAS unsigned* red = (LAS unsigned*)lds;
    LAS int* sel = (LAS int*)(lds + 1024);
    const float* av = (const float*)(ws + WS_AFFT) + (size_t)(b * NE + e) * SEQ + tid * 8;
    const f32x4 va = *(const f32x4*)av, vb = *(const f32x4*)(av + 4);
    unsigned v[8] = {__float_as_uint(va[0]), __float_as_uint(va[1]), __float_as_uint(va[2]), __float_as_uint(va[3]), __float_as_uint(vb[0]), __float_as_uint(vb[1]), __float_as_uint(vb[2]), __float_as_uint(vb[3])};
    unsigned x = 0u;
    for (int bit = 30; bit >= 0; --bit) {
        const unsigned cand = x | (1u << bit);
        unsigned cnt = 0u;
#pragma unroll
        for (int j = 0; j < 8; ++j) cnt += (unsigned)__popcll(__ballot(v[j] >= cand));
        LAS unsigned* rb = red + (bit & 1) * 8;
        if (lane == 0) rb[wave] = cnt;
        __syncthreads();
        unsigned tot = 0u;
#pragma unroll
        for (int k = 0; k < 8; ++k) tot += rb[k];
        if (tot >= (unsigned)CAP) x = cand;
    }
    unsigned mycnt = 0u;
#pragma unroll
    for (int j = 0; j < 8; ++j) mycnt += (v[j] > x ? 1u : 0u) + (v[j] == x ? 0x10000u : 0u);
    unsigned inc = mycnt;
#pragma unroll
    for (int o = 1; o < 64; o <<= 1) { const unsigned t = __shfl_up(inc, o); if (lane >= o) inc += t; }
    LAS unsigned* wsum = red + 64;
    __syncthreads();
    if (lane == 63) wsum[wave] = inc;
    __syncthreads();
    unsigned wpre = 0u, total = 0u;
#pragma unroll
    for (int k = 0; k < 8; ++k) { const unsigned t = wsum[k]; if (k < wave) wpre += t; total += t; }
    const unsigned excl = wpre + inc - mycnt;
    unsigned gtb = excl & 0xffffu, eqb = excl >> 16;
    const unsigned need = (unsigned)CAP - (total & 0xffffu);
    const int rowbase = (e * NB + b) * CAP;
    int* idx = (int*)(ws + WS_IDX); float* gate = (float*)(ws + WS_GATE); int* slotmap = (int*)(ws + WS_SLOT);
    const bool own_tok = ((tid >> 7) == q);
#pragma unroll
    for (int j = 0; j < 8; ++j) {
        const bool isgt = v[j] > x, iseq = v[j] == x;
        const bool issel = isgt || (iseq && eqb < need);
        const unsigned slot = gtb + (eqb < need ? eqb : need);
        const int tok = b * SEQ + tid * 8 + j;
        if (issel && (int)(slot >> 7) == q) { idx[rowbase + slot] = tok; gate[rowbase + slot] = __uint_as_float(v[j]); }
        if (own_tok) slotmap[(size_t)tok * NE + e] = issel ? (int)(rowbase + slot) : -1;
        gtb += isgt ? 1u : 0u; eqb += iseq ? 1u : 0u;
    }
    __syncthreads();
}

__device__ __forceinline__ void phase_ln2(const Args& a, int l, int tid) {
    unsigned char* ws = a.ws;
    const int lane = tid & 63, wave = tid >> 6;
    const int gw = blockIdx.x * NWAVES + wave, NGW = gridDim.x * NWAVES;
    const bf16_t* hbf = (const bf16_t*)(ws + WS_HBF); const int* slotmap = (const int*)(ws + WS_SLOT); const bf16_t* contrib = (const bf16_t*)(ws + WS_RB);
    const bool last = (l == 1);
    u32x2 vn[4]; int slot_n = -1;
    if (gw < MTOK) {
#pragma unroll
        for (int j = 0; j < 4; ++j) vn[j] = ((const u32x2*)(hbf + (size_t)gw * DM))[lane + 64 * j];
        slot_n = slotmap[(size_t)gw * NE + (lane & 15)];
    }
    for (int m = gw; m < MTOK; m += NGW) {
        f32x4 v[4];
#pragma unroll
        for (int j = 0; j < 4; ++j) { v[j][0] = bflo(vn[j].x) * ALPHA; v[j][1] = bfhi(vn[j].x) * ALPHA; v[j][2] = bflo(vn[j].y) * ALPHA; v[j][3] = bfhi(vn[j].y) * ALPHA; }
        const int myslot = slot_n;
        unsigned bal = (unsigned)(__ballot(myslot >= 0) & 0xffffull);
        int r0 = -1, r1 = -1, r2 = -1, r3 = -1;
        if (bal) { r0 = __shfl(myslot, __builtin_ctz(bal)); bal &= bal - 1; }
        if (bal) { r1 = __shfl(myslot, __builtin_ctz(bal)); bal &= bal - 1; }
        if (bal) { r2 = __shfl(myslot, __builtin_ctz(bal)); bal &= bal - 1; }
        if (bal) { r3 = __shfl(myslot, __builtin_ctz(bal)); bal &= bal - 1; }
        u32x2 c0[4], c1[4], c2[4], c3[4];
#pragma unroll
        for (int j = 0; j < 4; ++j) { c0[j] = (u32x2){0u, 0u}; c1[j] = c0[j]; c2[j] = c0[j]; c3[j] = c0[j]; }
        if (r0 >= 0) {
#pragma unroll
            for (int j = 0; j < 4; ++j) c0[j] = ((const u32x2*)(contrib + (size_t)r0 * DM))[lane + 64 * j]; }
        if (r1 >= 0) {
#pragma unroll
            for (int j = 0; j < 4; ++j) c1[j] = ((const u32x2*)(contrib + (size_t)r1 * DM))[lane + 64 * j]; }
        if (r2 >= 0) {
#pragma unroll
            for (int j = 0; j < 4; ++j) c2[j] = ((const u32x2*)(contrib + (size_t)r2 * DM))[lane + 64 * j]; }
        if (r3 >= 0) {
#pragma unroll
            for (int j = 0; j < 4; ++j) c3[j] = ((const u32x2*)(contrib + (size_t)r3 * DM))[lane + 64 * j]; }
        if (m + NGW < MTOK) {
#pragma unroll
            for (int j = 0; j < 4; ++j) vn[j] = ((const u32x2*)(hbf + (size_t)(m + NGW) * DM))[lane + 64 * j];
            slot_n = slotmap[(size_t)(m + NGW) * NE + (lane & 15)];
        }
#pragma unroll
        for (int j = 0; j < 4; ++j) {
            v[j][0] += bflo(c0[j].x); v[j][1] += bfhi(c0[j].x); v[j][2] += bflo(c0[j].y); v[j][3] += bfhi(c0[j].y);
            v[j][0] += bflo(c1[j].x); v[j][1] += bfhi(c1[j].x); v[j][2] += bflo(c1[j].y); v[j][3] += bfhi(c1[j].y);
            v[j][0] += bflo(c2[j].x); v[j][1] += bfhi(c2[j].x); v[j][2] += bflo(c2[j].y); v[j][3] += bfhi(c2[j].y);
            v[j][0] += bflo(c3[j].x); v[j][1] += bfhi(c3[j].x); v[j][2] += bflo(c3[j].y); v[j][3] += bfhi(c3[j].y);
        }
        while (bal) {
            const int row = __shfl(myslot, __builtin_ctz(bal)); bal &= bal - 1;
            const u32x2* cr = (const u32x2*)(contrib + (size_t)row * DM);
#pragma unroll
            for (int j = 0; j < 4; ++j) { const u32x2 wv = cr[lane + 64 * j]; v[j][0] += bflo(wv.x); v[j][1] += bfhi(wv.x); v[j][2] += bflo(wv.y); v[j][3] += bfhi(wv.y); }
        }
        ln_rows4(v, a.in[23] + l * DM, a.in[24] + l * DM, lane);
        if (last) store_row(v, a.out + (size_t)m * DM, nullptr, lane);
        else store_row(v, nullptr, (bf16_t*)(ws + WS_HBF) + (size_t)m * DM, lane);
    }
}

typedef __attribute__((address_space(1))) unsigned gu32;
#define RLX_AGENT __ATOMIC_RELAXED, __HIP_MEMORY_SCOPE_AGENT
#define XB_TMO      128
#define XB_XCNT(j)  (256  + 64 * (j))
#define XB_XSUB(j)  (1280 + 64 * (j))
#define XB_XGEN(j)  (2304 + 64 * (j))
#define XB_TOP      3328
#define XB_TOPGEN   3392
#define XCD_BAR_WORDS 3456
#define XB_SPIN_CAP (1u << 18)

__device__ __forceinline__ unsigned xb_ld(unsigned* p)              { return __hip_atomic_load(p, __ATOMIC_RELAXED, __HIP_MEMORY_SCOPE_AGENT); }
__device__ __forceinline__ unsigned xb_add(unsigned* p, unsigned v) { return __hip_atomic_fetch_add(p, v, __ATOMIC_RELAXED, __HIP_MEMORY_SCOPE_AGENT); }
__device__ __forceinline__ unsigned xb_xcc_id() { return (unsigned)__builtin_amdgcn_s_getreg((3 << 11) | 20) & 0xFu; }
#define XB_SPIN(cond, bar) do { unsigned _sp = 0; while (cond) { __builtin_amdgcn_s_sleep(1); \
    if ((++_sp & 255u) == 0u) { if (xb_ld(&(bar)[XB_TMO])) break; if (_sp > XB_SPIN_CAP) { atomicAdd(&(bar)[XB_TMO], 1u); break; } } } } while (0)

struct XcdBarrier {
    unsigned* bar; unsigned x;
    volatile LAS unsigned* st;
};

__device__ __forceinline__ XcdBarrier xcd_barrier_post(unsigned* bar, volatile LAS unsigned* st) {
    XcdBarrier b; b.bar = bar; b.x = xb_xcc_id(); b.st = st;
    if (threadIdx.x == 0) (void)xb_add(&bar[XB_XCNT(b.x)], 1u);
    return b;
}
__device__ __forceinline__ void xcd_barrier_complete(unsigned* bar, unsigned x, unsigned& nloc, unsigned& nx) {
    const unsigned G = gridDim.x * gridDim.y * gridDim.z;
    unsigned sum, cnt, mine, sp = 0u;
    for (;;) {
        sum = 0u; cnt = 0u; mine = 0u;
#pragma unroll
        for (unsigned j = 0; j < 16; ++j) { const unsigned c = xb_ld(&bar[XB_XCNT(j)]); sum += c; cnt += (c > 0u) ? 1u : 0u; mine = (j == x) ? c : mine; }
        if (sum == G) break;
        __builtin_amdgcn_s_sleep(1);
        if ((++sp & 255u) == 0u) { if (xb_ld(&bar[XB_TMO])) break; if (sp > XB_SPIN_CAP) { atomicAdd(&bar[XB_TMO], 1u); break; } }
    }
    nloc = mine > 0u ? mine : 1u; nx = cnt > 0u ? cnt : 1u;
}

__device__ __forceinline__ void xcd_barrier(const XcdBarrier& b) {
    asm volatile("s_waitcnt vmcnt(0)" ::: "memory");
    __syncthreads();
    if (threadIdx.x == 0) {
        unsigned* bar = b.bar;
        __builtin_amdgcn_s_waitcnt(0);
        unsigned nloc = b.st[0], nx = b.st[1];
        if (nloc == 0u) { xcd_barrier_complete(bar, b.x, nloc, nx); b.st[0] = nloc; b.st[1] = nx; }
        const unsigned old = xb_add(&bar[XB_XSUB(b.x)], 1u);
        const unsigned gen = old / nloc;
        if (old + 1u == (gen + 1u) * nloc) {
            __builtin_amdgcn_fence(__ATOMIC_RELEASE, "agent");
            asm volatile("s_waitcnt vmcnt(0)" ::: "memory");
            const unsigned og = xb_add(&bar[XB_TOP], 1u);
            const unsigned tg = og / nx;
            if (og + 1u == (tg + 1u) * nx) xb_add(&bar[XB_TOPGEN], 1u);
            else XB_SPIN(xb_ld(&bar[XB_TOPGEN]) == tg, bar);
            __builtin_amdgcn_fence(__ATOMIC_ACQUIRE, "agent");
            xb_add(&bar[XB_XGEN(b.x)], 1u);
            asm volatile("s_waitcnt vmcnt(0)" ::: "memory");
        } else {
            XB_SPIN(xb_ld(&bar[XB_XGEN(b.x)]) == gen, bar);
            __builtin_amdgcn_fence(__ATOMIC_ACQUIRE, "agent");
            asm volatile("s_waitcnt vmcnt(0)" ::: "memory");
        }
    }
    __syncthreads();
}

constexpr int NPHASES = 21;
#ifndef REP_MASK
#define REP_MASK 0
#endif
template <int L, int K>
__device__ __forceinline__ void run_phase(const Args& a, LAS unsigned char* lds, int tid) {
    unsigned char* ws = a.ws;
    constexpr int l = L;
    bf16_t* proj = (bf16_t*)(ws + WS_RA); bf16_t* mix = (bf16_t*)(ws + WS_RB);
    if constexpr (K == 0) {
        pg8::Gemm g{(const bf16_t*)(ws + WS_HBF), (const bf16_t*)(ws + WS_WIN) + (size_t)l * DIN * DM, MTOK, DIN, DM};
        pg8::StaticOrder S; S.init(MTOK, DIN, (int)gridDim.x, (int)blockIdx.x);
        pg8::EpiStoreBf16 E{proj, DIN};
        pg8::gemm_phase<pg8::EpiStoreBf16, pg8::StaticOrder, true, true>(lds, g, S, E);
    } else if constexpr (K == 1) {
        const float* tab = (const float*)(ws + WS_S5TAB) + (size_t)l * 2048 * 8;
        constexpr int XB = ((REP_MASK >> 11) & 1) ? 512 : ((REP_MASK >> 12) & 1) ? 256 : ((REP_MASK >> 13) & 1) ? 512 : 0, XOFF = ((REP_MASK >> 11) & 1) ? 0 : ((REP_MASK >> 12) & 1) ? 512 : 768;
        for (int it0 = blockIdx.x; it0 < 1280 + XB; it0 += gridDim.x) {
            const int it = it0 < 1280 ? it0 : it0 - 1280 + XOFF;
            if (it < 512) s5e_item(it, proj, tab, (const bf16_t*)(ws + WS_S5BT) + (size_t)l * 4096 * 32, (float*)(ws + WS_S5E), lds, tid);
            else if (it < 768) attn_item(it - 512, proj, mix, a.in[15] + l * 8, lds, tid);
            else retkv_item(it - 768, proj, (float*)(ws + WS_KVF), (float*)(ws + WS_KVB), a.in[4] + l * 8, lds, tid);
        }
    } else if constexpr (K == 2) {
        phase_scan(a, l, tid);
    } else if constexpr (K == 3) {
        const float* tab = (const float*)(ws + WS_S5TAB) + (size_t)l * 2048 * 8;
        constexpr int XD = ((REP_MASK >> 14) & 3) ? 512 : 0, XOFD = ((REP_MASK >> 14) & 1) ? 0 : 512;
        for (int it0 = blockIdx.x; it0 < 1024 + XD; it0 += gridDim.x) {
            const int it = it0 < 1024 ? it0 : it0 - 1024 + XOFD;
            if (it < 512) s5out_item(it, proj, tab, (const bf16_t*)(ws + WS_S5BT) + (size_t)l * 4096 * 32, (const bf16_t*)(ws + WS_S5CT) + (size_t)l * 65536, a.in[12] + l * 256,
                                     (const bf16_t*)(ws + WS_WGLU) + (size_t)l * 65536, a.in[14] + l * 256, (const float*)(ws + WS_S5C), mix, lds, tid);
            else retout_item(it - 512, proj, (const float*)(ws + WS_STF), (const float*)(ws + WS_STB), mix, a.in[4] + l * 8, lds, tid);
        }
    } else if constexpr (K == 4) {
        pg8::Gemm g{mix, (const bf16_t*)(ws + WS_WOUT) + (size_t)l * DM * DM, MTOK, DM, DM};
        pg8::StaticOrder S; S.init(MTOK, DM, (int)gridDim.x, (int)blockIdx.x);
        pg8::EpiResF32 E{(const bf16_t*)(ws + WS_HBF), (float*)(ws + WS_RA), DM, ALPHA};
        pg8::gemm_phase<pg8::EpiResF32, pg8::StaticOrder, true, true>(lds, g, S, E);
    } else if constexpr (K == 5) {
        phase_ln1_router(a, l, lds, tid);
    } else if constexpr (K == 6) {
        for (int it = blockIdx.x; it < 256; it += gridDim.x) select_item(it, a, lds, tid);
    } else if constexpr (K == 7) {
        pg8::Gemm g{(const bf16_t*)(ws + WS_HBF), (const bf16_t*)(ws + WS_WGU) + (size_t)l * NE * 2 * FF * DM, NROWX, NE * 2 * FF, DM};
        pg8::GroupedOrder S; S.init(16, (int)gridDim.x, (int)blockIdx.x);
        pg8::EpiSwiGLU E{(bf16_t*)(ws + WS_HDN), FF, 16};
        pg8::gemm_phase<pg8::EpiSwiGLU, pg8::GroupedOrder, true, true, true>(lds, g, S, E, (const int*)(ws + WS_IDX));
    } else if constexpr (K == 8) {
        pg8::Gemm g{(const bf16_t*)(ws + WS_HDN), (const bf16_t*)(ws + WS_WD) + (size_t)l * NE * DM * FF, NROWX, NE * DM, FF};
        pg8::GroupedOrder S; S.init(4, (int)gridDim.x, (int)blockIdx.x);
        pg8::EpiScaleRow E{(bf16_t*)(ws + WS_RB), DM, 4, (const float*)(ws + WS_GATE)};
        pg8::gemm_phase<pg8::EpiScaleRow, pg8::GroupedOrder, true, true>(lds, g, S, E);
    } else {
        phase_ln2(a, l, tid);
    }
}
__global__ void __launch_bounds__(NTHR, 2) fwd_kernel(Args a) {
    extern __shared__ __attribute__((aligned(16))) unsigned char lds_raw[];
    LAS unsigned char* lds = (LAS unsigned char*)lds_raw;
    cg::grid_group grid = cg::this_grid();
    const int lo = a.ph_lo, hi = a.ph_hi;
    volatile LAS unsigned* bst = (volatile LAS unsigned*)(lds + LDS_BYTES - 64);
    if (threadIdx.x < 16) bst[threadIdx.x] = 0u;
    __syncthreads();
    XcdBarrier bar = xcd_barrier_post((unsigned*)(a.ws + WS_BAR), bst);
    if (hi > 1000) grid.sync();
#define PH_BEGIN(ph) if (lo <= (ph) && (ph) < hi) { int tid = threadIdx.x; asm volatile("" : "+v"(tid));
#define PH_END(ph) if ((ph) + 1 < hi) xcd_barrier(bar); }
    PH_BEGIN(0) for (int rep = 0; rep <= ((REP_MASK >> 10) & 1); ++rep) phase_p0(a, lds, tid); PH_END(0)
#define LAYER(L) \
    PH_BEGIN(1 + 10 * L + 0) for (int rep = 0; rep <= ((REP_MASK >> 0) & 1); ++rep) run_phase<L, 0>(a, lds, tid); PH_END(1 + 10 * L + 0) \
    PH_BEGIN(1 + 10 * L + 1) for (int rep = 0; rep <= ((REP_MASK >> 1) & 1); ++rep) run_phase<L, 1>(a, lds, tid); PH_END(1 + 10 * L + 1) \
    PH_BEGIN(1 + 10 * L + 2) for (int rep = 0; rep <= ((REP_MASK >> 2) & 1); ++rep) run_phase<L, 2>(a, lds, tid); PH_END(1 + 10 * L + 2) \
    PH_BEGIN(1 + 10 * L + 3) for (int rep = 0; rep <= ((REP_MASK >> 3) & 1); ++rep) run_phase<L, 3>(a, lds, tid); PH_END(1 + 10 * L + 3) \
    PH_BEGIN(1 + 10 * L + 4) for (int rep = 0; rep <= ((REP_MASK >> 4) & 1); ++rep) run_phase<L, 4>(a, lds, tid); PH_END(1 + 10 * L + 4) \
    PH_BEGIN(1 + 10 * L + 5) for (int rep = 0; rep <= ((REP_MASK >> 5) & 1); ++rep) run_phase<L, 5>(a, lds, tid); PH_END(1 + 10 * L + 5) \
    PH_BEGIN(1 + 10 * L + 6) for (int rep = 0; rep <= ((REP_MASK >> 6) & 1); ++rep) run_phase<L, 6>(a, lds, tid); PH_END(1 + 10 * L + 6) \
    PH_BEGIN(1 + 10 * L + 7) for (int rep = 0; rep <= ((REP_MASK >> 7) & 1); ++rep) run_phase<L, 7>(a, lds, tid); PH_END(1 + 10 * L + 7) \
    PH_BEGIN(1 + 10 * L + 8) for (int rep = 0; rep <= ((REP_MASK >> 8) & 1); ++rep) run_phase<L, 8>(a, lds, tid); PH_END(1 + 10 * L + 8) \
    PH_BEGIN(1 + 10 * L + 9) for (int rep = 0; rep <= (((REP_MASK >> 9) & 1) && L == 1 ? 1 : 0); ++rep) run_phase<L, 9>(a, lds, tid); PH_END(1 + 10 * L + 9)
    LAYER(0)
    LAYER(1)
#undef LAYER
#undef PH_BEGIN
#undef PH_END
}

#ifndef ONE_LAUNCH
#define ONE_LAUNCH 1
#endif
extern "C" void kernel_launch(void* const* d_in, const int* in_sizes, int n_in, void* d_out, int out_size, void* d_ws, size_t ws_size, hipStream_t stream) {
    static int grid = 0;
    if (grid == 0) {
        if (n_in != 25 || ws_size < WS_END) { fprintf(stderr, "kernel_launch: unexpected problem (n_in %d, ws %zu)\n", n_in, ws_size); grid = -1; return; }
        int dev = 0, cus = 0, per_cu = 0;
        (void)hipGetDevice(&dev);
        (void)hipDeviceGetAttribute(&cus, hipDeviceAttributeMultiprocessorCount, dev);
        if (hipFuncSetAttribute((const void*)fwd_kernel, hipFuncAttributeMaxDynamicSharedMemorySize, LDS_BYTES) != hipSuccess) { fprintf(stderr, "kernel_launch: hipFuncSetAttribute failed\n"); grid = -1; return; }
        if (hipOccupancyMaxActiveBlocksPerMultiprocessor(&per_cu, (const void*)fwd_kernel, NTHR, LDS_BYTES) != hipSuccess || per_cu < 1) { fprintf(stderr, "kernel_launch: occupancy query says %d\n", per_cu); per_cu = 1; }
        (void)hipGetLastError();
        if (cus <= 0) cus = 256;
        grid = cus * per_cu;
    }
    if (grid < 0) return;
    Args a{};
    for (int i = 0; i < 25; ++i) a.in[i] = (const float*)d_in[i];
    a.out = (float*)d_out; a.ws = (unsigned char*)d_ws;
#if ONE_LAUNCH
    if (hipMemsetAsync((char*)d_ws + WS_BAR, 0, 16384, stream) != hipSuccess) { fprintf(stderr, "kernel_launch: memset failed\n"); return; }
    a.ph_lo = 0; a.ph_hi = NPHASES;
    void* args[] = {&a};
    hipError_t e = hipLaunchCooperativeKernel((const void*)fwd_kernel, dim3(grid), dim3(NTHR), args, LDS_BYTES, stream);
    if (e != hipSuccess) fprintf(stderr, "kernel_launch: cooperative launch failed: %s (grid %d)\n", hipGetErrorString(e), grid);
#else
    for (int ph = 0; ph < NPHASES; ++ph) {
        a.ph_lo = ph; a.ph_hi = ph + 1;
        hipLaunchKernelGGL(fwd_kernel, dim3(grid), dim3(NTHR), LDS_BYTES, stream, a);
    }
#endif
}
```

```cpp
#include <hip/hip_runtime.h>
#include <hip/hip_cooperative_groups.h>
#include <cstdio>
#include <cstdint>
namespace cg = cooperative_groups;
namespace pg8 {
#define PG8_LAS __attribute__((address_space(3)))
typedef unsigned short bf16_t;
typedef short bf16x8 __attribute__((ext_vector_type(8)));
typedef float f32x4 __attribute__((ext_vector_type(4)));
typedef unsigned u32x4 __attribute__((ext_vector_type(4)));
constexpr int BM = 256, BK = 64, HALF = 128, HTB = HALF * BK * 2  , STAGE_BYTES = 8 * HTB, NXCD = 8, WGM = 8;

__host__ __device__ __forceinline__ int lds_byte(int r, int c) { const int st = (r >> 4) * 2 + (c >> 5), rr = r & 15, cc = c & 31, ob = rr * 64 + cc * 2; return st * 1024 + (ob ^ (((ob >> 9) & 1) << 5)); }
__host__ __device__ __forceinline__ void stage_rc(int b, int& R, int& C) { const int st = b / 1024, sb = b % 1024, swz = sb ^ (((sb >> 9) & 1) << 5); R = (st >> 1) * 16 + swz / 64; C = (st & 1) * 32 + (swz % 64) / 2; }
__host__ __device__ __forceinline__ int perm32(int rho) { const int n = rho >> 4, i = rho & 15; return 8 * (i >> 2) + 4 * n + (i & 3); }

struct Unit { int pm, pn; };
struct Gemm { const bf16_t* A; const bf16_t* Bt; int M, N, K; };

struct StaticOrder {
    int nM, nN, nwg, G, c;
    __host__ __device__ void init(int M, int N, int G_, int c_) { nM = M / BM; nN = N / BM; nwg = nM * nN; G = G_; c = c_; }
    __host__ __device__ bool next(int i, Unit& u) const {
        const long L = (long)i * G + c; if (L >= nwg) return false;
        int wgid = (int)L; { const int q = nwg / NXCD, r = nwg % NXCD, xcd = wgid % NXCD, off = wgid / NXCD; wgid = (xcd < r ? xcd * (q + 1) : r * (q + 1) + (xcd - r) * q) + off; }
        const int nig = WGM * nN, gid = wgid / nig, fm = gid * WGM, gsz = (nM - fm) < WGM ? (nM - fm) : WGM;
        u.pm = fm + ((wgid % nig) % gsz); u.pn = (wgid % nig) / gsz; return true;
    }
    __device__ __forceinline__ void a_ready(const Unit&) const {}
    __device__ __forceinline__ void done(const Unit&) const {}
};

__device__ __forceinline__ unsigned cvt_pk_bf16(float lo, float hi) { unsigned r; asm volatile("v_cvt_pk_bf16_f32 %0, %1, %2" : "=v"(r) : "v"(lo), "v"(hi)); return r; }
typedef unsigned u32x2 __attribute__((ext_vector_type(2)));

struct GroupedOrder {
    int upe, nNe, nwg, G, c;
    __host__ __device__ void init(int nNe_, int G_, int c_) { nNe = nNe_; upe = 8 * nNe_; nwg = 16 * upe; G = G_; c = c_; }
    __host__ __device__ bool next(int i, Unit& u) const {
        const long L = (long)i * G + c; if (L >= nwg) return false;
        int wgid = (int)L; { const int q = nwg / NXCD, r = nwg % NXCD, xcd = wgid % NXCD, off = wgid / NXCD; wgid = (xcd < r ? xcd * (q + 1) : r * (q + 1) + (xcd - r) * q) + off; }
        const int e = wgid / upe, rr = wgid % upe;
        u.pm = e * 8 + (rr & 7); u.pn = e * nNe + (rr >> 3); return true;
    }
    __device__ __forceinline__ void a_ready(const Unit&) const {}
    __device__ __forceinline__ void done(const Unit&) const {}
};

struct EpiStoreBf16 {
    static constexpr bool PERM = true, AFTER_DRAIN = false;
    bf16_t* O; int ldc;
    __device__ __forceinline__ void operator()(const f32x4 (&acc)[2][2][4][2], const Unit& u, int wr, int wc, int fr, int fq) const {
        const int row0 = u.pm * BM + wr * 64 + fr, col0 = u.pn * BM + wc * 32 + 8 * fq;
#pragma unroll
        for (int ai = 0; ai < 2; ++ai)
#pragma unroll
            for (int m = 0; m < 4; ++m) { bf16_t* rowp = O + (size_t)(row0 + ai * HALF + m * 16) * ldc + col0;
#pragma unroll
                for (int bj = 0; bj < 2; ++bj) { const f32x4 v0 = acc[ai][bj][m][0], v1 = acc[ai][bj][m][1];
                    u32x4 w; w.x = cvt_pk_bf16(v0[0], v0[1]); w.y = cvt_pk_bf16(v0[2], v0[3]); w.z = cvt_pk_bf16(v1[0], v1[1]); w.w = cvt_pk_bf16(v1[2], v1[3]);
                    *(u32x4*)(rowp + bj * HALF) = w; } }
    }
};
struct EpiResF32 {
    static constexpr bool PERM = false, AFTER_DRAIN = false;
    const bf16_t* base; float* O; int ldc; float alpha;
    __device__ __forceinline__ void operator()(const f32x4 (&acc)[2][2][4][2], const Unit& u, int wr, int wc, int fr, int fq) const {
        const int row0 = u.pm * BM + wr * 64 + fr, col0 = u.pn * BM + wc * 32 + 4 * fq;
#pragma unroll
        for (int ai = 0; ai < 2; ++ai)
#pragma unroll
            for (int m = 0; m < 4; ++m) { const size_t ro = (size_t)(row0 + ai * HALF + m * 16) * ldc + col0;
#pragma unroll
                for (int bj = 0; bj < 2; ++bj)
#pragma unroll
                    for (int n = 0; n < 2; ++n) { const u32x2 bw = *(const u32x2*)(base + ro + bj * HALF + 16 * n);
                        f32x4 b; b[0] = __uint_as_float(bw.x << 16); b[1] = __uint_as_float(bw.x & 0xffff0000u); b[2] = __uint_as_float(bw.y << 16); b[3] = __uint_as_float(bw.y & 0xffff0000u);
                        *(f32x4*)(O + ro + bj * HALF + 16 * n) = b * alpha + acc[ai][bj][m][n]; } }
    }
};
struct EpiSwiGLU {
    static constexpr bool PERM = true, AFTER_DRAIN = false;
    bf16_t* O; int ldc; int ntn;
    __device__ __forceinline__ void operator()(const f32x4 (&acc)[2][2][4][2], const Unit& u, int wr, int wc, int fr, int fq) const {
        const int row0 = u.pm * BM + wr * 64 + fr, col0 = ((u.pn % ntn) * BM + wc * 32 + 8 * fq) >> 1;
#pragma unroll
        for (int ai = 0; ai < 2; ++ai)
#pragma unroll
            for (int m = 0; m < 4; ++m) { bf16_t* rowp = O + (size_t)(row0 + ai * HALF + m * 16) * ldc + col0;
#pragma unroll
                for (int bj = 0; bj < 2; ++bj) { const f32x4 v0 = acc[ai][bj][m][0], v1 = acc[ai][bj][m][1];
                    const float h0 = v0[0] * v0[1] * __builtin_amdgcn_rcpf(1.f + __expf(-v0[0])), h1 = v0[2] * v0[3] * __builtin_amdgcn_rcpf(1.f + __expf(-v0[2]));
                    const float h2 = v1[0] * v1[1] * __builtin_amdgcn_rcpf(1.f + __expf(-v1[0])), h3 = v1[2] * v1[3] * __builtin_amdgcn_rcpf(1.f + __expf(-v1[2]));
                    u32x2 w; w.x = cvt_pk_bf16(h0, h1); w.y = cvt_pk_bf16(h2, h3);
                    *(u32x2*)(rowp + bj * (HALF / 2)) = w; } }
    }
};
struct EpiScaleRow {
    static constexpr bool PERM = true, AFTER_DRAIN = false;
    bf16_t* O; int ldc; int ntn; const float* gate;
    __device__ __forceinline__ void operator()(const f32x4 (&acc)[2][2][4][2], const Unit& u, int wr, int wc, int fr, int fq) const {
        const int row0 = u.pm * BM + wr * 64 + fr, col0 = (u.pn % ntn) * BM + wc * 32 + 8 * fq;
#pragma unroll
        for (int ai = 0; ai < 2; ++ai)
#pragma unroll
            for (int m = 0; m < 4; ++m) { const int row = row0 + ai * HALF + m * 16; const float gsc = gate[row]; bf16_t* rowp = O + (size_t)row * ldc + col0;
#pragma unroll
                for (int bj = 0; bj < 2; ++bj) { const f32x4 v0 = acc[ai][bj][m][0] * gsc, v1 = acc[ai][bj][m][1] * gsc;
                    u32x4 w; w.x = cvt_pk_bf16(v0[0], v0[1]); w.y = cvt_pk_bf16(v0[2], v0[3]); w.z = cvt_pk_bf16(v1[0], v1[1]); w.w = cvt_pk_bf16(v1[2], v1[3]);
                    *(u32x4*)(rowp + bj * HALF) = w; } }
    }
};
template <class Epi, class Sched, bool ALIGN_EPI = false, bool SP2 = false, bool GATHER = false>
__device__ __forceinline__ void gemm_phase(PG8_LAS unsigned char* lds, const Gemm g, const Sched& S, const Epi& E, const int* __restrict__ rowidx = nullptr) {
    static_assert(!GATHER || SP2, "GATHER is implemented for the SP2 loop");
    int tid_ = threadIdx.x; asm volatile("" : "+v"(tid_)); const int tid = tid_, wid = __builtin_amdgcn_readfirstlane(tid >> 6), lane = tid & 63, wr = wid >> 2, wc = wid & 3, fr = lane & 15, fq = lane >> 4;
    const int K = g.K, nt = K / BK;
    unsigned voffA[2], voffB[2];
#pragma unroll
    for (int i = 0; i < 2; ++i) { int R, C; stage_rc(tid * 16 + i * 8192, R, C); const int Rb = Epi::PERM ? ((R & ~31) + perm32(R & 31)) : R;
        voffA[i] = (unsigned)(R * K + C) * 2u; voffB[i] = (unsigned)(Rb * K + C) * 2u; }
    int gR[2], gCc[2];
#pragma unroll
    for (int i = 0; i < 2; ++i) { int R, C; stage_rc(tid * 16 + i * 8192, R, C); gR[i] = R; gCc[i] = C * 2; }
    unsigned gC[2][2], gN[2][2];
#define PG8_GOFF(dst, pmv) do { _Pragma("unroll") for (int _h = 0; _h < 2; ++_h) _Pragma("unroll") for (int _i = 0; _i < 2; ++_i) \
        dst[_h][_i] = (unsigned)rowidx[(pmv) * BM + _h * HALF + gR[_i]] * (unsigned)(K * 2) + (unsigned)gCc[_i]; } while (0)
    const size_t kstep = (size_t)(BK * 2);
    const size_t hstep = (size_t)HALF * K * 2;
    const size_t tstep = 2 * hstep;
    const unsigned ldsw = (unsigned)wid * 1024u;
    const int aoff = lds_byte(wr * 64 + fr, fq * 8), boff = lds_byte(wc * 32 + fr, fq * 8);
#define PG8_SA(b, h) (((b) * 2 + (h)) * HTB)
#define PG8_SB(b, h) ((4 + (b) * 2 + (h)) * HTB)
#define PG8_STAGE(bufoff, gbase, voff) do { _Pragma("unroll") for (int _i = 0; _i < 2; ++_i) \
        __builtin_amdgcn_global_load_lds((const unsigned*)((const char*)(gbase) + (voff)[_i]), (PG8_LAS unsigned*)(lds + (bufoff) + ldsw + _i * 8192), 16, 0, 0); } while (0)
#define PG8_STAGE_A(bufoff, gbase, h, nx) do { if constexpr (GATHER) { unsigned _o[2]; _o[0] = (nx) ? gN[h][0] : gC[h][0]; _o[1] = (nx) ? gN[h][1] : gC[h][1]; PG8_STAGE(bufoff, gbase, _o); } \
        else { PG8_STAGE(bufoff, (gbase) + (h) * hstep, voffA); } } while (0)
#define PG8_LDA(dst, b, h) do { _Pragma("unroll") for (int m = 0; m < 4; ++m) _Pragma("unroll") for (int k = 0; k < 2; ++k) dst[m][k] = *(const PG8_LAS bf16x8*)(lds + PG8_SA(b, h) + aoff + m * 2048 + k * 1024); } while (0)
#define PG8_LDB(dst, b, h) do { _Pragma("unroll") for (int n = 0; n < 2; ++n) _Pragma("unroll") for (int k = 0; k < 2; ++k) dst[n][k] = *(const PG8_LAS bf16x8*)(lds + PG8_SB(b, h) + boff + n * 2048 + k * 1024); } while (0)
#define PG8_MMA(ai, bj, At, Bt) do { __builtin_amdgcn_s_setprio(1); _Pragma("unroll") for (int m = 0; m < 4; ++m) _Pragma("unroll") for (int n = 0; n < 2; ++n) _Pragma("unroll") for (int k = 0; k < 2; ++k) \
        acc[ai][bj][m][n] = __builtin_amdgcn_mfma_f32_16x16x32_bf16(Bt[n][k], At[m][k], acc[ai][bj][m][n], 0, 0, 0); __builtin_amdgcn_s_setprio(0); } while (0)
#define PG8_WAIT_V(n) asm volatile("s_waitcnt vmcnt(" #n ")" ::: "memory")
#define PG8_WAIT_L(n) asm volatile("s_waitcnt lgkmcnt(" #n ")" ::: "memory")
#define PG8_BAR __builtin_amdgcn_s_barrier()
#define PG8_SCHED __builtin_amdgcn_sched_barrier(0)
    Unit cur, nxt; int ui = 0;
    if (!S.next(0, cur)) return;
    f32x4 acc[2][2][4][2];
#pragma unroll
    for (int a = 0; a < 2; ++a)
#pragma unroll
        for (int b = 0; b < 2; ++b)
#pragma unroll
            for (int m = 0; m < 4; ++m)
#pragma unroll
                for (int n = 0; n < 2; ++n) acc[a][b][m][n] = (f32x4){0.f, 0.f, 0.f, 0.f};
    bf16x8 At[4][2], B0[2][2], B1[2][2];
    const char* cA = GATHER ? (const char*)g.A : (const char*)g.A + (size_t)cur.pm * tstep; const char* cB = (const char*)g.Bt + (size_t)cur.pn * tstep;
    if constexpr (GATHER) { PG8_GOFF(gC, cur.pm); PG8_GOFF(gN, cur.pm); }
    S.a_ready(cur);
    if constexpr (SP2) {
        PG8_STAGE(PG8_SB(0, 0), cB, voffB); PG8_STAGE(PG8_SB(0, 1), cB + hstep, voffB); PG8_STAGE_A(PG8_SA(0, 0), cA, 0, false); PG8_STAGE_A(PG8_SA(0, 1), cA, 1, false);
        if (wr == 1) PG8_BAR;
        PG8_WAIT_V(2); PG8_BAR;
        PG8_STAGE(PG8_SB(1, 0), cB + kstep, voffB); PG8_STAGE_A(PG8_SA(1, 0), cA + kstep, 0, false); PG8_STAGE(PG8_SB(1, 1), cB + hstep + kstep, voffB);
        PG8_WAIT_V(6); PG8_BAR;
    } else {
        PG8_STAGE(PG8_SB(0, 0), cB, voffB); PG8_STAGE(PG8_SA(0, 0), cA, voffA); PG8_STAGE(PG8_SB(0, 1), cB + hstep, voffB); PG8_STAGE(PG8_SA(0, 1), cA + hstep, voffA);
        if (wr == 1) PG8_BAR;
        PG8_WAIT_V(4); PG8_BAR;
        PG8_STAGE(PG8_SB(1, 0), cB + kstep, voffB); PG8_STAGE(PG8_SA(1, 0), cA + kstep, voffA); PG8_STAGE(PG8_SB(1, 1), cB + hstep + kstep, voffB);
        PG8_WAIT_V(6); PG8_BAR;
    }
    for (;;) {
        const bool has_next = S.next(ui + 1, nxt);
        const char* nA = GATHER ? cA : (has_next ? (const char*)g.A + (size_t)nxt.pm * tstep : cA); const char* nB = has_next ? (const char*)g.Bt + (size_t)nxt.pn * tstep : cB;
        if constexpr (GATHER) { if (has_next) PG8_GOFF(gN, nxt.pm); }
        for (int t = 0; t < nt; t += 2) {
            const bool last = (t == nt - 2);
            const char* a1 = cA + (size_t)(t + 1) * kstep;
            const char* a2 = last ? nA : cA + (size_t)(t + 2) * kstep; const char* b2 = last ? nB : cB + (size_t)(t + 2) * kstep;
            const char* a3 = a2 + kstep; const char* b3 = b2 + kstep;
            if (last && has_next) S.a_ready(nxt);
            if constexpr (SP2) {
            PG8_LDB(B0, 0, 0); PG8_LDB(B1, 0, 1); PG8_SCHED; PG8_LDA(At, 0, 0); PG8_STAGE_A(PG8_SA(1, 1), a1, 1, false);
            PG8_WAIT_V(8); PG8_WAIT_L(0); PG8_BAR; PG8_MMA(0, 0, At, B0); PG8_MMA(0, 1, At, B1); PG8_BAR; PG8_SCHED;
            PG8_LDA(At, 0, 1); PG8_STAGE(PG8_SB(0, 0), b2, voffB); PG8_STAGE(PG8_SB(0, 1), b2 + hstep, voffB); PG8_STAGE_A(PG8_SA(0, 0), a2, 0, last);
            PG8_WAIT_V(8); PG8_WAIT_L(0); PG8_BAR; PG8_MMA(1, 0, At, B0); PG8_MMA(1, 1, At, B1); PG8_BAR; PG8_SCHED;
            PG8_LDB(B0, 1, 0); PG8_LDB(B1, 1, 1); PG8_SCHED; PG8_LDA(At, 1, 0); PG8_STAGE_A(PG8_SA(0, 1), a2, 1, last);
            PG8_WAIT_V(8); PG8_WAIT_L(0); PG8_BAR; PG8_MMA(0, 0, At, B0); PG8_MMA(0, 1, At, B1); PG8_BAR; PG8_SCHED;
            PG8_LDA(At, 1, 1); PG8_STAGE(PG8_SB(1, 0), b3, voffB); PG8_STAGE(PG8_SB(1, 1), b3 + hstep, voffB); PG8_STAGE_A(PG8_SA(1, 0), a3, 0, last);
            PG8_WAIT_V(8); PG8_WAIT_L(0); PG8_BAR; PG8_MMA(1, 0, At, B0); PG8_MMA(1, 1, At, B1); PG8_BAR; PG8_SCHED;
            } else {
            PG8_LDB(B0, 0, 0); PG8_SCHED; PG8_LDA(At, 0, 0); PG8_STAGE(PG8_SA(1, 1), a1 + hstep, voffA);
            PG8_WAIT_L(8); PG8_BAR; PG8_WAIT_L(0); PG8_MMA(0, 0, At, B0); PG8_BAR; PG8_SCHED;
            PG8_LDB(B1, 0, 1); PG8_STAGE(PG8_SB(0, 0), b2, voffB);
            PG8_BAR; PG8_WAIT_L(0); PG8_MMA(0, 1, At, B1); PG8_BAR;
            PG8_LDA(At, 0, 1); PG8_STAGE(PG8_SA(0, 0), a2, voffA);
            PG8_BAR; PG8_WAIT_L(0); PG8_MMA(1, 0, At, B0); PG8_BAR; PG8_SCHED;
            PG8_STAGE(PG8_SB(0, 1), b2 + hstep, voffB);
            PG8_WAIT_V(6); PG8_BAR; PG8_MMA(1, 1, At, B1); PG8_BAR;
            PG8_LDB(B0, 1, 0); PG8_SCHED; PG8_LDA(At, 1, 0); PG8_STAGE(PG8_SA(0, 1), a2 + hstep, voffA);
            PG8_WAIT_L(8); PG8_BAR; PG8_WAIT_L(0); PG8_MMA(0, 0, At, B0); PG8_BAR; PG8_SCHED;
            PG8_LDB(B1, 1, 1); PG8_STAGE(PG8_SB(1, 0), b3, voffB);
            PG8_BAR; PG8_WAIT_L(0); PG8_MMA(0, 1, At, B1); PG8_BAR;
            PG8_LDA(At, 1, 1); PG8_STAGE(PG8_SA(1, 0), a3, voffA);
            PG8_BAR; PG8_WAIT_L(0); PG8_MMA(1, 0, At, B0); PG8_BAR; PG8_SCHED;
            PG8_STAGE(PG8_SB(1, 1), b3 + hstep, voffB);
            PG8_WAIT_V(6); PG8_BAR; PG8_MMA(1, 1, At, B1); PG8_BAR;
            }
        }
        if constexpr (ALIGN_EPI) { if (wr == 0) PG8_BAR; }
        if constexpr (!Epi::AFTER_DRAIN) { E(acc, cur, wr, wc, fr, fq); S.done(cur); }
        if (!has_next) break;
#pragma unroll
        for (int a = 0; a < 2; ++a)
#pragma unroll
            for (int b = 0; b < 2; ++b)
#pragma unroll
                for (int m = 0; m < 4; ++m)
#pragma unroll
                    for (int n = 0; n < 2; ++n) acc[a][b][m][n] = (f32x4){0.f, 0.f, 0.f, 0.f};
        cur = nxt; cA = nA; cB = nB; ++ui;
        if constexpr (GATHER) { _Pragma("unroll") for (int _h = 0; _h < 2; ++_h) _Pragma("unroll") for (int _i = 0; _i < 2; ++_i) gC[_h][_i] = gN[_h][_i]; }
        if constexpr (ALIGN_EPI) { if (wr == 1) PG8_BAR; }
    }
    PG8_WAIT_V(0);
    if constexpr (!ALIGN_EPI) { if (wr == 0) PG8_BAR; }
    PG8_BAR;
    if constexpr (Epi::AFTER_DRAIN) { E.fused(acc, cur, wr, wc, fr, fq, lds, wid, lane); S.done(cur); }
#undef PG8_SA
#undef PG8_SB
#undef PG8_STAGE
#undef PG8_STAGE_A
#undef PG8_GOFF
#undef PG8_LDA
#undef PG8_LDB
#undef PG8_MMA
#undef PG8_WAIT_V
#undef PG8_WAIT_L
#undef PG8_BAR
#undef PG8_SCHED
}
}

using pg8::bf16_t; using pg8::bf16x8; using pg8::f32x4; using pg8::u32x4; using pg8::u32x2;
#define LAS __attribute__((address_space(3)))
typedef short bf16x4 __attribute__((ext_vector_type(4)));

constexpr int NB = 4, SEQ = 4096, DM = 1024, MTOK = NB * SEQ, DIN = 2048, NE = 16, FF = 2048, CAP = 512, NROWX = NE * NB * CAP;
constexpr float ALPHA = 1.41421356237309515f, LN_EPS = 1e-5f;
constexpr int NWAVES = 8, NTHR = 512;
constexpr int LDS_BYTES = 147456;
constexpr int S5T = 32, S5NCH = SEQ / S5T;

constexpr size_t MiB = 1u << 20;
constexpr size_t WS_WIN = 0, WS_WOUT = 8 * MiB, WS_WGLU = 12 * MiB, WS_S5TAB = 13 * MiB, WS_AFFT = 14 * MiB, WS_IDX = 15 * MiB, WS_GATE = 16 * MiB, WS_SLOT = 17 * MiB, WS_BAR = 18 * MiB, WS_S5BT = 19 * MiB, WS_S5CT = 20 * MiB;
constexpr size_t WS_WGU = 32 * MiB, WS_WD = 288 * MiB, WS_H32 = 416 * MiB, WS_HBF = 480 * MiB, WS_RA = 512 * MiB  , WS_RB = 576 * MiB  ;
constexpr size_t WS_HDN = 640 * MiB, WS_KVF = 768 * MiB, WS_KVB = 776 * MiB, WS_STF = 784 * MiB, WS_STB = 792 * MiB, WS_S5E = 800 * MiB, WS_S5C = 808 * MiB, WS_END = 816 * MiB;

struct Args { const float* in[25]; float* out; unsigned char* ws; int ph_lo, ph_hi; };

typedef __bf16 bf16x2_hw __attribute__((ext_vector_type(2)));
typedef float f32x2_hw __attribute__((ext_vector_type(2)));
__device__ __forceinline__ unsigned pk2(float lo, float hi) { const f32x2_hw v = {lo, hi}; const bf16x2_hw b = __builtin_convertvector(v, bf16x2_hw); return __builtin_bit_cast(unsigned, b); }
__device__ __forceinline__ unsigned f2bf(float f) { return pk2(f, 0.f) & 0xffffu; }
__device__ __forceinline__ float bflo(unsigned w) { return __uint_as_float(w << 16); }
__device__ __forceinline__ float bfhi(unsigned w) { return __uint_as_float(w & 0xffff0000u); }
__device__ __forceinline__ f32x4 mfma16(bf16x8 a, bf16x8 b, f32x4 c) { return __builtin_amdgcn_mfma_f32_16x16x32_bf16(a, b, c, 0, 0, 0); }
__device__ __forceinline__ float wave_sum(float v) {
#pragma unroll
    for (int o = 1; o < 64; o <<= 1) v += __shfl_xor(v, o);
    return v;
}
__device__ __forceinline__ bf16x8 pack8(const f32x4& a, const f32x4& b) {
    u32x4 w; w.x = pk2(a[0], a[1]); w.y = pk2(a[2], a[3]); w.z = pk2(b[0], b[1]); w.w = pk2(b[2], b[3]);
    return __builtin_bit_cast(bf16x8, w);
}
__device__ __forceinline__ bf16x8 cat8(bf16x4 lo, bf16x4 hi) { bf16x8 r; r[0] = lo[0]; r[1] = lo[1]; r[2] = lo[2]; r[3] = lo[3]; r[4] = hi[0]; r[5] = hi[1]; r[6] = hi[2]; r[7] = hi[3]; return r; }
#define LDS_WAIT() asm volatile("s_waitcnt lgkmcnt(0)" ::: "memory")

struct ConvItem { const float* srcp; bf16_t* dstp; int N; int rstep; };
__device__ __forceinline__ ConvItem conv_decode(const Args& a, int it, int lane) {
    constexpr int I3 = 16384, I4 = 16384, I5 = 16384, I0 = 1024, I1 = 512;
    unsigned char* ws = a.ws;
    const float* src; bf16_t* dst; int K, N, rmul = 1, ro = 0, kb, nb;
    int r = it;
    if (r < I3 + I4) { const int up = r >= I3; r -= up ? I3 : 0; const int mat = r >> 9, q = r & 511; src = (up ? a.in[21] : a.in[20]) + (size_t)mat * DM * FF; dst = (bf16_t*)(ws + WS_WGU) + (size_t)mat * 2 * FF * DM; K = DM; N = FF; rmul = 2; ro = up; kb = q >> 5; nb = q & 31; }
    else { r -= I3 + I4;
        if (r < I5) { const int mat = r >> 9, q = r & 511; src = a.in[22] + (size_t)mat * FF * DM; dst = (bf16_t*)(ws + WS_WD) + (size_t)mat * DM * FF; K = FF; N = DM; kb = q >> 4; nb = q & 15; }
        else { r -= I5;
            if (r < I0) { const int mat = r >> 9, q = r & 511; src = a.in[3] + (size_t)mat * DM * DIN; dst = (bf16_t*)(ws + WS_WIN) + (size_t)mat * DIN * DM; K = DM; N = DIN; kb = q >> 5; nb = q & 31; }
            else { r -= I0;
                if (r < I1) { const int mat = r >> 8, q = r & 255; src = a.in[16] + (size_t)mat * DM * DM; dst = (bf16_t*)(ws + WS_WOUT) + (size_t)mat * DM * DM; K = DM; N = DM; kb = q >> 4; nb = q & 15; }
                else { r -= I1; const int mat = r >> 4, q = r & 15; src = a.in[13] + (size_t)mat * 65536; dst = (bf16_t*)(ws + WS_WGLU) + (size_t)mat * 65536; K = 256; N = 256; kb = q >> 2; nb = q & 3; } } } }
    ConvItem c; c.N = N;
    c.srcp = src + (size_t)(kb * 64 + (lane >> 4)) * N + nb * 64 + (lane & 15) * 4;
    c.dstp = dst + (size_t)((nb * 64) * rmul + ro) * K + kb * 64; c.rstep = rmul * K;
    return c;
}
__device__ __forceinline__ void conv_load(const ConvItem& c, f32x4 (&v)[16]) {
#pragma unroll
    for (int i = 0; i < 16; ++i) v[i] = __builtin_nontemporal_load((const f32x4*)(c.srcp + (size_t)(i * 4) * c.N));
}
__device__ __forceinline__ void conv_store(const ConvItem& c, const f32x4 (&v)[16], LAS float* scr, int lane) {
    const int r4 = lane >> 4, c4 = (lane & 15) * 4;
#pragma unroll
    for (int i = 0; i < 16; ++i) { const int kk = i * 4 + r4; *(LAS f32x4*)(scr + kk * 68 + (c4 ^ (((kk >> 3) & 7) * 4))) = v[i]; }
    LDS_WAIT();
    const int cc = lane & 7, nl = lane >> 3;
#pragma unroll
    for (int p = 0; p < 8; ++p) {
        const int n = nl + 8 * p;
        const LAS float* s = scr + (8 * cc) * 68 + (n ^ (4 * cc));
        u32x4 o; o.x = pk2(s[0], s[68]); o.y = pk2(s[2 * 68], s[3 * 68]); o.z = pk2(s[4 * 68], s[5 * 68]); o.w = pk2(s[6 * 68], s[7 * 68]);
        *(u32x4*)(c.dstp + (size_t)n * c.rstep + 8 * cc) = o;
    }
    LDS_WAIT();
}
__device__ __forceinline__ void sincos_rev(double f, double& sn, double& cs) {
    const double a = f * 6.283185307179586476925;
    const double q = rint(a * 0.636619772367581343);
    const double r = a - q * 1.570796326794896619;
    const double r2 = r * r;
    double s = -7.6471637318198164759e-13; s = s * r2 + 1.6059043836821614599e-10; s = s * r2 - 2.5052108385441718775e-8; s = s * r2 + 2.7557319223985890653e-6;
    s = s * r2 - 1.9841269841269841270e-4; s = s * r2 + 8.3333333333333333333e-3; s = s * r2 - 1.6666666666666666667e-1; s = s * r2 * r + r;
    double c = 4.7794773323873852974e-14; c = c * r2 - 1.1470745597729724714e-11; c = c * r2 + 2.0876756987868098979e-9; c = c * r2 - 2.7557319223985890653e-7;
    c = c * r2 + 2.4801587301587301587e-5; c = c * r2 - 1.3888888888888888889e-3; c = c * r2 + 4.1666666666666666667e-2; c = c * r2 - 0.5; c = c * r2 + 1.0;
    const int qi = ((int)q) & 3;
    sn = (qi == 0) ? s : (qi == 1) ? c : (qi == 2) ? -s : -c;
    cs = (qi == 0) ? c : (qi == 1) ? -s : (qi == 2) ? -c : s;
}
__device__ __forceinline__ double exp_small(double x) {
    const double y = x * (1.0 / 64.0);
    double e = 1.0 / 479001600.0;
    e = e * y + 1.0 / 39916800.0; e = e * y + 1.0 / 3628800.0; e = e * y + 1.0 / 362880.0; e = e * y + 1.0 / 40320.0; e = e * y + 1.0 / 5040.0; e = e * y + 1.0 / 720.0;
    e = e * y + 1.0 / 120.0; e = e * y + 1.0 / 24.0; e = e * y + 1.0 / 6.0; e = e * y + 0.5; e = e * y + 1.0; e = e * y + 1.0;
#pragma unroll
    for (int i = 0; i < 6; ++i) e = e * e;
    return e;
}
__device__ __forceinline__ void s5_coefs(const Args& a, int t, double& br, double& bi, double& cr, double& ci, double& tr, double& ti) {
    const int g = (t >> 6) & 15, lr = t >> 10;
    const double lre = (double)a.in[5][t], lim = (double)a.in[6][t];
    const double step = exp_small((double)a.in[7][lr * 16 + g]);
    const double ar = lre * step, th = lim * step;
    const double rev = th * 0.15915494309189533577; const double fr = rev - rint(rev);
    double sn, cs; sincos_rev(fr, sn, cs);
    const double mag = exp_small(ar);
    br = mag * cs; bi = mag * sn;
    const double nr = br - 1.0, ni = bi, den = lre * lre + lim * lim;
    cr = (nr * lre + ni * lim) / den; ci = (ni * lre - nr * lim) / den;
    const double rev2 = rev * (double)S5T; const double fr2 = rev2 - rint(rev2);
    double sn2, cs2; sincos_rev(fr2, sn2, cs2);
    const double mag2 = exp_small(ar * (double)S5T);
    tr = mag2 * cs2; ti = mag2 * sn2;
}
__device__ __forceinline__ void s5_table_entry(const Args& a, int t) {
    double br, bi, cr, ci, tr, ti; s5_coefs(a, t, br, bi, cr, ci, tr, ti);
    float* o = (float*)(a.ws + WS_S5TAB) + (size_t)t * 8;
    o[0] = (float)br; o[1] = (float)bi; o[2] = (float)cr; o[3] = (float)ci; o[4] = (float)tr; o[5] = (float)ti; o[6] = 0.f; o[7] = 0.f;
}
__device__ __forceinline__ void s5_bt_row(const Args& a, int t) {
    const int l = t >> 12, g = (t >> 8) & 15, n = t & 255, r = n >> 7, p = (n >> 1) & 63, ri = n & 1;
    double br, bi, cr, ci, tr, ti; s5_coefs(a, ((l * 2 + r) * 16 + g) * 64 + p, br, bi, cr, ci, tr, ti);
    const float crf = (float)cr, cif = (float)ci;
    const float* bre = a.in[8] + (size_t)((l * 16 + g) * 64 + p) * 16; const float* bim = a.in[9] + (size_t)((l * 16 + g) * 64 + p) * 16;
    u32x4 o[2];
#pragma unroll
    for (int h = 0; h < 2; ++h) {
        const f32x4 x0 = *(const f32x4*)(bre + 8 * h), x1 = *(const f32x4*)(bre + 8 * h + 4), y0 = *(const f32x4*)(bim + 8 * h), y1 = *(const f32x4*)(bim + 8 * h + 4);
        float v[8];
#pragma unroll
        for (int k = 0; k < 4; ++k) { v[k] = ri ? (crf * y0[k] + cif * x0[k]) : (crf * x0[k] - cif * y0[k]); v[4 + k] = ri ? (crf * y1[k] + cif * x1[k]) : (crf * x1[k] - cif * y1[k]); }
        o[h].x = pk2(v[0], v[1]); o[h].y = pk2(v[2], v[3]); o[h].z = pk2(v[4], v[5]); o[h].w = pk2(v[6], v[7]);
    }
    u32x4* dst = (u32x4*)((bf16_t*)(a.ws + WS_S5BT) + (size_t)t * 32);
    dst[0] = o[0]; dst[1] = o[1]; dst[2] = (u32x4){0u, 0u, 0u, 0u}; dst[3] = (u32x4){0u, 0u, 0u, 0u};
}
__device__ __forceinline__ void s5_ct_entry(const Args& a, int t) {
    const int p = t & 63, r = (t >> 6) & 1, c = (t >> 7) & 15, g = (t >> 11) & 15, l = t >> 15;
    const size_t ci = (size_t)(((l * 2 + r) * 16 + g) * 16 + c) * 64 + p;
    ((unsigned*)(a.ws + WS_S5CT))[t] = pk2(a.in[10][ci], -a.in[11][ci]);
}
__device__ __forceinline__ void ln_rows4(f32x4 (&v)[4], const float* __restrict__ g, const float* __restrict__ bt, int lane) {
    float s = 0.f;
#pragma unroll
    for (int j = 0; j < 4; ++j) s += (v[j][0] + v[j][1]) + (v[j][2] + v[j][3]);
    const float mean = wave_sum(s) * (1.f / DM); float s2 = 0.f;
#pragma unroll
    for (int j = 0; j < 4; ++j) { v[j] = v[j] - mean; s2 += (v[j][0] * v[j][0] + v[j][1] * v[j][1]) + (v[j][2] * v[j][2] + v[j][3] * v[j][3]); }
    const float rstd = 1.f / sqrtf(wave_sum(s2) * (1.f / DM) + LN_EPS);
#pragma unroll
    for (int j = 0; j < 4; ++j) { const f32x4 gv = ((const f32x4*)g)[lane + 64 * j], bv = ((const f32x4*)bt)[lane + 64 * j]; v[j] = v[j] * rstd * gv + bv; }
}
__device__ __forceinline__ void store_row(const f32x4 (&v)[4], float* o32, bf16_t* obf, int lane) {
#pragma unroll
    for (int j = 0; j < 4; ++j) {
        if (o32) ((f32x4*)o32)[lane + 64 * j] = v[j];
        if (obf) { u32x2 w; w.x = pk2(v[j][0], v[j][1]); w.y = pk2(v[j][2], v[j][3]); ((u32x2*)obf)[lane + 64 * j] = w; }
    }
}
__device__ __forceinline__ void phase_p0(const Args& a, LAS unsigned char* lds, int tid) {
    const int lane = tid & 63, wave = tid >> 6;
    const int gw = blockIdx.x * NWAVES + wave, NGW = gridDim.x * NWAVES;
    LAS float* scr = (LAS float*)(lds + wave * 17408);
    unsigned char* ws = a.ws;
    constexpr int NIT = 16384 * 3 + 1024 + 512 + 32;
    if (gw < NIT) {
        ConvItem cur = conv_decode(a, gw, lane);
        f32x4 v[16]; conv_load(cur, v);
        for (int it = gw; it < NIT; it += NGW) {
            const bool more = (it + NGW) < NIT;
            ConvItem nxt = cur; f32x4 vn[16];
            if (more) { nxt = conv_decode(a, it + NGW, lane); conv_load(nxt, vn); }
            conv_store(cur, v, scr, lane);
            if (more) { cur = nxt;
#pragma unroll
                for (int i = 0; i < 16; ++i) v[i] = vn[i]; }
        }
    }
    for (int t = blockIdx.x * NTHR + tid; t < 4096; t += gridDim.x * NTHR) s5_table_entry(a, t);
    for (int t = blockIdx.x * NTHR + tid; t < 8192; t += gridDim.x * NTHR) s5_bt_row(a, t);
    for (int t = blockIdx.x * NTHR + tid; t < 65536; t += gridDim.x * NTHR) s5_ct_entry(a, t);
    for (int m = gw; m < MTOK; m += NGW) {
        f32x4 v[4];
#pragma unroll
        for (int j = 0; j < 4; ++j) v[j] = ((const f32x4*)(a.in[0] + (size_t)m * DM))[lane + 64 * j];
        ln_rows4(v, a.in[1], a.in[2], lane);
        store_row(v, nullptr, (bf16_t*)(ws + WS_HBF) + (size_t)m * DM, lane);
    }
}

__device__ __forceinline__ void attn_item(int item, const bf16_t* __restrict__ proj, bf16_t* __restrict__ mix, const float* __restrict__ sink_l, LAS unsigned char* lds, int tid) {
    const int kh = item & 1, c = (item >> 1) & 31, b = item >> 6;
    constexpr int VS = 408;
    LAS bf16_t* Ks = (LAS bf16_t*)lds;
    LAS bf16_t* Vt = (LAS bf16_t*)(lds + 384 * 72 * 2);
    const int lane = tid & 63, w = tid >> 6, fr = lane & 15, fq = lane >> 4;
    const int hq = kh * 4 + (w >> 1);
    const bf16_t* qbase = proj + ((size_t)b * SEQ + c * 128 + (w & 1) * 64 + fr) * DIN + 1280 + hq * 64 + fq * 8;
    bf16x8 qn0 = *(const bf16x8*)qbase, qn1 = *(const bf16x8*)(qbase + 32);
#pragma unroll
    for (int i = 0; i < 6; ++i) {
        const int id = tid + NTHR * i, key = id >> 3, ch = id & 7;
        const int s = (c - 1) * 128 + key; const bool ok = (s >= 0) && (s < SEQ);
        u32x4 kv = {0u, 0u, 0u, 0u}, vv = {0u, 0u, 0u, 0u};
        if (ok) { const bf16_t* rowp = proj + (size_t)(b * SEQ + s) * DIN; kv = *(const u32x4*)(rowp + 1792 + kh * 64 + ch * 8); vv = *(const u32x4*)(rowp + 1920 + kh * 64 + ch * 8); }
        *(LAS u32x4*)(Ks + key * 72 + ch * 8) = kv;
        LAS bf16_t* vp = Vt + (ch * 8) * VS + key;
        vp[0 * VS] = (bf16_t)(vv.x & 0xffffu); vp[1 * VS] = (bf16_t)(vv.x >> 16); vp[2 * VS] = (bf16_t)(vv.y & 0xffffu); vp[3 * VS] = (bf16_t)(vv.y >> 16);
        vp[4 * VS] = (bf16_t)(vv.z & 0xffffu); vp[5 * VS] = (bf16_t)(vv.z >> 16); vp[6 * VS] = (bf16_t)(vv.w & 0xffffu); vp[7 * VS] = (bf16_t)(vv.w >> 16);
    }
    if (tid < 128) { const int d = tid >> 1, hh = tid & 1; *(LAS u32x4*)(Vt + d * VS + 384 + hh * 8) = (u32x4){0u, 0u, 0u, 0u}; }
    __syncthreads();
    const float slope = exp2f(-(float)(hq + 1));
    const float sinkv = sink_l[hq];
    const bool lo_ok = (c >= 1), hi_ok = (c <= 30);
    float plo[4], phi[4];
#pragma unroll
    for (int j = 0; j < 4; ++j) { plo[j] = (fq * 4 + j >= fr) ? 0.f : -1e30f; phi[j] = (fq * 4 + j <= fr) ? 0.f : -1e30f; }
#pragma unroll 1
    for (int qi = 0; qi < 4; ++qi) {
        const int qt = (w & 1) * 4 + qi;
        const size_t tok = (size_t)b * SEQ + c * 128 + qt * 16 + fr;
        const bf16x8 qa0 = qn0, qa1 = qn1;
        float slope_l = slope; asm volatile("" : "+v"(slope_l));
        float sd[4];
#pragma unroll
        for (int j = 0; j < 4; ++j) sd[j] = slope_l * (float)(fq * 4 + j - fr);
        if (qi < 3) { const bf16_t* qp = qbase + (size_t)(qi + 1) * 16 * DIN; qn0 = *(const bf16x8*)qp; qn1 = *(const bf16x8*)(qp + 32); }
        f32x4 s[18];
        float mx = sinkv;
        const LAS bf16_t* kbase = Ks + (qt * 16 + fr) * 72 + fq * 8;
        const LAS bf16_t* vbase = Vt + fr * VS + qt * 16 + fq * 4;
#pragma unroll
        for (int i = 0; i < 17; ++i) {
            const int kt = qt + i;
            const LAS bf16_t* kp = kbase + i * (16 * 72);
            f32x4 acc = {0.f, 0.f, 0.f, 0.f};
            acc = mfma16(*(const LAS bf16x8*)kp, qa0, acc); acc = mfma16(*(const LAS bf16x8*)(kp + 32), qa1, acc);
            const float pblk = ((kt < 8) ? lo_ok : ((kt >= 16) ? hi_ok : true)) ? 0.f : -1e30f;
            const float base = slope_l * (float)(16 * i - 128);
#pragma unroll
            for (int j = 0; j < 4; ++j) {
                float t = (i < 8) ? (base + sd[j]) : ((i > 8) ? -(base + sd[j]) : -fabsf(sd[j]));
                if (i == 0) t += plo[j];
                if (i == 16) t += phi[j];
                const float v = fmaf(acc[j], 0.125f, t + pblk);
                acc[j] = v; mx = fmaxf(mx, v);
            }
            s[i] = acc;
        }
        mx = fmaxf(mx, __shfl_xor(mx, 16)); mx = fmaxf(mx, __shfl_xor(mx, 32));
        float sum = 0.f;
#pragma unroll
        for (int i = 0; i < 17; ++i)
#pragma unroll
            for (int j = 0; j < 4; ++j) { const float p = __expf(s[i][j] - mx); s[i][j] = p; sum += p; }
        s[17] = (f32x4){0.f, 0.f, 0.f, 0.f};
        sum += __shfl_xor(sum, 16); sum += __shfl_xor(sum, 32);
        const float inv = 1.f / (sum + __expf(sinkv - mx));
        f32x4 o[4];
#pragma unroll
        for (int dt = 0; dt < 4; ++dt) o[dt] = (f32x4){0.f, 0.f, 0.f, 0.f};
#pragma unroll
        for (int kk = 0; kk < 9; ++kk) {
            const bf16x8 pb = pack8(s[2 * kk], s[2 * kk + 1]);
#pragma unroll
            for (int dt = 0; dt < 4; ++dt) {
                const LAS bf16_t* vp = vbase + dt * (16 * VS) + kk * 32;
                o[dt] = mfma16(cat8(*(const LAS bf16x4*)vp, *(const LAS bf16x4*)(vp + 16)), pb, o[dt]);
            }
        }
        bf16_t* op = mix + tok * DM + 512 + hq * 64 + fq * 4;
#pragma unroll
        for (int dt = 0; dt < 4; ++dt) { u32x2 wv; wv.x = pk2(o[dt][0] * inv, o[dt][1] * inv); wv.y = pk2(o[dt][2] * inv, o[dt][3] * inv); *(u32x2*)(op + dt * 16) = wv; }
    }
    __syncthreads();
}

__device__ __forceinline__ float log_sigmoid(float t) { return -log1pf(__expf(-t)); }
__device__ __forceinline__ void retkv_item(int item, const bf16_t* __restrict__ proj, float* __restrict__ kvf, float* __restrict__ kvb, const float* __restrict__ theta, LAS unsigned char* lds, int tid) {
    const int h = item & 3, c = (item >> 2) & 31, b = item >> 7;
    const float lgf = log_sigmoid(theta[h]), lgb = log_sigmoid(theta[4 + h]);
    LAS bf16_t* KTf = (LAS bf16_t*)lds; LAS bf16_t* KTb = KTf + 64 * 136; LAS bf16_t* VT = KTb + 64 * 136;
#pragma unroll
    for (int i = 0; i < 2; ++i) {
        const int id = tid + NTHR * i, j = id >> 3, ch = id & 7;
        const bf16_t* rowp = proj + (size_t)(b * SEQ + c * 128 + j) * DIN;
        const u32x4 kr = *(const u32x4*)(rowp + 256 + h * 64 + ch * 8), vr = *(const u32x4*)(rowp + 512 + h * 64 + ch * 8);
        const float wf = __expf(lgf * (float)(127 - j)) * 0.125f, wb = __expf(lgb * (float)j) * 0.125f;
        const int o = (ch * 8) * 136 + j;
        KTf[o + 0 * 136] = (bf16_t)f2bf(bflo(kr.x) * wf); KTf[o + 1 * 136] = (bf16_t)f2bf(bfhi(kr.x) * wf); KTf[o + 2 * 136] = (bf16_t)f2bf(bflo(kr.y) * wf); KTf[o + 3 * 136] = (bf16_t)f2bf(bfhi(kr.y) * wf);
        KTf[o + 4 * 136] = (bf16_t)f2bf(bflo(kr.z) * wf); KTf[o + 5 * 136] = (bf16_t)f2bf(bfhi(kr.z) * wf); KTf[o + 6 * 136] = (bf16_t)f2bf(bflo(kr.w) * wf); KTf[o + 7 * 136] = (bf16_t)f2bf(bfhi(kr.w) * wf);
        KTb[o + 0 * 136] = (bf16_t)f2bf(bflo(kr.x) * wb); KTb[o + 1 * 136] = (bf16_t)f2bf(bfhi(kr.x) * wb); KTb[o + 2 * 136] = (bf16_t)f2bf(bflo(kr.y) * wb); KTb[o + 3 * 136] = (bf16_t)f2bf(bfhi(kr.y) * wb);
        KTb[o + 4 * 136] = (bf16_t)f2bf(bflo(kr.z) * wb); KTb[o + 5 * 136] = (bf16_t)f2bf(bfhi(kr.z) * wb); KTb[o + 6 * 136] = (bf16_t)f2bf(bflo(kr.w) * wb); KTb[o + 7 * 136] = (bf16_t)f2bf(bfhi(kr.w) * wb);
        VT[o + 0 * 136] = (bf16_t)(vr.x & 0xffffu); VT[o + 1 * 136] = (bf16_t)(vr.x >> 16); VT[o + 2 * 136] = (bf16_t)(vr.y & 0xffffu); VT[o + 3 * 136] = (bf16_t)(vr.y >> 16);
        VT[o + 4 * 136] = (bf16_t)(vr.z & 0xffffu); VT[o + 5 * 136] = (bf16_t)(vr.z >> 16); VT[o + 6 * 136] = (bf16_t)(vr.w & 0xffffu); VT[o + 7 * 136] = (bf16_t)(vr.w >> 16);
    }
    __syncthreads();
    const int lane = tid & 63, w = tid >> 6, fr = lane & 15, fq = lane >> 4;
    const size_t obase = (size_t)((b * 32 + c) * 4 + h) * 4096;
#pragma unroll
    for (int i = 0; i < 4; ++i) {
        const int job = w * 4 + i, dirb = job >> 4, et = (job >> 2) & 3, dt = job & 3;
        const LAS bf16_t* ap = VT + (et * 16 + fr) * 136 + fq * 8;
        const LAS bf16_t* bp = (dirb ? KTb : KTf) + (dt * 16 + fr) * 136 + fq * 8;
        f32x4 acc = {0.f, 0.f, 0.f, 0.f};
#pragma unroll
        for (int ks = 0; ks < 4; ++ks) acc = mfma16(*(const LAS bf16x8*)(ap + ks * 32), *(const LAS bf16x8*)(bp + ks * 32), acc);
        float* op = (dirb ? kvb : kvf) + obase + (et * 16 + fq * 4) * 64 + dt * 16 + fr;
        op[0] = acc[0]; op[64] = acc[1]; op[128] = acc[2]; op[192] = acc[3];
    }
    __syncthreads();
}
__device__ __forceinline__ void retout_item(int item, const bf16_t* __restrict__ proj, const float* __restrict__ stf, const float* __restrict__ stb, bf16_t* __restrict__ mix, const float* __restrict__ theta, LAS unsigned char* lds, int tid) {
    const int h = item & 3, c = (item >> 2) & 31, b = item >> 7;
    const float lgf = log_sigmoid(theta[h]), lgb = log_sigmoid(theta[4 + h]);
    LAS bf16_t* Qs = (LAS bf16_t*)lds; LAS bf16_t* Ks = Qs + 128 * 72; LAS bf16_t* VT = Ks + 128 * 72; LAS bf16_t* SFt = VT + 64 * 136; LAS bf16_t* SBt = SFt + 64 * 72;
#pragma unroll
    for (int i = 0; i < 2; ++i) {
        const int id = tid + NTHR * i, j = id >> 3, ch = id & 7;
        const bf16_t* rowp = proj + (size_t)(b * SEQ + c * 128 + j) * DIN;
        const u32x4 qr = *(const u32x4*)(rowp + h * 64 + ch * 8), kr = *(const u32x4*)(rowp + 256 + h * 64 + ch * 8), vr = *(const u32x4*)(rowp + 512 + h * 64 + ch * 8);
        *(LAS u32x4*)(Qs + j * 72 + ch * 8) = qr; *(LAS u32x4*)(Ks + j * 72 + ch * 8) = kr;
        const int o = (ch * 8) * 136 + j;
        VT[o + 0 * 136] = (bf16_t)(vr.x & 0xffffu); VT[o + 1 * 136] = (bf16_t)(vr.x >> 16); VT[o + 2 * 136] = (bf16_t)(vr.y & 0xffffu); VT[o + 3 * 136] = (bf16_t)(vr.y >> 16);
        VT[o + 4 * 136] = (bf16_t)(vr.z & 0xffffu); VT[o + 5 * 136] = (bf16_t)(vr.z >> 16); VT[o + 6 * 136] = (bf16_t)(vr.w & 0xffffu); VT[o + 7 * 136] = (bf16_t)(vr.w >> 16);
    }
    const size_t sbase = (size_t)((b * 32 + c) * 4 + h) * 4096;
#pragma unroll
    for (int i = 0; i < 8; ++i) { const int id = tid + NTHR * i, e = id >> 6, d = id & 63; SFt[e * 72 + d] = (bf16_t)f2bf(stf[sbase + id]); SBt[e * 72 + d] = (bf16_t)f2bf(stb[sbase + id]); }
    __syncthreads();
    const int lane = tid & 63, it = tid >> 6, fr = lane & 15, fq = lane >> 4;
    const int ipos = it * 16 + fr;
    const LAS bf16_t* qp = Qs + ipos * 72 + fq * 8;
    const bf16x8 qb0 = *(const LAS bf16x8*)qp, qb1 = *(const LAS bf16x8*)(qp + 32);
    f32x4 st[8];
#pragma unroll
    for (int jt = 0; jt < 8; ++jt) {
        const LAS bf16_t* kp = Ks + (jt * 16 + fr) * 72 + fq * 8;
        f32x4 acc = {0.f, 0.f, 0.f, 0.f};
        acc = mfma16(*(const LAS bf16x8*)kp, qb0, acc); acc = mfma16(*(const LAS bf16x8*)(kp + 32), qb1, acc);
#pragma unroll
        for (int jj = 0; jj < 4; ++jj) { const int dij = ipos - (jt * 16 + fq * 4 + jj); const float dec = dij >= 0 ? __expf(lgf * (float)dij) : __expf(lgb * (float)(-dij)); acc[jj] *= 0.125f * dec; }
        st[jt] = acc;
    }
    f32x4 o[4], ff[4], fb[4];
#pragma unroll
    for (int et = 0; et < 4; ++et) { o[et] = (f32x4){0.f, 0.f, 0.f, 0.f}; ff[et] = o[et]; fb[et] = o[et]; }
#pragma unroll
    for (int kk = 0; kk < 4; ++kk) {
        const bf16x8 pb = pack8(st[2 * kk], st[2 * kk + 1]);
#pragma unroll
        for (int et = 0; et < 4; ++et) { const LAS bf16_t* vp = VT + (et * 16 + fr) * 136 + kk * 32 + fq * 4; o[et] = mfma16(cat8(*(const LAS bf16x4*)vp, *(const LAS bf16x4*)(vp + 16)), pb, o[et]); }
    }
#pragma unroll
    for (int et = 0; et < 4; ++et) {
        const LAS bf16_t* fp = SFt + (et * 16 + fr) * 72 + fq * 8; const LAS bf16_t* bp = SBt + (et * 16 + fr) * 72 + fq * 8;
        ff[et] = mfma16(*(const LAS bf16x8*)fp, qb0, ff[et]); ff[et] = mfma16(*(const LAS bf16x8*)(fp + 32), qb1, ff[et]);
        fb[et] = mfma16(*(const LAS bf16x8*)bp, qb0, fb[et]); fb[et] = mfma16(*(const LAS bf16x8*)(bp + 32), qb1, fb[et]);
    }
    const float cf = __expf(lgf * (float)(ipos + 1)), cb = __expf(lgb * (float)(128 - ipos));
    float s = 0.f;
#pragma unroll
    for (int et = 0; et < 4; ++et) { o[et] = o[et] + ff[et] * cf + fb[et] * cb; s += (o[et][0] + o[et][1]) + (o[et][2] + o[et][3]); }
    s += __shfl_xor(s, 16); s += __shfl_xor(s, 32);
    const float mean = s * (1.f / 64.f); float s2 = 0.f;
#pragma unroll
    for (int et = 0; et < 4; ++et) { o[et] = o[et] - mean; s2 += (o[et][0] * o[et][0] + o[et][1] * o[et][1]) + (o[et][2] * o[et][2] + o[et][3] * o[et][3]); }
    s2 += __shfl_xor(s2, 16); s2 += __shfl_xor(s2, 32);
    const float rstd = 1.f / sqrtf(s2 * (1.f / 64.f) + LN_EPS);
    const size_t tok = (size_t)b * SEQ + c * 128 + ipos;
    const bf16_t* gp = proj + tok * DIN + 768 + h * 64 + fq * 4;
    bf16_t* op = mix + tok * DM + h * 64 + fq * 4;
#pragma unroll
    for (int et = 0; et < 4; ++et) {
        const u32x2 gr = *(const u32x2*)(gp + et * 16);
        const float g0 = bflo(gr.x), g1 = bfhi(gr.x), g2 = bflo(gr.y), g3 = bfhi(gr.y);
        const float y0 = o[et][0] * rstd * (g0 / (1.f + __expf(-g0))), y1 = o[et][1] * rstd * (g1 / (1.f + __expf(-g1)));
        const float y2 = o[et][2] * rstd * (g2 / (1.f + __expf(-g2))), y3 = o[et][3] * rstd * (g3 / (1.f + __expf(-g3)));
        u32x2 wv; wv.x = pk2(y0, y1); wv.y = pk2(y2, y3); *(u32x2*)(op + et * 16) = wv;
    }
    __syncthreads();
}

constexpr int S5XS = 136;
struct S5Pass { bf16x8 bf[8]; f32x4 t0; };
__device__ __forceinline__ void s5_fetch(S5Pass& P, const float* __restrict__ tab, const bf16_t* __restrict__ BT, int g, int r, int lane) {
    const int fr = lane & 15, fq = lane >> 4;
    P.t0 = *(const f32x4*)(tab + (size_t)((r * 16 + g) * 64 + lane) * 8);
    const bf16_t* btp = BT + (size_t)(g * 256 + r * 128 + fr) * 32 + fq * 8;
#pragma unroll
    for (int nt = 0; nt < 8; ++nt) P.bf[nt] = *(const bf16x8*)(btp + nt * 16 * 32);
}
__device__ __forceinline__ void s5_bu(LAS bf16_t* Xw, const S5Pass& P, bf16x8 uf0, bf16x8 uf1, int lane) {
    const int fr = lane & 15, fq = lane >> 4;
#pragma unroll
    for (int mt = 0; mt < 2; ++mt)
#pragma unroll
        for (int nt = 0; nt < 8; ++nt) {
            f32x4 acc = {0.f, 0.f, 0.f, 0.f};
            acc = mfma16(P.bf[nt], mt ? uf1 : uf0, acc);
            u32x2 wv; wv.x = pk2(acc[0], acc[1]); wv.y = pk2(acc[2], acc[3]);
            *(LAS u32x2*)(Xw + (mt * 16 + fr) * S5XS + nt * 16 + fq * 4) = wv;
        }
    asm volatile("s_waitcnt lgkmcnt(0)" ::: "memory");
}
template <bool WRITE>
__device__ __forceinline__ void s5_recur(LAS bf16_t* xq, int r, float lr_, float li_, float& xr, float& xi) {
#pragma unroll 1
    for (int blk = 0; blk < 4; ++blk) {
        LAS bf16_t* q = xq + (r ? (3 - blk) : blk) * (8 * S5XS);
        unsigned bw[8];
#pragma unroll
        for (int k = 0; k < 8; ++k) bw[k] = *(const LAS unsigned*)(q + k * S5XS);
        if (r == 0) {
#pragma unroll
            for (int s = 0; s < 8; ++s) {
                const float nr = fmaf(lr_, xr, fmaf(-li_, xi, bflo(bw[s]))), ni = fmaf(lr_, xi, fmaf(li_, xr, bfhi(bw[s])));
                xr = nr; xi = ni;
                if (WRITE) *(LAS unsigned*)(q + s * S5XS) = pk2(xr, xi);
            }
        } else {
#pragma unroll
            for (int s = 7; s >= 0; --s) {
                const float nr = fmaf(lr_, xr, fmaf(-li_, xi, bflo(bw[s]))), ni = fmaf(lr_, xi, fmaf(li_, xr, bfhi(bw[s])));
                xr = nr; xi = ni;
                if (WRITE) *(LAS unsigned*)(q + s * S5XS) = pk2(xr, xi);
            }
        }
    }
    if (WRITE) asm volatile("s_waitcnt lgkmcnt(0)" ::: "memory");
}
__device__ __forceinline__ void s5_ufrag(const bf16_t* __restrict__ proj, int b, int ch, int g, int lane, bf16x8& uf0, bf16x8& uf1) {
    const int fr = lane & 15, fq = lane >> 4;
    uf0 = (bf16x8){0, 0, 0, 0, 0, 0, 0, 0}; uf1 = uf0;
    if (fq < 2) { const bf16_t* up = proj + (size_t)(b * SEQ + ch * S5T + fr) * DIN + 1024 + g * 16 + fq * 8; uf0 = *(const bf16x8*)up; uf1 = *(const bf16x8*)(up + (size_t)16 * DIN); }
}

__device__ __forceinline__ void s5e_item(int item, const bf16_t* __restrict__ proj, const float* __restrict__ tab  , const bf16_t* __restrict__ BT,
                                         float* __restrict__ E, LAS unsigned char* lds, int tid) {
    const int ch = item & (S5NCH - 1), b = item / S5NCH;
    const int lane = tid & 63, w = tid >> 6;
    LAS bf16_t* Xw = (LAS bf16_t*)lds + w * (32 * S5XS);
    S5Pass cur;
    s5_fetch(cur, tab, BT, w, 0, lane);
    bf16x8 uf0, uf1;
    s5_ufrag(proj, b, ch, w, lane, uf0, uf1);
#pragma unroll 1
    for (int ps = 0; ps < 4; ++ps) {
        const int g = w + 8 * (ps >> 1), r = ps & 1;
        const float lr_ = cur.t0[0], li_ = cur.t0[1];
        s5_bu(Xw, cur, uf0, uf1, lane);
        if (ps < 3) s5_fetch(cur, tab, BT, w + 8 * ((ps + 1) >> 1), (ps + 1) & 1, lane);
        if (ps == 1) s5_ufrag(proj, b, ch, w + 8, lane, uf0, uf1);
        float xr = 0.f, xi = 0.f;
        s5_recur<false>(Xw + lane * 2, r, lr_, li_, xr, xi);
        float2 ev; ev.x = xr; ev.y = xi;
        ((float2*)E)[(size_t)(((b * S5NCH + ch) * 16 + g) * 2 + r) * 64 + lane] = ev;
        asm volatile("s_waitcnt lgkmcnt(0)" ::: "memory");
    }
    __syncthreads();
}
__device__ __forceinline__ void s5out_item(int item, const bf16_t* __restrict__ proj, const float* __restrict__ tab, const bf16_t* __restrict__ BT,
                                           const bf16_t* __restrict__ CT  , const float* __restrict__ dvec, const bf16_t* __restrict__ wgluT, const float* __restrict__ bglu,
                                           const float* __restrict__ CIN, bf16_t* __restrict__ mix, LAS unsigned char* lds, int tid) {
    const int ch = item & (S5NCH - 1), b = item / S5NCH;
    constexpr int YS = 264;
    const int lane = tid & 63, w = tid >> 6, fr = lane & 15, fq = lane >> 4;
    LAS bf16_t* Xw = (LAS bf16_t*)lds + w * (32 * S5XS);
    LAS bf16_t* Y = (LAS bf16_t*)(lds + 8 * 32 * S5XS * 2);
    S5Pass cur; bf16x8 ccf[4]; float2 ccin;
    s5_fetch(cur, tab, BT, w, 0, lane);
    ccin = ((const float2*)CIN)[(size_t)(((b * S5NCH + ch) * 16 + w) * 2 + 0) * 64 + lane];
#pragma unroll
    for (int ks = 0; ks < 4; ++ks) ccf[ks] = *(const bf16x8*)(CT + (size_t)(w * 16 + fr) * 256 + ks * 32 + fq * 8);
    bf16x8 uf0, uf1;
    s5_ufrag(proj, b, ch, w, lane, uf0, uf1);
    f32x4 ya0 = {0.f, 0.f, 0.f, 0.f}, ya1 = ya0;
#pragma unroll 1
    for (int ps = 0; ps < 4; ++ps) {
        const int g = w + 8 * (ps >> 1), r = ps & 1;
        const int gn = w + 8 * ((ps + 1) >> 1), rn = (ps + 1) & 1;
        const float lr_ = cur.t0[0], li_ = cur.t0[1];
        s5_bu(Xw, cur, uf0, uf1, lane);
        if (ps < 3) s5_fetch(cur, tab, BT, gn, rn, lane);
        if (ps == 1) s5_ufrag(proj, b, ch, w + 8, lane, uf0, uf1);
        float xr = ccin.x, xi = ccin.y;
        s5_recur<true>(Xw + lane * 2, r, lr_, li_, xr, xi);
        if (ps < 3) ccin = ((const float2*)CIN)[(size_t)(((b * S5NCH + ch) * 16 + gn) * 2 + rn) * 64 + lane];
#pragma unroll
        for (int ks = 0; ks < 4; ++ks) {
            ya0 = mfma16(ccf[ks], *(const LAS bf16x8*)(Xw + fr * S5XS + ks * 32 + fq * 8), ya0);
            ya1 = mfma16(ccf[ks], *(const LAS bf16x8*)(Xw + (16 + fr) * S5XS + ks * 32 + fq * 8), ya1);
        }
        if (ps < 3) {
#pragma unroll
            for (int ks = 0; ks < 4; ++ks) ccf[ks] = *(const bf16x8*)(CT + (size_t)(gn * 16 + fr) * 256 + rn * 128 + ks * 32 + fq * 8);
        }
        if (r == 1) {
            const int chn = g * 16 + fq * 4;
            const f32x4 dv = *(const f32x4*)(dvec + chn);
#pragma unroll
            for (int mt = 0; mt < 2; ++mt) {
                const int s = mt * 16 + fr;
                const u32x2 uw = *(const u32x2*)(proj + (size_t)(b * SEQ + ch * S5T + s) * DIN + 1024 + chn);
                const float uu[4] = {bflo(uw.x), bfhi(uw.x), bflo(uw.y), bfhi(uw.y)};
                float gl4[4];
#pragma unroll
                for (int jj = 0; jj < 4; ++jj) {
                    const float yv = (mt ? ya1[jj] : ya0[jj]) + dv[jj] * uu[jj];
                    const float t = 0.7978845608028654f * (yv + 0.044715f * yv * yv * yv);
                    gl4[jj] = yv * (1.f - __builtin_amdgcn_rcpf(1.f + __expf(2.f * t)));
                }
                u32x2 yw; yw.x = pk2(gl4[0], gl4[1]); yw.y = pk2(gl4[2], gl4[3]);
                *(LAS u32x2*)(Y + s * YS + chn) = yw;
            }
            ya0 = (f32x4){0.f, 0.f, 0.f, 0.f}; ya1 = ya0;
        }
        asm volatile("s_waitcnt lgkmcnt(0)" ::: "memory");
    }
    __syncthreads();
    {
        const int mt = w & 1;
        bf16x8 yf[8];
#pragma unroll
        for (int ks = 0; ks < 8; ++ks) yf[ks] = *(const LAS bf16x8*)(Y + (mt * 16 + fr) * YS + ks * 32 + fq * 8);
        const int s = mt * 16 + fr;
        bf16_t* orow = mix + (size_t)(b * SEQ + ch * S5T + s) * DM + 256;
#pragma unroll 2
        for (int i = 0; i < 4; ++i) {
            const int nt = (w >> 1) * 4 + i;
            const bf16_t* ap = wgluT + (size_t)(nt * 16 + fr) * 256 + fq * 8;
            f32x4 acc = {0.f, 0.f, 0.f, 0.f};
#pragma unroll
            for (int ks = 0; ks < 8; ++ks) acc = mfma16(*(const bf16x8*)(ap + ks * 32), yf[ks], acc);
            const int n0 = nt * 16 + fq * 4;
            const f32x4 bg = *(const f32x4*)(bglu + n0);
            const u32x2 yw = *(const LAS u32x2*)(Y + s * YS + n0);
            const float yv[4] = {bflo(yw.x), bfhi(yw.x), bflo(yw.y), bfhi(yw.y)};
            float ov[4];
#pragma unroll
            for (int jj = 0; jj < 4; ++jj) ov[jj] = yv[jj] * __builtin_amdgcn_rcpf(1.f + __expf(-(acc[jj] + bg[jj])));
            u32x2 ow; ow.x = pk2(ov[0], ov[1]); ow.y = pk2(ov[2], ov[3]);
            *(u32x2*)(orow + n0) = ow;
        }
    }
    __syncthreads();
}

__device__ __forceinline__ void phase_scan(const Args& a, int l, int tid) {
    unsigned char* ws = a.ws;
    const int lane = tid & 63, wave = tid >> 6;
    {
        const float* tab = (const float*)(ws + WS_S5TAB) + (size_t)l * 2048 * 8;
        const float2* __restrict__ E = (const float2*)(ws + WS_S5E); float2* __restrict__ C = (float2*)(ws + WS_S5C);
        for (int wv = blockIdx.x; wv < 128; wv += gridDim.x) if (wave == 0) {
            const int p = lane, r = wv & 1, g = (wv >> 1) & 15, b = wv >> 5;
            const float* tp = tab + (size_t)((r * 16 + g) * 64 + p) * 8;
            const float tr = tp[4], ti = tp[5];
            float xr = 0.f, xi = 0.f;
            for (int k0 = 0; k0 < S5NCH; k0 += 32) {
                float2 e[32];
#pragma unroll
                for (int k = 0; k < 32; ++k) { const int ch = r ? (S5NCH - 1 - (k0 + k)) : (k0 + k); e[k] = E[(size_t)(((b * S5NCH + ch) * 16 + g) * 2 + r) * 64 + p]; }
#pragma unroll
                for (int k = 0; k < 32; ++k) { const int ch = r ? (S5NCH - 1 - (k0 + k)) : (k0 + k);
                    float2 cv; cv.x = xr; cv.y = xi; C[(size_t)(((b * S5NCH + ch) * 16 + g) * 2 + r) * 64 + p] = cv;
                    const float nr = fmaf(tr, xr, fmaf(-ti, xi, e[k].x)), ni = fmaf(tr, xi, fmaf(ti, xr, e[k].y));
                    xr = nr; xi = ni; }
            }
        }
    }
    {
        const float* theta = a.in[4] + l * 8;
        const float* __restrict__ kvf = (const float*)(ws + WS_KVF); const float* __restrict__ kvb = (const float*)(ws + WS_KVB);
        float* __restrict__ stf = (float*)(ws + WS_STF); float* __restrict__ stb = (float*)(ws + WS_STB);
        for (int gid = blockIdx.x * NTHR + tid; gid < 131072; gid += gridDim.x * NTHR) {
            const int el = gid & 4095, dir = (gid >> 12) & 1, h = (gid >> 13) & 3, b = gid >> 15;
            const float dec = __expf(log_sigmoid(theta[dir * 4 + h]) * 128.f);
            const float* __restrict__ kv = dir ? kvb : kvf; float* __restrict__ st = dir ? stb : stf;
            float s = 0.f;
            for (int c0 = 0; c0 < 32; c0 += 16) {
                float kk[16];
#pragma unroll
                for (int k = 0; k < 16; ++k) { const int c = dir ? (31 - (c0 + k)) : (c0 + k); kk[k] = kv[(size_t)((b * 32 + c) * 4 + h) * 4096 + el]; }
#pragma unroll
                for (int k = 0; k < 16; ++k) { const int c = dir ? (31 - (c0 + k)) : (c0 + k); st[(size_t)((b * 32 + c) * 4 + h) * 4096 + el] = s; s = fmaf(dec, s, kk[k]); }
            }
        }
    }
}

__device__ __forceinline__ float router_softmax(const float (&sp)[16], int lane) {
    const bool b5 = (lane & 32) != 0, b4 = (lane & 16) != 0, b3 = (lane & 8) != 0, b2 = (lane & 4) != 0;
    float t8[8], t4[4], t2[2];
#pragma unroll
    for (int i = 0; i < 8; ++i) { const float snd = b5 ? sp[i] : sp[i + 8], kp = b5 ? sp[i + 8] : sp[i]; t8[i] = kp + __shfl_xor(snd, 32); }
#pragma unroll
    for (int i = 0; i < 4; ++i) { const float snd = b4 ? t8[i] : t8[i + 4], kp = b4 ? t8[i + 4] : t8[i]; t4[i] = kp + __shfl_xor(snd, 16); }
#pragma unroll
    for (int i = 0; i < 2; ++i) { const float snd = b3 ? t4[i] : t4[i + 2], kp = b3 ? t4[i + 2] : t4[i]; t2[i] = kp + __shfl_xor(snd, 8); }
    float lgt; { const float snd = b2 ? t2[0] : t2[1], kp = b2 ? t2[1] : t2[0]; lgt = kp + __shfl_xor(snd, 4); }
    lgt += __shfl_xor(lgt, 1); lgt += __shfl_xor(lgt, 2);
    float mx = lgt;
#pragma unroll
    for (int o = 4; o < 64; o <<= 1) mx = fmaxf(mx, __shfl_xor(mx, o));
    const float ex = expf(lgt - mx);
    float sum = ex;
#pragma unroll
    for (int o = 4; o < 64; o <<= 1) sum += __shfl_xor(sum, o);
    return ex / sum;
}
__device__ __forceinline__ void phase_ln1_router(const Args& a, int l, LAS unsigned char* lds, int tid) {
    unsigned char* ws = a.ws;
    const int lane = tid & 63, wave = tid >> 6;
    LAS float* rwT = (LAS float*)lds;
    const float* rw = a.in[19] + (size_t)l * DM * NE;
    for (int i = tid; i < DM * NE; i += NTHR) rwT[(i & 15) * DM + (i >> 4)] = rw[i];
    __syncthreads();
    const float* pre = (const float*)(ws + WS_RA);
    float* afft = (float*)(ws + WS_AFFT);
    const int gw = blockIdx.x * NWAVES + wave, NGW = gridDim.x * NWAVES;
    for (int m = gw; m < MTOK; m += 2 * NGW) {
        const int m1 = m + NGW; const bool has1 = m1 < MTOK; const int mb = has1 ? m1 : m;
        f32x4 v0[4], v1[4];
#pragma unroll
        for (int j = 0; j < 4; ++j) { v0[j] = ((const f32x4*)(pre + (size_t)m * DM))[lane + 64 * j]; v1[j] = ((const f32x4*)(pre + (size_t)mb * DM))[lane + 64 * j]; }
        ln_rows4(v0, a.in[17] + l * DM, a.in[18] + l * DM, lane);
        ln_rows4(v1, a.in[17] + l * DM, a.in[18] + l * DM, lane);
        store_row(v0, nullptr, (bf16_t*)(ws + WS_HBF) + (size_t)m * DM, lane);
        if (has1) store_row(v1, nullptr, (bf16_t*)(ws + WS_HBF) + (size_t)m1 * DM, lane);
        float sp0[16], sp1[16];
#pragma unroll
        for (int eg = 0; eg < 4; ++eg) {
#pragma unroll
            for (int ee = 0; ee < 4; ++ee) { const int e = eg * 4 + ee; float s0 = 0.f, s1 = 0.f;
#pragma unroll
                for (int j = 0; j < 4; ++j) { const f32x4 wv = *(const LAS f32x4*)(rwT + e * DM + 256 * j + 4 * lane);
                    s0 += (v0[j][0] * wv[0] + v0[j][1] * wv[1]) + (v0[j][2] * wv[2] + v0[j][3] * wv[3]);
                    s1 += (v1[j][0] * wv[0] + v1[j][1] * wv[1]) + (v1[j][2] * wv[2] + v1[j][3] * wv[3]); }
                sp0[e] = s0; sp1[e] = s1; }
            asm volatile("" ::: "memory");
        }
        const float af0 = router_softmax(sp0, lane), af1 = router_softmax(sp1, lane);
        if ((lane & 3) == 0) {
            afft[(size_t)((m / SEQ) * NE + (lane >> 2)) * SEQ + (m % SEQ)] = af0;
            if (has1) afft[(size_t)((m1 / SEQ) * NE + (lane >> 2)) * SEQ + (m1 % SEQ)] = af1;
        }
    }
    __syncthreads();
}

__device__ __forceinline__ void select_item(int item, const Args& a, LAS unsigned char* lds, int tid) {
    unsigned char* ws = a.ws;
    const int q = item & 3, e = (item >> 2) & 15, b = item >> 6;
    const int lane = tid & 63, wave = tid >> 6;
    LAS unsigned* red = (LAS unsigned*)lds;
    LAS int* sel = (LAS int*)(lds + 1024);
    const float* av = (const float*)(ws + WS_AFFT) + (size_t)(b * NE + e) * SEQ + tid * 8;
    const f32x4 va = *(const f32x4*)av, vb = *(const f32x4*)(av + 4);
    unsigned v[8] = {__float_as_uint(va[0]), __float_as_uint(va[1]), __float_as_uint(va[2]), __float_as_uint(va[3]), __float_as_uint(vb[0]), __float_as_uint(vb[1]), __float_as_uint(vb[2]), __float_as_uint(vb[3])};
    unsigned x = 0u;
    for (int bit = 30; bit >= 0; --bit) {
        const unsigned cand = x | (1u << bit);
        unsigned cnt = 0u;
#pragma unroll
        for (int j = 0; j < 8; ++j) cnt += (unsigned)__popcll(__ballot(v[j] >= cand));
        LAS unsigned* rb = red + (bit & 1) * 8;
        if (lane == 0) rb[wave] = cnt;
        __syncthreads();
        unsigned tot = 0u;
#pragma unroll
        for (int k = 0; k < 8; ++k) tot += rb[k];
        if (tot >= (unsigned)CAP) x = cand;
    }
    unsigned mycnt = 0u;
#pragma unroll
    for (int j = 0; j < 8; ++j) mycnt += (v[j] > x ? 1u : 0u) + (v[j] == x ? 0x10000u : 0u);
    unsigned inc = mycnt;
#pragma unroll
    for (int o = 1; o < 64; o <<= 1) { const unsigned t = __shfl_up(inc, o); if (lane >= o) inc += t; }
    LAS unsigned* wsum = red + 64;
    __syncthreads();
    if (lane == 63) wsum[wave] = inc;
    __syncthreads();
    unsigned wpre = 0u, total = 0u;
#pragma unroll
    for (int k = 0; k < 8; ++k) { const unsigned t = wsum[k]; if (k < wave) wpre += t; total += t; }
    const unsigned excl = wpre + inc - mycnt;
    unsigned gtb = excl & 0xffffu, eqb = excl >> 16;
    const unsigned need = (unsigned)CAP - (total & 0xffffu);
    const int rowbase = (e * NB + b) * CAP;
    int* idx = (int*)(ws + WS_IDX); float* gate = (float*)(ws + WS_GATE); int* slotmap = (int*)(ws + WS_SLOT);
    const bool own_tok = ((tid >> 7) == q);
#pragma unroll
    for (int j = 0; j < 8; ++j) {
        const bool isgt = v[j] > x, iseq = v[j] == x;
        const bool issel = isgt || (iseq && eqb < need);
        const unsigned slot = gtb + (eqb < need ? eqb : need);
        const int tok = b * SEQ + tid * 8 + j;
        if (issel && (int)(slot >> 7) == q) { idx[rowbase + slot] = tok; gate[rowbase + slot] = __uint_as_float(v[j]); }
        if (own_tok) slotmap[(size_t)tok * NE + e] = issel ? (int)(rowbase + slot) : -1;
        gtb += isgt ? 1u : 0u; eqb += iseq ? 1u : 0u;
    }
    __syncthreads();
}

__device__ __forceinline__ void phase_ln2(const Args& a, int l, int tid) {
    unsigned char* ws = a.ws;
    const int lane = tid & 63, wave = tid >> 6;
    const int gw = blockIdx.x * NWAVES + wave, NGW = gridDim.x * NWAVES;
    const bf16_t* hbf = (const bf16_t*)(ws + WS_HBF); const int* slotmap = (const int*)(ws + WS_SLOT); const bf16_t* contrib = (const bf16_t*)(ws + WS_RB);
    const bool last = (l == 1);
    u32x2 vn[4]; int slot_n = -1;
    if (gw < MTOK) {
#pragma unroll
        for (int j = 0; j < 4; ++j) vn[j] = ((const u32x2*)(hbf + (size_t)gw * DM))[lane + 64 * j];
        slot_n = slotmap[(size_t)gw * NE + (lane & 15)];
    }
    for (int m = gw; m < MTOK; m += NGW) {
        f32x4 v[4];
#pragma unroll
        for (int j = 0; j < 4; ++j) { v[j][0] = bflo(vn[j].x) * ALPHA; v[j][1] = bfhi(vn[j].x) * ALPHA; v[j][2] = bflo(vn[j].y) * ALPHA; v[j][3] = bfhi(vn[j].y) * ALPHA; }
        const int myslot = slot_n;
        unsigned bal = (unsigned)(__ballot(myslot >= 0) & 0xffffull);
        int r0 = -1, r1 = -1, r2 = -1, r3 = -1;
        if (bal) { r0 = __shfl(myslot, __builtin_ctz(bal)); bal &= bal - 1; }
        if (bal) { r1 = __shfl(myslot, __builtin_ctz(bal)); bal &= bal - 1; }
        if (bal) { r2 = __shfl(myslot, __builtin_ctz(bal)); bal &= bal - 1; }
        if (bal) { r3 = __shfl(myslot, __builtin_ctz(bal)); bal &= bal - 1; }
        u32x2 c0[4], c1[4], c2[4], c3[4];
#pragma unroll
        for (int j = 0; j < 4; ++j) { c0[j] = (u32x2){0u, 0u}; c1[j] = c0[j]; c2[j] = c0[j]; c3[j] = c0[j]; }
        if (r0 >= 0) {
#pragma unroll
            for (int j = 0; j < 4; ++j) c0[j] = ((const u32x2*)(contrib + (size_t)r0 * DM))[lane + 64 * j]; }
        if (r1 >= 0) {
#pragma unroll
            for (int j = 0; j < 4; ++j) c1[j] = ((const u32x2*)(contrib + (size_t)r1 * DM))[lane + 64 * j]; }
        if (r2 >= 0) {
#pragma unroll
            for (int j = 0; j < 4; ++j) c2[j] = ((const u32x2*)(contrib + (size_t)r2 * DM))[lane + 64 * j]; }
        if (r3 >= 0) {
#pragma unroll
            for (int j = 0; j < 4; ++j) c3[j] = ((const u32x2*)(contrib + (size_t)r3 * DM))[lane + 64 * j]; }
        if (m + NGW < MTOK) {
#pragma unroll
            for (int j = 0; j < 4; ++j) vn[j] = ((const u32x2*)(hbf + (size_t)(m + NGW) * DM))[lane + 64 * j];
            slot_n = slotmap[(size_t)(m + NGW) * NE + (lane & 15)];
        }
#pragma unroll
        for (int j = 0; j < 4; ++j) {
            v[j][0] += bflo(c0[j].x); v[j][1] += bfhi(c0[j].x); v[j][2] += bflo(c0[j].y); v[j][3] += bfhi(c0[j].y);
            v[j][0] += bflo(c1[j].x); v[j][1] += bfhi(c1[j].x); v[j][2] += bflo(c1[j].y); v[j][3] += bfhi(c1[j].y);
            v[j][0] += bflo(c2[j].x); v[j][1] += bfhi(c2[j].x); v[j][2] += bflo(c2[j].y); v[j][3] += bfhi(c2[j].y);
            v[j][0] += bflo(c3[j].x); v[j][1] += bfhi(c3[j].x); v[j][2] += bflo(c3[j].y); v[j][3] += bfhi(c3[j].y);
        }
        while (bal) {
            const int row = __shfl(myslot, __builtin_ctz(bal)); bal &= bal - 1;
            const u32x2* cr = (const u32x2*)(contrib + (size_t)row * DM);
#pragma unroll
            for (int j = 0; j < 4; ++j) { const u32x2 wv = cr[lane + 64 * j]; v[j][0] += bflo(wv.x); v[j][1] += bfhi(wv.x); v[j][2] += bflo(wv.y); v[j][3] += bfhi(wv.y); }
        }
        ln_rows4(v, a.in[23] + l * DM, a.in[24] + l * DM, lane);
        if (last) store_row(v, a.out + (size_t)m * DM, nullptr, lane);
        else store_row(v, nullptr, (bf16_t*)(ws + WS_HBF) + (size_t)m * DM, lane);
    }
}

typedef __attribute__((address_space(1))) unsigned gu32;
#define RLX_AGENT __ATOMIC_RELAXED, __HIP_MEMORY_SCOPE_AGENT
#define XB_TMO      128
#define XB_XCNT(j)  (256  + 64 * (j))
#define XB_XSUB(j)  (1280 + 64 * (j))
#define XB_XGEN(j)  (2304 + 64 * (j))
#define XB_TOP      3328
#define XB_TOPGEN   3392
#define XCD_BAR_WORDS 3456
#define XB_SPIN_CAP (1u << 18)

__device__ __forceinline__ unsigned xb_ld(unsigned* p)              { return __hip_atomic_load(p, __ATOMIC_RELAXED, __HIP_MEMORY_SCOPE_AGENT); }
__device__ __forceinline__ unsigned xb_add(unsigned* p, unsigned v) { return __hip_atomic_fetch_add(p, v, __ATOMIC_RELAXED, __HIP_MEMORY_SCOPE_AGENT); }
__device__ __forceinline__ unsigned xb_xcc_id() { return (unsigned)__builtin_amdgcn_s_getreg((3 << 11) | 20) & 0xFu; }
#define XB_SPIN(cond, bar) do { unsigned _sp = 0; while (cond) { __builtin_amdgcn_s_sleep(1); \
    if ((++_sp & 255u) == 0u) { if (xb_ld(&(bar)[XB_TMO])) break; if (_sp > XB_SPIN_CAP) { atomicAdd(&(bar)[XB_TMO], 1u); break; } } } } while (0)

struct XcdBarrier {
    unsigned* bar; unsigned x;
    volatile LAS unsigned* st;
};

__device__ __forceinline__ XcdBarrier xcd_barrier_post(unsigned* bar, volatile LAS unsigned* st) {
    XcdBarrier b; b.bar = bar; b.x = xb_xcc_id(); b.st = st;
    if (threadIdx.x == 0) (void)xb_add(&bar[XB_XCNT(b.x)], 1u);
    return b;
}
__device__ __forceinline__ void xcd_barrier_complete(unsigned* bar, unsigned x, unsigned& nloc, unsigned& nx) {
    const unsigned G = gridDim.x * gridDim.y * gridDim.z;
    unsigned sum, cnt, mine, sp = 0u;
    for (;;) {
        sum = 0u; cnt = 0u; mine = 0u;
#pragma unroll
        for (unsigned j = 0; j < 16; ++j) { const unsigned c = xb_ld(&bar[XB_XCNT(j)]); sum += c; cnt += (c > 0u) ? 1u : 0u; mine = (j == x) ? c : mine; }
        if (sum == G) break;
        __builtin_amdgcn_s_sleep(1);
        if ((++sp & 255u) == 0u) { if (xb_ld(&bar[XB_TMO])) break; if (sp > XB_SPIN_CAP) { atomicAdd(&bar[XB_TMO], 1u); break; } }
    }
    nloc = mine > 0u ? mine : 1u; nx = cnt > 0u ? cnt : 1u;
}

__device__ __forceinline__ void xcd_barrier(const XcdBarrier& b) {
    asm volatile("s_waitcnt vmcnt(0)" ::: "memory");
    __syncthreads();
    if (threadIdx.x == 0) {
        unsigned* bar = b.bar;
        __builtin_amdgcn_s_waitcnt(0);
        unsigned nloc = b.st[0], nx = b.st[1];
        if (nloc == 0u) { xcd_barrier_complete(bar, b.x, nloc, nx); b.st[0] = nloc; b.st[1] = nx; }
        const unsigned old = xb_add(&bar[XB_XSUB(b.x)], 1u);
        const unsigned gen = old / nloc;
        if (old + 1u == (gen + 1u) * nloc) {
            __builtin_amdgcn_fence(__ATOMIC_RELEASE, "agent");
            asm volatile("s_waitcnt vmcnt(0)" ::: "memory");
            const unsigned og = xb_add(&bar[XB_TOP], 1u);
            const unsigned tg = og / nx;
            if (og + 1u == (tg + 1u) * nx) xb_add(&bar[XB_TOPGEN], 1u);
            else XB_SPIN(xb_ld(&bar[XB_TOPGEN]) == tg, bar);
            __builtin_amdgcn_fence(__ATOMIC_ACQUIRE, "agent");
            xb_add(&bar[XB_XGEN(b.x)], 1u);
            asm volatile("s_waitcnt vmcnt(0)" ::: "memory");
        } else {
            XB_SPIN(xb_ld(&bar[XB_XGEN(b.x)]) == gen, bar);
            __builtin_amdgcn_fence(__ATOMIC_ACQUIRE, "agent");
            asm volatile("s_waitcnt vmcnt(0)" ::: "memory");
        }
    }
    __syncthreads();
}

constexpr int NPHASES = 21;
#ifndef REP_MASK
#define REP_MASK 0
#endif
template <int L, int K>
__device__ __forceinline__ void run_phase(const Args& a, LAS unsigned char* lds, int tid) {
    unsigned char* ws = a.ws;
    constexpr int l = L;
    bf16_t* proj = (bf16_t*)(ws + WS_RA); bf16_t* mix = (bf16_t*)(ws + WS_RB);
    if constexpr (K == 0) {
        pg8::Gemm g{(const bf16_t*)(ws + WS_HBF), (const bf16_t*)(ws + WS_WIN) + (size_t)l * DIN * DM, MTOK, DIN, DM};
        pg8::StaticOrder S; S.init(MTOK, DIN, (int)gridDim.x, (int)blockIdx.x);
        pg8::EpiStoreBf16 E{proj, DIN};
        pg8::gemm_phase<pg8::EpiStoreBf16, pg8::StaticOrder, true, true>(lds, g, S, E);
    } else if constexpr (K == 1) {
        const float* tab = (const float*)(ws + WS_S5TAB) + (size_t)l * 2048 * 8;
        constexpr int XB = ((REP_MASK >> 11) & 1) ? 512 : ((REP_MASK >> 12) & 1) ? 256 : ((REP_MASK >> 13) & 1) ? 512 : 0, XOFF = ((REP_MASK >> 11) & 1) ? 0 : ((REP_MASK >> 12) & 1) ? 512 : 768;
        for (int it0 = blockIdx.x; it0 < 1280 + XB; it0 += gridDim.x) {
            const int it = it0 < 1280 ? it0 : it0 - 1280 + XOFF;
            if (it < 512) s5e_item(it, proj, tab, (const bf16_t*)(ws + WS_S5BT) + (size_t)l * 4096 * 32, (float*)(ws + WS_S5E), lds, tid);
            else if (it < 768) attn_item(it - 512, proj, mix, a.in[15] + l * 8, lds, tid);
            else retkv_item(it - 768, proj, (float*)(ws + WS_KVF), (float*)(ws + WS_KVB), a.in[4] + l * 8, lds, tid);
        }
    } else if constexpr (K == 2) {
        phase_scan(a, l, tid);
    } else if constexpr (K == 3) {
        const float* tab = (const float*)(ws + WS_S5TAB) + (size_t)l * 2048 * 8;
        constexpr int XD = ((REP_MASK >> 14) & 3) ? 512 : 0, XOFD = ((REP_MASK >> 14) & 1) ? 0 : 512;
        for (int it0 = blockIdx.x; it0 < 1024 + XD; it0 += gridDim.x) {
            const int it = it0 < 1024 ? it0 : it0 - 1024 + XOFD;
            if (it < 512) s5out_item(it, proj, tab, (const bf16_t*)(ws + WS_S5BT) + (size_t)l * 4096 * 32, (const bf16_t*)(ws + WS_S5CT) + (size_t)l * 65536, a.in[12] + l * 256,
                                     (const bf16_t*)(ws + WS_WGLU) + (size_t)l * 65536, a.in[14] + l * 256, (const float*)(ws + WS_S5C), mix, lds, tid);
            else retout_item(it - 512, proj, (const float*)(ws + WS_STF), (const float*)(ws + WS_STB), mix, a.in[4] + l * 8, lds, tid);
        }
    } else if constexpr (K == 4) {
        pg8::Gemm g{mix, (const bf16_t*)(ws + WS_WOUT) + (size_t)l * DM * DM, MTOK, DM, DM};
        pg8::StaticOrder S; S.init(MTOK, DM, (int)gridDim.x, (int)blockIdx.x);
        pg8::EpiResF32 E{(const bf16_t*)(ws + WS_HBF), (float*)(ws + WS_RA), DM, ALPHA};
        pg8::gemm_phase<pg8::EpiResF32, pg8::StaticOrder, true, true>(lds, g, S, E);
    } else if constexpr (K == 5) {
        phase_ln1_router(a, l, lds, tid);
    } else if constexpr (K == 6) {
        for (int it = blockIdx.x; it < 256; it += gridDim.x) select_item(it, a, lds, tid);
    } else if constexpr (K == 7) {
        pg8::Gemm g{(const bf16_t*)(ws + WS_HBF), (const bf16_t*)(ws + WS_WGU) + (size_t)l * NE * 2 * FF * DM, NROWX, NE * 2 * FF, DM};
        pg8::GroupedOrder S; S.init(16, (int)gridDim.x, (int)blockIdx.x);
        pg8::EpiSwiGLU E{(bf16_t*)(ws + WS_HDN), FF, 16};
        pg8::gemm_phase<pg8::EpiSwiGLU, pg8::GroupedOrder, true, true, true>(lds, g, S, E, (const int*)(ws + WS_IDX));
    } else if constexpr (K == 8) {
        pg8::Gemm g{(const bf16_t*)(ws + WS_HDN), (const bf16_t*)(ws + WS_WD) + (size_t)l * NE * DM * FF, NROWX, NE * DM, FF};
        pg8::GroupedOrder S; S.init(4, (int)gridDim.x, (int)blockIdx.x);
        pg8::EpiScaleRow E{(bf16_t*)(ws + WS_RB), DM, 4, (const float*)(ws + WS_GATE)};
        pg8::gemm_phase<pg8::EpiScaleRow, pg8::GroupedOrder, true, true>(lds, g, S, E);
    } else {
        phase_ln2(a, l, tid);
    }
}
__global__ void __launch_bounds__(NTHR, 2) fwd_kernel(Args a) {
    extern __shared__ __attribute__((aligned(16))) unsigned char lds_raw[];
    LAS unsigned char* lds = (LAS unsigned char*)lds_raw;
    cg::grid_group grid = cg::this_grid();
    const int lo = a.ph_lo, hi = a.ph_hi;
    volatile LAS unsigned* bst = (volatile LAS unsigned*)(lds + LDS_BYTES - 64);
    if (threadIdx.x < 16) bst[threadIdx.x] = 0u;
    __syncthreads();
    XcdBarrier bar = xcd_barrier_post((unsigned*)(a.ws + WS_BAR), bst);
    if (hi > 1000) grid.sync();
#define PH_BEGIN(ph) if (lo <= (ph) && (ph) < hi) { int tid = threadIdx.x; asm volatile("" : "+v"(tid));
#define PH_END(ph) if ((ph) + 1 < hi) xcd_barrier(bar); }
    PH_BEGIN(0) for (int rep = 0; rep <= ((REP_MASK >> 10) & 1); ++rep) phase_p0(a, lds, tid); PH_END(0)
#define LAYER(L) \
    PH_BEGIN(1 + 10 * L + 0) for (int rep = 0; rep <= ((REP_MASK >> 0) & 1); ++rep) run_phase<L, 0>(a, lds, tid); PH_END(1 + 10 * L + 0) \
    PH_BEGIN(1 + 10 * L + 1) for (int rep = 0; rep <= ((REP_MASK >> 1) & 1); ++rep) run_phase<L, 1>(a, lds, tid); PH_END(1 + 10 * L + 1) \
    PH_BEGIN(1 + 10 * L + 2) for (int rep = 0; rep <= ((REP_MASK >> 2) & 1); ++rep) run_phase<L, 2>(a, lds, tid); PH_END(1 + 10 * L + 2) \
    PH_BEGIN(1 + 10 * L + 3) for (int rep = 0; rep <= ((REP_MASK >> 3) & 1); ++rep) run_phase<L, 3>(a, lds, tid); PH_END(1 + 10 * L + 3) \
    PH_BEGIN(1 + 10 * L + 4) for (int rep = 0; rep <= ((REP_MASK >> 4) & 1); ++rep) run_phase<L, 4>(a, lds, tid); PH_END(1 + 10 * L + 4) \
    PH_BEGIN(1 + 10 * L + 5) for (int rep = 0; rep <= ((REP_MASK >> 5) & 1); ++rep) run_phase<L, 5>(a, lds, tid); PH_END(1 + 10 * L + 5) \
    PH_BEGIN(1 + 10 * L + 6) for (int rep = 0; rep <= ((REP_MASK >> 6) & 1); ++rep) run_phase<L, 6>(a, lds, tid); PH_END(1 + 10 * L + 6) \
    PH_BEGIN(1 + 10 * L + 7) for (int rep = 0; rep <= ((REP_MASK >> 7) & 1); ++rep) run_phase<L, 7>(a, lds, tid); PH_END(1 + 10 * L + 7) \
    PH_BEGIN(1 + 10 * L + 8) for (int rep = 0; rep <= ((REP_MASK >> 8) & 1); ++rep) run_phase<L, 8>(a, lds, tid); PH_END(1 + 10 * L + 8) \
    PH_BEGIN(1 + 10 * L + 9) for (int rep = 0; rep <= (((REP_MASK >> 9) & 1) && L == 1 ? 1 : 0); ++rep) run_phase<L, 9>(a, lds, tid); PH_END(1 + 10 * L + 9)
    LAYER(0)
    LAYER(1)
#undef LAYER
#undef PH_BEGIN
#undef PH_END
}

#ifndef ONE_LAUNCH
#define ONE_LAUNCH 1
#endif
extern "C" void kernel_launch(void* const* d_in, const int* in_sizes, int n_in, void* d_out, int out_size, void* d_ws, size_t ws_size, hipStream_t stream) {
    static int grid = 0;
    if (grid == 0) {
        if (n_in != 25 || ws_size < WS_END) { fprintf(stderr, "kernel_launch: unexpected problem (n_in %d, ws %zu)\n", n_in, ws_size); grid = -1; return; }
        int dev = 0, cus = 0, per_cu = 0;
        (void)hipGetDevice(&dev);
        (void)hipDeviceGetAttribute(&cus, hipDeviceAttributeMultiprocessorCount, dev);
        if (hipFuncSetAttribute((const void*)fwd_kernel, hipFuncAttributeMaxDynamicSharedMemorySize, LDS_BYTES) != hipSuccess) { fprintf(stderr, "kernel_launch: hipFuncSetAttribute failed\n"); grid = -1; return; }
        if (hipOccupancyMaxActiveBlocksPerMultiprocessor(&per_cu, (const void*)fwd_kernel, NTHR, LDS_BYTES) != hipSuccess || per_cu < 1) { fprintf(stderr, "kernel_launch: occupancy query says %d\n", per_cu); per_cu = 1; }
        (void)hipGetLastError();
        if (cus <= 0) cus = 256;
        grid = cus * per_cu;
    }
    if (grid < 0) return;
    Args a{};
    for (int i = 0; i < 25; ++i) a.in[i] = (const float*)d_in[i];
    a.out = (float*)d_out; a.ws = (unsigned char*)d_ws;
#if ONE_LAUNCH
    if (hipMemsetAsync((char*)d_ws + WS_BAR, 0, 16384, stream) != hipSuccess) { fprintf(stderr, "kernel_launch: memset failed\n"); return; }
    a.ph_lo = 0; a.ph_hi = NPHASES;
    void* args[] = {&a};
    hipError_t e = hipLaunchCooperativeKernel((const void*)fwd_kernel, dim3(grid), dim3(NTHR), args, LDS_BYTES, stream);
    if (e != hipSuccess) fprintf(stderr, "kernel_launch: cooperative launch failed: %s (grid %d)\n", hipGetErrorString(e), grid);
#else
    for (int ph = 0; ph < NPHASES; ++ph) {
        a.ph_lo = ph; a.ph_hi = ph + 1;
        hipLaunchKernelGGL(fwd_kernel, dim3(grid), dim3(NTHR), LDS_BYTES, stream, a);
    }
#endif
}
```

```cpp
#include <hip/hip_runtime.h>
#include <hip/hip_cooperative_groups.h>
#include <cstdio>
#include <cstdint>
namespace cg = cooperative_groups;
namespace pg8 {
#define PG8_LAS __attribute__((address_space(3)))
typedef unsigned short bf16_t;
typedef short bf16x8 __attribute__((ext_vector_type(8)));
typedef float f32x4 __attribute__((ext_vector_type(4)));
typedef unsigned u32x4 __attribute__((ext_vector_type(4)));
constexpr int BM = 256, BK = 64, HALF = 128, HTB = HALF * BK * 2  , STAGE_BYTES = 8 * HTB, NXCD = 8, WGM = 8;

__host__ __device__ __forceinline__ int lds_byte(int r, int c) { const int st = (r >> 4) * 2 + (c >> 5), rr = r & 15, cc = c & 31, ob = rr * 64 + cc * 2; return st * 1024 + (ob ^ (((ob >> 9) & 1) << 5)); }
__host__ __device__ __forceinline__ void stage_rc(int b, int& R, int& C) { const int st = b / 1024, sb = b % 1024, swz = sb ^ (((sb >> 9) & 1) << 5); R = (st >> 1) * 16 + swz / 64; C = (st & 1) * 32 + (swz % 64) / 2; }
__host__ __device__ __forceinline__ int perm32(int rho) { const int n = rho >> 4, i = rho & 15; return 8 * (i >> 2) + 4 * n + (i & 3); }

struct Unit { int pm, pn; };
struct Gemm { const bf16_t* A; const bf16_t* Bt; int M, N, K; };

struct StaticOrder {
    int nM, nN, nwg, G, c;
    __host__ __device__ void init(int M, int N, int G_, int c_) { nM = M / BM; nN = N / BM; nwg = nM * nN; G = G_; c = c_; }
    __host__ __device__ bool next(int i, Unit& u) const {
        const long L = (long)i * G + c; if (L >= nwg) return false;
        int wgid = (int)L; { const int q = nwg / NXCD, r = nwg % NXCD, xcd = wgid % NXCD, off = wgid / NXCD; wgid = (xcd < r ? xcd * (q + 1) : r * (q + 1) + (xcd - r) * q) + off; }
        const int nig = WGM * nN, gid = wgid / nig, fm = gid * WGM, gsz = (nM - fm) < WGM ? (nM - fm) : WGM;
        u.pm = fm + ((wgid % nig) % gsz); u.pn = (wgid % nig) / gsz; return true;
    }
    __device__ __forceinline__ void a_ready(const Unit&) const {}
    __device__ __forceinline__ void done(const Unit&) const {}
};

__device__ __forceinline__ unsigned cvt_pk_bf16(float lo, float hi) { unsigned r; asm volatile("v_cvt_pk_bf16_f32 %0, %1, %2" : "=v"(r) : "v"(lo), "v"(hi)); return r; }
typedef unsigned u32x2 __attribute__((ext_vector_type(2)));

struct GroupedOrder {
    int upe, nNe, nwg, G, c;
    __host__ __device__ void init(int nNe_, int G_, int c_) { nNe = nNe_; upe = 8 * nNe_; nwg = 16 * upe; G = G_; c = c_; }
    __host__ __device__ bool next(int i, Unit& u) const {
        const long L = (long)i * G + c; if (L >= nwg) return false;
        int wgid = (int)L; { const int q = nwg / NXCD, r = nwg % NXCD, xcd = wgid % NXCD, off = wgid / NXCD; wgid = (xcd < r ? xcd * (q + 1) : r * (q + 1) + (xcd - r) * q) + off; }
        const int e = wgid / upe, rr = wgid % upe;
        u.pm = e * 8 + (rr & 7); u.pn = e * nNe + (rr >> 3); return true;
    }
    __device__ __forceinline__ void a_ready(const Unit&) const {}
    __device__ __forceinline__ void done(const Unit&) const {}
};

struct EpiStoreBf16 {
    static constexpr bool PERM = true, AFTER_DRAIN = false;
    bf16_t* O; int ldc;
    __device__ __forceinline__ void operator()(const f32x4 (&acc)[2][2][4][2], const Unit& u, int wr, int wc, int fr, int fq) const {
        const int row0 = u.pm * BM + wr * 64 + fr, col0 = u.pn * BM + wc * 32 + 8 * fq;
#pragma unroll
        for (int ai = 0; ai < 2; ++ai)
#pragma unroll
            for (int m = 0; m < 4; ++m) { bf16_t* rowp = O + (size_t)(row0 + ai * HALF + m * 16) * ldc + col0;
#pragma unroll
                for (int bj = 0; bj < 2; ++bj) { const f32x4 v0 = acc[ai][bj][m][0], v1 = acc[ai][bj][m][1];
                    u32x4 w; w.x = cvt_pk_bf16(v0[0], v0[1]); w.y = cvt_pk_bf16(v0[2], v0[3]); w.z = cvt_pk_bf16(v1[0], v1[1]); w.w = cvt_pk_bf16(v1[2], v1[3]);
                    *(u32x4*)(rowp + bj * HALF) = w; } }
    }
};
struct EpiResF32 {
    static constexpr bool PERM = false, AFTER_DRAIN = false;
    const bf16_t* base; float* O; int ldc; float alpha;
    __device__ __forceinline__ void operator()(const f32x4 (&acc)[2][2][4][2], const Unit& u, int wr, int wc, int fr, int fq) const {
        const int row0 = u.pm * BM + wr * 64 + fr, col0 = u.pn * BM + wc * 32 + 4 * fq;
#pragma unroll
        for (int ai = 0; ai < 2; ++ai)
#pragma unroll
            for (int m = 0; m < 4; ++m) { const size_t ro = (size_t)(row0 + ai * HALF + m * 16) * ldc + col0;
#pragma unroll
                for (int bj = 0; bj < 2; ++bj)
#pragma unroll
                    for (int n = 0; n < 2; ++n) { const u32x2 bw = *(const u32x2*)(base + ro + bj * HALF + 16 * n);
                        f32x4 b; b[0] = __uint_as_float(bw.x << 16); b[1] = __uint_as_float(bw.x & 0xffff0000u); b[2] = __uint_as_float(bw.y << 16); b[3] = __uint_as_float(bw.y & 0xffff0000u);
                        *(f32x4*)(O + ro + bj * HALF + 16 * n) = b * alpha + acc[ai][bj][m][n]; } }
    }
};
struct EpiSwiGLU {
    static constexpr bool PERM = true, AFTER_DRAIN = false;
    bf16_t* O; int ldc; int ntn;
    __device__ __forceinline__ void operator()(const f32x4 (&acc)[2][2][4][2], const Unit& u, int wr, int wc, int fr, int fq) const {
        const int row0 = u.pm * BM + wr * 64 + fr, col0 = (u.pn % ntn) * HALF + wc * 32 + 8 * fq;
#pragma unroll
        for (int ai = 0; ai < 2; ++ai)
#pragma unroll
            for (int m = 0; m < 4; ++m) { bf16_t* rowp = O + (size_t)(row0 + ai * HALF + m * 16) * ldc + col0;
                float h[8];
#pragma unroll
                for (int n = 0; n < 2; ++n) { const f32x4 g = acc[ai][0][m][n], up = acc[ai][1][m][n];
#pragma unroll
                    for (int j = 0; j < 4; ++j) h[4 * n + j] = g[j] * up[j] * __builtin_amdgcn_rcpf(1.f + __expf(-g[j])); }
                u32x4 w; w.x = cvt_pk_bf16(h[0], h[1]); w.y = cvt_pk_bf16(h[2], h[3]); w.z = cvt_pk_bf16(h[4], h[5]); w.w = cvt_pk_bf16(h[6], h[7]);
                *(u32x4*)rowp = w; }
    }
};
struct EpiScaleRow {
    static constexpr bool PERM = true, AFTER_DRAIN = false;
    bf16_t* O; int ldc; int ntn; const float* gate;
    __device__ __forceinline__ void operator()(const f32x4 (&acc)[2][2][4][2], const Unit& u, int wr, int wc, int fr, int fq) const {
        const int row0 = u.pm * BM + wr * 64 + fr, col0 = (u.pn % ntn) * BM + wc * 32 + 8 * fq;
#pragma unroll
        for (int ai = 0; ai < 2; ++ai)
#pragma unroll
            for (int m = 0; m < 4; ++m) { const int row = row0 + ai * HALF + m * 16; const float gsc = gate[row]; bf16_t* rowp = O + (size_t)row * ldc + col0;
#pragma unroll
                for (int bj = 0; bj < 2; ++bj) { const f32x4 v0 = acc[ai][bj][m][0] * gsc, v1 = acc[ai][bj][m][1] * gsc;
                    u32x4 w; w.x = cvt_pk_bf16(v0[0], v0[1]); w.y = cvt_pk_bf16(v0[2], v0[3]); w.z = cvt_pk_bf16(v1[0], v1[1]); w.w = cvt_pk_bf16(v1[2], v1[3]);
                    *(u32x4*)(rowp + bj * HALF) = w; } }
    }
};
template <class Epi, class Sched, bool ALIGN_EPI = false, bool SP2 = false, bool GATHER = false>
__device__ __forceinline__ void gemm_phase(PG8_LAS unsigned char* lds, const Gemm g, const Sched& S, const Epi& E, const int* __restrict__ rowidx = nullptr) {
    static_assert(!GATHER || SP2, "GATHER is implemented for the SP2 loop");
    int tid_ = threadIdx.x; asm volatile("" : "+v"(tid_)); const int tid = tid_, wid = __builtin_amdgcn_readfirstlane(tid >> 6), lane = tid & 63, wr = wid >> 2, wc = wid & 3, fr = lane & 15, fq = lane >> 4;
    const int K = g.K, nt = K / BK;
    unsigned voffA[2], voffB[2];
#pragma unroll
    for (int i = 0; i < 2; ++i) { int R, C; stage_rc(tid * 16 + i * 8192, R, C); const int Rb = Epi::PERM ? ((R & ~31) + perm32(R & 31)) : R;
        voffA[i] = (unsigned)(R * K + C) * 2u; voffB[i] = (unsigned)(Rb * K + C) * 2u; }
    int gR[2], gCc[2];
#pragma unroll
    for (int i = 0; i < 2; ++i) { int R, C; stage_rc(tid * 16 + i * 8192, R, C); gR[i] = R; gCc[i] = C * 2; }
    unsigned gC[2][2], gN[2][2];
#define PG8_GOFF(dst, pmv) do { _Pragma("unroll") for (int _h = 0; _h < 2; ++_h) _Pragma("unroll") for (int _i = 0; _i < 2; ++_i) \
        dst[_h][_i] = (unsigned)rowidx[(pmv) * BM + _h * HALF + gR[_i]] * (unsigned)(K * 2) + (unsigned)gCc[_i]; } while (0)
    const size_t kstep = (size_t)(BK * 2);
    const size_t hstep = (size_t)HALF * K * 2;
    const size_t tstep = 2 * hstep;
    const unsigned ldsw = (unsigned)wid * 1024u;
    const int aoff = lds_byte(wr * 64 + fr, fq * 8), boff = lds_byte(wc * 32 + fr, fq * 8);
#define PG8_SA(b, h) (((b) * 2 + (h)) * HTB)
#define PG8_SB(b, h) ((4 + (b) * 2 + (h)) * HTB)
#define PG8_STAGE(bufoff, gbase, voff) do { _Pragma("unroll") for (int _i = 0; _i < 2; ++_i) \
        __builtin_amdgcn_global_load_lds((const unsigned*)((const char*)(gbase) + (voff)[_i]), (PG8_LAS unsigned*)(lds + (bufoff) + ldsw + _i * 8192), 16, 0, 0); } while (0)
#define PG8_STAGE_A(bufoff, gbase, h, nx) do { if constexpr (GATHER) { unsigned _o[2]; _o[0] = (nx) ? gN[h][0] : gC[h][0]; _o[1] = (nx) ? gN[h][1] : gC[h][1]; PG8_STAGE(bufoff, gbase, _o); } \
        else { PG8_STAGE(bufoff, (gbase) + (h) * hstep, voffA); } } while (0)
#define PG8_LDA(dst, b, h) do { _Pragma("unroll") for (int m = 0; m < 4; ++m) _Pragma("unroll") for (int k = 0; k < 2; ++k) dst[m][k] = *(const PG8_LAS bf16x8*)(lds + PG8_SA(b, h) + aoff + m * 2048 + k * 1024); } while (0)
#define PG8_LDB(dst, b, h) do { _Pragma("unroll") for (int n = 0; n < 2; ++n) _Pragma("unroll") for (int k = 0; k < 2; ++k) dst[n][k] = *(const PG8_LAS bf16x8*)(lds + PG8_SB(b, h) + boff + n * 2048 + k * 1024); } while (0)
#define PG8_MMA(ai, bj, At, Bt) do { __builtin_amdgcn_s_setprio(1); _Pragma("unroll") for (int m = 0; m < 4; ++m) _Pragma("unroll") for (int n = 0; n < 2; ++n) _Pragma("unroll") for (int k = 0; k < 2; ++k) \
        acc[ai][bj][m][n] = __builtin_amdgcn_mfma_f32_16x16x32_bf16(Bt[n][k], At[m][k], acc[ai][bj][m][n], 0, 0, 0); __builtin_amdgcn_s_setprio(0); } while (0)
#define PG8_WAIT_V(n) asm volatile("s_waitcnt vmcnt(" #n ")" ::: "memory")
#define PG8_WAIT_L(n) asm volatile("s_waitcnt lgkmcnt(" #n ")" ::: "memory")
#define PG8_BAR __builtin_amdgcn_s_barrier()
#define PG8_SCHED __builtin_amdgcn_sched_barrier(0)
    Unit cur, nxt; int ui = 0;
    if (!S.next(0, cur)) return;
    f32x4 acc[2][2][4][2];
#pragma unroll
    for (int a = 0; a < 2; ++a)
#pragma unroll
        for (int b = 0; b < 2; ++b)
#pragma unroll
            for (int m = 0; m < 4; ++m)
#pragma unroll
                for (int n = 0; n < 2; ++n) acc[a][b][m][n] = (f32x4){0.f, 0.f, 0.f, 0.f};
    bf16x8 At[4][2], B0[2][2], B1[2][2];
    const char* cA = GATHER ? (const char*)g.A : (const char*)g.A + (size_t)cur.pm * tstep; const char* cB = (const char*)g.Bt + (size_t)cur.pn * tstep;
    if constexpr (GATHER) { PG8_GOFF(gC, cur.pm); PG8_GOFF(gN, cur.pm); }
    S.a_ready(cur);
    if constexpr (SP2) {
        PG8_STAGE(PG8_SB(0, 0), cB, voffB); PG8_STAGE(PG8_SB(0, 1), cB + hstep, voffB); PG8_STAGE_A(PG8_SA(0, 0), cA, 0, false); PG8_STAGE_A(PG8_SA(0, 1), cA, 1, false);
        if (wr == 1) PG8_BAR;
        PG8_WAIT_V(2); PG8_BAR;
        PG8_STAGE(PG8_SB(1, 0), cB + kstep, voffB); PG8_STAGE_A(PG8_SA(1, 0), cA + kstep, 0, false); PG8_STAGE(PG8_SB(1, 1), cB + hstep + kstep, voffB);
        PG8_WAIT_V(6); PG8_BAR;
    } else {
        PG8_STAGE(PG8_SB(0, 0), cB, voffB); PG8_STAGE(PG8_SA(0, 0), cA, voffA); PG8_STAGE(PG8_SB(0, 1), cB + hstep, voffB); PG8_STAGE(PG8_SA(0, 1), cA + hstep, voffA);
        if (wr == 1) PG8_BAR;
        PG8_WAIT_V(4); PG8_BAR;
        PG8_STAGE(PG8_SB(1, 0), cB + kstep, voffB); PG8_STAGE(PG8_SA(1, 0), cA + kstep, voffA); PG8_STAGE(PG8_SB(1, 1), cB + hstep + kstep, voffB);
        PG8_WAIT_V(6); PG8_BAR;
    }
    for (;;) {
        const bool has_next = S.next(ui + 1, nxt);
        const char* nA = GATHER ? cA : (has_next ? (const char*)g.A + (size_t)nxt.pm * tstep : cA); const char* nB = has_next ? (const char*)g.Bt + (size_t)nxt.pn * tstep : cB;
        if constexpr (GATHER) { if (has_next) PG8_GOFF(gN, nxt.pm); }
        for (int t = 0; t < nt; t += 2) {
            const bool last = (t == nt - 2);
            const char* a1 = cA + (size_t)(t + 1) * kstep;
            const char* a2 = last ? nA : cA + (size_t)(t + 2) * kstep; const char* b2 = last ? nB : cB + (size_t)(t + 2) * kstep;
            const char* a3 = a2 + kstep; const char* b3 = b2 + kstep;
            if (last && has_next) S.a_ready(nxt);
            if constexpr (SP2) {
            PG8_LDB(B0, 0, 0); PG8_LDB(B1, 0, 1); PG8_SCHED; PG8_LDA(At, 0, 0); PG8_STAGE_A(PG8_SA(1, 1), a1, 1, false);
            PG8_WAIT_V(8); PG8_WAIT_L(0); PG8_BAR; PG8_MMA(0, 0, At, B0); PG8_MMA(0, 1, At, B1); PG8_BAR; PG8_SCHED;
            PG8_LDA(At, 0, 1); PG8_STAGE(PG8_SB(0, 0), b2, voffB); PG8_STAGE(PG8_SB(0, 1), b2 + hstep, voffB); PG8_STAGE_A(PG8_SA(0, 0), a2, 0, last);
            PG8_WAIT_V(8); PG8_WAIT_L(0); PG8_BAR; PG8_MMA(1, 0, At, B0); PG8_MMA(1, 1, At, B1); PG8_BAR; PG8_SCHED;
            PG8_LDB(B0, 1, 0); PG8_LDB(B1, 1, 1); PG8_SCHED; PG8_LDA(At, 1, 0); PG8_STAGE_A(PG8_SA(0, 1), a2, 1, last);
            PG8_WAIT_V(8); PG8_WAIT_L(0); PG8_BAR; PG8_MMA(0, 0, At, B0); PG8_MMA(0, 1, At, B1); PG8_BAR; PG8_SCHED;
            PG8_LDA(At, 1, 1); PG8_STAGE(PG8_SB(1, 0), b3, voffB); PG8_STAGE(PG8_SB(1, 1), b3 + hstep, voffB); PG8_STAGE_A(PG8_SA(1, 0), a3, 0, last);
            PG8_WAIT_V(8); PG8_WAIT_L(0); PG8_BAR; PG8_MMA(1, 0, At, B0); PG8_MMA(1, 1, At, B1); PG8_BAR; PG8_SCHED;
            } else {
            PG8_LDB(B0, 0, 0); PG8_SCHED; PG8_LDA(At, 0, 0); PG8_STAGE(PG8_SA(1, 1), a1 + hstep, voffA);
            PG8_WAIT_L(8); PG8_BAR; PG8_WAIT_L(0); PG8_MMA(0, 0, At, B0); PG8_BAR; PG8_SCHED;
            PG8_LDB(B1, 0, 1); PG8_STAGE(PG8_SB(0, 0), b2, voffB);
            PG8_BAR; PG8_WAIT_L(0); PG8_MMA(0, 1, At, B1); PG8_BAR;
            PG8_LDA(At, 0, 1); PG8_STAGE(PG8_SA(0, 0), a2, voffA);
            PG8_BAR; PG8_WAIT_L(0); PG8_MMA(1, 0, At, B0); PG8_BAR; PG8_SCHED;
            PG8_STAGE(PG8_SB(0, 1), b2 + hstep, voffB);
            PG8_WAIT_V(6); PG8_BAR; PG8_MMA(1, 1, At, B1); PG8_BAR;
            PG8_LDB(B0, 1, 0); PG8_SCHED; PG8_LDA(At, 1, 0); PG8_STAGE(PG8_SA(0, 1), a2 + hstep, voffA);
            PG8_WAIT_L(8); PG8_BAR; PG8_WAIT_L(0); PG8_MMA(0, 0, At, B0); PG8_BAR; PG8_SCHED;
            PG8_LDB(B1, 1, 1); PG8_STAGE(PG8_SB(1, 0), b3, voffB);
            PG8_BAR; PG8_WAIT_L(0); PG8_MMA(0, 1, At, B1); PG8_BAR;
            PG8_LDA(At, 1, 1); PG8_STAGE(PG8_SA(1, 0), a3, voffA);
            PG8_BAR; PG8_WAIT_L(0); PG8_MMA(1, 0, At, B0); PG8_BAR; PG8_SCHED;
            PG8_STAGE(PG8_SB(1, 1), b3 + hstep, voffB);
            PG8_WAIT_V(6); PG8_BAR; PG8_MMA(1, 1, At, B1); PG8_BAR;
            }
        }
        if constexpr (ALIGN_EPI) { if (wr == 0) PG8_BAR; }
        if constexpr (!Epi::AFTER_DRAIN) { E(acc, cur, wr, wc, fr, fq); S.done(cur); }
        if (!has_next) break;
#pragma unroll
        for (int a = 0; a < 2; ++a)
#pragma unroll
            for (int b = 0; b < 2; ++b)
#pragma unroll
                for (int m = 0; m < 4; ++m)
#pragma unroll
                    for (int n = 0; n < 2; ++n) acc[a][b][m][n] = (f32x4){0.f, 0.f, 0.f, 0.f};
        cur = nxt; cA = nA; cB = nB; ++ui;
        if constexpr (GATHER) { _Pragma("unroll") for (int _h = 0; _h < 2; ++_h) _Pragma("unroll") for (int _i = 0; _i < 2; ++_i) gC[_h][_i] = gN[_h][_i]; }
        if constexpr (ALIGN_EPI) { if (wr == 1) PG8_BAR; }
    }
    PG8_WAIT_V(0);
    if constexpr (!ALIGN_EPI) { if (wr == 0) PG8_BAR; }
    PG8_BAR;
    if constexpr (Epi::AFTER_DRAIN) { E.fused(acc, cur, wr, wc, fr, fq, lds, wid, lane); S.done(cur); }
#undef PG8_SA
#undef PG8_SB
#undef PG8_STAGE
#undef PG8_STAGE_A
#undef PG8_GOFF
#undef PG8_LDA
#undef PG8_LDB
#undef PG8_MMA
#undef PG8_WAIT_V
#undef PG8_WAIT_L
#undef PG8_BAR
#undef PG8_SCHED
}
}

using pg8::bf16_t; using pg8::bf16x8; using pg8::f32x4; using pg8::u32x4; using pg8::u32x2;
#define LAS __attribute__((address_space(3)))
typedef short bf16x4 __attribute__((ext_vector_type(4)));

constexpr int NB = 4, SEQ = 4096, DM = 1024, MTOK = NB * SEQ, DIN = 2048, NE = 16, FF = 2048, CAP = 512, NROWX = NE * NB * CAP;
constexpr float ALPHA = 1.41421356237309515f, LN_EPS = 1e-5f;
constexpr int NWAVES = 8, NTHR = 512;
constexpr int LDS_BYTES = 147456;
constexpr int S5T = 32, S5NCH = SEQ / S5T;

constexpr size_t MiB = 1u << 20;
constexpr size_t WS_WIN = 0, WS_WOUT = 8 * MiB, WS_WGLU = 12 * MiB, WS_S5TAB = 13 * MiB, WS_AFFT = 14 * MiB, WS_IDX = 15 * MiB, WS_GATE = 16 * MiB, WS_SLOT = 17 * MiB, WS_BAR = 18 * MiB, WS_S5BT = 19 * MiB, WS_S5CT = 20 * MiB;
constexpr size_t WS_WGU = 32 * MiB, WS_WD = 288 * MiB, WS_H32 = 416 * MiB, WS_HBF = 480 * MiB, WS_RA = 512 * MiB  , WS_RB = 576 * MiB  ;
constexpr size_t WS_HDN = 640 * MiB, WS_KVF = 768 * MiB, WS_KVB = 776 * MiB, WS_STF = 784 * MiB, WS_STB = 792 * MiB, WS_S5E = 800 * MiB, WS_S5C = 808 * MiB, WS_END = 816 * MiB;

struct Args { const float* in[25]; float* out; unsigned char* ws; int ph_lo, ph_hi; };

typedef __bf16 bf16x2_hw __attribute__((ext_vector_type(2)));
typedef float f32x2_hw __attribute__((ext_vector_type(2)));
__device__ __forceinline__ unsigned pk2(float lo, float hi) { const f32x2_hw v = {lo, hi}; const bf16x2_hw b = __builtin_convertvector(v, bf16x2_hw); return __builtin_bit_cast(unsigned, b); }
__device__ __forceinline__ unsigned f2bf(float f) { return pk2(f, 0.f) & 0xffffu; }
__device__ __forceinline__ float bflo(unsigned w) { return __uint_as_float(w << 16); }
__device__ __forceinline__ float bfhi(unsigned w) { return __uint_as_float(w & 0xffff0000u); }
__device__ __forceinline__ f32x4 mfma16(bf16x8 a, bf16x8 b, f32x4 c) { return __builtin_amdgcn_mfma_f32_16x16x32_bf16(a, b, c, 0, 0, 0); }
__device__ __forceinline__ float wave_sum(float v) {
#pragma unroll
    for (int o = 1; o < 64; o <<= 1) v += __shfl_xor(v, o);
    return v;
}
__device__ __forceinline__ bf16x8 pack8(const f32x4& a, const f32x4& b) {
    u32x4 w; w.x = pk2(a[0], a[1]); w.y = pk2(a[2], a[3]); w.z = pk2(b[0], b[1]); w.w = pk2(b[2], b[3]);
    return __builtin_bit_cast(bf16x8, w);
}
__device__ __forceinline__ bf16x8 cat8(bf16x4 lo, bf16x4 hi) { bf16x8 r; r[0] = lo[0]; r[1] = lo[1]; r[2] = lo[2]; r[3] = lo[3]; r[4] = hi[0]; r[5] = hi[1]; r[6] = hi[2]; r[7] = hi[3]; return r; }
#define LDS_WAIT() asm volatile("s_waitcnt lgkmcnt(0)" ::: "memory")

struct ConvItem { const float* srcp; bf16_t* dstp; int N; int rstep; };
__device__ __forceinline__ ConvItem conv_decode(const Args& a, int it, int lane) {
    constexpr int I3 = 16384, I4 = 16384, I5 = 16384, I0 = 1024, I1 = 512;
    unsigned char* ws = a.ws;
    const float* src; bf16_t* dst; int K, N, rmul = 1, ro = 0, kb, nb;
    int r = it;
    if (r < I3 + I4) { const int up = r >= I3; r -= up ? I3 : 0; const int mat = r >> 9, q = r & 511; src = (up ? a.in[21] : a.in[20]) + (size_t)mat * DM * FF; dst = (bf16_t*)(ws + WS_WGU) + (size_t)mat * 2 * FF * DM; K = DM; N = FF; rmul = 2; ro = up; kb = q >> 5; nb = q & 31; }
    else { r -= I3 + I4;
        if (r < I5) { const int mat = r >> 9, q = r & 511; src = a.in[22] + (size_t)mat * FF * DM; dst = (bf16_t*)(ws + WS_WD) + (size_t)mat * DM * FF; K = FF; N = DM; kb = q >> 4; nb = q & 15; }
        else { r -= I5;
            if (r < I0) { const int mat = r >> 9, q = r & 511; src = a.in[3] + (size_t)mat * DM * DIN; dst = (bf16_t*)(ws + WS_WIN) + (size_t)mat * DIN * DM; K = DM; N = DIN; kb = q >> 5; nb = q & 31; }
            else { r -= I0;
                if (r < I1) { const int mat = r >> 8, q = r & 255; src = a.in[16] + (size_t)mat * DM * DM; dst = (bf16_t*)(ws + WS_WOUT) + (size_t)mat * DM * DM; K = DM; N = DM; kb = q >> 4; nb = q & 15; }
                else { r -= I1; const int mat = r >> 4, q = r & 15; src = a.in[13] + (size_t)mat * 65536; dst = (bf16_t*)(ws + WS_WGLU) + (size_t)mat * 65536; K = 256; N = 256; kb = q >> 2; nb = q & 3; } } } }
    ConvItem c; c.N = N;
    c.srcp = src + (size_t)(kb * 64 + (lane >> 4)) * N + nb * 64 + (lane & 15) * 4;
    if (rmul == 2) { c.dstp = dst + (size_t)((nb >> 1) * 256 + ro * 128 + (nb & 1) * 64) * K + kb * 64; c.rstep = K; }
    else { c.dstp = dst + (size_t)(nb * 64) * K + kb * 64; c.rstep = K; }
    return c;
}
__device__ __forceinline__ void conv_load(const ConvItem& c, f32x4 (&v)[16]) {
#pragma unroll
    for (int i = 0; i < 16; ++i) v[i] = __builtin_nontemporal_load((const f32x4*)(c.srcp + (size_t)(i * 4) * c.N));
}
__device__ __forceinline__ void conv_store(const ConvItem& c, const f32x4 (&v)[16], LAS float* scr, int lane) {
    const int r4 = lane >> 4, c4 = (lane & 15) * 4;
#pragma unroll
    for (int i = 0; i < 16; ++i) { const int kk = i * 4 + r4; *(LAS f32x4*)(scr + kk * 68 + (c4 ^ (((kk >> 3) & 7) * 4))) = v[i]; }
    LDS_WAIT();
    const int cc = lane & 7, nl = lane >> 3;
#pragma unroll
    for (int p = 0; p < 8; ++p) {
        const int n = nl + 8 * p;
        const LAS float* s = scr + (8 * cc) * 68 + (n ^ (4 * cc));
        u32x4 o; o.x = pk2(s[0], s[68]); o.y = pk2(s[2 * 68], s[3 * 68]); o.z = pk2(s[4 * 68], s[5 * 68]); o.w = pk2(s[6 * 68], s[7 * 68]);
        *(u32x4*)(c.dstp + (size_t)n * c.rstep + 8 * cc) = o;
    }
    LDS_WAIT();
}
__device__ __forceinline__ void sincos_rev(double f, double& sn, double& cs) {
    const double a = f * 6.283185307179586476925;
    const double q = rint(a * 0.636619772367581343);
    const double r = a - q * 1.570796326794896619;
    const double r2 = r * r;
    double s = -7.6471637318198164759e-13; s = s * r2 + 1.6059043836821614599e-10; s = s * r2 - 2.5052108385441718775e-8; s = s * r2 + 2.7557319223985890653e-6;
    s = s * r2 - 1.9841269841269841270e-4; s = s * r2 + 8.3333333333333333333e-3; s = s * r2 - 1.6666666666666666667e-1; s = s * r2 * r + r;
    double c = 4.7794773323873852974e-14; c = c * r2 - 1.1470745597729724714e-11; c = c * r2 + 2.0876756987868098979e-9; c = c * r2 - 2.7557319223985890653e-7;
    c = c * r2 + 2.4801587301587301587e-5; c = c * r2 - 1.3888888888888888889e-3; c = c * r2 + 4.1666666666666666667e-2; c = c * r2 - 0.5; c = c * r2 + 1.0;
    const int qi = ((int)q) & 3;
    sn = (qi == 0) ? s : (qi == 1) ? c : (qi == 2) ? -s : -c;
    cs = (qi == 0) ? c : (qi == 1) ? -s : (qi == 2) ? -c : s;
}
__device__ __forceinline__ double exp_small(double x) {
    const double y = x * (1.0 / 64.0);
    double e = 1.0 / 479001600.0;
    e = e * y + 1.0 / 39916800.0; e = e * y + 1.0 / 3628800.0; e = e * y + 1.0 / 362880.0; e = e * y + 1.0 / 40320.0; e = e * y + 1.0 / 5040.0; e = e * y + 1.0 / 720.0;
    e = e * y + 1.0 / 120.0; e = e * y + 1.0 / 24.0; e = e * y + 1.0 / 6.0; e = e * y + 0.5; e = e * y + 1.0; e = e * y + 1.0;
#pragma unroll
    for (int i = 0; i < 6; ++i) e = e * e;
    return e;
}
__device__ __forceinline__ void s5_coefs(const Args& a, int t, double& br, double& bi, double& cr, double& ci, double& tr, double& ti) {
    const int g = (t >> 6) & 15, lr = t >> 10;
    const double lre = (double)a.in[5][t], lim = (double)a.in[6][t];
    const double step = exp_small((double)a.in[7][lr * 16 + g]);
    const double ar = lre * step, th = lim * step;
    const double rev = th * 0.15915494309189533577; const double fr = rev - rint(rev);
    double sn, cs; sincos_rev(fr, sn, cs);
    const double mag = exp_small(ar);
    br = mag * cs; bi = mag * sn;
    const double nr = br - 1.0, ni = bi, den = lre * lre + lim * lim;
    cr = (nr * lre + ni * lim) / den; ci = (ni * lre - nr * lim) / den;
    const double rev2 = rev * (double)S5T; const double fr2 = rev2 - rint(rev2);
    double sn2, cs2; sincos_rev(fr2, sn2, cs2);
    const double mag2 = exp_small(ar * (double)S5T);
    tr = mag2 * cs2; ti = mag2 * sn2;
}
__device__ __forceinline__ void s5_table_entry(const Args& a, int t) {
    double br, bi, cr, ci, tr, ti; s5_coefs(a, t, br, bi, cr, ci, tr, ti);
    float* o = (float*)(a.ws + WS_S5TAB) + (size_t)t * 8;
    o[0] = (float)br; o[1] = (float)bi; o[2] = (float)cr; o[3] = (float)ci; o[4] = (float)tr; o[5] = (float)ti; o[6] = 0.f; o[7] = 0.f;
}
__device__ __forceinline__ void s5_bt_row(const Args& a, int t) {
    const int l = t >> 12, g = (t >> 8) & 15, n = t & 255, r = n >> 7, p = (n >> 1) & 63, ri = n & 1;
    double br, bi, cr, ci, tr, ti; s5_coefs(a, ((l * 2 + r) * 16 + g) * 64 + p, br, bi, cr, ci, tr, ti);
    const float crf = (float)cr, cif = (float)ci;
    const float* bre = a.in[8] + (size_t)((l * 16 + g) * 64 + p) * 16; const float* bim = a.in[9] + (size_t)((l * 16 + g) * 64 + p) * 16;
    u32x4 o[2];
#pragma unroll
    for (int h = 0; h < 2; ++h) {
        const f32x4 x0 = *(const f32x4*)(bre + 8 * h), x1 = *(const f32x4*)(bre + 8 * h + 4), y0 = *(const f32x4*)(bim + 8 * h), y1 = *(const f32x4*)(bim + 8 * h + 4);
        float v[8];
#pragma unroll
        for (int k = 0; k < 4; ++k) { v[k] = ri ? (crf * y0[k] + cif * x0[k]) : (crf * x0[k] - cif * y0[k]); v[4 + k] = ri ? (crf * y1[k] + cif * x1[k]) : (crf * x1[k] - cif * y1[k]); }
        o[h].x = pk2(v[0], v[1]); o[h].y = pk2(v[2], v[3]); o[h].z = pk2(v[4], v[5]); o[h].w = pk2(v[6], v[7]);
    }
    u32x4* dst = (u32x4*)((bf16_t*)(a.ws + WS_S5BT) + (size_t)t * 32);
    dst[0] = o[0]; dst[1] = o[1]; dst[2] = (u32x4){0u, 0u, 0u, 0u}; dst[3] = (u32x4){0u, 0u, 0u, 0u};
}
__device__ __forceinline__ void s5_ct_entry(const Args& a, int t) {
    const int p = t & 63, r = (t >> 6) & 1, c = (t >> 7) & 15, g = (t >> 11) & 15, l = t >> 15;
    const size_t ci = (size_t)(((l * 2 + r) * 16 + g) * 16 + c) * 64 + p;
    ((unsigned*)(a.ws + WS_S5CT))[t] = pk2(a.in[10][ci], -a.in[11][ci]);
}
__device__ __forceinline__ void ln_rows4(f32x4 (&v)[4], const float* __restrict__ g, const float* __restrict__ bt, int lane) {
    float s = 0.f;
#pragma unroll
    for (int j = 0; j < 4; ++j) s += (v[j][0] + v[j][1]) + (v[j][2] + v[j][3]);
    const float mean = wave_sum(s) * (1.f / DM); float s2 = 0.f;
#pragma unroll
    for (int j = 0; j < 4; ++j) { v[j] = v[j] - mean; s2 += (v[j][0] * v[j][0] + v[j][1] * v[j][1]) + (v[j][2] * v[j][2] + v[j][3] * v[j][3]); }
    const float rstd = 1.f / sqrtf(wave_sum(s2) * (1.f / DM) + LN_EPS);
#pragma unroll
    for (int j = 0; j < 4; ++j) { const f32x4 gv = ((const f32x4*)g)[lane + 64 * j], bv = ((const f32x4*)bt)[lane + 64 * j]; v[j] = v[j] * rstd * gv + bv; }
}
__device__ __forceinline__ void store_row(const f32x4 (&v)[4], float* o32, bf16_t* obf, int lane) {
#pragma unroll
    for (int j = 0; j < 4; ++j) {
        if (o32) ((f32x4*)o32)[lane + 64 * j] = v[j];
        if (obf) { u32x2 w; w.x = pk2(v[j][0], v[j][1]); w.y = pk2(v[j][2], v[j][3]); ((u32x2*)obf)[lane + 64 * j] = w; }
    }
}
__device__ __forceinline__ void phase_p0(const Args& a, LAS unsigned char* lds, int tid) {
    const int lane = tid & 63, wave = tid >> 6;
    const int gw = blockIdx.x * NWAVES + wave, NGW = gridDim.x * NWAVES;
    LAS float* scr = (LAS float*)(lds + wave * 17408);
    unsigned char* ws = a.ws;
    constexpr int NIT = 16384 * 3 + 1024 + 512 + 32;
    if (gw < NIT) {
        ConvItem cur = conv_decode(a, gw, lane);
        f32x4 v[16]; conv_load(cur, v);
        for (int it = gw; it < NIT; it += NGW) {
            const bool more = (it + NGW) < NIT;
            ConvItem nxt = cur; f32x4 vn[16];
            if (more) { nxt = conv_decode(a, it + NGW, lane); conv_load(nxt, vn); }
            conv_store(cur, v, scr, lane);
            if (more) { cur = nxt;
#pragma unroll
                for (int i = 0; i < 16; ++i) v[i] = vn[i]; }
        }
    }
    for (int t = blockIdx.x * NTHR + tid; t < 4096; t += gridDim.x * NTHR) s5_table_entry(a, t);
    for (int t = blockIdx.x * NTHR + tid; t < 8192; t += gridDim.x * NTHR) s5_bt_row(a, t);
    for (int t = blockIdx.x * NTHR + tid; t < 65536; t += gridDim.x * NTHR) s5_ct_entry(a, t);
    for (int m = gw; m < MTOK; m += NGW) {
        f32x4 v[4];
#pragma unroll
        for (int j = 0; j < 4; ++j) v[j] = ((const f32x4*)(a.in[0] + (size_t)m * DM))[lane + 64 * j];
        ln_rows4(v, a.in[1], a.in[2], lane);
        store_row(v, nullptr, (bf16_t*)(ws + WS_HBF) + (size_t)m * DM, lane);
    }
}

__device__ __forceinline__ void attn_item(int item, const bf16_t* __restrict__ proj, bf16_t* __restrict__ mix, const float* __restrict__ sink_l, LAS unsigned char* lds, int tid) {
    const int kh = item & 1, c = (item >> 1) & 31, b = item >> 6;
    constexpr int VS = 408;
    LAS bf16_t* Ks = (LAS bf16_t*)lds;
    LAS bf16_t* Vt = (LAS bf16_t*)(lds + 384 * 72 * 2);
    const int lane = tid & 63, w = tid >> 6, fr = lane & 15, fq = lane >> 4;
    const int hq = kh * 4 + (w >> 1);
    const bf16_t* qbase = proj + ((size_t)b * SEQ + c * 128 + (w & 1) * 64 + fr) * DIN + 1280 + hq * 64 + fq * 8;
    bf16x8 qn0 = *(const bf16x8*)qbase, qn1 = *(const bf16x8*)(qbase + 32);
#pragma unroll
    for (int i = 0; i < 6; ++i) {
        const int id = tid + NTHR * i, key = id >> 3, ch = id & 7;
        const int s = (c - 1) * 128 + key; const bool ok = (s >= 0) && (s < SEQ);
        u32x4 kv = {0u, 0u, 0u, 0u}, vv = {0u, 0u, 0u, 0u};
        if (ok) { const bf16_t* rowp = proj + (size_t)(b * SEQ + s) * DIN; kv = *(const u32x4*)(rowp + 1792 + kh * 64 + ch * 8); vv = *(const u32x4*)(rowp + 1920 + kh * 64 + ch * 8); }
        *(LAS u32x4*)(Ks + key * 72 + ch * 8) = kv;
        LAS bf16_t* vp = Vt + (ch * 8) * VS + key;
        vp[0 * VS] = (bf16_t)(vv.x & 0xffffu); vp[1 * VS] = (bf16_t)(vv.x >> 16); vp[2 * VS] = (bf16_t)(vv.y & 0xffffu); vp[3 * VS] = (bf16_t)(vv.y >> 16);
        vp[4 * VS] = (bf16_t)(vv.z & 0xffffu); vp[5 * VS] = (bf16_t)(vv.z >> 16); vp[6 * VS] = (bf16_t)(vv.w & 0xffffu); vp[7 * VS] = (bf16_t)(vv.w >> 16);
    }
    if (tid < 128) { const int d = tid >> 1, hh = tid & 1; *(LAS u32x4*)(Vt + d * VS + 384 + hh * 8) = (u32x4){0u, 0u, 0u, 0u}; }
    __syncthreads();
    const float slope = exp2f(-(float)(hq + 1));
    const float sinkv = sink_l[hq];
    const bool lo_ok = (c >= 1), hi_ok = (c <= 30);
    float plo[4], phi[4];
#pragma unroll
    for (int j = 0; j < 4; ++j) { plo[j] = (fq * 4 + j >= fr) ? 0.f : -1e30f; phi[j] = (fq * 4 + j <= fr) ? 0.f : -1e30f; }
#pragma unroll 1
    for (int qi = 0; qi < 4; ++qi) {
        const int qt = (w & 1) * 4 + qi;
        const size_t tok = (size_t)b * SEQ + c * 128 + qt * 16 + fr;
        const bf16x8 qa0 = qn0, qa1 = qn1;
        float slope_l = slope; asm volatile("" : "+v"(slope_l));
        float sd[4];
#pragma unroll
        for (int j = 0; j < 4; ++j) sd[j] = slope_l * (float)(fq * 4 + j - fr);
        if (qi < 3) { const bf16_t* qp = qbase + (size_t)(qi + 1) * 16 * DIN; qn0 = *(const bf16x8*)qp; qn1 = *(const bf16x8*)(qp + 32); }
        f32x4 s[18];
        float mx = sinkv;
        const LAS bf16_t* kbase = Ks + (qt * 16 + fr) * 72 + fq * 8;
        const LAS bf16_t* vbase = Vt + fr * VS + qt * 16 + fq * 4;
#pragma unroll
        for (int i = 0; i < 17; ++i) {
            const int kt = qt + i;
            const LAS bf16_t* kp = kbase + i * (16 * 72);
            f32x4 acc = {0.f, 0.f, 0.f, 0.f};
            acc = mfma16(*(const LAS bf16x8*)kp, qa0, acc); acc = mfma16(*(const LAS bf16x8*)(kp + 32), qa1, acc);
            const float pblk = ((kt < 8) ? lo_ok : ((kt >= 16) ? hi_ok : true)) ? 0.f : -1e30f;
            const float base = slope_l * (float)(16 * i - 128);
#pragma unroll
            for (int j = 0; j < 4; ++j) {
                float t = (i < 8) ? (base + sd[j]) : ((i > 8) ? -(base + sd[j]) : -fabsf(sd[j]));
                if (i == 0) t += plo[j];
                if (i == 16) t += phi[j];
                const float v = fmaf(acc[j], 0.125f, t + pblk);
                acc[j] = v; mx = fmaxf(mx, v);
            }
            s[i] = acc;
        }
        mx = fmaxf(mx, __shfl_xor(mx, 16)); mx = fmaxf(mx, __shfl_xor(mx, 32));
        float sum = 0.f;
#pragma unroll
        for (int i = 0; i < 17; ++i)
#pragma unroll
            for (int j = 0; j < 4; ++j) { const float p = __expf(s[i][j] - mx); s[i][j] = p; sum += p; }
        s[17] = (f32x4){0.f, 0.f, 0.f, 0.f};
        sum += __shfl_xor(sum, 16); sum += __shfl_xor(sum, 32);
        const float inv = 1.f / (sum + __expf(sinkv - mx));
        f32x4 o[4];
#pragma unroll
        for (int dt = 0; dt < 4; ++dt) o[dt] = (f32x4){0.f, 0.f, 0.f, 0.f};
#pragma unroll
        for (int kk = 0; kk < 9; ++kk) {
            const bf16x8 pb = pack8(s[2 * kk], s[2 * kk + 1]);
#pragma unroll
            for (int dt = 0; dt < 4; ++dt) {
                const LAS bf16_t* vp = vbase + dt * (16 * VS) + kk * 32;
                o[dt] = mfma16(cat8(*(const LAS bf16x4*)vp, *(const LAS bf16x4*)(vp + 16)), pb, o[dt]);
            }
        }
        bf16_t* op = mix + tok * DM + 512 + hq * 64 + fq * 4;
#pragma unroll
        for (int dt = 0; dt < 4; ++dt) { u32x2 wv; wv.x = pk2(o[dt][0] * inv, o[dt][1] * inv); wv.y = pk2(o[dt][2] * inv, o[dt][3] * inv); *(u32x2*)(op + dt * 16) = wv; }
    }
    __syncthreads();
}

__device__ __forceinline__ float log_sigmoid(float t) { return -log1pf(__expf(-t)); }
__device__ __forceinline__ void retkv_item(int item, const bf16_t* __restrict__ proj, float* __restrict__ kvf, float* __restrict__ kvb, const float* __restrict__ theta, LAS unsigned char* lds, int tid) {
    const int h = item & 3, c = (item >> 2) & 31, b = item >> 7;
    const float lgf = log_sigmoid(theta[h]), lgb = log_sigmoid(theta[4 + h]);
    LAS bf16_t* KTf = (LAS bf16_t*)lds; LAS bf16_t* KTb = KTf + 64 * 136; LAS bf16_t* VT = KTb + 64 * 136;
#pragma unroll
    for (int i = 0; i < 2; ++i) {
        const int id = tid + NTHR * i, j = id >> 3, ch = id & 7;
        const bf16_t* rowp = proj + (size_t)(b * SEQ + c * 128 + j) * DIN;
        const u32x4 kr = *(const u32x4*)(rowp + 256 + h * 64 + ch * 8), vr = *(const u32x4*)(rowp + 512 + h * 64 + ch * 8);
        const float wf = __expf(lgf * (float)(127 - j)) * 0.125f, wb = __expf(lgb * (float)j) * 0.125f;
        const int o = (ch * 8) * 136 + j;
        KTf[o + 0 * 136] = (bf16_t)f2bf(bflo(kr.x) * wf); KTf[o + 1 * 136] = (bf16_t)f2bf(bfhi(kr.x) * wf); KTf[o + 2 * 136] = (bf16_t)f2bf(bflo(kr.y) * wf); KTf[o + 3 * 136] = (bf16_t)f2bf(bfhi(kr.y) * wf);
        KTf[o + 4 * 136] = (bf16_t)f2bf(bflo(kr.z) * wf); KTf[o + 5 * 136] = (bf16_t)f2bf(bfhi(kr.z) * wf); KTf[o + 6 * 136] = (bf16_t)f2bf(bflo(kr.w) * wf); KTf[o + 7 * 136] = (bf16_t)f2bf(bfhi(kr.w) * wf);
        KTb[o + 0 * 136] = (bf16_t)f2bf(bflo(kr.x) * wb); KTb[o + 1 * 136] = (bf16_t)f2bf(bfhi(kr.x) * wb); KTb[o + 2 * 136] = (bf16_t)f2bf(bflo(kr.y) * wb); KTb[o + 3 * 136] = (bf16_t)f2bf(bfhi(kr.y) * wb);
        KTb[o + 4 * 136] = (bf16_t)f2bf(bflo(kr.z) * wb); KTb[o + 5 * 136] = (bf16_t)f2bf(bfhi(kr.z) * wb); KTb[o + 6 * 136] = (bf16_t)f2bf(bflo(kr.w) * wb); KTb[o + 7 * 136] = (bf16_t)f2bf(bfhi(kr.w) * wb);
        VT[o + 0 * 136] = (bf16_t)(vr.x & 0xffffu); VT[o + 1 * 136] = (bf16_t)(vr.x >> 16); VT[o + 2 * 136] = (bf16_t)(vr.y & 0xffffu); VT[o + 3 * 136] = (bf16_t)(vr.y >> 16);
        VT[o + 4 * 136] = (bf16_t)(vr.z & 0xffffu); VT[o + 5 * 136] = (bf16_t)(vr.z >> 16); VT[o + 6 * 136] = (bf16_t)(vr.w & 0xffffu); VT[o + 7 * 136] = (bf16_t)(vr.w >> 16);
    }
    __syncthreads();
    const int lane = tid & 63, w = tid >> 6, fr = lane & 15, fq = lane >> 4;
    const size_t obase = (size_t)((b * 32 + c) * 4 + h) * 4096;
#pragma unroll
    for (int i = 0; i < 4; ++i) {
        const int job = w * 4 + i, dirb = job >> 4, et = (job >> 2) & 3, dt = job & 3;
        const LAS bf16_t* ap = VT + (et * 16 + fr) * 136 + fq * 8;
        const LAS bf16_t* bp = (dirb ? KTb : KTf) + (dt * 16 + fr) * 136 + fq * 8;
        f32x4 acc = {0.f, 0.f, 0.f, 0.f};
#pragma unroll
        for (int ks = 0; ks < 4; ++ks) acc = mfma16(*(const LAS bf16x8*)(ap + ks * 32), *(const LAS bf16x8*)(bp + ks * 32), acc);
        float* op = (dirb ? kvb : kvf) + obase + (et * 16 + fq * 4) * 64 + dt * 16 + fr;
        op[0] = acc[0]; op[64] = acc[1]; op[128] = acc[2]; op[192] = acc[3];
    }
    __syncthreads();
}
__device__ __forceinline__ void retout_item(int item, const bf16_t* __restrict__ proj, const float* __restrict__ stf, const float* __restrict__ stb, bf16_t* __restrict__ mix, const float* __restrict__ theta, LAS unsigned char* lds, int tid) {
    const int h = item & 3, c = (item >> 2) & 31, b = item >> 7;
    const float lgf = log_sigmoid(theta[h]), lgb = log_sigmoid(theta[4 + h]);
    LAS bf16_t* Qs = (LAS bf16_t*)lds; LAS bf16_t* Ks = Qs + 128 * 72; LAS bf16_t* VT = Ks + 128 * 72; LAS bf16_t* SFt = VT + 64 * 136; LAS bf16_t* SBt = SFt + 64 * 72;
#pragma unroll
    for (int i = 0; i < 2; ++i) {
        const int id = tid + NTHR * i, j = id >> 3, ch = id & 7;
        const bf16_t* rowp = proj + (size_t)(b * SEQ + c * 128 + j) * DIN;
        const u32x4 qr = *(const u32x4*)(rowp + h * 64 + ch * 8), kr = *(const u32x4*)(rowp + 256 + h * 64 + ch * 8), vr = *(const u32x4*)(rowp + 512 + h * 64 + ch * 8);
        *(LAS u32x4*)(Qs + j * 72 + ch * 8) = qr; *(LAS u32x4*)(Ks + j * 72 + ch * 8) = kr;
        const int o = (ch * 8) * 136 + j;
        VT[o + 0 * 136] = (bf16_t)(vr.x & 0xffffu); VT[o + 1 * 136] = (bf16_t)(vr.x >> 16); VT[o + 2 * 136] = (bf16_t)(vr.y & 0xffffu); VT[o + 3 * 136] = (bf16_t)(vr.y >> 16);
        VT[o + 4 * 136] = (bf16_t)(vr.z & 0xffffu); VT[o + 5 * 136] = (bf16_t)(vr.z >> 16); VT[o + 6 * 136] = (bf16_t)(vr.w & 0xffffu); VT[o + 7 * 136] = (bf16_t)(vr.w >> 16);
    }
    const size_t sbase = (size_t)((b * 32 + c) * 4 + h) * 4096;
#pragma unroll
    for (int i = 0; i < 8; ++i) { const int id = tid + NTHR * i, e = id >> 6, d = id & 63; SFt[e * 72 + d] = (bf16_t)f2bf(stf[sbase + id]); SBt[e * 72 + d] = (bf16_t)f2bf(stb[sbase + id]); }
    __syncthreads();
    const int lane = tid & 63, it = tid >> 6, fr = lane & 15, fq = lane >> 4;
    const int ipos = it * 16 + fr;
    const LAS bf16_t* qp = Qs + ipos * 72 + fq * 8;
    const bf16x8 qb0 = *(const LAS bf16x8*)qp, qb1 = *(const LAS bf16x8*)(qp + 32);
    f32x4 st[8];
#pragma unroll
    for (int jt = 0; jt < 8; ++jt) {
        const LAS bf16_t* kp = Ks + (jt * 16 + fr) * 72 + fq * 8;
        f32x4 acc = {0.f, 0.f, 0.f, 0.f};
        acc = mfma16(*(const LAS bf16x8*)kp, qb0, acc); acc = mfma16(*(const LAS bf16x8*)(kp + 32), qb1, acc);
#pragma unroll
        for (int jj = 0; jj < 4; ++jj) { const int dij = ipos - (jt * 16 + fq * 4 + jj); const float dec = dij >= 0 ? __expf(lgf * (float)dij) : __expf(lgb * (float)(-dij)); acc[jj] *= 0.125f * dec; }
        st[jt] = acc;
    }
    f32x4 o[4], ff[4], fb[4];
#pragma unroll
    for (int et = 0; et < 4; ++et) { o[et] = (f32x4){0.f, 0.f, 0.f, 0.f}; ff[et] = o[et]; fb[et] = o[et]; }
#pragma unroll
    for (int kk = 0; kk < 4; ++kk) {
        const bf16x8 pb = pack8(st[2 * kk], st[2 * kk + 1]);
#pragma unroll
        for (int et = 0; et < 4; ++et) { const LAS bf16_t* vp = VT + (et * 16 + fr) * 136 + kk * 32 + fq * 4; o[et] = mfma16(cat8(*(const LAS bf16x4*)vp, *(const LAS bf16x4*)(vp + 16)), pb, o[et]); }
    }
#pragma unroll
    for (int et = 0; et < 4; ++et) {
        const LAS bf16_t* fp = SFt + (et * 16 + fr) * 72 + fq * 8; const LAS bf16_t* bp = SBt + (et * 16 + fr) * 72 + fq * 8;
        ff[et] = mfma16(*(const LAS bf16x8*)fp, qb0, ff[et]); ff[et] = mfma16(*(const LAS bf16x8*)(fp + 32), qb1, ff[et]);
        fb[et] = mfma16(*(const LAS bf16x8*)bp, qb0, fb[et]); fb[et] = mfma16(*(const LAS bf16x8*)(bp + 32), qb1, fb[et]);
    }
    const float cf = __expf(lgf * (float)(ipos + 1)), cb = __expf(lgb * (float)(128 - ipos));
    float s = 0.f;
#pragma unroll
    for (int et = 0; et < 4; ++et) { o[et] = o[et] + ff[et] * cf + fb[et] * cb; s += (o[et][0] + o[et][1]) + (o[et][2] + o[et][3]); }
    s += __shfl_xor(s, 16); s += __shfl_xor(s, 32);
    const float mean = s * (1.f / 64.f); float s2 = 0.f;
#pragma unroll
    for (int et = 0; et < 4; ++et) { o[et] = o[et] - mean; s2 += (o[et][0] * o[et][0] + o[et][1] * o[et][1]) + (o[et][2] * o[et][2] + o[et][3] * o[et][3]); }
    s2 += __shfl_xor(s2, 16); s2 += __shfl_xor(s2, 32);
    const float rstd = 1.f / sqrtf(s2 * (1.f / 64.f) + LN_EPS);
    const size_t tok = (size_t)b * SEQ + c * 128 + ipos;
    const bf16_t* gp = proj + tok * DIN + 768 + h * 64 + fq * 4;
    bf16_t* op = mix + tok * DM + h * 64 + fq * 4;
#pragma unroll
    for (int et = 0; et < 4; ++et) {
        const u32x2 gr = *(const u32x2*)(gp + et * 16);
        const float g0 = bflo(gr.x), g1 = bfhi(gr.x), g2 = bflo(gr.y), g3 = bfhi(gr.y);
        const float y0 = o[et][0] * rstd * (g0 / (1.f + __expf(-g0))), y1 = o[et][1] * rstd * (g1 / (1.f + __expf(-g1)));
        const float y2 = o[et][2] * rstd * (g2 / (1.f + __expf(-g2))), y3 = o[et][3] * rstd * (g3 / (1.f + __expf(-g3)));
        u32x2 wv; wv.x = pk2(y0, y1); wv.y = pk2(y2, y3); *(u32x2*)(op + et * 16) = wv;
    }
    __syncthreads();
}

constexpr int S5XS = 136;
struct S5Pass { bf16x8 bf[8]; f32x4 t0; };
__device__ __forceinline__ void s5_fetch(S5Pass& P, const float* __restrict__ tab, const bf16_t* __restrict__ BT, int g, int r, int lane) {
    const int fr = lane & 15, fq = lane >> 4;
    P.t0 = *(const f32x4*)(tab + (size_t)((r * 16 + g) * 64 + lane) * 8);
    const bf16_t* btp = BT + (size_t)(g * 256 + r * 128 + fr) * 32 + fq * 8;
#pragma unroll
    for (int nt = 0; nt < 8; ++nt) P.bf[nt] = *(const bf16x8*)(btp + nt * 16 * 32);
}
__device__ __forceinline__ void s5_bu(LAS bf16_t* Xw, const S5Pass& P, bf16x8 uf0, bf16x8 uf1, int lane) {
    const int fr = lane & 15, fq = lane >> 4;
#pragma unroll
    for (int mt = 0; mt < 2; ++mt)
#pragma unroll
        for (int nt = 0; nt < 8; ++nt) {
            f32x4 acc = {0.f, 0.f, 0.f, 0.f};
            acc = mfma16(P.bf[nt], mt ? uf1 : uf0, acc);
            u32x2 wv; wv.x = pk2(acc[0], acc[1]); wv.y = pk2(acc[2], acc[3]);
            *(LAS u32x2*)(Xw + (mt * 16 + fr) * S5XS + nt * 16 + fq * 4) = wv;
        }
    asm volatile("s_waitcnt lgkmcnt(0)" ::: "memory");
}
template <bool WRITE>
__device__ __forceinline__ void s5_recur(LAS bf16_t* xq, int r, float lr_, float li_, float& xr, float& xi) {
#pragma unroll 1
    for (int blk = 0; blk < 4; ++blk) {
        LAS bf16_t* q = xq + (r ? (3 - blk) : blk) * (8 * S5XS);
        unsigned bw[8];
#pragma unroll
        for (int k = 0; k < 8; ++k) bw[k] = *(const LAS unsigned*)(q + k * S5XS);
        if (r == 0) {
#pragma unroll
            for (int s = 0; s < 8; ++s) {
                const float nr = fmaf(lr_, xr, fmaf(-li_, xi, bflo(bw[s]))), ni = fmaf(lr_, xi, fmaf(li_, xr, bfhi(bw[s])));
                xr = nr; xi = ni;
                if (WRITE) *(LAS unsigned*)(q + s * S5XS) = pk2(xr, xi);
            }
        } else {
#pragma unroll
            for (int s = 7; s >= 0; --s) {
                const float nr = fmaf(lr_, xr, fmaf(-li_, xi, bflo(bw[s]))), ni = fmaf(lr_, xi, fmaf(li_, xr, bfhi(bw[s])));
                xr = nr; xi = ni;
                if (WRITE) *(LAS unsigned*)(q + s * S5XS) = pk2(xr, xi);
            }
        }
    }
    if (WRITE) asm volatile("s_waitcnt lgkmcnt(0)" ::: "memory");
}
__device__ __forceinline__ void s5_ufrag(const bf16_t* __restrict__ proj, int b, int ch, int g, int lane, bf16x8& uf0, bf16x8& uf1) {
    const int fr = lane & 15, fq = lane >> 4;
    uf0 = (bf16x8){0, 0, 0, 0, 0, 0, 0, 0}; uf1 = uf0;
    if (fq < 2) { const bf16_t* up = proj + (size_t)(b * SEQ + ch * S5T + fr) * DIN + 1024 + g * 16 + fq * 8; uf0 = *(const bf16x8*)up; uf1 = *(const bf16x8*)(up + (size_t)16 * DIN); }
}

__device__ __forceinline__ void s5e_item(int item, const bf16_t* __restrict__ proj, const float* __restrict__ tab  , const bf16_t* __restrict__ BT,
                                         float* __restrict__ E, LAS unsigned char* lds, int tid) {
    const int ch = item & (S5NCH - 1), b = item / S5NCH;
    const int lane = tid & 63, w = tid >> 6;
    LAS bf16_t* Xw = (LAS bf16_t*)lds + w * (32 * S5XS);
    S5Pass cur;
    s5_fetch(cur, tab, BT, w, 0, lane);
    bf16x8 uf0, uf1;
    s5_ufrag(proj, b, ch, w, lane, uf0, uf1);
#pragma unroll 1
    for (int ps = 0; ps < 4; ++ps) {
        const int g = w + 8 * (ps >> 1), r = ps & 1;
        const float lr_ = cur.t0[0], li_ = cur.t0[1];
        s5_bu(Xw, cur, uf0, uf1, lane);
        if (ps < 3) s5_fetch(cur, tab, BT, w + 8 * ((ps + 1) >> 1), (ps + 1) & 1, lane);
        if (ps == 1) s5_ufrag(proj, b, ch, w + 8, lane, uf0, uf1);
        float xr = 0.f, xi = 0.f;
        s5_recur<false>(Xw + lane * 2, r, lr_, li_, xr, xi);
        float2 ev; ev.x = xr; ev.y = xi;
        ((float2*)E)[(size_t)(((b * S5NCH + ch) * 16 + g) * 2 + r) * 64 + lane] = ev;
        asm volatile("s_waitcnt lgkmcnt(0)" ::: "memory");
    }
    __syncthreads();
}
__device__ __forceinline__ void s5out_item(int item, const bf16_t* __restrict__ proj, const float* __restrict__ tab, const bf16_t* __restrict__ BT,
                                           const bf16_t* __restrict__ CT  , const float* __restrict__ dvec, const bf16_t* __restrict__ wgluT, const float* __restrict__ bglu,
                                           const float* __restrict__ CIN, bf16_t* __restrict__ mix, LAS unsigned char* lds, int tid) {
    const int ch = item & (S5NCH - 1), b = item / S5NCH;
    constexpr int YS = 264;
    const int lane = tid & 63, w = tid >> 6, fr = lane & 15, fq = lane >> 4;
    LAS bf16_t* Xw = (LAS bf16_t*)lds + w * (32 * S5XS);
    LAS bf16_t* Y = (LAS bf16_t*)(lds + 8 * 32 * S5XS * 2);
    S5Pass cur; bf16x8 ccf[4]; float2 ccin;
    s5_fetch(cur, tab, BT, w, 0, lane);
    ccin = ((const float2*)CIN)[(size_t)(((b * S5NCH + ch) * 16 + w) * 2 + 0) * 64 + lane];
#pragma unroll
    for (int ks = 0; ks < 4; ++ks) ccf[ks] = *(const bf16x8*)(CT + (size_t)(w * 16 + fr) * 256 + ks * 32 + fq * 8);
    bf16x8 uf0, uf1;
    s5_ufrag(proj, b, ch, w, lane, uf0, uf1);
    f32x4 ya0 = {0.f, 0.f, 0.f, 0.f}, ya1 = ya0;
#pragma unroll 1
    for (int ps = 0; ps < 4; ++ps) {
        const int g = w + 8 * (ps >> 1), r = ps & 1;
        const int gn = w + 8 * ((ps + 1) >> 1), rn = (ps + 1) & 1;
        const float lr_ = cur.t0[0], li_ = cur.t0[1];
        s5_bu(Xw, cur, uf0, uf1, lane);
        if (ps < 3) s5_fetch(cur, tab, BT, gn, rn, lane);
        if (ps == 1) s5_ufrag(proj, b, ch, w + 8, lane, uf0, uf1);
        float xr = ccin.x, xi = ccin.y;
        s5_recur<true>(Xw + lane * 2, r, lr_, li_, xr, xi);
        if (ps < 3) ccin = ((const float2*)CIN)[(size_t)(((b * S5NCH + ch) * 16 + gn) * 2 + rn) * 64 + lane];
#pragma unroll
        for (int ks = 0; ks < 4; ++ks) {
            ya0 = mfma16(ccf[ks], *(const LAS bf16x8*)(Xw + fr * S5XS + ks * 32 + fq * 8), ya0);
            ya1 = mfma16(ccf[ks], *(const LAS bf16x8*)(Xw + (16 + fr) * S5XS + ks * 32 + fq * 8), ya1);
        }
        if (ps < 3) {
#pragma unroll
            for (int ks = 0; ks < 4; ++ks) ccf[ks] = *(const bf16x8*)(CT + (size_t)(gn * 16 + fr) * 256 + rn * 128 + ks * 32 + fq * 8);
        }
        if (r == 1) {
            const int chn = g * 16 + fq * 4;
            const f32x4 dv = *(const f32x4*)(dvec + chn);
#pragma unroll
            for (int mt = 0; mt < 2; ++mt) {
                const int s = mt * 16 + fr;
                const u32x2 uw = *(const u32x2*)(proj + (size_t)(b * SEQ + ch * S5T + s) * DIN + 1024 + chn);
                const float uu[4] = {bflo(uw.x), bfhi(uw.x), bflo(uw.y), bfhi(uw.y)};
                float gl4[4];
#pragma unroll
                for (int jj = 0; jj < 4; ++jj) {
                    const float yv = (mt ? ya1[jj] : ya0[jj]) + dv[jj] * uu[jj];
                    const float t = 0.7978845608028654f * (yv + 0.044715f * yv * yv * yv);
                    gl4[jj] = yv * (1.f - __builtin_amdgcn_rcpf(1.f + __expf(2.f * t)));
                }
                u32x2 yw; yw.x = pk2(gl4[0], gl4[1]); yw.y = pk2(gl4[2], gl4[3]);
                *(LAS u32x2*)(Y + s * YS + chn) = yw;
            }
            ya0 = (f32x4){0.f, 0.f, 0.f, 0.f}; ya1 = ya0;
        }
        asm volatile("s_waitcnt lgkmcnt(0)" ::: "memory");
    }
    __syncthreads();
    {
        const int mt = w & 1;
        bf16x8 yf[8];
#pragma unroll
        for (int ks = 0; ks < 8; ++ks) yf[ks] = *(const LAS bf16x8*)(Y + (mt * 16 + fr) * YS + ks * 32 + fq * 8);
        const int s = mt * 16 + fr;
        bf16_t* orow = mix + (size_t)(b * SEQ + ch * S5T + s) * DM + 256;
#pragma unroll 2
        for (int i = 0; i < 4; ++i) {
            const int nt = (w >> 1) * 4 + i;
            const bf16_t* ap = wgluT + (size_t)(nt * 16 + fr) * 256 + fq * 8;
            f32x4 acc = {0.f, 0.f, 0.f, 0.f};
#pragma unroll
            for (int ks = 0; ks < 8; ++ks) acc = mfma16(*(const bf16x8*)(ap + ks * 32), yf[ks], acc);
            const int n0 = nt * 16 + fq * 4;
            const f32x4 bg = *(const f32x4*)(bglu + n0);
            const u32x2 yw = *(const LAS u32x2*)(Y + s * YS + n0);
            const float yv[4] = {bflo(yw.x), bfhi(yw.x), bflo(yw.y), bfhi(yw.y)};
            float ov[4];
#pragma unroll
            for (int jj = 0; jj < 4; ++jj) ov[jj] = yv[jj] * __builtin_amdgcn_rcpf(1.f + __expf(-(acc[jj] + bg[jj])));
            u32x2 ow; ow.x = pk2(ov[0], ov[1]); ow.y = pk2(ov[2], ov[3]);
            *(u32x2*)(orow + n0) = ow;
        }
    }
    __syncthreads();
}

__device__ __forceinline__ void phase_scan(const Args& a, int l, int tid) {
    unsigned char* ws = a.ws;
    const int lane = tid & 63, wave = tid >> 6;
    {
        const float* tab = (const float*)(ws + WS_S5TAB) + (size_t)l * 2048 * 8;
        const float2* __restrict__ E = (const float2*)(ws + WS_S5E); float2* __restrict__ C = (float2*)(ws + WS_S5C);
        for (int wv = blockIdx.x; wv < 128; wv += gridDim.x) if (wave == 0) {
            const int p = lane, r = wv & 1, g = (wv >> 1) & 15, b = wv >> 5;
            const float* tp = tab + (size_t)((r * 16 + g) * 64 + p) * 8;
            const float tr = tp[4], ti = tp[5];
            float xr = 0.f, xi = 0.f;
            for (int k0 = 0; k0 < S5NCH; k0 += 32) {
                float2 e[32];
#pragma unroll
                for (int k = 0; k < 32; ++k) { const int ch = r ? (S5NCH - 1 - (k0 + k)) : (k0 + k); e[k] = E[(size_t)(((b * S5NCH + ch) * 16 + g) * 2 + r) * 64 + p]; }
#pragma unroll
                for (int k = 0; k < 32; ++k) { const int ch = r ? (S5NCH - 1 - (k0 + k)) : (k0 + k);
                    float2 cv; cv.x = xr; cv.y = xi; C[(size_t)(((b * S5NCH + ch) * 16 + g) * 2 + r) * 64 + p] = cv;
                    const float nr = fmaf(tr, xr, fmaf(-ti, xi, e[k].x)), ni = fmaf(tr, xi, fmaf(ti, xr, e[k].y));
                    xr = nr; xi = ni; }
            }
        }
    }
    {
        const float* theta = a.in[4] + l * 8;
        const float* __restrict__ kvf = (const float*)(ws + WS_KVF); const float* __restrict__ kvb = (const float*)(ws + WS_KVB);
        float* __restrict__ stf = (float*)(ws + WS_STF); float* __restrict__ stb = (float*)(ws + WS_STB);
        for (int gid = blockIdx.x * NTHR + tid; gid < 131072; gid += gridDim.x * NTHR) {
            const int el = gid & 4095, dir = (gid >> 12) & 1, h = (gid >> 13) & 3, b = gid >> 15;
            const float dec = __expf(log_sigmoid(theta[dir * 4 + h]) * 128.f);
            const float* __restrict__ kv = dir ? kvb : kvf; float* __restrict__ st = dir ? stb : stf;
            float s = 0.f;
            for (int c0 = 0; c0 < 32; c0 += 16) {
                float kk[16];
#pragma unroll
                for (int k = 0; k < 16; ++k) { const int c = dir ? (31 - (c0 + k)) : (c0 + k); kk[k] = kv[(size_t)((b * 32 + c) * 4 + h) * 4096 + el]; }
#pragma unroll
                for (int k = 0; k < 16; ++k) { const int c = dir ? (31 - (c0 + k)) : (c0 + k); st[(size_t)((b * 32 + c) * 4 + h) * 4096 + el] = s; s = fmaf(dec, s, kk[k]); }
            }
        }
    }
}

__device__ __forceinline__ float router_softmax(const float (&sp)[16], int lane) {
    const bool b5 = (lane & 32) != 0, b4 = (lane & 16) != 0, b3 = (lane & 8) != 0, b2 = (lane & 4) != 0;
    float t8[8], t4[4], t2[2];
#pragma unroll
    for (int i = 0; i < 8; ++i) { const float snd = b5 ? sp[i] : sp[i + 8], kp = b5 ? sp[i + 8] : sp[i]; t8[i] = kp + __shfl_xor(snd, 32); }
#pragma unroll
    for (int i = 0; i < 4; ++i) { const float snd = b4 ? t8[i] : t8[i + 4], kp = b4 ? t8[i + 4] : t8[i]; t4[i] = kp + __shfl_xor(snd, 16); }
#pragma unroll
    for (int i = 0; i < 2; ++i) { const float snd = b3 ? t4[i] : t4[i + 2], kp = b3 ? t4[i + 2] : t4[i]; t2[i] = kp + __shfl_xor(snd, 8); }
    float lgt; { const float snd = b2 ? t2[0] : t2[1], kp = b2 ? t2[1] : t2[0]; lgt = kp + __shfl_xor(snd, 4); }
    lgt += __shfl_xor(lgt, 1); lgt += __shfl_xor(lgt, 2);
    float mx = lgt;
#pragma unroll
    for (int o = 4; o < 64; o <<= 1) mx = fmaxf(mx, __shfl_xor(mx, o));
    const float ex = expf(lgt - mx);
    float sum = ex;
#pragma unroll
    for (int o = 4; o < 64; o <<= 1) sum += __shfl_xor(sum, o);
    return ex / sum;
}
__device__ __forceinline__ void phase_ln1_router(const Args& a, int l, LAS unsigned char* lds, int tid) {
    unsigned char* ws = a.ws;
    const int lane = tid & 63, wave = tid >> 6;
    LAS float* rwT = (LAS float*)lds;
    const float* rw = a.in[19] + (size_t)l * DM * NE;
    for (int i = tid; i < DM * NE; i += NTHR) rwT[(i & 15) * DM + (i >> 4)] = rw[i];
    __syncthreads();
    const float* pre = (const float*)(ws + WS_RA);
    float* afft = (float*)(ws + WS_AFFT);
    const int gw = blockIdx.x * NWAVES + wave, NGW = gridDim.x * NWAVES;
    for (int m = gw; m < MTOK; m += 2 * NGW) {
        const int m1 = m + NGW; const bool has1 = m1 < MTOK; const int mb = has1 ? m1 : m;
        f32x4 v0[4], v1[4];
#pragma unroll
        for (int j = 0; j < 4; ++j) { v0[j] = ((const f32x4*)(pre + (size_t)m * DM))[lane + 64 * j]; v1[j] = ((const f32x4*)(pre + (size_t)mb * DM))[lane + 64 * j]; }
        ln_rows4(v0, a.in[17] + l * DM, a.in[18] + l * DM, lane);
        ln_rows4(v1, a.in[17] + l * DM, a.in[18] + l * DM, lane);
        store_row(v0, nullptr, (bf16_t*)(ws + WS_HBF) + (size_t)m * DM, lane);
        if (has1) store_row(v1, nullptr, (bf16_t*)(ws + WS_HBF) + (size_t)m1 * DM, lane);
        float sp0[16], sp1[16];
#pragma unroll
        for (int eg = 0; eg < 4; ++eg) {
#pragma unroll
            for (int ee = 0; ee < 4; ++ee) { const int e = eg * 4 + ee; float s0 = 0.f, s1 = 0.f;
#pragma unroll
                for (int j = 0; j < 4; ++j) { const f32x4 wv = *(const LAS f32x4*)(rwT + e * DM + 256 * j + 4 * lane);
                    s0 += (v0[j][0] * wv[0] + v0[j][1] * wv[1]) + (v0[j][2] * wv[2] + v0[j][3] * wv[3]);
                    s1 += (v1[j][0] * wv[0] + v1[j][1] * wv[1]) + (v1[j][2] * wv[2] + v1[j][3] * wv[3]); }
                sp0[e] = s0; sp1[e] = s1; }
            asm volatile("" ::: "memory");
        }
        const float af0 = router_softmax(sp0, lane), af1 = router_softmax(sp1, lane);
        if ((lane & 3) == 0) {
            afft[(size_t)((m / SEQ) * NE + (lane >> 2)) * SEQ + (m % SEQ)] = af0;
            if (has1) afft[(size_t)((m1 / SEQ) * NE + (lane >> 2)) * SEQ + (m1 % SEQ)] = af1;
        }
    }
    __syncthreads();
}

__device__ __forceinline__ void select_item(int item, const Args& a, LAS unsigned char* lds, int tid) {
    unsigned char* ws = a.ws;
    const int q = item & 3, e = (item >> 2) & 15, b = item >> 6;
    const int lane = tid & 63, wave = tid >> 6;
    LAS unsigned* red = (LAS unsigned*)lds;
    LAS int* sel = (LAS int*)(lds + 1024);
    const float* av = (const float*)(ws + WS_AFFT) + (size_t)(b * NE + e) * SEQ + tid * 8;
    const f32x4 va = *(const f32x4*)av, vb = *(const f32x4*)(av + 4);
    unsigned v[8] = {__float_as_uint(va[0]), __float_as_uint(va[1]), __float_as_uint(va[2]), __float_as_uint(va[3]), __float_as_uint(vb[0]), __float_as_uint(vb[1]), __float_as_uint(vb[2]), __float_as_uint(vb[3])};
    unsigned x = 0u;
    for (int bit = 30; bit >= 0; --bit) {
        const unsigned cand = x | (1u << bit);
        unsigned cnt = 0u;
#pragma unroll
        for (int j = 0; j < 8; ++j) cnt += (unsigned)__popcll(__ballot(v[j] >= cand));
        LAS unsigned* rb = red + (bit & 1) * 8;
        if (lane == 0) rb[wave] = cnt;
        __syncthreads();
        unsigned tot = 0u;
#pragma unroll
        for (int k = 0; k < 8; ++k) tot += rb[k];
        if (tot >= (unsigned)CAP) x = cand;
    }
    unsigned mycnt = 0u;
#pragma unroll
    for (int j = 0; j < 8; ++j) mycnt += (v[j] > x ? 1u : 0u) + (v[j] == x ? 0x10000u : 0u);
    unsigned inc = mycnt;
#pragma unroll
    for (int o = 1; o < 64; o <<= 1) { const unsigned t = __shfl_up(inc, o); if (lane >= o) inc += t; }
    LAS unsigned* wsum = red + 64;
    __syncthreads();
    if (lane == 63) wsum[wave] = inc;
    __syncthreads();
    unsigned wpre = 0u, total = 0u;
#pragma unroll
    for (int k = 0; k < 8; ++k) { const unsigned t = wsum[k]; if (k < wave) wpre += t; total += t; }
    const unsigned excl = wpre + inc - mycnt;
    unsigned gtb = excl & 0xffffu, eqb = excl >> 16;
    const unsigned need = (unsigned)CAP - (total & 0xffffu);
    const int rowbase = (e * NB + b) * CAP;
    int* idx = (int*)(ws + WS_IDX); float* gate = (float*)(ws + WS_GATE); int* slotmap = (int*)(ws + WS_SLOT);
    const bool own_tok = ((tid >> 7) == q);
#pragma unroll
    for (int j = 0; j < 8; ++j) {
        const bool isgt = v[j] > x, iseq = v[j] == x;
        const bool issel = isgt || (iseq && eqb < need);
        const unsigned slot = gtb + (eqb < need ? eqb : need);
        const int tok = b * SEQ + tid * 8 + j;
        if (issel && (int)(slot >> 7) == q) { idx[rowbase + slot] = tok; gate[rowbase + slot] = __uint_as_float(v[j]); }
        if (own_tok) slotmap[(size_t)tok * NE + e] = issel ? (int)(rowbase + slot) : -1;
        gtb += isgt ? 1u : 0u; eqb += iseq ? 1u : 0u;
    }
    __syncthreads();
}

__device__ __forceinline__ void phase_ln2(const Args& a, int l, int tid) {
    unsigned char* ws = a.ws;
    const int lane = tid & 63, wave = tid >> 6;
    const int gw = blockIdx.x * NWAVES + wave, NGW = gridDim.x * NWAVES;
    const bf16_t* hbf = (const bf16_t*)(ws + WS_HBF); const int* slotmap = (const int*)(ws + WS_SLOT); const bf16_t* contrib = (const bf16_t*)(ws + WS_RB);
    const bool last = (l == 1);
    u32x2 vn[4]; int slot_n = -1;
    if (gw < MTOK) {
#pragma unroll
        for (int j = 0; j < 4; ++j) vn[j] = ((const u32x2*)(hbf + (size_t)gw * DM))[lane + 64 * j];
        slot_n = slotmap[(size_t)gw * NE + (lane & 15)];
    }
    for (int m = gw; m < MTOK; m += NGW) {
        f32x4 v[4];
#pragma unroll
        for (int j = 0; j < 4; ++j) { v[j][0] = bflo(vn[j].x) * ALPHA; v[j][1] = bfhi(vn[j].x) * ALPHA; v[j][2] = bflo(vn[j].y) * ALPHA; v[j][3] = bfhi(vn[j].y) * ALPHA; }
        const int myslot = slot_n;
        unsigned bal = (unsigned)(__ballot(myslot >= 0) & 0xffffull);
        int r0 = -1, r1 = -1, r2 = -1, r3 = -1;
        if (bal) { r0 = __shfl(myslot, __builtin_ctz(bal)); bal &= bal - 1; }
        if (bal) { r1 = __shfl(myslot, __builtin_ctz(bal)); bal &= bal - 1; }
        if (bal) { r2 = __shfl(myslot, __builtin_ctz(bal)); bal &= bal - 1; }
        if (bal) { r3 = __shfl(myslot, __builtin_ctz(bal)); bal &= bal - 1; }
        u32x2 c0[4], c1[4], c2[4], c3[4];
#pragma unroll
        for (int j = 0; j < 4; ++j) { c0[j] = (u32x2){0u, 0u}; c1[j] = c0[j]; c2[j] = c0[j]; c3[j] = c0[j]; }
        if (r0 >= 0) {
#pragma unroll
            for (int j = 0; j < 4; ++j) c0[j] = ((const u32x2*)(contrib + (size_t)r0 * DM))[lane + 64 * j]; }
        if (r1 >= 0) {
#pragma unroll
            for (int j = 0; j < 4; ++j) c1[j] = ((const u32x2*)(contrib + (size_t)r1 * DM))[lane + 64 * j]; }
        if (r2 >= 0) {
#pragma unroll
            for (int j = 0; j < 4; ++j) c2[j] = ((const u32x2*)(contrib + (size_t)r2 * DM))[lane + 64 * j]; }
        if (r3 >= 0) {
#pragma unroll
            for (int j = 0; j < 4; ++j) c3[j] = ((const u32x2*)(contrib + (size_t)r3 * DM))[lane + 64 * j]; }
        if (m + NGW < MTOK) {
#pragma unroll
            for (int j = 0; j < 4; ++j) vn[j] = ((const u32x2*)(hbf + (size_t)(m + NGW) * DM))[lane + 64 * j];
            slot_n = slotmap[(size_t)(m + NGW) * NE + (lane & 15)];
        }
#pragma unroll
        for (int j = 0; j < 4; ++j) {
            v[j][0] += bflo(c0[j].x); v[j][1] += bfhi(c0[j].x); v[j][2] += bflo(c0[j].y); v[j][3] += bfhi(c0[j].y);
            v[j][0] += bflo(c1[j].x); v[j][1] += bfhi(c1[j].x); v[j][2] += bflo(c1[j].y); v[j][3] += bfhi(c1[j].y);
            v[j][0] += bflo(c2[j].x); v[j][1] += bfhi(c2[j].x); v[j][2] += bflo(c2[j].y); v[j][3] += bfhi(c2[j].y);
            v[j][0] += bflo(c3[j].x); v[j][1] += bfhi(c3[j].x); v[j][2] += bflo(c3[j].y); v[j][3] += bfhi(c3[j].y);
        }
        while (bal) {
            const int row = __shfl(myslot, __builtin_ctz(bal)); bal &= bal - 1;
            const u32x2* cr = (const u32x2*)(contrib + (size_t)row * DM);
#pragma unroll
            for (int j = 0; j < 4; ++j) { const u32x2 wv = cr[lane + 64 * j]; v[j][0] += bflo(wv.x); v[j][1] += bfhi(wv.x); v[j][2] += bflo(wv.y); v[j][3] += bfhi(wv.y); }
        }
        ln_rows4(v, a.in[23] + l * DM, a.in[24] + l * DM, lane);
        if (last) store_row(v, a.out + (size_t)m * DM, nullptr, lane);
        else store_row(v, nullptr, (bf16_t*)(ws + WS_HBF) + (size_t)m * DM, lane);
    }
}

typedef __attribute__((address_space(1))) unsigned gu32;
#define RLX_AGENT __ATOMIC_RELAXED, __HIP_MEMORY_SCOPE_AGENT
#define XB_TMO      128
#define XB_XCNT(j)  (256  + 64 * (j))
#define XB_XSUB(j)  (1280 + 64 * (j))
#define XB_XGEN(j)  (2304 + 64 * (j))
#define XB_TOP      3328
#define XB_TOPGEN   3392
#define XCD_BAR_WORDS 3456
#define XB_SPIN_CAP (1u << 18)

__device__ __forceinline__ unsigned xb_ld(unsigned* p)              { return __hip_atomic_load(p, __ATOMIC_RELAXED, __HIP_MEMORY_SCOPE_AGENT); }
__device__ __forceinline__ unsigned xb_add(unsigned* p, unsigned v) { return __hip_atomic_fetch_add(p, v, __ATOMIC_RELAXED, __HIP_MEMORY_SCOPE_AGENT); }
__device__ __forceinline__ unsigned xb_xcc_id() { return (unsigned)__builtin_amdgcn_s_getreg((3 << 11) | 20) & 0xFu; }
#define XB_SPIN(cond, bar) do { unsigned _sp = 0; while (cond) { __builtin_amdgcn_s_sleep(1); \
    if ((++_sp & 255u) == 0u) { if (xb_ld(&(bar)[XB_TMO])) break; if (_sp > XB_SPIN_CAP) { atomicAdd(&(bar)[XB_TMO], 1u); break; } } } } while (0)

struct XcdBarrier {
    unsigned* bar; unsigned x;
    volatile LAS unsigned* st;
};

__device__ __forceinline__ XcdBarrier xcd_barrier_post(unsigned* bar, volatile LAS unsigned* st) {
    XcdBarrier b; b.bar = bar; b.x = xb_xcc_id(); b.st = st;
    if (threadIdx.x == 0) (void)xb_add(&bar[XB_XCNT(b.x)], 1u);
    return b;
}
__device__ __forceinline__ void xcd_barrier_complete(unsigned* bar, unsigned x, unsigned& nloc, unsigned& nx) {
    const unsigned G = gridDim.x * gridDim.y * gridDim.z;
    unsigned sum, cnt, mine, sp = 0u;
    for (;;) {
        sum = 0u; cnt = 0u; mine = 0u;
#pragma unroll
        for (unsigned j = 0; j < 16; ++j) { const unsigned c = xb_ld(&bar[XB_XCNT(j)]); sum += c; cnt += (c > 0u) ? 1u : 0u; mine = (j == x) ? c : mine; }
        if (sum == G) break;
        __builtin_amdgcn_s_sleep(1);
        if ((++sp & 255u) == 0u) { if (xb_ld(&bar[XB_TMO])) break; if (sp > XB_SPIN_CAP) { atomicAdd(&bar[XB_TMO], 1u); break; } }
    }
    nloc = mine > 0u ? mine : 1u; nx = cnt > 0u ? cnt : 1u;
}

__device__ __forceinline__ void xcd_barrier(const XcdBarrier& b) {
    asm volatile("s_waitcnt vmcnt(0)" ::: "memory");
    __syncthreads();
    if (threadIdx.x == 0) {
        unsigned* bar = b.bar;
        __builtin_amdgcn_s_waitcnt(0);
        unsigned nloc = b.st[0], nx = b.st[1];
        if (nloc == 0u) { xcd_barrier_complete(bar, b.x, nloc, nx); b.st[0] = nloc; b.st[1] = nx; }
        const unsigned old = xb_add(&bar[XB_XSUB(b.x)], 1u);
        const unsigned gen = old / nloc;
        if (old + 1u == (gen + 1u) * nloc) {
            __builtin_amdgcn_fence(__ATOMIC_RELEASE, "agent");
            asm volatile("s_waitcnt vmcnt(0)" ::: "memory");
            const unsigned og = xb_add(&bar[XB_TOP], 1u);
            const unsigned tg = og / nx;
            if (og + 1u == (tg + 1u) * nx) xb_add(&bar[XB_TOPGEN], 1u);
            else XB_SPIN(xb_ld(&bar[XB_TOPGEN]) == tg, bar);
            __builtin_amdgcn_fence(__ATOMIC_ACQUIRE, "agent");
            xb_add(&bar[XB_XGEN(b.x)], 1u);
            asm volatile("s_waitcnt vmcnt(0)" ::: "memory");
        } else {
            XB_SPIN(xb_ld(&bar[XB_XGEN(b.x)]) == gen, bar);
            __builtin_amdgcn_fence(__ATOMIC_ACQUIRE, "agent");
            asm volatile("s_waitcnt vmcnt(0)" ::: "memory");
        }
    }
    __syncthreads();
}

constexpr int NPHASES = 21;
#ifndef REP_MASK
#define REP_MASK 0
#endif
template <int L, int K>
__device__ __forceinline__ void run_phase(const Args& a, LAS unsigned char* lds, int tid) {
    unsigned char* ws = a.ws;
    constexpr int l = L;
    bf16_t* proj = (bf16_t*)(ws + WS_RA); bf16_t* mix = (bf16_t*)(ws + WS_RB);
    if constexpr (K == 0) {
        pg8::Gemm g{(const bf16_t*)(ws + WS_HBF), (const bf16_t*)(ws + WS_WIN) + (size_t)l * DIN * DM, MTOK, DIN, DM};
        pg8::StaticOrder S; S.init(MTOK, DIN, (int)gridDim.x, (int)blockIdx.x);
        pg8::EpiStoreBf16 E{proj, DIN};
        pg8::gemm_phase<pg8::EpiStoreBf16, pg8::StaticOrder, true, true>(lds, g, S, E);
    } else if constexpr (K == 1) {
        const float* tab = (const float*)(ws + WS_S5TAB) + (size_t)l * 2048 * 8;
        constexpr int XB = ((REP_MASK >> 11) & 1) ? 512 : ((REP_MASK >> 12) & 1) ? 256 : ((REP_MASK >> 13) & 1) ? 512 : 0, XOFF = ((REP_MASK >> 11) & 1) ? 0 : ((REP_MASK >> 12) & 1) ? 512 : 768;
        for (int it0 = blockIdx.x; it0 < 1280 + XB; it0 += gridDim.x) {
            const int it = it0 < 1280 ? it0 : it0 - 1280 + XOFF;
            if (it < 512) s5e_item(it, proj, tab, (const bf16_t*)(ws + WS_S5BT) + (size_t)l * 4096 * 32, (float*)(ws + WS_S5E), lds, tid);
            else if (it < 768) attn_item(it - 512, proj, mix, a.in[15] + l * 8, lds, tid);
            else retkv_item(it - 768, proj, (float*)(ws + WS_KVF), (float*)(ws + WS_KVB), a.in[4] + l * 8, lds, tid);
        }
    } else if constexpr (K == 2) {
        phase_scan(a, l, tid);
    } else if constexpr (K == 3) {
        const float* tab = (const float*)(ws + WS_S5TAB) + (size_t)l * 2048 * 8;
        constexpr int XD = ((REP_MASK >> 14) & 3) ? 512 : 0, XOFD = ((REP_MASK >> 14) & 1) ? 0 : 512;
        for (int it0 = blockIdx.x; it0 < 1024 + XD; it0 += gridDim.x) {
            const int it = it0 < 1024 ? it0 : it0 - 1024 + XOFD;
            if (it < 512) s5out_item(it, proj, tab, (const bf16_t*)(ws + WS_S5BT) + (size_t)l * 4096 * 32, (const bf16_t*)(ws + WS_S5CT) + (size_t)l * 65536, a.in[12] + l * 256,
                                     (const bf16_t*)(ws + WS_WGLU) + (size_t)l * 65536, a.in[14] + l * 256, (const float*)(ws + WS_S5C), mix, lds, tid);
            else retout_item(it - 512, proj, (const float*)(ws + WS_STF), (const float*)(ws + WS_STB), mix, a.in[4] + l * 8, lds, tid);
        }
    } else if constexpr (K == 4) {
        pg8::Gemm g{mix, (const bf16_t*)(ws + WS_WOUT) + (size_t)l * DM * DM, MTOK, DM, DM};
        pg8::StaticOrder S; S.init(MTOK, DM, (int)gridDim.x, (int)blockIdx.x);
        pg8::EpiResF32 E{(const bf16_t*)(ws + WS_HBF), (float*)(ws + WS_RA), DM, ALPHA};
        pg8::gemm_phase<pg8::EpiResF32, pg8::StaticOrder, true, true>(lds, g, S, E);
    } else if constexpr (K == 5) {
        phase_ln1_router(a, l, lds, tid);
    } else if constexpr (K == 6) {
        for (int it = blockIdx.x; it < 256; it += gridDim.x) select_item(it, a, lds, tid);
    } else if constexpr (K == 7) {
        pg8::Gemm g{(const bf16_t*)(ws + WS_HBF), (const bf16_t*)(ws + WS_WGU) + (size_t)l * NE * 2 * FF * DM, NROWX, NE * 2 * FF, DM};
        pg8::GroupedOrder S; S.init(16, (int)gridDim.x, (int)blockIdx.x);
        pg8::EpiSwiGLU E{(bf16_t*)(ws + WS_HDN), FF, 16};
        pg8::gemm_phase<pg8::EpiSwiGLU, pg8::GroupedOrder, true, true, true>(lds, g, S, E, (const int*)(ws + WS_IDX));
    } else if constexpr (K == 8) {
        pg8::Gemm g{(const bf16_t*)(ws + WS_HDN), (const bf16_t*)(ws + WS_WD) + (size_t)l * NE * DM * FF, NROWX, NE * DM, FF};
        pg8::GroupedOrder S; S.init(4, (int)gridDim.x, (int)blockIdx.x);
        pg8::EpiScaleRow E{(bf16_t*)(ws + WS_RB), DM, 4, (const float*)(ws + WS_GATE)};
        pg8::gemm_phase<pg8::EpiScaleRow, pg8::GroupedOrder, true, true>(lds, g, S, E);
    } else {
        phase_ln2(a, l, tid);
    }
}
__global__ void __launch_bounds__(NTHR, 2) fwd_kernel(Args a) {
    extern __shared__ __attribute__((aligned(16))) unsigned char lds_raw[];
    LAS unsigned char* lds = (LAS unsigned char*)lds_raw;
    cg::grid_group grid = cg::this_grid();
    const int lo = a.ph_lo, hi = a.ph_hi;
    volatile LAS unsigned* bst = (volatile LAS unsigned*)(lds + LDS_BYTES - 64);
    if (threadIdx.x < 16) bst[threadIdx.x] = 0u;
    __syncthreads();
    XcdBarrier bar = xcd_barrier_post((unsigned*)(a.ws + WS_BAR), bst);
    if (hi > 1000) grid.sync();
#define PH_BEGIN(ph) if (lo <= (ph) && (ph) < hi) { int tid = threadIdx.x; asm volatile("" : "+v"(tid));
#define PH_END(ph) if ((ph) + 1 < hi) xcd_barrier(bar); }
    PH_BEGIN(0) for (int rep = 0; rep <= ((REP_MASK >> 10) & 1); ++rep) phase_p0(a, lds, tid); PH_END(0)
#define LAYER(L) \
    PH_BEGIN(1 + 10 * L + 0) for (int rep = 0; rep <= ((REP_MASK >> 0) & 1); ++rep) run_phase<L, 0>(a, lds, tid); PH_END(1 + 10 * L + 0) \
    PH_BEGIN(1 + 10 * L + 1) for (int rep = 0; rep <= ((REP_MASK >> 1) & 1); ++rep) run_phase<L, 1>(a, lds, tid); PH_END(1 + 10 * L + 1) \
    PH_BEGIN(1 + 10 * L + 2) for (int rep = 0; rep <= ((REP_MASK >> 2) & 1); ++rep) run_phase<L, 2>(a, lds, tid); PH_END(1 + 10 * L + 2) \
    PH_BEGIN(1 + 10 * L + 3) for (int rep = 0; rep <= ((REP_MASK >> 3) & 1); ++rep) run_phase<L, 3>(a, lds, tid); PH_END(1 + 10 * L + 3) \
    PH_BEGIN(1 + 10 * L + 4) for (int rep = 0; rep <= ((REP_MASK >> 4) & 1); ++rep) run_phase<L, 4>(a, lds, tid); PH_END(1 + 10 * L + 4) \
    PH_BEGIN(1 + 10 * L + 5) for (int rep = 0; rep <= ((REP_MASK >> 5) & 1); ++rep) run_phase<L, 5>(a, lds, tid); PH_END(1 + 10 * L + 5) \
    PH_BEGIN(1 + 10 * L + 6) for (int rep = 0; rep <= ((REP_MASK >> 6) & 1); ++rep) run_phase<L, 6>(a, lds, tid); PH_END(1 + 10 * L + 6) \
    PH_BEGIN(1 + 10 * L + 7) for (int rep = 0; rep <= ((REP_MASK >> 7) & 1); ++rep) run_phase<L, 7>(a, lds, tid); PH_END(1 + 10 * L + 7) \
    PH_BEGIN(1 + 10 * L + 8) for (int rep = 0; rep <= ((REP_MASK >> 8) & 1); ++rep) run_phase<L, 8>(a, lds, tid); PH_END(1 + 10 * L + 8) \
    PH_BEGIN(1 + 10 * L + 9) for (int rep = 0; rep <= (((REP_MASK >> 9) & 1) && L == 1 ? 1 : 0); ++rep) run_phase<L, 9>(a, lds, tid); PH_END(1 + 10 * L + 9)
    LAYER(0)
    LAYER(1)
#undef LAYER
#undef PH_BEGIN
#undef PH_END
}

#ifndef ONE_LAUNCH
#define ONE_LAUNCH 1
#endif
extern "C" void kernel_launch(void* const* d_in, const int* in_sizes, int n_in, void* d_out, int out_size, void* d_ws, size_t ws_size, hipStream_t stream) {
    static int grid = 0;
    if (grid == 0) {
        if (n_in != 25 || ws_size < WS_END) { fprintf(stderr, "kernel_launch: unexpected problem (n_in %d, ws %zu)\n", n_in, ws_size); grid = -1; return; }
        int dev = 0, cus = 0, per_cu = 0;
        (void)hipGetDevice(&dev);
        (void)hipDeviceGetAttribute(&cus, hipDeviceAttributeMultiprocessorCount, dev);
        if (hipFuncSetAttribute((const void*)fwd_kernel, hipFuncAttributeMaxDynamicSharedMemorySize, LDS_BYTES) != hipSuccess) { fprintf(stderr, "kernel_launch: hipFuncSetAttribute failed\n"); grid = -1; return; }
        if (hipOccupancyMaxActiveBlocksPerMultiprocessor(&per_cu, (const void*)fwd_kernel, NTHR, LDS_BYTES) != hipSuccess || per_cu < 1) { fprintf(stderr, "kernel_launch: occupancy query says %d\n", per_cu); per_cu = 1; }
        (void)hipGetLastError();
        if (cus <= 0) cus = 256;
        grid = cus * per_cu;
    }
    if (grid < 0) return;
    Args a{};
    for (int i = 0; i < 25; ++i) a.in[i] = (const float*)d_in[i];
    a.out = (float*)d_out; a.ws = (unsigned char*)d_ws;
#if ONE_LAUNCH
    if (hipMemsetAsync((char*)d_ws + WS_BAR, 0, 16384, stream) != hipSuccess) { fprintf(stderr, "kernel_launch: memset failed\n"); return; }
    a.ph_lo = 0; a.ph_hi = NPHASES;
    void* args[] = {&a};
    hipError_t e = hipLaunchCooperativeKernel((const void*)fwd_kernel, dim3(grid), dim3(NTHR), args, LDS_BYTES, stream);
    if (e != hipSuccess) fprintf(stderr, "kernel_launch: cooperative launch failed: %s (grid %d)\n", hipGetErrorString(e), grid);
#else
    for (int ph = 0; ph < NPHASES; ++ph) {
        a.ph_lo = ph; a.ph_hi = ph + 1;
        hipLaunchKernelGGL(fwd_kernel, dim3(grid), dim3(NTHR), LDS_BYTES, stream, a);
    }
#endif
}
```

```cpp
#include <hip/hip_runtime.h>
#include <hip/hip_cooperative_groups.h>
#include <cstdio>
#include <cstdint>
namespace cg = cooperative_groups;
namespace pg8 {
#define PG8_LAS __attribute__((address_space(3)))
typedef unsigned short bf16_t;
typedef short bf16x8 __attribute__((ext_vector_type(8)));
typedef float f32x4 __attribute__((ext_vector_type(4)));
typedef unsigned u32x4 __attribute__((ext_vector_type(4)));
constexpr int BM = 256, BK = 64, HALF = 128, HTB = HALF * BK * 2  , STAGE_BYTES = 8 * HTB, NXCD = 8, WGM = 8;

__host__ __device__ __forceinline__ int lds_byte(int r, int c) { const int st = (r >> 4) * 2 + (c >> 5), rr = r & 15, cc = c & 31, ob = rr * 64 + cc * 2; return st * 1024 + (ob ^ (((ob >> 9) & 1) << 5)); }
__host__ __device__ __forceinline__ void stage_rc(int b, int& R, int& C) { const int st = b / 1024, sb = b % 1024, swz = sb ^ (((sb >> 9) & 1) << 5); R = (st >> 1) * 16 + swz / 64; C = (st & 1) * 32 + (swz % 64) / 2; }
__host__ __device__ __forceinline__ int perm32(int rho) { const int n = rho >> 4, i = rho & 15; return 8 * (i >> 2) + 4 * n + (i & 3); }

struct Unit { int pm, pn; };
struct Gemm { const bf16_t* A; const bf16_t* Bt; int M, N, K; };

struct StaticOrder {
    int nM, nN, nwg, G, c;
    __host__ __device__ void init(int M, int N, int G_, int c_) { nM = M / BM; nN = N / BM; nwg = nM * nN; G = G_; c = c_; }
    __host__ __device__ bool next(int i, Unit& u) const {
        const long L = (long)i * G + c; if (L >= nwg) return false;
        int wgid = (int)L; { const int q = nwg / NXCD, r = nwg % NXCD, xcd = wgid % NXCD, off = wgid / NXCD; wgid = (xcd < r ? xcd * (q + 1) : r * (q + 1) + (xcd - r) * q) + off; }
        const int nig = WGM * nN, gid = wgid / nig, fm = gid * WGM, gsz = (nM - fm) < WGM ? (nM - fm) : WGM;
        u.pm = fm + ((wgid % nig) % gsz); u.pn = (wgid % nig) / gsz; return true;
    }
    __device__ __forceinline__ void a_ready(const Unit&) const {}
    __device__ __forceinline__ void done(const Unit&) const {}
};

__device__ __forceinline__ unsigned cvt_pk_bf16(float lo, float hi) { unsigned r; asm volatile("v_cvt_pk_bf16_f32 %0, %1, %2" : "=v"(r) : "v"(lo), "v"(hi)); return r; }
typedef unsigned u32x2 __attribute__((ext_vector_type(2)));

struct GroupedOrder {
    int upe, nNe, nwg, G, c;
    __host__ __device__ void init(int nNe_, int G_, int c_) { nNe = nNe_; upe = 8 * nNe_; nwg = 16 * upe; G = G_; c = c_; }
    __host__ __device__ bool next(int i, Unit& u) const {
        const long L = (long)i * G + c; if (L >= nwg) return false;
        int wgid = (int)L; { const int q = nwg / NXCD, r = nwg % NXCD, xcd = wgid % NXCD, off = wgid / NXCD; wgid = (xcd < r ? xcd * (q + 1) : r * (q + 1) + (xcd - r) * q) + off; }
        const int e = wgid / upe, rr = wgid % upe;
        u.pm = e * 8 + (rr & 7); u.pn = e * nNe + (rr >> 3); return true;
    }
    __device__ __forceinline__ void a_ready(const Unit&) const {}
    __device__ __forceinline__ void done(const Unit&) const {}
};

struct EpiStoreBf16 {
    static constexpr bool PERM = true, AFTER_DRAIN = false;
    bf16_t* O; int ldc;
    __device__ __forceinline__ void operator()(const f32x4 (&acc)[2][2][4][2], const Unit& u, int wr, int wc, int fr, int fq) const {
        const int row0 = u.pm * BM + wr * 64 + fr, col0 = u.pn * BM + wc * 32 + 8 * fq;
#pragma unroll
        for (int ai = 0; ai < 2; ++ai)
#pragma unroll
            for (int m = 0; m < 4; ++m) { bf16_t* rowp = O + (size_t)(row0 + ai * HALF + m * 16) * ldc + col0;
#pragma unroll
                for (int bj = 0; bj < 2; ++bj) { const f32x4 v0 = acc[ai][bj][m][0], v1 = acc[ai][bj][m][1];
                    u32x4 w; w.x = cvt_pk_bf16(v0[0], v0[1]); w.y = cvt_pk_bf16(v0[2], v0[3]); w.z = cvt_pk_bf16(v1[0], v1[1]); w.w = cvt_pk_bf16(v1[2], v1[3]);
                    *(u32x4*)(rowp + bj * HALF) = w; } }
    }
};
struct EpiResF32 {
    static constexpr bool PERM = false, AFTER_DRAIN = false;
    const bf16_t* base; float* O; int ldc; float alpha;
    __device__ __forceinline__ void operator()(const f32x4 (&acc)[2][2][4][2], const Unit& u, int wr, int wc, int fr, int fq) const {
        const int row0 = u.pm * BM + wr * 64 + fr, col0 = u.pn * BM + wc * 32 + 4 * fq;
#pragma unroll
        for (int ai = 0; ai < 2; ++ai)
#pragma unroll
            for (int m = 0; m < 4; ++m) { const size_t ro = (size_t)(row0 + ai * HALF + m * 16) * ldc + col0;
#pragma unroll
                for (int bj = 0; bj < 2; ++bj)
#pragma unroll
                    for (int n = 0; n < 2; ++n) { const u32x2 bw = *(const u32x2*)(base + ro + bj * HALF + 16 * n);
                        f32x4 b; b[0] = __uint_as_float(bw.x << 16); b[1] = __uint_as_float(bw.x & 0xffff0000u); b[2] = __uint_as_float(bw.y << 16); b[3] = __uint_as_float(bw.y & 0xffff0000u);
                        *(f32x4*)(O + ro + bj * HALF + 16 * n) = b * alpha + acc[ai][bj][m][n]; } }
    }
};
struct EpiSwiGLU {
    static constexpr bool PERM = true, AFTER_DRAIN = false;
    bf16_t* O; int ldc; int ntn;
    __device__ __forceinline__ void operator()(const f32x4 (&acc)[2][2][4][2], const Unit& u, int wr, int wc, int fr, int fq) const {
        const int row0 = u.pm * BM + wr * 64 + fr, col0 = (u.pn % ntn) * HALF + wc * 32 + 8 * fq;
#pragma unroll
        for (int ai = 0; ai < 2; ++ai)
#pragma unroll
            for (int m = 0; m < 4; ++m) { const int row = row0 + ai * HALF + m * 16;
                bf16_t* rowp = O + ((size_t)(row >> 7) * (ldc >> 6) + (col0 >> 6)) * 8192 + (row & 127) * 64 + (col0 & 63);
                float h[8];
#pragma unroll
                for (int n = 0; n < 2; ++n) { const f32x4 g = acc[ai][0][m][n], up = acc[ai][1][m][n];
#pragma unroll
                    for (int j = 0; j < 4; ++j) h[4 * n + j] = g[j] * up[j] * __builtin_amdgcn_rcpf(1.f + __expf(-g[j])); }
                u32x4 w; w.x = cvt_pk_bf16(h[0], h[1]); w.y = cvt_pk_bf16(h[2], h[3]); w.z = cvt_pk_bf16(h[4], h[5]); w.w = cvt_pk_bf16(h[6], h[7]);
                *(u32x4*)rowp = w; }
    }
};
struct EpiScaleRow {
    static constexpr bool PERM = true, AFTER_DRAIN = false;
    bf16_t* O; int ldc; int ntn; const float* gate;
    __device__ __forceinline__ void operator()(const f32x4 (&acc)[2][2][4][2], const Unit& u, int wr, int wc, int fr, int fq) const {
        const int row0 = u.pm * BM + wr * 64 + fr, col0 = (u.pn % ntn) * BM + wc * 32 + 8 * fq;
#pragma unroll
        for (int ai = 0; ai < 2; ++ai)
#pragma unroll
            for (int m = 0; m < 4; ++m) { const int row = row0 + ai * HALF + m * 16; const float gsc = gate[row]; bf16_t* rowp = O + (size_t)row * ldc + col0;
#pragma unroll
                for (int bj = 0; bj < 2; ++bj) { const f32x4 v0 = acc[ai][bj][m][0] * gsc, v1 = acc[ai][bj][m][1] * gsc;
                    u32x4 w; w.x = cvt_pk_bf16(v0[0], v0[1]); w.y = cvt_pk_bf16(v0[2], v0[3]); w.z = cvt_pk_bf16(v1[0], v1[1]); w.w = cvt_pk_bf16(v1[2], v1[3]);
                    *(u32x4*)(rowp + bj * HALF) = w; } }
    }
};
template <class Epi, class Sched, bool ALIGN_EPI = false, bool SP2 = false, bool GATHER = false, bool ABLK = false>
__device__ __forceinline__ void gemm_phase(PG8_LAS unsigned char* lds, const Gemm g, const Sched& S, const Epi& E, const int* __restrict__ rowidx = nullptr) {
    static_assert(!GATHER || SP2, "GATHER is implemented for the SP2 loop");
    int tid_ = threadIdx.x; asm volatile("" : "+v"(tid_)); const int tid = tid_, wid = __builtin_amdgcn_readfirstlane(tid >> 6), lane = tid & 63, wr = wid >> 2, wc = wid & 3, fr = lane & 15, fq = lane >> 4;
    const int K = g.K, nt = K / BK;
    unsigned voffA[2], voffB[2];
#pragma unroll
    for (int i = 0; i < 2; ++i) { int R, C; stage_rc(tid * 16 + i * 8192, R, C); const int Rb = Epi::PERM ? ((R & ~31) + perm32(R & 31)) : R;
        voffA[i] = ABLK ? (unsigned)(R * BK + C) * 2u : (unsigned)(R * K + C) * 2u; voffB[i] = (unsigned)(Rb * K + C) * 2u; }
    int gR[2], gCc[2];
#pragma unroll
    for (int i = 0; i < 2; ++i) { int R, C; stage_rc(tid * 16 + i * 8192, R, C); gR[i] = R; gCc[i] = C * 2; }
    unsigned gC[2][2], gN[2][2];
#define PG8_GOFF(dst, pmv) do { _Pragma("unroll") for (int _h = 0; _h < 2; ++_h) _Pragma("unroll") for (int _i = 0; _i < 2; ++_i) \
        dst[_h][_i] = (unsigned)rowidx[(pmv) * BM + _h * HALF + gR[_i]] * (unsigned)(K * 2) + (unsigned)gCc[_i]; } while (0)
    const size_t kstep = (size_t)(BK * 2);
    const size_t kstepA = ABLK ? (size_t)(HALF * BK * 2) : kstep;
    const size_t hstep = (size_t)HALF * K * 2;
    const size_t tstep = 2 * hstep;
    const unsigned ldsw = (unsigned)wid * 1024u;
    const int aoff = lds_byte(wr * 64 + fr, fq * 8), boff = lds_byte(wc * 32 + fr, fq * 8);
#define PG8_SA(b, h) (((b) * 2 + (h)) * HTB)
#define PG8_SB(b, h) ((4 + (b) * 2 + (h)) * HTB)
#define PG8_STAGE(bufoff, gbase, voff) do { _Pragma("unroll") for (int _i = 0; _i < 2; ++_i) \
        __builtin_amdgcn_global_load_lds((const unsigned*)((const char*)(gbase) + (voff)[_i]), (PG8_LAS unsigned*)(lds + (bufoff) + ldsw + _i * 8192), 16, 0, 0); } while (0)
#define PG8_STAGE_A(bufoff, gbase, h, nx) do { if constexpr (GATHER) { unsigned _o[2]; _o[0] = (nx) ? gN[h][0] : gC[h][0]; _o[1] = (nx) ? gN[h][1] : gC[h][1]; PG8_STAGE(bufoff, gbase, _o); } \
        else { PG8_STAGE(bufoff, (gbase) + (h) * hstep, voffA); } } while (0)
#define PG8_LDA(dst, b, h) do { _Pragma("unroll") for (int m = 0; m < 4; ++m) _Pragma("unroll") for (int k = 0; k < 2; ++k) dst[m][k] = *(const PG8_LAS bf16x8*)(lds + PG8_SA(b, h) + aoff + m * 2048 + k * 1024); } while (0)
#define PG8_LDB(dst, b, h) do { _Pragma("unroll") for (int n = 0; n < 2; ++n) _Pragma("unroll") for (int k = 0; k < 2; ++k) dst[n][k] = *(const PG8_LAS bf16x8*)(lds + PG8_SB(b, h) + boff + n * 2048 + k * 1024); } while (0)
#define PG8_MMA(ai, bj, At, Bt) do { __builtin_amdgcn_s_setprio(1); _Pragma("unroll") for (int m = 0; m < 4; ++m) _Pragma("unroll") for (int n = 0; n < 2; ++n) _Pragma("unroll") for (int k = 0; k < 2; ++k) \
        acc[ai][bj][m][n] = __builtin_amdgcn_mfma_f32_16x16x32_bf16(Bt[n][k], At[m][k], acc[ai][bj][m][n], 0, 0, 0); __builtin_amdgcn_s_setprio(0); } while (0)
#define PG8_WAIT_V(n) asm volatile("s_waitcnt vmcnt(" #n ")" ::: "memory")
#define PG8_WAIT_L(n) asm volatile("s_waitcnt lgkmcnt(" #n ")" ::: "memory")
#define PG8_BAR __builtin_amdgcn_s_barrier()
#define PG8_SCHED __builtin_amdgcn_sched_barrier(0)
    Unit cur, nxt; int ui = 0;
    if (!S.next(0, cur)) return;
    f32x4 acc[2][2][4][2];
#pragma unroll
    for (int a = 0; a < 2; ++a)
#pragma unroll
        for (int b = 0; b < 2; ++b)
#pragma unroll
            for (int m = 0; m < 4; ++m)
#pragma unroll
                for (int n = 0; n < 2; ++n) acc[a][b][m][n] = (f32x4){0.f, 0.f, 0.f, 0.f};
    bf16x8 At[4][2], B0[2][2], B1[2][2];
    const char* cA = GATHER ? (const char*)g.A : (const char*)g.A + (size_t)cur.pm * tstep; const char* cB = (const char*)g.Bt + (size_t)cur.pn * tstep;
    if constexpr (GATHER) { PG8_GOFF(gC, cur.pm); PG8_GOFF(gN, cur.pm); }
    S.a_ready(cur);
    if constexpr (SP2) {
        PG8_STAGE(PG8_SB(0, 0), cB, voffB); PG8_STAGE(PG8_SB(0, 1), cB + hstep, voffB); PG8_STAGE_A(PG8_SA(0, 0), cA, 0, false); PG8_STAGE_A(PG8_SA(0, 1), cA, 1, false);
        if (wr == 1) PG8_BAR;
        PG8_WAIT_V(2); PG8_BAR;
        PG8_STAGE(PG8_SB(1, 0), cB + kstep, voffB); PG8_STAGE_A(PG8_SA(1, 0), cA + kstepA, 0, false); PG8_STAGE(PG8_SB(1, 1), cB + hstep + kstep, voffB);
        PG8_WAIT_V(6); PG8_BAR;
    } else {
        PG8_STAGE(PG8_SB(0, 0), cB, voffB); PG8_STAGE(PG8_SA(0, 0), cA, voffA); PG8_STAGE(PG8_SB(0, 1), cB + hstep, voffB); PG8_STAGE(PG8_SA(0, 1), cA + hstep, voffA);
        if (wr == 1) PG8_BAR;
        PG8_WAIT_V(4); PG8_BAR;
        PG8_STAGE(PG8_SB(1, 0), cB + kstep, voffB); PG8_STAGE(PG8_SA(1, 0), cA + kstep, voffA); PG8_STAGE(PG8_SB(1, 1), cB + hstep + kstep, voffB);
        PG8_WAIT_V(6); PG8_BAR;
    }
    for (;;) {
        const bool has_next = S.next(ui + 1, nxt);
        const char* nA = GATHER ? cA : (has_next ? (const char*)g.A + (size_t)nxt.pm * tstep : cA); const char* nB = has_next ? (const char*)g.Bt + (size_t)nxt.pn * tstep : cB;
        if constexpr (GATHER) { if (has_next) PG8_GOFF(gN, nxt.pm); }
        for (int t = 0; t < nt; t += 2) {
            const bool last = (t == nt - 2);
            const char* a1 = cA + (size_t)(t + 1) * kstepA;
            const char* a2 = last ? nA : cA + (size_t)(t + 2) * kstepA; const char* b2 = last ? nB : cB + (size_t)(t + 2) * kstep;
            const char* a3 = a2 + kstepA; const char* b3 = b2 + kstep;
            if (last && has_next) S.a_ready(nxt);
            if constexpr (SP2) {
            PG8_LDB(B0, 0, 0); PG8_LDB(B1, 0, 1); PG8_SCHED; PG8_LDA(At, 0, 0); PG8_STAGE_A(PG8_SA(1, 1), a1, 1, false);
            PG8_WAIT_V(8); PG8_WAIT_L(0); PG8_BAR; PG8_MMA(0, 0, At, B0); PG8_MMA(0, 1, At, B1); PG8_BAR; PG8_SCHED;
            PG8_LDA(At, 0, 1); PG8_STAGE(PG8_SB(0, 0), b2, voffB); PG8_STAGE(PG8_SB(0, 1), b2 + hstep, voffB); PG8_STAGE_A(PG8_SA(0, 0), a2, 0, last);
            PG8_WAIT_V(8); PG8_WAIT_L(0); PG8_BAR; PG8_MMA(1, 0, At, B0); PG8_MMA(1, 1, At, B1); PG8_BAR; PG8_SCHED;
            PG8_LDB(B0, 1, 0); PG8_LDB(B1, 1, 1); PG8_SCHED; PG8_LDA(At, 1, 0); PG8_STAGE_A(PG8_SA(0, 1), a2, 1, last);
            PG8_WAIT_V(8); PG8_WAIT_L(0); PG8_BAR; PG8_MMA(0, 0, At, B0); PG8_MMA(0, 1, At, B1); PG8_BAR; PG8_SCHED;
            PG8_LDA(At, 1, 1); PG8_STAGE(PG8_SB(1, 0), b3, voffB); PG8_STAGE(PG8_SB(1, 1), b3 + hstep, voffB); PG8_STAGE_A(PG8_SA(1, 0), a3, 0, last);
            PG8_WAIT_V(8); PG8_WAIT_L(0); PG8_BAR; PG8_MMA(1, 0, At, B0); PG8_MMA(1, 1, At, B1); PG8_BAR; PG8_SCHED;
            } else {
            PG8_LDB(B0, 0, 0); PG8_SCHED; PG8_LDA(At, 0, 0); PG8_STAGE(PG8_SA(1, 1), a1 + hstep, voffA);
            PG8_WAIT_L(8); PG8_BAR; PG8_WAIT_L(0); PG8_MMA(0, 0, At, B0); PG8_BAR; PG8_SCHED;
            PG8_LDB(B1, 0, 1); PG8_STAGE(PG8_SB(0, 0), b2, voffB);
            PG8_BAR; PG8_WAIT_L(0); PG8_MMA(0, 1, At, B1); PG8_BAR;
            PG8_LDA(At, 0, 1); PG8_STAGE(PG8_SA(0, 0), a2, voffA);
            PG8_BAR; PG8_WAIT_L(0); PG8_MMA(1, 0, At, B0); PG8_BAR; PG8_SCHED;
            PG8_STAGE(PG8_SB(0, 1), b2 + hstep, voffB);
            PG8_WAIT_V(6); PG8_BAR; PG8_MMA(1, 1, At, B1); PG8_BAR;
            PG8_LDB(B0, 1, 0); PG8_SCHED; PG8_LDA(At, 1, 0); PG8_STAGE(PG8_SA(0, 1), a2 + hstep, voffA);
            PG8_WAIT_L(8); PG8_BAR; PG8_WAIT_L(0); PG8_MMA(0, 0, At, B0); PG8_BAR; PG8_SCHED;
            PG8_LDB(B1, 1, 1); PG8_STAGE(PG8_SB(1, 0), b3, voffB);
            PG8_BAR; PG8_WAIT_L(0); PG8_MMA(0, 1, At, B1); PG8_BAR;
            PG8_LDA(At, 1, 1); PG8_STAGE(PG8_SA(1, 0), a3, voffA);
            PG8_BAR; PG8_WAIT_L(0); PG8_MMA(1, 0, At, B0); PG8_BAR; PG8_SCHED;
            PG8_STAGE(PG8_SB(1, 1), b3 + hstep, voffB);
            PG8_WAIT_V(6); PG8_BAR; PG8_MMA(1, 1, At, B1); PG8_BAR;
            }
        }
        if constexpr (ALIGN_EPI) { if (wr == 0) PG8_BAR; }
        if constexpr (!Epi::AFTER_DRAIN) { E(acc, cur, wr, wc, fr, fq); S.done(cur); }
        if (!has_next) break;
#pragma unroll
        for (int a = 0; a < 2; ++a)
#pragma unroll
            for (int b = 0; b < 2; ++b)
#pragma unroll
                for (int m = 0; m < 4; ++m)
#pragma unroll
                    for (int n = 0; n < 2; ++n) acc[a][b][m][n] = (f32x4){0.f, 0.f, 0.f, 0.f};
        cur = nxt; cA = nA; cB = nB; ++ui;
        if constexpr (GATHER) { _Pragma("unroll") for (int _h = 0; _h < 2; ++_h) _Pragma("unroll") for (int _i = 0; _i < 2; ++_i) gC[_h][_i] = gN[_h][_i]; }
        if constexpr (ALIGN_EPI) { if (wr == 1) PG8_BAR; }
    }
    PG8_WAIT_V(0);
    if constexpr (!ALIGN_EPI) { if (wr == 0) PG8_BAR; }
    PG8_BAR;
    if constexpr (Epi::AFTER_DRAIN) { E.fused(acc, cur, wr, wc, fr, fq, lds, wid, lane); S.done(cur); }
#undef PG8_SA
#undef PG8_SB
#undef PG8_STAGE
#undef PG8_STAGE_A
#undef PG8_GOFF
#undef PG8_LDA
#undef PG8_LDB
#undef PG8_MMA
#undef PG8_WAIT_V
#undef PG8_WAIT_L
#undef PG8_BAR
#undef PG8_SCHED
}
}

using pg8::bf16_t; using pg8::bf16x8; using pg8::f32x4; using pg8::u32x4; using pg8::u32x2;
#define LAS __attribute__((address_space(3)))
typedef short bf16x4 __attribute__((ext_vector_type(4)));

constexpr int NB = 4, SEQ = 4096, DM = 1024, MTOK = NB * SEQ, DIN = 2048, NE = 16, FF = 2048, CAP = 512, NROWX = NE * NB * CAP;
constexpr float ALPHA = 1.41421356237309515f, LN_EPS = 1e-5f;
constexpr int NWAVES = 8, NTHR = 512;
constexpr int LDS_BYTES = 147456;
constexpr int S5T = 32, S5NCH = SEQ / S5T;

constexpr size_t MiB = 1u << 20;
constexpr size_t WS_WIN = 0, WS_WOUT = 8 * MiB, WS_WGLU = 12 * MiB, WS_S5TAB = 13 * MiB, WS_AFFT = 14 * MiB, WS_IDX = 15 * MiB, WS_GATE = 16 * MiB, WS_SLOT = 17 * MiB, WS_BAR = 18 * MiB, WS_S5BT = 19 * MiB, WS_S5CT = 20 * MiB;
constexpr size_t WS_WGU = 32 * MiB, WS_WD = 288 * MiB, WS_H32 = 416 * MiB, WS_HBF = 480 * MiB, WS_RA = 512 * MiB  , WS_RB = 576 * MiB  ;
constexpr size_t WS_HDN = 640 * MiB, WS_KVF = 768 * MiB, WS_KVB = 776 * MiB, WS_STF = 784 * MiB, WS_STB = 792 * MiB, WS_S5E = 800 * MiB, WS_S5C = 808 * MiB, WS_END = 816 * MiB;

struct Args { const float* in[25]; float* out; unsigned char* ws; int ph_lo, ph_hi; };

typedef __bf16 bf16x2_hw __attribute__((ext_vector_type(2)));
typedef float f32x2_hw __attribute__((ext_vector_type(2)));
__device__ __forceinline__ unsigned pk2(float lo, float hi) { const f32x2_hw v = {lo, hi}; const bf16x2_hw b = __builtin_convertvector(v, bf16x2_hw); return __builtin_bit_cast(unsigned, b); }
__device__ __forceinline__ unsigned f2bf(float f) { return pk2(f, 0.f) & 0xffffu; }
__device__ __forceinline__ float bflo(unsigned w) { return __uint_as_float(w << 16); }
__device__ __forceinline__ float bfhi(unsigned w) { return __uint_as_float(w & 0xffff0000u); }
__device__ __forceinline__ f32x4 mfma16(bf16x8 a, bf16x8 b, f32x4 c) { return __builtin_amdgcn_mfma_f32_16x16x32_bf16(a, b, c, 0, 0, 0); }
__device__ __forceinline__ float wave_sum(float v) {
#pragma unroll
    for (int o = 1; o < 64; o <<= 1) v += __shfl_xor(v, o);
    return v;
}
__device__ __forceinline__ bf16x8 pack8(const f32x4& a, const f32x4& b) {
    u32x4 w; w.x = pk2(a[0], a[1]); w.y = pk2(a[2], a[3]); w.z = pk2(b[0], b[1]); w.w = pk2(b[2], b[3]);
    return __builtin_bit_cast(bf16x8, w);
}
__device__ __forceinline__ bf16x8 cat8(bf16x4 lo, bf16x4 hi) { bf16x8 r; r[0] = lo[0]; r[1] = lo[1]; r[2] = lo[2]; r[3] = lo[3]; r[4] = hi[0]; r[5] = hi[1]; r[6] = hi[2]; r[7] = hi[3]; return r; }
#define LDS_WAIT() asm volatile("s_waitcnt lgkmcnt(0)" ::: "memory")

struct ConvItem { const float* srcp; bf16_t* dstp; int N; int rstep; };
__device__ __forceinline__ ConvItem conv_decode(const Args& a, int it, int lane) {
    constexpr int I3 = 16384, I4 = 16384, I5 = 16384, I0 = 1024, I1 = 512;
    unsigned char* ws = a.ws;
    const float* src; bf16_t* dst; int K, N, rmul = 1, ro = 0, kb, nb;
    int r = it;
    if (r < I3 + I4) { const int up = r >= I3; r -= up ? I3 : 0; const int mat = r >> 9, q = r & 511; src = (up ? a.in[21] : a.in[20]) + (size_t)mat * DM * FF; dst = (bf16_t*)(ws + WS_WGU) + (size_t)mat * 2 * FF * DM; K = DM; N = FF; rmul = 2; ro = up; kb = q >> 5; nb = q & 31; }
    else { r -= I3 + I4;
        if (r < I5) { const int mat = r >> 9, q = r & 511; src = a.in[22] + (size_t)mat * FF * DM; dst = (bf16_t*)(ws + WS_WD) + (size_t)mat * DM * FF; K = FF; N = DM; kb = q >> 4; nb = q & 15; }
        else { r -= I5;
            if (r < I0) { const int mat = r >> 9, q = r & 511; src = a.in[3] + (size_t)mat * DM * DIN; dst = (bf16_t*)(ws + WS_WIN) + (size_t)mat * DIN * DM; K = DM; N = DIN; kb = q >> 5; nb = q & 31; }
            else { r -= I0;
                if (r < I1) { const int mat = r >> 8, q = r & 255; src = a.in[16] + (size_t)mat * DM * DM; dst = (bf16_t*)(ws + WS_WOUT) + (size_t)mat * DM * DM; K = DM; N = DM; kb = q >> 4; nb = q & 15; }
                else { r -= I1; const int mat = r >> 4, q = r & 15; src = a.in[13] + (size_t)mat * 65536; dst = (bf16_t*)(ws + WS_WGLU) + (size_t)mat * 65536; K = 256; N = 256; kb = q >> 2; nb = q & 3; } } } }
    ConvItem c; c.N = N;
    c.srcp = src + (size_t)(kb * 64 + (lane >> 4)) * N + nb * 64 + (lane & 15) * 4;
    if (rmul == 2) { c.dstp = dst + (size_t)((nb >> 1) * 256 + ro * 128 + (nb & 1) * 64) * K + kb * 64; c.rstep = K; }
    else { c.dstp = dst + (size_t)(nb * 64) * K + kb * 64; c.rstep = K; }
    return c;
}
__device__ __forceinline__ void conv_load(const ConvItem& c, f32x4 (&v)[16]) {
#pragma unroll
    for (int i = 0; i < 16; ++i) v[i] = __builtin_nontemporal_load((const f32x4*)(c.srcp + (size_t)(i * 4) * c.N));
}
__device__ __forceinline__ void conv_store(const ConvItem& c, const f32x4 (&v)[16], LAS float* scr, int lane) {
    const int r4 = lane >> 4, c4 = (lane & 15) * 4;
#pragma unroll
    for (int i = 0; i < 16; ++i) { const int kk = i * 4 + r4; *(LAS f32x4*)(scr + kk * 68 + (c4 ^ (((kk >> 3) & 7) * 4))) = v[i]; }
    LDS_WAIT();
    const int cc = lane & 7, nl = lane >> 3;
#pragma unroll
    for (int p = 0; p < 8; ++p) {
        const int n = nl + 8 * p;
        const LAS float* s = scr + (8 * cc) * 68 + (n ^ (4 * cc));
        u32x4 o; o.x = pk2(s[0], s[68]); o.y = pk2(s[2 * 68], s[3 * 68]); o.z = pk2(s[4 * 68], s[5 * 68]); o.w = pk2(s[6 * 68], s[7 * 68]);
        *(u32x4*)(c.dstp + (size_t)n * c.rstep + 8 * cc) = o;
    }
    LDS_WAIT();
}
__device__ __forceinline__ void sincos_rev(double f, double& sn, double& cs) {
    const double a = f * 6.283185307179586476925;
    const double q = rint(a * 0.636619772367581343);
    const double r = a - q * 1.570796326794896619;
    const double r2 = r * r;
    double s = -7.6471637318198164759e-13; s = s * r2 + 1.6059043836821614599e-10; s = s * r2 - 2.5052108385441718775e-8; s = s * r2 + 2.7557319223985890653e-6;
    s = s * r2 - 1.9841269841269841270e-4; s = s * r2 + 8.3333333333333333333e-3; s = s * r2 - 1.6666666666666666667e-1; s = s * r2 * r + r;
    double c = 4.7794773323873852974e-14; c = c * r2 - 1.1470745597729724714e-11; c = c * r2 + 2.0876756987868098979e-9; c = c * r2 - 2.7557319223985890653e-7;
    c = c * r2 + 2.4801587301587301587e-5; c = c * r2 - 1.3888888888888888889e-3; c = c * r2 + 4.1666666666666666667e-2; c = c * r2 - 0.5; c = c * r2 + 1.0;
    const int qi = ((int)q) & 3;
    sn = (qi == 0) ? s : (qi == 1) ? c : (qi == 2) ? -s : -c;
    cs = (qi == 0) ? c : (qi == 1) ? -s : (qi == 2) ? -c : s;
}
__device__ __forceinline__ double exp_small(double x) {
    const double y = x * (1.0 / 64.0);
    double e = 1.0 / 479001600.0;
    e = e * y + 1.0 / 39916800.0; e = e * y + 1.0 / 3628800.0; e = e * y + 1.0 / 362880.0; e = e * y + 1.0 / 40320.0; e = e * y + 1.0 / 5040.0; e = e * y + 1.0 / 720.0;
    e = e * y + 1.0 / 120.0; e = e * y + 1.0 / 24.0; e = e * y + 1.0 / 6.0; e = e * y + 0.5; e = e * y + 1.0; e = e * y + 1.0;
#pragma unroll
    for (int i = 0; i < 6; ++i) e = e * e;
    return e;
}
__device__ __forceinline__ void s5_coefs(const Args& a, int t, double& br, double& bi, double& cr, double& ci, double& tr, double& ti) {
    const int g = (t >> 6) & 15, lr = t >> 10;
    const double lre = (double)a.in[5][t], lim = (double)a.in[6][t];
    const double step = exp_small((double)a.in[7][lr * 16 + g]);
    const double ar = lre * step, th = lim * step;
    const double rev = th * 0.15915494309189533577; const double fr = rev - rint(rev);
    double sn, cs; sincos_rev(fr, sn, cs);
    const double mag = exp_small(ar);
    br = mag * cs; bi = mag * sn;
    const double nr = br - 1.0, ni = bi, den = lre * lre + lim * lim;
    cr = (nr * lre + ni * lim) / den; ci = (ni * lre - nr * lim) / den;
    const double rev2 = rev * (double)S5T; const double fr2 = rev2 - rint(rev2);
    double sn2, cs2; sincos_rev(fr2, sn2, cs2);
    const double mag2 = exp_small(ar * (double)S5T);
    tr = mag2 * cs2; ti = mag2 * sn2;
}
__device__ __forceinline__ void s5_table_entry(const Args& a, int t) {
    double br, bi, cr, ci, tr, ti; s5_coefs(a, t, br, bi, cr, ci, tr, ti);
    float* o = (float*)(a.ws + WS_S5TAB) + (size_t)t * 8;
    o[0] = (float)br; o[1] = (float)bi; o[2] = (float)cr; o[3] = (float)ci; o[4] = (float)tr; o[5] = (float)ti; o[6] = 0.f; o[7] = 0.f;
}
__device__ __forceinline__ void s5_bt_row(const Args& a, int t) {
    const int l = t >> 12, g = (t >> 8) & 15, n = t & 255, r = n >> 7, p = (n >> 1) & 63, ri = n & 1;
    double br, bi, cr, ci, tr, ti; s5_coefs(a, ((l * 2 + r) * 16 + g) * 64 + p, br, bi, cr, ci, tr, ti);
    const float crf = (float)cr, cif = (float)ci;
    const float* bre = a.in[8] + (size_t)((l * 16 + g) * 64 + p) * 16; const float* bim = a.in[9] + (size_t)((l * 16 + g) * 64 + p) * 16;
    u32x4 o[2];
#pragma unroll
    for (int h = 0; h < 2; ++h) {
        const f32x4 x0 = *(const f32x4*)(bre + 8 * h), x1 = *(const f32x4*)(bre + 8 * h + 4), y0 = *(const f32x4*)(bim + 8 * h), y1 = *(const f32x4*)(bim + 8 * h + 4);
        float v[8];
#pragma unroll
        for (int k = 0; k < 4; ++k) { v[k] = ri ? (crf * y0[k] + cif * x0[k]) : (crf * x0[k] - cif * y0[k]); v[4 + k] = ri ? (crf * y1[k] + cif * x1[k]) : (crf * x1[k] - cif * y1[k]); }
        o[h].x = pk2(v[0], v[1]); o[h].y = pk2(v[2], v[3]); o[h].z = pk2(v[4], v[5]); o[h].w = pk2(v[6], v[7]);
    }
    u32x4* dst = (u32x4*)((bf16_t*)(a.ws + WS_S5BT) + (size_t)t * 32);
    dst[0] = o[0]; dst[1] = o[1]; dst[2] = (u32x4){0u, 0u, 0u, 0u}; dst[3] = (u32x4){0u, 0u, 0u, 0u};
}
__device__ __forceinline__ void s5_ct_entry(const Args& a, int t) {
    const int p = t & 63, r = (t >> 6) & 1, c = (t >> 7) & 15, g = (t >> 11) & 15, l = t >> 15;
    const size_t ci = (size_t)(((l * 2 + r) * 16 + g) * 16 + c) * 64 + p;
    ((unsigned*)(a.ws + WS_S5CT))[t] = pk2(a.in[10][ci], -a.in[11][ci]);
}
__device__ __forceinline__ void ln_rows4(f32x4 (&v)[4], const float* __restrict__ g, const float* __restrict__ bt, int lane) {
    float s = 0.f;
#pragma unroll
    for (int j = 0; j < 4; ++j) s += (v[j][0] + v[j][1]) + (v[j][2] + v[j][3]);
    const float mean = wave_sum(s) * (1.f / DM); float s2 = 0.f;
#pragma unroll
    for (int j = 0; j < 4; ++j) { v[j] = v[j] - mean; s2 += (v[j][0] * v[j][0] + v[j][1] * v[j][1]) + (v[j][2] * v[j][2] + v[j][3] * v[j][3]); }
    const float rstd = 1.f / sqrtf(wave_sum(s2) * (1.f / DM) + LN_EPS);
#pragma unroll
    for (int j = 0; j < 4; ++j) { const f32x4 gv = ((const f32x4*)g)[lane + 64 * j], bv = ((const f32x4*)bt)[lane + 64 * j]; v[j] = v[j] * rstd * gv + bv; }
}
__device__ __forceinline__ void store_row(const f32x4 (&v)[4], float* o32, bf16_t* obf, int lane) {
#pragma unroll
    for (int j = 0; j < 4; ++j) {
        if (o32) ((f32x4*)o32)[lane + 64 * j] = v[j];
        if (obf) { u32x2 w; w.x = pk2(v[j][0], v[j][1]); w.y = pk2(v[j][2], v[j][3]); ((u32x2*)obf)[lane + 64 * j] = w; }
    }
}
__device__ __forceinline__ void phase_p0(const Args& a, LAS unsigned char* lds, int tid) {
    const int lane = tid & 63, wave = tid >> 6;
    const int gw = blockIdx.x * NWAVES + wave, NGW = gridDim.x * NWAVES;
    LAS float* scr = (LAS float*)(lds + wave * 17408);
    unsigned char* ws = a.ws;
    constexpr int NIT = 16384 * 3 + 1024 + 512 + 32;
    if (gw < NIT) {
        ConvItem cur = conv_decode(a, gw, lane);
        f32x4 v[16]; conv_load(cur, v);
        for (int it = gw; it < NIT; it += NGW) {
            const bool more = (it + NGW) < NIT;
            ConvItem nxt = cur; f32x4 vn[16];
            if (more) { nxt = conv_decode(a, it + NGW, lane); conv_load(nxt, vn); }
            conv_store(cur, v, scr, lane);
            if (more) { cur = nxt;
#pragma unroll
                for (int i = 0; i < 16; ++i) v[i] = vn[i]; }
        }
    }
    for (int t = blockIdx.x * NTHR + tid; t < 4096; t += gridDim.x * NTHR) s5_table_entry(a, t);
    for (int t = blockIdx.x * NTHR + tid; t < 8192; t += gridDim.x * NTHR) s5_bt_row(a, t);
    for (int t = blockIdx.x * NTHR + tid; t < 65536; t += gridDim.x * NTHR) s5_ct_entry(a, t);
    for (int m = gw; m < MTOK; m += NGW) {
        f32x4 v[4];
#pragma unroll
        for (int j = 0; j < 4; ++j) v[j] = ((const f32x4*)(a.in[0] + (size_t)m * DM))[lane + 64 * j];
        ln_rows4(v, a.in[1], a.in[2], lane);
        store_row(v, nullptr, (bf16_t*)(ws + WS_HBF) + (size_t)m * DM, lane);
    }
}

__device__ __forceinline__ void attn_item(int item, const bf16_t* __restrict__ proj, bf16_t* __restrict__ mix, const float* __restrict__ sink_l, LAS unsigned char* lds, int tid) {
    const int kh = item & 1, c = (item >> 1) & 31, b = item >> 6;
    constexpr int VS = 408;
    LAS bf16_t* Ks = (LAS bf16_t*)lds;
    LAS bf16_t* Vt = (LAS bf16_t*)(lds + 384 * 72 * 2);
    const int lane = tid & 63, w = tid >> 6, fr = lane & 15, fq = lane >> 4;
    const int hq = kh * 4 + (w >> 1);
    const bf16_t* qbase = proj + ((size_t)b * SEQ + c * 128 + (w & 1) * 64 + fr) * DIN + 1280 + hq * 64 + fq * 8;
    bf16x8 qn0 = *(const bf16x8*)qbase, qn1 = *(const bf16x8*)(qbase + 32);
#pragma unroll
    for (int i = 0; i < 6; ++i) {
        const int id = tid + NTHR * i, key = id >> 3, ch = id & 7;
        const int s = (c - 1) * 128 + key; const bool ok = (s >= 0) && (s < SEQ);
        u32x4 kv = {0u, 0u, 0u, 0u}, vv = {0u, 0u, 0u, 0u};
        if (ok) { const bf16_t* rowp = proj + (size_t)(b * SEQ + s) * DIN; kv = *(const u32x4*)(rowp + 1792 + kh * 64 + ch * 8); vv = *(const u32x4*)(rowp + 1920 + kh * 64 + ch * 8); }
        *(LAS u32x4*)(Ks + key * 72 + ch * 8) = kv;
        LAS bf16_t* vp = Vt + (ch * 8) * VS + key;
        vp[0 * VS] = (bf16_t)(vv.x & 0xffffu); vp[1 * VS] = (bf16_t)(vv.x >> 16); vp[2 * VS] = (bf16_t)(vv.y & 0xffffu); vp[3 * VS] = (bf16_t)(vv.y >> 16);
        vp[4 * VS] = (bf16_t)(vv.z & 0xffffu); vp[5 * VS] = (bf16_t)(vv.z >> 16); vp[6 * VS] = (bf16_t)(vv.w & 0xffffu); vp[7 * VS] = (bf16_t)(vv.w >> 16);
    }
    if (tid < 128) { const int d = tid >> 1, hh = tid & 1; *(LAS u32x4*)(Vt + d * VS + 384 + hh * 8) = (u32x4){0u, 0u, 0u, 0u}; }
    __syncthreads();
    const float slope = exp2f(-(float)(hq + 1));
    const float sinkv = sink_l[hq];
    const bool lo_ok = (c >= 1), hi_ok = (c <= 30);
    float plo[4], phi[4];
#pragma unroll
    for (int j = 0; j < 4; ++j) { plo[j] = (fq * 4 + j >= fr) ? 0.f : -1e30f; phi[j] = (fq * 4 + j <= fr) ? 0.f : -1e30f; }
#pragma unroll 1
    for (int qi = 0; qi < 4; ++qi) {
        const int qt = (w & 1) * 4 + qi;
        const size_t tok = (size_t)b * SEQ + c * 128 + qt * 16 + fr;
        const bf16x8 qa0 = qn0, qa1 = qn1;
        float slope_l = slope; asm volatile("" : "+v"(slope_l));
        float sd[4];
#pragma unroll
        for (int j = 0; j < 4; ++j) sd[j] = slope_l * (float)(fq * 4 + j - fr);
        if (qi < 3) { const bf16_t* qp = qbase + (size_t)(qi + 1) * 16 * DIN; qn0 = *(const bf16x8*)qp; qn1 = *(const bf16x8*)(qp + 32); }
        f32x4 s[18];
        float mx = sinkv;
        const LAS bf16_t* kbase = Ks + (qt * 16 + fr) * 72 + fq * 8;
        const LAS bf16_t* vbase = Vt + fr * VS + qt * 16 + fq * 4;
#pragma unroll
        for (int i = 0; i < 17; ++i) {
            const int kt = qt + i;
            const LAS bf16_t* kp = kbase + i * (16 * 72);
            f32x4 acc = {0.f, 0.f, 0.f, 0.f};
            acc = mfma16(*(const LAS bf16x8*)kp, qa0, acc); acc = mfma16(*(const LAS bf16x8*)(kp + 32), qa1, acc);
            const float pblk = ((kt < 8) ? lo_ok : ((kt >= 16) ? hi_ok : true)) ? 0.f : -1e30f;
            const float base = slope_l * (float)(16 * i - 128);
#pragma unroll
            for (int j = 0; j < 4; ++j) {
                float t = (i < 8) ? (base + sd[j]) : ((i > 8) ? -(base + sd[j]) : -fabsf(sd[j]));
                if (i == 0) t += plo[j];
                if (i == 16) t += phi[j];
                const float v = fmaf(acc[j], 0.125f, t + pblk);
                acc[j] = v; mx = fmaxf(mx, v);
            }
            s[i] = acc;
        }
        mx = fmaxf(mx, __shfl_xor(mx, 16)); mx = fmaxf(mx, __shfl_xor(mx, 32));
        float sum = 0.f;
#pragma unroll
        for (int i = 0; i < 17; ++i)
#pragma unroll
            for (int j = 0; j < 4; ++j) { const float p = __expf(s[i][j] - mx); s[i][j] = p; sum += p; }
        s[17] = (f32x4){0.f, 0.f, 0.f, 0.f};
        sum += __shfl_xor(sum, 16); sum += __shfl_xor(sum, 32);
        const float inv = 1.f / (sum + __expf(sinkv - mx));
        f32x4 o[4];
#pragma unroll
        for (int dt = 0; dt < 4; ++dt) o[dt] = (f32x4){0.f, 0.f, 0.f, 0.f};
#pragma unroll
        for (int kk = 0; kk < 9; ++kk) {
            const bf16x8 pb = pack8(s[2 * kk], s[2 * kk + 1]);
#pragma unroll
            for (int dt = 0; dt < 4; ++dt) {
                const LAS bf16_t* vp = vbase + dt * (16 * VS) + kk * 32;
                o[dt] = mfma16(cat8(*(const LAS bf16x4*)vp, *(const LAS bf16x4*)(vp + 16)), pb, o[dt]);
            }
        }
        bf16_t* op = mix + tok * DM + 512 + hq * 64 + fq * 4;
#pragma unroll
        for (int dt = 0; dt < 4; ++dt) { u32x2 wv; wv.x = pk2(o[dt][0] * inv, o[dt][1] * inv); wv.y = pk2(o[dt][2] * inv, o[dt][3] * inv); *(u32x2*)(op + dt * 16) = wv; }
    }
    __syncthreads();
}

__device__ __forceinline__ float log_sigmoid(float t) { return -log1pf(__expf(-t)); }
__device__ __forceinline__ void retkv_item(int item, const bf16_t* __restrict__ proj, float* __restrict__ kvf, float* __restrict__ kvb, const float* __restrict__ theta, LAS unsigned char* lds, int tid) {
    const int h = item & 3, c = (item >> 2) & 31, b = item >> 7;
    const float lgf = log_sigmoid(theta[h]), lgb = log_sigmoid(theta[4 + h]);
    LAS bf16_t* KTf = (LAS bf16_t*)lds; LAS bf16_t* KTb = KTf + 64 * 136; LAS bf16_t* VT = KTb + 64 * 136;
#pragma unroll
    for (int i = 0; i < 2; ++i) {
        const int id = tid + NTHR * i, j = id >> 3, ch = id & 7;
        const bf16_t* rowp = proj + (size_t)(b * SEQ + c * 128 + j) * DIN;
        const u32x4 kr = *(const u32x4*)(rowp + 256 + h * 64 + ch * 8), vr = *(const u32x4*)(rowp + 512 + h * 64 + ch * 8);
        const float wf = __expf(lgf * (float)(127 - j)) * 0.125f, wb = __expf(lgb * (float)j) * 0.125f;
        const int o = (ch * 8) * 136 + j;
        KTf[o + 0 * 136] = (bf16_t)f2bf(bflo(kr.x) * wf); KTf[o + 1 * 136] = (bf16_t)f2bf(bfhi(kr.x) * wf); KTf[o + 2 * 136] = (bf16_t)f2bf(bflo(kr.y) * wf); KTf[o + 3 * 136] = (bf16_t)f2bf(bfhi(kr.y) * wf);
        KTf[o + 4 * 136] = (bf16_t)f2bf(bflo(kr.z) * wf); KTf[o + 5 * 136] = (bf16_t)f2bf(bfhi(kr.z) * wf); KTf[o + 6 * 136] = (bf16_t)f2bf(bflo(kr.w) * wf); KTf[o + 7 * 136] = (bf16_t)f2bf(bfhi(kr.w) * wf);
        KTb[o + 0 * 136] = (bf16_t)f2bf(bflo(kr.x) * wb); KTb[o + 1 * 136] = (bf16_t)f2bf(bfhi(kr.x) * wb); KTb[o + 2 * 136] = (bf16_t)f2bf(bflo(kr.y) * wb); KTb[o + 3 * 136] = (bf16_t)f2bf(bfhi(kr.y) * wb);
        KTb[o + 4 * 136] = (bf16_t)f2bf(bflo(kr.z) * wb); KTb[o + 5 * 136] = (bf16_t)f2bf(bfhi(kr.z) * wb); KTb[o + 6 * 136] = (bf16_t)f2bf(bflo(kr.w) * wb); KTb[o + 7 * 136] = (bf16_t)f2bf(bfhi(kr.w) * wb);
        VT[o + 0 * 136] = (bf16_t)(vr.x & 0xffffu); VT[o + 1 * 136] = (bf16_t)(vr.x >> 16); VT[o + 2 * 136] = (bf16_t)(vr.y & 0xffffu); VT[o + 3 * 136] = (bf16_t)(vr.y >> 16);
        VT[o + 4 * 136] = (bf16_t)(vr.z & 0xffffu); VT[o + 5 * 136] = (bf16_t)(vr.z >> 16); VT[o + 6 * 136] = (bf16_t)(vr.w & 0xffffu); VT[o + 7 * 136] = (bf16_t)(vr.w >> 16);
    }
    __syncthreads();
    const int lane = tid & 63, w = tid >> 6, fr = lane & 15, fq = lane >> 4;
    const size_t obase = (size_t)((b * 32 + c) * 4 + h) * 4096;
#pragma unroll
    for (int i = 0; i < 4; ++i) {
        const int job = w * 4 + i, dirb = job >> 4, et = (job >> 2) & 3, dt = job & 3;
        const LAS bf16_t* ap = VT + (et * 16 + fr) * 136 + fq * 8;
        const LAS bf16_t* bp = (dirb ? KTb : KTf) + (dt * 16 + fr) * 136 + fq * 8;
        f32x4 acc = {0.f, 0.f, 0.f, 0.f};
#pragma unroll
        for (int ks = 0; ks < 4; ++ks) acc = mfma16(*(const LAS bf16x8*)(ap + ks * 32), *(const LAS bf16x8*)(bp + ks * 32), acc);
        float* op = (dirb ? kvb : kvf) + obase + (et * 16 + fq * 4) * 64 + dt * 16 + fr;
        op[0] = acc[0]; op[64] = acc[1]; op[128] = acc[2]; op[192] = acc[3];
    }
    __syncthreads();
}
__device__ __forceinline__ void retout_item(int item, const bf16_t* __restrict__ proj, const float* __restrict__ stf, const float* __restrict__ stb, bf16_t* __restrict__ mix, const float* __restrict__ theta, LAS unsigned char* lds, int tid) {
    const int h = item & 3, c = (item >> 2) & 31, b = item >> 7;
    const float lgf = log_sigmoid(theta[h]), lgb = log_sigmoid(theta[4 + h]);
    LAS bf16_t* Qs = (LAS bf16_t*)lds; LAS bf16_t* Ks = Qs + 128 * 72; LAS bf16_t* VT = Ks + 128 * 72; LAS bf16_t* SFt = VT + 64 * 136; LAS bf16_t* SBt = SFt + 64 * 72;
#pragma unroll
    for (int i = 0; i < 2; ++i) {
        const int id = tid + NTHR * i, j = id >> 3, ch = id & 7;
        const bf16_t* rowp = proj + (size_t)(b * SEQ + c * 128 + j) * DIN;
        const u32x4 qr = *(const u32x4*)(rowp + h * 64 + ch * 8), kr = *(const u32x4*)(rowp + 256 + h * 64 + ch * 8), vr = *(const u32x4*)(rowp + 512 + h * 64 + ch * 8);
        *(LAS u32x4*)(Qs + j * 72 + ch * 8) = qr; *(LAS u32x4*)(Ks + j * 72 + ch * 8) = kr;
        const int o = (ch * 8) * 136 + j;
        VT[o + 0 * 136] = (bf16_t)(vr.x & 0xffffu); VT[o + 1 * 136] = (bf16_t)(vr.x >> 16); VT[o + 2 * 136] = (bf16_t)(vr.y & 0xffffu); VT[o + 3 * 136] = (bf16_t)(vr.y >> 16);
        VT[o + 4 * 136] = (bf16_t)(vr.z & 0xffffu); VT[o + 5 * 136] = (bf16_t)(vr.z >> 16); VT[o + 6 * 136] = (bf16_t)(vr.w & 0xffffu); VT[o + 7 * 136] = (bf16_t)(vr.w >> 16);
    }
    const size_t sbase = (size_t)((b * 32 + c) * 4 + h) * 4096;
#pragma unroll
    for (int i = 0; i < 8; ++i) { const int id = tid + NTHR * i, e = id >> 6, d = id & 63; SFt[e * 72 + d] = (bf16_t)f2bf(stf[sbase + id]); SBt[e * 72 + d] = (bf16_t)f2bf(stb[sbase + id]); }
    __syncthreads();
    const int lane = tid & 63, it = tid >> 6, fr = lane & 15, fq = lane >> 4;
    const int ipos = it * 16 + fr;
    const LAS bf16_t* qp = Qs + ipos * 72 + fq * 8;
    const bf16x8 qb0 = *(const LAS bf16x8*)qp, qb1 = *(const LAS bf16x8*)(qp + 32);
    f32x4 st[8];
#pragma unroll
    for (int jt = 0; jt < 8; ++jt) {
        const LAS bf16_t* kp = Ks + (jt * 16 + fr) * 72 + fq * 8;
        f32x4 acc = {0.f, 0.f, 0.f, 0.f};
        acc = mfma16(*(const LAS bf16x8*)kp, qb0, acc); acc = mfma16(*(const LAS bf16x8*)(kp + 32), qb1, acc);
#pragma unroll
        for (int jj = 0; jj < 4; ++jj) { const int dij = ipos - (jt * 16 + fq * 4 + jj); const float dec = dij >= 0 ? __expf(lgf * (float)dij) : __expf(lgb * (float)(-dij)); acc[jj] *= 0.125f * dec; }
        st[jt] = acc;
    }
    f32x4 o[4], ff[4], fb[4];
#pragma unroll
    for (int et = 0; et < 4; ++et) { o[et] = (f32x4){0.f, 0.f, 0.f, 0.f}; ff[et] = o[et]; fb[et] = o[et]; }
#pragma unroll
    for (int kk = 0; kk < 4; ++kk) {
        const bf16x8 pb = pack8(st[2 * kk], st[2 * kk + 1]);
#pragma unroll
        for (int et = 0; et < 4; ++et) { const LAS bf16_t* vp = VT + (et * 16 + fr) * 136 + kk * 32 + fq * 4; o[et] = mfma16(cat8(*(const LAS bf16x4*)vp, *(const LAS bf16x4*)(vp + 16)), pb, o[et]); }
    }
#pragma unroll
    for (int et = 0; et < 4; ++et) {
        const LAS bf16_t* fp = SFt + (et * 16 + fr) * 72 + fq * 8; const LAS bf16_t* bp = SBt + (et * 16 + fr) * 72 + fq * 8;
        ff[et] = mfma16(*(const LAS bf16x8*)fp, qb0, ff[et]); ff[et] = mfma16(*(const LAS bf16x8*)(fp + 32), qb1, ff[et]);
        fb[et] = mfma16(*(const LAS bf16x8*)bp, qb0, fb[et]); fb[et] = mfma16(*(const LAS bf16x8*)(bp + 32), qb1, fb[et]);
    }
    const float cf = __expf(lgf * (float)(ipos + 1)), cb = __expf(lgb * (float)(128 - ipos));
    float s = 0.f;
#pragma unroll
    for (int et = 0; et < 4; ++et) { o[et] = o[et] + ff[et] * cf + fb[et] * cb; s += (o[et][0] + o[et][1]) + (o[et][2] + o[et][3]); }
    s += __shfl_xor(s, 16); s += __shfl_xor(s, 32);
    const float mean = s * (1.f / 64.f); float s2 = 0.f;
#pragma unroll
    for (int et = 0; et < 4; ++et) { o[et] = o[et] - mean; s2 += (o[et][0] * o[et][0] + o[et][1] * o[et][1]) + (o[et][2] * o[et][2] + o[et][3] * o[et][3]); }
    s2 += __shfl_xor(s2, 16); s2 += __shfl_xor(s2, 32);
    const float rstd = 1.f / sqrtf(s2 * (1.f / 64.f) + LN_EPS);
    const size_t tok = (size_t)b * SEQ + c * 128 + ipos;
    const bf16_t* gp = proj + tok * DIN + 768 + h * 64 + fq * 4;
    bf16_t* op = mix + tok * DM + h * 64 + fq * 4;
#pragma unroll
    for (int et = 0; et < 4; ++et) {
        const u32x2 gr = *(const u32x2*)(gp + et * 16);
        const float g0 = bflo(gr.x), g1 = bfhi(gr.x), g2 = bflo(gr.y), g3 = bfhi(gr.y);
        const float y0 = o[et][0] * rstd * (g0 / (1.f + __expf(-g0))), y1 = o[et][1] * rstd * (g1 / (1.f + __expf(-g1)));
        const float y2 = o[et][2] * rstd * (g2 / (1.f + __expf(-g2))), y3 = o[et][3] * rstd * (g3 / (1.f + __expf(-g3)));
        u32x2 wv; wv.x = pk2(y0, y1); wv.y = pk2(y2, y3); *(u32x2*)(op + et * 16) = wv;
    }
    __syncthreads();
}

constexpr int S5XS = 136;
struct S5Pass { bf16x8 bf[8]; f32x4 t0; };
__device__ __forceinline__ void s5_fetch(S5Pass& P, const float* __restrict__ tab, const bf16_t* __restrict__ BT, int g, int r, int lane) {
    const int fr = lane & 15, fq = lane >> 4;
    P.t0 = *(const f32x4*)(tab + (size_t)((r * 16 + g) * 64 + lane) * 8);
    const bf16_t* btp = BT + (size_t)(g * 256 + r * 128 + fr) * 32 + fq * 8;
#pragma unroll
    for (int nt = 0; nt < 8; ++nt) P.bf[nt] = *(const bf16x8*)(btp + nt * 16 * 32);
}
__device__ __forceinline__ void s5_bu(LAS bf16_t* Xw, const S5Pass& P, bf16x8 uf0, bf16x8 uf1, int lane) {
    const int fr = lane & 15, fq = lane >> 4;
#pragma unroll
    for (int mt = 0; mt < 2; ++mt)
#pragma unroll
        for (int nt = 0; nt < 8; ++nt) {
            f32x4 acc = {0.f, 0.f, 0.f, 0.f};
            acc = mfma16(P.bf[nt], mt ? uf1 : uf0, acc);
            u32x2 wv; wv.x = pk2(acc[0], acc[1]); wv.y = pk2(acc[2], acc[3]);
            *(LAS u32x2*)(Xw + (mt * 16 + fr) * S5XS + nt * 16 + fq * 4) = wv;
        }
    asm volatile("s_waitcnt lgkmcnt(0)" ::: "memory");
}
template <bool WRITE>
__device__ __forceinline__ void s5_recur(LAS bf16_t* xq, int r, float lr_, float li_, float& xr, float& xi) {
#pragma unroll 1
    for (int blk = 0; blk < 4; ++blk) {
        LAS bf16_t* q = xq + (r ? (3 - blk) : blk) * (8 * S5XS);
        unsigned bw[8];
#pragma unroll
        for (int k = 0; k < 8; ++k) bw[k] = *(const LAS unsigned*)(q + k * S5XS);
        if (r == 0) {
#pragma unroll
            for (int s = 0; s < 8; ++s) {
                const float nr = fmaf(lr_, xr, fmaf(-li_, xi, bflo(bw[s]))), ni = fmaf(lr_, xi, fmaf(li_, xr, bfhi(bw[s])));
                xr = nr; xi = ni;
                if (WRITE) *(LAS unsigned*)(q + s * S5XS) = pk2(xr, xi);
            }
        } else {
#pragma unroll
            for (int s = 7; s >= 0; --s) {
                const float nr = fmaf(lr_, xr, fmaf(-li_, xi, bflo(bw[s]))), ni = fmaf(lr_, xi, fmaf(li_, xr, bfhi(bw[s])));
                xr = nr; xi = ni;
                if (WRITE) *(LAS unsigned*)(q + s * S5XS) = pk2(xr, xi);
            }
        }
    }
    if (WRITE) asm volatile("s_waitcnt lgkmcnt(0)" ::: "memory");
}
__device__ __forceinline__ void s5_ufrag(const bf16_t* __restrict__ proj, int b, int ch, int g, int lane, bf16x8& uf0, bf16x8& uf1) {
    const int fr = lane & 15, fq = lane >> 4;
    uf0 = (bf16x8){0, 0, 0, 0, 0, 0, 0, 0}; uf1 = uf0;
    if (fq < 2) { const bf16_t* up = proj + (size_t)(b * SEQ + ch * S5T + fr) * DIN + 1024 + g * 16 + fq * 8; uf0 = *(const bf16x8*)up; uf1 = *(const bf16x8*)(up + (size_t)16 * DIN); }
}

__device__ __forceinline__ void s5e_item(int item, const bf16_t* __restrict__ proj, const float* __restrict__ tab  , const bf16_t* __restrict__ BT,
                                         float* __restrict__ E, LAS unsigned char* lds, int tid) {
    const int ch = item & (S5NCH - 1), b = item / S5NCH;
    const int lane = tid & 63, w = tid >> 6;
    LAS bf16_t* Xw = (LAS bf16_t*)lds + w * (32 * S5XS);
    S5Pass cur;
    s5_fetch(cur, tab, BT, w, 0, lane);
    bf16x8 uf0, uf1;
    s5_ufrag(proj, b, ch, w, lane, uf0, uf1);
#pragma unroll 1
    for (int ps = 0; ps < 4; ++ps) {
        const int g = w + 8 * (ps >> 1), r = ps & 1;
        const float lr_ = cur.t0[0], li_ = cur.t0[1];
        s5_bu(Xw, cur, uf0, uf1, lane);
        if (ps < 3) s5_fetch(cur, tab, BT, w + 8 * ((ps + 1) >> 1), (ps + 1) & 1, lane);
        if (ps == 1) s5_ufrag(proj, b, ch, w + 8, lane, uf0, uf1);
        float xr = 0.f, xi = 0.f;
        s5_recur<false>(Xw + lane * 2, r, lr_, li_, xr, xi);
        float2 ev; ev.x = xr; ev.y = xi;
        ((float2*)E)[(size_t)(((b * S5NCH + ch) * 16 + g) * 2 + r) * 64 + lane] = ev;
        asm volatile("s_waitcnt lgkmcnt(0)" ::: "memory");
    }
    __syncthreads();
}
__device__ __forceinline__ void s5out_item(int item, const bf16_t* __restrict__ proj, const float* __restrict__ tab, const bf16_t* __restrict__ BT,
                                           const bf16_t* __restrict__ CT  , const float* __restrict__ dvec, const bf16_t* __restrict__ wgluT, const float* __restrict__ bglu,
                                           const float* __restrict__ CIN, bf16_t* __restrict__ mix, LAS unsigned char* lds, int tid) {
    const int ch = item & (S5NCH - 1), b = item / S5NCH;
    constexpr int YS = 264;
    const int lane = tid & 63, w = tid >> 6, fr = lane & 15, fq = lane >> 4;
    LAS bf16_t* Xw = (LAS bf16_t*)lds + w * (32 * S5XS);
    LAS bf16_t* Y = (LAS bf16_t*)(lds + 8 * 32 * S5XS * 2);
    S5Pass cur; bf16x8 ccf[4]; float2 ccin;
    s5_fetch(cur, tab, BT, w, 0, lane);
    ccin = ((const float2*)CIN)[(size_t)(((b * S5NCH + ch) * 16 + w) * 2 + 0) * 64 + lane];
#pragma unroll
    for (int ks = 0; ks < 4; ++ks) ccf[ks] = *(const bf16x8*)(CT + (size_t)(w * 16 + fr) * 256 + ks * 32 + fq * 8);
    bf16x8 uf0, uf1;
    s5_ufrag(proj, b, ch, w, lane, uf0, uf1);
    f32x4 ya0 = {0.f, 0.f, 0.f, 0.f}, ya1 = ya0;
#pragma unroll 1
    for (int ps = 0; ps < 4; ++ps) {
        const int g = w + 8 * (ps >> 1), r = ps & 1;
        const int gn = w + 8 * ((ps + 1) >> 1), rn = (ps + 1) & 1;
        const float lr_ = cur.t0[0], li_ = cur.t0[1];
        s5_bu(Xw, cur, uf0, uf1, lane);
        if (ps < 3) s5_fetch(cur, tab, BT, gn, rn, lane);
        if (ps == 1) s5_ufrag(proj, b, ch, w + 8, lane, uf0, uf1);
        float xr = ccin.x, xi = ccin.y;
        s5_recur<true>(Xw + lane * 2, r, lr_, li_, xr, xi);
        if (ps < 3) ccin = ((const float2*)CIN)[(size_t)(((b * S5NCH + ch) * 16 + gn) * 2 + rn) * 64 + lane];
#pragma unroll
        for (int ks = 0; ks < 4; ++ks) {
            ya0 = mfma16(ccf[ks], *(const LAS bf16x8*)(Xw + fr * S5XS + ks * 32 + fq * 8), ya0);
            ya1 = mfma16(ccf[ks], *(const LAS bf16x8*)(Xw + (16 + fr) * S5XS + ks * 32 + fq * 8), ya1);
        }
        if (ps < 3) {
#pragma unroll
            for (int ks = 0; ks < 4; ++ks) ccf[ks] = *(const bf16x8*)(CT + (size_t)(gn * 16 + fr) * 256 + rn * 128 + ks * 32 + fq * 8);
        }
        if (r == 1) {
            const int chn = g * 16 + fq * 4;
            const f32x4 dv = *(const f32x4*)(dvec + chn);
#pragma unroll
            for (int mt = 0; mt < 2; ++mt) {
                const int s = mt * 16 + fr;
                const u32x2 uw = *(const u32x2*)(proj + (size_t)(b * SEQ + ch * S5T + s) * DIN + 1024 + chn);
                const float uu[4] = {bflo(uw.x), bfhi(uw.x), bflo(uw.y), bfhi(uw.y)};
                float gl4[4];
#pragma unroll
                for (int jj = 0; jj < 4; ++jj) {
                    const float yv = (mt ? ya1[jj] : ya0[jj]) + dv[jj] * uu[jj];
                    const float t = 0.7978845608028654f * (yv + 0.044715f * yv * yv * yv);
                    gl4[jj] = yv * (1.f - __builtin_amdgcn_rcpf(1.f + __expf(2.f * t)));
                }
                u32x2 yw; yw.x = pk2(gl4[0], gl4[1]); yw.y = pk2(gl4[2], gl4[3]);
                *(LAS u32x2*)(Y + s * YS + chn) = yw;
            }
            ya0 = (f32x4){0.f, 0.f, 0.f, 0.f}; ya1 = ya0;
        }
        asm volatile("s_waitcnt lgkmcnt(0)" ::: "memory");
    }
    __syncthreads();
    {
        const int mt = w & 1;
        bf16x8 yf[8];
#pragma unroll
        for (int ks = 0; ks < 8; ++ks) yf[ks] = *(const LAS bf16x8*)(Y + (mt * 16 + fr) * YS + ks * 32 + fq * 8);
        const int s = mt * 16 + fr;
        bf16_t* orow = mix + (size_t)(b * SEQ + ch * S5T + s) * DM + 256;
#pragma unroll 2
        for (int i = 0; i < 4; ++i) {
            const int nt = (w >> 1) * 4 + i;
            const bf16_t* ap = wgluT + (size_t)(nt * 16 + fr) * 256 + fq * 8;
            f32x4 acc = {0.f, 0.f, 0.f, 0.f};
#pragma unroll
            for (int ks = 0; ks < 8; ++ks) acc = mfma16(*(const bf16x8*)(ap + ks * 32), yf[ks], acc);
            const int n0 = nt * 16 + fq * 4;
            const f32x4 bg = *(const f32x4*)(bglu + n0);
            const u32x2 yw = *(const LAS u32x2*)(Y + s * YS + n0);
            const float yv[4] = {bflo(yw.x), bfhi(yw.x), bflo(yw.y), bfhi(yw.y)};
            float ov[4];
#pragma unroll
            for (int jj = 0; jj < 4; ++jj) ov[jj] = yv[jj] * __builtin_amdgcn_rcpf(1.f + __expf(-(acc[jj] + bg[jj])));
            u32x2 ow; ow.x = pk2(ov[0], ov[1]); ow.y = pk2(ov[2], ov[3]);
            *(u32x2*)(orow + n0) = ow;
        }
    }
    __syncthreads();
}

__device__ __forceinline__ void phase_scan(const Args& a, int l, int tid) {
    unsigned char* ws = a.ws;
    const int lane = tid & 63, wave = tid >> 6;
    {
        const float* tab = (const float*)(ws + WS_S5TAB) + (size_t)l * 2048 * 8;
        const float2* __restrict__ E = (const float2*)(ws + WS_S5E); float2* __restrict__ C = (float2*)(ws + WS_S5C);
        for (int wv = blockIdx.x; wv < 128; wv += gridDim.x) if (wave == 0) {
            const int p = lane, r = wv & 1, g = (wv >> 1) & 15, b = wv >> 5;
            const float* tp = tab + (size_t)((r * 16 + g) * 64 + p) * 8;
            const float tr = tp[4], ti = tp[5];
            float xr = 0.f, xi = 0.f;
            for (int k0 = 0; k0 < S5NCH; k0 += 32) {
                float2 e[32];
#pragma unroll
                for (int k = 0; k < 32; ++k) { const int ch = r ? (S5NCH - 1 - (k0 + k)) : (k0 + k); e[k] = E[(size_t)(((b * S5NCH + ch) * 16 + g) * 2 + r) * 64 + p]; }
#pragma unroll
                for (int k = 0; k < 32; ++k) { const int ch = r ? (S5NCH - 1 - (k0 + k)) : (k0 + k);
                    float2 cv; cv.x = xr; cv.y = xi; C[(size_t)(((b * S5NCH + ch) * 16 + g) * 2 + r) * 64 + p] = cv;
                    const float nr = fmaf(tr, xr, fmaf(-ti, xi, e[k].x)), ni = fmaf(tr, xi, fmaf(ti, xr, e[k].y));
                    xr = nr; xi = ni; }
            }
        }
    }
    {
        const float* theta = a.in[4] + l * 8;
        const float* __restrict__ kvf = (const float*)(ws + WS_KVF); const float* __restrict__ kvb = (const float*)(ws + WS_KVB);
        float* __restrict__ stf = (float*)(ws + WS_STF); float* __restrict__ stb = (float*)(ws + WS_STB);
        for (int gid = blockIdx.x * NTHR + tid; gid < 131072; gid += gridDim.x * NTHR) {
            const int el = gid & 4095, dir = (gid >> 12) & 1, h = (gid >> 13) & 3, b = gid >> 15;
            const float dec = __expf(log_sigmoid(theta[dir * 4 + h]) * 128.f);
            const float* __restrict__ kv = dir ? kvb : kvf; float* __restrict__ st = dir ? stb : stf;
            float s = 0.f;
            for (int c0 = 0; c0 < 32; c0 += 16) {
                float kk[16];
#pragma unroll
                for (int k = 0; k < 16; ++k) { const int c = dir ? (31 - (c0 + k)) : (c0 + k); kk[k] = kv[(size_t)((b * 32 + c) * 4 + h) * 4096 + el]; }
#pragma unroll
                for (int k = 0; k < 16; ++k) { const int c = dir ? (31 - (c0 + k)) : (c0 + k); st[(size_t)((b * 32 + c) * 4 + h) * 4096 + el] = s; s = fmaf(dec, s, kk[k]); }
            }
        }
    }
}

__device__ __forceinline__ float router_softmax(const float (&sp)[16], int lane) {
    const bool b5 = (lane & 32) != 0, b4 = (lane & 16) != 0, b3 = (lane & 8) != 0, b2 = (lane & 4) != 0;
    float t8[8], t4[4], t2[2];
#pragma unroll
    for (int i = 0; i < 8; ++i) { const float snd = b5 ? sp[i] : sp[i + 8], kp = b5 ? sp[i + 8] : sp[i]; t8[i] = kp + __shfl_xor(snd, 32); }
#pragma unroll
    for (int i = 0; i < 4; ++i) { const float snd = b4 ? t8[i] : t8[i + 4], kp = b4 ? t8[i + 4] : t8[i]; t4[i] = kp + __shfl_xor(snd, 16); }
#pragma unroll
    for (int i = 0; i < 2; ++i) { const float snd = b3 ? t4[i] : t4[i + 2], kp = b3 ? t4[i + 2] : t4[i]; t2[i] = kp + __shfl_xor(snd, 8); }
    float lgt; { const float snd = b2 ? t2[0] : t2[1], kp = b2 ? t2[1] : t2[0]; lgt = kp + __shfl_xor(snd, 4); }
    lgt += __shfl_xor(lgt, 1); lgt += __shfl_xor(lgt, 2);
    float mx = lgt;
#pragma unroll
    for (int o = 4; o < 64; o <<= 1) mx = fmaxf(mx, __shfl_xor(mx, o));
    const float ex = expf(lgt - mx);
    float sum = ex;
#pragma unroll
    for (int o = 4; o < 64; o <<= 1) sum += __shfl_xor(sum, o);
    return ex / sum;
}
__device__ __forceinline__ void phase_ln1_router(const Args& a, int l, LAS unsigned char* lds, int tid) {
    unsigned char* ws = a.ws;
    const int lane = tid & 63, wave = tid >> 6;
    LAS float* rwT = (LAS float*)lds;
    const float* rw = a.in[19] + (size_t)l * DM * NE;
    for (int i = tid; i < DM * NE; i += NTHR) rwT[(i & 15) * DM + (i >> 4)] = rw[i];
    __syncthreads();
    const float* pre = (const float*)(ws + WS_RA);
    float* afft = (float*)(ws + WS_AFFT);
    const int gw = blockIdx.x * NWAVES + wave, NGW = gridDim.x * NWAVES;
    for (int m = gw; m < MTOK; m += 2 * NGW) {
        const int m1 = m + NGW; const bool has1 = m1 < MTOK; const int mb = has1 ? m1 : m;
        f32x4 v0[4], v1[4];
#pragma unroll
        for (int j = 0; j < 4; ++j) { v0[j] = ((const f32x4*)(pre + (size_t)m * DM))[lane + 64 * j]; v1[j] = ((const f32x4*)(pre + (size_t)mb * DM))[lane + 64 * j]; }
        ln_rows4(v0, a.in[17] + l * DM, a.in[18] + l * DM, lane);
        ln_rows4(v1, a.in[17] + l * DM, a.in[18] + l * DM, lane);
        store_row(v0, nullptr, (bf16_t*)(ws + WS_HBF) + (size_t)m * DM, lane);
        if (has1) store_row(v1, nullptr, (bf16_t*)(ws + WS_HBF) + (size_t)m1 * DM, lane);
        float sp0[16], sp1[16];
#pragma unroll
        for (int eg = 0; eg < 4; ++eg) {
#pragma unroll
            for (int ee = 0; ee < 4; ++ee) { const int e = eg * 4 + ee; float s0 = 0.f, s1 = 0.f;
#pragma unroll
                for (int j = 0; j < 4; ++j) { const f32x4 wv = *(const LAS f32x4*)(rwT + e * DM + 256 * j + 4 * lane);
                    s0 += (v0[j][0] * wv[0] + v0[j][1] * wv[1]) + (v0[j][2] * wv[2] + v0[j][3] * wv[3]);
                    s1 += (v1[j][0] * wv[0] + v1[j][1] * wv[1]) + (v1[j][2] * wv[2] + v1[j][3] * wv[3]); }
                sp0[e] = s0; sp1[e] = s1; }
            asm volatile("" ::: "memory");
        }
        const float af0 = router_softmax(sp0, lane), af1 = router_softmax(sp1, lane);
        if ((lane & 3) == 0) {
            afft[(size_t)((m / SEQ) * NE + (lane >> 2)) * SEQ + (m % SEQ)] = af0;
            if (has1) afft[(size_t)((m1 / SEQ) * NE + (lane >> 2)) * SEQ + (m1 % SEQ)] = af1;
        }
    }
    __syncthreads();
}

__device__ __forceinline__ void select_item(int item, const Args& a, LAS unsigned char* lds, int tid) {
    unsigned char* ws = a.ws;
    const int q = item & 3, e = (item >> 2) & 15, b = item >> 6;
    const int lane = tid & 63, wave = tid >> 6;
    LAS unsigned* red = (LAS unsigned*)lds;
    LAS int* sel = (LAS int*)(lds + 1024);
    const float* av = (const float*)(ws + WS_AFFT) + (size_t)(b * NE + e) * SEQ + tid * 8;
    const f32x4 va = *(const f32x4*)av, vb = *(const f32x4*)(av + 4);
    unsigned v[8] = {__float_as_uint(va[0]), __float_as_uint(va[1]), __float_as_uint(va[2]), __float_as_uint(va[3]), __float_as_uint(vb[0]), __float_as_uint(vb[1]), __float_as_uint(vb[2]), __float_as_uint(vb[3])};
    unsigned x = 0u;
    for (int bit = 30; bit >= 0; --bit) {
        const unsigned cand = x | (1u << bit);
        unsigned cnt = 0u;
#pragma unroll
        for (int j = 0; j < 8; ++j) cnt += (unsigned)__popcll(__ballot(v[j] >= cand));
        LAS unsigned* rb = red + (bit & 1) * 8;
        if (lane == 0) rb[wave] = cnt;
        __syncthreads();
        unsigned tot = 0u;
#pragma unroll
        for (int k = 0; k < 8; ++k) tot += rb[k];
        if (tot >= (unsigned)CAP) x = cand;
    }
    unsigned mycnt = 0u;
#pragma unroll
    for (int j = 0; j < 8; ++j) mycnt += (v[j] > x ? 1u : 0u) + (v[j] == x ? 0x10000u : 0u);
    unsigned inc = mycnt;
#pragma unroll
    for (int o = 1; o < 64; o <<= 1) { const unsigned t = __shfl_up(inc, o); if (lane >= o) inc += t; }
    LAS unsigned* wsum = red + 64;
    __syncthreads();
    if (lane == 63) wsum[wave] = inc;
    __syncthreads();
    unsigned wpre = 0u, total = 0u;
#pragma unroll
    for (int k = 0; k < 8; ++k) { const unsigned t = wsum[k]; if (k < wave) wpre += t; total += t; }
    const unsigned excl = wpre + inc - mycnt;
    unsigned gtb = excl & 0xffffu, eqb = excl >> 16;
    const unsigned need = (unsigned)CAP - (total & 0xffffu);
    const int rowbase = (e * NB + b) * CAP;
    int* idx = (int*)(ws + WS_IDX); float* gate = (float*)(ws + WS_GATE); int* slotmap = (int*)(ws + WS_SLOT);
    const bool own_tok = ((tid >> 7) == q);
#pragma unroll
    for (int j = 0; j < 8; ++j) {
        const bool isgt = v[j] > x, iseq = v[j] == x;
        const bool issel = isgt || (iseq && eqb < need);
        const unsigned slot = gtb + (eqb < need ? eqb : need);
        const int tok = b * SEQ + tid * 8 + j;
        if (issel && (int)(slot >> 7) == q) { idx[rowbase + slot] = tok; gate[rowbase + slot] = __uint_as_float(v[j]); }
        if (own_tok) slotmap[(size_t)tok * NE + e] = issel ? (int)(rowbase + slot) : -1;
        gtb += isgt ? 1u : 0u; eqb += iseq ? 1u : 0u;
    }
    __syncthreads();
}

__device__ __forceinline__ void phase_ln2(const Args& a, int l, int tid) {
    unsigned char* ws = a.ws;
    const int lane = tid & 63, wave = tid >> 6;
    const int gw = blockIdx.x * NWAVES + wave, NGW = gridDim.x * NWAVES;
    const bf16_t* hbf = (const bf16_t*)(ws + WS_HBF); const int* slotmap = (const int*)(ws + WS_SLOT); const bf16_t* contrib = (const bf16_t*)(ws + WS_RB);
    const bool last = (l == 1);
    u32x2 vn[4]; int slot_n = -1;
    if (gw < MTOK) {
#pragma unroll
        for (int j = 0; j < 4; ++j) vn[j] = ((const u32x2*)(hbf + (size_t)gw * DM))[lane + 64 * j];
        slot_n = slotmap[(size_t)gw * NE + (lane & 15)];
    }
    for (int m = gw; m < MTOK; m += NGW) {
        f32x4 v[4];
#pragma unroll
        for (int j = 0; j < 4; ++j) { v[j][0] = bflo(vn[j].x) * ALPHA; v[j][1] = bfhi(vn[j].x) * ALPHA; v[j][2] = bflo(vn[j].y) * ALPHA; v[j][3] = bfhi(vn[j].y) * ALPHA; }
        const int myslot = slot_n;
        unsigned bal = (unsigned)(__ballot(myslot >= 0) & 0xffffull);
        int r0 = -1, r1 = -1, r2 = -1, r3 = -1;
        if (bal) { r0 = __shfl(myslot, __builtin_ctz(bal)); bal &= bal - 1; }
        if (bal) { r1 = __shfl(myslot, __builtin_ctz(bal)); bal &= bal - 1; }
        if (bal) { r2 = __shfl(myslot, __builtin_ctz(bal)); bal &= bal - 1; }
        if (bal) { r3 = __shfl(myslot, __builtin_ctz(bal)); bal &= bal - 1; }
        u32x2 c0[4], c1[4], c2[4], c3[4];
#pragma unroll
        for (int j = 0; j < 4; ++j) { c0[j] = (u32x2){0u, 0u}; c1[j] = c0[j]; c2[j] = c0[j]; c3[j] = c0[j]; }
        if (r0 >= 0) {
#pragma unroll
            for (int j = 0; j < 4; ++j) c0[j] = ((const u32x2*)(contrib + (size_t)r0 * DM))[lane + 64 * j]; }
        if (r1 >= 0) {
#pragma unroll
            for (int j = 0; j < 4; ++j) c1[j] = ((const u32x2*)(contrib + (size_t)r1 * DM))[lane + 64 * j]; }
        if (r2 >= 0) {
#pragma unroll
            for (int j = 0; j < 4; ++j) c2[j] = ((const u32x2*)(contrib + (size_t)r2 * DM))[lane + 64 * j]; }
        if (r3 >= 0) {
#pragma unroll
            for (int j = 0; j < 4; ++j) c3[j] = ((const u32x2*)(contrib + (size_t)r3 * DM))[lane + 64 * j]; }
        if (m + NGW < MTOK) {
#pragma unroll
            for (int j = 0; j < 4; ++j) vn[j] = ((const u32x2*)(hbf + (size_t)(m + NGW) * DM))[lane + 64 * j];
            slot_n = slotmap[(size_t)(m + NGW) * NE + (lane & 15)];
        }
#pragma unroll
        for (int j = 0; j < 4; ++j) {
            v[j][0] += bflo(c0[j].x); v[j][1] += bfhi(c0[j].x); v[j][2] += bflo(c0[j].y); v[j][3] += bfhi(c0[j].y);
            v[j][0] += bflo(c1[j].x); v[j][1] += bfhi(c1[j].x); v[j][2] += bflo(c1[j].y); v[j][3] += bfhi(c1[j].y);
            v[j][0] += bflo(c2[j].x); v[j][1] += bfhi(c2[j].x); v[j][2] += bflo(c2[j].y); v[j][3] += bfhi(c2[j].y);
            v[j][0] += bflo(c3[j].x); v[j][1] += bfhi(c3[j].x); v[j][2] += bflo(c3[j].y); v[j][3] += bfhi(c3[j].y);
        }
        while (bal) {
            const int row = __shfl(myslot, __builtin_ctz(bal)); bal &= bal - 1;
            const u32x2* cr = (const u32x2*)(contrib + (size_t)row * DM);
#pragma unroll
            for (int j = 0; j < 4; ++j) { const u32x2 wv = cr[lane + 64 * j]; v[j][0] += bflo(wv.x); v[j][1] += bfhi(wv.x); v[j][2] += bflo(wv.y); v[j][3] += bfhi(wv.y); }
        }
        ln_rows4(v, a.in[23] + l * DM, a.in[24] + l * DM, lane);
        if (last) store_row(v, a.out + (size_t)m * DM, nullptr, lane);
        else store_row(v, nullptr, (bf16_t*)(ws + WS_HBF) + (size_t)m * DM, lane);
    }
}

typedef __attribute__((address_space(1))) unsigned gu32;
#define RLX_AGENT __ATOMIC_RELAXED, __HIP_MEMORY_SCOPE_AGENT
#define XB_TMO      128
#define XB_XCNT(j)  (256  + 64 * (j))
#define XB_XSUB(j)  (1280 + 64 * (j))
#define XB_XGEN(j)  (2304 + 64 * (j))
#define XB_TOP      3328
#define XB_TOPGEN   3392
#define XCD_BAR_WORDS 3456
#define XB_SPIN_CAP (1u << 18)

__device__ __forceinline__ unsigned xb_ld(unsigned* p)              { return __hip_atomic_load(p, __ATOMIC_RELAXED, __HIP_MEMORY_SCOPE_AGENT); }
__device__ __forceinline__ unsigned xb_add(unsigned* p, unsigned v) { return __hip_atomic_fetch_add(p, v, __ATOMIC_RELAXED, __HIP_MEMORY_SCOPE_AGENT); }
__device__ __forceinline__ unsigned xb_xcc_id() { return (unsigned)__builtin_amdgcn_s_getreg((3 << 11) | 20) & 0xFu; }
#define XB_SPIN(cond, bar) do { unsigned _sp = 0; while (cond) { __builtin_amdgcn_s_sleep(1); \
    if ((++_sp & 255u) == 0u) { if (xb_ld(&(bar)[XB_TMO])) break; if (_sp > XB_SPIN_CAP) { atomicAdd(&(bar)[XB_TMO], 1u); break; } } } } while (0)

struct XcdBarrier {
    unsigned* bar; unsigned x;
    volatile LAS unsigned* st;
};

__device__ __forceinline__ XcdBarrier xcd_barrier_post(unsigned* bar, volatile LAS unsigned* st) {
    XcdBarrier b; b.bar = bar; b.x = xb_xcc_id(); b.st = st;
    if (threadIdx.x == 0) (void)xb_add(&bar[XB_XCNT(b.x)], 1u);
    return b;
}
__device__ __forceinline__ void xcd_barrier_complete(unsigned* bar, unsigned x, unsigned& nloc, unsigned& nx) {
    const unsigned G = gridDim.x * gridDim.y * gridDim.z;
    unsigned sum, cnt, mine, sp = 0u;
    for (;;) {
        sum = 0u; cnt = 0u; mine = 0u;
#pragma unroll
        for (unsigned j = 0; j < 16; ++j) { const unsigned c = xb_ld(&bar[XB_XCNT(j)]); sum += c; cnt += (c > 0u) ? 1u : 0u; mine = (j == x) ? c : mine; }
        if (sum == G) break;
        __builtin_amdgcn_s_sleep(1);
        if ((++sp & 255u) == 0u) { if (xb_ld(&bar[XB_TMO])) break; if (sp > XB_SPIN_CAP) { atomicAdd(&bar[XB_TMO], 1u); break; } }
    }
    nloc = mine > 0u ? mine : 1u; nx = cnt > 0u ? cnt : 1u;
}

__device__ __forceinline__ void xcd_barrier(const XcdBarrier& b) {
    asm volatile("s_waitcnt vmcnt(0)" ::: "memory");
    __syncthreads();
    if (threadIdx.x == 0) {
        unsigned* bar = b.bar;
        __builtin_amdgcn_s_waitcnt(0);
        unsigned nloc = b.st[0], nx = b.st[1];
        if (nloc == 0u) { xcd_barrier_complete(bar, b.x, nloc, nx); b.st[0] = nloc; b.st[1] = nx; }
        const unsigned old = xb_add(&bar[XB_XSUB(b.x)], 1u);
        const unsigned gen = old / nloc;
        if (old + 1u == (gen + 1u) * nloc) {
            __builtin_amdgcn_fence(__ATOMIC_RELEASE, "agent");
            asm volatile("s_waitcnt vmcnt(0)" ::: "memory");
            const unsigned og = xb_add(&bar[XB_TOP], 1u);
            const unsigned tg = og / nx;
            if (og + 1u == (tg + 1u) * nx) xb_add(&bar[XB_TOPGEN], 1u);
            else XB_SPIN(xb_ld(&bar[XB_TOPGEN]) == tg, bar);
            __builtin_amdgcn_fence(__ATOMIC_ACQUIRE, "agent");
            xb_add(&bar[XB_XGEN(b.x)], 1u);
            asm volatile("s_waitcnt vmcnt(0)" ::: "memory");
        } else {
            XB_SPIN(xb_ld(&bar[XB_XGEN(b.x)]) == gen, bar);
            __builtin_amdgcn_fence(__ATOMIC_ACQUIRE, "agent");
            asm volatile("s_waitcnt vmcnt(0)" ::: "memory");
        }
    }
    __syncthreads();
}

constexpr int NPHASES = 21;
#ifndef REP_MASK
#define REP_MASK 0
#endif
template <int L, int K>
__device__ __forceinline__ void run_phase(const Args& a, LAS unsigned char* lds, int tid) {
    unsigned char* ws = a.ws;
    constexpr int l = L;
    bf16_t* proj = (bf16_t*)(ws + WS_RA); bf16_t* mix = (bf16_t*)(ws + WS_RB);
    if constexpr (K == 0) {
        pg8::Gemm g{(const bf16_t*)(ws + WS_HBF), (const bf16_t*)(ws + WS_WIN) + (size_t)l * DIN * DM, MTOK, DIN, DM};
        pg8::StaticOrder S; S.init(MTOK, DIN, (int)gridDim.x, (int)blockIdx.x);
        pg8::EpiStoreBf16 E{proj, DIN};
        pg8::gemm_phase<pg8::EpiStoreBf16, pg8::StaticOrder, true, true>(lds, g, S, E);
    } else if constexpr (K == 1) {
        const float* tab = (const float*)(ws + WS_S5TAB) + (size_t)l * 2048 * 8;
        constexpr int XB = ((REP_MASK >> 11) & 1) ? 512 : ((REP_MASK >> 12) & 1) ? 256 : ((REP_MASK >> 13) & 1) ? 512 : 0, XOFF = ((REP_MASK >> 11) & 1) ? 0 : ((REP_MASK >> 12) & 1) ? 512 : 768;
        for (int it0 = blockIdx.x; it0 < 1280 + XB; it0 += gridDim.x) {
            const int it = it0 < 1280 ? it0 : it0 - 1280 + XOFF;
            if (it < 512) s5e_item(it, proj, tab, (const bf16_t*)(ws + WS_S5BT) + (size_t)l * 4096 * 32, (float*)(ws + WS_S5E), lds, tid);
            else if (it < 768) attn_item(it - 512, proj, mix, a.in[15] + l * 8, lds, tid);
            else retkv_item(it - 768, proj, (float*)(ws + WS_KVF), (float*)(ws + WS_KVB), a.in[4] + l * 8, lds, tid);
        }
    } else if constexpr (K == 2) {
        phase_scan(a, l, tid);
    } else if constexpr (K == 3) {
        const float* tab = (const float*)(ws + WS_S5TAB) + (size_t)l * 2048 * 8;
        constexpr int XD = ((REP_MASK >> 14) & 3) ? 512 : 0, XOFD = ((REP_MASK >> 14) & 1) ? 0 : 512;
        for (int it0 = blockIdx.x; it0 < 1024 + XD; it0 += gridDim.x) {
            const int it = it0 < 1024 ? it0 : it0 - 1024 + XOFD;
            if (it < 512) s5out_item(it, proj, tab, (const bf16_t*)(ws + WS_S5BT) + (size_t)l * 4096 * 32, (const bf16_t*)(ws + WS_S5CT) + (size_t)l * 65536, a.in[12] + l * 256,
                                     (const bf16_t*)(ws + WS_WGLU) + (size_t)l * 65536, a.in[14] + l * 256, (const float*)(ws + WS_S5C), mix, lds, tid);
            else retout_item(it - 512, proj, (const float*)(ws + WS_STF), (const float*)(ws + WS_STB), mix, a.in[4] + l * 8, lds, tid);
        }
    } else if constexpr (K == 4) {
        pg8::Gemm g{mix, (const bf16_t*)(ws + WS_WOUT) + (size_t)l * DM * DM, MTOK, DM, DM};
        pg8::StaticOrder S; S.init(MTOK, DM, (int)gridDim.x, (int)blockIdx.x);
        pg8::EpiResF32 E{(const bf16_t*)(ws + WS_HBF), (float*)(ws + WS_RA), DM, ALPHA};
        pg8::gemm_phase<pg8::EpiResF32, pg8::StaticOrder, true, true>(lds, g, S, E);
    } else if constexpr (K == 5) {
        phase_ln1_router(a, l, lds, tid);
    } else if constexpr (K == 6) {
        for (int it = blockIdx.x; it < 256; it += gridDim.x) select_item(it, a, lds, tid);
    } else if constexpr (K == 7) {
        pg8::Gemm g{(const bf16_t*)(ws + WS_HBF), (const bf16_t*)(ws + WS_WGU) + (size_t)l * NE * 2 * FF * DM, NROWX, NE * 2 * FF, DM};
        pg8::GroupedOrder S; S.init(16, (int)gridDim.x, (int)blockIdx.x);
        pg8::EpiSwiGLU E{(bf16_t*)(ws + WS_HDN), FF, 16};
        pg8::gemm_phase<pg8::EpiSwiGLU, pg8::GroupedOrder, true, true, true>(lds, g, S, E, (const int*)(ws + WS_IDX));
    } else if constexpr (K == 8) {
        pg8::Gemm g{(const bf16_t*)(ws + WS_HDN), (const bf16_t*)(ws + WS_WD) + (size_t)l * NE * DM * FF, NROWX, NE * DM, FF};
        pg8::GroupedOrder S; S.init(4, (int)gridDim.x, (int)blockIdx.x);
        pg8::EpiScaleRow E{(bf16_t*)(ws + WS_RB), DM, 4, (const float*)(ws + WS_GATE)};
        pg8::gemm_phase<pg8::EpiScaleRow, pg8::GroupedOrder, true, true, false, true>(lds, g, S, E);
    } else {
        phase_ln2(a, l, tid);
    }
}
__global__ void __launch_bounds__(NTHR, 2) fwd_kernel(Args a) {
    extern __shared__ __attribute__((aligned(16))) unsigned char lds_raw[];
    LAS unsigned char* lds = (LAS unsigned char*)lds_raw;
    cg::grid_group grid = cg::this_grid();
    const int lo = a.ph_lo, hi = a.ph_hi;
    volatile LAS unsigned* bst = (volatile LAS unsigned*)(lds + LDS_BYTES - 64);
    if (threadIdx.x < 16) bst[threadIdx.x] = 0u;
    __syncthreads();
    XcdBarrier bar = xcd_barrier_post((unsigned*)(a.ws + WS_BAR), bst);
    if (hi > 1000) grid.sync();
#define PH_BEGIN(ph) if (lo <= (ph) && (ph) < hi) { int tid = threadIdx.x; asm volatile("" : "+v"(tid));
#define PH_END(ph) if ((ph) + 1 < hi) xcd_barrier(bar); }
    PH_BEGIN(0) for (int rep = 0; rep <= ((REP_MASK >> 10) & 1); ++rep) phase_p0(a, lds, tid); PH_END(0)
#define LAYER(L) \
    PH_BEGIN(1 + 10 * L + 0) for (int rep = 0; rep <= ((REP_MASK >> 0) & 1); ++rep) run_phase<L, 0>(a, lds, tid); PH_END(1 + 10 * L + 0) \
    PH_BEGIN(1 + 10 * L + 1) for (int rep = 0; rep <= ((REP_MASK >> 1) & 1); ++rep) run_phase<L, 1>(a, lds, tid); PH_END(1 + 10 * L + 1) \
    PH_BEGIN(1 + 10 * L + 2) for (int rep = 0; rep <= ((REP_MASK >> 2) & 1); ++rep) run_phase<L, 2>(a, lds, tid); PH_END(1 + 10 * L + 2) \
    PH_BEGIN(1 + 10 * L + 3) for (int rep = 0; rep <= ((REP_MASK >> 3) & 1); ++rep) run_phase<L, 3>(a, lds, tid); PH_END(1 + 10 * L + 3) \
    PH_BEGIN(1 + 10 * L + 4) for (int rep = 0; rep <= ((REP_MASK >> 4) & 1); ++rep) run_phase<L, 4>(a, lds, tid); PH_END(1 + 10 * L + 4) \
    PH_BEGIN(1 + 10 * L + 5) for (int rep = 0; rep <= ((REP_MASK >> 5) & 1); ++rep) run_phase<L, 5>(a, lds, tid); PH_END(1 + 10 * L + 5) \
    PH_BEGIN(1 + 10 * L + 6) for (int rep = 0; rep <= ((REP_MASK >> 6) & 1); ++rep) run_phase<L, 6>(a, lds, tid); PH_END(1 + 10 * L + 6) \
    PH_BEGIN(1 + 10 * L + 7) for (int rep = 0; rep <= ((REP_MASK >> 7) & 1); ++rep) run_phase<L, 7>(a, lds, tid); PH_END(1 + 10 * L + 7) \
    PH_BEGIN(1 + 10 * L + 8) for (int rep = 0; rep <= ((REP_MASK >> 8) & 1); ++rep) run_phase<L, 8>(a, lds, tid); PH_END(1 + 10 * L + 8) \
    PH_BEGIN(1 + 10 * L + 9) for (int rep = 0; rep <= (((REP_MASK >> 9) & 1) && L == 1 ? 1 : 0); ++rep) run_phase<L, 9>(a, lds, tid); PH_END(1 + 10 * L + 9)
    LAYER(0)
    LAYER(1)
#undef LAYER
#undef PH_BEGIN
#undef PH_END
}

#ifndef ONE_LAUNCH
#define ONE_LAUNCH 1
#endif
extern "C" void kernel_launch(void* const* d_in, const int* in_sizes, int n_in, void* d_out, int out_size, void* d_ws, size_t ws_size, hipStream_t stream) {
    static int grid = 0;
    if (grid == 0) {
        if (n_in != 25 || ws_size < WS_END) { fprintf(stderr, "kernel_launch: unexpected problem (n_in %d, ws %zu)\n", n_in, ws_size); grid = -1; return; }
        int dev = 0, cus = 0, per_cu = 0;
        (void)hipGetDevice(&dev);
        (void)hipDeviceGetAttribute(&cus, hipDeviceAttributeMultiprocessorCount, dev);
        if (hipFuncSetAttribute((const void*)fwd_kernel, hipFuncAttributeMaxDynamicSharedMemorySize, LDS_BYTES) != hipSuccess) { fprintf(stderr, "kernel_launch: hipFuncSetAttribute failed\n"); grid = -1; return; }
        if (hipOccupancyMaxActiveBlocksPerMultiprocessor(&per_cu, (const void*)fwd_kernel, NTHR, LDS_BYTES) != hipSuccess || per_cu < 1) { fprintf(stderr, "kernel_launch: occupancy query says %d\n", per_cu); per_cu = 1; }
        (void)hipGetLastError();
        if (cus <= 0) cus = 256;
        grid = cus * per_cu;
    }
    if (grid < 0) return;
    Args a{};
    for (int i = 0; i < 25; ++i) a.in[i] = (const float*)d_in[i];
    a.out = (float*)d_out; a.ws = (unsigned char*)d_ws;
#if ONE_LAUNCH
    if (hipMemsetAsync((char*)d_ws + WS_BAR, 0, 16384, stream) != hipSuccess) { fprintf(stderr, "kernel_launch: memset failed\n"); return; }
    a.ph_lo = 0; a.ph_hi = NPHASES;
    void* args[] = {&a};
    hipError_t e = hipLaunchCooperativeKernel((const void*)fwd_kernel, dim3(grid), dim3(NTHR), args, LDS_BYTES, stream);
    if (e != hipSuccess) fprintf(stderr, "kernel_launch: cooperative launch failed: %s (grid %d)\n", hipGetErrorString(e), grid);
#else
    for (int ph = 0; ph < NPHASES; ++ph) {
        a.ph_lo = ph; a.ph_hi = ph + 1;
        hipLaunchKernelGGL(fwd_kernel, dim3(grid), dim3(NTHR), LDS_BYTES, stream, a);
    }
#endif
}
```

```cpp
#include <hip/hip_runtime.h>
#include <hip/hip_cooperative_groups.h>
#include <cstdio>
#include <cstdint>
namespace cg = cooperative_groups;
namespace pg8 {
#define PG8_LAS __attribute__((address_space(3)))
typedef unsigned short bf16_t;
typedef short bf16x8 __attribute__((ext_vector_type(8)));
typedef float f32x4 __attribute__((ext_vector_type(4)));
typedef unsigned u32x4 __attribute__((ext_vector_type(4)));
constexpr int BM = 256, BK = 64, HALF = 128, HTB = HALF * BK * 2  , STAGE_BYTES = 8 * HTB, NXCD = 8, WGM = 8;

__host__ __device__ __forceinline__ int lds_byte(int r, int c) { const int st = (r >> 4) * 2 + (c >> 5), rr = r & 15, cc = c & 31, ob = rr * 64 + cc * 2; return st * 1024 + (ob ^ (((ob >> 9) & 1) << 5)); }
__host__ __device__ __forceinline__ void stage_rc(int b, int& R, int& C) { const int st = b / 1024, sb = b % 1024, swz = sb ^ (((sb >> 9) & 1) << 5); R = (st >> 1) * 16 + swz / 64; C = (st & 1) * 32 + (swz % 64) / 2; }
__host__ __device__ __forceinline__ int perm32(int rho) { const int n = rho >> 4, i = rho & 15; return 8 * (i >> 2) + 4 * n + (i & 3); }

struct Unit { int pm, pn; };
struct Gemm { const bf16_t* A; const bf16_t* Bt; int M, N, K; };

struct StaticOrder {
    int nM, nN, nwg, G, c;
    __host__ __device__ void init(int M, int N, int G_, int c_) { nM = M / BM; nN = N / BM; nwg = nM * nN; G = G_; c = c_; }
    __host__ __device__ bool next(int i, Unit& u) const {
        const long L = (long)i * G + c; if (L >= nwg) return false;
        int wgid = (int)L; { const int q = nwg / NXCD, r = nwg % NXCD, xcd = wgid % NXCD, off = wgid / NXCD; wgid = (xcd < r ? xcd * (q + 1) : r * (q + 1) + (xcd - r) * q) + off; }
        const int nig = WGM * nN, gid = wgid / nig, fm = gid * WGM, gsz = (nM - fm) < WGM ? (nM - fm) : WGM;
        u.pm = fm + ((wgid % nig) % gsz); u.pn = (wgid % nig) / gsz; return true;
    }
    __device__ __forceinline__ void a_ready(const Unit&) const {}
    __device__ __forceinline__ void done(const Unit&) const {}
};

__device__ __forceinline__ unsigned cvt_pk_bf16(float lo, float hi) { unsigned r; asm volatile("v_cvt_pk_bf16_f32 %0, %1, %2" : "=v"(r) : "v"(lo), "v"(hi)); return r; }
typedef unsigned u32x2 __attribute__((ext_vector_type(2)));

struct GroupedOrder {
    int upe, nNe, nwg, G, c;
    __host__ __device__ void init(int nNe_, int G_, int c_) { nNe = nNe_; upe = 8 * nNe_; nwg = 16 * upe; G = G_; c = c_; }
    __host__ __device__ bool next(int i, Unit& u) const {
        const long L = (long)i * G + c; if (L >= nwg) return false;
        int wgid = (int)L; { const int q = nwg / NXCD, r = nwg % NXCD, xcd = wgid % NXCD, off = wgid / NXCD; wgid = (xcd < r ? xcd * (q + 1) : r * (q + 1) + (xcd - r) * q) + off; }
        const int e = wgid / upe, rr = wgid % upe;
        u.pm = e * 8 + (rr & 7); u.pn = e * nNe + (rr >> 3); return true;
    }
    __device__ __forceinline__ void a_ready(const Unit&) const {}
    __device__ __forceinline__ void done(const Unit&) const {}
};

struct EpiStoreBf16 {
    static constexpr bool PERM = true, AFTER_DRAIN = false;
    bf16_t* O; int ldc;
    __device__ __forceinline__ void operator()(const f32x4 (&acc)[2][2][4][2], const Unit& u, int wr, int wc, int fr, int fq) const {
        const int row0 = u.pm * BM + wr * 64 + fr, col0 = u.pn * BM + wc * 32 + 8 * fq;
#pragma unroll
        for (int ai = 0; ai < 2; ++ai)
#pragma unroll
            for (int m = 0; m < 4; ++m) { bf16_t* rowp = O + (size_t)(row0 + ai * HALF + m * 16) * ldc + col0;
#pragma unroll
                for (int bj = 0; bj < 2; ++bj) { const f32x4 v0 = acc[ai][bj][m][0], v1 = acc[ai][bj][m][1];
                    u32x4 w; w.x = cvt_pk_bf16(v0[0], v0[1]); w.y = cvt_pk_bf16(v0[2], v0[3]); w.z = cvt_pk_bf16(v1[0], v1[1]); w.w = cvt_pk_bf16(v1[2], v1[3]);
                    *(u32x4*)(rowp + bj * HALF) = w; } }
    }
};
struct EpiResF32 {
    static constexpr bool PERM = false, AFTER_DRAIN = false;
    const bf16_t* base; float* O; int ldc; float alpha;
    __device__ __forceinline__ void operator()(const f32x4 (&acc)[2][2][4][2], const Unit& u, int wr, int wc, int fr, int fq) const {
        const int row0 = u.pm * BM + wr * 64 + fr, col0 = u.pn * BM + wc * 32 + 4 * fq;
#pragma unroll
        for (int ai = 0; ai < 2; ++ai)
#pragma unroll
            for (int m = 0; m < 4; ++m) { const size_t ro = (size_t)(row0 + ai * HALF + m * 16) * ldc + col0;
#pragma unroll
                for (int bj = 0; bj < 2; ++bj)
#pragma unroll
                    for (int n = 0; n < 2; ++n) { const u32x2 bw = *(const u32x2*)(base + ro + bj * HALF + 16 * n);
                        f32x4 b; b[0] = __uint_as_float(bw.x << 16); b[1] = __uint_as_float(bw.x & 0xffff0000u); b[2] = __uint_as_float(bw.y << 16); b[3] = __uint_as_float(bw.y & 0xffff0000u);
                        *(f32x4*)(O + ro + bj * HALF + 16 * n) = b * alpha + acc[ai][bj][m][n]; } }
    }
};
struct EpiSwiGLU {
    static constexpr bool PERM = true, AFTER_DRAIN = false;
    bf16_t* O; int ldc; int ntn;
    __device__ __forceinline__ void operator()(const f32x4 (&acc)[2][2][4][2], const Unit& u, int wr, int wc, int fr, int fq) const {
        const int row0 = u.pm * BM + wr * 64 + fr, col0 = (u.pn % ntn) * HALF + wc * 32 + 8 * fq;
#pragma unroll
        for (int ai = 0; ai < 2; ++ai)
#pragma unroll
            for (int m = 0; m < 4; ++m) { const int row = row0 + ai * HALF + m * 16;
                bf16_t* rowp = O + ((size_t)(row >> 7) * (ldc >> 6) + (col0 >> 6)) * 8192 + (row & 127) * 64 + (col0 & 63);
                float h[8];
#pragma unroll
                for (int n = 0; n < 2; ++n) { const f32x4 g = acc[ai][0][m][n], up = acc[ai][1][m][n];
#pragma unroll
                    for (int j = 0; j < 4; ++j) h[4 * n + j] = g[j] * up[j] * __builtin_amdgcn_rcpf(1.f + __expf(-g[j])); }
                u32x4 w; w.x = cvt_pk_bf16(h[0], h[1]); w.y = cvt_pk_bf16(h[2], h[3]); w.z = cvt_pk_bf16(h[4], h[5]); w.w = cvt_pk_bf16(h[6], h[7]);
                *(u32x4*)rowp = w; }
    }
};
struct EpiScaleRow {
    static constexpr bool PERM = true, AFTER_DRAIN = false;
    bf16_t* O; int ldc; int ntn; const float* gate;
    __device__ __forceinline__ void operator()(const f32x4 (&acc)[2][2][4][2], const Unit& u, int wr, int wc, int fr, int fq) const {
        const int row0 = u.pm * BM + wr * 64 + fr, col0 = (u.pn % ntn) * BM + wc * 32 + 8 * fq;
#pragma unroll
        for (int ai = 0; ai < 2; ++ai)
#pragma unroll
            for (int m = 0; m < 4; ++m) { const int row = row0 + ai * HALF + m * 16; const float gsc = gate[row]; bf16_t* rowp = O + (size_t)row * ldc + col0;
#pragma unroll
                for (int bj = 0; bj < 2; ++bj) { const f32x4 v0 = acc[ai][bj][m][0] * gsc, v1 = acc[ai][bj][m][1] * gsc;
                    u32x4 w; w.x = cvt_pk_bf16(v0[0], v0[1]); w.y = cvt_pk_bf16(v0[2], v0[3]); w.z = cvt_pk_bf16(v1[0], v1[1]); w.w = cvt_pk_bf16(v1[2], v1[3]);
                    *(u32x4*)(rowp + bj * HALF) = w; } }
    }
};
template <class Epi, class Sched, bool ALIGN_EPI = false, bool SP2 = false, bool GATHER = false, bool ABLK = false>
__device__ __forceinline__ void gemm_phase(PG8_LAS unsigned char* lds, const Gemm g, const Sched& S, const Epi& E, const int* __restrict__ rowidx = nullptr) {
    static_assert(!GATHER || SP2, "GATHER is implemented for the SP2 loop");
    int tid_ = threadIdx.x; asm volatile("" : "+v"(tid_)); const int tid = tid_, wid = __builtin_amdgcn_readfirstlane(tid >> 6), lane = tid & 63, wr = wid >> 2, wc = wid & 3, fr = lane & 15, fq = lane >> 4;
    const int K = g.K, nt = K / BK;
    unsigned voffA[2], voffB[2];
#pragma unroll
    for (int i = 0; i < 2; ++i) { int R, C; stage_rc(tid * 16 + i * 8192, R, C); const int Rb = Epi::PERM ? ((R & ~31) + perm32(R & 31)) : R;
        voffA[i] = ABLK ? (unsigned)(R * BK + C) * 2u : (unsigned)(R * K + C) * 2u; voffB[i] = (unsigned)(Rb * BK + C) * 2u; }
    int gR[2], gCc[2];
#pragma unroll
    for (int i = 0; i < 2; ++i) { int R, C; stage_rc(tid * 16 + i * 8192, R, C); gR[i] = R; gCc[i] = C * 2; }
    unsigned gC[2][2], gN[2][2];
#define PG8_GOFF(dst, pmv) do { _Pragma("unroll") for (int _h = 0; _h < 2; ++_h) _Pragma("unroll") for (int _i = 0; _i < 2; ++_i) \
        dst[_h][_i] = (unsigned)rowidx[(pmv) * BM + _h * HALF + gR[_i]] * (unsigned)(K * 2) + (unsigned)gCc[_i]; } while (0)
    const size_t kstep = (size_t)(BK * 2);
    const size_t kstepB = (size_t)(HALF * BK * 2);
    const size_t kstepA = ABLK ? (size_t)(HALF * BK * 2) : kstep;
    const size_t hstep = (size_t)HALF * K * 2;
    const size_t tstep = 2 * hstep;
    const unsigned ldsw = (unsigned)wid * 1024u;
    const int aoff = lds_byte(wr * 64 + fr, fq * 8), boff = lds_byte(wc * 32 + fr, fq * 8);
#define PG8_SA(b, h) (((b) * 2 + (h)) * HTB)
#define PG8_SB(b, h) ((4 + (b) * 2 + (h)) * HTB)
#define PG8_STAGE(bufoff, gbase, voff) do { _Pragma("unroll") for (int _i = 0; _i < 2; ++_i) \
        __builtin_amdgcn_global_load_lds((const unsigned*)((const char*)(gbase) + (voff)[_i]), (PG8_LAS unsigned*)(lds + (bufoff) + ldsw + _i * 8192), 16, 0, 0); } while (0)
#define PG8_STAGE_A(bufoff, gbase, h, nx) do { if constexpr (GATHER) { unsigned _o[2]; _o[0] = (nx) ? gN[h][0] : gC[h][0]; _o[1] = (nx) ? gN[h][1] : gC[h][1]; PG8_STAGE(bufoff, gbase, _o); } \
        else { PG8_STAGE(bufoff, (gbase) + (h) * hstep, voffA); } } while (0)
#define PG8_LDA(dst, b, h) do { _Pragma("unroll") for (int m = 0; m < 4; ++m) _Pragma("unroll") for (int k = 0; k < 2; ++k) dst[m][k] = *(const PG8_LAS bf16x8*)(lds + PG8_SA(b, h) + aoff + m * 2048 + k * 1024); } while (0)
#define PG8_LDB(dst, b, h) do { _Pragma("unroll") for (int n = 0; n < 2; ++n) _Pragma("unroll") for (int k = 0; k < 2; ++k) dst[n][k] = *(const PG8_LAS bf16x8*)(lds + PG8_SB(b, h) + boff + n * 2048 + k * 1024); } while (0)
#define PG8_MMA(ai, bj, At, Bt) do { __builtin_amdgcn_s_setprio(1); _Pragma("unroll") for (int m = 0; m < 4; ++m) _Pragma("unroll") for (int n = 0; n < 2; ++n) _Pragma("unroll") for (int k = 0; k < 2; ++k) \
        acc[ai][bj][m][n] = __builtin_amdgcn_mfma_f32_16x16x32_bf16(Bt[n][k], At[m][k], acc[ai][bj][m][n], 0, 0, 0); __builtin_amdgcn_s_setprio(0); } while (0)
#define PG8_WAIT_V(n) asm volatile("s_waitcnt vmcnt(" #n ")" ::: "memory")
#define PG8_WAIT_L(n) asm volatile("s_waitcnt lgkmcnt(" #n ")" ::: "memory")
#define PG8_BAR __builtin_amdgcn_s_barrier()
#define PG8_SCHED __builtin_amdgcn_sched_barrier(0)
    Unit cur, nxt; int ui = 0;
    if (!S.next(0, cur)) return;
    f32x4 acc[2][2][4][2];
#pragma unroll
    for (int a = 0; a < 2; ++a)
#pragma unroll
        for (int b = 0; b < 2; ++b)
#pragma unroll
            for (int m = 0; m < 4; ++m)
#pragma unroll
                for (int n = 0; n < 2; ++n) acc[a][b][m][n] = (f32x4){0.f, 0.f, 0.f, 0.f};
    bf16x8 At[4][2], B0[2][2], B1[2][2];
    const char* cA = GATHER ? (const char*)g.A : (const char*)g.A + (size_t)cur.pm * tstep; const char* cB = (const char*)g.Bt + (size_t)cur.pn * tstep;
    if constexpr (GATHER) { PG8_GOFF(gC, cur.pm); PG8_GOFF(gN, cur.pm); }
    S.a_ready(cur);
    if constexpr (SP2) {
        PG8_STAGE(PG8_SB(0, 0), cB, voffB); PG8_STAGE(PG8_SB(0, 1), cB + hstep, voffB); PG8_STAGE_A(PG8_SA(0, 0), cA, 0, false); PG8_STAGE_A(PG8_SA(0, 1), cA, 1, false);
        if (wr == 1) PG8_BAR;
        PG8_WAIT_V(2); PG8_BAR;
        PG8_STAGE(PG8_SB(1, 0), cB + kstepB, voffB); PG8_STAGE_A(PG8_SA(1, 0), cA + kstepA, 0, false); PG8_STAGE(PG8_SB(1, 1), cB + hstep + kstepB, voffB);
        PG8_WAIT_V(6); PG8_BAR;
    } else {
        PG8_STAGE(PG8_SB(0, 0), cB, voffB); PG8_STAGE(PG8_SA(0, 0), cA, voffA); PG8_STAGE(PG8_SB(0, 1), cB + hstep, voffB); PG8_STAGE(PG8_SA(0, 1), cA + hstep, voffA);
        if (wr == 1) PG8_BAR;
        PG8_WAIT_V(4); PG8_BAR;
        PG8_STAGE(PG8_SB(1, 0), cB + kstepB, voffB); PG8_STAGE(PG8_SA(1, 0), cA + kstep, voffA); PG8_STAGE(PG8_SB(1, 1), cB + hstep + kstepB, voffB);
        PG8_WAIT_V(6); PG8_BAR;
    }
    for (;;) {
        const bool has_next = S.next(ui + 1, nxt);
        const char* nA = GATHER ? cA : (has_next ? (const char*)g.A + (size_t)nxt.pm * tstep : cA); const char* nB = has_next ? (const char*)g.Bt + (size_t)nxt.pn * tstep : cB;
        if constexpr (GATHER) { if (has_next) PG8_GOFF(gN, nxt.pm); }
        for (int t = 0; t < nt; t += 2) {
            const bool last = (t == nt - 2);
            const char* a1 = cA + (size_t)(t + 1) * kstepA;
            const char* a2 = last ? nA : cA + (size_t)(t + 2) * kstepA; const char* b2 = last ? nB : cB + (size_t)(t + 2) * kstepB;
            const char* a3 = a2 + kstepA; const char* b3 = b2 + kstepB;
            if (last && has_next) S.a_ready(nxt);
            if constexpr (SP2) {
            PG8_LDB(B0, 0, 0); PG8_LDB(B1, 0, 1); PG8_SCHED; PG8_LDA(At, 0, 0); PG8_STAGE_A(PG8_SA(1, 1), a1, 1, false);
            PG8_WAIT_V(8); PG8_WAIT_L(0); PG8_BAR; PG8_MMA(0, 0, At, B0); PG8_MMA(0, 1, At, B1); PG8_BAR; PG8_SCHED;
            PG8_LDA(At, 0, 1); PG8_STAGE(PG8_SB(0, 0), b2, voffB); PG8_STAGE(PG8_SB(0, 1), b2 + hstep, voffB); PG8_STAGE_A(PG8_SA(0, 0), a2, 0, last);
            PG8_WAIT_V(8); PG8_WAIT_L(0); PG8_BAR; PG8_MMA(1, 0, At, B0); PG8_MMA(1, 1, At, B1); PG8_BAR; PG8_SCHED;
            PG8_LDB(B0, 1, 0); PG8_LDB(B1, 1, 1); PG8_SCHED; PG8_LDA(At, 1, 0); PG8_STAGE_A(PG8_SA(0, 1), a2, 1, last);
            PG8_WAIT_V(8); PG8_WAIT_L(0); PG8_BAR; PG8_MMA(0, 0, At, B0); PG8_MMA(0, 1, At, B1); PG8_BAR; PG8_SCHED;
            PG8_LDA(At, 1, 1); PG8_STAGE(PG8_SB(1, 0), b3, voffB); PG8_STAGE(PG8_SB(1, 1), b3 + hstep, voffB); PG8_STAGE_A(PG8_SA(1, 0), a3, 0, last);
            PG8_WAIT_V(8); PG8_WAIT_L(0); PG8_BAR; PG8_MMA(1, 0, At, B0); PG8_MMA(1, 1, At, B1); PG8_BAR; PG8_SCHED;
            } else {
            PG8_LDB(B0, 0, 0); PG8_SCHED; PG8_LDA(At, 0, 0); PG8_STAGE(PG8_SA(1, 1), a1 + hstep, voffA);
            PG8_WAIT_L(8); PG8_BAR; PG8_WAIT_L(0); PG8_MMA(0, 0, At, B0); PG8_BAR; PG8_SCHED;
            PG8_LDB(B1, 0, 1); PG8_STAGE(PG8_SB(0, 0), b2, voffB);
            PG8_BAR; PG8_WAIT_L(0); PG8_MMA(0, 1, At, B1); PG8_BAR;
            PG8_LDA(At, 0, 1); PG8_STAGE(PG8_SA(0, 0), a2, voffA);
            PG8_BAR; PG8_WAIT_L(0); PG8_MMA(1, 0, At, B0); PG8_BAR; PG8_SCHED;
            PG8_STAGE(PG8_SB(0, 1), b2 + hstep, voffB);
            PG8_WAIT_V(6); PG8_BAR; PG8_MMA(1, 1, At, B1); PG8_BAR;
            PG8_LDB(B0, 1, 0); PG8_SCHED; PG8_LDA(At, 1, 0); PG8_STAGE(PG8_SA(0, 1), a2 + hstep, voffA);
            PG8_WAIT_L(8); PG8_BAR; PG8_WAIT_L(0); PG8_MMA(0, 0, At, B0); PG8_BAR; PG8_SCHED;
            PG8_LDB(B1, 1, 1); PG8_STAGE(PG8_SB(1, 0), b3, voffB);
            PG8_BAR; PG8_WAIT_L(0); PG8_MMA(0, 1, At, B1); PG8_BAR;
            PG8_LDA(At, 1, 1); PG8_STAGE(PG8_SA(1, 0), a3, voffA);
            PG8_BAR; PG8_WAIT_L(0); PG8_MMA(1, 0, At, B0); PG8_BAR; PG8_SCHED;
            PG8_STAGE(PG8_SB(1, 1), b3 + hstep, voffB);
            PG8_WAIT_V(6); PG8_BAR; PG8_MMA(1, 1, At, B1); PG8_BAR;
            }
        }
        if constexpr (ALIGN_EPI) { if (wr == 0) PG8_BAR; }
        if constexpr (!Epi::AFTER_DRAIN) { E(acc, cur, wr, wc, fr, fq); S.done(cur); }
        if (!has_next) break;
#pragma unroll
        for (int a = 0; a < 2; ++a)
#pragma unroll
            for (int b = 0; b < 2; ++b)
#pragma unroll
                for (int m = 0; m < 4; ++m)
#pragma unroll
                    for (int n = 0; n < 2; ++n) acc[a][b][m][n] = (f32x4){0.f, 0.f, 0.f, 0.f};
        cur = nxt; cA = nA; cB = nB; ++ui;
        if constexpr (GATHER) { _Pragma("unroll") for (int _h = 0; _h < 2; ++_h) _Pragma("unroll") for (int _i = 0; _i < 2; ++_i) gC[_h][_i] = gN[_h][_i]; }
        if constexpr (ALIGN_EPI) { if (wr == 1) PG8_BAR; }
    }
    PG8_WAIT_V(0);
    if constexpr (!ALIGN_EPI) { if (wr == 0) PG8_BAR; }
    PG8_BAR;
    if constexpr (Epi::AFTER_DRAIN) { E.fused(acc, cur, wr, wc, fr, fq, lds, wid, lane); S.done(cur); }
#undef PG8_SA
#undef PG8_SB
#undef PG8_STAGE
#undef PG8_STAGE_A
#undef PG8_GOFF
#undef PG8_LDA
#undef PG8_LDB
#undef PG8_MMA
#undef PG8_WAIT_V
#undef PG8_WAIT_L
#undef PG8_BAR
#undef PG8_SCHED
}
}

using pg8::bf16_t; using pg8::bf16x8; using pg8::f32x4; using pg8::u32x4; using pg8::u32x2;
#define LAS __attribute__((address_space(3)))
typedef short bf16x4 __attribute__((ext_vector_type(4)));

constexpr int NB = 4, SEQ = 4096, DM = 1024, MTOK = NB * SEQ, DIN = 2048, NE = 16, FF = 2048, CAP = 512, NROWX = NE * NB * CAP;
constexpr float ALPHA = 1.41421356237309515f, LN_EPS = 1e-5f;
constexpr int NWAVES = 8, NTHR = 512;
constexpr int LDS_BYTES = 147456;
constexpr int S5T = 32, S5NCH = SEQ / S5T;

constexpr size_t MiB = 1u << 20;
constexpr size_t WS_WIN = 0, WS_WOUT = 8 * MiB, WS_WGLU = 12 * MiB, WS_S5TAB = 13 * MiB, WS_AFFT = 14 * MiB, WS_IDX = 15 * MiB, WS_GATE = 16 * MiB, WS_SLOT = 17 * MiB, WS_BAR = 18 * MiB, WS_S5BT = 19 * MiB, WS_S5CT = 20 * MiB;
constexpr size_t WS_WGU = 32 * MiB, WS_WD = 288 * MiB, WS_H32 = 416 * MiB, WS_HBF = 480 * MiB, WS_RA = 512 * MiB  , WS_RB = 576 * MiB  ;
constexpr size_t WS_HDN = 640 * MiB, WS_KVF = 768 * MiB, WS_KVB = 776 * MiB, WS_STF = 784 * MiB, WS_STB = 792 * MiB, WS_S5E = 800 * MiB, WS_S5C = 808 * MiB, WS_END = 816 * MiB;

struct Args { const float* in[25]; float* out; unsigned char* ws; int ph_lo, ph_hi; };

typedef __bf16 bf16x2_hw __attribute__((ext_vector_type(2)));
typedef float f32x2_hw __attribute__((ext_vector_type(2)));
__device__ __forceinline__ unsigned pk2(float lo, float hi) { const f32x2_hw v = {lo, hi}; const bf16x2_hw b = __builtin_convertvector(v, bf16x2_hw); return __builtin_bit_cast(unsigned, b); }
__device__ __forceinline__ unsigned f2bf(float f) { return pk2(f, 0.f) & 0xffffu; }
__device__ __forceinline__ float bflo(unsigned w) { return __uint_as_float(w << 16); }
__device__ __forceinline__ float bfhi(unsigned w) { return __uint_as_float(w & 0xffff0000u); }
__device__ __forceinline__ f32x4 mfma16(bf16x8 a, bf16x8 b, f32x4 c) { return __builtin_amdgcn_mfma_f32_16x16x32_bf16(a, b, c, 0, 0, 0); }
__device__ __forceinline__ float wave_sum(float v) {
#pragma unroll
    for (int o = 1; o < 64; o <<= 1) v += __shfl_xor(v, o);
    return v;
}
__device__ __forceinline__ bf16x8 pack8(const f32x4& a, const f32x4& b) {
    u32x4 w; w.x = pk2(a[0], a[1]); w.y = pk2(a[2], a[3]); w.z = pk2(b[0], b[1]); w.w = pk2(b[2], b[3]);
    return __builtin_bit_cast(bf16x8, w);
}
__device__ __forceinline__ bf16x8 cat8(bf16x4 lo, bf16x4 hi) { bf16x8 r; r[0] = lo[0]; r[1] = lo[1]; r[2] = lo[2]; r[3] = lo[3]; r[4] = hi[0]; r[5] = hi[1]; r[6] = hi[2]; r[7] = hi[3]; return r; }
#define LDS_WAIT() asm volatile("s_waitcnt lgkmcnt(0)" ::: "memory")

struct ConvItem { const float* srcp; bf16_t* dstp; int N; int rstep; };
__device__ __forceinline__ ConvItem conv_decode(const Args& a, int it, int lane) {
    constexpr int I3 = 16384, I4 = 16384, I5 = 16384, I0 = 1024, I1 = 512;
    unsigned char* ws = a.ws;
    const float* src; bf16_t* dst; int K, N, rmul = 1, ro = 0, kb, nb;
    int r = it;
    if (r < I3 + I4) { const int up = r >= I3; r -= up ? I3 : 0; const int mat = r >> 9, q = r & 511; src = (up ? a.in[21] : a.in[20]) + (size_t)mat * DM * FF; dst = (bf16_t*)(ws + WS_WGU) + (size_t)mat * 2 * FF * DM; K = DM; N = FF; rmul = 2; ro = up; kb = q >> 5; nb = q & 31; }
    else { r -= I3 + I4;
        if (r < I5) { const int mat = r >> 9, q = r & 511; src = a.in[22] + (size_t)mat * FF * DM; dst = (bf16_t*)(ws + WS_WD) + (size_t)mat * DM * FF; K = FF; N = DM; kb = q >> 4; nb = q & 15; }
        else { r -= I5;
            if (r < I0) { const int mat = r >> 9, q = r & 511; src = a.in[3] + (size_t)mat * DM * DIN; dst = (bf16_t*)(ws + WS_WIN) + (size_t)mat * DIN * DM; K = DM; N = DIN; kb = q >> 5; nb = q & 31; }
            else { r -= I0;
                if (r < I1) { const int mat = r >> 8, q = r & 255; src = a.in[16] + (size_t)mat * DM * DM; dst = (bf16_t*)(ws + WS_WOUT) + (size_t)mat * DM * DM; K = DM; N = DM; kb = q >> 4; nb = q & 15; }
                else { r -= I1; const int mat = r >> 4, q = r & 15; src = a.in[13] + (size_t)mat * 65536; dst = (bf16_t*)(ws + WS_WGLU) + (size_t)mat * 65536; K = 256; N = 256; kb = q >> 2; nb = q & 3; } } } }
    ConvItem c; c.N = N;
    c.srcp = src + (size_t)(kb * 64 + (lane >> 4)) * N + nb * 64 + (lane & 15) * 4;
    {
        const int brow = (rmul == 2) ? ((nb >> 1) * 256 + ro * 128 + (nb & 1) * 64) : nb * 64;
        if (K == 256) { c.dstp = dst + (size_t)brow * K + kb * 64; c.rstep = K; }
        else { c.dstp = dst + ((size_t)(brow >> 7) * (K >> 6) + kb) * 8192 + (brow & 127) * 64; c.rstep = 64; }
    }
    return c;
}
__device__ __forceinline__ void conv_load(const ConvItem& c, f32x4 (&v)[16]) {
#pragma unroll
    for (int i = 0; i < 16; ++i) v[i] = __builtin_nontemporal_load((const f32x4*)(c.srcp + (size_t)(i * 4) * c.N));
}
__device__ __forceinline__ void conv_store(const ConvItem& c, const f32x4 (&v)[16], LAS float* scr, int lane) {
    const int r4 = lane >> 4, c4 = (lane & 15) * 4;
#pragma unroll
    for (int i = 0; i < 16; ++i) { const int kk = i * 4 + r4; *(LAS f32x4*)(scr + kk * 68 + (c4 ^ (((kk >> 3) & 7) * 4))) = v[i]; }
    LDS_WAIT();
    const int cc = lane & 7, nl = lane >> 3;
#pragma unroll
    for (int p = 0; p < 8; ++p) {
        const int n = nl + 8 * p;
        const LAS float* s = scr + (8 * cc) * 68 + (n ^ (4 * cc));
        u32x4 o; o.x = pk2(s[0], s[68]); o.y = pk2(s[2 * 68], s[3 * 68]); o.z = pk2(s[4 * 68], s[5 * 68]); o.w = pk2(s[6 * 68], s[7 * 68]);
        *(u32x4*)(c.dstp + (size_t)n * c.rstep + 8 * cc) = o;
    }
    LDS_WAIT();
}
__device__ __forceinline__ void sincos_rev(double f, double& sn, double& cs) {
    const double a = f * 6.283185307179586476925;
    const double q = rint(a * 0.636619772367581343);
    const double r = a - q * 1.570796326794896619;
    const double r2 = r * r;
    double s = -7.6471637318198164759e-13; s = s * r2 + 1.6059043836821614599e-10; s = s * r2 - 2.5052108385441718775e-8; s = s * r2 + 2.7557319223985890653e-6;
    s = s * r2 - 1.9841269841269841270e-4; s = s * r2 + 8.3333333333333333333e-3; s = s * r2 - 1.6666666666666666667e-1; s = s * r2 * r + r;
    double c = 4.7794773323873852974e-14; c = c * r2 - 1.1470745597729724714e-11; c = c * r2 + 2.0876756987868098979e-9; c = c * r2 - 2.7557319223985890653e-7;
    c = c * r2 + 2.4801587301587301587e-5; c = c * r2 - 1.3888888888888888889e-3; c = c * r2 + 4.1666666666666666667e-2; c = c * r2 - 0.5; c = c * r2 + 1.0;
    const int qi = ((int)q) & 3;
    sn = (qi == 0) ? s : (qi == 1) ? c : (qi == 2) ? -s : -c;
    cs = (qi == 0) ? c : (qi == 1) ? -s : (qi == 2) ? -c : s;
}
__device__ __forceinline__ double exp_small(double x) {
    const double y = x * (1.0 / 64.0);
    double e = 1.0 / 479001600.0;
    e = e * y + 1.0 / 39916800.0; e = e * y + 1.0 / 3628800.0; e = e * y + 1.0 / 362880.0; e = e * y + 1.0 / 40320.0; e = e * y + 1.0 / 5040.0; e = e * y + 1.0 / 720.0;
    e = e * y + 1.0 / 120.0; e = e * y + 1.0 / 24.0; e = e * y + 1.0 / 6.0; e = e * y + 0.5; e = e * y + 1.0; e = e * y + 1.0;
#pragma unroll
    for (int i = 0; i < 6; ++i) e = e * e;
    return e;
}
__device__ __forceinline__ void s5_coefs(const Args& a, int t, double& br, double& bi, double& cr, double& ci, double& tr, double& ti) {
    const int g = (t >> 6) & 15, lr = t >> 10;
    const double lre = (double)a.in[5][t], lim = (double)a.in[6][t];
    const double step = exp_small((double)a.in[7][lr * 16 + g]);
    const double ar = lre * step, th = lim * step;
    const double rev = th * 0.15915494309189533577; const double fr = rev - rint(rev);
    double sn, cs; sincos_rev(fr, sn, cs);
    const double mag = exp_small(ar);
    br = mag * cs; bi = mag * sn;
    const double nr = br - 1.0, ni = bi, den = lre * lre + lim * lim;
    cr = (nr * lre + ni * lim) / den; ci = (ni * lre - nr * lim) / den;
    const double rev2 = rev * (double)S5T; const double fr2 = rev2 - rint(rev2);
    double sn2, cs2; sincos_rev(fr2, sn2, cs2);
    const double mag2 = exp_small(ar * (double)S5T);
    tr = mag2 * cs2; ti = mag2 * sn2;
}
__device__ __forceinline__ void s5_table_entry(const Args& a, int t) {
    double br, bi, cr, ci, tr, ti; s5_coefs(a, t, br, bi, cr, ci, tr, ti);
    float* o = (float*)(a.ws + WS_S5TAB) + (size_t)t * 8;
    o[0] = (float)br; o[1] = (float)bi; o[2] = (float)cr; o[3] = (float)ci; o[4] = (float)tr; o[5] = (float)ti; o[6] = 0.f; o[7] = 0.f;
}
__device__ __forceinline__ void s5_bt_row(const Args& a, int t) {
    const int l = t >> 12, g = (t >> 8) & 15, n = t & 255, r = n >> 7, p = (n >> 1) & 63, ri = n & 1;
    double br, bi, cr, ci, tr, ti; s5_coefs(a, ((l * 2 + r) * 16 + g) * 64 + p, br, bi, cr, ci, tr, ti);
    const float crf = (float)cr, cif = (float)ci;
    const float* bre = a.in[8] + (size_t)((l * 16 + g) * 64 + p) * 16; const float* bim = a.in[9] + (size_t)((l * 16 + g) * 64 + p) * 16;
    u32x4 o[2];
#pragma unroll
    for (int h = 0; h < 2; ++h) {
        const f32x4 x0 = *(const f32x4*)(bre + 8 * h), x1 = *(const f32x4*)(bre + 8 * h + 4), y0 = *(const f32x4*)(bim + 8 * h), y1 = *(const f32x4*)(bim + 8 * h + 4);
        float v[8];
#pragma unroll
        for (int k = 0; k < 4; ++k) { v[k] = ri ? (crf * y0[k] + cif * x0[k]) : (crf * x0[k] - cif * y0[k]); v[4 + k] = ri ? (crf * y1[k] + cif * x1[k]) : (crf * x1[k] - cif * y1[k]); }
        o[h].x = pk2(v[0], v[1]); o[h].y = pk2(v[2], v[3]); o[h].z = pk2(v[4], v[5]); o[h].w = pk2(v[6], v[7]);
    }
    u32x4* dst = (u32x4*)((bf16_t*)(a.ws + WS_S5BT) + (size_t)t * 32);
    dst[0] = o[0]; dst[1] = o[1]; dst[2] = (u32x4){0u, 0u, 0u, 0u}; dst[3] = (u32x4){0u, 0u, 0u, 0u};
}
__device__ __forceinline__ void s5_ct_entry(const Args& a, int t) {
    const int p = t & 63, r = (t >> 6) & 1, c = (t >> 7) & 15, g = (t >> 11) & 15, l = t >> 15;
    const size_t ci = (size_t)(((l * 2 + r) * 16 + g) * 16 + c) * 64 + p;
    ((unsigned*)(a.ws + WS_S5CT))[t] = pk2(a.in[10][ci], -a.in[11][ci]);
}
__device__ __forceinline__ void ln_rows4(f32x4 (&v)[4], const float* __restrict__ g, const float* __restrict__ bt, int lane) {
    float s = 0.f;
#pragma unroll
    for (int j = 0; j < 4; ++j) s += (v[j][0] + v[j][1]) + (v[j][2] + v[j][3]);
    const float mean = wave_sum(s) * (1.f / DM); float s2 = 0.f;
#pragma unroll
    for (int j = 0; j < 4; ++j) { v[j] = v[j] - mean; s2 += (v[j][0] * v[j][0] + v[j][1] * v[j][1]) + (v[j][2] * v[j][2] + v[j][3] * v[j][3]); }
    const float rstd = 1.f / sqrtf(wave_sum(s2) * (1.f / DM) + LN_EPS);
#pragma unroll
    for (int j = 0; j < 4; ++j) { const f32x4 gv = ((const f32x4*)g)[lane + 64 * j], bv = ((const f32x4*)bt)[lane + 64 * j]; v[j] = v[j] * rstd * gv + bv; }
}
__device__ __forceinline__ void store_row(const f32x4 (&v)[4], float* o32, bf16_t* obf, int lane) {
#pragma unroll
    for (int j = 0; j < 4; ++j) {
        if (o32) ((f32x4*)o32)[lane + 64 * j] = v[j];
        if (obf) { u32x2 w; w.x = pk2(v[j][0], v[j][1]); w.y = pk2(v[j][2], v[j][3]); ((u32x2*)obf)[lane + 64 * j] = w; }
    }
}
__device__ __forceinline__ void phase_p0(const Args& a, LAS unsigned char* lds, int tid) {
    const int lane = tid & 63, wave = tid >> 6;
    const int gw = blockIdx.x * NWAVES + wave, NGW = gridDim.x * NWAVES;
    LAS float* scr = (LAS float*)(lds + wave * 17408);
    unsigned char* ws = a.ws;
    constexpr int NIT = 16384 * 3 + 1024 + 512 + 32;
    if (gw < NIT) {
        ConvItem cur = conv_decode(a, gw, lane);
        f32x4 v[16]; conv_load(cur, v);
        for (int it = gw; it < NIT; it += NGW) {
            const bool more = (it + NGW) < NIT;
            ConvItem nxt = cur; f32x4 vn[16];
            if (more) { nxt = conv_decode(a, it + NGW, lane); conv_load(nxt, vn); }
            conv_store(cur, v, scr, lane);
            if (more) { cur = nxt;
#pragma unroll
                for (int i = 0; i < 16; ++i) v[i] = vn[i]; }
        }
    }
    for (int t = blockIdx.x * NTHR + tid; t < 4096; t += gridDim.x * NTHR) s5_table_entry(a, t);
    for (int t = blockIdx.x * NTHR + tid; t < 8192; t += gridDim.x * NTHR) s5_bt_row(a, t);
    for (int t = blockIdx.x * NTHR + tid; t < 65536; t += gridDim.x * NTHR) s5_ct_entry(a, t);
    for (int m = gw; m < MTOK; m += NGW) {
        f32x4 v[4];
#pragma unroll
        for (int j = 0; j < 4; ++j) v[j] = ((const f32x4*)(a.in[0] + (size_t)m * DM))[lane + 64 * j];
        ln_rows4(v, a.in[1], a.in[2], lane);
        store_row(v, nullptr, (bf16_t*)(ws + WS_HBF) + (size_t)m * DM, lane);
    }
}

__device__ __forceinline__ void attn_item(int item, const bf16_t* __restrict__ proj, bf16_t* __restrict__ mix, const float* __restrict__ sink_l, LAS unsigned char* lds, int tid) {
    const int kh = item & 1, c = (item >> 1) & 31, b = item >> 6;
    constexpr int VS = 408;
    LAS bf16_t* Ks = (LAS bf16_t*)lds;
    LAS bf16_t* Vt = (LAS bf16_t*)(lds + 384 * 72 * 2);
    const int lane = tid & 63, w = tid >> 6, fr = lane & 15, fq = lane >> 4;
    const int hq = kh * 4 + (w >> 1);
    const bf16_t* qbase = proj + ((size_t)b * SEQ + c * 128 + (w & 1) * 64 + fr) * DIN + 1280 + hq * 64 + fq * 8;
    bf16x8 qn0 = *(const bf16x8*)qbase, qn1 = *(const bf16x8*)(qbase + 32);
#pragma unroll
    for (int i = 0; i < 6; ++i) {
        const int id = tid + NTHR * i, key = id >> 3, ch = id & 7;
        const int s = (c - 1) * 128 + key; const bool ok = (s >= 0) && (s < SEQ);
        u32x4 kv = {0u, 0u, 0u, 0u}, vv = {0u, 0u, 0u, 0u};
        if (ok) { const bf16_t* rowp = proj + (size_t)(b * SEQ + s) * DIN; kv = *(const u32x4*)(rowp + 1792 + kh * 64 + ch * 8); vv = *(const u32x4*)(rowp + 1920 + kh * 64 + ch * 8); }
        *(LAS u32x4*)(Ks + key * 72 + ch * 8) = kv;
        LAS bf16_t* vp = Vt + (ch * 8) * VS + key;
        vp[0 * VS] = (bf16_t)(vv.x & 0xffffu); vp[1 * VS] = (bf16_t)(vv.x >> 16); vp[2 * VS] = (bf16_t)(vv.y & 0xffffu); vp[3 * VS] = (bf16_t)(vv.y >> 16);
        vp[4 * VS] = (bf16_t)(vv.z & 0xffffu); vp[5 * VS] = (bf16_t)(vv.z >> 16); vp[6 * VS] = (bf16_t)(vv.w & 0xffffu); vp[7 * VS] = (bf16_t)(vv.w >> 16);
    }
    if (tid < 128) { const int d = tid >> 1, hh = tid & 1; *(LAS u32x4*)(Vt + d * VS + 384 + hh * 8) = (u32x4){0u, 0u, 0u, 0u}; }
    __syncthreads();
    const float slope = exp2f(-(float)(hq + 1));
    const float sinkv = sink_l[hq];
    const bool lo_ok = (c >= 1), hi_ok = (c <= 30);
    float plo[4], phi[4];
#pragma unroll
    for (int j = 0; j < 4; ++j) { plo[j] = (fq * 4 + j >= fr) ? 0.f : -1e30f; phi[j] = (fq * 4 + j <= fr) ? 0.f : -1e30f; }
#pragma unroll 1
    for (int qi = 0; qi < 4; ++qi) {
        const int qt = (w & 1) * 4 + qi;
        const size_t tok = (size_t)b * SEQ + c * 128 + qt * 16 + fr;
        const bf16x8 qa0 = qn0, qa1 = qn1;
        float slope_l = slope; asm volatile("" : "+v"(slope_l));
        float sd[4];
#pragma unroll
        for (int j = 0; j < 4; ++j) sd[j] = slope_l * (float)(fq * 4 + j - fr);
        if (qi < 3) { const bf16_t* qp = qbase + (size_t)(qi + 1) * 16 * DIN; qn0 = *(const bf16x8*)qp; qn1 = *(const bf16x8*)(qp + 32); }
        f32x4 s[18];
        float mx = sinkv;
        const LAS bf16_t* kbase = Ks + (qt * 16 + fr) * 72 + fq * 8;
        const LAS bf16_t* vbase = Vt + fr * VS + qt * 16 + fq * 4;
#pragma unroll
        for (int i = 0; i < 17; ++i) {
            const int kt = qt + i;
            const LAS bf16_t* kp = kbase + i * (16 * 72);
            f32x4 acc = {0.f, 0.f, 0.f, 0.f};
            acc = mfma16(*(const LAS bf16x8*)kp, qa0, acc); acc = mfma16(*(const LAS bf16x8*)(kp + 32), qa1, acc);
            const float pblk = ((kt < 8) ? lo_ok : ((kt >= 16) ? hi_ok : true)) ? 0.f : -1e30f;
            const float base = slope_l * (float)(16 * i - 128);
#pragma unroll
            for (int j = 0; j < 4; ++j) {
                float t = (i < 8) ? (base + sd[j]) : ((i > 8) ? -(base + sd[j]) : -fabsf(sd[j]));
                if (i == 0) t += plo[j];
                if (i == 16) t += phi[j];
                const float v = fmaf(acc[j], 0.125f, t + pblk);
                acc[j] = v; mx = fmaxf(mx, v);
            }
            s[i] = acc;
        }
        mx = fmaxf(mx, __shfl_xor(mx, 16)); mx = fmaxf(mx, __shfl_xor(mx, 32));
        float sum = 0.f;
#pragma unroll
        for (int i = 0; i < 17; ++i)
#pragma unroll
            for (int j = 0; j < 4; ++j) { const float p = __expf(s[i][j] - mx); s[i][j] = p; sum += p; }
        s[17] = (f32x4){0.f, 0.f, 0.f, 0.f};
        sum += __shfl_xor(sum, 16); sum += __shfl_xor(sum, 32);
        const float inv = 1.f / (sum + __expf(sinkv - mx));
        f32x4 o[4];
#pragma unroll
        for (int dt = 0; dt < 4; ++dt) o[dt] = (f32x4){0.f, 0.f, 0.f, 0.f};
#pragma unroll
        for (int kk = 0; kk < 9; ++kk) {
            const bf16x8 pb = pack8(s[2 * kk], s[2 * kk + 1]);
#pragma unroll
            for (int dt = 0; dt < 4; ++dt) {
                const LAS bf16_t* vp = vbase + dt * (16 * VS) + kk * 32;
                o[dt] = mfma16(cat8(*(const LAS bf16x4*)vp, *(const LAS bf16x4*)(vp + 16)), pb, o[dt]);
            }
        }
        bf16_t* op = mix + tok * DM + 512 + hq * 64 + fq * 4;
#pragma unroll
        for (int dt = 0; dt < 4; ++dt) { u32x2 wv; wv.x = pk2(o[dt][0] * inv, o[dt][1] * inv); wv.y = pk2(o[dt][2] * inv, o[dt][3] * inv); *(u32x2*)(op + dt * 16) = wv; }
    }
    __syncthreads();
}

__device__ __forceinline__ float log_sigmoid(float t) { return -log1pf(__expf(-t)); }
__device__ __forceinline__ void retkv_item(int item, const bf16_t* __restrict__ proj, float* __restrict__ kvf, float* __restrict__ kvb, const float* __restrict__ theta, LAS unsigned char* lds, int tid) {
    const int h = item & 3, c = (item >> 2) & 31, b = item >> 7;
    const float lgf = log_sigmoid(theta[h]), lgb = log_sigmoid(theta[4 + h]);
    LAS bf16_t* KTf = (LAS bf16_t*)lds; LAS bf16_t* KTb = KTf + 64 * 136; LAS bf16_t* VT = KTb + 64 * 136;
#pragma unroll
    for (int i = 0; i < 2; ++i) {
        const int id = tid + NTHR * i, j = id >> 3, ch = id & 7;
        const bf16_t* rowp = proj + (size_t)(b * SEQ + c * 128 + j) * DIN;
        const u32x4 kr = *(const u32x4*)(rowp + 256 + h * 64 + ch * 8), vr = *(const u32x4*)(rowp + 512 + h * 64 + ch * 8);
        const float wf = __expf(lgf * (float)(127 - j)) * 0.125f, wb = __expf(lgb * (float)j) * 0.125f;
        const int o = (ch * 8) * 136 + j;
        KTf[o + 0 * 136] = (bf16_t)f2bf(bflo(kr.x) * wf); KTf[o + 1 * 136] = (bf16_t)f2bf(bfhi(kr.x) * wf); KTf[o + 2 * 136] = (bf16_t)f2bf(bflo(kr.y) * wf); KTf[o + 3 * 136] = (bf16_t)f2bf(bfhi(kr.y) * wf);
        KTf[o + 4 * 136] = (bf16_t)f2bf(bflo(kr.z) * wf); KTf[o + 5 * 136] = (bf16_t)f2bf(bfhi(kr.z) * wf); KTf[o + 6 * 136] = (bf16_t)f2bf(bflo(kr.w) * wf); KTf[o + 7 * 136] = (bf16_t)f2bf(bfhi(kr.w) * wf);
        KTb[o + 0 * 136] = (bf16_t)f2bf(bflo(kr.x) * wb); KTb[o + 1 * 136] = (bf16_t)f2bf(bfhi(kr.x) * wb); KTb[o + 2 * 136] = (bf16_t)f2bf(bflo(kr.y) * wb); KTb[o + 3 * 136] = (bf16_t)f2bf(bfhi(kr.y) * wb);
        KTb[o + 4 * 136] = (bf16_t)f2bf(bflo(kr.z) * wb); KTb[o + 5 * 136] = (bf16_t)f2bf(bfhi(kr.z) * wb); KTb[o + 6 * 136] = (bf16_t)f2bf(bflo(kr.w) * wb); KTb[o + 7 * 136] = (bf16_t)f2bf(bfhi(kr.w) * wb);
        VT[o + 0 * 136] = (bf16_t)(vr.x & 0xffffu); VT[o + 1 * 136] = (bf16_t)(vr.x >> 16); VT[o + 2 * 136] = (bf16_t)(vr.y & 0xffffu); VT[o + 3 * 136] = (bf16_t)(vr.y >> 16);
        VT[o + 4 * 136] = (bf16_t)(vr.z & 0xffffu); VT[o + 5 * 136] = (bf16_t)(vr.z >> 16); VT[o + 6 * 136] = (bf16_t)(vr.w & 0xffffu); VT[o + 7 * 136] = (bf16_t)(vr.w >> 16);
    }
    __syncthreads();
    const int lane = tid & 63, w = tid >> 6, fr = lane & 15, fq = lane >> 4;
    const size_t obase = (size_t)((b * 32 + c) * 4 + h) * 4096;
#pragma unroll
    for (int i = 0; i < 4; ++i) {
        const int job = w * 4 + i, dirb = job >> 4, et = (job >> 2) & 3, dt = job & 3;
        const LAS bf16_t* ap = VT + (et * 16 + fr) * 136 + fq * 8;
        const LAS bf16_t* bp = (dirb ? KTb : KTf) + (dt * 16 + fr) * 136 + fq * 8;
        f32x4 acc = {0.f, 0.f, 0.f, 0.f};
#pragma unroll
        for (int ks = 0; ks < 4; ++ks) acc = mfma16(*(const LAS bf16x8*)(ap + ks * 32), *(const LAS bf16x8*)(bp + ks * 32), acc);
        float* op = (dirb ? kvb : kvf) + obase + (et * 16 + fq * 4) * 64 + dt * 16 + fr;
        op[0] = acc[0]; op[64] = acc[1]; op[128] = acc[2]; op[192] = acc[3];
    }
    __syncthreads();
}
__device__ __forceinline__ void retout_item(int item, const bf16_t* __restrict__ proj, const float* __restrict__ stf, const float* __restrict__ stb, bf16_t* __restrict__ mix, const float* __restrict__ theta, LAS unsigned char* lds, int tid) {
    const int h = item & 3, c = (item >> 2) & 31, b = item >> 7;
    const float lgf = log_sigmoid(theta[h]), lgb = log_sigmoid(theta[4 + h]);
    LAS bf16_t* Qs = (LAS bf16_t*)lds; LAS bf16_t* Ks = Qs + 128 * 72; LAS bf16_t* VT = Ks + 128 * 72; LAS bf16_t* SFt = VT + 64 * 136; LAS bf16_t* SBt = SFt + 64 * 72;
#pragma unroll
    for (int i = 0; i < 2; ++i) {
        const int id = tid + NTHR * i, j = id >> 3, ch = id & 7;
        const bf16_t* rowp = proj + (size_t)(b * SEQ + c * 128 + j) * DIN;
        const u32x4 qr = *(const u32x4*)(rowp + h * 64 + ch * 8), kr = *(const u32x4*)(rowp + 256 + h * 64 + ch * 8), vr = *(const u32x4*)(rowp + 512 + h * 64 + ch * 8);
        *(LAS u32x4*)(Qs + j * 72 + ch * 8) = qr; *(LAS u32x4*)(Ks + j * 72 + ch * 8) = kr;
        const int o = (ch * 8) * 136 + j;
        VT[o + 0 * 136] = (bf16_t)(vr.x & 0xffffu); VT[o + 1 * 136] = (bf16_t)(vr.x >> 16); VT[o + 2 * 136] = (bf16_t)(vr.y & 0xffffu); VT[o + 3 * 136] = (bf16_t)(vr.y >> 16);
        VT[o + 4 * 136] = (bf16_t)(vr.z & 0xffffu); VT[o + 5 * 136] = (bf16_t)(vr.z >> 16); VT[o + 6 * 136] = (bf16_t)(vr.w & 0xffffu); VT[o + 7 * 136] = (bf16_t)(vr.w >> 16);
    }
    const size_t sbase = (size_t)((b * 32 + c) * 4 + h) * 4096;
#pragma unroll
    for (int i = 0; i < 8; ++i) { const int id = tid + NTHR * i, e = id >> 6, d = id & 63; SFt[e * 72 + d] = (bf16_t)f2bf(stf[sbase + id]); SBt[e * 72 + d] = (bf16_t)f2bf(stb[sbase + id]); }
    __syncthreads();
    const int lane = tid & 63, it = tid >> 6, fr = lane & 15, fq = lane >> 4;
    const int ipos = it * 16 + fr;
    const LAS bf16_t* qp = Qs + ipos * 72 + fq * 8;
    const bf16x8 qb0 = *(const LAS bf16x8*)qp, qb1 = *(const LAS bf16x8*)(qp + 32);
    f32x4 st[8];
#pragma unroll
    for (int jt = 0; jt < 8; ++jt) {
        const LAS bf16_t* kp = Ks + (jt * 16 + fr) * 72 + fq * 8;
        f32x4 acc = {0.f, 0.f, 0.f, 0.f};
        acc = mfma16(*(const LAS bf16x8*)kp, qb0, acc); acc = mfma16(*(const LAS bf16x8*)(kp + 32), qb1, acc);
#pragma unroll
        for (int jj = 0; jj < 4; ++jj) { const int dij = ipos - (jt * 16 + fq * 4 + jj); const float dec = dij >= 0 ? __expf(lgf * (float)dij) : __expf(lgb * (float)(-dij)); acc[jj] *= 0.125f * dec; }
        st[jt] = acc;
    }
    f32x4 o[4], ff[4], fb[4];
#pragma unroll
    for (int et = 0; et < 4; ++et) { o[et] = (f32x4){0.f, 0.f, 0.f, 0.f}; ff[et] = o[et]; fb[et] = o[et]; }
#pragma unroll
    for (int kk = 0; kk < 4; ++kk) {
        const bf16x8 pb = pack8(st[2 * kk], st[2 * kk + 1]);
#pragma unroll
        for (int et = 0; et < 4; ++et) { const LAS bf16_t* vp = VT + (et * 16 + fr) * 136 + kk * 32 + fq * 4; o[et] = mfma16(cat8(*(const LAS bf16x4*)vp, *(const LAS bf16x4*)(vp + 16)), pb, o[et]); }
    }
#pragma unroll
    for (int et = 0; et < 4; ++et) {
        const LAS bf16_t* fp = SFt + (et * 16 + fr) * 72 + fq * 8; const LAS bf16_t* bp = SBt + (et * 16 + fr) * 72 + fq * 8;
        ff[et] = mfma16(*(const LAS bf16x8*)fp, qb0, ff[et]); ff[et] = mfma16(*(const LAS bf16x8*)(fp + 32), qb1, ff[et]);
        fb[et] = mfma16(*(const LAS bf16x8*)bp, qb0, fb[et]); fb[et] = mfma16(*(const LAS bf16x8*)(bp + 32), qb1, fb[et]);
    }
    const float cf = __expf(lgf * (float)(ipos + 1)), cb = __expf(lgb * (float)(128 - ipos));
    float s = 0.f;
#pragma unroll
    for (int et = 0; et < 4; ++et) { o[et] = o[et] + ff[et] * cf + fb[et] * cb; s += (o[et][0] + o[et][1]) + (o[et][2] + o[et][3]); }
    s += __shfl_xor(s, 16); s += __shfl_xor(s, 32);
    const float mean = s * (1.f / 64.f); float s2 = 0.f;
#pragma unroll
    for (int et = 0; et < 4; ++et) { o[et] = o[et] - mean; s2 += (o[et][0] * o[et][0] + o[et][1] * o[et][1]) + (o[et][2] * o[et][2] + o[et][3] * o[et][3]); }
    s2 += __shfl_xor(s2, 16); s2 += __shfl_xor(s2, 32);
    const float rstd = 1.f / sqrtf(s2 * (1.f / 64.f) + LN_EPS);
    const size_t tok = (size_t)b * SEQ + c * 128 + ipos;
    const bf16_t* gp = proj + tok * DIN + 768 + h * 64 + fq * 4;
    bf16_t* op = mix + tok * DM + h * 64 + fq * 4;
#pragma unroll
    for (int et = 0; et < 4; ++et) {
        const u32x2 gr = *(const u32x2*)(gp + et * 16);
        const float g0 = bflo(gr.x), g1 = bfhi(gr.x), g2 = bflo(gr.y), g3 = bfhi(gr.y);
        const float y0 = o[et][0] * rstd * (g0 / (1.f + __expf(-g0))), y1 = o[et][1] * rstd * (g1 / (1.f + __expf(-g1)));
        const float y2 = o[et][2] * rstd * (g2 / (1.f + __expf(-g2))), y3 = o[et][3] * rstd * (g3 / (1.f + __expf(-g3)));
        u32x2 wv; wv.x = pk2(y0, y1); wv.y = pk2(y2, y3); *(u32x2*)(op + et * 16) = wv;
    }
    __syncthreads();
}

constexpr int S5XS = 136;
struct S5Pass { bf16x8 bf[8]; f32x4 t0; };
__device__ __forceinline__ void s5_fetch(S5Pass& P, const float* __restrict__ tab, const bf16_t* __restrict__ BT, int g, int r, int lane) {
    const int fr = lane & 15, fq = lane >> 4;
    P.t0 = *(const f32x4*)(tab + (size_t)((r * 16 + g) * 64 + lane) * 8);
    const bf16_t* btp = BT + (size_t)(g * 256 + r * 128 + fr) * 32 + fq * 8;
#pragma unroll
    for (int nt = 0; nt < 8; ++nt) P.bf[nt] = *(const bf16x8*)(btp + nt * 16 * 32);
}
__device__ __forceinline__ void s5_bu(LAS bf16_t* Xw, const S5Pass& P, bf16x8 uf0, bf16x8 uf1, int lane) {
    const int fr = lane & 15, fq = lane >> 4;
#pragma unroll
    for (int mt = 0; mt < 2; ++mt)
#pragma unroll
        for (int nt = 0; nt < 8; ++nt) {
            f32x4 acc = {0.f, 0.f, 0.f, 0.f};
            acc = mfma16(P.bf[nt], mt ? uf1 : uf0, acc);
            u32x2 wv; wv.x = pk2(acc[0], acc[1]); wv.y = pk2(acc[2], acc[3]);
            *(LAS u32x2*)(Xw + (mt * 16 + fr) * S5XS + nt * 16 + fq * 4) = wv;
        }
    asm volatile("s_waitcnt lgkmcnt(0)" ::: "memory");
}
template <bool WRITE>
__device__ __forceinline__ void s5_recur(LAS bf16_t* xq, int r, float lr_, float li_, float& xr, float& xi) {
#pragma unroll 1
    for (int blk = 0; blk < 4; ++blk) {
        LAS bf16_t* q = xq + (r ? (3 - blk) : blk) * (8 * S5XS);
        unsigned bw[8];
#pragma unroll
        for (int k = 0; k < 8; ++k) bw[k] = *(const LAS unsigned*)(q + k * S5XS);
        if (r == 0) {
#pragma unroll
            for (int s = 0; s < 8; ++s) {
                const float nr = fmaf(lr_, xr, fmaf(-li_, xi, bflo(bw[s]))), ni = fmaf(lr_, xi, fmaf(li_, xr, bfhi(bw[s])));
                xr = nr; xi = ni;
                if (WRITE) *(LAS unsigned*)(q + s * S5XS) = pk2(xr, xi);
            }
        } else {
#pragma unroll
            for (int s = 7; s >= 0; --s) {
                const float nr = fmaf(lr_, xr, fmaf(-li_, xi, bflo(bw[s]))), ni = fmaf(lr_, xi, fmaf(li_, xr, bfhi(bw[s])));
                xr = nr; xi = ni;
                if (WRITE) *(LAS unsigned*)(q + s * S5XS) = pk2(xr, xi);
            }
        }
    }
    if (WRITE) asm volatile("s_waitcnt lgkmcnt(0)" ::: "memory");
}
__device__ __forceinline__ void s5_ufrag(const bf16_t* __restrict__ proj, int b, int ch, int g, int lane, bf16x8& uf0, bf16x8& uf1) {
    const int fr = lane & 15, fq = lane >> 4;
    uf0 = (bf16x8){0, 0, 0, 0, 0, 0, 0, 0}; uf1 = uf0;
    if (fq < 2) { const bf16_t* up = proj + (size_t)(b * SEQ + ch * S5T + fr) * DIN + 1024 + g * 16 + fq * 8; uf0 = *(const bf16x8*)up; uf1 = *(const bf16x8*)(up + (size_t)16 * DIN); }
}

__device__ __forceinline__ void s5e_item(int item, const bf16_t* __restrict__ proj, const float* __restrict__ tab  , const bf16_t* __restrict__ BT,
                                         float* __restrict__ E, LAS unsigned char* lds, int tid) {
    const int ch = item & (S5NCH - 1), b = item / S5NCH;
    const int lane = tid & 63, w = tid >> 6;
    LAS bf16_t* Xw = (LAS bf16_t*)lds + w * (32 * S5XS);
    S5Pass cur;
    s5_fetch(cur, tab, BT, w, 0, lane);
    bf16x8 uf0, uf1;
    s5_ufrag(proj, b, ch, w, lane, uf0, uf1);
#pragma unroll 1
    for (int ps = 0; ps < 4; ++ps) {
        const int g = w + 8 * (ps >> 1), r = ps & 1;
        const float lr_ = cur.t0[0], li_ = cur.t0[1];
        s5_bu(Xw, cur, uf0, uf1, lane);
        if (ps < 3) s5_fetch(cur, tab, BT, w + 8 * ((ps + 1) >> 1), (ps + 1) & 1, lane);
        if (ps == 1) s5_ufrag(proj, b, ch, w + 8, lane, uf0, uf1);
        float xr = 0.f, xi = 0.f;
        s5_recur<false>(Xw + lane * 2, r, lr_, li_, xr, xi);
        float2 ev; ev.x = xr; ev.y = xi;
        ((float2*)E)[(size_t)(((b * S5NCH + ch) * 16 + g) * 2 + r) * 64 + lane] = ev;
        asm volatile("s_waitcnt lgkmcnt(0)" ::: "memory");
    }
    __syncthreads();
}
__device__ __forceinline__ void s5out_item(int item, const bf16_t* __restrict__ proj, const float* __restrict__ tab, const bf16_t* __restrict__ BT,
                                           const bf16_t* __restrict__ CT  , const float* __restrict__ dvec, const bf16_t* __restrict__ wgluT, const float* __restrict__ bglu,
                                           const float* __restrict__ CIN, bf16_t* __restrict__ mix, LAS unsigned char* lds, int tid) {
    const int ch = item & (S5NCH - 1), b = item / S5NCH;
    constexpr int YS = 264;
    const int lane = tid & 63, w = tid >> 6, fr = lane & 15, fq = lane >> 4;
    LAS bf16_t* Xw = (LAS bf16_t*)lds + w * (32 * S5XS);
    LAS bf16_t* Y = (LAS bf16_t*)(lds + 8 * 32 * S5XS * 2);
    S5Pass cur; bf16x8 ccf[4]; float2 ccin;
    s5_fetch(cur, tab, BT, w, 0, lane);
    ccin = ((const float2*)CIN)[(size_t)(((b * S5NCH + ch) * 16 + w) * 2 + 0) * 64 + lane];
#pragma unroll
    for (int ks = 0; ks < 4; ++ks) ccf[ks] = *(const bf16x8*)(CT + (size_t)(w * 16 + fr) * 256 + ks * 32 + fq * 8);
    bf16x8 uf0, uf1;
    s5_ufrag(proj, b, ch, w, lane, uf0, uf1);
    f32x4 ya0 = {0.f, 0.f, 0.f, 0.f}, ya1 = ya0;
#pragma unroll 1
    for (int ps = 0; ps < 4; ++ps) {
        const int g = w + 8 * (ps >> 1), r = ps & 1;
        const int gn = w + 8 * ((ps + 1) >> 1), rn = (ps + 1) & 1;
        const float lr_ = cur.t0[0], li_ = cur.t0[1];
        s5_bu(Xw, cur, uf0, uf1, lane);
        if (ps < 3) s5_fetch(cur, tab, BT, gn, rn, lane);
        if (ps == 1) s5_ufrag(proj, b, ch, w + 8, lane, uf0, uf1);
        float xr = ccin.x, xi = ccin.y;
        s5_recur<true>(Xw + lane * 2, r, lr_, li_, xr, xi);
        if (ps < 3) ccin = ((const float2*)CIN)[(size_t)(((b * S5NCH + ch) * 16 + gn) * 2 + rn) * 64 + lane];
#pragma unroll
        for (int ks = 0; ks < 4; ++ks) {
            ya0 = mfma16(ccf[ks], *(const LAS bf16x8*)(Xw + fr * S5XS + ks * 32 + fq * 8), ya0);
            ya1 = mfma16(ccf[ks], *(const LAS bf16x8*)(Xw + (16 + fr) * S5XS + ks * 32 + fq * 8), ya1);
        }
        if (ps < 3) {
#pragma unroll
            for (int ks = 0; ks < 4; ++ks) ccf[ks] = *(const bf16x8*)(CT + (size_t)(gn * 16 + fr) * 256 + rn * 128 + ks * 32 + fq * 8);
        }
        if (r == 1) {
            const int chn = g * 16 + fq * 4;
            const f32x4 dv = *(const f32x4*)(dvec + chn);
#pragma unroll
            for (int mt = 0; mt < 2; ++mt) {
                const int s = mt * 16 + fr;
                const u32x2 uw = *(const u32x2*)(proj + (size_t)(b * SEQ + ch * S5T + s) * DIN + 1024 + chn);
                const float uu[4] = {bflo(uw.x), bfhi(uw.x), bflo(uw.y), bfhi(uw.y)};
                float gl4[4];
#pragma unroll
                for (int jj = 0; jj < 4; ++jj) {
                    const float yv = (mt ? ya1[jj] : ya0[jj]) + dv[jj] * uu[jj];
                    const float t = 0.7978845608028654f * (yv + 0.044715f * yv * yv * yv);
                    gl4[jj] = yv * (1.f - __builtin_amdgcn_rcpf(1.f + __expf(2.f * t)));
                }
                u32x2 yw; yw.x = pk2(gl4[0], gl4[1]); yw.y = pk2(gl4[2], gl4[3]);
                *(LAS u32x2*)(Y + s * YS + chn) = yw;
            }
            ya0 = (f32x4){0.f, 0.f, 0.f, 0.f}; ya1 = ya0;
        }
        asm volatile("s_waitcnt lgkmcnt(0)" ::: "memory");
    }
    __syncthreads();
    {
        const int mt = w & 1;
        bf16x8 yf[8];
#pragma unroll
        for (int ks = 0; ks < 8; ++ks) yf[ks] = *(const LAS bf16x8*)(Y + (mt * 16 + fr) * YS + ks * 32 + fq * 8);
        const int s = mt * 16 + fr;
        bf16_t* orow = mix + (size_t)(b * SEQ + ch * S5T + s) * DM + 256;
#pragma unroll 2
        for (int i = 0; i < 4; ++i) {
            const int nt = (w >> 1) * 4 + i;
            const bf16_t* ap = wgluT + (size_t)(nt * 16 + fr) * 256 + fq * 8;
            f32x4 acc = {0.f, 0.f, 0.f, 0.f};
#pragma unroll
            for (int ks = 0; ks < 8; ++ks) acc = mfma16(*(const bf16x8*)(ap + ks * 32), yf[ks], acc);
            const int n0 = nt * 16 + fq * 4;
            const f32x4 bg = *(const f32x4*)(bglu + n0);
            const u32x2 yw = *(const LAS u32x2*)(Y + s * YS + n0);
            const float yv[4] = {bflo(yw.x), bfhi(yw.x), bflo(yw.y), bfhi(yw.y)};
            float ov[4];
#pragma unroll
            for (int jj = 0; jj < 4; ++jj) ov[jj] = yv[jj] * __builtin_amdgcn_rcpf(1.f + __expf(-(acc[jj] + bg[jj])));
            u32x2 ow; ow.x = pk2(ov[0], ov[1]); ow.y = pk2(ov[2], ov[3]);
            *(u32x2*)(orow + n0) = ow;
        }
    }
    __syncthreads();
}

__device__ __forceinline__ void phase_scan(const Args& a, int l, int tid) {
    unsigned char* ws = a.ws;
    const int lane = tid & 63, wave = tid >> 6;
    {
        const float* tab = (const float*)(ws + WS_S5TAB) + (size_t)l * 2048 * 8;
        const float2* __restrict__ E = (const float2*)(ws + WS_S5E); float2* __restrict__ C = (float2*)(ws + WS_S5C);
        for (int wv = blockIdx.x; wv < 128; wv += gridDim.x) if (wave == 0) {
            const int p = lane, r = wv & 1, g = (wv >> 1) & 15, b = wv >> 5;
            const float* tp = tab + (size_t)((r * 16 + g) * 64 + p) * 8;
            const float tr = tp[4], ti = tp[5];
            float xr = 0.f, xi = 0.f;
            for (int k0 = 0; k0 < S5NCH; k0 += 32) {
                float2 e[32];
#pragma unroll
                for (int k = 0; k < 32; ++k) { const int ch = r ? (S5NCH - 1 - (k0 + k)) : (k0 + k); e[k] = E[(size_t)(((b * S5NCH + ch) * 16 + g) * 2 + r) * 64 + p]; }
#pragma unroll
                for (int k = 0; k < 32; ++k) { const int ch = r ? (S5NCH - 1 - (k0 + k)) : (k0 + k);
                    float2 cv; cv.x = xr; cv.y = xi; C[(size_t)(((b * S5NCH + ch) * 16 + g) * 2 + r) * 64 + p] = cv;
                    const float nr = fmaf(tr, xr, fmaf(-ti, xi, e[k].x)), ni = fmaf(tr, xi, fmaf(ti, xr, e[k].y));
                    xr = nr; xi = ni; }
            }
        }
    }
    {
        const float* theta = a.in[4] + l * 8;
        const float* __restrict__ kvf = (const float*)(ws + WS_KVF); const float* __restrict__ kvb = (const float*)(ws + WS_KVB);
        float* __restrict__ stf = (float*)(ws + WS_STF); float* __restrict__ stb = (float*)(ws + WS_STB);
        for (int gid = blockIdx.x * NTHR + tid; gid < 131072; gid += gridDim.x * NTHR) {
            const int el = gid & 4095, dir = (gid >> 12) & 1, h = (gid >> 13) & 3, b = gid >> 15;
            const float dec = __expf(log_sigmoid(theta[dir * 4 + h]) * 128.f);
            const float* __restrict__ kv = dir ? kvb : kvf; float* __restrict__ st = dir ? stb : stf;
            float s = 0.f;
            for (int c0 = 0; c0 < 32; c0 += 16) {
                float kk[16];
#pragma unroll
                for (int k = 0; k < 16; ++k) { const int c = dir ? (31 - (c0 + k)) : (c0 + k); kk[k] = kv[(size_t)((b * 32 + c) * 4 + h) * 4096 + el]; }
#pragma unroll
                for (int k = 0; k < 16; ++k) { const int c = dir ? (31 - (c0 + k)) : (c0 + k); st[(size_t)((b * 32 + c) * 4 + h) * 4096 + el] = s; s = fmaf(dec, s, kk[k]); }
            }
        }
    }
}

__device__ __forceinline__ float router_softmax(const float (&sp)[16], int lane) {
    const bool b5 = (lane & 32) != 0, b4 = (lane & 16) != 0, b3 = (lane & 8) != 0, b2 = (lane & 4) != 0;
    float t8[8], t4[4], t2[2];
#pragma unroll
    for (int i = 0; i < 8; ++i) { const float snd = b5 ? sp[i] : sp[i + 8], kp = b5 ? sp[i + 8] : sp[i]; t8[i] = kp + __shfl_xor(snd, 32); }
#pragma unroll
    for (int i = 0; i < 4; ++i) { const float snd = b4 ? t8[i] : t8[i + 4], kp = b4 ? t8[i + 4] : t8[i]; t4[i] = kp + __shfl_xor(snd, 16); }
#pragma unroll
    for (int i = 0; i < 2; ++i) { const float snd = b3 ? t4[i] : t4[i + 2], kp = b3 ? t4[i + 2] : t4[i]; t2[i] = kp + __shfl_xor(snd, 8); }
    float lgt; { const float snd = b2 ? t2[0] : t2[1], kp = b2 ? t2[1] : t2[0]; lgt = kp + __shfl_xor(snd, 4); }
    lgt += __shfl_xor(lgt, 1); lgt += __shfl_xor(lgt, 2);
    float mx = lgt;
#pragma unroll
    for (int o = 4; o < 64; o <<= 1) mx = fmaxf(mx, __shfl_xor(mx, o));
    const float ex = expf(lgt - mx);
    float sum = ex;
#pragma unroll
    for (int o = 4; o < 64; o <<= 1) sum += __shfl_xor(sum, o);
    return ex / sum;
}
__device__ __forceinline__ void phase_ln1_router(const Args& a, int l, LAS unsigned char* lds, int tid) {
    unsigned char* ws = a.ws;
    const int lane = tid & 63, wave = tid >> 6;
    LAS float* rwT = (LAS float*)lds;
    const float* rw = a.in[19] + (size_t)l * DM * NE;
    for (int i = tid; i < DM * NE; i += NTHR) rwT[(i & 15) * DM + (i >> 4)] = rw[i];
    __syncthreads();
    const float* pre = (const float*)(ws + WS_RA);
    float* afft = (float*)(ws + WS_AFFT);
    const int gw = blockIdx.x * NWAVES + wave, NGW = gridDim.x * NWAVES;
    for (int m = gw; m < MTOK; m += 2 * NGW) {
        const int m1 = m + NGW; const bool has1 = m1 < MTOK; const int mb = has1 ? m1 : m;
        f32x4 v0[4], v1[4];
#pragma unroll
        for (int j = 0; j < 4; ++j) { v0[j] = ((const f32x4*)(pre + (size_t)m * DM))[lane + 64 * j]; v1[j] = ((const f32x4*)(pre + (size_t)mb * DM))[lane + 64 * j]; }
        ln_rows4(v0, a.in[17] + l * DM, a.in[18] + l * DM, lane);
        ln_rows4(v1, a.in[17] + l * DM, a.in[18] + l * DM, lane);
        store_row(v0, nullptr, (bf16_t*)(ws + WS_HBF) + (size_t)m * DM, lane);
        if (has1) store_row(v1, nullptr, (bf16_t*)(ws + WS_HBF) + (size_t)m1 * DM, lane);
        float sp0[16], sp1[16];
#pragma unroll
        for (int eg = 0; eg < 4; ++eg) {
#pragma unroll
            for (int ee = 0; ee < 4; ++ee) { const int e = eg * 4 + ee; float s0 = 0.f, s1 = 0.f;
#pragma unroll
                for (int j = 0; j < 4; ++j) { const f32x4 wv = *(const LAS f32x4*)(rwT + e * DM + 256 * j + 4 * lane);
                    s0 += (v0[j][0] * wv[0] + v0[j][1] * wv[1]) + (v0[j][2] * wv[2] + v0[j][3] * wv[3]);
                    s1 += (v1[j][0] * wv[0] + v1[j][1] * wv[1]) + (v1[j][2] * wv[2] + v1[j][3] * wv[3]); }
                sp0[e] = s0; sp1[e] = s1; }
            asm volatile("" ::: "memory");
        }
        const float af0 = router_softmax(sp0, lane), af1 = router_softmax(sp1, lane);
        if ((lane & 3) == 0) {
            afft[(size_t)((m / SEQ) * NE + (lane >> 2)) * SEQ + (m % SEQ)] = af0;
            if (has1) afft[(size_t)((m1 / SEQ) * NE + (lane >> 2)) * SEQ + (m1 % SEQ)] = af1;
        }
    }
    __syncthreads();
}

__device__ __forceinline__ void select_item(int item, const Args& a, LAS unsigned char* lds, int tid) {
    unsigned char* ws = a.ws;
    const int q = item & 3, e = (item >> 2) & 15, b = item >> 6;
    const int lane = tid & 63, wave = tid >> 6;
    LAS unsigned* red = (LAS unsigned*)lds;
    LAS int* sel = (LAS int*)(lds + 1024);
    const float* av = (const float*)(ws + WS_AFFT) + (size_t)(b * NE + e) * SEQ + tid * 8;
    const f32x4 va = *(const f32x4*)av, vb = *(const f32x4*)(av + 4);
    unsigned v[8] = {__float_as_uint(va[0]), __float_as_uint(va[1]), __float_as_uint(va[2]), __float_as_uint(va[3]), __float_as_uint(vb[0]), __float_as_uint(vb[1]), __float_as_uint(vb[2]), __float_as_uint(vb[3])};
    unsigned x = 0u;
    for (int bit = 30; bit >= 0; --bit) {
        const unsigned cand = x | (1u << bit);
        unsigned cnt = 0u;
#pragma unroll
        for (int j = 0; j < 8; ++j) cnt += (unsigned)__popcll(__ballot(v[j] >= cand));
        LAS unsigned* rb = red + (bit & 1) * 8;
        if (lane == 0) rb[wave] = cnt;
        __syncthreads();
        unsigned tot = 0u;
#pragma unroll
        for (int k = 0; k < 8; ++k) tot += rb[k];
        if (tot >= (unsigned)CAP) x = cand;
    }
    unsigned mycnt = 0u;
#pragma unroll
    for (int j = 0; j < 8; ++j) mycnt += (v[j] > x ? 1u : 0u) + (v[j] == x ? 0x10000u : 0u);
    unsigned inc = mycnt;
#pragma unroll
    for (int o = 1; o < 64; o <<= 1) { const unsigned t = __shfl_up(inc, o); if (lane >= o) inc += t; }
    LAS unsigned* wsum = red + 64;
    __syncthreads();
    if (lane == 63) wsum[wave] = inc;
    __syncthreads();
    unsigned wpre = 0u, total = 0u;
#pragma unroll
    for (int k = 0; k < 8; ++k) { const unsigned t = wsum[k]; if (k < wave) wpre += t; total += t; }
    const unsigned excl = wpre + inc - mycnt;
    unsigned gtb = excl & 0xffffu, eqb = excl >> 16;
    const unsigned need = (unsigned)CAP - (total & 0xffffu);
    const int rowbase = (e * NB + b) * CAP;
    int* idx = (int*)(ws + WS_IDX); float* gate = (float*)(ws + WS_GATE); int* slotmap = (int*)(ws + WS_SLOT);
    const bool own_tok = ((tid >> 7) == q);
#pragma unroll
    for (int j = 0; j < 8; ++j) {
        const bool isgt = v[j] > x, iseq = v[j] == x;
        const bool issel = isgt || (iseq && eqb < need);
        const unsigned slot = gtb + (eqb < need ? eqb : need);
        const int tok = b * SEQ + tid * 8 + j;
        if (issel && (int)(slot >> 7) == q) { idx[rowbase + slot] = tok; gate[rowbase + slot] = __uint_as_float(v[j]); }
        if (own_tok) slotmap[(size_t)tok * NE + e] = issel ? (int)(rowbase + slot) : -1;
        gtb += isgt ? 1u : 0u; eqb += iseq ? 1u : 0u;
    }
    __syncthreads();
}

__device__ __forceinline__ void phase_ln2(const Args& a, int l, int tid) {
    unsigned char* ws = a.ws;
    const int lane = tid & 63, wave = tid >> 6;
    const int gw = blockIdx.x * NWAVES + wave, NGW = gridDim.x * NWAVES;
    const bf16_t* hbf = (const bf16_t*)(ws + WS_HBF); const int* slotmap = (const int*)(ws + WS_SLOT); const bf16_t* contrib = (const bf16_t*)(ws + WS_RB);
    const bool last = (l == 1);
    u32x2 vn[4]; int slot_n = -1;
    if (gw < MTOK) {
#pragma unroll
        for (int j = 0; j < 4; ++j) vn[j] = ((const u32x2*)(hbf + (size_t)gw * DM))[lane + 64 * j];
        slot_n = slotmap[(size_t)gw * NE + (lane & 15)];
    }
    for (int m = gw; m < MTOK; m += NGW) {
        f32x4 v[4];
#pragma unroll
        for (int j = 0; j < 4; ++j) { v[j][0] = bflo(vn[j].x) * ALPHA; v[j][1] = bfhi(vn[j].x) * ALPHA; v[j][2] = bflo(vn[j].y) * ALPHA; v[j][3] = bfhi(vn[j].y) * ALPHA; }
        const int myslot = slot_n;
        unsigned bal = (unsigned)(__ballot(myslot >= 0) & 0xffffull);
        int r0 = -1, r1 = -1, r2 = -1, r3 = -1;
        if (bal) { r0 = __shfl(myslot, __builtin_ctz(bal)); bal &= bal - 1; }
        if (bal) { r1 = __shfl(myslot, __builtin_ctz(bal)); bal &= bal - 1; }
        if (bal) { r2 = __shfl(myslot, __builtin_ctz(bal)); bal &= bal - 1; }
        if (bal) { r3 = __shfl(myslot, __builtin_ctz(bal)); bal &= bal - 1; }
        u32x2 c0[4], c1[4], c2[4], c3[4];
#pragma unroll
        for (int j = 0; j < 4; ++j) { c0[j] = (u32x2){0u, 0u}; c1[j] = c0[j]; c2[j] = c0[j]; c3[j] = c0[j]; }
        if (r0 >= 0) {
#pragma unroll
            for (int j = 0; j < 4; ++j) c0[j] = ((const u32x2*)(contrib + (size_t)r0 * DM))[lane + 64 * j]; }
        if (r1 >= 0) {
#pragma unroll
            for (int j = 0; j < 4; ++j) c1[j] = ((const u32x2*)(contrib + (size_t)r1 * DM))[lane + 64 * j]; }
        if (r2 >= 0) {
#pragma unroll
            for (int j = 0; j < 4; ++j) c2[j] = ((const u32x2*)(contrib + (size_t)r2 * DM))[lane + 64 * j]; }
        if (r3 >= 0) {
#pragma unroll
            for (int j = 0; j < 4; ++j) c3[j] = ((const u32x2*)(contrib + (size_t)r3 * DM))[lane + 64 * j]; }
        if (m + NGW < MTOK) {
#pragma unroll
            for (int j = 0; j < 4; ++j) vn[j] = ((const u32x2*)(hbf + (size_t)(m + NGW) * DM))[lane + 64 * j];
            slot_n = slotmap[(size_t)(m + NGW) * NE + (lane & 15)];
        }
#pragma unroll
        for (int j = 0; j < 4; ++j) {
            v[j][0] += bflo(c0[j].x); v[j][1] += bfhi(c0[j].x); v[j][2] += bflo(c0[j].y); v[j][3] += bfhi(c0[j].y);
            v[j][0] += bflo(c1[j].x); v[j][1] += bfhi(c1[j].x); v[j][2] += bflo(c1[j].y); v[j][3] += bfhi(c1[j].y);
            v[j][0] += bflo(c2[j].x); v[j][1] += bfhi(c2[j].x); v[j][2] += bflo(c2[j].y); v[j][3] += bfhi(c2[j].y);
            v[j][0] += bflo(c3[j].x); v[j][1] += bfhi(c3[j].x); v[j][2] += bflo(c3[j].y); v[j][3] += bfhi(c3[j].y);
        }
        while (bal) {
            const int row = __shfl(myslot, __builtin_ctz(bal)); bal &= bal - 1;
            const u32x2* cr = (const u32x2*)(contrib + (size_t)row * DM);
#pragma unroll
            for (int j = 0; j < 4; ++j) { const u32x2 wv = cr[lane + 64 * j]; v[j][0] += bflo(wv.x); v[j][1] += bfhi(wv.x); v[j][2] += bflo(wv.y); v[j][3] += bfhi(wv.y); }
        }
        ln_rows4(v, a.in[23] + l * DM, a.in[24] + l * DM, lane);
        if (last) store_row(v, a.out + (size_t)m * DM, nullptr, lane);
        else store_row(v, nullptr, (bf16_t*)(ws + WS_HBF) + (size_t)m * DM, lane);
    }
}

typedef __attribute__((address_space(1))) unsigned gu32;
#define RLX_AGENT __ATOMIC_RELAXED, __HIP_MEMORY_SCOPE_AGENT
#define XB_TMO      128
#define XB_XCNT(j)  (256  + 64 * (j))
#define XB_XSUB(j)  (1280 + 64 * (j))
#define XB_XGEN(j)  (2304 + 64 * (j))
#define XB_TOP      3328
#define XB_TOPGEN   3392
#define XCD_BAR_WORDS 3456
#define XB_SPIN_CAP (1u << 18)

__device__ __forceinline__ unsigned xb_ld(unsigned* p)              { return __hip_atomic_load(p, __ATOMIC_RELAXED, __HIP_MEMORY_SCOPE_AGENT); }
__device__ __forceinline__ unsigned xb_add(unsigned* p, unsigned v) { return __hip_atomic_fetch_add(p, v, __ATOMIC_RELAXED, __HIP_MEMORY_SCOPE_AGENT); }
__device__ __forceinline__ unsigned xb_xcc_id() { return (unsigned)__builtin_amdgcn_s_getreg((3 << 11) | 20) & 0xFu; }
#define XB_SPIN(cond, bar) do { unsigned _sp = 0; while (cond) { __builtin_amdgcn_s_sleep(1); \
    if ((++_sp & 255u) == 0u) { if (xb_ld(&(bar)[XB_TMO])) break; if (_sp > XB_SPIN_CAP) { atomicAdd(&(bar)[XB_TMO], 1u); break; } } } } while (0)

struct XcdBarrier {
    unsigned* bar; unsigned x;
    volatile LAS unsigned* st;
};

__device__ __forceinline__ XcdBarrier xcd_barrier_post(unsigned* bar, volatile LAS unsigned* st) {
    XcdBarrier b; b.bar = bar; b.x = xb_xcc_id(); b.st = st;
    if (threadIdx.x == 0) (void)xb_add(&bar[XB_XCNT(b.x)], 1u);
    return b;
}
__device__ __forceinline__ void xcd_barrier_complete(unsigned* bar, unsigned x, unsigned& nloc, unsigned& nx) {
    const unsigned G = gridDim.x * gridDim.y * gridDim.z;
    unsigned sum, cnt, mine, sp = 0u;
    for (;;) {
        sum = 0u; cnt = 0u; mine = 0u;
#pragma unroll
        for (unsigned j = 0; j < 16; ++j) { const unsigned c = xb_ld(&bar[XB_XCNT(j)]); sum += c; cnt += (c > 0u) ? 1u : 0u; mine = (j == x) ? c : mine; }
        if (sum == G) break;
        __builtin_amdgcn_s_sleep(1);
        if ((++sp & 255u) == 0u) { if (xb_ld(&bar[XB_TMO])) break; if (sp > XB_SPIN_CAP) { atomicAdd(&bar[XB_TMO], 1u); break; } }
    }
    nloc = mine > 0u ? mine : 1u; nx = cnt > 0u ? cnt : 1u;
}

__device__ __forceinline__ void xcd_barrier(const XcdBarrier& b) {
    asm volatile("s_waitcnt vmcnt(0)" ::: "memory");
    __syncthreads();
    if (threadIdx.x == 0) {
        unsigned* bar = b.bar;
        __builtin_amdgcn_s_waitcnt(0);
        unsigned nloc = b.st[0], nx = b.st[1];
        if (nloc == 0u) { xcd_barrier_complete(bar, b.x, nloc, nx); b.st[0] = nloc; b.st[1] = nx; }
        const unsigned old = xb_add(&bar[XB_XSUB(b.x)], 1u);
        const unsigned gen = old / nloc;
        if (old + 1u == (gen + 1u) * nloc) {
            __builtin_amdgcn_fence(__ATOMIC_RELEASE, "agent");
            asm volatile("s_waitcnt vmcnt(0)" ::: "memory");
            const unsigned og = xb_add(&bar[XB_TOP], 1u);
            const unsigned tg = og / nx;
            if (og + 1u == (tg + 1u) * nx) xb_add(&bar[XB_TOPGEN], 1u);
            else XB_SPIN(xb_ld(&bar[XB_TOPGEN]) == tg, bar);
            __builtin_amdgcn_fence(__ATOMIC_ACQUIRE, "agent");
            xb_add(&bar[XB_XGEN(b.x)], 1u);
            asm volatile("s_waitcnt vmcnt(0)" ::: "memory");
        } else {
            XB_SPIN(xb_ld(&bar[XB_XGEN(b.x)]) == gen, bar);
            __builtin_amdgcn_fence(__ATOMIC_ACQUIRE, "agent");
            asm volatile("s_waitcnt vmcnt(0)" ::: "memory");
        }
    }
    __syncthreads();
}

constexpr int NPHASES = 21;
#ifndef REP_MASK
#define REP_MASK 0
#endif
template <int L, int K>
__device__ __forceinline__ void run_phase(const Args& a, LAS unsigned char* lds, int tid) {
    unsigned char* ws = a.ws;
    constexpr int l = L;
    bf16_t* proj = (bf16_t*)(ws + WS_RA); bf16_t* mix = (bf16_t*)(ws + WS_RB);
    if constexpr (K == 0) {
        pg8::Gemm g{(const bf16_t*)(ws + WS_HBF), (const bf16_t*)(ws + WS_WIN) + (size_t)l * DIN * DM, MTOK, DIN, DM};
        pg8::StaticOrder S; S.init(MTOK, DIN, (int)gridDim.x, (int)blockIdx.x);
        pg8::EpiStoreBf16 E{proj, DIN};
        pg8::gemm_phase<pg8::EpiStoreBf16, pg8::StaticOrder, true, true>(lds, g, S, E);
    } else if constexpr (K == 1) {
        const float* tab = (const float*)(ws + WS_S5TAB) + (size_t)l * 2048 * 8;
        constexpr int XB = ((REP_MASK >> 11) & 1) ? 512 : ((REP_MASK >> 12) & 1) ? 256 : ((REP_MASK >> 13) & 1) ? 512 : 0, XOFF = ((REP_MASK >> 11) & 1) ? 0 : ((REP_MASK >> 12) & 1) ? 512 : 768;
        for (int it0 = blockIdx.x; it0 < 1280 + XB; it0 += gridDim.x) {
            const int it = it0 < 1280 ? it0 : it0 - 1280 + XOFF;
            if (it < 512) s5e_item(it, proj, tab, (const bf16_t*)(ws + WS_S5BT) + (size_t)l * 4096 * 32, (float*)(ws + WS_S5E), lds, tid);
            else if (it < 768) attn_item(it - 512, proj, mix, a.in[15] + l * 8, lds, tid);
            else retkv_item(it - 768, proj, (float*)(ws + WS_KVF), (float*)(ws + WS_KVB), a.in[4] + l * 8, lds, tid);
        }
    } else if constexpr (K == 2) {
        phase_scan(a, l, tid);
    } else if constexpr (K == 3) {
        const float* tab = (const float*)(ws + WS_S5TAB) + (size_t)l * 2048 * 8;
        constexpr int XD = ((REP_MASK >> 14) & 3) ? 512 : 0, XOFD = ((REP_MASK >> 14) & 1) ? 0 : 512;
        for (int it0 = blockIdx.x; it0 < 1024 + XD; it0 += gridDim.x) {
            const int it = it0 < 1024 ? it0 : it0 - 1024 + XOFD;
            if (it < 512) s5out_item(it, proj, tab, (const bf16_t*)(ws + WS_S5BT) + (size_t)l * 4096 * 32, (const bf16_t*)(ws + WS_S5CT) + (size_t)l * 65536, a.in[12] + l * 256,
                                     (const bf16_t*)(ws + WS_WGLU) + (size_t)l * 65536, a.in[14] + l * 256, (const float*)(ws + WS_S5C), mix, lds, tid);
            else retout_item(it - 512, proj, (const float*)(ws + WS_STF), (const float*)(ws + WS_STB), mix, a.in[4] + l * 8, lds, tid);
        }
    } else if constexpr (K == 4) {
        pg8::Gemm g{mix, (const bf16_t*)(ws + WS_WOUT) + (size_t)l * DM * DM, MTOK, DM, DM};
        pg8::StaticOrder S; S.init(MTOK, DM, (int)gridDim.x, (int)blockIdx.x);
        pg8::EpiResF32 E{(const bf16_t*)(ws + WS_HBF), (float*)(ws + WS_RA), DM, ALPHA};
        pg8::gemm_phase<pg8::EpiResF32, pg8::StaticOrder, true, true>(lds, g, S, E);
    } else if constexpr (K == 5) {
        phase_ln1_router(a, l, lds, tid);
    } else if constexpr (K == 6) {
        for (int it = blockIdx.x; it < 256; it += gridDim.x) select_item(it, a, lds, tid);
    } else if constexpr (K == 7) {
        pg8::Gemm g{(const bf16_t*)(ws + WS_HBF), (const bf16_t*)(ws + WS_WGU) + (size_t)l * NE * 2 * FF * DM, NROWX, NE * 2 * FF, DM};
        pg8::GroupedOrder S; S.init(16, (int)gridDim.x, (int)blockIdx.x);
        pg8::EpiSwiGLU E{(bf16_t*)(ws + WS_HDN), FF, 16};
        pg8::gemm_phase<pg8::EpiSwiGLU, pg8::GroupedOrder, true, true, true>(lds, g, S, E, (const int*)(ws + WS_IDX));
    } else if constexpr (K == 8) {
        pg8::Gemm g{(const bf16_t*)(ws + WS_HDN), (const bf16_t*)(ws + WS_WD) + (size_t)l * NE * DM * FF, NROWX, NE * DM, FF};
        pg8::GroupedOrder S; S.init(4, (int)gridDim.x, (int)blockIdx.x);
        pg8::EpiScaleRow E{(bf16_t*)(ws + WS_RB), DM, 4, (const float*)(ws + WS_GATE)};
        pg8::gemm_phase<pg8::EpiScaleRow, pg8::GroupedOrder, true, true, false, true>(lds, g, S, E);
    } else {
        phase_ln2(a, l, tid);
    }
}
__global__ void __launch_bounds__(NTHR, 2) fwd_kernel(Args a) {
    extern __shared__ __attribute__((aligned(16))) unsigned char lds_raw[];
    LAS unsigned char* lds = (LAS unsigned char*)lds_raw;
    cg::grid_group grid = cg::this_grid();
    const int lo = a.ph_lo, hi = a.ph_hi;
    volatile LAS unsigned* bst = (volatile LAS unsigned*)(lds + LDS_BYTES - 64);
    if (threadIdx.x < 16) bst[threadIdx.x] = 0u;
    __syncthreads();
    XcdBarrier bar = xcd_barrier_post((unsigned*)(a.ws + WS_BAR), bst);
    if (hi > 1000) grid.sync();
#define PH_BEGIN(ph) if (lo <= (ph) && (ph) < hi) { int tid = threadIdx.x; asm volatile("" : "+v"(tid));
#define PH_END(ph) if ((ph) + 1 < hi) xcd_barrier(bar); }
    PH_BEGIN(0) for (int rep = 0; rep <= ((REP_MASK >> 10) & 1); ++rep) phase_p0(a, lds, tid); PH_END(0)
#define LAYER(L) \
    PH_BEGIN(1 + 10 * L + 0) for (int rep = 0; rep <= ((REP_MASK >> 0) & 1); ++rep) run_phase<L, 0>(a, lds, tid); PH_END(1 + 10 * L + 0) \
    PH_BEGIN(1 + 10 * L + 1) for (int rep = 0; rep <= ((REP_MASK >> 1) & 1); ++rep) run_phase<L, 1>(a, lds, tid); PH_END(1 + 10 * L + 1) \
    PH_BEGIN(1 + 10 * L + 2) for (int rep = 0; rep <= ((REP_MASK >> 2) & 1); ++rep) run_phase<L, 2>(a, lds, tid); PH_END(1 + 10 * L + 2) \
    PH_BEGIN(1 + 10 * L + 3) for (int rep = 0; rep <= ((REP_MASK >> 3) & 1); ++rep) run_phase<L, 3>(a, lds, tid); PH_END(1 + 10 * L + 3) \
    PH_BEGIN(1 + 10 * L + 4) for (int rep = 0; rep <= ((REP_MASK >> 4) & 1); ++rep) run_phase<L, 4>(a, lds, tid); PH_END(1 + 10 * L + 4) \
    PH_BEGIN(1 + 10 * L + 5) for (int rep = 0; rep <= ((REP_MASK >> 5) & 1); ++rep) run_phase<L, 5>(a, lds, tid); PH_END(1 + 10 * L + 5) \
    PH_BEGIN(1 + 10 * L + 6) for (int rep = 0; rep <= ((REP_MASK >> 6) & 1); ++rep) run_phase<L, 6>(a, lds, tid); PH_END(1 + 10 * L + 6) \
    PH_BEGIN(1 + 10 * L + 7) for (int rep = 0; rep <= ((REP_MASK >> 7) & 1); ++rep) run_phase<L, 7>(a, lds, tid); PH_END(1 + 10 * L + 7) \
    PH_BEGIN(1 + 10 * L + 8) for (int rep = 0; rep <= ((REP_MASK >> 8) & 1); ++rep) run_phase<L, 8>(a, lds, tid); PH_END(1 + 10 * L + 8) \
    PH_BEGIN(1 + 10 * L + 9) for (int rep = 0; rep <= (((REP_MASK >> 9) & 1) && L == 1 ? 1 : 0); ++rep) run_phase<L, 9>(a, lds, tid); PH_END(1 + 10 * L + 9)
    LAYER(0)
    LAYER(1)
#undef LAYER
#undef PH_BEGIN
#undef PH_END
}

#ifndef ONE_LAUNCH
#define ONE_LAUNCH 1
#endif
extern "C" void kernel_launch(void* const* d_in, const int* in_sizes, int n_in, void* d_out, int out_size, void* d_ws, size_t ws_size, hipStream_t stream) {
    static int grid = 0;
    if (grid == 0) {
        if (n_in != 25 || ws_size < WS_END) { fprintf(stderr, "kernel_launch: unexpected problem (n_in %d, ws %zu)\n", n_in, ws_size); grid = -1; return; }
        int dev = 0, cus = 0, per_cu = 0;
        (void)hipGetDevice(&dev);
        (void)hipDeviceGetAttribute(&cus, hipDeviceAttributeMultiprocessorCount, dev);
        if (hipFuncSetAttribute((const void*)fwd_kernel, hipFuncAttributeMaxDynamicSharedMemorySize, LDS_BYTES) != hipSuccess) { fprintf(stderr, "kernel_launch: hipFuncSetAttribute failed\n"); grid = -1; return; }
        if (hipOccupancyMaxActiveBlocksPerMultiprocessor(&per_cu, (const void*)fwd_kernel, NTHR, LDS_BYTES) != hipSuccess || per_cu < 1) { fprintf(stderr, "kernel_launch: occupancy query says %d\n", per_cu); per_cu = 1; }
        (void)hipGetLastError();
        if (cus <= 0) cus = 256;
        grid = cus * per_cu;
    }
    if (grid < 0) return;
    Args a{};
    for (int i = 0; i < 25; ++i) a.in[i] = (const float*)d_in[i];
    a.out = (float*)d_out; a.ws = (unsigned char*)d_ws;
#if ONE_LAUNCH
    if (hipMemsetAsync((char*)d_ws + WS_BAR, 0, 16384, stream) != hipSuccess) { fprintf(stderr, "kernel_launch: memset failed\n"); return; }
    a.ph_lo = 0; a.ph_hi = NPHASES;
    void* args[] = {&a};
    hipError_t e = hipLaunchCooperativeKernel((const void*)fwd_kernel, dim3(grid), dim3(NTHR), args, LDS_BYTES, stream);
    if (e != hipSuccess) fprintf(stderr, "kernel_launch: cooperative launch failed: %s (grid %d)\n", hipGetErrorString(e), grid);
#else
    for (int ph = 0; ph < NPHASES; ++ph) {
        a.ph_lo = ph; a.ph_hi = ph + 1;
        hipLaunchKernelGGL(fwd_kernel, dim3(grid), dim3(NTHR), LDS_BYTES, stream, a);
    }
#endif
}
```

```cpp
#include <hip/hip_runtime.h>
#include <hip/hip_cooperative_groups.h>
#include <cstdio>
#include <cstdint>
namespace cg = cooperative_groups;
namespace pg8 {
#define PG8_LAS __attribute__((address_space(3)))
typedef unsigned short bf16_t;
typedef short bf16x8 __attribute__((ext_vector_type(8)));
typedef float f32x4 __attribute__((ext_vector_type(4)));
typedef unsigned u32x4 __attribute__((ext_vector_type(4)));
constexpr int BM = 256, BK = 64, HALF = 128, HTB = HALF * BK * 2  , STAGE_BYTES = 8 * HTB, NXCD = 8, WGM = 8;

__host__ __device__ __forceinline__ int lds_byte(int r, int c) { const int st = (r >> 4) * 2 + (c >> 5), rr = r & 15, cc = c & 31, ob = rr * 64 + cc * 2; return st * 1024 + (ob ^ (((ob >> 9) & 1) << 5)); }
__host__ __device__ __forceinline__ void stage_rc(int b, int& R, int& C) { const int st = b / 1024, sb = b % 1024, swz = sb ^ (((sb >> 9) & 1) << 5); R = (st >> 1) * 16 + swz / 64; C = (st & 1) * 32 + (swz % 64) / 2; }
__host__ __device__ __forceinline__ int perm32(int rho) { const int n = rho >> 4, i = rho & 15; return 8 * (i >> 2) + 4 * n + (i & 3); }

struct Unit { int pm, pn; };
struct Gemm { const bf16_t* A; const bf16_t* Bt; int M, N, K; };

struct StaticOrder {
    int nM, nN, nwg, G, c;
    __host__ __device__ void init(int M, int N, int G_, int c_) { nM = M / BM; nN = N / BM; nwg = nM * nN; G = G_; c = c_; }
    __host__ __device__ bool next(int i, Unit& u) const {
        const long L = (long)i * G + c; if (L >= nwg) return false;
        int wgid = (int)L; { const int q = nwg / NXCD, r = nwg % NXCD, xcd = wgid % NXCD, off = wgid / NXCD; wgid = (xcd < r ? xcd * (q + 1) : r * (q + 1) + (xcd - r) * q) + off; }
        const int nig = WGM * nN, gid = wgid / nig, fm = gid * WGM, gsz = (nM - fm) < WGM ? (nM - fm) : WGM;
        u.pm = fm + ((wgid % nig) % gsz); u.pn = (wgid % nig) / gsz; return true;
    }
    __device__ __forceinline__ void a_ready(const Unit&) const {}
    __device__ __forceinline__ void done(const Unit&) const {}
};

__device__ __forceinline__ unsigned cvt_pk_bf16(float lo, float hi) { unsigned r; asm volatile("v_cvt_pk_bf16_f32 %0, %1, %2" : "=v"(r) : "v"(lo), "v"(hi)); return r; }
typedef unsigned u32x2 __attribute__((ext_vector_type(2)));

struct GroupedOrder {
    int upe, nNe, nwg, G, c;
    __host__ __device__ void init(int nNe_, int G_, int c_) { nNe = nNe_; upe = 8 * nNe_; nwg = 16 * upe; G = G_; c = c_; }
    __host__ __device__ bool next(int i, Unit& u) const {
        const long L = (long)i * G + c; if (L >= nwg) return false;
        int wgid = (int)L; { const int q = nwg / NXCD, r = nwg % NXCD, xcd = wgid % NXCD, off = wgid / NXCD; wgid = (xcd < r ? xcd * (q + 1) : r * (q + 1) + (xcd - r) * q) + off; }
        const int e = wgid / upe, rr = wgid % upe;
        u.pm = e * 8 + (rr & 7); u.pn = e * nNe + (rr >> 3); return true;
    }
    __device__ __forceinline__ void a_ready(const Unit&) const {}
    __device__ __forceinline__ void done(const Unit&) const {}
};

struct EpiStoreBf16 {
    static constexpr bool PERM = true, AFTER_DRAIN = false;
    bf16_t* O; int ldc;
    __device__ __forceinline__ void operator()(const f32x4 (&acc)[2][2][4][2], const Unit& u, int wr, int wc, int fr, int fq) const {
        const int row0 = u.pm * BM + wr * 64 + fr, col0 = u.pn * BM + wc * 32 + 8 * fq;
#pragma unroll
        for (int ai = 0; ai < 2; ++ai)
#pragma unroll
            for (int m = 0; m < 4; ++m) { bf16_t* rowp = O + (size_t)(row0 + ai * HALF + m * 16) * ldc + col0;
#pragma unroll
                for (int bj = 0; bj < 2; ++bj) { const f32x4 v0 = acc[ai][bj][m][0], v1 = acc[ai][bj][m][1];
                    u32x4 w; w.x = cvt_pk_bf16(v0[0], v0[1]); w.y = cvt_pk_bf16(v0[2], v0[3]); w.z = cvt_pk_bf16(v1[0], v1[1]); w.w = cvt_pk_bf16(v1[2], v1[3]);
                    *(u32x4*)(rowp + bj * HALF) = w; } }
    }
};
struct EpiResF32 {
    static constexpr bool PERM = false, AFTER_DRAIN = false;
    const bf16_t* base; float* O; int ldc; float alpha;
    __device__ __forceinline__ void operator()(const f32x4 (&acc)[2][2][4][2], const Unit& u, int wr, int wc, int fr, int fq) const {
        const int row0 = u.pm * BM + wr * 64 + fr, col0 = u.pn * BM + wc * 32 + 4 * fq;
#pragma unroll
        for (int ai = 0; ai < 2; ++ai)
#pragma unroll
            for (int m = 0; m < 4; ++m) { const size_t ro = (size_t)(row0 + ai * HALF + m * 16) * ldc + col0;
#pragma unroll
                for (int bj = 0; bj < 2; ++bj)
#pragma unroll
                    for (int n = 0; n < 2; ++n) { const u32x2 bw = *(const u32x2*)(base + ro + bj * HALF + 16 * n);
                        f32x4 b; b[0] = __uint_as_float(bw.x << 16); b[1] = __uint_as_float(bw.x & 0xffff0000u); b[2] = __uint_as_float(bw.y << 16); b[3] = __uint_as_float(bw.y & 0xffff0000u);
                        *(f32x4*)(O + ro + bj * HALF + 16 * n) = b * alpha + acc[ai][bj][m][n]; } }
    }
};
struct EpiSwiGLU {
    static constexpr bool PERM = true, AFTER_DRAIN = false;
    bf16_t* O; int ldc; int ntn;
    __device__ __forceinline__ void operator()(const f32x4 (&acc)[2][2][4][2], const Unit& u, int wr, int wc, int fr, int fq) const {
        const int row0 = u.pm * BM + wr * 64 + fr, col0 = (u.pn % ntn) * HALF + wc * 32 + 8 * fq;
#pragma unroll
        for (int ai = 0; ai < 2; ++ai)
#pragma unroll
            for (int m = 0; m < 4; ++m) { const int row = row0 + ai * HALF + m * 16;
                bf16_t* rowp = O + ((size_t)(row >> 7) * (ldc >> 6) + (col0 >> 6)) * 8192 + (row & 127) * 64 + (col0 & 63);
                float h[8];
#pragma unroll
                for (int n = 0; n < 2; ++n) { const f32x4 g = acc[ai][0][m][n], up = acc[ai][1][m][n];
#pragma unroll
                    for (int j = 0; j < 4; ++j) h[4 * n + j] = g[j] * up[j] * __builtin_amdgcn_rcpf(1.f + __expf(-g[j])); }
                u32x4 w; w.x = cvt_pk_bf16(h[0], h[1]); w.y = cvt_pk_bf16(h[2], h[3]); w.z = cvt_pk_bf16(h[4], h[5]); w.w = cvt_pk_bf16(h[6], h[7]);
                *(u32x4*)rowp = w; }
    }
};
struct EpiScaleRow {
    static constexpr bool PERM = true, AFTER_DRAIN = false;
    bf16_t* O; int ldc; int ntn; const float* gate;
    __device__ __forceinline__ void operator()(const f32x4 (&acc)[2][2][4][2], const Unit& u, int wr, int wc, int fr, int fq) const {
        const int row0 = u.pm * BM + wr * 64 + fr, col0 = (u.pn % ntn) * BM + wc * 32 + 8 * fq;
#pragma unroll
        for (int ai = 0; ai < 2; ++ai)
#pragma unroll
            for (int m = 0; m < 4; ++m) { const int row = row0 + ai * HALF + m * 16; const float gsc = gate[row]; bf16_t* rowp = O + (size_t)row * ldc + col0;
#pragma unroll
                for (int bj = 0; bj < 2; ++bj) { const f32x4 v0 = acc[ai][bj][m][0] * gsc, v1 = acc[ai][bj][m][1] * gsc;
                    u32x4 w; w.x = cvt_pk_bf16(v0[0], v0[1]); w.y = cvt_pk_bf16(v0[2], v0[3]); w.z = cvt_pk_bf16(v1[0], v1[1]); w.w = cvt_pk_bf16(v1[2], v1[3]);
                    *(u32x4*)(rowp + bj * HALF) = w; } }
    }
};
template <class Epi, class Sched, bool ALIGN_EPI = false, bool SP2 = false, bool GATHER = false, bool ABLK = false>
__device__ __forceinline__ void gemm_phase(PG8_LAS unsigned char* lds, const Gemm g, const Sched& S, const Epi& E, const int* __restrict__ rowidx = nullptr) {
    static_assert(!GATHER || SP2, "GATHER is implemented for the SP2 loop");
    int tid_ = threadIdx.x; asm volatile("" : "+v"(tid_)); const int tid = tid_, wid = __builtin_amdgcn_readfirstlane(tid >> 6), lane = tid & 63, wr = wid >> 2, wc = wid & 3, fr = lane & 15, fq = lane >> 4;
    const int K = g.K, nt = K / BK;
    unsigned voffA[2], voffB[2];
#pragma unroll
    for (int i = 0; i < 2; ++i) { int R, C; stage_rc(tid * 16 + i * 8192, R, C); const int Rb = Epi::PERM ? ((R & ~31) + perm32(R & 31)) : R;
        voffA[i] = ABLK ? (unsigned)(R * BK + C) * 2u : (unsigned)(R * K + C) * 2u; voffB[i] = (unsigned)(Rb * BK + C) * 2u; }
    int gR[2], gCc[2];
#pragma unroll
    for (int i = 0; i < 2; ++i) { int R, C; stage_rc(tid * 16 + i * 8192, R, C); gR[i] = R; gCc[i] = C * 2; }
    unsigned gC[2][2], gN[2][2];
#define PG8_GOFF(dst, pmv) do { _Pragma("unroll") for (int _h = 0; _h < 2; ++_h) _Pragma("unroll") for (int _i = 0; _i < 2; ++_i) \
        dst[_h][_i] = (unsigned)rowidx[(pmv) * BM + _h * HALF + gR[_i]] * (unsigned)(K * 2) + (unsigned)gCc[_i]; } while (0)
    const size_t kstep = (size_t)(BK * 2);
    const size_t kstepB = (size_t)(HALF * BK * 2);
    const size_t kstepA = ABLK ? (size_t)(HALF * BK * 2) : kstep;
    const size_t hstep = (size_t)HALF * K * 2;
    const size_t tstep = 2 * hstep;
    const unsigned ldsw = (unsigned)wid * 1024u;
    const int aoff = lds_byte(wr * 64 + fr, fq * 8), boff = lds_byte(wc * 32 + fr, fq * 8);
#define PG8_SA(b, h) (((b) * 2 + (h)) * HTB)
#define PG8_SB(b, h) ((4 + (b) * 2 + (h)) * HTB)
#define PG8_STAGE(bufoff, gbase, voff) do { _Pragma("unroll") for (int _i = 0; _i < 2; ++_i) \
        __builtin_amdgcn_global_load_lds((const unsigned*)((const char*)(gbase) + (voff)[_i]), (PG8_LAS unsigned*)(lds + (bufoff) + ldsw + _i * 8192), 16, 0, 0); } while (0)
#define PG8_STAGE_A(bufoff, gbase, h, nx) do { if constexpr (GATHER) { unsigned _o[2]; _o[0] = (nx) ? gN[h][0] : gC[h][0]; _o[1] = (nx) ? gN[h][1] : gC[h][1]; PG8_STAGE(bufoff, gbase, _o); } \
        else { PG8_STAGE(bufoff, (gbase) + (h) * hstep, voffA); } } while (0)
#define PG8_LDA(dst, b, h) do { _Pragma("unroll") for (int m = 0; m < 4; ++m) _Pragma("unroll") for (int k = 0; k < 2; ++k) dst[m][k] = *(const PG8_LAS bf16x8*)(lds + PG8_SA(b, h) + aoff + m * 2048 + k * 1024); } while (0)
#define PG8_LDB(dst, b, h) do { _Pragma("unroll") for (int n = 0; n < 2; ++n) _Pragma("unroll") for (int k = 0; k < 2; ++k) dst[n][k] = *(const PG8_LAS bf16x8*)(lds + PG8_SB(b, h) + boff + n * 2048 + k * 1024); } while (0)
#define PG8_MMA(ai, bj, At, Bt) do { __builtin_amdgcn_s_setprio(1); _Pragma("unroll") for (int m = 0; m < 4; ++m) _Pragma("unroll") for (int n = 0; n < 2; ++n) _Pragma("unroll") for (int k = 0; k < 2; ++k) \
        acc[ai][bj][m][n] = __builtin_amdgcn_mfma_f32_16x16x32_bf16(Bt[n][k], At[m][k], acc[ai][bj][m][n], 0, 0, 0); __builtin_amdgcn_s_setprio(0); } while (0)
#define PG8_WAIT_V(n) asm volatile("s_waitcnt vmcnt(" #n ")" ::: "memory")
#define PG8_WAIT_L(n) asm volatile("s_waitcnt lgkmcnt(" #n ")" ::: "memory")
#define PG8_BAR __builtin_amdgcn_s_barrier()
#define PG8_SCHED __builtin_amdgcn_sched_barrier(0)
    Unit cur, nxt; int ui = 0;
    if (!S.next(0, cur)) return;
    f32x4 acc[2][2][4][2];
#pragma unroll
    for (int a = 0; a < 2; ++a)
#pragma unroll
        for (int b = 0; b < 2; ++b)
#pragma unroll
            for (int m = 0; m < 4; ++m)
#pragma unroll
                for (int n = 0; n < 2; ++n) acc[a][b][m][n] = (f32x4){0.f, 0.f, 0.f, 0.f};
    bf16x8 At[4][2], B0[2][2], B1[2][2];
    const char* cA = GATHER ? (const char*)g.A : (const char*)g.A + (size_t)cur.pm * tstep; const char* cB = (const char*)g.Bt + (size_t)cur.pn * tstep;
    if constexpr (GATHER) { PG8_GOFF(gC, cur.pm); PG8_GOFF(gN, cur.pm); }
    S.a_ready(cur);
    if constexpr (SP2) {
        PG8_STAGE(PG8_SB(0, 0), cB, voffB); PG8_STAGE(PG8_SB(0, 1), cB + hstep, voffB); PG8_STAGE_A(PG8_SA(0, 0), cA, 0, false); PG8_STAGE_A(PG8_SA(0, 1), cA, 1, false);
        if (wr == 1) PG8_BAR;
        PG8_WAIT_V(2); PG8_BAR;
        PG8_STAGE(PG8_SB(1, 0), cB + kstepB, voffB); PG8_STAGE_A(PG8_SA(1, 0), cA + kstepA, 0, false); PG8_STAGE(PG8_SB(1, 1), cB + hstep + kstepB, voffB);
        PG8_WAIT_V(6); PG8_BAR;
    } else {
        PG8_STAGE(PG8_SB(0, 0), cB, voffB); PG8_STAGE(PG8_SA(0, 0), cA, voffA); PG8_STAGE(PG8_SB(0, 1), cB + hstep, voffB); PG8_STAGE(PG8_SA(0, 1), cA + hstep, voffA);
        if (wr == 1) PG8_BAR;
        PG8_WAIT_V(4); PG8_BAR;
        PG8_STAGE(PG8_SB(1, 0), cB + kstepB, voffB); PG8_STAGE(PG8_SA(1, 0), cA + kstep, voffA); PG8_STAGE(PG8_SB(1, 1), cB + hstep + kstepB, voffB);
        PG8_WAIT_V(6); PG8_BAR;
    }
    for (;;) {
        const bool has_next = S.next(ui + 1, nxt);
        const char* nA = GATHER ? cA : (has_next ? (const char*)g.A + (size_t)nxt.pm * tstep : cA); const char* nB = has_next ? (const char*)g.Bt + (size_t)nxt.pn * tstep : cB;
        if constexpr (GATHER) { if (has_next) PG8_GOFF(gN, nxt.pm); }
        for (int t = 0; t < nt; t += 2) {
            const bool last = (t == nt - 2);
            const char* a1 = cA + (size_t)(t + 1) * kstepA;
            const char* a2 = last ? nA : cA + (size_t)(t + 2) * kstepA; const char* b2 = last ? nB : cB + (size_t)(t + 2) * kstepB;
            const char* a3 = a2 + kstepA; const char* b3 = b2 + kstepB;
            if (last && has_next) S.a_ready(nxt);
            if constexpr (SP2) {
            PG8_LDB(B0, 0, 0); PG8_LDB(B1, 0, 1); PG8_SCHED; PG8_LDA(At, 0, 0); PG8_STAGE_A(PG8_SA(1, 1), a1, 1, false);
            PG8_WAIT_V(8); PG8_WAIT_L(0); PG8_BAR; PG8_MMA(0, 0, At, B0); PG8_MMA(0, 1, At, B1); PG8_BAR; PG8_SCHED;
            PG8_LDA(At, 0, 1); PG8_STAGE(PG8_SB(0, 0), b2, voffB); PG8_STAGE(PG8_SB(0, 1), b2 + hstep, voffB); PG8_STAGE_A(PG8_SA(0, 0), a2, 0, last);
            PG8_WAIT_V(8); PG8_WAIT_L(0); PG8_BAR; PG8_MMA(1, 0, At, B0); PG8_MMA(1, 1, At, B1); PG8_BAR; PG8_SCHED;
            PG8_LDB(B0, 1, 0); PG8_LDB(B1, 1, 1); PG8_SCHED; PG8_LDA(At, 1, 0); PG8_STAGE_A(PG8_SA(0, 1), a2, 1, last);
            PG8_WAIT_V(8); PG8_WAIT_L(0); PG8_BAR; PG8_MMA(0, 0, At, B0); PG8_MMA(0, 1, At, B1); PG8_BAR; PG8_SCHED;
            PG8_LDA(At, 1, 1); PG8_STAGE(PG8_SB(1, 0), b3, voffB); PG8_STAGE(PG8_SB(1, 1), b3 + hstep, voffB); PG8_STAGE_A(PG8_SA(1, 0), a3, 0, last);
            PG8_WAIT_V(8); PG8_WAIT_L(0); PG8_BAR; PG8_MMA(1, 0, At, B0); PG8_MMA(1, 1, At, B1); PG8_BAR; PG8_SCHED;
            } else {
            PG8_LDB(B0, 0, 0); PG8_SCHED; PG8_LDA(At, 0, 0); PG8_STAGE(PG8_SA(1, 1), a1 + hstep, voffA);
            PG8_WAIT_L(8); PG8_BAR; PG8_WAIT_L(0); PG8_MMA(0, 0, At, B0); PG8_BAR; PG8_SCHED;
            PG8_LDB(B1, 0, 1); PG8_STAGE(PG8_SB(0, 0), b2, voffB);
            PG8_BAR; PG8_WAIT_L(0); PG8_MMA(0, 1, At, B1); PG8_BAR;
            PG8_LDA(At, 0, 1); PG8_STAGE(PG8_SA(0, 0), a2, voffA);
            PG8_BAR; PG8_WAIT_L(0); PG8_MMA(1, 0, At, B0); PG8_BAR; PG8_SCHED;
            PG8_STAGE(PG8_SB(0, 1), b2 + hstep, voffB);
            PG8_WAIT_V(6); PG8_BAR; PG8_MMA(1, 1, At, B1); PG8_BAR;
            PG8_LDB(B0, 1, 0); PG8_SCHED; PG8_LDA(At, 1, 0); PG8_STAGE(PG8_SA(0, 1), a2 + hstep, voffA);
            PG8_WAIT_L(8); PG8_BAR; PG8_WAIT_L(0); PG8_MMA(0, 0, At, B0); PG8_BAR; PG8_SCHED;
            PG8_LDB(B1, 1, 1); PG8_STAGE(PG8_SB(1, 0), b3, voffB);
            PG8_BAR; PG8_WAIT_L(0); PG8_MMA(0, 1, At, B1); PG8_BAR;
            PG8_LDA(At, 1, 1); PG8_STAGE(PG8_SA(1, 0), a3, voffA);
            PG8_BAR; PG8_WAIT_L(0); PG8_MMA(1, 0, At, B0); PG8_BAR; PG8_SCHED;
            PG8_STAGE(PG8_SB(1, 1), b3 + hstep, voffB);
            PG8_WAIT_V(6); PG8_BAR; PG8_MMA(1, 1, At, B1); PG8_BAR;
            }
        }
        if constexpr (ALIGN_EPI) { if (wr == 0) PG8_BAR; }
        if constexpr (!Epi::AFTER_DRAIN) { E(acc, cur, wr, wc, fr, fq); S.done(cur); }
        if (!has_next) break;
#pragma unroll
        for (int a = 0; a < 2; ++a)
#pragma unroll
            for (int b = 0; b < 2; ++b)
#pragma unroll
                for (int m = 0; m < 4; ++m)
#pragma unroll
                    for (int n = 0; n < 2; ++n) acc[a][b][m][n] = (f32x4){0.f, 0.f, 0.f, 0.f};
        cur = nxt; cA = nA; cB = nB; ++ui;
        if constexpr (GATHER) { _Pragma("unroll") for (int _h = 0; _h < 2; ++_h) _Pragma("unroll") for (int _i = 0; _i < 2; ++_i) gC[_h][_i] = gN[_h][_i]; }
        if constexpr (ALIGN_EPI) { if (wr == 1) PG8_BAR; }
    }
    PG8_WAIT_V(0);
    if constexpr (!ALIGN_EPI) { if (wr == 0) PG8_BAR; }
    PG8_BAR;
    if constexpr (Epi::AFTER_DRAIN) { E.fused(acc, cur, wr, wc, fr, fq, lds, wid, lane); S.done(cur); }
#undef PG8_SA
#undef PG8_SB
#undef PG8_STAGE
#undef PG8_STAGE_A
#undef PG8_GOFF
#undef PG8_LDA
#undef PG8_LDB
#undef PG8_MMA
#undef PG8_WAIT_V
#undef PG8_WAIT_L
#undef PG8_BAR
#undef PG8_SCHED
}
}

using pg8::bf16_t; using pg8::bf16x8; using pg8::f32x4; using pg8::u32x4; using pg8::u32x2;
#define LAS __attribute__((address_space(3)))
typedef short bf16x4 __attribute__((ext_vector_type(4)));

constexpr int NB = 4, SEQ = 4096, DM = 1024, MTOK = NB * SEQ, DIN = 2048, NE = 16, FF = 2048, CAP = 512, NROWX = NE * NB * CAP;
constexpr float ALPHA = 1.41421356237309515f, LN_EPS = 1e-5f;
constexpr int NWAVES = 8, NTHR = 512;
constexpr int LDS_BYTES = 147456;
constexpr int S5T = 32, S5NCH = SEQ / S5T;

constexpr size_t MiB = 1u << 20;
constexpr size_t WS_WIN = 0, WS_WOUT = 8 * MiB, WS_WGLU = 12 * MiB, WS_S5TAB = 13 * MiB, WS_AFFT = 14 * MiB, WS_IDX = 15 * MiB, WS_GATE = 16 * MiB, WS_SLOT = 17 * MiB, WS_BAR = 18 * MiB, WS_S5BT = 19 * MiB, WS_S5CT = 20 * MiB;
constexpr size_t WS_WGU = 32 * MiB, WS_WD = 288 * MiB, WS_H32 = 416 * MiB, WS_HBF = 480 * MiB, WS_RA = 512 * MiB  , WS_RB = 576 * MiB  ;
constexpr size_t WS_HDN = 640 * MiB, WS_KVF = 768 * MiB, WS_KVB = 776 * MiB, WS_STF = 784 * MiB, WS_STB = 792 * MiB, WS_S5E = 800 * MiB, WS_S5C = 808 * MiB, WS_END = 816 * MiB;

struct Args { const float* in[25]; float* out; unsigned char* ws; int ph_lo, ph_hi; };

typedef __bf16 bf16x2_hw __attribute__((ext_vector_type(2)));
typedef float f32x2_hw __attribute__((ext_vector_type(2)));
__device__ __forceinline__ unsigned pk2(float lo, float hi) { const f32x2_hw v = {lo, hi}; const bf16x2_hw b = __builtin_convertvector(v, bf16x2_hw); return __builtin_bit_cast(unsigned, b); }
__device__ __forceinline__ unsigned f2bf(float f) { return pk2(f, 0.f) & 0xffffu; }
__device__ __forceinline__ float bflo(unsigned w) { return __uint_as_float(w << 16); }
__device__ __forceinline__ float bfhi(unsigned w) { return __uint_as_float(w & 0xffff0000u); }
__device__ __forceinline__ f32x4 mfma16(bf16x8 a, bf16x8 b, f32x4 c) { return __builtin_amdgcn_mfma_f32_16x16x32_bf16(a, b, c, 0, 0, 0); }
__device__ __forceinline__ float wave_sum(float v) {
#pragma unroll
    for (int o = 1; o < 64; o <<= 1) v += __shfl_xor(v, o);
    return v;
}
__device__ __forceinline__ bf16x8 pack8(const f32x4& a, const f32x4& b) {
    u32x4 w; w.x = pk2(a[0], a[1]); w.y = pk2(a[2], a[3]); w.z = pk2(b[0], b[1]); w.w = pk2(b[2], b[3]);
    return __builtin_bit_cast(bf16x8, w);
}
__device__ __forceinline__ bf16x8 cat8(bf16x4 lo, bf16x4 hi) { bf16x8 r; r[0] = lo[0]; r[1] = lo[1]; r[2] = lo[2]; r[3] = lo[3]; r[4] = hi[0]; r[5] = hi[1]; r[6] = hi[2]; r[7] = hi[3]; return r; }
#define LDS_WAIT() asm volatile("s_waitcnt lgkmcnt(0)" ::: "memory")

struct ConvItem { const float* srcp; bf16_t* dstp; int N; int rstep; };
__device__ __forceinline__ ConvItem conv_decode(const Args& a, int it, int lane) {
    constexpr int I3 = 16384, I4 = 16384, I5 = 16384, I0 = 1024, I1 = 512;
    unsigned char* ws = a.ws;
    const float* src; bf16_t* dst; int K, N, rmul = 1, ro = 0, kb, nb;
    int r = it;
    if (r < I3 + I4) { const int up = r >= I3; r -= up ? I3 : 0; const int mat = r >> 9, q = r & 511; src = (up ? a.in[21] : a.in[20]) + (size_t)mat * DM * FF; dst = (bf16_t*)(ws + WS_WGU) + (size_t)mat * 2 * FF * DM; K = DM; N = FF; rmul = 2; ro = up; kb = q >> 5; nb = q & 31; }
    else { r -= I3 + I4;
        if (r < I5) { const int mat = r >> 9, q = r & 511; src = a.in[22] + (size_t)mat * FF * DM; dst = (bf16_t*)(ws + WS_WD) + (size_t)mat * DM * FF; K = FF; N = DM; kb = q >> 4; nb = q & 15; }
        else { r -= I5;
            if (r < I0) { const int mat = r >> 9, q = r & 511; src = a.in[3] + (size_t)mat * DM * DIN; dst = (bf16_t*)(ws + WS_WIN) + (size_t)mat * DIN * DM; K = DM; N = DIN; kb = q >> 5; nb = q & 31; }
            else { r -= I0;
                if (r < I1) { const int mat = r >> 8, q = r & 255; src = a.in[16] + (size_t)mat * DM * DM; dst = (bf16_t*)(ws + WS_WOUT) + (size_t)mat * DM * DM; K = DM; N = DM; kb = q >> 4; nb = q & 15; }
                else { r -= I1; const int mat = r >> 4, q = r & 15; src = a.in[13] + (size_t)mat * 65536; dst = (bf16_t*)(ws + WS_WGLU) + (size_t)mat * 65536; K = 256; N = 256; kb = q >> 2; nb = q & 3; } } } }
    ConvItem c; c.N = N;
    c.srcp = src + (size_t)(kb * 64 + (lane >> 4)) * N + nb * 64 + (lane & 15) * 4;
    {
        const int brow = (rmul == 2) ? ((nb >> 1) * 256 + ro * 128 + (nb & 1) * 64) : nb * 64;
        if (K == 256) { c.dstp = dst + (size_t)brow * K + kb * 64; c.rstep = K; }
        else { c.dstp = dst + ((size_t)(brow >> 7) * (K >> 6) + kb) * 8192 + (brow & 127) * 64; c.rstep = 64; }
    }
    return c;
}
__device__ __forceinline__ void conv_load(const ConvItem& c, f32x4 (&v)[16]) {
#pragma unroll
    for (int i = 0; i < 16; ++i) v[i] = __builtin_nontemporal_load((const f32x4*)(c.srcp + (size_t)(i * 4) * c.N));
}
__device__ __forceinline__ void conv_store(const ConvItem& c, const f32x4 (&v)[16], LAS float* scr, int lane) {
    const int r4 = lane >> 4, c4 = (lane & 15) * 4;
#pragma unroll
    for (int i = 0; i < 16; ++i) { const int kk = i * 4 + r4; *(LAS f32x4*)(scr + kk * 68 + (c4 ^ (((kk >> 3) & 7) * 4))) = v[i]; }
    LDS_WAIT();
    const int cc = lane & 7, nl = lane >> 3;
#pragma unroll
    for (int p = 0; p < 8; ++p) {
        const int n = nl + 8 * p;
        const LAS float* s = scr + (8 * cc) * 68 + (n ^ (4 * cc));
        u32x4 o; o.x = pk2(s[0], s[68]); o.y = pk2(s[2 * 68], s[3 * 68]); o.z = pk2(s[4 * 68], s[5 * 68]); o.w = pk2(s[6 * 68], s[7 * 68]);
        *(u32x4*)(c.dstp + (size_t)n * c.rstep + 8 * cc) = o;
    }
    LDS_WAIT();
}
__device__ __forceinline__ void sincos_rev(double f, double& sn, double& cs) {
    const double a = f * 6.283185307179586476925;
    const double q = rint(a * 0.636619772367581343);
    const double r = a - q * 1.570796326794896619;
    const double r2 = r * r;
    double s = -7.6471637318198164759e-13; s = s * r2 + 1.6059043836821614599e-10; s = s * r2 - 2.5052108385441718775e-8; s = s * r2 + 2.7557319223985890653e-6;
    s = s * r2 - 1.9841269841269841270e-4; s = s * r2 + 8.3333333333333333333e-3; s = s * r2 - 1.6666666666666666667e-1; s = s * r2 * r + r;
    double c = 4.7794773323873852974e-14; c = c * r2 - 1.1470745597729724714e-11; c = c * r2 + 2.0876756987868098979e-9; c = c * r2 - 2.7557319223985890653e-7;
    c = c * r2 + 2.4801587301587301587e-5; c = c * r2 - 1.3888888888888888889e-3; c = c * r2 + 4.1666666666666666667e-2; c = c * r2 - 0.5; c = c * r2 + 1.0;
    const int qi = ((int)q) & 3;
    sn = (qi == 0) ? s : (qi == 1) ? c : (qi == 2) ? -s : -c;
    cs = (qi == 0) ? c : (qi == 1) ? -s : (qi == 2) ? -c : s;
}
__device__ __forceinline__ double exp_small(double x) {
    const double y = x * (1.0 / 64.0);
    double e = 1.0 / 479001600.0;
    e = e * y + 1.0 / 39916800.0; e = e * y + 1.0 / 3628800.0; e = e * y + 1.0 / 362880.0; e = e * y + 1.0 / 40320.0; e = e * y + 1.0 / 5040.0; e = e * y + 1.0 / 720.0;
    e = e * y + 1.0 / 120.0; e = e * y + 1.0 / 24.0; e = e * y + 1.0 / 6.0; e = e * y + 0.5; e = e * y + 1.0; e = e * y + 1.0;
#pragma unroll
    for (int i = 0; i < 6; ++i) e = e * e;
    return e;
}
__device__ __forceinline__ void s5_coefs(const Args& a, int t, double& br, double& bi, double& cr, double& ci, double& tr, double& ti) {
    const int g = (t >> 6) & 15, lr = t >> 10;
    const double lre = (double)a.in[5][t], lim = (double)a.in[6][t];
    const double step = exp_small((double)a.in[7][lr * 16 + g]);
    const double ar = lre * step, th = lim * step;
    const double rev = th * 0.15915494309189533577; const double fr = rev - rint(rev);
    double sn, cs; sincos_rev(fr, sn, cs);
    const double mag = exp_small(ar);
    br = mag * cs; bi = mag * sn;
    const double nr = br - 1.0, ni = bi, den = lre * lre + lim * lim;
    cr = (nr * lre + ni * lim) / den; ci = (ni * lre - nr * lim) / den;
    const double rev2 = rev * (double)S5T; const double fr2 = rev2 - rint(rev2);
    double sn2, cs2; sincos_rev(fr2, sn2, cs2);
    const double mag2 = exp_small(ar * (double)S5T);
    tr = mag2 * cs2; ti = mag2 * sn2;
}
__device__ __forceinline__ void s5_table_entry(const Args& a, int t) {
    double br, bi, cr, ci, tr, ti; s5_coefs(a, t, br, bi, cr, ci, tr, ti);
    float* o = (float*)(a.ws + WS_S5TAB) + (size_t)t * 8;
    o[0] = (float)br; o[1] = (float)bi; o[2] = (float)cr; o[3] = (float)ci; o[4] = (float)tr; o[5] = (float)ti; o[6] = 0.f; o[7] = 0.f;
}
__device__ __forceinline__ void s5_bt_row(const Args& a, int t) {
    const int l = t >> 12, g = (t >> 8) & 15, n = t & 255, r = n >> 7, p = (n >> 1) & 63, ri = n & 1;
    double br, bi, cr, ci, tr, ti; s5_coefs(a, ((l * 2 + r) * 16 + g) * 64 + p, br, bi, cr, ci, tr, ti);
    const float crf = (float)cr, cif = (float)ci;
    const float* bre = a.in[8] + (size_t)((l * 16 + g) * 64 + p) * 16; const float* bim = a.in[9] + (size_t)((l * 16 + g) * 64 + p) * 16;
    u32x4 o[2];
#pragma unroll
    for (int h = 0; h < 2; ++h) {
        const f32x4 x0 = *(const f32x4*)(bre + 8 * h), x1 = *(const f32x4*)(bre + 8 * h + 4), y0 = *(const f32x4*)(bim + 8 * h), y1 = *(const f32x4*)(bim + 8 * h + 4);
        float v[8];
#pragma unroll
        for (int k = 0; k < 4; ++k) { v[k] = ri ? (crf * y0[k] + cif * x0[k]) : (crf * x0[k] - cif * y0[k]); v[4 + k] = ri ? (crf * y1[k] + cif * x1[k]) : (crf * x1[k] - cif * y1[k]); }
        o[h].x = pk2(v[0], v[1]); o[h].y = pk2(v[2], v[3]); o[h].z = pk2(v[4], v[5]); o[h].w = pk2(v[6], v[7]);
    }
    u32x4* dst = (u32x4*)((bf16_t*)(a.ws + WS_S5BT) + (size_t)t * 32);
    dst[0] = o[0]; dst[1] = o[1]; dst[2] = (u32x4){0u, 0u, 0u, 0u}; dst[3] = (u32x4){0u, 0u, 0u, 0u};
}
__device__ __forceinline__ void s5_ct_entry(const Args& a, int t) {
    const int p = t & 63, r = (t >> 6) & 1, c = (t >> 7) & 15, g = (t >> 11) & 15, l = t >> 15;
    const size_t ci = (size_t)(((l * 2 + r) * 16 + g) * 16 + c) * 64 + p;
    ((unsigned*)(a.ws + WS_S5CT))[t] = pk2(a.in[10][ci], -a.in[11][ci]);
}
__device__ __forceinline__ void ln_rows4(f32x4 (&v)[4], const float* __restrict__ g, const float* __restrict__ bt, int lane) {
    float s = 0.f;
#pragma unroll
    for (int j = 0; j < 4; ++j) s += (v[j][0] + v[j][1]) + (v[j][2] + v[j][3]);
    const float mean = wave_sum(s) * (1.f / DM); float s2 = 0.f;
#pragma unroll
    for (int j = 0; j < 4; ++j) { v[j] = v[j] - mean; s2 += (v[j][0] * v[j][0] + v[j][1] * v[j][1]) + (v[j][2] * v[j][2] + v[j][3] * v[j][3]); }
    const float rstd = 1.f / sqrtf(wave_sum(s2) * (1.f / DM) + LN_EPS);
#pragma unroll
    for (int j = 0; j < 4; ++j) { const f32x4 gv = ((const f32x4*)g)[lane + 64 * j], bv = ((const f32x4*)bt)[lane + 64 * j]; v[j] = v[j] * rstd * gv + bv; }
}
__device__ __forceinline__ void store_row(const f32x4 (&v)[4], float* o32, bf16_t* obf, int lane) {
#pragma unroll
    for (int j = 0; j < 4; ++j) {
        if (o32) ((f32x4*)o32)[lane + 64 * j] = v[j];
        if (obf) { u32x2 w; w.x = pk2(v[j][0], v[j][1]); w.y = pk2(v[j][2], v[j][3]); ((u32x2*)obf)[lane + 64 * j] = w; }
    }
}
__device__ __forceinline__ void phase_p0(const Args& a, LAS unsigned char* lds, int tid) {
    const int lane = tid & 63, wave = tid >> 6;
    const int gw = blockIdx.x * NWAVES + wave, NGW = gridDim.x * NWAVES;
    LAS float* scr = (LAS float*)(lds + wave * 17408);
    unsigned char* ws = a.ws;
    constexpr int NIT = 16384 * 3 + 1024 + 512 + 32;
    if (gw < NIT) {
        ConvItem cur = conv_decode(a, gw, lane);
        f32x4 v[16]; conv_load(cur, v);
        for (int it = gw; it < NIT; it += NGW) {
            const bool more = (it + NGW) < NIT;
            ConvItem nxt = cur; f32x4 vn[16];
            if (more) { nxt = conv_decode(a, it + NGW, lane); conv_load(nxt, vn); }
            conv_store(cur, v, scr, lane);
            if (more) { cur = nxt;
#pragma unroll
                for (int i = 0; i < 16; ++i) v[i] = vn[i]; }
        }
    }
    for (int t = blockIdx.x * NTHR + tid; t < 4096; t += gridDim.x * NTHR) s5_table_entry(a, t);
    for (int t = blockIdx.x * NTHR + tid; t < 8192; t += gridDim.x * NTHR) s5_bt_row(a, t);
    for (int t = blockIdx.x * NTHR + tid; t < 65536; t += gridDim.x * NTHR) s5_ct_entry(a, t);
    for (int m = gw; m < MTOK; m += NGW) {
        f32x4 v[4];
#pragma unroll
        for (int j = 0; j < 4; ++j) v[j] = ((const f32x4*)(a.in[0] + (size_t)m * DM))[lane + 64 * j];
        ln_rows4(v, a.in[1], a.in[2], lane);
        store_row(v, nullptr, (bf16_t*)(ws + WS_HBF) + (size_t)m * DM, lane);
    }
}

__device__ __forceinline__ void attn_item(int item, const bf16_t* __restrict__ proj, bf16_t* __restrict__ mix, const float* __restrict__ sink_l, LAS unsigned char* lds, int tid) {
    const int kh = item & 1, c = (item >> 1) & 31, b = item >> 6;
    constexpr int VS = 408;
    LAS bf16_t* Ks = (LAS bf16_t*)lds;
    LAS bf16_t* Vt = (LAS bf16_t*)(lds + 384 * 72 * 2);
    const int lane = tid & 63, w = tid >> 6, fr = lane & 15, fq = lane >> 4;
    const int hq = kh * 4 + (w >> 1);
    const bf16_t* qbase = proj + ((size_t)b * SEQ + c * 128 + (w & 1) * 64 + fr) * DIN + 1280 + hq * 64 + fq * 8;
    bf16x8 qn0 = *(const bf16x8*)qbase, qn1 = *(const bf16x8*)(qbase + 32);
#pragma unroll
    for (int i = 0; i < 6; ++i) {
        const int id = tid + NTHR * i, key = id >> 3, ch = id & 7;
        const int s = (c - 1) * 128 + key; const bool ok = (s >= 0) && (s < SEQ);
        u32x4 kv = {0u, 0u, 0u, 0u}, vv = {0u, 0u, 0u, 0u};
        if (ok) { const bf16_t* rowp = proj + (size_t)(b * SEQ + s) * DIN; kv = *(const u32x4*)(rowp + 1792 + kh * 64 + ch * 8); vv = *(const u32x4*)(rowp + 1920 + kh * 64 + ch * 8); }
        *(LAS u32x4*)(Ks + key * 72 + ch * 8) = kv;
        LAS bf16_t* vp = Vt + (ch * 8) * VS + key;
        vp[0 * VS] = (bf16_t)(vv.x & 0xffffu); vp[1 * VS] = (bf16_t)(vv.x >> 16); vp[2 * VS] = (bf16_t)(vv.y & 0xffffu); vp[3 * VS] = (bf16_t)(vv.y >> 16);
        vp[4 * VS] = (bf16_t)(vv.z & 0xffffu); vp[5 * VS] = (bf16_t)(vv.z >> 16); vp[6 * VS] = (bf16_t)(vv.w & 0xffffu); vp[7 * VS] = (bf16_t)(vv.w >> 16);
    }
    if (tid < 128) { const int d = tid >> 1, hh = tid & 1; *(LAS u32x4*)(Vt + d * VS + 384 + hh * 8) = (u32x4){0u, 0u, 0u, 0u}; }
    __syncthreads();
    const float slope = exp2f(-(float)(hq + 1));
    const float sinkv = sink_l[hq];
    const bool lo_ok = (c >= 1), hi_ok = (c <= 30);
    float plo[4], phi[4];
#pragma unroll
    for (int j = 0; j < 4; ++j) { plo[j] = (fq * 4 + j >= fr) ? 0.f : -1e30f; phi[j] = (fq * 4 + j <= fr) ? 0.f : -1e30f; }
#pragma unroll 1
    for (int qi = 0; qi < 4; ++qi) {
        const int qt = (w & 1) * 4 + qi;
        const size_t tok = (size_t)b * SEQ + c * 128 + qt * 16 + fr;
        const bf16x8 qa0 = qn0, qa1 = qn1;
        float slope_l = slope; asm volatile("" : "+v"(slope_l));
        float sd[4];
#pragma unroll
        for (int j = 0; j < 4; ++j) sd[j] = slope_l * (float)(fq * 4 + j - fr);
        if (qi < 3) { const bf16_t* qp = qbase + (size_t)(qi + 1) * 16 * DIN; qn0 = *(const bf16x8*)qp; qn1 = *(const bf16x8*)(qp + 32); }
        f32x4 s[18];
        float mx = sinkv;
        const LAS bf16_t* kbase = Ks + (qt * 16 + fr) * 72 + fq * 8;
        const LAS bf16_t* vbase = Vt + fr * VS + qt * 16 + fq * 4;
#pragma unroll
        for (int i = 0; i < 17; ++i) {
            const int kt = qt + i;
            const LAS bf16_t* kp = kbase + i * (16 * 72);
            f32x4 acc = {0.f, 0.f, 0.f, 0.f};
            acc = mfma16(*(const LAS bf16x8*)kp, qa0, acc); acc = mfma16(*(const LAS bf16x8*)(kp + 32), qa1, acc);
            const float pblk = ((kt < 8) ? lo_ok : ((kt >= 16) ? hi_ok : true)) ? 0.f : -1e30f;
            const float base = slope_l * (float)(16 * i - 128);
#pragma unroll
            for (int j = 0; j < 4; ++j) {
                float t = (i < 8) ? (base + sd[j]) : ((i > 8) ? -(base + sd[j]) : -fabsf(sd[j]));
                if (i == 0) t += plo[j];
                if (i == 16) t += phi[j];
                const float v = fmaf(acc[j], 0.125f, t + pblk);
                acc[j] = v; mx = fmaxf(mx, v);
            }
            s[i] = acc;
        }
        mx = fmaxf(mx, __shfl_xor(mx, 16)); mx = fmaxf(mx, __shfl_xor(mx, 32));
        float sum = 0.f;
#pragma unroll
        for (int i = 0; i < 17; ++i)
#pragma unroll
            for (int j = 0; j < 4; ++j) { const float p = __expf(s[i][j] - mx); s[i][j] = p; sum += p; }
        s[17] = (f32x4){0.f, 0.f, 0.f, 0.f};
        sum += __shfl_xor(sum, 16); sum += __shfl_xor(sum, 32);
        const float inv = 1.f / (sum + __expf(sinkv - mx));
        f32x4 o[4];
#pragma unroll
        for (int dt = 0; dt < 4; ++dt) o[dt] = (f32x4){0.f, 0.f, 0.f, 0.f};
#pragma unroll
        for (int kk = 0; kk < 9; ++kk) {
            const bf16x8 pb = pack8(s[2 * kk], s[2 * kk + 1]);
#pragma unroll
            for (int dt = 0; dt < 4; ++dt) {
                const LAS bf16_t* vp = vbase + dt * (16 * VS) + kk * 32;
                o[dt] = mfma16(cat8(*(const LAS bf16x4*)vp, *(const LAS bf16x4*)(vp + 16)), pb, o[dt]);
            }
        }
        bf16_t* op = mix + ((tok >> 7) * 16 + 8 + hq) * 8192 + (tok & 127) * 64 + fq * 4;
#pragma unroll
        for (int dt = 0; dt < 4; ++dt) { u32x2 wv; wv.x = pk2(o[dt][0] * inv, o[dt][1] * inv); wv.y = pk2(o[dt][2] * inv, o[dt][3] * inv); *(u32x2*)(op + dt * 16) = wv; }
    }
    __syncthreads();
}

__device__ __forceinline__ float log_sigmoid(float t) { return -log1pf(__expf(-t)); }
__device__ __forceinline__ void retkv_item(int item, const bf16_t* __restrict__ proj, float* __restrict__ kvf, float* __restrict__ kvb, const float* __restrict__ theta, LAS unsigned char* lds, int tid) {
    const int h = item & 3, c = (item >> 2) & 31, b = item >> 7;
    const float lgf = log_sigmoid(theta[h]), lgb = log_sigmoid(theta[4 + h]);
    LAS bf16_t* KTf = (LAS bf16_t*)lds; LAS bf16_t* KTb = KTf + 64 * 136; LAS bf16_t* VT = KTb + 64 * 136;
#pragma unroll
    for (int i = 0; i < 2; ++i) {
        const int id = tid + NTHR * i, j = id >> 3, ch = id & 7;
        const bf16_t* rowp = proj + (size_t)(b * SEQ + c * 128 + j) * DIN;
        const u32x4 kr = *(const u32x4*)(rowp + 256 + h * 64 + ch * 8), vr = *(const u32x4*)(rowp + 512 + h * 64 + ch * 8);
        const float wf = __expf(lgf * (float)(127 - j)) * 0.125f, wb = __expf(lgb * (float)j) * 0.125f;
        const int o = (ch * 8) * 136 + j;
        KTf[o + 0 * 136] = (bf16_t)f2bf(bflo(kr.x) * wf); KTf[o + 1 * 136] = (bf16_t)f2bf(bfhi(kr.x) * wf); KTf[o + 2 * 136] = (bf16_t)f2bf(bflo(kr.y) * wf); KTf[o + 3 * 136] = (bf16_t)f2bf(bfhi(kr.y) * wf);
        KTf[o + 4 * 136] = (bf16_t)f2bf(bflo(kr.z) * wf); KTf[o + 5 * 136] = (bf16_t)f2bf(bfhi(kr.z) * wf); KTf[o + 6 * 136] = (bf16_t)f2bf(bflo(kr.w) * wf); KTf[o + 7 * 136] = (bf16_t)f2bf(bfhi(kr.w) * wf);
        KTb[o + 0 * 136] = (bf16_t)f2bf(bflo(kr.x) * wb); KTb[o + 1 * 136] = (bf16_t)f2bf(bfhi(kr.x) * wb); KTb[o + 2 * 136] = (bf16_t)f2bf(bflo(kr.y) * wb); KTb[o + 3 * 136] = (bf16_t)f2bf(bfhi(kr.y) * wb);
        KTb[o + 4 * 136] = (bf16_t)f2bf(bflo(kr.z) * wb); KTb[o + 5 * 136] = (bf16_t)f2bf(bfhi(kr.z) * wb); KTb[o + 6 * 136] = (bf16_t)f2bf(bflo(kr.w) * wb); KTb[o + 7 * 136] = (bf16_t)f2bf(bfhi(kr.w) * wb);
        VT[o + 0 * 136] = (bf16_t)(vr.x & 0xffffu); VT[o + 1 * 136] = (bf16_t)(vr.x >> 16); VT[o + 2 * 136] = (bf16_t)(vr.y & 0xffffu); VT[o + 3 * 136] = (bf16_t)(vr.y >> 16);
        VT[o + 4 * 136] = (bf16_t)(vr.z & 0xffffu); VT[o + 5 * 136] = (bf16_t)(vr.z >> 16); VT[o + 6 * 136] = (bf16_t)(vr.w & 0xffffu); VT[o + 7 * 136] = (bf16_t)(vr.w >> 16);
    }
    __syncthreads();
    const int lane = tid & 63, w = tid >> 6, fr = lane & 15, fq = lane >> 4;
    const size_t obase = (size_t)((b * 32 + c) * 4 + h) * 4096;
#pragma unroll
    for (int i = 0; i < 4; ++i) {
        const int job = w * 4 + i, dirb = job >> 4, et = (job >> 2) & 3, dt = job & 3;
        const LAS bf16_t* ap = VT + (et * 16 + fr) * 136 + fq * 8;
        const LAS bf16_t* bp = (dirb ? KTb : KTf) + (dt * 16 + fr) * 136 + fq * 8;
        f32x4 acc = {0.f, 0.f, 0.f, 0.f};
#pragma unroll
        for (int ks = 0; ks < 4; ++ks) acc = mfma16(*(const LAS bf16x8*)(ap + ks * 32), *(const LAS bf16x8*)(bp + ks * 32), acc);
        float* op = (dirb ? kvb : kvf) + obase + (et * 16 + fq * 4) * 64 + dt * 16 + fr;
        op[0] = acc[0]; op[64] = acc[1]; op[128] = acc[2]; op[192] = acc[3];
    }
    __syncthreads();
}
__device__ __forceinline__ void retout_item(int item, const bf16_t* __restrict__ proj, const float* __restrict__ stf, const float* __restrict__ stb, bf16_t* __restrict__ mix, const float* __restrict__ theta, LAS unsigned char* lds, int tid) {
    const int h = item & 3, c = (item >> 2) & 31, b = item >> 7;
    const float lgf = log_sigmoid(theta[h]), lgb = log_sigmoid(theta[4 + h]);
    LAS bf16_t* Qs = (LAS bf16_t*)lds; LAS bf16_t* Ks = Qs + 128 * 72; LAS bf16_t* VT = Ks + 128 * 72; LAS bf16_t* SFt = VT + 64 * 136; LAS bf16_t* SBt = SFt + 64 * 72;
#pragma unroll
    for (int i = 0; i < 2; ++i) {
        const int id = tid + NTHR * i, j = id >> 3, ch = id & 7;
        const bf16_t* rowp = proj + (size_t)(b * SEQ + c * 128 + j) * DIN;
        const u32x4 qr = *(const u32x4*)(rowp + h * 64 + ch * 8), kr = *(const u32x4*)(rowp + 256 + h * 64 + ch * 8), vr = *(const u32x4*)(rowp + 512 + h * 64 + ch * 8);
        *(LAS u32x4*)(Qs + j * 72 + ch * 8) = qr; *(LAS u32x4*)(Ks + j * 72 + ch * 8) = kr;
        const int o = (ch * 8) * 136 + j;
        VT[o + 0 * 136] = (bf16_t)(vr.x & 0xffffu); VT[o + 1 * 136] = (bf16_t)(vr.x >> 16); VT[o + 2 * 136] = (bf16_t)(vr.y & 0xffffu); VT[o + 3 * 136] = (bf16_t)(vr.y >> 16);
        VT[o + 4 * 136] = (bf16_t)(vr.z & 0xffffu); VT[o + 5 * 136] = (bf16_t)(vr.z >> 16); VT[o + 6 * 136] = (bf16_t)(vr.w & 0xffffu); VT[o + 7 * 136] = (bf16_t)(vr.w >> 16);
    }
    const size_t sbase = (size_t)((b * 32 + c) * 4 + h) * 4096;
#pragma unroll
    for (int i = 0; i < 8; ++i) { const int id = tid + NTHR * i, e = id >> 6, d = id & 63; SFt[e * 72 + d] = (bf16_t)f2bf(stf[sbase + id]); SBt[e * 72 + d] = (bf16_t)f2bf(stb[sbase + id]); }
    __syncthreads();
    const int lane = tid & 63, it = tid >> 6, fr = lane & 15, fq = lane >> 4;
    const int ipos = it * 16 + fr;
    const LAS bf16_t* qp = Qs + ipos * 72 + fq * 8;
    const bf16x8 qb0 = *(const LAS bf16x8*)qp, qb1 = *(const LAS bf16x8*)(qp + 32);
    f32x4 st[8];
#pragma unroll
    for (int jt = 0; jt < 8; ++jt) {
        const LAS bf16_t* kp = Ks + (jt * 16 + fr) * 72 + fq * 8;
        f32x4 acc = {0.f, 0.f, 0.f, 0.f};
        acc = mfma16(*(const LAS bf16x8*)kp, qb0, acc); acc = mfma16(*(const LAS bf16x8*)(kp + 32), qb1, acc);
#pragma unroll
        for (int jj = 0; jj < 4; ++jj) { const int dij = ipos - (jt * 16 + fq * 4 + jj); const float dec = dij >= 0 ? __expf(lgf * (float)dij) : __expf(lgb * (float)(-dij)); acc[jj] *= 0.125f * dec; }
        st[jt] = acc;
    }
    f32x4 o[4], ff[4], fb[4];
#pragma unroll
    for (int et = 0; et < 4; ++et) { o[et] = (f32x4){0.f, 0.f, 0.f, 0.f}; ff[et] = o[et]; fb[et] = o[et]; }
#pragma unroll
    for (int kk = 0; kk < 4; ++kk) {
        const bf16x8 pb = pack8(st[2 * kk], st[2 * kk + 1]);
#pragma unroll
        for (int et = 0; et < 4; ++et) { const LAS bf16_t* vp = VT + (et * 16 + fr) * 136 + kk * 32 + fq * 4; o[et] = mfma16(cat8(*(const LAS bf16x4*)vp, *(const LAS bf16x4*)(vp + 16)), pb, o[et]); }
    }
#pragma unroll
    for (int et = 0; et < 4; ++et) {
        const LAS bf16_t* fp = SFt + (et * 16 + fr) * 72 + fq * 8; const LAS bf16_t* bp = SBt + (et * 16 + fr) * 72 + fq * 8;
        ff[et] = mfma16(*(const LAS bf16x8*)fp, qb0, ff[et]); ff[et] = mfma16(*(const LAS bf16x8*)(fp + 32), qb1, ff[et]);
        fb[et] = mfma16(*(const LAS bf16x8*)bp, qb0, fb[et]); fb[et] = mfma16(*(const LAS bf16x8*)(bp + 32), qb1, fb[et]);
    }
    const float cf = __expf(lgf * (float)(ipos + 1)), cb = __expf(lgb * (float)(128 - ipos));
    float s = 0.f;
#pragma unroll
    for (int et = 0; et < 4; ++et) { o[et] = o[et] + ff[et] * cf + fb[et] * cb; s += (o[et][0] + o[et][1]) + (o[et][2] + o[et][3]); }
    s += __shfl_xor(s, 16); s += __shfl_xor(s, 32);
    const float mean = s * (1.f / 64.f); float s2 = 0.f;
#pragma unroll
    for (int et = 0; et < 4; ++et) { o[et] = o[et] - mean; s2 += (o[et][0] * o[et][0] + o[et][1] * o[et][1]) + (o[et][2] * o[et][2] + o[et][3] * o[et][3]); }
    s2 += __shfl_xor(s2, 16); s2 += __shfl_xor(s2, 32);
    const float rstd = 1.f / sqrtf(s2 * (1.f / 64.f) + LN_EPS);
    const size_t tok = (size_t)b * SEQ + c * 128 + ipos;
    const bf16_t* gp = proj + tok * DIN + 768 + h * 64 + fq * 4;
    bf16_t* op = mix + ((tok >> 7) * 16 + h) * 8192 + (tok & 127) * 64 + fq * 4;
#pragma unroll
    for (int et = 0; et < 4; ++et) {
        const u32x2 gr = *(const u32x2*)(gp + et * 16);
        const float g0 = bflo(gr.x), g1 = bfhi(gr.x), g2 = bflo(gr.y), g3 = bfhi(gr.y);
        const float y0 = o[et][0] * rstd * (g0 / (1.f + __expf(-g0))), y1 = o[et][1] * rstd * (g1 / (1.f + __expf(-g1)));
        const float y2 = o[et][2] * rstd * (g2 / (1.f + __expf(-g2))), y3 = o[et][3] * rstd * (g3 / (1.f + __expf(-g3)));
        u32x2 wv; wv.x = pk2(y0, y1); wv.y = pk2(y2, y3); *(u32x2*)(op + et * 16) = wv;
    }
    __syncthreads();
}

constexpr int S5XS = 136;
struct S5Pass { bf16x8 bf[8]; f32x4 t0; };
__device__ __forceinline__ void s5_fetch(S5Pass& P, const float* __restrict__ tab, const bf16_t* __restrict__ BT, int g, int r, int lane) {
    const int fr = lane & 15, fq = lane >> 4;
    P.t0 = *(const f32x4*)(tab + (size_t)((r * 16 + g) * 64 + lane) * 8);
    const bf16_t* btp = BT + (size_t)(g * 256 + r * 128 + fr) * 32 + fq * 8;
#pragma unroll
    for (int nt = 0; nt < 8; ++nt) P.bf[nt] = *(const bf16x8*)(btp + nt * 16 * 32);
}
__device__ __forceinline__ void s5_bu(LAS bf16_t* Xw, const S5Pass& P, bf16x8 uf0, bf16x8 uf1, int lane) {
    const int fr = lane & 15, fq = lane >> 4;
#pragma unroll
    for (int mt = 0; mt < 2; ++mt)
#pragma unroll
        for (int nt = 0; nt < 8; ++nt) {
            f32x4 acc = {0.f, 0.f, 0.f, 0.f};
            acc = mfma16(P.bf[nt], mt ? uf1 : uf0, acc);
            u32x2 wv; wv.x = pk2(acc[0], acc[1]); wv.y = pk2(acc[2], acc[3]);
            *(LAS u32x2*)(Xw + (mt * 16 + fr) * S5XS + nt * 16 + fq * 4) = wv;
        }
    asm volatile("s_waitcnt lgkmcnt(0)" ::: "memory");
}
template <bool WRITE>
__device__ __forceinline__ void s5_recur(LAS bf16_t* xq, int r, float lr_, float li_, float& xr, float& xi) {
#pragma unroll 1
    for (int blk = 0; blk < 4; ++blk) {
        LAS bf16_t* q = xq + (r ? (3 - blk) : blk) * (8 * S5XS);
        unsigned bw[8];
#pragma unroll
        for (int k = 0; k < 8; ++k) bw[k] = *(const LAS unsigned*)(q + k * S5XS);
        if (r == 0) {
#pragma unroll
            for (int s = 0; s < 8; ++s) {
                const float nr = fmaf(lr_, xr, fmaf(-li_, xi, bflo(bw[s]))), ni = fmaf(lr_, xi, fmaf(li_, xr, bfhi(bw[s])));
                xr = nr; xi = ni;
                if (WRITE) *(LAS unsigned*)(q + s * S5XS) = pk2(xr, xi);
            }
        } else {
#pragma unroll
            for (int s = 7; s >= 0; --s) {
                const float nr = fmaf(lr_, xr, fmaf(-li_, xi, bflo(bw[s]))), ni = fmaf(lr_, xi, fmaf(li_, xr, bfhi(bw[s])));
                xr = nr; xi = ni;
                if (WRITE) *(LAS unsigned*)(q + s * S5XS) = pk2(xr, xi);
            }
        }
    }
    if (WRITE) asm volatile("s_waitcnt lgkmcnt(0)" ::: "memory");
}
__device__ __forceinline__ void s5_ufrag(const bf16_t* __restrict__ proj, int b, int ch, int g, int lane, bf16x8& uf0, bf16x8& uf1) {
    const int fr = lane & 15, fq = lane >> 4;
    uf0 = (bf16x8){0, 0, 0, 0, 0, 0, 0, 0}; uf1 = uf0;
    if (fq < 2) { const bf16_t* up = proj + (size_t)(b * SEQ + ch * S5T + fr) * DIN + 1024 + g * 16 + fq * 8; uf0 = *(const bf16x8*)up; uf1 = *(const bf16x8*)(up + (size_t)16 * DIN); }
}

__device__ __forceinline__ void s5e_item(int item, const bf16_t* __restrict__ proj, const float* __restrict__ tab  , const bf16_t* __restrict__ BT,
                                         float* __restrict__ E, LAS unsigned char* lds, int tid) {
    const int ch = item & (S5NCH - 1), b = item / S5NCH;
    const int lane = tid & 63, w = tid >> 6;
    LAS bf16_t* Xw = (LAS bf16_t*)lds + w * (32 * S5XS);
    S5Pass cur;
    s5_fetch(cur, tab, BT, w, 0, lane);
    bf16x8 uf0, uf1;
    s5_ufrag(proj, b, ch, w, lane, uf0, uf1);
#pragma unroll 1
    for (int ps = 0; ps < 4; ++ps) {
        const int g = w + 8 * (ps >> 1), r = ps & 1;
        const float lr_ = cur.t0[0], li_ = cur.t0[1];
        s5_bu(Xw, cur, uf0, uf1, lane);
        if (ps < 3) s5_fetch(cur, tab, BT, w + 8 * ((ps + 1) >> 1), (ps + 1) & 1, lane);
        if (ps == 1) s5_ufrag(proj, b, ch, w + 8, lane, uf0, uf1);
        float xr = 0.f, xi = 0.f;
        s5_recur<false>(Xw + lane * 2, r, lr_, li_, xr, xi);
        float2 ev; ev.x = xr; ev.y = xi;
        ((float2*)E)[(size_t)(((b * S5NCH + ch) * 16 + g) * 2 + r) * 64 + lane] = ev;
        asm volatile("s_waitcnt lgkmcnt(0)" ::: "memory");
    }
    __syncthreads();
}
__device__ __forceinline__ void s5out_item(int item, const bf16_t* __restrict__ proj, const float* __restrict__ tab, const bf16_t* __restrict__ BT,
                                           const bf16_t* __restrict__ CT  , const float* __restrict__ dvec, const bf16_t* __restrict__ wgluT, const float* __restrict__ bglu,
                                           const float* __restrict__ CIN, bf16_t* __restrict__ mix, LAS unsigned char* lds, int tid) {
    const int ch = item & (S5NCH - 1), b = item / S5NCH;
    constexpr int YS = 264;
    const int lane = tid & 63, w = tid >> 6, fr = lane & 15, fq = lane >> 4;
    LAS bf16_t* Xw = (LAS bf16_t*)lds + w * (32 * S5XS);
    LAS bf16_t* Y = (LAS bf16_t*)(lds + 8 * 32 * S5XS * 2);
    S5Pass cur; bf16x8 ccf[4]; float2 ccin;
    s5_fetch(cur, tab, BT, w, 0, lane);
    ccin = ((const float2*)CIN)[(size_t)(((b * S5NCH + ch) * 16 + w) * 2 + 0) * 64 + lane];
#pragma unroll
    for (int ks = 0; ks < 4; ++ks) ccf[ks] = *(const bf16x8*)(CT + (size_t)(w * 16 + fr) * 256 + ks * 32 + fq * 8);
    bf16x8 uf0, uf1;
    s5_ufrag(proj, b, ch, w, lane, uf0, uf1);
    f32x4 ya0 = {0.f, 0.f, 0.f, 0.f}, ya1 = ya0;
#pragma unroll 1
    for (int ps = 0; ps < 4; ++ps) {
        const int g = w + 8 * (ps >> 1), r = ps & 1;
        const int gn = w + 8 * ((ps + 1) >> 1), rn = (ps + 1) & 1;
        const float lr_ = cur.t0[0], li_ = cur.t0[1];
        s5_bu(Xw, cur, uf0, uf1, lane);
        if (ps < 3) s5_fetch(cur, tab, BT, gn, rn, lane);
        if (ps == 1) s5_ufrag(proj, b, ch, w + 8, lane, uf0, uf1);
        float xr = ccin.x, xi = ccin.y;
        s5_recur<true>(Xw + lane * 2, r, lr_, li_, xr, xi);
        if (ps < 3) ccin = ((const float2*)CIN)[(size_t)(((b * S5NCH + ch) * 16 + gn) * 2 + rn) * 64 + lane];
#pragma unroll
        for (int ks = 0; ks < 4; ++ks) {
            ya0 = mfma16(ccf[ks], *(const LAS bf16x8*)(Xw + fr * S5XS + ks * 32 + fq * 8), ya0);
            ya1 = mfma16(ccf[ks], *(const LAS bf16x8*)(Xw + (16 + fr) * S5XS + ks * 32 + fq * 8), ya1);
        }
        if (ps < 3) {
#pragma unroll
            for (int ks = 0; ks < 4; ++ks) ccf[ks] = *(const bf16x8*)(CT + (size_t)(gn * 16 + fr) * 256 + rn * 128 + ks * 32 + fq * 8);
        }
        if (r == 1) {
            const int chn = g * 16 + fq * 4;
            const f32x4 dv = *(const f32x4*)(dvec + chn);
#pragma unroll
            for (int mt = 0; mt < 2; ++mt) {
                const int s = mt * 16 + fr;
                const u32x2 uw = *(const u32x2*)(proj + (size_t)(b * SEQ + ch * S5T + s) * DIN + 1024 + chn);
                const float uu[4] = {bflo(uw.x), bfhi(uw.x), bflo(uw.y), bfhi(uw.y)};
                float gl4[4];
#pragma unroll
                for (int jj = 0; jj < 4; ++jj) {
                    const float yv = (mt ? ya1[jj] : ya0[jj]) + dv[jj] * uu[jj];
                    const float t = 0.7978845608028654f * (yv + 0.044715f * yv * yv * yv);
                    gl4[jj] = yv * (1.f - __builtin_amdgcn_rcpf(1.f + __expf(2.f * t)));
                }
                u32x2 yw; yw.x = pk2(gl4[0], gl4[1]); yw.y = pk2(gl4[2], gl4[3]);
                *(LAS u32x2*)(Y + s * YS + chn) = yw;
            }
            ya0 = (f32x4){0.f, 0.f, 0.f, 0.f}; ya1 = ya0;
        }
        asm volatile("s_waitcnt lgkmcnt(0)" ::: "memory");
    }
    __syncthreads();
    {
        const int mt = w & 1;
        bf16x8 yf[8];
#pragma unroll
        for (int ks = 0; ks < 8; ++ks) yf[ks] = *(const LAS bf16x8*)(Y + (mt * 16 + fr) * YS + ks * 32 + fq * 8);
        const int s = mt * 16 + fr;
        const size_t tokm = (size_t)(b * SEQ + ch * S5T + s);
        bf16_t* orow = mix + ((tokm >> 7) * 16 + 4) * 8192 + (tokm & 127) * 64;
#pragma unroll 2
        for (int i = 0; i < 4; ++i) {
            const int nt = (w >> 1) * 4 + i;
            const bf16_t* ap = wgluT + (size_t)(nt * 16 + fr) * 256 + fq * 8;
            f32x4 acc = {0.f, 0.f, 0.f, 0.f};
#pragma unroll
            for (int ks = 0; ks < 8; ++ks) acc = mfma16(*(const bf16x8*)(ap + ks * 32), yf[ks], acc);
            const int n0 = nt * 16 + fq * 4;
            const f32x4 bg = *(const f32x4*)(bglu + n0);
            const u32x2 yw = *(const LAS u32x2*)(Y + s * YS + n0);
            const float yv[4] = {bflo(yw.x), bfhi(yw.x), bflo(yw.y), bfhi(yw.y)};
            float ov[4];
#pragma unroll
            for (int jj = 0; jj < 4; ++jj) ov[jj] = yv[jj] * __builtin_amdgcn_rcpf(1.f + __expf(-(acc[jj] + bg[jj])));
            u32x2 ow; ow.x = pk2(ov[0], ov[1]); ow.y = pk2(ov[2], ov[3]);
            *(u32x2*)(orow + (n0 >> 6) * 8192 + (n0 & 63)) = ow;
        }
    }
    __syncthreads();
}

__device__ __forceinline__ void phase_scan(const Args& a, int l, int tid) {
    unsigned char* ws = a.ws;
    const int lane = tid & 63, wave = tid >> 6;
    {
        const float* tab = (const float*)(ws + WS_S5TAB) + (size_t)l * 2048 * 8;
        const float2* __restrict__ E = (const float2*)(ws + WS_S5E); float2* __restrict__ C = (float2*)(ws + WS_S5C);
        for (int wv = blockIdx.x; wv < 128; wv += gridDim.x) if (wave == 0) {
            const int p = lane, r = wv & 1, g = (wv >> 1) & 15, b = wv >> 5;
            const float* tp = tab + (size_t)((r * 16 + g) * 64 + p) * 8;
            const float tr = tp[4], ti = tp[5];
            float xr = 0.f, xi = 0.f;
            for (int k0 = 0; k0 < S5NCH; k0 += 32) {
                float2 e[32];
#pragma unroll
                for (int k = 0; k < 32; ++k) { const int ch = r ? (S5NCH - 1 - (k0 + k)) : (k0 + k); e[k] = E[(size_t)(((b * S5NCH + ch) * 16 + g) * 2 + r) * 64 + p]; }
#pragma unroll
                for (int k = 0; k < 32; ++k) { const int ch = r ? (S5NCH - 1 - (k0 + k)) : (k0 + k);
                    float2 cv; cv.x = xr; cv.y = xi; C[(size_t)(((b * S5NCH + ch) * 16 + g) * 2 + r) * 64 + p] = cv;
                    const float nr = fmaf(tr, xr, fmaf(-ti, xi, e[k].x)), ni = fmaf(tr, xi, fmaf(ti, xr, e[k].y));
                    xr = nr; xi = ni; }
            }
        }
    }
    {
        const float* theta = a.in[4] + l * 8;
        const float* __restrict__ kvf = (const float*)(ws + WS_KVF); const float* __restrict__ kvb = (const float*)(ws + WS_KVB);
        float* __restrict__ stf = (float*)(ws + WS_STF); float* __restrict__ stb = (float*)(ws + WS_STB);
        for (int gid = blockIdx.x * NTHR + tid; gid < 131072; gid += gridDim.x * NTHR) {
            const int el = gid & 4095, dir = (gid >> 12) & 1, h = (gid >> 13) & 3, b = gid >> 15;
            const float dec = __expf(log_sigmoid(theta[dir * 4 + h]) * 128.f);
            const float* __restrict__ kv = dir ? kvb : kvf; float* __restrict__ st = dir ? stb : stf;
            float s = 0.f;
            for (int c0 = 0; c0 < 32; c0 += 16) {
                float kk[16];
#pragma unroll
                for (int k = 0; k < 16; ++k) { const int c = dir ? (31 - (c0 + k)) : (c0 + k); kk[k] = kv[(size_t)((b * 32 + c) * 4 + h) * 4096 + el]; }
#pragma unroll
                for (int k = 0; k < 16; ++k) { const int c = dir ? (31 - (c0 + k)) : (c0 + k); st[(size_t)((b * 32 + c) * 4 + h) * 4096 + el] = s; s = fmaf(dec, s, kk[k]); }
            }
        }
    }
}

__device__ __forceinline__ float router_softmax(const float (&sp)[16], int lane) {
    const bool b5 = (lane & 32) != 0, b4 = (lane & 16) != 0, b3 = (lane & 8) != 0, b2 = (lane & 4) != 0;
    float t8[8], t4[4], t2[2];
#pragma unroll
    for (int i = 0; i < 8; ++i) { const float snd = b5 ? sp[i] : sp[i + 8], kp = b5 ? sp[i + 8] : sp[i]; t8[i] = kp + __shfl_xor(snd, 32); }
#pragma unroll
    for (int i = 0; i < 4; ++i) { const float snd = b4 ? t8[i] : t8[i + 4], kp = b4 ? t8[i + 4] : t8[i]; t4[i] = kp + __shfl_xor(snd, 16); }
#pragma unroll
    for (int i = 0; i < 2; ++i) { const float snd = b3 ? t4[i] : t4[i + 2], kp = b3 ? t4[i + 2] : t4[i]; t2[i] = kp + __shfl_xor(snd, 8); }
    float lgt; { const float snd = b2 ? t2[0] : t2[1], kp = b2 ? t2[1] : t2[0]; lgt = kp + __shfl_xor(snd, 4); }
    lgt += __shfl_xor(lgt, 1); lgt += __shfl_xor(lgt, 2);
    float mx = lgt;
#pragma unroll
    for (int o = 4; o < 64; o <<= 1) mx = fmaxf(mx, __shfl_xor(mx, o));
    const float ex = expf(lgt - mx);
    float sum = ex;
#pragma unroll
    for (int o = 4; o < 64; o <<= 1) sum += __shfl_xor(sum, o);
    return ex / sum;
}
__device__ __forceinline__ void phase_ln1_router(const Args& a, int l, LAS unsigned char* lds, int tid) {
    unsigned char* ws = a.ws;
    const int lane = tid & 63, wave = tid >> 6;
    LAS float* rwT = (LAS float*)lds;
    const float* rw = a.in[19] + (size_t)l * DM * NE;
    for (int i = tid; i < DM * NE; i += NTHR) rwT[(i & 15) * DM + (i >> 4)] = rw[i];
    __syncthreads();
    const float* pre = (const float*)(ws + WS_RA);
    float* afft = (float*)(ws + WS_AFFT);
    const int gw = blockIdx.x * NWAVES + wave, NGW = gridDim.x * NWAVES;
    for (int m = gw; m < MTOK; m += 2 * NGW) {
        const int m1 = m + NGW; const bool has1 = m1 < MTOK; const int mb = has1 ? m1 : m;
        f32x4 v0[4], v1[4];
#pragma unroll
        for (int j = 0; j < 4; ++j) { v0[j] = ((const f32x4*)(pre + (size_t)m * DM))[lane + 64 * j]; v1[j] = ((const f32x4*)(pre + (size_t)mb * DM))[lane + 64 * j]; }
        ln_rows4(v0, a.in[17] + l * DM, a.in[18] + l * DM, lane);
        ln_rows4(v1, a.in[17] + l * DM, a.in[18] + l * DM, lane);
        store_row(v0, nullptr, (bf16_t*)(ws + WS_HBF) + (size_t)m * DM, lane);
        if (has1) store_row(v1, nullptr, (bf16_t*)(ws + WS_HBF) + (size_t)m1 * DM, lane);
        float sp0[16], sp1[16];
#pragma unroll
        for (int eg = 0; eg < 4; ++eg) {
#pragma unroll
            for (int ee = 0; ee < 4; ++ee) { const int e = eg * 4 + ee; float s0 = 0.f, s1 = 0.f;
#pragma unroll
                for (int j = 0; j < 4; ++j) { const f32x4 wv = *(const LAS f32x4*)(rwT + e * DM + 256 * j + 4 * lane);
                    s0 += (v0[j][0] * wv[0] + v0[j][1] * wv[1]) + (v0[j][2] * wv[2] + v0[j][3] * wv[3]);
                    s1 += (v1[j][0] * wv[0] + v1[j][1] * wv[1]) + (v1[j][2] * wv[2] + v1[j][3] * wv[3]); }
                sp0[e] = s0; sp1[e] = s1; }
            asm volatile("" ::: "memory");
        }
        const float af0 = router_softmax(sp0, lane), af1 = router_softmax(sp1, lane);
        if ((lane & 3) == 0) {
            afft[(size_t)((m / SEQ) * NE + (lane >> 2)) * SEQ + (m % SEQ)] = af0;
            if (has1) afft[(size_t)((m1 / SEQ) * NE + (lane >> 2)) * SEQ + (m1 % SEQ)] = af1;
        }
    }
    __syncthreads();
}

__device__ __forceinline__ void select_item(int item, const Args& a, LAS unsigned char* lds, int tid) {
    unsigned char* ws = a.ws;
    const int q = item & 3, e = (item >> 2) & 15, b = item >> 6;
    const int lane = tid & 63, wave = tid >> 6;
    LAS unsigned* red = (LAS unsigned*)lds;
    LAS int* sel = (LAS int*)(lds + 1024);
    const float* av = (const float*)(ws + WS_AFFT) + (size_t)(b * NE + e) * SEQ + tid * 8;
    const f32x4 va = *(const f32x4*)av, vb = *(const f32x4*)(av + 4);
    unsigned v[8] = {__float_as_uint(va[0]), __float_as_uint(va[1]), __float_as_uint(va[2]), __float_as_uint(va[3]), __float_as_uint(vb[0]), __float_as_uint(vb[1]), __float_as_uint(vb[2]), __float_as_uint(vb[3])};
    unsigned x = 0u;
    for (int bit = 30; bit >= 0; --bit) {
        const unsigned cand = x | (1u << bit);
        unsigned cnt = 0u;
#pragma unroll
        for (int j = 0; j < 8; ++j) cnt += (unsigned)__popcll(__ballot(v[j] >= cand));
        LAS unsigned* rb = red + (bit & 1) * 8;
        if (lane == 0) rb[wave] = cnt;
        __syncthreads();
        unsigned tot = 0u;
#pragma unroll
        for (int k = 0; k < 8; ++k) tot += rb[k];
        if (tot >= (unsigned)CAP) x = cand;
    }
    unsigned mycnt = 0u;
#pragma unroll
    for (int j = 0; j < 8; ++j) mycnt += (v[j] > x ? 1u : 0u) + (v[j] == x ? 0x10000u : 0u);
    unsigned inc = mycnt;
#pragma unroll
    for (int o = 1; o < 64; o <<= 1) { const unsigned t = __shfl_up(inc, o); if (lane >= o) inc += t; }
    LAS unsigned* wsum = red + 64;
    __syncthreads();
    if (lane == 63) wsum[wave] = inc;
    __syncthreads();
    unsigned wpre = 0u, total = 0u;
#pragma unroll
    for (int k = 0; k < 8; ++k) { const unsigned t = wsum[k]; if (k < wave) wpre += t; total += t; }
    const unsigned excl = wpre + inc - mycnt;
    unsigned gtb = excl & 0xffffu, eqb = excl >> 16;
    const unsigned need = (unsigned)CAP - (total & 0xffffu);
    const int rowbase = (e * NB + b) * CAP;
    int* idx = (int*)(ws + WS_IDX); float* gate = (float*)(ws + WS_GATE); int* slotmap = (int*)(ws + WS_SLOT);
    const bool own_tok = ((tid >> 7) == q);
#pragma unroll
    for (int j = 0; j < 8; ++j) {
        const bool isgt = v[j] > x, iseq = v[j] == x;
        const bool issel = isgt || (iseq && eqb < need);
        const unsigned slot = gtb + (eqb < need ? eqb : need);
        const int tok = b * SEQ + tid * 8 + j;
        if (issel && (int)(slot >> 7) == q) { idx[rowbase + slot] = tok; gate[rowbase + slot] = __uint_as_float(v[j]); }
        if (own_tok) slotmap[(size_t)tok * NE + e] = issel ? (int)(rowbase + slot) : -1;
        gtb += isgt ? 1u : 0u; eqb += iseq ? 1u : 0u;
    }
    __syncthreads();
}

__device__ __forceinline__ void phase_ln2(const Args& a, int l, int tid) {
    unsigned char* ws = a.ws;
    const int lane = tid & 63, wave = tid >> 6;
    const int gw = blockIdx.x * NWAVES + wave, NGW = gridDim.x * NWAVES;
    const bf16_t* hbf = (const bf16_t*)(ws + WS_HBF); const int* slotmap = (const int*)(ws + WS_SLOT); const bf16_t* contrib = (const bf16_t*)(ws + WS_RB);
    const bool last = (l == 1);
    u32x2 vn[4]; int slot_n = -1;
    if (gw < MTOK) {
#pragma unroll
        for (int j = 0; j < 4; ++j) vn[j] = ((const u32x2*)(hbf + (size_t)gw * DM))[lane + 64 * j];
        slot_n = slotmap[(size_t)gw * NE + (lane & 15)];
    }
    for (int m = gw; m < MTOK; m += NGW) {
        f32x4 v[4];
#pragma unroll
        for (int j = 0; j < 4; ++j) { v[j][0] = bflo(vn[j].x) * ALPHA; v[j][1] = bfhi(vn[j].x) * ALPHA; v[j][2] = bflo(vn[j].y) * ALPHA; v[j][3] = bfhi(vn[j].y) * ALPHA; }
        const int myslot = slot_n;
        unsigned bal = (unsigned)(__ballot(myslot >= 0) & 0xffffull);
        int r0 = -1, r1 = -1, r2 = -1, r3 = -1;
        if (bal) { r0 = __shfl(myslot, __builtin_ctz(bal)); bal &= bal - 1; }
        if (bal) { r1 = __shfl(myslot, __builtin_ctz(bal)); bal &= bal - 1; }
        if (bal) { r2 = __shfl(myslot, __builtin_ctz(bal)); bal &= bal - 1; }
        if (bal) { r3 = __shfl(myslot, __builtin_ctz(bal)); bal &= bal - 1; }
        u32x2 c0[4], c1[4], c2[4], c3[4];
#pragma unroll
        for (int j = 0; j < 4; ++j) { c0[j] = (u32x2){0u, 0u}; c1[j] = c0[j]; c2[j] = c0[j]; c3[j] = c0[j]; }
        if (r0 >= 0) {
#pragma unroll
            for (int j = 0; j < 4; ++j) c0[j] = ((const u32x2*)(contrib + (size_t)r0 * DM))[lane + 64 * j]; }
        if (r1 >= 0) {
#pragma unroll
            for (int j = 0; j < 4; ++j) c1[j] = ((const u32x2*)(contrib + (size_t)r1 * DM))[lane + 64 * j]; }
        if (r2 >= 0) {
#pragma unroll
            for (int j = 0; j < 4; ++j) c2[j] = ((const u32x2*)(contrib + (size_t)r2 * DM))[lane + 64 * j]; }
        if (r3 >= 0) {
#pragma unroll
            for (int j = 0; j < 4; ++j) c3[j] = ((const u32x2*)(contrib + (size_t)r3 * DM))[lane + 64 * j]; }
        if (m + NGW < MTOK) {
#pragma unroll
            for (int j = 0; j < 4; ++j) vn[j] = ((const u32x2*)(hbf + (size_t)(m + NGW) * DM))[lane + 64 * j];
            slot_n = slotmap[(size_t)(m + NGW) * NE + (lane & 15)];
        }
#pragma unroll
        for (int j = 0; j < 4; ++j) {
            v[j][0] += bflo(c0[j].x); v[j][1] += bfhi(c0[j].x); v[j][2] += bflo(c0[j].y); v[j][3] += bfhi(c0[j].y);
            v[j][0] += bflo(c1[j].x); v[j][1] += bfhi(c1[j].x); v[j][2] += bflo(c1[j].y); v[j][3] += bfhi(c1[j].y);
            v[j][0] += bflo(c2[j].x); v[j][1] += bfhi(c2[j].x); v[j][2] += bflo(c2[j].y); v[j][3] += bfhi(c2[j].y);
            v[j][0] += bflo(c3[j].x); v[j][1] += bfhi(c3[j].x); v[j][2] += bflo(c3[j].y); v[j][3] += bfhi(c3[j].y);
        }
        while (bal) {
            const int row = __shfl(myslot, __builtin_ctz(bal)); bal &= bal - 1;
            const u32x2* cr = (const u32x2*)(contrib + (size_t)row * DM);
#pragma unroll
            for (int j = 0; j < 4; ++j) { const u32x2 wv = cr[lane + 64 * j]; v[j][0] += bflo(wv.x); v[j][1] += bfhi(wv.x); v[j][2] += bflo(wv.y); v[j][3] += bfhi(wv.y); }
        }
        ln_rows4(v, a.in[23] + l * DM, a.in[24] + l * DM, lane);
        if (last) store_row(v, a.out + (size_t)m * DM, nullptr, lane);
        else store_row(v, nullptr, (bf16_t*)(ws + WS_HBF) + (size_t)m * DM, lane);
    }
}

typedef __attribute__((address_space(1))) unsigned gu32;
#define RLX_AGENT __ATOMIC_RELAXED, __HIP_MEMORY_SCOPE_AGENT
#define XB_TMO      128
#define XB_XCNT(j)  (256  + 64 * (j))
#define XB_XSUB(j)  (1280 + 64 * (j))
#define XB_XGEN(j)  (2304 + 64 * (j))
#define XB_TOP      3328
#define XB_TOPGEN   3392
#define XCD_BAR_WORDS 3456
#define XB_SPIN_CAP (1u << 18)

__device__ __forceinline__ unsigned xb_ld(unsigned* p)              { return __hip_atomic_load(p, __ATOMIC_RELAXED, __HIP_MEMORY_SCOPE_AGENT); }
__device__ __forceinline__ unsigned xb_add(unsigned* p, unsigned v) { return __hip_atomic_fetch_add(p, v, __ATOMIC_RELAXED, __HIP_MEMORY_SCOPE_AGENT); }
__device__ __forceinline__ unsigned xb_xcc_id() { return (unsigned)__builtin_amdgcn_s_getreg((3 << 11) | 20) & 0xFu; }
#define XB_SPIN(cond, bar) do { unsigned _sp = 0; while (cond) { __builtin_amdgcn_s_sleep(1); \
    if ((++_sp & 255u) == 0u) { if (xb_ld(&(bar)[XB_TMO])) break; if (_sp > XB_SPIN_CAP) { atomicAdd(&(bar)[XB_TMO], 1u); break; } } } } while (0)

struct XcdBarrier {
    unsigned* bar; unsigned x;
    volatile LAS unsigned* st;
};

__device__ __forceinline__ XcdBarrier xcd_barrier_post(unsigned* bar, volatile LAS unsigned* st) {
    XcdBarrier b; b.bar = bar; b.x = xb_xcc_id(); b.st = st;
    if (threadIdx.x == 0) (void)xb_add(&bar[XB_XCNT(b.x)], 1u);
    return b;
}
__device__ __forceinline__ void xcd_barrier_complete(unsigned* bar, unsigned x, unsigned& nloc, unsigned& nx) {
    const unsigned G = gridDim.x * gridDim.y * gridDim.z;
    unsigned sum, cnt, mine, sp = 0u;
    for (;;) {
        sum = 0u; cnt = 0u; mine = 0u;
#pragma unroll
        for (unsigned j = 0; j < 16; ++j) { const unsigned c = xb_ld(&bar[XB_XCNT(j)]); sum += c; cnt += (c > 0u) ? 1u : 0u; mine = (j == x) ? c : mine; }
        if (sum == G) break;
        __builtin_amdgcn_s_sleep(1);
        if ((++sp & 255u) == 0u) { if (xb_ld(&bar[XB_TMO])) break; if (sp > XB_SPIN_CAP) { atomicAdd(&bar[XB_TMO], 1u); break; } }
    }
    nloc = mine > 0u ? mine : 1u; nx = cnt > 0u ? cnt : 1u;
}

__device__ __forceinline__ void xcd_barrier(const XcdBarrier& b) {
    asm volatile("s_waitcnt vmcnt(0)" ::: "memory");
    __syncthreads();
    if (threadIdx.x == 0) {
        unsigned* bar = b.bar;
        __builtin_amdgcn_s_waitcnt(0);
        unsigned nloc = b.st[0], nx = b.st[1];
        if (nloc == 0u) { xcd_barrier_complete(bar, b.x, nloc, nx); b.st[0] = nloc; b.st[1] = nx; }
        const unsigned old = xb_add(&bar[XB_XSUB(b.x)], 1u);
        const unsigned gen = old / nloc;
        if (old + 1u == (gen + 1u) * nloc) {
            __builtin_amdgcn_fence(__ATOMIC_RELEASE, "agent");
            asm volatile("s_waitcnt vmcnt(0)" ::: "memory");
            const unsigned og = xb_add(&bar[XB_TOP], 1u);
            const unsigned tg = og / nx;
            if (og + 1u == (tg + 1u) * nx) xb_add(&bar[XB_TOPGEN], 1u);
            else XB_SPIN(xb_ld(&bar[XB_TOPGEN]) == tg, bar);
            __builtin_amdgcn_fence(__ATOMIC_ACQUIRE, "agent");
            xb_add(&bar[XB_XGEN(b.x)], 1u);
            asm volatile("s_waitcnt vmcnt(0)" ::: "memory");
        } else {
            XB_SPIN(xb_ld(&bar[XB_XGEN(b.x)]) == gen, bar);
            __builtin_amdgcn_fence(__ATOMIC_ACQUIRE, "agent");
            asm volatile("s_waitcnt vmcnt(0)" ::: "memory");
        }
    }
    __syncthreads();
}

constexpr int NPHASES = 21;
#ifndef REP_MASK
#define REP_MASK 0
#endif
template <int L, int K>
__device__ __forceinline__ void run_phase(const Args& a, LAS unsigned char* lds, int tid) {
    unsigned char* ws = a.ws;
    constexpr int l = L;
    bf16_t* proj = (bf16_t*)(ws + WS_RA); bf16_t* mix = (bf16_t*)(ws + WS_RB);
    if constexpr (K == 0) {
        pg8::Gemm g{(const bf16_t*)(ws + WS_HBF), (const bf16_t*)(ws + WS_WIN) + (size_t)l * DIN * DM, MTOK, DIN, DM};
        pg8::StaticOrder S; S.init(MTOK, DIN, (int)gridDim.x, (int)blockIdx.x);
        pg8::EpiStoreBf16 E{proj, DIN};
        pg8::gemm_phase<pg8::EpiStoreBf16, pg8::StaticOrder, true, true>(lds, g, S, E);
    } else if constexpr (K == 1) {
        const float* tab = (const float*)(ws + WS_S5TAB) + (size_t)l * 2048 * 8;
        constexpr int XB = ((REP_MASK >> 11) & 1) ? 512 : ((REP_MASK >> 12) & 1) ? 256 : ((REP_MASK >> 13) & 1) ? 512 : 0, XOFF = ((REP_MASK >> 11) & 1) ? 0 : ((REP_MASK >> 12) & 1) ? 512 : 768;
        for (int it0 = blockIdx.x; it0 < 1280 + XB; it0 += gridDim.x) {
            const int it = it0 < 1280 ? it0 : it0 - 1280 + XOFF;
            if (it < 512) s5e_item(it, proj, tab, (const bf16_t*)(ws + WS_S5BT) + (size_t)l * 4096 * 32, (float*)(ws + WS_S5E), lds, tid);
            else if (it < 768) attn_item(it - 512, proj, mix, a.in[15] + l * 8, lds, tid);
            else retkv_item(it - 768, proj, (float*)(ws + WS_KVF), (float*)(ws + WS_KVB), a.in[4] + l * 8, lds, tid);
        }
    } else if constexpr (K == 2) {
        phase_scan(a, l, tid);
    } else if constexpr (K == 3) {
        const float* tab = (const float*)(ws + WS_S5TAB) + (size_t)l * 2048 * 8;
        constexpr int XD = ((REP_MASK >> 14) & 3) ? 512 : 0, XOFD = ((REP_MASK >> 14) & 1) ? 0 : 512;
        for (int it0 = blockIdx.x; it0 < 1024 + XD; it0 += gridDim.x) {
            const int it = it0 < 1024 ? it0 : it0 - 1024 + XOFD;
            if (it < 512) s5out_item(it, proj, tab, (const bf16_t*)(ws + WS_S5BT) + (size_t)l * 4096 * 32, (const bf16_t*)(ws + WS_S5CT) + (size_t)l * 65536, a.in[12] + l * 256,
                                     (const bf16_t*)(ws + WS_WGLU) + (size_t)l * 65536, a.in[14] + l * 256, (const float*)(ws + WS_S5C), mix, lds, tid);
            else retout_item(it - 512, proj, (const float*)(ws + WS_STF), (const float*)(ws + WS_STB), mix, a.in[4] + l * 8, lds, tid);
        }
    } else if constexpr (K == 4) {
        pg8::Gemm g{mix, (const bf16_t*)(ws + WS_WOUT) + (size_t)l * DM * DM, MTOK, DM, DM};
        pg8::StaticOrder S; S.init(MTOK, DM, (int)gridDim.x, (int)blockIdx.x);
        pg8::EpiResF32 E{(const bf16_t*)(ws + WS_HBF), (float*)(ws + WS_RA), DM, ALPHA};
        pg8::gemm_phase<pg8::EpiResF32, pg8::StaticOrder, true, true, false, true>(lds, g, S, E);
    } else if constexpr (K == 5) {
        phase_ln1_router(a, l, lds, tid);
    } else if constexpr (K == 6) {
        for (int it = blockIdx.x; it < 256; it += gridDim.x) select_item(it, a, lds, tid);
    } else if constexpr (K == 7) {
        pg8::Gemm g{(const bf16_t*)(ws + WS_HBF), (const bf16_t*)(ws + WS_WGU) + (size_t)l * NE * 2 * FF * DM, NROWX, NE * 2 * FF, DM};
        pg8::GroupedOrder S; S.init(16, (int)gridDim.x, (int)blockIdx.x);
        pg8::EpiSwiGLU E{(bf16_t*)(ws + WS_HDN), FF, 16};
        pg8::gemm_phase<pg8::EpiSwiGLU, pg8::GroupedOrder, true, true, true>(lds, g, S, E, (const int*)(ws + WS_IDX));
    } else if constexpr (K == 8) {
        pg8::Gemm g{(const bf16_t*)(ws + WS_HDN), (const bf16_t*)(ws + WS_WD) + (size_t)l * NE * DM * FF, NROWX, NE * DM, FF};
        pg8::GroupedOrder S; S.init(4, (int)gridDim.x, (int)blockIdx.x);
        pg8::EpiScaleRow E{(bf16_t*)(ws + WS_RB), DM, 4, (const float*)(ws + WS_GATE)};
        pg8::gemm_phase<pg8::EpiScaleRow, pg8::GroupedOrder, true, true, false, true>(lds, g, S, E);
    } else {
        phase_ln2(a, l, tid);
    }
}
__global__ void __launch_bounds__(NTHR, 2) fwd_kernel(Args a) {
    extern __shared__ __attribute__((aligned(16))) unsigned char lds_raw[];
    LAS unsigned char* lds = (LAS unsigned char*)lds_raw;
    cg::grid_group grid = cg::this_grid();
    const int lo = a.ph_lo, hi = a.ph_hi;
    volatile LAS unsigned* bst = (volatile LAS unsigned*)(lds + LDS_BYTES - 64);
    if (threadIdx.x < 16) bst[threadIdx.x] = 0u;
    __syncthreads();
    XcdBarrier bar = xcd_barrier_post((unsigned*)(a.ws + WS_BAR), bst);
    if (hi > 1000) grid.sync();
#define PH_BEGIN(ph) if (lo <= (ph) && (ph) < hi) { int tid = threadIdx.x; asm volatile("" : "+v"(tid));
#define PH_END(ph) if ((ph) + 1 < hi) xcd_barrier(bar); }
    PH_BEGIN(0) for (int rep = 0; rep <= ((REP_MASK >> 10) & 1); ++rep) phase_p0(a, lds, tid); PH_END(0)
#define LAYER(L) \
    PH_BEGIN(1 + 10 * L + 0) for (int rep = 0; rep <= ((REP_MASK >> 0) & 1); ++rep) run_phase<L, 0>(a, lds, tid); PH_END(1 + 10 * L + 0) \
    PH_BEGIN(1 + 10 * L + 1) for (int rep = 0; rep <= ((REP_MASK >> 1) & 1); ++rep) run_phase<L, 1>(a, lds, tid); PH_END(1 + 10 * L + 1) \
    PH_BEGIN(1 + 10 * L + 2) for (int rep = 0; rep <= ((REP_MASK >> 2) & 1); ++rep) run_phase<L, 2>(a, lds, tid); PH_END(1 + 10 * L + 2) \
    PH_BEGIN(1 + 10 * L + 3) for (int rep = 0; rep <= ((REP_MASK >> 3) & 1); ++rep) run_phase<L, 3>(a, lds, tid); PH_END(1 + 10 * L + 3) \
    PH_BEGIN(1 + 10 * L + 4) for (int rep = 0; rep <= ((REP_MASK >> 4) & 1); ++rep) run_phase<L, 4>(a, lds, tid); PH_END(1 + 10 * L + 4) \
    PH_BEGIN(1 + 10 * L + 5) for (int rep = 0; rep <= ((REP_MASK >> 5) & 1); ++rep) run_phase<L, 5>(a, lds, tid); PH_END(1 + 10 * L + 5) \
    PH_BEGIN(1 + 10 * L + 6) for (int rep = 0; rep <= ((REP_MASK >> 6) & 1); ++rep) run_phase<L, 6>(a, lds, tid); PH_END(1 + 10 * L + 6) \
    PH_BEGIN(1 + 10 * L + 7) for (int rep = 0; rep <= ((REP_MASK >> 7) & 1); ++rep) run_phase<L, 7>(a, lds, tid); PH_END(1 + 10 * L + 7) \
    PH_BEGIN(1 + 10 * L + 8) for (int rep = 0; rep <= ((REP_MASK >> 8) & 1); ++rep) run_phase<L, 8>(a, lds, tid); PH_END(1 + 10 * L + 8) \
    PH_BEGIN(1 + 10 * L + 9) for (int rep = 0; rep <= (((REP_MASK >> 9) & 1) && L == 1 ? 1 : 0); ++rep) run_phase<L, 9>(a, lds, tid); PH_END(1 + 10 * L + 9)
    LAYER(0)
    LAYER(1)
#undef LAYER
#undef PH_BEGIN
#undef PH_END
}

#ifndef ONE_LAUNCH
#define ONE_LAUNCH 1
#endif
extern "C" void kernel_launch(void* const* d_in, const int* in_sizes, int n_in, void* d_out, int out_size, void* d_ws, size_t ws_size, hipStream_t stream) {
    static int grid = 0;
    if (grid == 0) {
        if (n_in != 25 || ws_size < WS_END) { fprintf(stderr, "kernel_launch: unexpected problem (n_in %d, ws %zu)\n", n_in, ws_size); grid = -1; return; }
        int dev = 0, cus = 0, per_cu = 0;
        (void)hipGetDevice(&dev);
        (void)hipDeviceGetAttribute(&cus, hipDeviceAttributeMultiprocessorCount, dev);
        if (hipFuncSetAttribute((const void*)fwd_kernel, hipFuncAttributeMaxDynamicSharedMemorySize, LDS_BYTES) != hipSuccess) { fprintf(stderr, "kernel_launch: hipFuncSetAttribute failed\n"); grid = -1; return; }
        if (hipOccupancyMaxActiveBlocksPerMultiprocessor(&per_cu, (const void*)fwd_kernel, NTHR, LDS_BYTES) != hipSuccess || per_cu < 1) { fprintf(stderr, "kernel_launch: occupancy query says %d\n", per_cu); per_cu = 1; }
        (void)hipGetLastError();
        if (cus <= 0) cus = 256;
        grid = cus * per_cu;
    }
    if (grid < 0) return;
    Args a{};
    for (int i = 0; i < 25; ++i) a.in[i] = (const float*)d_in[i];
    a.out = (float*)d_out; a.ws = (unsigned char*)d_ws;
#if ONE_LAUNCH
    if (hipMemsetAsync((char*)d_ws + WS_BAR, 0, 16384, stream) != hipSuccess) { fprintf(stderr, "kernel_launch: memset failed\n"); return; }
    a.ph_lo = 0; a.ph_hi = NPHASES;
    void* args[] = {&a};
    hipError_t e = hipLaunchCooperativeKernel((const void*)fwd_kernel, dim3(grid), dim3(NTHR), args, LDS_BYTES, stream);
    if (e != hipSuccess) fprintf(stderr, "kernel_launch: cooperative launch failed: %s (grid %d)\n", hipGetErrorString(e), grid);
#else
    for (int ph = 0; ph < NPHASES; ++ph) {
        a.ph_lo = ph; a.ph_hi = ph + 1;
        hipLaunchKernelGGL(fwd_kernel, dim3(grid), dim3(NTHR), LDS_BYTES, stream, a);
    }
#endif
}
```

```cpp
#include <hip/hip_runtime.h>
#include <hip/hip_cooperative_groups.h>
#include <cstdio>
#include <cstdint>
namespace cg = cooperative_groups;
namespace pg8 {
#define PG8_LAS __attribute__((address_space(3)))
typedef unsigned short bf16_t;
typedef short bf16x8 __attribute__((ext_vector_type(8)));
typedef float f32x4 __attribute__((ext_vector_type(4)));
typedef unsigned u32x4 __attribute__((ext_vector_type(4)));
constexpr int BM = 256, BK = 64, HALF = 128, HTB = HALF * BK * 2  , STAGE_BYTES = 8 * HTB, NXCD = 8, WGM = 8;

__host__ __device__ __forceinline__ int lds_byte(int r, int c) { const int st = (r >> 4) * 2 + (c >> 5), rr = r & 15, cc = c & 31, ob = rr * 64 + cc * 2; return st * 1024 + (ob ^ (((ob >> 9) & 1) << 5)); }
__host__ __device__ __forceinline__ void stage_rc(int b, int& R, int& C) { const int st = b / 1024, sb = b % 1024, swz = sb ^ (((sb >> 9) & 1) << 5); R = (st >> 1) * 16 + swz / 64; C = (st & 1) * 32 + (swz % 64) / 2; }
__host__ __device__ __forceinline__ int perm32(int rho) { const int n = rho >> 4, i = rho & 15; return 8 * (i >> 2) + 4 * n + (i & 3); }

struct Unit { int pm, pn; };
struct Gemm { const bf16_t* A; const bf16_t* Bt; int M, N, K; };

struct StaticOrder {
    int nM, nN, nwg, G, c;
    __host__ __device__ void init(int M, int N, int G_, int c_) { nM = M / BM; nN = N / BM; nwg = nM * nN; G = G_; c = c_; }
    __host__ __device__ bool next(int i, Unit& u) const {
        const long L = (long)i * G + c; if (L >= nwg) return false;
        int wgid = (int)L; { const int q = nwg / NXCD, r = nwg % NXCD, xcd = wgid % NXCD, off = wgid / NXCD; wgid = (xcd < r ? xcd * (q + 1) : r * (q + 1) + (xcd - r) * q) + off; }
        const int nig = WGM * nN, gid = wgid / nig, fm = gid * WGM, gsz = (nM - fm) < WGM ? (nM - fm) : WGM;
        u.pm = fm + ((wgid % nig) % gsz); u.pn = (wgid % nig) / gsz; return true;
    }
    __device__ __forceinline__ void a_ready(const Unit&) const {}
    __device__ __forceinline__ void done(const Unit&) const {}
};

__device__ __forceinline__ unsigned cvt_pk_bf16(float lo, float hi) { unsigned r; asm volatile("v_cvt_pk_bf16_f32 %0, %1, %2" : "=v"(r) : "v"(lo), "v"(hi)); return r; }
typedef unsigned u32x2 __attribute__((ext_vector_type(2)));

struct GroupedOrder {
    int upe, nNe, nwg, G, c;
    __host__ __device__ void init(int nNe_, int G_, int c_) { nNe = nNe_; upe = 8 * nNe_; nwg = 16 * upe; G = G_; c = c_; }
    __host__ __device__ bool next(int i, Unit& u) const {
        const long L = (long)i * G + c; if (L >= nwg) return false;
        int wgid = (int)L; { const int q = nwg / NXCD, r = nwg % NXCD, xcd = wgid % NXCD, off = wgid / NXCD; wgid = (xcd < r ? xcd * (q + 1) : r * (q + 1) + (xcd - r) * q) + off; }
        const int e = wgid / upe, rr = wgid % upe;
        u.pm = e * 8 + (rr & 7); u.pn = e * nNe + (rr >> 3); return true;
    }
    __device__ __forceinline__ void a_ready(const Unit&) const {}
    __device__ __forceinline__ void done(const Unit&) const {}
};

struct EpiStoreBf16 {
    static constexpr bool PERM = true, AFTER_DRAIN = false;
    bf16_t* O; int ldc;
    __device__ __forceinline__ void operator()(const f32x4 (&acc)[2][2][4][2], const Unit& u, int wr, int wc, int fr, int fq) const {
        const int row0 = u.pm * BM + wr * 64 + fr, col0 = u.pn * BM + wc * 32 + 8 * fq;
#pragma unroll
        for (int ai = 0; ai < 2; ++ai)
#pragma unroll
            for (int m = 0; m < 4; ++m) { const int row = row0 + ai * HALF + m * 16;
                bf16_t* rowp = O + ((size_t)(row >> 7) * (ldc >> 6) + (col0 >> 6)) * 8192 + (row & 127) * 64 + (col0 & 63);
#pragma unroll
                for (int bj = 0; bj < 2; ++bj) { const f32x4 v0 = acc[ai][bj][m][0], v1 = acc[ai][bj][m][1];
                    u32x4 w; w.x = cvt_pk_bf16(v0[0], v0[1]); w.y = cvt_pk_bf16(v0[2], v0[3]); w.z = cvt_pk_bf16(v1[0], v1[1]); w.w = cvt_pk_bf16(v1[2], v1[3]);
                    *(u32x4*)(rowp + bj * 2 * 8192) = w; } }
    }
};
struct EpiResF32 {
    static constexpr bool PERM = false, AFTER_DRAIN = false;
    const bf16_t* base; float* O; int ldc; float alpha;
    __device__ __forceinline__ void operator()(const f32x4 (&acc)[2][2][4][2], const Unit& u, int wr, int wc, int fr, int fq) const {
        const int row0 = u.pm * BM + wr * 64 + fr, col0 = u.pn * BM + wc * 32 + 4 * fq;
#pragma unroll
        for (int ai = 0; ai < 2; ++ai)
#pragma unroll
            for (int m = 0; m < 4; ++m) { const size_t ro = (size_t)(row0 + ai * HALF + m * 16) * ldc + col0;
#pragma unroll
                for (int bj = 0; bj < 2; ++bj)
#pragma unroll
                    for (int n = 0; n < 2; ++n) { const u32x2 bw = *(const u32x2*)(base + ro + bj * HALF + 16 * n);
                        f32x4 b; b[0] = __uint_as_float(bw.x << 16); b[1] = __uint_as_float(bw.x & 0xffff0000u); b[2] = __uint_as_float(bw.y << 16); b[3] = __uint_as_float(bw.y & 0xffff0000u);
                        *(f32x4*)(O + ro + bj * HALF + 16 * n) = b * alpha + acc[ai][bj][m][n]; } }
    }
};
struct EpiSwiGLU {
    static constexpr bool PERM = true, AFTER_DRAIN = false;
    bf16_t* O; int ldc; int ntn;
    __device__ __forceinline__ void operator()(const f32x4 (&acc)[2][2][4][2], const Unit& u, int wr, int wc, int fr, int fq) const {
        const int row0 = u.pm * BM + wr * 64 + fr, col0 = (u.pn % ntn) * HALF + wc * 32 + 8 * fq;
#pragma unroll
        for (int ai = 0; ai < 2; ++ai)
#pragma unroll
            for (int m = 0; m < 4; ++m) { const int row = row0 + ai * HALF + m * 16;
                bf16_t* rowp = O + ((size_t)(row >> 7) * (ldc >> 6) + (col0 >> 6)) * 8192 + (row & 127) * 64 + (col0 & 63);
                float h[8];
#pragma unroll
                for (int n = 0; n < 2; ++n) { const f32x4 g = acc[ai][0][m][n], up = acc[ai][1][m][n];
#pragma unroll
                    for (int j = 0; j < 4; ++j) h[4 * n + j] = g[j] * up[j] * __builtin_amdgcn_rcpf(1.f + __expf(-g[j])); }
                u32x4 w; w.x = cvt_pk_bf16(h[0], h[1]); w.y = cvt_pk_bf16(h[2], h[3]); w.z = cvt_pk_bf16(h[4], h[5]); w.w = cvt_pk_bf16(h[6], h[7]);
                *(u32x4*)rowp = w; }
    }
};
struct EpiScaleRow {
    static constexpr bool PERM = true, AFTER_DRAIN = false;
    bf16_t* O; int ldc; int ntn; const float* gate;
    __device__ __forceinline__ void operator()(const f32x4 (&acc)[2][2][4][2], const Unit& u, int wr, int wc, int fr, int fq) const {
        const int row0 = u.pm * BM + wr * 64 + fr, col0 = (u.pn % ntn) * BM + wc * 32 + 8 * fq;
#pragma unroll
        for (int ai = 0; ai < 2; ++ai)
#pragma unroll
            for (int m = 0; m < 4; ++m) { const int row = row0 + ai * HALF + m * 16; const float gsc = gate[row]; bf16_t* rowp = O + (size_t)row * ldc + col0;
#pragma unroll
                for (int bj = 0; bj < 2; ++bj) { const f32x4 v0 = acc[ai][bj][m][0] * gsc, v1 = acc[ai][bj][m][1] * gsc;
                    u32x4 w; w.x = cvt_pk_bf16(v0[0], v0[1]); w.y = cvt_pk_bf16(v0[2], v0[3]); w.z = cvt_pk_bf16(v1[0], v1[1]); w.w = cvt_pk_bf16(v1[2], v1[3]);
                    *(u32x4*)(rowp + bj * HALF) = w; } }
    }
};
template <class Epi, class Sched, bool ALIGN_EPI = false, bool SP2 = false, bool GATHER = false, bool ABLK = false>
__device__ __forceinline__ void gemm_phase(PG8_LAS unsigned char* lds, const Gemm g, const Sched& S, const Epi& E, const int* __restrict__ rowidx = nullptr) {
    static_assert(!GATHER || SP2, "GATHER is implemented for the SP2 loop");
    int tid_ = threadIdx.x; asm volatile("" : "+v"(tid_)); const int tid = tid_, wid = __builtin_amdgcn_readfirstlane(tid >> 6), lane = tid & 63, wr = wid >> 2, wc = wid & 3, fr = lane & 15, fq = lane >> 4;
    const int K = g.K, nt = K / BK;
    unsigned voffA[2], voffB[2];
#pragma unroll
    for (int i = 0; i < 2; ++i) { int R, C; stage_rc(tid * 16 + i * 8192, R, C); const int Rb = Epi::PERM ? ((R & ~31) + perm32(R & 31)) : R;
        voffA[i] = ABLK ? (unsigned)(R * BK + C) * 2u : (unsigned)(R * K + C) * 2u; voffB[i] = (unsigned)(Rb * BK + C) * 2u; }
    int gR[2], gCc[2];
#pragma unroll
    for (int i = 0; i < 2; ++i) { int R, C; stage_rc(tid * 16 + i * 8192, R, C); gR[i] = R; gCc[i] = C * 2; }
    unsigned gC[2][2], gN[2][2];
#define PG8_GOFF(dst, pmv) do { _Pragma("unroll") for (int _h = 0; _h < 2; ++_h) _Pragma("unroll") for (int _i = 0; _i < 2; ++_i) \
        dst[_h][_i] = (unsigned)rowidx[(pmv) * BM + _h * HALF + gR[_i]] * (unsigned)(K * 2) + (unsigned)gCc[_i]; } while (0)
    const size_t kstep = (size_t)(BK * 2);
    const size_t kstepB = (size_t)(HALF * BK * 2);
    const size_t kstepA = ABLK ? (size_t)(HALF * BK * 2) : kstep;
    const size_t hstep = (size_t)HALF * K * 2;
    const size_t tstep = 2 * hstep;
    const unsigned ldsw = (unsigned)wid * 1024u;
    const int aoff = lds_byte(wr * 64 + fr, fq * 8), boff = lds_byte(wc * 32 + fr, fq * 8);
#define PG8_SA(b, h) (((b) * 2 + (h)) * HTB)
#define PG8_SB(b, h) ((4 + (b) * 2 + (h)) * HTB)
#define PG8_STAGE(bufoff, gbase, voff) do { _Pragma("unroll") for (int _i = 0; _i < 2; ++_i) \
        __builtin_amdgcn_global_load_lds((const unsigned*)((const char*)(gbase) + (voff)[_i]), (PG8_LAS unsigned*)(lds + (bufoff) + ldsw + _i * 8192), 16, 0, 0); } while (0)
#define PG8_STAGE_A(bufoff, gbase, h, nx) do { if constexpr (GATHER) { unsigned _o[2]; _o[0] = (nx) ? gN[h][0] : gC[h][0]; _o[1] = (nx) ? gN[h][1] : gC[h][1]; PG8_STAGE(bufoff, gbase, _o); } \
        else { PG8_STAGE(bufoff, (gbase) + (h) * hstep, voffA); } } while (0)
#define PG8_LDA(dst, b, h) do { _Pragma("unroll") for (int m = 0; m < 4; ++m) _Pragma("unroll") for (int k = 0; k < 2; ++k) dst[m][k] = *(const PG8_LAS bf16x8*)(lds + PG8_SA(b, h) + aoff + m * 2048 + k * 1024); } while (0)
#define PG8_LDB(dst, b, h) do { _Pragma("unroll") for (int n = 0; n < 2; ++n) _Pragma("unroll") for (int k = 0; k < 2; ++k) dst[n][k] = *(const PG8_LAS bf16x8*)(lds + PG8_SB(b, h) + boff + n * 2048 + k * 1024); } while (0)
#define PG8_MMA(ai, bj, At, Bt) do { __builtin_amdgcn_s_setprio(1); _Pragma("unroll") for (int m = 0; m < 4; ++m) _Pragma("unroll") for (int n = 0; n < 2; ++n) _Pragma("unroll") for (int k = 0; k < 2; ++k) \
        acc[ai][bj][m][n] = __builtin_amdgcn_mfma_f32_16x16x32_bf16(Bt[n][k], At[m][k], acc[ai][bj][m][n], 0, 0, 0); __builtin_amdgcn_s_setprio(0); } while (0)
#define PG8_WAIT_V(n) asm volatile("s_waitcnt vmcnt(" #n ")" ::: "memory")
#define PG8_WAIT_L(n) asm volatile("s_waitcnt lgkmcnt(" #n ")" ::: "memory")
#define PG8_BAR __builtin_amdgcn_s_barrier()
#define PG8_SCHED __builtin_amdgcn_sched_barrier(0)
    Unit cur, nxt; int ui = 0;
    if (!S.next(0, cur)) return;
    f32x4 acc[2][2][4][2];
#pragma unroll
    for (int a = 0; a < 2; ++a)
#pragma unroll
        for (int b = 0; b < 2; ++b)
#pragma unroll
            for (int m = 0; m < 4; ++m)
#pragma unroll
                for (int n = 0; n < 2; ++n) acc[a][b][m][n] = (f32x4){0.f, 0.f, 0.f, 0.f};
    bf16x8 At[4][2], B0[2][2], B1[2][2];
    const char* cA = GATHER ? (const char*)g.A : (const char*)g.A + (size_t)cur.pm * tstep; const char* cB = (const char*)g.Bt + (size_t)cur.pn * tstep;
    if constexpr (GATHER) { PG8_GOFF(gC, cur.pm); PG8_GOFF(gN, cur.pm); }
    S.a_ready(cur);
    if constexpr (SP2) {
        PG8_STAGE(PG8_SB(0, 0), cB, voffB); PG8_STAGE(PG8_SB(0, 1), cB + hstep, voffB); PG8_STAGE_A(PG8_SA(0, 0), cA, 0, false); PG8_STAGE_A(PG8_SA(0, 1), cA, 1, false);
        if (wr == 1) PG8_BAR;
        PG8_WAIT_V(2); PG8_BAR;
        PG8_STAGE(PG8_SB(1, 0), cB + kstepB, voffB); PG8_STAGE_A(PG8_SA(1, 0), cA + kstepA, 0, false); PG8_STAGE(PG8_SB(1, 1), cB + hstep + kstepB, voffB);
        PG8_WAIT_V(6); PG8_BAR;
    } else {
        PG8_STAGE(PG8_SB(0, 0), cB, voffB); PG8_STAGE(PG8_SA(0, 0), cA, voffA); PG8_STAGE(PG8_SB(0, 1), cB + hstep, voffB); PG8_STAGE(PG8_SA(0, 1), cA + hstep, voffA);
        if (wr == 1) PG8_BAR;
        PG8_WAIT_V(4); PG8_BAR;
        PG8_STAGE(PG8_SB(1, 0), cB + kstepB, voffB); PG8_STAGE(PG8_SA(1, 0), cA + kstep, voffA); PG8_STAGE(PG8_SB(1, 1), cB + hstep + kstepB, voffB);
        PG8_WAIT_V(6); PG8_BAR;
    }
    for (;;) {
        const bool has_next = S.next(ui + 1, nxt);
        const char* nA = GATHER ? cA : (has_next ? (const char*)g.A + (size_t)nxt.pm * tstep : cA); const char* nB = has_next ? (const char*)g.Bt + (size_t)nxt.pn * tstep : cB;
        if constexpr (GATHER) { if (has_next) PG8_GOFF(gN, nxt.pm); }
        for (int t = 0; t < nt; t += 2) {
            const bool last = (t == nt - 2);
            const char* a1 = cA + (size_t)(t + 1) * kstepA;
            const char* a2 = last ? nA : cA + (size_t)(t + 2) * kstepA; const char* b2 = last ? nB : cB + (size_t)(t + 2) * kstepB;
            const char* a3 = a2 + kstepA; const char* b3 = b2 + kstepB;
            if (last && has_next) S.a_ready(nxt);
            if constexpr (SP2) {
            PG8_LDB(B0, 0, 0); PG8_LDB(B1, 0, 1); PG8_SCHED; PG8_LDA(At, 0, 0); PG8_STAGE_A(PG8_SA(1, 1), a1, 1, false);
            PG8_WAIT_V(8); PG8_WAIT_L(0); PG8_BAR; PG8_MMA(0, 0, At, B0); PG8_MMA(0, 1, At, B1); PG8_BAR; PG8_SCHED;
            PG8_LDA(At, 0, 1); PG8_STAGE(PG8_SB(0, 0), b2, voffB); PG8_STAGE(PG8_SB(0, 1), b2 + hstep, voffB); PG8_STAGE_A(PG8_SA(0, 0), a2, 0, last);
            PG8_WAIT_V(8); PG8_WAIT_L(0); PG8_BAR; PG8_MMA(1, 0, At, B0); PG8_MMA(1, 1, At, B1); PG8_BAR; PG8_SCHED;
            PG8_LDB(B0, 1, 0); PG8_LDB(B1, 1, 1); PG8_SCHED; PG8_LDA(At, 1, 0); PG8_STAGE_A(PG8_SA(0, 1), a2, 1, last);
            PG8_WAIT_V(8); PG8_WAIT_L(0); PG8_BAR; PG8_MMA(0, 0, At, B0); PG8_MMA(0, 1, At, B1); PG8_BAR; PG8_SCHED;
            PG8_LDA(At, 1, 1); PG8_STAGE(PG8_SB(1, 0), b3, voffB); PG8_STAGE(PG8_SB(1, 1), b3 + hstep, voffB); PG8_STAGE_A(PG8_SA(1, 0), a3, 0, last);
            PG8_WAIT_V(8); PG8_WAIT_L(0); PG8_BAR; PG8_MMA(1, 0, At, B0); PG8_MMA(1, 1, At, B1); PG8_BAR; PG8_SCHED;
            } else {
            PG8_LDB(B0, 0, 0); PG8_SCHED; PG8_LDA(At, 0, 0); PG8_STAGE(PG8_SA(1, 1), a1 + hstep, voffA);
            PG8_WAIT_L(8); PG8_BAR; PG8_WAIT_L(0); PG8_MMA(0, 0, At, B0); PG8_BAR; PG8_SCHED;
            PG8_LDB(B1, 0, 1); PG8_STAGE(PG8_SB(0, 0), b2, voffB);
            PG8_BAR; PG8_WAIT_L(0); PG8_MMA(0, 1, At, B1); PG8_BAR;
            PG8_LDA(At, 0, 1); PG8_STAGE(PG8_SA(0, 0), a2, voffA);
            PG8_BAR; PG8_WAIT_L(0); PG8_MMA(1, 0, At, B0); PG8_BAR; PG8_SCHED;
            PG8_STAGE(PG8_SB(0, 1), b2 + hstep, voffB);
            PG8_WAIT_V(6); PG8_BAR; PG8_MMA(1, 1, At, B1); PG8_BAR;
            PG8_LDB(B0, 1, 0); PG8_SCHED; PG8_LDA(At, 1, 0); PG8_STAGE(PG8_SA(0, 1), a2 + hstep, voffA);
            PG8_WAIT_L(8); PG8_BAR; PG8_WAIT_L(0); PG8_MMA(0, 0, At, B0); PG8_BAR; PG8_SCHED;
            PG8_LDB(B1, 1, 1); PG8_STAGE(PG8_SB(1, 0), b3, voffB);
            PG8_BAR; PG8_WAIT_L(0); PG8_MMA(0, 1, At, B1); PG8_BAR;
            PG8_LDA(At, 1, 1); PG8_STAGE(PG8_SA(1, 0), a3, voffA);
            PG8_BAR; PG8_WAIT_L(0); PG8_MMA(1, 0, At, B0); PG8_BAR; PG8_SCHED;
            PG8_STAGE(PG8_SB(1, 1), b3 + hstep, voffB);
            PG8_WAIT_V(6); PG8_BAR; PG8_MMA(1, 1, At, B1); PG8_BAR;
            }
        }
        if constexpr (ALIGN_EPI) { if (wr == 0) PG8_BAR; }
        if constexpr (!Epi::AFTER_DRAIN) { E(acc, cur, wr, wc, fr, fq); S.done(cur); }
        if (!has_next) break;
#pragma unroll
        for (int a = 0; a < 2; ++a)
#pragma unroll
            for (int b = 0; b < 2; ++b)
#pragma unroll
                for (int m = 0; m < 4; ++m)
#pragma unroll
                    for (int n = 0; n < 2; ++n) acc[a][b][m][n] = (f32x4){0.f, 0.f, 0.f, 0.f};
        cur = nxt; cA = nA; cB = nB; ++ui;
        if constexpr (GATHER) { _Pragma("unroll") for (int _h = 0; _h < 2; ++_h) _Pragma("unroll") for (int _i = 0; _i < 2; ++_i) gC[_h][_i] = gN[_h][_i]; }
        if constexpr (ALIGN_EPI) { if (wr == 1) PG8_BAR; }
    }
    PG8_WAIT_V(0);
    if constexpr (!ALIGN_EPI) { if (wr == 0) PG8_BAR; }
    PG8_BAR;
    if constexpr (Epi::AFTER_DRAIN) { E.fused(acc, cur, wr, wc, fr, fq, lds, wid, lane); S.done(cur); }
#undef PG8_SA
#undef PG8_SB
#undef PG8_STAGE
#undef PG8_STAGE_A
#undef PG8_GOFF
#undef PG8_LDA
#undef PG8_LDB
#undef PG8_MMA
#undef PG8_WAIT_V
#undef PG8_WAIT_L
#undef PG8_BAR
#undef PG8_SCHED
}
}

using pg8::bf16_t; using pg8::bf16x8; using pg8::f32x4; using pg8::u32x4; using pg8::u32x2;
#define LAS __attribute__((address_space(3)))
typedef short bf16x4 __attribute__((ext_vector_type(4)));

constexpr int NB = 4, SEQ = 4096, DM = 1024, MTOK = NB * SEQ, DIN = 2048, NE = 16, FF = 2048, CAP = 512, NROWX = NE * NB * CAP;
constexpr float ALPHA = 1.41421356237309515f, LN_EPS = 1e-5f;
constexpr int NWAVES = 8, NTHR = 512;
constexpr int LDS_BYTES = 147456;
constexpr int S5T = 32, S5NCH = SEQ / S5T;

constexpr size_t MiB = 1u << 20;
constexpr size_t WS_WIN = 0, WS_WOUT = 8 * MiB, WS_WGLU = 12 * MiB, WS_S5TAB = 13 * MiB, WS_AFFT = 14 * MiB, WS_IDX = 15 * MiB, WS_GATE = 16 * MiB, WS_SLOT = 17 * MiB, WS_BAR = 18 * MiB, WS_S5BT = 19 * MiB, WS_S5CT = 20 * MiB;
constexpr size_t WS_WGU = 32 * MiB, WS_WD = 288 * MiB, WS_H32 = 416 * MiB, WS_HBF = 480 * MiB, WS_RA = 512 * MiB  , WS_RB = 576 * MiB  ;
constexpr size_t WS_HDN = 640 * MiB, WS_KVF = 768 * MiB, WS_KVB = 776 * MiB, WS_STF = 784 * MiB, WS_STB = 792 * MiB, WS_S5E = 800 * MiB, WS_S5C = 808 * MiB, WS_END = 816 * MiB;

struct Args { const float* in[25]; float* out; unsigned char* ws; int ph_lo, ph_hi; };

typedef __bf16 bf16x2_hw __attribute__((ext_vector_type(2)));
typedef float f32x2_hw __attribute__((ext_vector_type(2)));
__device__ __forceinline__ unsigned pk2(float lo, float hi) { const f32x2_hw v = {lo, hi}; const bf16x2_hw b = __builtin_convertvector(v, bf16x2_hw); return __builtin_bit_cast(unsigned, b); }
__device__ __forceinline__ unsigned f2bf(float f) { return pk2(f, 0.f) & 0xffffu; }
__device__ __forceinline__ float bflo(unsigned w) { return __uint_as_float(w << 16); }
__device__ __forceinline__ float bfhi(unsigned w) { return __uint_as_float(w & 0xffff0000u); }
__device__ __forceinline__ f32x4 mfma16(bf16x8 a, bf16x8 b, f32x4 c) { return __builtin_amdgcn_mfma_f32_16x16x32_bf16(a, b, c, 0, 0, 0); }
__device__ __forceinline__ float wave_sum(float v) {
#pragma unroll
    for (int o = 1; o < 64; o <<= 1) v += __shfl_xor(v, o);
    return v;
}
__device__ __forceinline__ bf16x8 pack8(const f32x4& a, const f32x4& b) {
    u32x4 w; w.x = pk2(a[0], a[1]); w.y = pk2(a[2], a[3]); w.z = pk2(b[0], b[1]); w.w = pk2(b[2], b[3]);
    return __builtin_bit_cast(bf16x8, w);
}
__device__ __forceinline__ bf16x8 cat8(bf16x4 lo, bf16x4 hi) { bf16x8 r; r[0] = lo[0]; r[1] = lo[1]; r[2] = lo[2]; r[3] = lo[3]; r[4] = hi[0]; r[5] = hi[1]; r[6] = hi[2]; r[7] = hi[3]; return r; }
#define LDS_WAIT() asm volatile("s_waitcnt lgkmcnt(0)" ::: "memory")
#define PROJ_AT(P, row, col) ((P) + ((size_t)((row) >> 7) * 32 + ((col) >> 6)) * 8192 + ((row) & 127) * 64 + ((col) & 63))

struct ConvItem { const float* srcp; bf16_t* dstp; int N; int rstep; };
__device__ __forceinline__ ConvItem conv_decode(const Args& a, int it, int lane) {
    constexpr int I3 = 16384, I4 = 16384, I5 = 16384, I0 = 1024, I1 = 512;
    unsigned char* ws = a.ws;
    const float* src; bf16_t* dst; int K, N, rmul = 1, ro = 0, kb, nb;
    int r = it;
    if (r < I3 + I4) { const int up = r >= I3; r -= up ? I3 : 0; const int mat = r >> 9, q = r & 511; src = (up ? a.in[21] : a.in[20]) + (size_t)mat * DM * FF; dst = (bf16_t*)(ws + WS_WGU) + (size_t)mat * 2 * FF * DM; K = DM; N = FF; rmul = 2; ro = up; kb = q >> 5; nb = q & 31; }
    else { r -= I3 + I4;
        if (r < I5) { const int mat = r >> 9, q = r & 511; src = a.in[22] + (size_t)mat * FF * DM; dst = (bf16_t*)(ws + WS_WD) + (size_t)mat * DM * FF; K = FF; N = DM; kb = q >> 4; nb = q & 15; }
        else { r -= I5;
            if (r < I0) { const int mat = r >> 9, q = r & 511; src = a.in[3] + (size_t)mat * DM * DIN; dst = (bf16_t*)(ws + WS_WIN) + (size_t)mat * DIN * DM; K = DM; N = DIN; kb = q >> 5; nb = q & 31; }
            else { r -= I0;
                if (r < I1) { const int mat = r >> 8, q = r & 255; src = a.in[16] + (size_t)mat * DM * DM; dst = (bf16_t*)(ws + WS_WOUT) + (size_t)mat * DM * DM; K = DM; N = DM; kb = q >> 4; nb = q & 15; }
                else { r -= I1; const int mat = r >> 4, q = r & 15; src = a.in[13] + (size_t)mat * 65536; dst = (bf16_t*)(ws + WS_WGLU) + (size_t)mat * 65536; K = 256; N = 256; kb = q >> 2; nb = q & 3; } } } }
    ConvItem c; c.N = N;
    c.srcp = src + (size_t)(kb * 64 + (lane >> 4)) * N + nb * 64 + (lane & 15) * 4;
    {
        const int brow = (rmul == 2) ? ((nb >> 1) * 256 + ro * 128 + (nb & 1) * 64) : nb * 64;
        if (K == 256) { c.dstp = dst + (size_t)brow * K + kb * 64; c.rstep = K; }
        else { c.dstp = dst + ((size_t)(brow >> 7) * (K >> 6) + kb) * 8192 + (brow & 127) * 64; c.rstep = 64; }
    }
    return c;
}
__device__ __forceinline__ void conv_load(const ConvItem& c, f32x4 (&v)[16]) {
#pragma unroll
    for (int i = 0; i < 16; ++i) v[i] = __builtin_nontemporal_load((const f32x4*)(c.srcp + (size_t)(i * 4) * c.N));
}
__device__ __forceinline__ void conv_store(const ConvItem& c, const f32x4 (&v)[16], LAS float* scr, int lane) {
    const int r4 = lane >> 4, c4 = (lane & 15) * 4;
#pragma unroll
    for (int i = 0; i < 16; ++i) { const int kk = i * 4 + r4; *(LAS f32x4*)(scr + kk * 68 + (c4 ^ (((kk >> 3) & 7) * 4))) = v[i]; }
    LDS_WAIT();
    const int cc = lane & 7, nl = lane >> 3;
#pragma unroll
    for (int p = 0; p < 8; ++p) {
        const int n = nl + 8 * p;
        const LAS float* s = scr + (8 * cc) * 68 + (n ^ (4 * cc));
        u32x4 o; o.x = pk2(s[0], s[68]); o.y = pk2(s[2 * 68], s[3 * 68]); o.z = pk2(s[4 * 68], s[5 * 68]); o.w = pk2(s[6 * 68], s[7 * 68]);
        *(u32x4*)(c.dstp + (size_t)n * c.rstep + 8 * cc) = o;
    }
    LDS_WAIT();
}
__device__ __forceinline__ void sincos_rev(double f, double& sn, double& cs) {
    const double a = f * 6.283185307179586476925;
    const double q = rint(a * 0.636619772367581343);
    const double r = a - q * 1.570796326794896619;
    const double r2 = r * r;
    double s = -7.6471637318198164759e-13; s = s * r2 + 1.6059043836821614599e-10; s = s * r2 - 2.5052108385441718775e-8; s = s * r2 + 2.7557319223985890653e-6;
    s = s * r2 - 1.9841269841269841270e-4; s = s * r2 + 8.3333333333333333333e-3; s = s * r2 - 1.6666666666666666667e-1; s = s * r2 * r + r;
    double c = 4.7794773323873852974e-14; c = c * r2 - 1.1470745597729724714e-11; c = c * r2 + 2.0876756987868098979e-9; c = c * r2 - 2.7557319223985890653e-7;
    c = c * r2 + 2.4801587301587301587e-5; c = c * r2 - 1.3888888888888888889e-3; c = c * r2 + 4.1666666666666666667e-2; c = c * r2 - 0.5; c = c * r2 + 1.0;
    const int qi = ((int)q) & 3;
    sn = (qi == 0) ? s : (qi == 1) ? c : (qi == 2) ? -s : -c;
    cs = (qi == 0) ? c : (qi == 1) ? -s : (qi == 2) ? -c : s;
}
__device__ __forceinline__ double exp_small(double x) {
    const double y = x * (1.0 / 64.0);
    double e = 1.0 / 479001600.0;
    e = e * y + 1.0 / 39916800.0; e = e * y + 1.0 / 3628800.0; e = e * y + 1.0 / 362880.0; e = e * y + 1.0 / 40320.0; e = e * y + 1.0 / 5040.0; e = e * y + 1.0 / 720.0;
    e = e * y + 1.0 / 120.0; e = e * y + 1.0 / 24.0; e = e * y + 1.0 / 6.0; e = e * y + 0.5; e = e * y + 1.0; e = e * y + 1.0;
#pragma unroll
    for (int i = 0; i < 6; ++i) e = e * e;
    return e;
}
__device__ __forceinline__ void s5_coefs(const Args& a, int t, double& br, double& bi, double& cr, double& ci, double& tr, double& ti) {
    const int g = (t >> 6) & 15, lr = t >> 10;
    const double lre = (double)a.in[5][t], lim = (double)a.in[6][t];
    const double step = exp_small((double)a.in[7][lr * 16 + g]);
    const double ar = lre * step, th = lim * step;
    const double rev = th * 0.15915494309189533577; const double fr = rev - rint(rev);
    double sn, cs; sincos_rev(fr, sn, cs);
    const double mag = exp_small(ar);
    br = mag * cs; bi = mag * sn;
    const double nr = br - 1.0, ni = bi, den = lre * lre + lim * lim;
    cr = (nr * lre + ni * lim) / den; ci = (ni * lre - nr * lim) / den;
    const double rev2 = rev * (double)S5T; const double fr2 = rev2 - rint(rev2);
    double sn2, cs2; sincos_rev(fr2, sn2, cs2);
    const double mag2 = exp_small(ar * (double)S5T);
    tr = mag2 * cs2; ti = mag2 * sn2;
}
__device__ __forceinline__ void s5_table_entry(const Args& a, int t) {
    double br, bi, cr, ci, tr, ti; s5_coefs(a, t, br, bi, cr, ci, tr, ti);
    float* o = (float*)(a.ws + WS_S5TAB) + (size_t)t * 8;
    o[0] = (float)br; o[1] = (float)bi; o[2] = (float)cr; o[3] = (float)ci; o[4] = (float)tr; o[5] = (float)ti; o[6] = 0.f; o[7] = 0.f;
}
__device__ __forceinline__ void s5_bt_row(const Args& a, int t) {
    const int l = t >> 12, g = (t >> 8) & 15, n = t & 255, r = n >> 7, p = (n >> 1) & 63, ri = n & 1;
    double br, bi, cr, ci, tr, ti; s5_coefs(a, ((l * 2 + r) * 16 + g) * 64 + p, br, bi, cr, ci, tr, ti);
    const float crf = (float)cr, cif = (float)ci;
    const float* bre = a.in[8] + (size_t)((l * 16 + g) * 64 + p) * 16; const float* bim = a.in[9] + (size_t)((l * 16 + g) * 64 + p) * 16;
    u32x4 o[2];
#pragma unroll
    for (int h = 0; h < 2; ++h) {
        const f32x4 x0 = *(const f32x4*)(bre + 8 * h), x1 = *(const f32x4*)(bre + 8 * h + 4), y0 = *(const f32x4*)(bim + 8 * h), y1 = *(const f32x4*)(bim + 8 * h + 4);
        float v[8];
#pragma unroll
        for (int k = 0; k < 4; ++k) { v[k] = ri ? (crf * y0[k] + cif * x0[k]) : (crf * x0[k] - cif * y0[k]); v[4 + k] = ri ? (crf * y1[k] + cif * x1[k]) : (crf * x1[k] - cif * y1[k]); }
        o[h].x = pk2(v[0], v[1]); o[h].y = pk2(v[2], v[3]); o[h].z = pk2(v[4], v[5]); o[h].w = pk2(v[6], v[7]);
    }
    u32x4* dst = (u32x4*)((bf16_t*)(a.ws + WS_S5BT) + (size_t)t * 32);
    dst[0] = o[0]; dst[1] = o[1]; dst[2] = (u32x4){0u, 0u, 0u, 0u}; dst[3] = (u32x4){0u, 0u, 0u, 0u};
}
__device__ __forceinline__ void s5_ct_entry(const Args& a, int t) {
    const int p = t & 63, r = (t >> 6) & 1, c = (t >> 7) & 15, g = (t >> 11) & 15, l = t >> 15;
    const size_t ci = (size_t)(((l * 2 + r) * 16 + g) * 16 + c) * 64 + p;
    ((unsigned*)(a.ws + WS_S5CT))[t] = pk2(a.in[10][ci], -a.in[11][ci]);
}
__device__ __forceinline__ void ln_rows4(f32x4 (&v)[4], const float* __restrict__ g, const float* __restrict__ bt, int lane) {
    float s = 0.f;
#pragma unroll
    for (int j = 0; j < 4; ++j) s += (v[j][0] + v[j][1]) + (v[j][2] + v[j][3]);
    const float mean = wave_sum(s) * (1.f / DM); float s2 = 0.f;
#pragma unroll
    for (int j = 0; j < 4; ++j) { v[j] = v[j] - mean; s2 += (v[j][0] * v[j][0] + v[j][1] * v[j][1]) + (v[j][2] * v[j][2] + v[j][3] * v[j][3]); }
    const float rstd = 1.f / sqrtf(wave_sum(s2) * (1.f / DM) + LN_EPS);
#pragma unroll
    for (int j = 0; j < 4; ++j) { const f32x4 gv = ((const f32x4*)g)[lane + 64 * j], bv = ((const f32x4*)bt)[lane + 64 * j]; v[j] = v[j] * rstd * gv + bv; }
}
__device__ __forceinline__ void store_row(const f32x4 (&v)[4], float* o32, bf16_t* obf, int lane) {
#pragma unroll
    for (int j = 0; j < 4; ++j) {
        if (o32) ((f32x4*)o32)[lane + 64 * j] = v[j];
        if (obf) { u32x2 w; w.x = pk2(v[j][0], v[j][1]); w.y = pk2(v[j][2], v[j][3]); ((u32x2*)obf)[lane + 64 * j] = w; }
    }
}
__device__ __forceinline__ void phase_p0(const Args& a, LAS unsigned char* lds, int tid) {
    const int lane = tid & 63, wave = tid >> 6;
    const int gw = blockIdx.x * NWAVES + wave, NGW = gridDim.x * NWAVES;
    LAS float* scr = (LAS float*)(lds + wave * 17408);
    unsigned char* ws = a.ws;
    constexpr int NIT = 16384 * 3 + 1024 + 512 + 32;
    if (gw < NIT) {
        ConvItem cur = conv_decode(a, gw, lane);
        f32x4 v[16]; conv_load(cur, v);
        for (int it = gw; it < NIT; it += NGW) {
            const bool more = (it + NGW) < NIT;
            ConvItem nxt = cur; f32x4 vn[16];
            if (more) { nxt = conv_decode(a, it + NGW, lane); conv_load(nxt, vn); }
            conv_store(cur, v, scr, lane);
            if (more) { cur = nxt;
#pragma unroll
                for (int i = 0; i < 16; ++i) v[i] = vn[i]; }
        }
    }
    for (int t = blockIdx.x * NTHR + tid; t < 4096; t += gridDim.x * NTHR) s5_table_entry(a, t);
    for (int t = blockIdx.x * NTHR + tid; t < 8192; t += gridDim.x * NTHR) s5_bt_row(a, t);
    for (int t = blockIdx.x * NTHR + tid; t < 65536; t += gridDim.x * NTHR) s5_ct_entry(a, t);
    for (int m = gw; m < MTOK; m += NGW) {
        f32x4 v[4];
#pragma unroll
        for (int j = 0; j < 4; ++j) v[j] = ((const f32x4*)(a.in[0] + (size_t)m * DM))[lane + 64 * j];
        ln_rows4(v, a.in[1], a.in[2], lane);
        store_row(v, nullptr, (bf16_t*)(ws + WS_HBF) + (size_t)m * DM, lane);
    }
}

__device__ __forceinline__ void attn_item(int item, const bf16_t* __restrict__ proj, bf16_t* __restrict__ mix, const float* __restrict__ sink_l, LAS unsigned char* lds, int tid) {
    const int kh = item & 1, c = (item >> 1) & 31, b = item >> 6;
    constexpr int VS = 408;
    LAS bf16_t* Ks = (LAS bf16_t*)lds;
    LAS bf16_t* Vt = (LAS bf16_t*)(lds + 384 * 72 * 2);
    const int lane = tid & 63, w = tid >> 6, fr = lane & 15, fq = lane >> 4;
    const int hq = kh * 4 + (w >> 1);
    const bf16_t* qbase = PROJ_AT(proj, b * SEQ + c * 128 + (w & 1) * 64 + fr, 1280 + hq * 64 + fq * 8);
    bf16x8 qn0 = *(const bf16x8*)qbase, qn1 = *(const bf16x8*)(qbase + 32);
#pragma unroll
    for (int i = 0; i < 6; ++i) {
        const int id = tid + NTHR * i, key = id >> 3, ch = id & 7;
        const int s = (c - 1) * 128 + key; const bool ok = (s >= 0) && (s < SEQ);
        u32x4 kv = {0u, 0u, 0u, 0u}, vv = {0u, 0u, 0u, 0u};
        if (ok) { kv = *(const u32x4*)PROJ_AT(proj, b * SEQ + s, 1792 + kh * 64 + ch * 8); vv = *(const u32x4*)PROJ_AT(proj, b * SEQ + s, 1920 + kh * 64 + ch * 8); }
        *(LAS u32x4*)(Ks + key * 72 + ch * 8) = kv;
        LAS bf16_t* vp = Vt + (ch * 8) * VS + key;
        vp[0 * VS] = (bf16_t)(vv.x & 0xffffu); vp[1 * VS] = (bf16_t)(vv.x >> 16); vp[2 * VS] = (bf16_t)(vv.y & 0xffffu); vp[3 * VS] = (bf16_t)(vv.y >> 16);
        vp[4 * VS] = (bf16_t)(vv.z & 0xffffu); vp[5 * VS] = (bf16_t)(vv.z >> 16); vp[6 * VS] = (bf16_t)(vv.w & 0xffffu); vp[7 * VS] = (bf16_t)(vv.w >> 16);
    }
    if (tid < 128) { const int d = tid >> 1, hh = tid & 1; *(LAS u32x4*)(Vt + d * VS + 384 + hh * 8) = (u32x4){0u, 0u, 0u, 0u}; }
    __syncthreads();
    const float slope = exp2f(-(float)(hq + 1));
    const float sinkv = sink_l[hq];
    const bool lo_ok = (c >= 1), hi_ok = (c <= 30);
    float plo[4], phi[4];
#pragma unroll
    for (int j = 0; j < 4; ++j) { plo[j] = (fq * 4 + j >= fr) ? 0.f : -1e30f; phi[j] = (fq * 4 + j <= fr) ? 0.f : -1e30f; }
#pragma unroll 1
    for (int qi = 0; qi < 4; ++qi) {
        const int qt = (w & 1) * 4 + qi;
        const size_t tok = (size_t)b * SEQ + c * 128 + qt * 16 + fr;
        const bf16x8 qa0 = qn0, qa1 = qn1;
        float slope_l = slope; asm volatile("" : "+v"(slope_l));
        float sd[4];
#pragma unroll
        for (int j = 0; j < 4; ++j) sd[j] = slope_l * (float)(fq * 4 + j - fr);
        if (qi < 3) { const bf16_t* qp = qbase + (size_t)(qi + 1) * 16 * 64; qn0 = *(const bf16x8*)qp; qn1 = *(const bf16x8*)(qp + 32); }
        f32x4 s[18];
        float mx = sinkv;
        const LAS bf16_t* kbase = Ks + (qt * 16 + fr) * 72 + fq * 8;
        const LAS bf16_t* vbase = Vt + fr * VS + qt * 16 + fq * 4;
#pragma unroll
        for (int i = 0; i < 17; ++i) {
            const int kt = qt + i;
            const LAS bf16_t* kp = kbase + i * (16 * 72);
            f32x4 acc = {0.f, 0.f, 0.f, 0.f};
            acc = mfma16(*(const LAS bf16x8*)kp, qa0, acc); acc = mfma16(*(const LAS bf16x8*)(kp + 32), qa1, acc);
            const float pblk = ((kt < 8) ? lo_ok : ((kt >= 16) ? hi_ok : true)) ? 0.f : -1e30f;
            const float base = slope_l * (float)(16 * i - 128);
#pragma unroll
            for (int j = 0; j < 4; ++j) {
                float t = (i < 8) ? (base + sd[j]) : ((i > 8) ? -(base + sd[j]) : -fabsf(sd[j]));
                if (i == 0) t += plo[j];
                if (i == 16) t += phi[j];
                const float v = fmaf(acc[j], 0.125f, t + pblk);
                acc[j] = v; mx = fmaxf(mx, v);
            }
            s[i] = acc;
        }
        mx = fmaxf(mx, __shfl_xor(mx, 16)); mx = fmaxf(mx, __shfl_xor(mx, 32));
        float sum = 0.f;
#pragma unroll
        for (int i = 0; i < 17; ++i)
#pragma unroll
            for (int j = 0; j < 4; ++j) { const float p = __expf(s[i][j] - mx); s[i][j] = p; sum += p; }
        s[17] = (f32x4){0.f, 0.f, 0.f, 0.f};
        sum += __shfl_xor(sum, 16); sum += __shfl_xor(sum, 32);
        const float inv = 1.f / (sum + __expf(sinkv - mx));
        f32x4 o[4];
#pragma unroll
        for (int dt = 0; dt < 4; ++dt) o[dt] = (f32x4){0.f, 0.f, 0.f, 0.f};
#pragma unroll
        for (int kk = 0; kk < 9; ++kk) {
            const bf16x8 pb = pack8(s[2 * kk], s[2 * kk + 1]);
#pragma unroll
            for (int dt = 0; dt < 4; ++dt) {
                const LAS bf16_t* vp = vbase + dt * (16 * VS) + kk * 32;
                o[dt] = mfma16(cat8(*(const LAS bf16x4*)vp, *(const LAS bf16x4*)(vp + 16)), pb, o[dt]);
            }
        }
        bf16_t* op = mix + ((tok >> 7) * 16 + 8 + hq) * 8192 + (tok & 127) * 64 + fq * 4;
#pragma unroll
        for (int dt = 0; dt < 4; ++dt) { u32x2 wv; wv.x = pk2(o[dt][0] * inv, o[dt][1] * inv); wv.y = pk2(o[dt][2] * inv, o[dt][3] * inv); *(u32x2*)(op + dt * 16) = wv; }
    }
    __syncthreads();
}

__device__ __forceinline__ float log_sigmoid(float t) { return -log1pf(__expf(-t)); }
__device__ __forceinline__ void retkv_item(int item, const bf16_t* __restrict__ proj, float* __restrict__ kvf, float* __restrict__ kvb, const float* __restrict__ theta, LAS unsigned char* lds, int tid) {
    const int h = item & 3, c = (item >> 2) & 31, b = item >> 7;
    const float lgf = log_sigmoid(theta[h]), lgb = log_sigmoid(theta[4 + h]);
    LAS bf16_t* KTf = (LAS bf16_t*)lds; LAS bf16_t* KTb = KTf + 64 * 136; LAS bf16_t* VT = KTb + 64 * 136;
#pragma unroll
    for (int i = 0; i < 2; ++i) {
        const int id = tid + NTHR * i, j = id >> 3, ch = id & 7;
        const int prow = b * SEQ + c * 128 + j;
        const u32x4 kr = *(const u32x4*)PROJ_AT(proj, prow, 256 + h * 64 + ch * 8), vr = *(const u32x4*)PROJ_AT(proj, prow, 512 + h * 64 + ch * 8);
        const float wf = __expf(lgf * (float)(127 - j)) * 0.125f, wb = __expf(lgb * (float)j) * 0.125f;
        const int o = (ch * 8) * 136 + j;
        KTf[o + 0 * 136] = (bf16_t)f2bf(bflo(kr.x) * wf); KTf[o + 1 * 136] = (bf16_t)f2bf(bfhi(kr.x) * wf); KTf[o + 2 * 136] = (bf16_t)f2bf(bflo(kr.y) * wf); KTf[o + 3 * 136] = (bf16_t)f2bf(bfhi(kr.y) * wf);
        KTf[o + 4 * 136] = (bf16_t)f2bf(bflo(kr.z) * wf); KTf[o + 5 * 136] = (bf16_t)f2bf(bfhi(kr.z) * wf); KTf[o + 6 * 136] = (bf16_t)f2bf(bflo(kr.w) * wf); KTf[o + 7 * 136] = (bf16_t)f2bf(bfhi(kr.w) * wf);
        KTb[o + 0 * 136] = (bf16_t)f2bf(bflo(kr.x) * wb); KTb[o + 1 * 136] = (bf16_t)f2bf(bfhi(kr.x) * wb); KTb[o + 2 * 136] = (bf16_t)f2bf(bflo(kr.y) * wb); KTb[o + 3 * 136] = (bf16_t)f2bf(bfhi(kr.y) * wb);
        KTb[o + 4 * 136] = (bf16_t)f2bf(bflo(kr.z) * wb); KTb[o + 5 * 136] = (bf16_t)f2bf(bfhi(kr.z) * wb); KTb[o + 6 * 136] = (bf16_t)f2bf(bflo(kr.w) * wb); KTb[o + 7 * 136] = (bf16_t)f2bf(bfhi(kr.w) * wb);
        VT[o + 0 * 136] = (bf16_t)(vr.x & 0xffffu); VT[o + 1 * 136] = (bf16_t)(vr.x >> 16); VT[o + 2 * 136] = (bf16_t)(vr.y & 0xffffu); VT[o + 3 * 136] = (bf16_t)(vr.y >> 16);
        VT[o + 4 * 136] = (bf16_t)(vr.z & 0xffffu); VT[o + 5 * 136] = (bf16_t)(vr.z >> 16); VT[o + 6 * 136] = (bf16_t)(vr.w & 0xffffu); VT[o + 7 * 136] = (bf16_t)(vr.w >> 16);
    }
    __syncthreads();
    const int lane = tid & 63, w = tid >> 6, fr = lane & 15, fq = lane >> 4;
    const size_t obase = (size_t)((b * 32 + c) * 4 + h) * 4096;
#pragma unroll
    for (int i = 0; i < 4; ++i) {
        const int job = w * 4 + i, dirb = job >> 4, et = (job >> 2) & 3, dt = job & 3;
        const LAS bf16_t* ap = VT + (et * 16 + fr) * 136 + fq * 8;
        const LAS bf16_t* bp = (dirb ? KTb : KTf) + (dt * 16 + fr) * 136 + fq * 8;
        f32x4 acc = {0.f, 0.f, 0.f, 0.f};
#pragma unroll
        for (int ks = 0; ks < 4; ++ks) acc = mfma16(*(const LAS bf16x8*)(ap + ks * 32), *(const LAS bf16x8*)(bp + ks * 32), acc);
        float* op = (dirb ? kvb : kvf) + obase + (et * 16 + fq * 4) * 64 + dt * 16 + fr;
        op[0] = acc[0]; op[64] = acc[1]; op[128] = acc[2]; op[192] = acc[3];
    }
    __syncthreads();
}
__device__ __forceinline__ void retout_item(int item, const bf16_t* __restrict__ proj, const float* __restrict__ stf, const float* __restrict__ stb, bf16_t* __restrict__ mix, const float* __restrict__ theta, LAS unsigned char* lds, int tid) {
    const int h = item & 3, c = (item >> 2) & 31, b = item >> 7;
    const float lgf = log_sigmoid(theta[h]), lgb = log_sigmoid(theta[4 + h]);
    LAS bf16_t* Qs = (LAS bf16_t*)lds; LAS bf16_t* Ks = Qs + 128 * 72; LAS bf16_t* VT = Ks + 128 * 72; LAS bf16_t* SFt = VT + 64 * 136; LAS bf16_t* SBt = SFt + 64 * 72;
#pragma unroll
    for (int i = 0; i < 2; ++i) {
        const int id = tid + NTHR * i, j = id >> 3, ch = id & 7;
        const int prow = b * SEQ + c * 128 + j;
        const u32x4 qr = *(const u32x4*)PROJ_AT(proj, prow, h * 64 + ch * 8), kr = *(const u32x4*)PROJ_AT(proj, prow, 256 + h * 64 + ch * 8), vr = *(const u32x4*)PROJ_AT(proj, prow, 512 + h * 64 + ch * 8);
        *(LAS u32x4*)(Qs + j * 72 + ch * 8) = qr; *(LAS u32x4*)(Ks + j * 72 + ch * 8) = kr;
        const int o = (ch * 8) * 136 + j;
        VT[o + 0 * 136] = (bf16_t)(vr.x & 0xffffu); VT[o + 1 * 136] = (bf16_t)(vr.x >> 16); VT[o + 2 * 136] = (bf16_t)(vr.y & 0xffffu); VT[o + 3 * 136] = (bf16_t)(vr.y >> 16);
        VT[o + 4 * 136] = (bf16_t)(vr.z & 0xffffu); VT[o + 5 * 136] = (bf16_t)(vr.z >> 16); VT[o + 6 * 136] = (bf16_t)(vr.w & 0xffffu); VT[o + 7 * 136] = (bf16_t)(vr.w >> 16);
    }
    const size_t sbase = (size_t)((b * 32 + c) * 4 + h) * 4096;
#pragma unroll
    for (int i = 0; i < 8; ++i) { const int id = tid + NTHR * i, e = id >> 6, d = id & 63; SFt[e * 72 + d] = (bf16_t)f2bf(stf[sbase + id]); SBt[e * 72 + d] = (bf16_t)f2bf(stb[sbase + id]); }
    __syncthreads();
    const int lane = tid & 63, it = tid >> 6, fr = lane & 15, fq = lane >> 4;
    const int ipos = it * 16 + fr;
    const LAS bf16_t* qp = Qs + ipos * 72 + fq * 8;
    const bf16x8 qb0 = *(const LAS bf16x8*)qp, qb1 = *(const LAS bf16x8*)(qp + 32);
    f32x4 st[8];
#pragma unroll
    for (int jt = 0; jt < 8; ++jt) {
        const LAS bf16_t* kp = Ks + (jt * 16 + fr) * 72 + fq * 8;
        f32x4 acc = {0.f, 0.f, 0.f, 0.f};
        acc = mfma16(*(const LAS bf16x8*)kp, qb0, acc); acc = mfma16(*(const LAS bf16x8*)(kp + 32), qb1, acc);
#pragma unroll
        for (int jj = 0; jj < 4; ++jj) { const int dij = ipos - (jt * 16 + fq * 4 + jj); const float dec = dij >= 0 ? __expf(lgf * (float)dij) : __expf(lgb * (float)(-dij)); acc[jj] *= 0.125f * dec; }
        st[jt] = acc;
    }
    f32x4 o[4], ff[4], fb[4];
#pragma unroll
    for (int et = 0; et < 4; ++et) { o[et] = (f32x4){0.f, 0.f, 0.f, 0.f}; ff[et] = o[et]; fb[et] = o[et]; }
#pragma unroll
    for (int kk = 0; kk < 4; ++kk) {
        const bf16x8 pb = pack8(st[2 * kk], st[2 * kk + 1]);
#pragma unroll
        for (int et = 0; et < 4; ++et) { const LAS bf16_t* vp = VT + (et * 16 + fr) * 136 + kk * 32 + fq * 4; o[et] = mfma16(cat8(*(const LAS bf16x4*)vp, *(const LAS bf16x4*)(vp + 16)), pb, o[et]); }
    }
#pragma unroll
    for (int et = 0; et < 4; ++et) {
        const LAS bf16_t* fp = SFt + (et * 16 + fr) * 72 + fq * 8; const LAS bf16_t* bp = SBt + (et * 16 + fr) * 72 + fq * 8;
        ff[et] = mfma16(*(const LAS bf16x8*)fp, qb0, ff[et]); ff[et] = mfma16(*(const LAS bf16x8*)(fp + 32), qb1, ff[et]);
        fb[et] = mfma16(*(const LAS bf16x8*)bp, qb0, fb[et]); fb[et] = mfma16(*(const LAS bf16x8*)(bp + 32), qb1, fb[et]);
    }
    const float cf = __expf(lgf * (float)(ipos + 1)), cb = __expf(lgb * (float)(128 - ipos));
    float s = 0.f;
#pragma unroll
    for (int et = 0; et < 4; ++et) { o[et] = o[et] + ff[et] * cf + fb[et] * cb; s += (o[et][0] + o[et][1]) + (o[et][2] + o[et][3]); }
    s += __shfl_xor(s, 16); s += __shfl_xor(s, 32);
    const float mean = s * (1.f / 64.f); float s2 = 0.f;
#pragma unroll
    for (int et = 0; et < 4; ++et) { o[et] = o[et] - mean; s2 += (o[et][0] * o[et][0] + o[et][1] * o[et][1]) + (o[et][2] * o[et][2] + o[et][3] * o[et][3]); }
    s2 += __shfl_xor(s2, 16); s2 += __shfl_xor(s2, 32);
    const float rstd = 1.f / sqrtf(s2 * (1.f / 64.f) + LN_EPS);
    const size_t tok = (size_t)b * SEQ + c * 128 + ipos;
    const bf16_t* gp = PROJ_AT(proj, tok, 768 + h * 64 + fq * 4);
    bf16_t* op = mix + ((tok >> 7) * 16 + h) * 8192 + (tok & 127) * 64 + fq * 4;
#pragma unroll
    for (int et = 0; et < 4; ++et) {
        const u32x2 gr = *(const u32x2*)(gp + et * 16);
        const float g0 = bflo(gr.x), g1 = bfhi(gr.x), g2 = bflo(gr.y), g3 = bfhi(gr.y);
        const float y0 = o[et][0] * rstd * (g0 / (1.f + __expf(-g0))), y1 = o[et][1] * rstd * (g1 / (1.f + __expf(-g1)));
        const float y2 = o[et][2] * rstd * (g2 / (1.f + __expf(-g2))), y3 = o[et][3] * rstd * (g3 / (1.f + __expf(-g3)));
        u32x2 wv; wv.x = pk2(y0, y1); wv.y = pk2(y2, y3); *(u32x2*)(op + et * 16) = wv;
    }
    __syncthreads();
}

constexpr int S5XS = 136;
struct S5Pass { bf16x8 bf[8]; f32x4 t0; };
__device__ __forceinline__ void s5_fetch(S5Pass& P, const float* __restrict__ tab, const bf16_t* __restrict__ BT, int g, int r, int lane) {
    const int fr = lane & 15, fq = lane >> 4;
    P.t0 = *(const f32x4*)(tab + (size_t)((r * 16 + g) * 64 + lane) * 8);
    const bf16_t* btp = BT + (size_t)(g * 256 + r * 128 + fr) * 32 + fq * 8;
#pragma unroll
    for (int nt = 0; nt < 8; ++nt) P.bf[nt] = *(const bf16x8*)(btp + nt * 16 * 32);
}
__device__ __forceinline__ void s5_bu(LAS bf16_t* Xw, const S5Pass& P, bf16x8 uf0, bf16x8 uf1, int lane) {
    const int fr = lane & 15, fq = lane >> 4;
#pragma unroll
    for (int mt = 0; mt < 2; ++mt)
#pragma unroll
        for (int nt = 0; nt < 8; ++nt) {
            f32x4 acc = {0.f, 0.f, 0.f, 0.f};
            acc = mfma16(P.bf[nt], mt ? uf1 : uf0, acc);
            u32x2 wv; wv.x = pk2(acc[0], acc[1]); wv.y = pk2(acc[2], acc[3]);
            *(LAS u32x2*)(Xw + (mt * 16 + fr) * S5XS + nt * 16 + fq * 4) = wv;
        }
    asm volatile("s_waitcnt lgkmcnt(0)" ::: "memory");
}
template <bool WRITE>
__device__ __forceinline__ void s5_recur(LAS bf16_t* xq, int r, float lr_, float li_, float& xr, float& xi) {
#pragma unroll 1
    for (int blk = 0; blk < 4; ++blk) {
        LAS bf16_t* q = xq + (r ? (3 - blk) : blk) * (8 * S5XS);
        unsigned bw[8];
#pragma unroll
        for (int k = 0; k < 8; ++k) bw[k] = *(const LAS unsigned*)(q + k * S5XS);
        if (r == 0) {
#pragma unroll
            for (int s = 0; s < 8; ++s) {
                const float nr = fmaf(lr_, xr, fmaf(-li_, xi, bflo(bw[s]))), ni = fmaf(lr_, xi, fmaf(li_, xr, bfhi(bw[s])));
                xr = nr; xi = ni;
                if (WRITE) *(LAS unsigned*)(q + s * S5XS) = pk2(xr, xi);
            }
        } else {
#pragma unroll
            for (int s = 7; s >= 0; --s) {
                const float nr = fmaf(lr_, xr, fmaf(-li_, xi, bflo(bw[s]))), ni = fmaf(lr_, xi, fmaf(li_, xr, bfhi(bw[s])));
                xr = nr; xi = ni;
                if (WRITE) *(LAS unsigned*)(q + s * S5XS) = pk2(xr, xi);
            }
        }
    }
    if (WRITE) asm volatile("s_waitcnt lgkmcnt(0)" ::: "memory");
}
__device__ __forceinline__ void s5_ufrag(const bf16_t* __restrict__ proj, int b, int ch, int g, int lane, bf16x8& uf0, bf16x8& uf1) {
    const int fr = lane & 15, fq = lane >> 4;
    uf0 = (bf16x8){0, 0, 0, 0, 0, 0, 0, 0}; uf1 = uf0;
    if (fq < 2) { const bf16_t* up = PROJ_AT(proj, b * SEQ + ch * S5T + fr, 1024 + g * 16 + fq * 8); uf0 = *(const bf16x8*)up; uf1 = *(const bf16x8*)(up + 16 * 64); }
}

__device__ __forceinline__ void s5e_item(int item, const bf16_t* __restrict__ proj, const float* __restrict__ tab  , const bf16_t* __restrict__ BT,
                                         float* __restrict__ E, LAS unsigned char* lds, int tid) {
    const int ch = item & (S5NCH - 1), b = item / S5NCH;
    const int lane = tid & 63, w = tid >> 6;
    LAS bf16_t* Xw = (LAS bf16_t*)lds + w * (32 * S5XS);
    S5Pass cur;
    s5_fetch(cur, tab, BT, w, 0, lane);
    bf16x8 uf0, uf1;
    s5_ufrag(proj, b, ch, w, lane, uf0, uf1);
#pragma unroll 1
    for (int ps = 0; ps < 4; ++ps) {
        const int g = w + 8 * (ps >> 1), r = ps & 1;
        const float lr_ = cur.t0[0], li_ = cur.t0[1];
        s5_bu(Xw, cur, uf0, uf1, lane);
        if (ps < 3) s5_fetch(cur, tab, BT, w + 8 * ((ps + 1) >> 1), (ps + 1) & 1, lane);
        if (ps == 1) s5_ufrag(proj, b, ch, w + 8, lane, uf0, uf1);
        float xr = 0.f, xi = 0.f;
        s5_recur<false>(Xw + lane * 2, r, lr_, li_, xr, xi);
        float2 ev; ev.x = xr; ev.y = xi;
        ((float2*)E)[(size_t)(((b * S5NCH + ch) * 16 + g) * 2 + r) * 64 + lane] = ev;
        asm volatile("s_waitcnt lgkmcnt(0)" ::: "memory");
    }
    __syncthreads();
}
__device__ __forceinline__ void s5out_item(int item, const bf16_t* __restrict__ proj, const float* __restrict__ tab, const bf16_t* __restrict__ BT,
                                           const bf16_t* __restrict__ CT  , const float* __restrict__ dvec, const bf16_t* __restrict__ wgluT, const float* __restrict__ bglu,
                                           const float* __restrict__ CIN, bf16_t* __restrict__ mix, LAS unsigned char* lds, int tid) {
    const int ch = item & (S5NCH - 1), b = item / S5NCH;
    constexpr int YS = 264;
    const int lane = tid & 63, w = tid >> 6, fr = lane & 15, fq = lane >> 4;
    LAS bf16_t* Xw = (LAS bf16_t*)lds + w * (32 * S5XS);
    LAS bf16_t* Y = (LAS bf16_t*)(lds + 8 * 32 * S5XS * 2);
    S5Pass cur; bf16x8 ccf[4]; float2 ccin;
    s5_fetch(cur, tab, BT, w, 0, lane);
    ccin = ((const float2*)CIN)[(size_t)(((b * S5NCH + ch) * 16 + w) * 2 + 0) * 64 + lane];
#pragma unroll
    for (int ks = 0; ks < 4; ++ks) ccf[ks] = *(const bf16x8*)(CT + (size_t)(w * 16 + fr) * 256 + ks * 32 + fq * 8);
    bf16x8 uf0, uf1;
    s5_ufrag(proj, b, ch, w, lane, uf0, uf1);
    f32x4 ya0 = {0.f, 0.f, 0.f, 0.f}, ya1 = ya0;
#pragma unroll 1
    for (int ps = 0; ps < 4; ++ps) {
        const int g = w + 8 * (ps >> 1), r = ps & 1;
        const int gn = w + 8 * ((ps + 1) >> 1), rn = (ps + 1) & 1;
        const float lr_ = cur.t0[0], li_ = cur.t0[1];
        s5_bu(Xw, cur, uf0, uf1, lane);
        if (ps < 3) s5_fetch(cur, tab, BT, gn, rn, lane);
        if (ps == 1) s5_ufrag(proj, b, ch, w + 8, lane, uf0, uf1);
        float xr = ccin.x, xi = ccin.y;
        s5_recur<true>(Xw + lane * 2, r, lr_, li_, xr, xi);
        if (ps < 3) ccin = ((const float2*)CIN)[(size_t)(((b * S5NCH + ch) * 16 + gn) * 2 + rn) * 64 + lane];
#pragma unroll
        for (int ks = 0; ks < 4; ++ks) {
            ya0 = mfma16(ccf[ks], *(const LAS bf16x8*)(Xw + fr * S5XS + ks * 32 + fq * 8), ya0);
            ya1 = mfma16(ccf[ks], *(const LAS bf16x8*)(Xw + (16 + fr) * S5XS + ks * 32 + fq * 8), ya1);
        }
        if (ps < 3) {
#pragma unroll
            for (int ks = 0; ks < 4; ++ks) ccf[ks] = *(const bf16x8*)(CT + (size_t)(gn * 16 + fr) * 256 + rn * 128 + ks * 32 + fq * 8);
        }
        if (r == 1) {
            const int chn = g * 16 + fq * 4;
            const f32x4 dv = *(const f32x4*)(dvec + chn);
#pragma unroll
            for (int mt = 0; mt < 2; ++mt) {
                const int s = mt * 16 + fr;
                const u32x2 uw = *(const u32x2*)PROJ_AT(proj, b * SEQ + ch * S5T + s, 1024 + chn);
                const float uu[4] = {bflo(uw.x), bfhi(uw.x), bflo(uw.y), bfhi(uw.y)};
                float gl4[4];
#pragma unroll
                for (int jj = 0; jj < 4; ++jj) {
                    const float yv = (mt ? ya1[jj] : ya0[jj]) + dv[jj] * uu[jj];
                    const float t = 0.7978845608028654f * (yv + 0.044715f * yv * yv * yv);
                    gl4[jj] = yv * (1.f - __builtin_amdgcn_rcpf(1.f + __expf(2.f * t)));
                }
                u32x2 yw; yw.x = pk2(gl4[0], gl4[1]); yw.y = pk2(gl4[2], gl4[3]);
                *(LAS u32x2*)(Y + s * YS + chn) = yw;
            }
            ya0 = (f32x4){0.f, 0.f, 0.f, 0.f}; ya1 = ya0;
        }
        asm volatile("s_waitcnt lgkmcnt(0)" ::: "memory");
    }
    __syncthreads();
    {
        const int mt = w & 1;
        bf16x8 yf[8];
#pragma unroll
        for (int ks = 0; ks < 8; ++ks) yf[ks] = *(const LAS bf16x8*)(Y + (mt * 16 + fr) * YS + ks * 32 + fq * 8);
        const int s = mt * 16 + fr;
        const size_t tokm = (size_t)(b * SEQ + ch * S5T + s);
        bf16_t* orow = mix + ((tokm >> 7) * 16 + 4) * 8192 + (tokm & 127) * 64;
#pragma unroll 2
        for (int i = 0; i < 4; ++i) {
            const int nt = (w >> 1) * 4 + i;
            const bf16_t* ap = wgluT + (size_t)(nt * 16 + fr) * 256 + fq * 8;
            f32x4 acc = {0.f, 0.f, 0.f, 0.f};
#pragma unroll
            for (int ks = 0; ks < 8; ++ks) acc = mfma16(*(const bf16x8*)(ap + ks * 32), yf[ks], acc);
            const int n0 = nt * 16 + fq * 4;
            const f32x4 bg = *(const f32x4*)(bglu + n0);
            const u32x2 yw = *(const LAS u32x2*)(Y + s * YS + n0);
            const float yv[4] = {bflo(yw.x), bfhi(yw.x), bflo(yw.y), bfhi(yw.y)};
            float ov[4];
#pragma unroll
            for (int jj = 0; jj < 4; ++jj) ov[jj] = yv[jj] * __builtin_amdgcn_rcpf(1.f + __expf(-(acc[jj] + bg[jj])));
            u32x2 ow; ow.x = pk2(ov[0], ov[1]); ow.y = pk2(ov[2], ov[3]);
            *(u32x2*)(orow + (n0 >> 6) * 8192 + (n0 & 63)) = ow;
        }
    }
    __syncthreads();
}

__device__ __forceinline__ void phase_scan(const Args& a, int l, int tid) {
    unsigned char* ws = a.ws;
    const int lane = tid & 63, wave = tid >> 6;
    {
        const float* tab = (const float*)(ws + WS_S5TAB) + (size_t)l * 2048 * 8;
        const float2* __restrict__ E = (const float2*)(ws + WS_S5E); float2* __restrict__ C = (float2*)(ws + WS_S5C);
        for (int wv = blockIdx.x; wv < 128; wv += gridDim.x) if (wave == 0) {
            const int p = lane, r = wv & 1, g = (wv >> 1) & 15, b = wv >> 5;
            const float* tp = tab + (size_t)((r * 16 + g) * 64 + p) * 8;
            const float tr = tp[4], ti = tp[5];
            float xr = 0.f, xi = 0.f;
            for (int k0 = 0; k0 < S5NCH; k0 += 32) {
                float2 e[32];
#pragma unroll
                for (int k = 0; k < 32; ++k) { const int ch = r ? (S5NCH - 1 - (k0 + k)) : (k0 + k); e[k] = E[(size_t)(((b * S5NCH + ch) * 16 + g) * 2 + r) * 64 + p]; }
#pragma unroll
                for (int k = 0; k < 32; ++k) { const int ch = r ? (S5NCH - 1 - (k0 + k)) : (k0 + k);
                    float2 cv; cv.x = xr; cv.y = xi; C[(size_t)(((b * S5NCH + ch) * 16 + g) * 2 + r) * 64 + p] = cv;
                    const float nr = fmaf(tr, xr, fmaf(-ti, xi, e[k].x)), ni = fmaf(tr, xi, fmaf(ti, xr, e[k].y));
                    xr = nr; xi = ni; }
            }
        }
    }
    {
        const float* theta = a.in[4] + l * 8;
        const float* __restrict__ kvf = (const float*)(ws + WS_KVF); const float* __restrict__ kvb = (const float*)(ws + WS_KVB);
        float* __restrict__ stf = (float*)(ws + WS_STF); float* __restrict__ stb = (float*)(ws + WS_STB);
        for (int gid = blockIdx.x * NTHR + tid; gid < 131072; gid += gridDim.x * NTHR) {
            const int el = gid & 4095, dir = (gid >> 12) & 1, h = (gid >> 13) & 3, b = gid >> 15;
            const float dec = __expf(log_sigmoid(theta[dir * 4 + h]) * 128.f);
            const float* __restrict__ kv = dir ? kvb : kvf; float* __restrict__ st = dir ? stb : stf;
            float s = 0.f;
            for (int c0 = 0; c0 < 32; c0 += 16) {
                float kk[16];
#pragma unroll
                for (int k = 0; k < 16; ++k) { const int c = dir ? (31 - (c0 + k)) : (c0 + k); kk[k] = kv[(size_t)((b * 32 + c) * 4 + h) * 4096 + el]; }
#pragma unroll
                for (int k = 0; k < 16; ++k) { const int c = dir ? (31 - (c0 + k)) : (c0 + k); st[(size_t)((b * 32 + c) * 4 + h) * 4096 + el] = s; s = fmaf(dec, s, kk[k]); }
            }
        }
    }
}

__device__ __forceinline__ float router_softmax(const float (&sp)[16], int lane) {
    const bool b5 = (lane & 32) != 0, b4 = (lane & 16) != 0, b3 = (lane & 8) != 0, b2 = (lane & 4) != 0;
    float t8[8], t4[4], t2[2];
#pragma unroll
    for (int i = 0; i < 8; ++i) { const float snd = b5 ? sp[i] : sp[i + 8], kp = b5 ? sp[i + 8] : sp[i]; t8[i] = kp + __shfl_xor(snd, 32); }
#pragma unroll
    for (int i = 0; i < 4; ++i) { const float snd = b4 ? t8[i] : t8[i + 4], kp = b4 ? t8[i + 4] : t8[i]; t4[i] = kp + __shfl_xor(snd, 16); }
#pragma unroll
    for (int i = 0; i < 2; ++i) { const float snd = b3 ? t4[i] : t4[i + 2], kp = b3 ? t4[i + 2] : t4[i]; t2[i] = kp + __shfl_xor(snd, 8); }
    float lgt; { const float snd = b2 ? t2[0] : t2[1], kp = b2 ? t2[1] : t2[0]; lgt = kp + __shfl_xor(snd, 4); }
    lgt += __shfl_xor(lgt, 1); lgt += __shfl_xor(lgt, 2);
    float mx = lgt;
#pragma unroll
    for (int o = 4; o < 64; o <<= 1) mx = fmaxf(mx, __shfl_xor(mx, o));
    const float ex = expf(lgt - mx);
    float sum = ex;
#pragma unroll
    for (int o = 4; o < 64; o <<= 1) sum += __shfl_xor(sum, o);
    return ex / sum;
}
__device__ __forceinline__ void phase_ln1_router(const Args& a, int l, LAS unsigned char* lds, int tid) {
    unsigned char* ws = a.ws;
    const int lane = tid & 63, wave = tid >> 6;
    LAS float* rwT = (LAS float*)lds;
    const float* rw = a.in[19] + (size_t)l * DM * NE;
    for (int i = tid; i < DM * NE; i += NTHR) rwT[(i & 15) * DM + (i >> 4)] = rw[i];
    __syncthreads();
    const float* pre = (const float*)(ws + WS_RA);
    float* afft = (float*)(ws + WS_AFFT);
    const int gw = blockIdx.x * NWAVES + wave, NGW = gridDim.x * NWAVES;
    for (int m = gw; m < MTOK; m += 2 * NGW) {
        const int m1 = m + NGW; const bool has1 = m1 < MTOK; const int mb = has1 ? m1 : m;
        f32x4 v0[4], v1[4];
#pragma unroll
        for (int j = 0; j < 4; ++j) { v0[j] = ((const f32x4*)(pre + (size_t)m * DM))[lane + 64 * j]; v1[j] = ((const f32x4*)(pre + (size_t)mb * DM))[lane + 64 * j]; }
        ln_rows4(v0, a.in[17] + l * DM, a.in[18] + l * DM, lane);
        ln_rows4(v1, a.in[17] + l * DM, a.in[18] + l * DM, lane);
        store_row(v0, nullptr, (bf16_t*)(ws + WS_HBF) + (size_t)m * DM, lane);
        if (has1) store_row(v1, nullptr, (bf16_t*)(ws + WS_HBF) + (size_t)m1 * DM, lane);
        float sp0[16], sp1[16];
#pragma unroll
        for (int eg = 0; eg < 4; ++eg) {
#pragma unroll
            for (int ee = 0; ee < 4; ++ee) { const int e = eg * 4 + ee; float s0 = 0.f, s1 = 0.f;
#pragma unroll
                for (int j = 0; j < 4; ++j) { const f32x4 wv = *(const LAS f32x4*)(rwT + e * DM + 256 * j + 4 * lane);
                    s0 += (v0[j][0] * wv[0] + v0[j][1] * wv[1]) + (v0[j][2] * wv[2] + v0[j][3] * wv[3]);
                    s1 += (v1[j][0] * wv[0] + v1[j][1] * wv[1]) + (v1[j][2] * wv[2] + v1[j][3] * wv[3]); }
                sp0[e] = s0; sp1[e] = s1; }
            asm volatile("" ::: "memory");
        }
        const float af0 = router_softmax(sp0, lane), af1 = router_softmax(sp1, lane);
        if ((lane & 3) == 0) {
            afft[(size_t)((m / SEQ) * NE + (lane >> 2)) * SEQ + (m % SEQ)] = af0;
            if (has1) afft[(size_t)((m1 / SEQ) * NE + (lane >> 2)) * SEQ + (m1 % SEQ)] = af1;
        }
    }
    __syncthreads();
}

__device__ __forceinline__ void select_item(int item, const Args& a, LAS unsigned char* lds, int tid) {
    unsigned char* ws = a.ws;
    const int q = item & 3, e = (item >> 2) & 15, b = item >> 6;
    const int lane = tid & 63, wave = tid >> 6;
    LAS unsigned* red = (LAS unsigned*)lds;
    LAS int* sel = (LAS int*)(lds + 1024);
    const float* av = (const float*)(ws + WS_AFFT) + (size_t)(b * NE + e) * SEQ + tid * 8;
    const f32x4 va = *(const f32x4*)av, vb = *(const f32x4*)(av + 4);
    unsigned v[8] = {__float_as_uint(va[0]), __float_as_uint(va[1]), __float_as_uint(va[2]), __float_as_uint(va[3]), __float_as_uint(vb[0]), __float_as_uint(vb[1]), __float_as_uint(vb[2]), __float_as_uint(vb[3])};
    unsigned x = 0u;
    for (int bit = 30; bit >= 0; --bit) {
        const unsigned cand = x | (1u << bit);
        unsigned cnt = 0u;
#pragma unroll
        for (int j = 0; j < 8; ++j) cnt += (unsigned)__popcll(__ballot(v[j] >= cand));
        LAS unsigned* rb = red + (bit & 1) * 8;
        if (lane == 0) rb[wave] = cnt;
        __syncthreads();
        unsigned tot = 0u;
#pragma unroll
        for (int k = 0; k < 8; ++k) tot += rb[k];
        if (tot >= (unsigned)CAP) x = cand;
    }
    unsigned mycnt = 0u;
#pragma unroll
    for (int j = 0; j < 8; ++j) mycnt += (v[j] > x ? 1u : 0u) + (v[j] == x ? 0x10000u : 0u);
    unsigned inc = mycnt;
#pragma unroll
    for (int o = 1; o < 64; o <<= 1) { const unsigned t = __shfl_up(inc, o); if (lane >= o) inc += t; }
    LAS unsigned* wsum = red + 64;
    __syncthreads();
    if (lane == 63) wsum[wave] = inc;
    __syncthreads();
    unsigned wpre = 0u, total = 0u;
#pragma unroll
    for (int k = 0; k < 8; ++k) { const unsigned t = wsum[k]; if (k < wave) wpre += t; total += t; }
    const unsigned excl = wpre + inc - mycnt;
    unsigned gtb = excl & 0xffffu, eqb = excl >> 16;
    const unsigned need = (unsigned)CAP - (total & 0xffffu);
    const int rowbase = (e * NB + b) * CAP;
    int* idx = (int*)(ws + WS_IDX); float* gate = (float*)(ws + WS_GATE); int* slotmap = (int*)(ws + WS_SLOT);
    const bool own_tok = ((tid >> 7) == q);
#pragma unroll
    for (int j = 0; j < 8; ++j) {
        const bool isgt = v[j] > x, iseq = v[j] == x;
        const bool issel = isgt || (iseq && eqb < need);
        const unsigned slot = gtb + (eqb < need ? eqb : need);
        const int tok = b * SEQ + tid * 8 + j;
        if (issel && (int)(slot >> 7) == q) { idx[rowbase + slot] = tok; gate[rowbase + slot] = __uint_as_float(v[j]); }
        if (own_tok) slotmap[(size_t)tok * NE + e] = issel ? (int)(rowbase + slot) : -1;
        gtb += isgt ? 1u : 0u; eqb += iseq ? 1u : 0u;
    }
    __syncthreads();
}

__device__ __forceinline__ void phase_ln2(const Args& a, int l, int tid) {
    unsigned char* ws = a.ws;
    const int lane = tid & 63, wave = tid >> 6;
    const int gw = blockIdx.x * NWAVES + wave, NGW = gridDim.x * NWAVES;
    const bf16_t* hbf = (const bf16_t*)(ws + WS_HBF); const int* slotmap = (const int*)(ws + WS_SLOT); const bf16_t* contrib = (const bf16_t*)(ws + WS_RB);
    const bool last = (l == 1);
    u32x2 vn[4]; int slot_n = -1;
    if (gw < MTOK) {
#pragma unroll
        for (int j = 0; j < 4; ++j) vn[j] = ((const u32x2*)(hbf + (size_t)gw * DM))[lane + 64 * j];
        slot_n = slotmap[(size_t)gw * NE + (lane & 15)];
    }
    for (int m = gw; m < MTOK; m += NGW) {
        f32x4 v[4];
#pragma unroll
        for (int j = 0; j < 4; ++j) { v[j][0] = bflo(vn[j].x) * ALPHA; v[j][1] = bfhi(vn[j].x) * ALPHA; v[j][2] = bflo(vn[j].y) * ALPHA; v[j][3] = bfhi(vn[j].y) * ALPHA; }
        const int myslot = slot_n;
        unsigned bal = (unsigned)(__ballot(myslot >= 0) & 0xffffull);
        int r0 = -1, r1 = -1, r2 = -1, r3 = -1;
        if (bal) { r0 = __shfl(myslot, __builtin_ctz(bal)); bal &= bal - 1; }
        if (bal) { r1 = __shfl(myslot, __builtin_ctz(bal)); bal &= bal - 1; }
        if (bal) { r2 = __shfl(myslot, __builtin_ctz(bal)); bal &= bal - 1; }
        if (bal) { r3 = __shfl(myslot, __builtin_ctz(bal)); bal &= bal - 1; }
        u32x2 c0[4], c1[4], c2[4], c3[4];
#pragma unroll
        for (int j = 0; j < 4; ++j) { c0[j] = (u32x2){0u, 0u}; c1[j] = c0[j]; c2[j] = c0[j]; c3[j] = c0[j]; }
        if (r0 >= 0) {
#pragma unroll
            for (int j = 0; j < 4; ++j) c0[j] = ((const u32x2*)(contrib + (size_t)r0 * DM))[lane + 64 * j]; }
        if (r1 >= 0) {
#pragma unroll
            for (int j = 0; j < 4; ++j) c1[j] = ((const u32x2*)(contrib + (size_t)r1 * DM))[lane + 64 * j]; }
        if (r2 >= 0) {
#pragma unroll
            for (int j = 0; j < 4; ++j) c2[j] = ((const u32x2*)(contrib + (size_t)r2 * DM))[lane + 64 * j]; }
        if (r3 >= 0) {
#pragma unroll
            for (int j = 0; j < 4; ++j) c3[j] = ((const u32x2*)(contrib + (size_t)r3 * DM))[lane + 64 * j]; }
        if (m + NGW < MTOK) {
#pragma unroll
            for (int j = 0; j < 4; ++j) vn[j] = ((const u32x2*)(hbf + (size_t)(m + NGW) * DM))[lane + 64 * j];
            slot_n = slotmap[(size_t)(m + NGW) * NE + (lane & 15)];
        }
#pragma unroll
        for (int j = 0; j < 4; ++j) {
            v[j][0] += bflo(c0[j].x); v[j][1] += bfhi(c0[j].x); v[j][2] += bflo(c0[j].y); v[j][3] += bfhi(c0[j].y);
            v[j][0] += bflo(c1[j].x); v[j][1] += bfhi(c1[j].x); v[j][2] += bflo(c1[j].y); v[j][3] += bfhi(c1[j].y);
            v[j][0] += bflo(c2[j].x); v[j][1] += bfhi(c2[j].x); v[j][2] += bflo(c2[j].y); v[j][3] += bfhi(c2[j].y);
            v[j][0] += bflo(c3[j].x); v[j][1] += bfhi(c3[j].x); v[j][2] += bflo(c3[j].y); v[j][3] += bfhi(c3[j].y);
        }
        while (bal) {
            const int row = __shfl(myslot, __builtin_ctz(bal)); bal &= bal - 1;
            const u32x2* cr = (const u32x2*)(contrib + (size_t)row * DM);
#pragma unroll
            for (int j = 0; j < 4; ++j) { const u32x2 wv = cr[lane + 64 * j]; v[j][0] += bflo(wv.x); v[j][1] += bfhi(wv.x); v[j][2] += bflo(wv.y); v[j][3] += bfhi(wv.y); }
        }
        ln_rows4(v, a.in[23] + l * DM, a.in[24] + l * DM, lane);
        if (last) store_row(v, a.out + (size_t)m * DM, nullptr, lane);
        else store_row(v, nullptr, (bf16_t*)(ws + WS_HBF) + (size_t)m * DM, lane);
    }
}

typedef __attribute__((address_space(1))) unsigned gu32;
#define RLX_AGENT __ATOMIC_RELAXED, __HIP_MEMORY_SCOPE_AGENT
#define XB_TMO      128
#define XB_XCNT(j)  (256  + 64 * (j))
#define XB_XSUB(j)  (1280 + 64 * (j))
#define XB_XGEN(j)  (2304 + 64 * (j))
#define XB_TOP      3328
#define XB_TOPGEN   3392
#define XCD_BAR_WORDS 3456
#define XB_SPIN_CAP (1u << 18)

__device__ __forceinline__ unsigned xb_ld(unsigned* p)              { return __hip_atomic_load(p, __ATOMIC_RELAXED, __HIP_MEMORY_SCOPE_AGENT); }
__device__ __forceinline__ unsigned xb_add(unsigned* p, unsigned v) { return __hip_atomic_fetch_add(p, v, __ATOMIC_RELAXED, __HIP_MEMORY_SCOPE_AGENT); }
__device__ __forceinline__ unsigned xb_xcc_id() { return (unsigned)__builtin_amdgcn_s_getreg((3 << 11) | 20) & 0xFu; }
#define XB_SPIN(cond, bar) do { unsigned _sp = 0; while (cond) { __builtin_amdgcn_s_sleep(1); \
    if ((++_sp & 255u) == 0u) { if (xb_ld(&(bar)[XB_TMO])) break; if (_sp > XB_SPIN_CAP) { atomicAdd(&(bar)[XB_TMO], 1u); break; } } } } while (0)

struct XcdBarrier {
    unsigned* bar; unsigned x;
    volatile LAS unsigned* st;
};

__device__ __forceinline__ XcdBarrier xcd_barrier_post(unsigned* bar, volatile LAS unsigned* st) {
    XcdBarrier b; b.bar = bar; b.x = xb_xcc_id(); b.st = st;
    if (threadIdx.x == 0) (void)xb_add(&bar[XB_XCNT(b.x)], 1u);
    return b;
}
__device__ __forceinline__ void xcd_barrier_complete(unsigned* bar, unsigned x, unsigned& nloc, unsigned& nx) {
    const unsigned G = gridDim.x * gridDim.y * gridDim.z;
    unsigned sum, cnt, mine, sp = 0u;
    for (;;) {
        sum = 0u; cnt = 0u; mine = 0u;
#pragma unroll
        for (unsigned j = 0; j < 16; ++j) { const unsigned c = xb_ld(&bar[XB_XCNT(j)]); sum += c; cnt += (c > 0u) ? 1u : 0u; mine = (j == x) ? c : mine; }
        if (sum == G) break;
        __builtin_amdgcn_s_sleep(1);
        if ((++sp & 255u) == 0u) { if (xb_ld(&bar[XB_TMO])) break; if (sp > XB_SPIN_CAP) { atomicAdd(&bar[XB_TMO], 1u); break; } }
    }
    nloc = mine > 0u ? mine : 1u; nx = cnt > 0u ? cnt : 1u;
}

__device__ __forceinline__ void xcd_barrier(const XcdBarrier& b) {
    asm volatile("s_waitcnt vmcnt(0)" ::: "memory");
    __syncthreads();
    if (threadIdx.x == 0) {
        unsigned* bar = b.bar;
        __builtin_amdgcn_s_waitcnt(0);
        unsigned nloc = b.st[0], nx = b.st[1];
        if (nloc == 0u) { xcd_barrier_complete(bar, b.x, nloc, nx); b.st[0] = nloc; b.st[1] = nx; }
        const unsigned old = xb_add(&bar[XB_XSUB(b.x)], 1u);
        const unsigned gen = old / nloc;
        if (old + 1u == (gen + 1u) * nloc) {
            __builtin_amdgcn_fence(__ATOMIC_RELEASE, "agent");
            asm volatile("s_waitcnt vmcnt(0)" ::: "memory");
            const unsigned og = xb_add(&bar[XB_TOP], 1u);
            const unsigned tg = og / nx;
            if (og + 1u == (tg + 1u) * nx) xb_add(&bar[XB_TOPGEN], 1u);
            else XB_SPIN(xb_ld(&bar[XB_TOPGEN]) == tg, bar);
            __builtin_amdgcn_fence(__ATOMIC_ACQUIRE, "agent");
            xb_add(&bar[XB_XGEN(b.x)], 1u);
            asm volatile("s_waitcnt vmcnt(0)" ::: "memory");
        } else {
            XB_SPIN(xb_ld(&bar[XB_XGEN(b.x)]) == gen, bar);
            __builtin_amdgcn_fence(__ATOMIC_ACQUIRE, "agent");
            asm volatile("s_waitcnt vmcnt(0)" ::: "memory");
        }
    }
    __syncthreads();
}

constexpr int NPHASES = 21;
#ifndef REP_MASK
#define REP_MASK 0
#endif
template <int L, int K>
__device__ __forceinline__ void run_phase(const Args& a, LAS unsigned char* lds, int tid) {
    unsigned char* ws = a.ws;
    constexpr int l = L;
    bf16_t* proj = (bf16_t*)(ws + WS_RA); bf16_t* mix = (bf16_t*)(ws + WS_RB);
    if constexpr (K == 0) {
        pg8::Gemm g{(const bf16_t*)(ws + WS_HBF), (const bf16_t*)(ws + WS_WIN) + (size_t)l * DIN * DM, MTOK, DIN, DM};
        pg8::StaticOrder S; S.init(MTOK, DIN, (int)gridDim.x, (int)blockIdx.x);
        pg8::EpiStoreBf16 E{proj, DIN};
        pg8::gemm_phase<pg8::EpiStoreBf16, pg8::StaticOrder, true, true>(lds, g, S, E);
    } else if constexpr (K == 1) {
        const float* tab = (const float*)(ws + WS_S5TAB) + (size_t)l * 2048 * 8;
        constexpr int XB = ((REP_MASK >> 11) & 1) ? 512 : ((REP_MASK >> 12) & 1) ? 256 : ((REP_MASK >> 13) & 1) ? 512 : 0, XOFF = ((REP_MASK >> 11) & 1) ? 0 : ((REP_MASK >> 12) & 1) ? 512 : 768;
        for (int it0 = blockIdx.x; it0 < 1280 + XB; it0 += gridDim.x) {
            const int it = it0 < 1280 ? it0 : it0 - 1280 + XOFF;
            if (it < 512) s5e_item(it, proj, tab, (const bf16_t*)(ws + WS_S5BT) + (size_t)l * 4096 * 32, (float*)(ws + WS_S5E), lds, tid);
            else if (it < 768) attn_item(it - 512, proj, mix, a.in[15] + l * 8, lds, tid);
            else retkv_item(it - 768, proj, (float*)(ws + WS_KVF), (float*)(ws + WS_KVB), a.in[4] + l * 8, lds, tid);
        }
    } else if constexpr (K == 2) {
        phase_scan(a, l, tid);
    } else if constexpr (K == 3) {
        const float* tab = (const float*)(ws + WS_S5TAB) + (size_t)l * 2048 * 8;
        constexpr int XD = ((REP_MASK >> 14) & 3) ? 512 : 0, XOFD = ((REP_MASK >> 14) & 1) ? 0 : 512;
        for (int it0 = blockIdx.x; it0 < 1024 + XD; it0 += gridDim.x) {
            const int it = it0 < 1024 ? it0 : it0 - 1024 + XOFD;
            if (it < 512) s5out_item(it, proj, tab, (const bf16_t*)(ws + WS_S5BT) + (size_t)l * 4096 * 32, (const bf16_t*)(ws + WS_S5CT) + (size_t)l * 65536, a.in[12] + l * 256,
                                     (const bf16_t*)(ws + WS_WGLU) + (size_t)l * 65536, a.in[14] + l * 256, (const float*)(ws + WS_S5C), mix, lds, tid);
            else retout_item(it - 512, proj, (const float*)(ws + WS_STF), (const float*)(ws + WS_STB), mix, a.in[4] + l * 8, lds, tid);
        }
    } else if constexpr (K == 4) {
        pg8::Gemm g{mix, (const bf16_t*)(ws + WS_WOUT) + (size_t)l * DM * DM, MTOK, DM, DM};
        pg8::StaticOrder S; S.init(MTOK, DM, (int)gridDim.x, (int)blockIdx.x);
        pg8::EpiResF32 E{(const bf16_t*)(ws + WS_HBF), (float*)(ws + WS_RA), DM, ALPHA};
        pg8::gemm_phase<pg8::EpiResF32, pg8::StaticOrder, true, true, false, true>(lds, g, S, E);
    } else if constexpr (K == 5) {
        phase_ln1_router(a, l, lds, tid);
    } else if constexpr (K == 6) {
        for (int it = blockIdx.x; it < 256; it += gridDim.x) select_item(it, a, lds, tid);
    } else if constexpr (K == 7) {
        pg8::Gemm g{(const bf16_t*)(ws + WS_HBF), (const bf16_t*)(ws + WS_WGU) + (size_t)l * NE * 2 * FF * DM, NROWX, NE * 2 * FF, DM};
        pg8::GroupedOrder S; S.init(16, (int)gridDim.x, (int)blockIdx.x);
        pg8::EpiSwiGLU E{(bf16_t*)(ws + WS_HDN), FF, 16};
        pg8::gemm_phase<pg8::EpiSwiGLU, pg8::GroupedOrder, true, true, true>(lds, g, S, E, (const int*)(ws + WS_IDX));
    } else if constexpr (K == 8) {
        pg8::Gemm g{(const bf16_t*)(ws + WS_HDN), (const bf16_t*)(ws + WS_WD) + (size_t)l * NE * DM * FF, NROWX, NE * DM, FF};
        pg8::GroupedOrder S; S.init(4, (int)gridDim.x, (int)blockIdx.x);
        pg8::EpiScaleRow E{(bf16_t*)(ws + WS_RB), DM, 4, (const float*)(ws + WS_GATE)};
        pg8::gemm_phase<pg8::EpiScaleRow, pg8::GroupedOrder, true, true, false, true>(lds, g, S, E);
    } else {
        phase_ln2(a, l, tid);
    }
}
__global__ void __launch_bounds__(NTHR, 2) fwd_kernel(Args a) {
    extern __shared__ __attribute__((aligned(16))) unsigned char lds_raw[];
    LAS unsigned char* lds = (LAS unsigned char*)lds_raw;
    cg::grid_group grid = cg::this_grid();
    const int lo = a.ph_lo, hi = a.ph_hi;
    volatile LAS unsigned* bst = (volatile LAS unsigned*)(lds + LDS_BYTES - 64);
    if (threadIdx.x < 16) bst[threadIdx.x] = 0u;
    __syncthreads();
    XcdBarrier bar = xcd_barrier_post((unsigned*)(a.ws + WS_BAR), bst);
    if (hi > 1000) grid.sync();
#define PH_BEGIN(ph) if (lo <= (ph) && (ph) < hi) { int tid = threadIdx.x; asm volatile("" : "+v"(tid));
#define PH_END(ph) if ((ph) + 1 < hi) xcd_barrier(bar); }
    PH_BEGIN(0) for (int rep = 0; rep <= ((REP_MASK >> 10) & 1); ++rep) phase_p0(a, lds, tid); PH_END(0)
#define LAYER(L) \
    PH_BEGIN(1 + 10 * L + 0) for (int rep = 0; rep <= ((REP_MASK >> 0) & 1); ++rep) run_phase<L, 0>(a, lds, tid); PH_END(1 + 10 * L + 0) \
    PH_BEGIN(1 + 10 * L + 1) for (int rep = 0; rep <= ((REP_MASK >> 1) & 1); ++rep) run_phase<L, 1>(a, lds, tid); PH_END(1 + 10 * L + 1) \
    PH_BEGIN(1 + 10 * L + 2) for (int rep = 0; rep <= ((REP_MASK >> 2) & 1); ++rep) run_phase<L, 2>(a, lds, tid); PH_END(1 + 10 * L + 2) \
    PH_BEGIN(1 + 10 * L + 3) for (int rep = 0; rep <= ((REP_MASK >> 3) & 1); ++rep) run_phase<L, 3>(a, lds, tid); PH_END(1 + 10 * L + 3) \
    PH_BEGIN(1 + 10 * L + 4) for (int rep = 0; rep <= ((REP_MASK >> 4) & 1); ++rep) run_phase<L, 4>(a, lds, tid); PH_END(1 + 10 * L + 4) \
    PH_BEGIN(1 + 10 * L + 5) for (int rep = 0; rep <= ((REP_MASK >> 5) & 1); ++rep) run_phase<L, 5>(a, lds, tid); PH_END(1 + 10 * L + 5) \
    PH_BEGIN(1 + 10 * L + 6) for (int rep = 0; rep <= ((REP_MASK >> 6) & 1); ++rep) run_phase<L, 6>(a, lds, tid); PH_END(1 + 10 * L + 6) \
    PH_BEGIN(1 + 10 * L + 7) for (int rep = 0; rep <= ((REP_MASK >> 7) & 1); ++rep) run_phase<L, 7>(a, lds, tid); PH_END(1 + 10 * L + 7) \
    PH_BEGIN(1 + 10 * L + 8) for (int rep = 0; rep <= ((REP_MASK >> 8) & 1); ++rep) run_phase<L, 8>(a, lds, tid); PH_END(1 + 10 * L + 8) \
    PH_BEGIN(1 + 10 * L + 9) for (int rep = 0; rep <= (((REP_MASK >> 9) & 1) && L == 1 ? 1 : 0); ++rep) run_phase<L, 9>(a, lds, tid); PH_END(1 + 10 * L + 9)
    LAYER(0)
    LAYER(1)
#undef LAYER
#undef PH_BEGIN
#undef PH_END
}

#ifndef ONE_LAUNCH
#define ONE_LAUNCH 1
#endif
extern "C" void kernel_launch(void* const* d_in, const int* in_sizes, int n_in, void* d_out, int out_size, void* d_ws, size_t ws_size, hipStream_t stream) {
    static int grid = 0;
    if (grid == 0) {
        if (n_in != 25 || ws_size < WS_END) { fprintf(stderr, "kernel_launch: unexpected problem (n_in %d, ws %zu)\n", n_in, ws_size); grid = -1; return; }
        int dev = 0, cus = 0, per_cu = 0;
        (void)hipGetDevice(&dev);
        (void)hipDeviceGetAttribute(&cus, hipDeviceAttributeMultiprocessorCount, dev);
        if (hipFuncSetAttribute((const void*)fwd_kernel, hipFuncAttributeMaxDynamicSharedMemorySize, LDS_BYTES) != hipSuccess) { fprintf(stderr, "kernel_launch: hipFuncSetAttribute failed\n"); grid = -1; return; }
        if (hipOccupancyMaxActiveBlocksPerMultiprocessor(&per_cu, (const void*)fwd_kernel, NTHR, LDS_BYTES) != hipSuccess || per_cu < 1) { fprintf(stderr, "kernel_launch: occupancy query says %d\n", per_cu); per_cu = 1; }
        (void)hipGetLastError();
        if (cus <= 0) cus = 256;
        grid = cus * per_cu;
    }
    if (grid < 0) return;
    Args a{};
    for (int i = 0; i < 25; ++i) a.in[i] = (const float*)d_in[i];
    a.out = (float*)d_out; a.ws = (unsigned char*)d_ws;
#if ONE_LAUNCH
    if (hipMemsetAsync((char*)d_ws + WS_BAR, 0, 16384, stream) != hipSuccess) { fprintf(stderr, "kernel_launch: memset failed\n"); return; }
    a.ph_lo = 0; a.ph_hi = NPHASES;
    void* args[] = {&a};
    hipError_t e = hipLaunchCooperativeKernel((const void*)fwd_kernel, dim3(grid), dim3(NTHR), args, LDS_BYTES, stream);
    if (e != hipSuccess) fprintf(stderr, "kernel_launch: cooperative launch failed: %s (grid %d)\n", hipGetErrorString(e), grid);
#else
    for (int ph = 0; ph < NPHASES; ++ph) {
        a.ph_lo = ph; a.ph_hi = ph + 1;
        hipLaunchKernelGGL(fwd_kernel, dim3(grid), dim3(NTHR), LDS_BYTES, stream, a);
    }
#endif
}
```
